# Optimizing an MI355X kernel written in HIP

```python
import jax, jax.numpy as jnp
from jax import lax
import numpy as np

D_MODEL = 2048
BATCH = 2
SEQ = 16384
DEPTH = 1

CTX_LEN = 256
GRID_W = 64
D_MIX = D_MODEL
GLA_HEADS = 4
GLA_WIDTH = D_MIX // 2
GLA_DV = GLA_WIDTH // GLA_HEADS
GLA_DK = GLA_DV // 2
GLA_QK = GLA_HEADS * GLA_DK
GATE_RANK = 16
GATE_NORMALIZER = 16.0
CHUNK = 64
FOURIER_WIDTH = D_MIX - GLA_WIDTH
FOURIER_GROUPS = 8
FOURIER_GROUP_DIM = FOURIER_WIDTH // FOURIER_GROUPS
N_EXPERTS = 16
CAPACITY_FACTOR = 2
D_EXPERT = D_MODEL // 2
EPS = 1e-6
PROJ_WIDTH = 2 * GLA_QK + 2 * GLA_WIDTH + 2 * GATE_RANK + FOURIER_WIDTH
SPLIT_POINTS = (GLA_QK, 2 * GLA_QK, 2 * GLA_QK + GLA_WIDTH, 2 * GLA_QK + 2 * GLA_WIDTH,
                2 * GLA_QK + 2 * GLA_WIDTH + GATE_RANK, 2 * GLA_QK + 2 * GLA_WIDTH + 2 * GATE_RANK)

kernel_name = 'hybrid_gla_fnet_ec_moe_diffusion_block'


def rms_norm(x, g):
    xf = x.astype(jnp.float32)
    y = xf * lax.rsqrt(jnp.mean(xf * xf, axis=-1, keepdims=True) + EPS)
    return (y * g.astype(jnp.float32)).astype(x.dtype)


def modulate(h, shift, scale):
    return h * (1 + scale) + shift


def ada_params(cond, w_ada, b_ada):
    return jnp.split(jax.nn.silu(cond) @ w_ada + b_ada, 6, axis=-1)


def split_projection(p, w_a2_f, b_a2_f, w_a2_b, b_a2_b):
    q, k, v, g, z_f, z_b, u = jnp.split(p, SPLIT_POINTS, axis=-1)
    log_a_f = jax.nn.log_sigmoid((z_f @ w_a2_f + b_a2_f).astype(jnp.float32)) / GATE_NORMALIZER
    log_a_b = jax.nn.log_sigmoid((z_b @ w_a2_b + b_a2_b).astype(jnp.float32)) / GATE_NORMALIZER
    heads = lambda t: t.reshape(t.shape[0], t.shape[1], GLA_HEADS, -1).transpose(0, 2, 1, 3)
    return heads(q), heads(k), heads(v), g, heads(log_a_f), heads(log_a_b), u


def gla_chunked(q, k, v, log_a, s0):
    b, h, l, dk = q.shape
    dv = v.shape[-1]
    n = l // CHUNK
    q = (q.astype(jnp.float32) * dk ** -0.5).reshape(b, h, n, CHUNK, dk)
    k = k.astype(jnp.float32).reshape(b, h, n, CHUNK, dk)
    v = v.astype(jnp.float32).reshape(b, h, n, CHUNK, dv)
    cum = jnp.cumsum(log_a.astype(jnp.float32).reshape(b, h, n, CHUNK, dk), axis=3)
    cum_last = cum[:, :, :, -1:, :]
    q_dec = q * jnp.exp(cum)
    k_inv = k * jnp.exp(-cum)
    k_to_end = k * jnp.exp(cum_last - cum)
    in_chunk = jnp.tril(jnp.ones((CHUNK, CHUNK), dtype=bool))
    scores = jnp.where(in_chunk, jnp.einsum('bhnid,bhnjd->bhnij', q_dec, k_inv), 0.0)
    o_intra = jnp.einsum('bhnij,bhnjv->bhniv', scores, v)
    chunk_decay = jnp.exp(cum_last[:, :, :, 0, :])
    xs = tuple(jnp.moveaxis(t, 2, 0) for t in (q_dec, k_to_end, v, chunk_decay))

    def step(state, inp):
        q_n, k_n, v_n, d_n = inp
        o_n = jnp.einsum('bhid,bhdv->bhiv', q_n, state)
        state = d_n[..., None] * state + jnp.einsum('bhjd,bhjv->bhdv', k_n, v_n)
        return state, o_n

    s_final, o_inter = lax.scan(step, s0.astype(jnp.float32), xs)
    o = o_intra + jnp.moveaxis(o_inter, 0, 2)
    return o.reshape(b, h, l, dv), s_final


def gla_bidirectional(q, k, v, log_a_f, log_a_b, s0_f, s0_b):
    rev = lambda t: jnp.flip(t, axis=2)
    o_f, s_f = gla_chunked(q, k, v, log_a_f, s0_f)
    o_b, s_b = gla_chunked(rev(q), rev(k), rev(v), rev(log_a_b), s0_b)
    return o_f + rev(o_b), s_f, s_b


def fourier_mix(u):
    b, l, _ = u.shape
    uf = u.astype(jnp.float32).reshape(b, l, FOURIER_GROUPS, FOURIER_GROUP_DIM)
    y = jnp.fft.fft2(uf, axes=(1, 3), norm='ortho').real
    return y.reshape(b, l, FOURIER_WIDTH).astype(u.dtype)


def merge_heads(o, g, u, gla_norm_g, w_out):
    b, h, l, dv = o.shape
    o = o.transpose(0, 2, 1, 3)
    o = o * lax.rsqrt(jnp.mean(o * o, axis=-1, keepdims=True) + EPS)
    o = o * gla_norm_g.reshape(GLA_HEADS, GLA_DV).astype(jnp.float32)
    y_gla = (o.reshape(b, l, GLA_WIDTH) * jax.nn.silu(g.astype(jnp.float32))).astype(g.dtype)
    return jnp.concatenate([y_gla, fourier_mix(u)], axis=-1) @ w_out


def ec_moe(h, w_router, w_gate, w_up, w_down):
    b, l, d = h.shape
    cap = CAPACITY_FACTOR * l // N_EXPERTS
    aff = jax.nn.softmax(jnp.einsum('bld,de->ble', h, w_router).astype(jnp.float32), axis=-1)
    gate, idx = lax.top_k(jnp.swapaxes(aff, 1, 2), cap)
    xe = jax.vmap(lambda hb, ib: hb[ib])(h, idx)
    hid = jax.nn.silu(jnp.einsum('becd,edf->becf', xe, w_gate)) * jnp.einsum('becd,edf->becf', xe, w_up)
    ye = jnp.einsum('becf,efd->becd', hid, w_down) * gate[..., None].astype(h.dtype)
    combine = lambda yb, ib: jnp.zeros((l, d), yb.dtype).at[ib.reshape(-1)].add(yb.reshape(-1, d))
    return jax.vmap(combine)(ye, idx)


def setup_inputs(seed: int = 0) -> dict:
    key = jax.random.key(seed)
    ks = jax.random.split(key, 24)
    nrm = lambda k, shape, s: jax.random.normal(k, shape, jnp.float32) * s
    D, L = DEPTH, D_MODEL
    return {
        'x': nrm(ks[0], (BATCH, SEQ, D_MODEL), 1.0),
        'c': nrm(ks[1], (BATCH, D_MODEL), 1.0),
        'ctx': nrm(ks[2], (BATCH, CTX_LEN, D_MODEL), 1.0),
        'c_ctx': nrm(ks[3], (D_MODEL,), 1.0),
        'w_ada': nrm(ks[4], (D, D_MODEL, 6 * D_MODEL), D_MODEL ** -0.5),
        'b_ada': nrm(ks[5], (D, 6 * D_MODEL), 0.02),
        'norm1_g': 1.0 + nrm(ks[6], (D, D_MODEL), 0.02),
        'w_in': nrm(ks[7], (D, D_MODEL, PROJ_WIDTH), D_MODEL ** -0.5),
        'w_a2_f': nrm(ks[8], (D, GATE_RANK, GLA_QK), GATE_RANK ** -0.5),
        'b_a2_f': nrm(ks[9], (D, GLA_QK), 0.1),
        'w_a2_b': nrm(ks[10], (D, GATE_RANK, GLA_QK), GATE_RANK ** -0.5),
        'b_a2_b': nrm(ks[11], (D, GLA_QK), 0.1),
        'gla_norm_g': 1.0 + nrm(ks[12], (D, GLA_WIDTH), 0.02),
        'w_out': nrm(ks[13], (D, D_MIX, D_MODEL), D_MIX ** -0.5),
        'norm2_g': 1.0 + nrm(ks[14], (D, D_MODEL), 0.02),
        'w_router': nrm(ks[15], (D, D_MODEL, N_EXPERTS), D_MODEL ** -0.5),
        'w_e_gate': nrm(ks[16], (D, N_EXPERTS, D_MODEL, D_EXPERT), D_MODEL ** -0.5),
        'w_e_up': nrm(ks[17], (D, N_EXPERTS, D_MODEL, D_EXPERT), D_MODEL ** -0.5),
        'w_e_down': nrm(ks[18], (D, N_EXPERTS, D_EXPERT, D_MODEL), D_EXPERT ** -0.5),
        'final_norm_g': 1.0 + nrm(ks[19], (D_MODEL,), 0.02),
    }


def reference(x, c, ctx, c_ctx, w_ada, b_ada, norm1_g, w_in, w_a2_f, b_a2_f, w_a2_b, b_a2_b,
              gla_norm_g, w_out, norm2_g, w_router, w_e_gate, w_e_up, w_e_down, final_norm_g):
    b, l, _ = x.shape
    rows = l // GRID_W
    assert rows * GRID_W == l
    zero_state = jnp.zeros((b, GLA_HEADS, GLA_DK, GLA_DV), jnp.float32)
    x_lat, x_ctx = x, ctx
    for layer in range(DEPTH):
        is_last = layer == DEPTH - 1
        sh1_l, sc1_l, g1_l, sh2_l, sc2_l, g2_l = [m[:, None, :] for m in ada_params(c, w_ada[layer], b_ada[layer])]
        sh1_c, sc1_c, g1_c, sh2_c, sc2_c, g2_c = ada_params(c_ctx, w_ada[layer], b_ada[layer])
        gate_w = (w_a2_f[layer], b_a2_f[layer], w_a2_b[layer], b_a2_b[layer])

        h_c = modulate(rms_norm(x_ctx, norm1_g[layer]), sh1_c, sc1_c)
        q_c, k_c, v_c, gt_c, laf_c, lab_c, u_c = split_projection(h_c @ w_in[layer], *gate_w)
        o_c, s_f, s_b = gla_bidirectional(q_c, k_c, v_c, laf_c, lab_c, zero_state, zero_state)

        h_l = modulate(rms_norm(x_lat, norm1_g[layer]), sh1_l, sc1_l)
        q_l, k_l, v_l, gt_l, laf_l, lab_l, u_l = split_projection(h_l @ w_in[layer], *gate_w)
        o_l, _, _ = gla_bidirectional(q_l, k_l, v_l, laf_l, lab_l, s_f, s_b)
        x_lat = x_lat + g1_l * merge_heads(o_l, gt_l, u_l, gla_norm_g[layer], w_out[layer])

        if not is_last:
            x_ctx = x_ctx + g1_c * merge_heads(o_c, gt_c, u_c, gla_norm_g[layer], w_out[layer])
            hf_c = modulate(rms_norm(x_ctx, norm2_g[layer]), sh2_c, sc2_c)
            x_ctx = x_ctx + g2_c * ec_moe(hf_c, w_router[layer], w_e_gate[layer], w_e_up[layer], w_e_down[layer])

        hf_l = modulate(rms_norm(x_lat, norm2_g[layer]), sh2_l, sc2_l)
        x_lat = x_lat + g2_l * ec_moe(hf_l, w_router[layer], w_e_gate[layer], w_e_up[layer], w_e_down[layer])
    return rms_norm(x_lat, final_norm_g)
```

```cpp
#include <hip/hip_runtime.h>
#include <hip/hip_cooperative_groups.h>
#include <cstdio>
#include <cstdint>
namespace cg = cooperative_groups;

#define LAS __attribute__((address_space(3)))
typedef unsigned short bf16;
typedef short bf16x8 __attribute__((ext_vector_type(8)));
typedef float f32x4 __attribute__((ext_vector_type(4)));
typedef float f32x2 __attribute__((ext_vector_type(2)));
typedef unsigned u32x4 __attribute__((ext_vector_type(4)));
typedef unsigned u32x2 __attribute__((ext_vector_type(2)));

constexpr int NB = 2, SEQ = 16384, DM = 2048, CTXL = 256;
constexpr int NLAT = NB * SEQ;
constexpr int NROWS = NLAT + NB * CTXL;
constexpr int PROJW = 4128;
constexpr int NE = 16, CAP = 2048, DEXP = 1024;
constexpr int PW = 4096;
constexpr int WIN_ROWS = 4352;
constexpr float EPS = 1e-6f;

constexpr size_t MiB = 1u << 20;
constexpr size_t WS_ADA = 0;
constexpr size_t WS_TW = 1 * MiB;
constexpr size_t WS_Z = 2 * MiB;
constexpr size_t WS_AFF = 8 * MiB;
constexpr size_t WS_TOK = 10 * MiB;
constexpr size_t WS_GATE = 11 * MiB;
constexpr size_t WS_SEL = 12 * MiB;
constexpr size_t WS_ST0 = 14 * MiB;
constexpr size_t WS_WIN = 32 * MiB;
constexpr size_t WS_WOUT = 50 * MiB;
constexpr size_t WS_WGU = 58 * MiB;
constexpr size_t WS_WD = 186 * MiB;
constexpr size_t WS_P = 250 * MiB;
constexpr size_t WS_HF = 250 * MiB;
constexpr size_t WS_HID = 378 * MiB;
constexpr size_t WS_FX = 250 * MiB;
constexpr size_t WS_FA = 510 * MiB;
constexpr size_t WS_H = 510 * MiB;
constexpr size_t WS_OF = 510 * MiB;
constexpr size_t WS_OB = 638 * MiB;
constexpr size_t WS_XL = 510 * MiB;
constexpr size_t WS_YCAT = 766 * MiB;
constexpr size_t WS_YE = 766 * MiB;
constexpr size_t WS_END = 1022 * MiB;

constexpr int LDS_BYTES = 147456;
constexpr int NTHREADS = 512;

struct Args {
    const float* in[20];
    float* out;
    unsigned char* ws;
    int ph_lo, ph_hi;
};

__device__ __forceinline__ float bf2f(bf16 v) { return __uint_as_float(((unsigned)v) << 16); }
__device__ __forceinline__ unsigned f2bf(float f) { unsigned u = __float_as_uint(f); return (u + 0x7fffu + ((u >> 16) & 1u)) >> 16; }
__device__ __forceinline__ unsigned pk2(float lo, float hi) { return f2bf(lo) | (f2bf(hi) << 16); }
__device__ __forceinline__ float wave_sum(float v) {
#pragma unroll
    for (int o = 1; o < 64; o <<= 1) v += __shfl_xor(v, o);
    return v;
}
__device__ __forceinline__ float silu_f(float x) { return x / (1.f + __expf(-x)); }
__device__ __forceinline__ float logsigmoid_f(float x) { return fminf(x, 0.f) - log1pf(expf(-fabsf(x))); }

namespace pg8 {
constexpr int BM = 256, BK = 64, HALF = 128, HTB = HALF * BK * 2, STAGE_BYTES = 8 * HTB, NXCD = 8, WGM = 8;
__host__ __device__ __forceinline__ int lds_byte(int r, int c) { const int st = (r >> 4) * 2 + (c >> 5), rr = r & 15, cc = c & 31, ob = rr * 64 + cc * 2; return st * 1024 + (ob ^ (((ob >> 9) & 1) << 5)); }
__host__ __device__ __forceinline__ void stage_rc(int b, int& R, int& C) { const int st = b / 1024, sb = b % 1024, swz = sb ^ (((sb >> 9) & 1) << 5); R = (st >> 1) * 16 + swz / 64; C = (st & 1) * 32 + (swz % 64) / 2; }
__host__ __device__ __forceinline__ int perm32(int rho) { const int n = rho >> 4, i = rho & 15; return 8 * (i >> 2) + 4 * n + (i & 3); }
struct Unit { int pm, pn; };
__device__ __forceinline__ unsigned cvt_pk_bf16(float lo, float hi) { unsigned r; asm volatile("v_cvt_pk_bf16_f32 %0, %1, %2" : "=v"(r) : "v"(lo), "v"(hi)); return r; }

struct OrderBase {
    int nM, nN, nwg, G, c;
    __device__ void init(int nM_, int nN_, int G_, int c_) { nM = nM_; nN = nN_; nwg = nM * nN; G = G_; c = c_; }
    __device__ bool next(int i, Unit& u) const {
        const long L = (long)i * G + c; if (L >= nwg) return false;
        int wgid = (int)L; { const int q = nwg / NXCD, r = nwg % NXCD, xcd = wgid % NXCD, off = wgid / NXCD; wgid = (xcd < r ? xcd * (q + 1) : r * (q + 1) + (xcd - r) * q) + off; }
        const int nig = WGM * nN, gid = wgid / nig, fm = gid * WGM, gsz = (nM - fm) < WGM ? (nM - fm) : WGM;
        u.pm = fm + ((wgid % nig) % gsz); u.pn = (wgid % nig) / gsz; return true;
    }
};

template <class Epi, class Sched, bool GATHER, bool ALIGN_EPI, bool SP2>
__device__ __forceinline__ void gemm_phase(LAS unsigned char* lds, const int K, const Sched& S, const Epi& E) {
    const int tid = threadIdx.x, wid = __builtin_amdgcn_readfirstlane(tid >> 6), lane = tid & 63, wr = wid >> 2, wc = wid & 3, fr = lane & 15, fq = lane >> 4;
    const int nt = K / BK;
    unsigned voffA[2], voffA1[2], voffB[2];
    int RA[2], CA[2];
#pragma unroll
    for (int i = 0; i < 2; ++i) { int R, C; stage_rc(tid * 16 + i * 8192, R, C); const int Rb = Epi::PERM ? ((R & ~31) + perm32(R & 31)) : R;
        RA[i] = R; CA[i] = C;
        voffA[i] = (unsigned)(R * K + C) * 2u; voffA1[i] = voffA[i]; voffB[i] = (unsigned)(Rb * K + C) * 2u; }
    const size_t kstep = (size_t)(BK * 2);
    const size_t hstep = (size_t)HALF * K * 2;
    const size_t hstepA = GATHER ? 0 : hstep;
    const unsigned ldsw = (unsigned)wid * 1024u;
    const int aoff = lds_byte(wr * 64 + fr, fq * 8), boff = lds_byte(wc * 32 + fr, fq * 8);
#define PG8_SA(b, h) (((b) * 2 + (h)) * HTB)
#define PG8_SB(b, h) ((4 + (b) * 2 + (h)) * HTB)
#define PG8_STAGE(bufoff, gbase, voff) do { _Pragma("unroll") for (int _i = 0; _i < 2; ++_i) \
        __builtin_amdgcn_global_load_lds((const unsigned*)((const char*)(gbase) + (voff)[_i]), (LAS unsigned*)(lds + (bufoff) + ldsw + _i * 8192), 16, 0, 0); } while (0)
#define PG8_LDA(dst, b, h) do { _Pragma("unroll") for (int m = 0; m < 4; ++m) _Pragma("unroll") for (int k = 0; k < 2; ++k) dst[m][k] = *(const LAS bf16x8*)(lds + PG8_SA(b, h) + aoff + m * 2048 + k * 1024); } while (0)
#define PG8_LDB(dst, b, h) do { _Pragma("unroll") for (int n = 0; n < 2; ++n) _Pragma("unroll") for (int k = 0; k < 2; ++k) dst[n][k] = *(const LAS bf16x8*)(lds + PG8_SB(b, h) + boff + n * 2048 + k * 1024); } while (0)
#define PG8_MMA(ai, bj, At, Bt) do { __builtin_amdgcn_s_setprio(1); _Pragma("unroll") for (int m = 0; m < 4; ++m) _Pragma("unroll") for (int n = 0; n < 2; ++n) _Pragma("unroll") for (int k = 0; k < 2; ++k) \
        acc[ai][bj][m][n] = __builtin_amdgcn_mfma_f32_16x16x32_bf16(Bt[n][k], At[m][k], acc[ai][bj][m][n], 0, 0, 0); __builtin_amdgcn_s_setprio(0); } while (0)
#define PG8_WAIT_V(n) asm volatile("s_waitcnt vmcnt(" #n ")" ::: "memory")
#define PG8_WAIT_L(n) asm volatile("s_waitcnt lgkmcnt(" #n ")" ::: "memory")
#define PG8_BAR __builtin_amdgcn_s_barrier()
#define PG8_SCHED __builtin_amdgcn_sched_barrier(0)
    Unit cur, nxt; int ui = 0;
    if (!S.next(0, cur)) return;
    f32x4 acc[2][2][4][2];
#pragma unroll
    for (int a = 0; a < 2; ++a)
#pragma unroll
        for (int b = 0; b < 2; ++b)
#pragma unroll
            for (int m = 0; m < 4; ++m)
#pragma unroll
                for (int n = 0; n < 2; ++n) acc[a][b][m][n] = (f32x4){0.f, 0.f, 0.f, 0.f};
    bf16x8 At[4][2], B0[2][2], B1[2][2];
    const char* cA = S.abase(cur); const char* cB = S.bbase(cur);
    if constexpr (GATHER) {
#pragma unroll
        for (int i = 0; i < 2; ++i) { voffA[i] = ((unsigned)S.arow(cur, RA[i]) * (unsigned)K + (unsigned)CA[i]) * 2u; voffA1[i] = ((unsigned)S.arow(cur, HALF + RA[i]) * (unsigned)K + (unsigned)CA[i]) * 2u; }
    }
    static_assert(SP2, "only the SP2 loop is kept");
    PG8_STAGE(PG8_SB(0, 0), cB, voffB); PG8_STAGE(PG8_SB(0, 1), cB + hstep, voffB); PG8_STAGE(PG8_SA(0, 0), cA, voffA); PG8_STAGE(PG8_SA(0, 1), cA + hstepA, voffA1);
    if (wr == 1) PG8_BAR;
    PG8_WAIT_V(2); PG8_BAR;
    PG8_STAGE(PG8_SB(1, 0), cB + kstep, voffB); PG8_STAGE(PG8_SA(1, 0), cA + kstep, voffA); PG8_STAGE(PG8_SB(1, 1), cB + hstep + kstep, voffB);
    PG8_WAIT_V(6); PG8_BAR;
    for (;;) {
        const bool has_next = S.next(ui + 1, nxt);
        const char* nA = has_next ? S.abase(nxt) : cA; const char* nB = has_next ? S.bbase(nxt) : cB;
        for (int t = 0; t < nt; t += 2) {
            const bool last = (t == nt - 2);
            const char* a1 = cA + (size_t)(t + 1) * kstep;
            const char* a2 = last ? nA : cA + (size_t)(t + 2) * kstep; const char* b2 = last ? nB : cB + (size_t)(t + 2) * kstep;
            const char* a3 = a2 + kstep; const char* b3 = b2 + kstep;
            PG8_LDB(B0, 0, 0); PG8_LDB(B1, 0, 1); PG8_SCHED; PG8_LDA(At, 0, 0); PG8_STAGE(PG8_SA(1, 1), a1 + hstepA, voffA1);
            if constexpr (GATHER) { if (last && has_next) {
#pragma unroll
                for (int i = 0; i < 2; ++i) { voffA[i] = ((unsigned)S.arow(nxt, RA[i]) * (unsigned)K + (unsigned)CA[i]) * 2u; voffA1[i] = ((unsigned)S.arow(nxt, HALF + RA[i]) * (unsigned)K + (unsigned)CA[i]) * 2u; } } }
            PG8_WAIT_V(8); PG8_WAIT_L(0); PG8_BAR; PG8_MMA(0, 0, At, B0); PG8_MMA(0, 1, At, B1); PG8_BAR; PG8_SCHED;
            PG8_LDA(At, 0, 1); PG8_STAGE(PG8_SB(0, 0), b2, voffB); PG8_STAGE(PG8_SB(0, 1), b2 + hstep, voffB); PG8_STAGE(PG8_SA(0, 0), a2, voffA);
            PG8_WAIT_V(8); PG8_WAIT_L(0); PG8_BAR; PG8_MMA(1, 0, At, B0); PG8_MMA(1, 1, At, B1); PG8_BAR; PG8_SCHED;
            PG8_LDB(B0, 1, 0); PG8_LDB(B1, 1, 1); PG8_SCHED; PG8_LDA(At, 1, 0); PG8_STAGE(PG8_SA(0, 1), a2 + hstepA, voffA1);
            PG8_WAIT_V(8); PG8_WAIT_L(0); PG8_BAR; PG8_MMA(0, 0, At, B0); PG8_MMA(0, 1, At, B1); PG8_BAR; PG8_SCHED;
            PG8_LDA(At, 1, 1); PG8_STAGE(PG8_SB(1, 0), b3, voffB); PG8_STAGE(PG8_SB(1, 1), b3 + hstep, voffB); PG8_STAGE(PG8_SA(1, 0), a3, voffA);
            PG8_WAIT_V(8); PG8_WAIT_L(0); PG8_BAR; PG8_MMA(1, 0, At, B0); PG8_MMA(1, 1, At, B1); PG8_BAR; PG8_SCHED;
        }
        if constexpr (ALIGN_EPI) { if (wr == 0) PG8_BAR; }
        E(acc, cur, wr, wc, fr, fq);
        if (!has_next) break;
#pragma unroll
        for (int a = 0; a < 2; ++a)
#pragma unroll
            for (int b = 0; b < 2; ++b)
#pragma unroll
                for (int m = 0; m < 4; ++m)
#pragma unroll
                    for (int n = 0; n < 2; ++n) acc[a][b][m][n] = (f32x4){0.f, 0.f, 0.f, 0.f};
        cur = nxt; cA = nA; cB = nB; ++ui;
        if constexpr (ALIGN_EPI) { if (wr == 1) PG8_BAR; }
    }
    PG8_WAIT_V(0);
    if constexpr (!ALIGN_EPI) { if (wr == 0) PG8_BAR; }
    PG8_BAR;
#undef PG8_SA
#undef PG8_SB
#undef PG8_STAGE
#undef PG8_LDA
#undef PG8_LDB
#undef PG8_MMA
#undef PG8_WAIT_V
#undef PG8_WAIT_L
#undef PG8_BAR
#undef PG8_SCHED
}
}
using pg8::Unit;
using pg8::cvt_pk_bf16;
constexpr int HALF = pg8::HALF, BM = pg8::BM;

struct SchedPlain : pg8::OrderBase {
    const char* A; const char* B; size_t tstep;
    __device__ __forceinline__ const char* abase(const Unit& u) const { return A + (size_t)u.pm * tstep; }
    __device__ __forceinline__ const char* bbase(const Unit& u) const { return B + (size_t)u.pn * tstep; }
    __device__ __forceinline__ int arow(const Unit&, int) const { return 0; }
};
struct SchedMoeUp : pg8::OrderBase {
    const char* A; const char* B; const int* tok;
    __device__ __forceinline__ const char* abase(const Unit&) const { return A; }
    __device__ __forceinline__ const char* bbase(const Unit& u) const { return B + ((size_t)(u.pm >> 4) * 2048 + (size_t)u.pn * 256) * (size_t)(DM * 2); }
    __device__ __forceinline__ int arow(const Unit& u, int r) const { const int e = u.pm >> 4, b = (u.pm >> 3) & 1, mt = u.pm & 7; return b * SEQ + tok[(b * NE + e) * CAP + mt * 256 + r]; }
};
struct SchedMoeDown : pg8::OrderBase {
    const char* A; const char* B;
    __device__ __forceinline__ const char* abase(const Unit& u) const { return A + (size_t)u.pm * 256 * (size_t)(DEXP * 2); }
    __device__ __forceinline__ const char* bbase(const Unit& u) const { return B + ((size_t)(u.pm >> 4) * 2048 + (size_t)u.pn * 256) * (size_t)(DEXP * 2); }
    __device__ __forceinline__ int arow(const Unit&, int) const { return 0; }
};

struct EpiInProj {
    static constexpr bool PERM = true;
    bf16* P; float* Z;
    __device__ __forceinline__ void operator()(const f32x4 (&acc)[2][2][4][2], const Unit& u, int wr, int wc, int fr, int fq) const {
        const int row0 = u.pm * BM + wr * 64 + fr;
        if (u.pn < 16) {
            const int col0 = u.pn * BM + wc * 32 + 8 * fq;
#pragma unroll
            for (int ai = 0; ai < 2; ++ai)
#pragma unroll
                for (int m = 0; m < 4; ++m) { bf16* rowp = P + (size_t)(row0 + ai * HALF + m * 16) * PW + col0;
#pragma unroll
                    for (int bj = 0; bj < 2; ++bj) { const f32x4 v0 = acc[ai][bj][m][0], v1 = acc[ai][bj][m][1];
                        u32x4 w; w.x = cvt_pk_bf16(v0[0], v0[1]); w.y = cvt_pk_bf16(v0[2], v0[3]); w.z = cvt_pk_bf16(v1[0], v1[1]); w.w = cvt_pk_bf16(v1[2], v1[3]);
                        *(u32x4*)(rowp + bj * HALF) = w; } }
        } else if (wc == 0) {
#pragma unroll
            for (int ai = 0; ai < 2; ++ai)
#pragma unroll
                for (int m = 0; m < 4; ++m) { float* rowp = Z + (size_t)(row0 + ai * HALF + m * 16) * 32 + 8 * fq;
                    *(f32x4*)(rowp) = acc[ai][0][m][0]; *(f32x4*)(rowp + 4) = acc[ai][0][m][1]; }
        }
    }
};
struct EpiOutProj {
    static constexpr bool PERM = false;
    const float* X; float* XL; const float* ada;
    __device__ __forceinline__ void operator()(const f32x4 (&acc)[2][2][4][2], const Unit& u, int wr, int wc, int fr, int fq) const {
        const int row0 = u.pm * BM + wr * 64 + fr, col0 = u.pn * BM + wc * 32 + 4 * fq;
        const int b = (u.pm * BM) / SEQ;
        const float* g1 = ada + (size_t)b * 12288 + 2 * DM;
        f32x4 gv[2][2];
#pragma unroll
        for (int bj = 0; bj < 2; ++bj)
#pragma unroll
            for (int n = 0; n < 2; ++n) gv[bj][n] = *(const f32x4*)(g1 + col0 + bj * HALF + n * 16);
#pragma unroll
        for (int ai = 0; ai < 2; ++ai)
#pragma unroll
            for (int m = 0; m < 4; ++m) { const size_t off = (size_t)(row0 + ai * HALF + m * 16) * DM + col0;
#pragma unroll
                for (int bj = 0; bj < 2; ++bj)
#pragma unroll
                    for (int n = 0; n < 2; ++n) { const f32x4 xv = *(const f32x4*)(X + off + bj * HALF + n * 16);
                        *(f32x4*)(XL + off + bj * HALF + n * 16) = xv + gv[bj][n] * acc[ai][bj][m][n]; }
                asm volatile("" ::: "memory"); }
    }
};
struct EpiSwiglu {
    static constexpr bool PERM = true;
    bf16* HID;
    __device__ __forceinline__ void operator()(const f32x4 (&acc)[2][2][4][2], const Unit& u, int wr, int wc, int fr, int fq) const {
        const int row0 = u.pm * BM + wr * 64 + fr, col0 = u.pn * 128 + wc * 32 + 8 * fq;
#pragma unroll
        for (int ai = 0; ai < 2; ++ai)
#pragma unroll
            for (int m = 0; m < 4; ++m) { bf16* rowp = HID + (size_t)(row0 + ai * HALF + m * 16) * DEXP + col0;
                f32x4 h0, h1;
#pragma unroll
                for (int j = 0; j < 4; ++j) { h0[j] = silu_f(acc[ai][0][m][0][j]) * acc[ai][1][m][0][j]; h1[j] = silu_f(acc[ai][0][m][1][j]) * acc[ai][1][m][1][j]; }
                u32x4 w; w.x = cvt_pk_bf16(h0[0], h0[1]); w.y = cvt_pk_bf16(h0[2], h0[3]); w.z = cvt_pk_bf16(h1[0], h1[1]); w.w = cvt_pk_bf16(h1[2], h1[3]);
                *(u32x4*)(rowp) = w; }
    }
};
struct EpiBf16 {
    static constexpr bool PERM = true;
    bf16* O; int ldc;
    __device__ __forceinline__ void operator()(const f32x4 (&acc)[2][2][4][2], const Unit& u, int wr, int wc, int fr, int fq) const {
        const int row0 = u.pm * BM + wr * 64 + fr, col0 = u.pn * BM + wc * 32 + 8 * fq;
#pragma unroll
        for (int ai = 0; ai < 2; ++ai)
#pragma unroll
            for (int m = 0; m < 4; ++m) { bf16* rowp = O + (size_t)(row0 + ai * HALF + m * 16) * ldc + col0;
#pragma unroll
                for (int bj = 0; bj < 2; ++bj) { const f32x4 v0 = acc[ai][bj][m][0], v1 = acc[ai][bj][m][1];
                    u32x4 w; w.x = cvt_pk_bf16(v0[0], v0[1]); w.y = cvt_pk_bf16(v0[2], v0[3]); w.z = cvt_pk_bf16(v1[0], v1[1]); w.w = cvt_pk_bf16(v1[2], v1[3]);
                    *(u32x4*)(rowp + bj * HALF) = w; } }
    }
};

__device__ __forceinline__ void transpose_item(const float* src, int ldsrc, int scol0, int k0, bf16* dst, size_t drow0, int ldd, LAS float* scr, int lane) {
#pragma unroll 8
    for (int i = 0; i < 32; ++i) { const int kk = 2 * i + (lane >> 5); scr[kk * 33 + (lane & 31)] = src[(size_t)(k0 + kk) * ldsrc + scol0 + (lane & 31)]; }
    asm volatile("s_waitcnt lgkmcnt(0)" ::: "memory");
    const int c = lane & 7;
#pragma unroll
    for (int j = 0; j < 4; ++j) { const int n = (lane >> 3) + 8 * j; const LAS float* s = scr + (8 * c) * 33 + n;
        u32x4 o; o.x = pk2(s[0 * 33], s[1 * 33]); o.y = pk2(s[2 * 33], s[3 * 33]); o.z = pk2(s[4 * 33], s[5 * 33]); o.w = pk2(s[6 * 33], s[7 * 33]);
        *(u32x4*)(dst + (drow0 + n) * (size_t)ldd + k0 + 8 * c) = o; }
    asm volatile("s_waitcnt lgkmcnt(0)" ::: "memory");
}

__device__ __forceinline__ void phase0(const Args& a, LAS unsigned char* lds) {
    const int tid = threadIdx.x, lane = tid & 63, wave = tid >> 6, G = gridDim.x, blk = blockIdx.x;
    unsigned char* ws = a.ws;
    {
        const float* c = a.in[1]; const float* cc = a.in[3]; const float* w_ada = a.in[4]; const float* b_ada = a.in[5];
        float* ada = (float*)(ws + WS_ADA);
        LAS float* red = (LAS float*)lds;
        for (int it = blk; it < 96; it += G) {
            const int col0 = it * 128 + 2 * lane;
            float a0x = 0, a0y = 0, a1x = 0, a1y = 0, a2x = 0, a2y = 0;
            const int r0 = wave * 256;
#pragma unroll 8
            for (int r = r0; r < r0 + 256; ++r) {
                const f32x2 w = *(const f32x2*)(w_ada + (size_t)r * 12288 + col0);
                const float s0 = silu_f(c[r]), s1 = silu_f(c[DM + r]), s2 = silu_f(cc[r]);
                a0x += s0 * w.x; a0y += s0 * w.y; a1x += s1 * w.x; a1y += s1 * w.y; a2x += s2 * w.x; a2y += s2 * w.y;
            }
            red[(wave * 3 + 0) * 128 + 2 * lane] = a0x; red[(wave * 3 + 0) * 128 + 2 * lane + 1] = a0y;
            red[(wave * 3 + 1) * 128 + 2 * lane] = a1x; red[(wave * 3 + 1) * 128 + 2 * lane + 1] = a1y;
            red[(wave * 3 + 2) * 128 + 2 * lane] = a2x; red[(wave * 3 + 2) * 128 + 2 * lane + 1] = a2y;
            __syncthreads();
            if (tid < 384) { const int v = tid >> 7, col = tid & 127; float s = b_ada[it * 128 + col];
                for (int w8 = 0; w8 < 8; ++w8) s += red[(w8 * 3 + v) * 128 + col];
                ada[v * 12288 + it * 128 + col] = s; }
            __syncthreads();
        }
    }
    LAS float* scr = (LAS float*)(lds + wave * 16384);
    const int gw = blk * 8 + wave, NGW = G * 8;
    constexpr int I_WIN = 32 * 129, I_ZERO = 224, I_WOUT = 32 * 64, I_WG = 16 * 32 * 32, I_WU = I_WG, I_WD = 16 * 16 * 64, I_TW = 256;
    constexpr int I_TOTAL = I_WIN + I_ZERO + I_WOUT + I_WG + I_WU + I_WD + I_TW;
    bf16* Win = (bf16*)(ws + WS_WIN); bf16* Wout = (bf16*)(ws + WS_WOUT); bf16* Wgu = (bf16*)(ws + WS_WGU); bf16* Wd = (bf16*)(ws + WS_WD);
    for (int it = gw; it < I_TOTAL; it += NGW) {
        int r = it;
        if (r < I_WIN) { const int kb = r / 129, nb = r % 129, n0 = nb * 32;
            const size_t drow = n0 < 3072 ? (size_t)n0 : (n0 < 3104 ? (size_t)(4096 + n0 - 3072) : (size_t)(3072 + n0 - 3104));
            transpose_item(a.in[7], PROJW, n0, kb * 64, Win, drow, DM, scr, lane); continue; }
        r -= I_WIN;
        if (r < I_ZERO) { u32x4 z = {0u, 0u, 0u, 0u}; u32x4* p = (u32x4*)(Win + (size_t)(4128 + r) * DM);
#pragma unroll
            for (int j = 0; j < 4; ++j) p[lane + 64 * j] = z; continue; }
        r -= I_ZERO;
        if (r < I_WOUT) { const int kb = r / 64, nb = r % 64; transpose_item(a.in[13], DM, nb * 32, kb * 64, Wout, (size_t)nb * 32, DM, scr, lane); continue; }
        r -= I_WOUT;
        if (r < I_WG + I_WU) { const int up = r >= I_WG; if (up) r -= I_WG; const int e = r / 1024, rr = r % 1024, kb = rr / 32, nb = rr % 32, n0 = nb * 32;
            const float* src = (up ? a.in[17] : a.in[16]) + (size_t)e * DM * DEXP;
            const size_t drow = (size_t)e * 2048 + (size_t)(n0 >> 7) * 256 + (n0 & 127) + (up ? 128 : 0);
            transpose_item(src, DEXP, n0, kb * 64, Wgu, drow, DM, scr, lane); continue; }
        r -= I_WG + I_WU;
        if (r < I_WD) { const int e = r / 1024, rr = r % 1024, kb = rr / 64, nb = rr % 64;
            transpose_item(a.in[18] + (size_t)e * DEXP * DM, DM, nb * 32, kb * 64, Wd, (size_t)e * 2048 + nb * 32, DEXP, scr, lane); continue; }
        r -= I_WD;
        { const int p = r * 64 + lane; float s, c; sincospif((float)p * (1.0f / 8192.0f), &s, &c); ((f32x2*)(ws + WS_TW))[p] = (f32x2){c, s}; }
    }
}

__device__ __forceinline__ void phase1(const Args& a) {
    const int tid = threadIdx.x, lane = tid & 63, wave = tid >> 6, G = gridDim.x;
    const int gw = blockIdx.x * 8 + wave, NGW = G * 8;
    const float* ada = (const float*)(a.ws + WS_ADA); const float* g1n = a.in[6];
    bf16* H = (bf16*)(a.ws + WS_H);
    for (int r = gw; r < NROWS; r += NGW) {
        const float* xr; int v;
        if (r < NLAT) { xr = a.in[0] + (size_t)r * DM; v = r / SEQ; } else { xr = a.in[2] + (size_t)(r - NLAT) * DM; v = 2; }
        const float* sh = ada + (size_t)v * 12288; const float* sc = sh + DM;
        f32x4 x[8]; float ss = 0.f;
#pragma unroll
        for (int j = 0; j < 8; ++j) { x[j] = *(const f32x4*)(xr + 256 * j + 4 * lane); ss += (x[j].x * x[j].x + x[j].y * x[j].y) + (x[j].z * x[j].z + x[j].w * x[j].w); }
        const float rstd = rsqrtf(wave_sum(ss) * (1.f / DM) + EPS);
        u32x2* o = (u32x2*)(H + (size_t)r * DM);
#pragma unroll
        for (int j = 0; j < 8; ++j) { const int d = 256 * j + 4 * lane; const f32x4 g = *(const f32x4*)(g1n + d), s1 = *(const f32x4*)(sc + d), s0 = *(const f32x4*)(sh + d);
            const f32x4 hh = (x[j] * rstd * g) * (s1 + 1.f) + s0;
            u32x2 w; w.x = pk2(hh.x, hh.y); w.y = pk2(hh.z, hh.w); o[64 * j + lane] = w; }
    }
}

__device__ __forceinline__ void gla_scan(const Args& a, LAS unsigned char* lds, int item, bool is_ctx) {
    const int tid = threadIdx.x, lane = tid & 63, wave = tid >> 6;
    const int b = item >> 3, h = (item >> 1) & 3, dir = item & 1;
    const bf16* P = (const bf16*)(a.ws + WS_P); const float* Z = (const float*)(a.ws + WS_Z);
    const float* w_a2 = dir ? a.in[10] : a.in[8]; const float* b_a2 = dir ? a.in[11] : a.in[9];
    float* st0 = (float*)(a.ws + WS_ST0) + (size_t)((b * 2 + dir) * 4 + h) * 128 * 256;
    float* O = (float*)(a.ws + (dir ? WS_OB : WS_OF));
    LAS float* sA = (LAS float*)lds;
    LAS float* sQ = sA + 32 * 128;
    LAS float* sK = sQ + 32 * 128;
    LAS float* sV = sK + 32 * 128;
    const int vcol = wave * 32 + (lane & 31), dh = lane >> 5;
    const int ntok = is_ctx ? CTXL : SEQ;
    const size_t rowbase = is_ctx ? (size_t)(NLAT + b * CTXL) : (size_t)b * SEQ;
    float S[64];
#pragma unroll
    for (int d = 0; d < 64; ++d) S[d] = is_ctx ? 0.f : st0[(size_t)(dh * 64 + d) * 256 + vcol];
    const float qscale = 0.08838834764831845f;
    for (int c0 = 0; c0 < ntok; c0 += 32) {
        for (int e = tid; e < 32 * 128; e += NTHREADS) { const int i = e >> 7, d = e & 127; const int t = dir ? (ntok - 1 - (c0 + i)) : (c0 + i); const size_t row = rowbase + t;
            const float* zr = Z + row * 32 + dir * 16; float pre = b_a2[h * 128 + d];
#pragma unroll
            for (int r = 0; r < 16; ++r) pre += zr[r] * w_a2[r * 512 + h * 128 + d];
            sA[e] = expf(logsigmoid_f(pre) * (1.f / 16.f));
            sQ[e] = bf2f(P[row * PW + h * 128 + d]) * qscale;
            sK[e] = bf2f(P[row * PW + 512 + h * 128 + d]); }
        for (int e = tid; e < 32 * 256; e += NTHREADS) { const int i = e >> 8, v = e & 255; const int t = dir ? (ntok - 1 - (c0 + i)) : (c0 + i); const size_t row = rowbase + t;
            sV[e] = bf2f(P[row * PW + 1024 + h * 256 + v]); }
        __syncthreads();
        for (int i = 0; i < 32; ++i) {
            const float vv = sV[i * 256 + vcol]; float o = 0.f;
            const LAS f32x4* pa = (const LAS f32x4*)(sA + i * 128 + dh * 64); const LAS f32x4* pq = (const LAS f32x4*)(sQ + i * 128 + dh * 64); const LAS f32x4* pk = (const LAS f32x4*)(sK + i * 128 + dh * 64);
#pragma unroll
            for (int d4 = 0; d4 < 16; ++d4) { const f32x4 av = pa[d4], qv = pq[d4], kv = pk[d4];
#pragma unroll
                for (int j = 0; j < 4; ++j) { S[d4 * 4 + j] = av[j] * S[d4 * 4 + j] + kv[j] * vv; o += qv[j] * S[d4 * 4 + j]; } }
            o += __shfl_xor(o, 32);
            if (!is_ctx && dh == 0) { const int t = dir ? (ntok - 1 - (c0 + i)) : (c0 + i); O[(rowbase + t) * 1024 + h * 256 + vcol] = o; }
        }
        __syncthreads();
    }
    if (is_ctx) {
#pragma unroll
        for (int d = 0; d < 64; ++d) st0[(size_t)(dh * 64 + d) * 256 + vcol] = S[d];
    }
}

__device__ __forceinline__ void phase_gla_merge(const Args& a) {
    const int tid = threadIdx.x, lane = tid & 63, wave = tid >> 6;
    const int gw = blockIdx.x * 8 + wave, NGW = gridDim.x * 8;
    const float* OF = (const float*)(a.ws + WS_OF); const float* OB = (const float*)(a.ws + WS_OB);
    const bf16* P = (const bf16*)(a.ws + WS_P); bf16* Y = (bf16*)(a.ws + WS_YCAT); const float* gg = a.in[12];
    for (int r = gw; r < NLAT; r += NGW) {
#pragma unroll
        for (int j = 0; j < 4; ++j) {
            const int col = 256 * j + 4 * lane;
            const f32x4 o = *(const f32x4*)(OF + (size_t)r * 1024 + col) + *(const f32x4*)(OB + (size_t)r * 1024 + col);
            const float ss = wave_sum((o.x * o.x + o.y * o.y) + (o.z * o.z + o.w * o.w));
            const float rstd = rsqrtf(ss * (1.f / 256.f) + EPS);
            const u32x2 gw2 = *(const u32x2*)(P + (size_t)r * PW + 2048 + col);
            const f32x4 gn = *(const f32x4*)(gg + col);
            const float g0 = __uint_as_float(gw2.x << 16), g1 = __uint_as_float(gw2.x & 0xffff0000u), g2 = __uint_as_float(gw2.y << 16), g3 = __uint_as_float(gw2.y & 0xffff0000u);
            u32x2 w; w.x = pk2(o.x * rstd * gn.x * silu_f(g0), o.y * rstd * gn.y * silu_f(g1)); w.y = pk2(o.z * rstd * gn.z * silu_f(g2), o.w * rstd * gn.w * silu_f(g3));
            *(u32x2*)(Y + (size_t)r * DM + col) = w;
        }
    }
}

__device__ __forceinline__ void phase_f1(const Args& a) {
    const int tid = threadIdx.x;
    const bf16* P = (const bf16*)(a.ws + WS_P); const f32x2* TW = (const f32x2*)(a.ws + WS_TW); f32x2* FA = (f32x2*)(a.ws + WS_FA);
    const int nitems = NB * 128 * 128 * 2;
    for (int it = blockIdx.x; it < nitems; it += gridDim.x) {
        const int chh = it & 1, l2 = (it >> 1) & 127, k1 = (it >> 8) & 127, b = it >> 15;
        const int ch = chh * 512 + tid;
        float ar = 0.f, ai = 0.f;
        const bf16* up = P + ((size_t)b * SEQ + l2) * PW + 3072 + ch;
#pragma unroll 8
        for (int l1 = 0; l1 < 128; ++l1) { const float x = bf2f(up[(size_t)l1 * 128 * PW]); const f32x2 w = TW[((l1 * k1) & 127) * 128]; ar += x * w.x; ai -= x * w.y; }
        const f32x2 t = TW[l2 * k1];
        FA[(((size_t)b * 128 + k1) * 128 + l2) * 1024 + ch] = (f32x2){ar * t.x + ai * t.y, ai * t.x - ar * t.y};
    }
}
__device__ __forceinline__ void phase_f3(const Args& a) {
    const int tid = threadIdx.x;
    const f32x2* TW = (const f32x2*)(a.ws + WS_TW); const f32x2* FA = (const f32x2*)(a.ws + WS_FA); f32x2* FX = (f32x2*)(a.ws + WS_FX);
    const int nitems = NB * 128 * 32 * 2;
    for (int it = blockIdx.x; it < nitems; it += gridDim.x) {
        const int chh = it & 1, kg = (it >> 1) & 31, k1 = (it >> 6) & 127, b = it >> 13;
        const int ch = chh * 512 + tid;
        float xr[4] = {0, 0, 0, 0}, xi[4] = {0, 0, 0, 0};
        const f32x2* fp = FA + (((size_t)b * 128 + k1) * 128) * 1024 + ch;
#pragma unroll 4
        for (int l2 = 0; l2 < 128; ++l2) { const f32x2 v = fp[(size_t)l2 * 1024];
#pragma unroll
            for (int q = 0; q < 4; ++q) { const int k2 = kg * 4 + q; const f32x2 w = TW[((l2 * k2) & 127) * 128]; xr[q] += v.x * w.x + v.y * w.y; xi[q] += v.y * w.x - v.x * w.y; } }
#pragma unroll
        for (int q = 0; q < 4; ++q) { const int lp = k1 + 128 * (kg * 4 + q); FX[((size_t)b * SEQ + lp) * 1024 + ch] = (f32x2){xr[q], xi[q]}; }
    }
}
__device__ __forceinline__ void phase_f4(const Args& a, LAS unsigned char* lds) {
    const int tid = threadIdx.x;
    const f32x2* TW = (const f32x2*)(a.ws + WS_TW); const f32x2* FX = (const f32x2*)(a.ws + WS_FX); bf16* Y = (bf16*)(a.ws + WS_YCAT);
    LAS f32x2* T128 = (LAS f32x2*)lds;
    LAS f32x2* xs = T128 + 128;
    if (tid < 128) T128[tid] = TW[tid * 128];
    __syncthreads();
    const float nrm = 1.0f / 1448.15468787005f;
    for (int r = blockIdx.x; r < NLAT; r += gridDim.x) {
        xs[tid] = FX[(size_t)r * 1024 + tid]; xs[tid + 512] = FX[(size_t)r * 1024 + 512 + tid];
        __syncthreads();
#pragma unroll
        for (int half = 0; half < 2; ++half) { const int col = half * 512 + tid, g = col >> 7, cp = col & 127; float y = 0.f;
#pragma unroll 8
            for (int c = 0; c < 128; ++c) { const f32x2 v = xs[g * 128 + c]; const f32x2 w = T128[(c * cp) & 127]; y += v.x * w.x + v.y * w.y; }
            Y[(size_t)r * DM + 1024 + col] = (bf16)f2bf(y * nrm); }
        __syncthreads();
    }
}

__device__ __forceinline__ void phase_norm2(const Args& a) {
    const int tid = threadIdx.x, lane = tid & 63, wave = tid >> 6;
    const int gw = blockIdx.x * 8 + wave, NGW = gridDim.x * 8;
    const float* ada = (const float*)(a.ws + WS_ADA); const float* g2n = a.in[14]; const float* wr = a.in[15];
    const float* XL = (const float*)(a.ws + WS_XL); bf16* HF = (bf16*)(a.ws + WS_HF); float* AFF = (float*)(a.ws + WS_AFF);
    for (int r = gw; r < NLAT; r += NGW) {
        const int b = r / SEQ, t = r % SEQ;
        const float* sh = ada + (size_t)b * 12288 + 3 * DM; const float* sc = sh + DM;
        const float* xr = XL + (size_t)r * DM;
        f32x4 x[8]; float ss = 0.f;
#pragma unroll
        for (int j = 0; j < 8; ++j) { x[j] = *(const f32x4*)(xr + 256 * j + 4 * lane); ss += (x[j].x * x[j].x + x[j].y * x[j].y) + (x[j].z * x[j].z + x[j].w * x[j].w); }
        const float rstd = rsqrtf(wave_sum(ss) * (1.f / DM) + EPS);
        float p[16];
#pragma unroll
        for (int e = 0; e < 16; ++e) p[e] = 0.f;
        u32x2* o = (u32x2*)(HF + (size_t)r * DM);
#pragma unroll
        for (int j = 0; j < 8; ++j) { const int d = 256 * j + 4 * lane; const f32x4 g = *(const f32x4*)(g2n + d), s1 = *(const f32x4*)(sc + d), s0 = *(const f32x4*)(sh + d);
            const f32x4 hh = (x[j] * rstd * g) * (s1 + 1.f) + s0;
            u32x2 w; w.x = pk2(hh.x, hh.y); w.y = pk2(hh.z, hh.w); o[64 * j + lane] = w;
#pragma unroll
            for (int jj = 0; jj < 4; ++jj) { const float hv = hh[jj]; const f32x4* wp = (const f32x4*)(wr + (size_t)(d + jj) * 16);
#pragma unroll
                for (int q = 0; q < 4; ++q) { const f32x4 wv = wp[q]; p[q * 4 + 0] += hv * wv.x; p[q * 4 + 1] += hv * wv.y; p[q * 4 + 2] += hv * wv.z; p[q * 4 + 3] += hv * wv.w; } } }
        float mx = -1e30f;
#pragma unroll
        for (int e = 0; e < 16; ++e) { p[e] = wave_sum(p[e]); mx = fmaxf(mx, p[e]); }
        float sum = 0.f;
#pragma unroll
        for (int e = 0; e < 16; ++e) { p[e] = expf(p[e] - mx); sum += p[e]; }
        float mine = 0.f;
#pragma unroll
        for (int e = 0; e < 16; ++e) mine = (lane == e) ? p[e] : mine;
        if (lane < 16) AFF[((size_t)b * NE + lane) * SEQ + t] = mine / sum;
    }
}

__device__ __forceinline__ void phase_topk(const Args& a, LAS unsigned char* lds) {
    const int tid = threadIdx.x;
    LAS unsigned* keys = (LAS unsigned*)lds;
    LAS unsigned* hist = (LAS unsigned*)(lds + 65536);
    LAS unsigned* misc = hist + 256;
    LAS unsigned* sg = misc + 16;
    LAS unsigned* se = sg + 512;
    const float* AFF = (const float*)(a.ws + WS_AFF); int* TOK = (int*)(a.ws + WS_TOK); float* GATE = (float*)(a.ws + WS_GATE); int* SEL = (int*)(a.ws + WS_SEL);
    for (int be = blockIdx.x; be < NB * NE; be += gridDim.x) {
        const int b = be / NE, e = be % NE;
        for (int i = tid; i < SEQ; i += NTHREADS) keys[i] = __float_as_uint(AFF[(size_t)be * SEQ + i]);
        unsigned prefix = 0u, pmask = 0u, krem = CAP;
        for (int pass = 0; pass < 4; ++pass) {
            const int shift = 24 - 8 * pass;
            if (tid < 256) hist[tid] = 0u;
            __syncthreads();
            for (int i = tid; i < SEQ; i += NTHREADS) { const unsigned k = keys[i]; if ((k & pmask) == prefix) atomicAdd((unsigned*)&hist[(k >> shift) & 255u], 1u); }
            __syncthreads();
            if (tid == 0) { unsigned cum = 0u; int bsel = 0;
                for (int bk = 255; bk >= 0; --bk) { const unsigned c = hist[bk]; if (cum + c >= krem) { bsel = bk; break; } cum += c; }
                misc[0] = prefix | ((unsigned)bsel << shift); misc[1] = krem - cum; }
            __syncthreads();
            prefix = misc[0]; krem = misc[1]; pmask |= (0xffu << shift);
            __syncthreads();
        }
        const unsigned T = prefix;
        unsigned cg_ = 0u, ce = 0u;
        for (int i = 0; i < 32; ++i) { const unsigned k = keys[tid * 32 + i]; cg_ += (k > T); ce += (k == T); }
        sg[tid] = cg_; se[tid] = ce;
        __syncthreads();
        if (tid == 0) { unsigned rg = 0u, re = 0u; for (int i = 0; i < NTHREADS; ++i) { const unsigned x = sg[i], y = se[i]; sg[i] = rg; se[i] = re; rg += x; re += y; } }
        __syncthreads();
        unsigned gt_before = sg[tid], eq_before = se[tid];
        for (int i = 0; i < 32; ++i) { const int t = tid * 32 + i; const unsigned k = keys[t];
            const bool isgt = k > T, iseq = k == T; const bool take = isgt || (iseq && eq_before < krem);
            const unsigned slot = gt_before + (eq_before < krem ? eq_before : krem);
            if (take) { TOK[(size_t)be * CAP + slot] = t; GATE[(size_t)be * CAP + slot] = __uint_as_float(k); }
            SEL[((size_t)b * SEQ + t) * NE + e] = take ? (int)slot : -1;
            gt_before += isgt; eq_before += iseq; }
        __syncthreads();
    }
}

__device__ __forceinline__ void phase_final(const Args& a) {
    const int tid = threadIdx.x, lane = tid & 63, wave = tid >> 6;
    const int gw = blockIdx.x * 8 + wave, NGW = gridDim.x * 8;
    const float* ada = (const float*)(a.ws + WS_ADA); const float* fg = a.in[19];
    const float* XL = (const float*)(a.ws + WS_XL); const bf16* YE = (const bf16*)(a.ws + WS_YE);
    const float* GATE = (const float*)(a.ws + WS_GATE); const int* SEL = (const int*)(a.ws + WS_SEL);
    for (int r = gw; r < NLAT; r += NGW) {
        const int b = r / SEQ;
        const float* g2 = ada + (size_t)b * 12288 + 5 * DM;
        f32x4 m[8];
#pragma unroll
        for (int j = 0; j < 8; ++j) m[j] = (f32x4){0.f, 0.f, 0.f, 0.f};
        for (int e = 0; e < NE; ++e) { const int s = SEL[(size_t)r * NE + e];
            if (s >= 0) { const float gt = GATE[((size_t)b * NE + e) * CAP + s]; const bf16* yr = YE + ((size_t)(e * 2 + b) * CAP + s) * DM;
#pragma unroll
                for (int j = 0; j < 8; ++j) { const u32x2 w = *(const u32x2*)(yr + 256 * j + 4 * lane);
                    m[j].x += gt * __uint_as_float(w.x << 16); m[j].y += gt * __uint_as_float(w.x & 0xffff0000u); m[j].z += gt * __uint_as_float(w.y << 16); m[j].w += gt * __uint_as_float(w.y & 0xffff0000u); } } }
        float ss = 0.f;
#pragma unroll
        for (int j = 0; j < 8; ++j) { const int d = 256 * j + 4 * lane; const f32x4 xv = *(const f32x4*)(XL + (size_t)r * DM + d), gv = *(const f32x4*)(g2 + d);
            m[j] = xv + gv * m[j]; ss += (m[j].x * m[j].x + m[j].y * m[j].y) + (m[j].z * m[j].z + m[j].w * m[j].w); }
        const float rstd = rsqrtf(wave_sum(ss) * (1.f / DM) + EPS);
#pragma unroll
        for (int j = 0; j < 8; ++j) { const int d = 256 * j + 4 * lane; const f32x4 gv = *(const f32x4*)(fg + d);
            *(f32x4*)(a.out + (size_t)r * DM + d) = m[j] * rstd * gv; }
    }
}

constexpr int NPHASES = 15;
__global__ void __launch_bounds__(NTHREADS, 2) mega(Args a) {
    extern __shared__ __attribute__((aligned(16))) unsigned char lds_raw[];
    LAS unsigned char* lds = (LAS unsigned char*)lds_raw;
    cg::grid_group grid = cg::this_grid();
    const int lo = a.ph_lo, hi = a.ph_hi;
    unsigned char* ws = a.ws;
#define IN(k) (lo <= (k) && (k) < hi)
#define SEAM(k) do { if (IN(k) && IN((k) + 1)) grid.sync(); } while (0)
    if (IN(0)) phase0(a, lds);
    SEAM(0);
    if (IN(1)) phase1(a);
    SEAM(1);
    if (IN(2)) {
        SchedPlain S; S.init(NROWS / 256, WIN_ROWS / 256, gridDim.x, blockIdx.x); S.A = (const char*)(ws + WS_H); S.B = (const char*)(ws + WS_WIN); S.tstep = (size_t)256 * DM * 2;
        EpiInProj E{(bf16*)(ws + WS_P), (float*)(ws + WS_Z)};
        pg8::gemm_phase<EpiInProj, SchedPlain, false, true, true>(lds, DM, S, E);
    }
    SEAM(2);
    if (IN(3)) { for (int it = blockIdx.x; it < 16; it += gridDim.x) gla_scan(a, lds, it, true); }
    SEAM(3);
    if (IN(4)) { for (int it = blockIdx.x; it < 16; it += gridDim.x) gla_scan(a, lds, it, false); }
    SEAM(4);
    if (IN(5)) phase_gla_merge(a);
    SEAM(5);
    if (IN(6)) phase_f1(a);
    SEAM(6);
    if (IN(7)) phase_f3(a);
    SEAM(7);
    if (IN(8)) phase_f4(a, lds);
    SEAM(8);
    if (IN(9)) {
        SchedPlain S; S.init(NLAT / 256, DM / 256, gridDim.x, blockIdx.x); S.A = (const char*)(ws + WS_YCAT); S.B = (const char*)(ws + WS_WOUT); S.tstep = (size_t)256 * DM * 2;
        EpiOutProj E{a.in[0], (float*)(ws + WS_XL), (const float*)(ws + WS_ADA)};
        pg8::gemm_phase<EpiOutProj, SchedPlain, false, true, true>(lds, DM, S, E);
    }
    SEAM(9);
    if (IN(10)) phase_norm2(a);
    SEAM(10);
    if (IN(11)) phase_topk(a, lds);
    SEAM(11);
    if (IN(12)) {
        SchedMoeUp S; S.init(256, 8, gridDim.x, blockIdx.x); S.A = (const char*)(ws + WS_HF); S.B = (const char*)(ws + WS_WGU); S.tok = (const int*)(ws + WS_TOK);
        EpiSwiglu E{(bf16*)(ws + WS_HID)};
        pg8::gemm_phase<EpiSwiglu, SchedMoeUp, true, true, true>(lds, DM, S, E);
    }
    SEAM(12);
    if (IN(13)) {
        SchedMoeDown S; S.init(256, 8, gridDim.x, blockIdx.x); S.A = (const char*)(ws + WS_HID); S.B = (const char*)(ws + WS_WD);
        EpiBf16 E{(bf16*)(ws + WS_YE), DM};
        pg8::gemm_phase<EpiBf16, SchedMoeDown, false, true, true>(lds, DEXP, S, E);
    }
    SEAM(13);
    if (IN(14)) phase_final(a);
#undef IN
#undef SEAM
}

#ifndef N_LAUNCH_MODE
#define N_LAUNCH_MODE 0
#endif
extern "C" void kernel_launch(void* const* d_in, const int* in_sizes, int n_in, void* d_out, int out_size, void* d_ws, size_t ws_size, hipStream_t stream) {
    static int grid = 0;
    if (grid == 0) {
        if (n_in != 20 || out_size != NLAT * DM || ws_size < WS_END) { fprintf(stderr, "kernel_launch: unexpected sizes n_in %d out %d ws %zu\n", n_in, out_size, ws_size); grid = -1; return; }
        int dev = 0, cus = 0, per_cu = 0;
        hipGetDevice(&dev); hipDeviceGetAttribute(&cus, hipDeviceAttributeMultiprocessorCount, dev);
        if (hipFuncSetAttribute((const void*)mega, hipFuncAttributeMaxDynamicSharedMemorySize, LDS_BYTES) != hipSuccess) { fprintf(stderr, "kernel_launch: hipFuncSetAttribute failed\n"); grid = -1; return; }
        hipOccupancyMaxActiveBlocksPerMultiprocessor(&per_cu, (const void*)mega, NTHREADS, LDS_BYTES);
        if (per_cu < 1) { fprintf(stderr, "kernel_launch: occupancy query reports %d blocks per CU\n", per_cu); per_cu = 1; }
        (void)hipGetLastError();
        grid = cus * 1;
    }
    if (grid < 0) return;
    Args a{};
    for (int i = 0; i < 20; ++i) a.in[i] = (const float*)d_in[i];
    a.out = (float*)d_out; a.ws = (unsigned char*)d_ws;
#if N_LAUNCH_MODE == 0
    for (int p = 0; p < NPHASES; ++p) { a.ph_lo = p; a.ph_hi = p + 1; hipLaunchKernelGGL(mega, dim3(grid), dim3(NTHREADS), LDS_BYTES, stream, a); }
#else
    a.ph_lo = 0; a.ph_hi = NPHASES;
    void* args[] = {&a};
    hipError_t e = hipLaunchCooperativeKernel((void*)mega, dim3(grid), dim3(NTHREADS), args, LDS_BYTES, stream);
    if (e != hipSuccess) fprintf(stderr, "cooperative launch failed: %s (grid %d)\n", hipGetErrorString(e), grid);
#endif
}
```

```cpp
#include <hip/hip_runtime.h>
#include <hip/hip_cooperative_groups.h>
#include <cstdio>
#include <cstdint>
namespace cg = cooperative_groups;

#define LAS __attribute__((address_space(3)))
typedef unsigned short bf16;
typedef short bf16x8 __attribute__((ext_vector_type(8)));
typedef float f32x4 __attribute__((ext_vector_type(4)));
typedef float f32x2 __attribute__((ext_vector_type(2)));
typedef unsigned u32x4 __attribute__((ext_vector_type(4)));
typedef unsigned u32x2 __attribute__((ext_vector_type(2)));

constexpr int NB = 2, SEQ = 16384, DM = 2048, CTXL = 256;
constexpr int NLAT = NB * SEQ;
constexpr int NROWS = NLAT + NB * CTXL;
constexpr int PROJW = 4128;
constexpr int NE = 16, CAP = 2048, DEXP = 1024;
constexpr int PW = 4096;
constexpr int WIN_ROWS = 4352;
constexpr float EPS = 1e-6f;

constexpr size_t MiB = 1u << 20;
constexpr size_t WS_ADA = 0;
constexpr size_t WS_TW = 1 * MiB;
constexpr size_t WS_Z = 2 * MiB;
constexpr size_t WS_AFF = 8 * MiB;
constexpr size_t WS_TOK = 10 * MiB;
constexpr size_t WS_GATE = 11 * MiB;
constexpr size_t WS_SEL = 12 * MiB;
constexpr size_t WS_ST0 = 14 * MiB;
constexpr size_t WS_WIN = 32 * MiB;
constexpr size_t WS_WOUT = 50 * MiB;
constexpr size_t WS_WGU = 58 * MiB;
constexpr size_t WS_WD = 186 * MiB;
constexpr size_t WS_P = 250 * MiB;
constexpr size_t WS_HF = 250 * MiB;
constexpr size_t WS_HID = 378 * MiB;
constexpr size_t WS_FX = 250 * MiB;
constexpr size_t WS_FA = 510 * MiB;
constexpr size_t WS_H = 510 * MiB;
constexpr size_t WS_OF = 510 * MiB;
constexpr size_t WS_OB = 638 * MiB;
constexpr size_t WS_XL = 510 * MiB;
constexpr size_t WS_YCAT = 766 * MiB;
constexpr size_t WS_YE = 766 * MiB;
constexpr size_t WS_END = 1022 * MiB;

constexpr int LDS_BYTES = 147456;
constexpr int NTHREADS = 512;

struct Args {
    const float* in[20];
    float* out;
    unsigned char* ws;
    int ph_lo, ph_hi;
};

__device__ __forceinline__ float bf2f(bf16 v) { return __uint_as_float(((unsigned)v) << 16); }
__device__ __forceinline__ unsigned f2bf(float f) { unsigned u = __float_as_uint(f); return (u + 0x7fffu + ((u >> 16) & 1u)) >> 16; }
__device__ __forceinline__ unsigned pk2(float lo, float hi) { return f2bf(lo) | (f2bf(hi) << 16); }
__device__ __forceinline__ float wave_sum(float v) {
#pragma unroll
    for (int o = 1; o < 64; o <<= 1) v += __shfl_xor(v, o);
    return v;
}
__device__ __forceinline__ float silu_f(float x) { return x / (1.f + __expf(-x)); }
__device__ __forceinline__ float logsigmoid_f(float x) { return fminf(x, 0.f) - log1pf(expf(-fabsf(x))); }

namespace pg8 {
constexpr int BM = 256, BK = 64, HALF = 128, HTB = HALF * BK * 2, STAGE_BYTES = 8 * HTB, NXCD = 8, WGM = 8;
__host__ __device__ __forceinline__ int lds_byte(int r, int c) { const int st = (r >> 4) * 2 + (c >> 5), rr = r & 15, cc = c & 31, ob = rr * 64 + cc * 2; return st * 1024 + (ob ^ (((ob >> 9) & 1) << 5)); }
__host__ __device__ __forceinline__ void stage_rc(int b, int& R, int& C) { const int st = b / 1024, sb = b % 1024, swz = sb ^ (((sb >> 9) & 1) << 5); R = (st >> 1) * 16 + swz / 64; C = (st & 1) * 32 + (swz % 64) / 2; }
__host__ __device__ __forceinline__ int perm32(int rho) { const int n = rho >> 4, i = rho & 15; return 8 * (i >> 2) + 4 * n + (i & 3); }
struct Unit { int pm, pn; };
__device__ __forceinline__ unsigned cvt_pk_bf16(float lo, float hi) { unsigned r; asm volatile("v_cvt_pk_bf16_f32 %0, %1, %2" : "=v"(r) : "v"(lo), "v"(hi)); return r; }

struct OrderBase {
    int nM, nN, nwg, G, c;
    __device__ void init(int nM_, int nN_, int G_, int c_) { nM = nM_; nN = nN_; nwg = nM * nN; G = G_; c = c_; }
    __device__ bool next(int i, Unit& u) const {
        const long L = (long)i * G + c; if (L >= nwg) return false;
        int wgid = (int)L; { const int q = nwg / NXCD, r = nwg % NXCD, xcd = wgid % NXCD, off = wgid / NXCD; wgid = (xcd < r ? xcd * (q + 1) : r * (q + 1) + (xcd - r) * q) + off; }
        const int nig = WGM * nN, gid = wgid / nig, fm = gid * WGM, gsz = (nM - fm) < WGM ? (nM - fm) : WGM;
        u.pm = fm + ((wgid % nig) % gsz); u.pn = (wgid % nig) / gsz; return true;
    }
};

template <class Epi, class Sched, bool GATHER, bool ALIGN_EPI, bool SP2>
__device__ __forceinline__ void gemm_phase(LAS unsigned char* lds, const int K, const Sched& S, const Epi& E) {
    const int tid = threadIdx.x, wid = __builtin_amdgcn_readfirstlane(tid >> 6), lane = tid & 63, wr = wid >> 2, wc = wid & 3, fr = lane & 15, fq = lane >> 4;
    const int nt = K / BK;
    unsigned voffA[2], voffA1[2], voffB[2];
    int RA[2], CA[2];
#pragma unroll
    for (int i = 0; i < 2; ++i) { int R, C; stage_rc(tid * 16 + i * 8192, R, C); const int Rb = Epi::PERM ? ((R & ~31) + perm32(R & 31)) : R;
        RA[i] = R; CA[i] = C;
        voffA[i] = (unsigned)(R * K + C) * 2u; voffA1[i] = voffA[i]; voffB[i] = (unsigned)(Rb * K + C) * 2u; }
    const size_t kstep = (size_t)(BK * 2);
    const size_t hstep = (size_t)HALF * K * 2;
    const size_t hstepA = GATHER ? 0 : hstep;
    const unsigned ldsw = (unsigned)wid * 1024u;
    const int aoff = lds_byte(wr * 64 + fr, fq * 8), boff = lds_byte(wc * 32 + fr, fq * 8);
#define PG8_SA(b, h) (((b) * 2 + (h)) * HTB)
#define PG8_SB(b, h) ((4 + (b) * 2 + (h)) * HTB)
#define PG8_STAGE(bufoff, gbase, voff) do { _Pragma("unroll") for (int _i = 0; _i < 2; ++_i) \
        __builtin_amdgcn_global_load_lds((const unsigned*)((const char*)(gbase) + (voff)[_i]), (LAS unsigned*)(lds + (bufoff) + ldsw + _i * 8192), 16, 0, 0); } while (0)
#define PG8_LDA(dst, b, h) do { _Pragma("unroll") for (int m = 0; m < 4; ++m) _Pragma("unroll") for (int k = 0; k < 2; ++k) dst[m][k] = *(const LAS bf16x8*)(lds + PG8_SA(b, h) + aoff + m * 2048 + k * 1024); } while (0)
#define PG8_LDB(dst, b, h) do { _Pragma("unroll") for (int n = 0; n < 2; ++n) _Pragma("unroll") for (int k = 0; k < 2; ++k) dst[n][k] = *(const LAS bf16x8*)(lds + PG8_SB(b, h) + boff + n * 2048 + k * 1024); } while (0)
#define PG8_MMA(ai, bj, At, Bt) do { __builtin_amdgcn_s_setprio(1); _Pragma("unroll") for (int m = 0; m < 4; ++m) _Pragma("unroll") for (int n = 0; n < 2; ++n) _Pragma("unroll") for (int k = 0; k < 2; ++k) \
        acc[ai][bj][m][n] = __builtin_amdgcn_mfma_f32_16x16x32_bf16(Bt[n][k], At[m][k], acc[ai][bj][m][n], 0, 0, 0); __builtin_amdgcn_s_setprio(0); } while (0)
#define PG8_WAIT_V(n) asm volatile("s_waitcnt vmcnt(" #n ")" ::: "memory")
#define PG8_WAIT_L(n) asm volatile("s_waitcnt lgkmcnt(" #n ")" ::: "memory")
#define PG8_BAR __builtin_amdgcn_s_barrier()
#define PG8_SCHED __builtin_amdgcn_sched_barrier(0)
    Unit cur, nxt; int ui = 0;
    if (!S.next(0, cur)) return;
    f32x4 acc[2][2][4][2];
#pragma unroll
    for (int a = 0; a < 2; ++a)
#pragma unroll
        for (int b = 0; b < 2; ++b)
#pragma unroll
            for (int m = 0; m < 4; ++m)
#pragma unroll
                for (int n = 0; n < 2; ++n) acc[a][b][m][n] = (f32x4){0.f, 0.f, 0.f, 0.f};
    bf16x8 At[4][2], B0[2][2], B1[2][2];
    const char* cA = S.abase(cur); const char* cB = S.bbase(cur);
    if constexpr (GATHER) {
#pragma unroll
        for (int i = 0; i < 2; ++i) { voffA[i] = ((unsigned)S.arow(cur, RA[i]) * (unsigned)K + (unsigned)CA[i]) * 2u; voffA1[i] = ((unsigned)S.arow(cur, HALF + RA[i]) * (unsigned)K + (unsigned)CA[i]) * 2u; }
    }
    static_assert(SP2, "only the SP2 loop is kept");
    PG8_STAGE(PG8_SB(0, 0), cB, voffB); PG8_STAGE(PG8_SB(0, 1), cB + hstep, voffB); PG8_STAGE(PG8_SA(0, 0), cA, voffA); PG8_STAGE(PG8_SA(0, 1), cA + hstepA, voffA1);
    if (wr == 1) PG8_BAR;
    PG8_WAIT_V(2); PG8_BAR;
    PG8_STAGE(PG8_SB(1, 0), cB + kstep, voffB); PG8_STAGE(PG8_SA(1, 0), cA + kstep, voffA); PG8_STAGE(PG8_SB(1, 1), cB + hstep + kstep, voffB);
    PG8_WAIT_V(6); PG8_BAR;
    for (;;) {
        const bool has_next = S.next(ui + 1, nxt);
        const char* nA = has_next ? S.abase(nxt) : cA; const char* nB = has_next ? S.bbase(nxt) : cB;
        for (int t = 0; t < nt; t += 2) {
            const bool last = (t == nt - 2);
            const char* a1 = cA + (size_t)(t + 1) * kstep;
            const char* a2 = last ? nA : cA + (size_t)(t + 2) * kstep; const char* b2 = last ? nB : cB + (size_t)(t + 2) * kstep;
            const char* a3 = a2 + kstep; const char* b3 = b2 + kstep;
            PG8_LDB(B0, 0, 0); PG8_LDB(B1, 0, 1); PG8_SCHED; PG8_LDA(At, 0, 0); PG8_STAGE(PG8_SA(1, 1), a1 + hstepA, voffA1);
            if constexpr (GATHER) { if (last && has_next) {
#pragma unroll
                for (int i = 0; i < 2; ++i) { voffA[i] = ((unsigned)S.arow(nxt, RA[i]) * (unsigned)K + (unsigned)CA[i]) * 2u; voffA1[i] = ((unsigned)S.arow(nxt, HALF + RA[i]) * (unsigned)K + (unsigned)CA[i]) * 2u; } } }
            PG8_WAIT_V(8); PG8_WAIT_L(0); PG8_BAR; PG8_MMA(0, 0, At, B0); PG8_MMA(0, 1, At, B1); PG8_BAR; PG8_SCHED;
            PG8_LDA(At, 0, 1); PG8_STAGE(PG8_SB(0, 0), b2, voffB); PG8_STAGE(PG8_SB(0, 1), b2 + hstep, voffB); PG8_STAGE(PG8_SA(0, 0), a2, voffA);
            PG8_WAIT_V(8); PG8_WAIT_L(0); PG8_BAR; PG8_MMA(1, 0, At, B0); PG8_MMA(1, 1, At, B1); PG8_BAR; PG8_SCHED;
            PG8_LDB(B0, 1, 0); PG8_LDB(B1, 1, 1); PG8_SCHED; PG8_LDA(At, 1, 0); PG8_STAGE(PG8_SA(0, 1), a2 + hstepA, voffA1);
            PG8_WAIT_V(8); PG8_WAIT_L(0); PG8_BAR; PG8_MMA(0, 0, At, B0); PG8_MMA(0, 1, At, B1); PG8_BAR; PG8_SCHED;
            PG8_LDA(At, 1, 1); PG8_STAGE(PG8_SB(1, 0), b3, voffB); PG8_STAGE(PG8_SB(1, 1), b3 + hstep, voffB); PG8_STAGE(PG8_SA(1, 0), a3, voffA);
            PG8_WAIT_V(8); PG8_WAIT_L(0); PG8_BAR; PG8_MMA(1, 0, At, B0); PG8_MMA(1, 1, At, B1); PG8_BAR; PG8_SCHED;
        }
        if constexpr (ALIGN_EPI) { if (wr == 0) PG8_BAR; }
        E(acc, cur, wr, wc, fr, fq);
        if (!has_next) break;
#pragma unroll
        for (int a = 0; a < 2; ++a)
#pragma unroll
            for (int b = 0; b < 2; ++b)
#pragma unroll
                for (int m = 0; m < 4; ++m)
#pragma unroll
                    for (int n = 0; n < 2; ++n) acc[a][b][m][n] = (f32x4){0.f, 0.f, 0.f, 0.f};
        cur = nxt; cA = nA; cB = nB; ++ui;
        if constexpr (ALIGN_EPI) { if (wr == 1) PG8_BAR; }
    }
    PG8_WAIT_V(0);
    if constexpr (!ALIGN_EPI) { if (wr == 0) PG8_BAR; }
    PG8_BAR;
#undef PG8_SA
#undef PG8_SB
#undef PG8_STAGE
#undef PG8_LDA
#undef PG8_LDB
#undef PG8_MMA
#undef PG8_WAIT_V
#undef PG8_WAIT_L
#undef PG8_BAR
#undef PG8_SCHED
}
}
using pg8::Unit;
using pg8::cvt_pk_bf16;
constexpr int HALF = pg8::HALF, BM = pg8::BM;

struct SchedPlain : pg8::OrderBase {
    const char* A; const char* B; size_t tstep;
    __device__ __forceinline__ const char* abase(const Unit& u) const { return A + (size_t)u.pm * tstep; }
    __device__ __forceinline__ const char* bbase(const Unit& u) const { return B + (size_t)u.pn * tstep; }
    __device__ __forceinline__ int arow(const Unit&, int) const { return 0; }
};
struct SchedMoeUp : pg8::OrderBase {
    const char* A; const char* B; const int* tok;
    __device__ __forceinline__ const char* abase(const Unit&) const { return A; }
    __device__ __forceinline__ const char* bbase(const Unit& u) const { return B + ((size_t)(u.pm >> 4) * 2048 + (size_t)u.pn * 256) * (size_t)(DM * 2); }
    __device__ __forceinline__ int arow(const Unit& u, int r) const { const int e = u.pm >> 4, b = (u.pm >> 3) & 1, mt = u.pm & 7; return b * SEQ + tok[(b * NE + e) * CAP + mt * 256 + r]; }
};
struct SchedMoeDown : pg8::OrderBase {
    const char* A; const char* B;
    __device__ __forceinline__ const char* abase(const Unit& u) const { return A + (size_t)u.pm * 256 * (size_t)(DEXP * 2); }
    __device__ __forceinline__ const char* bbase(const Unit& u) const { return B + ((size_t)(u.pm >> 4) * 2048 + (size_t)u.pn * 256) * (size_t)(DEXP * 2); }
    __device__ __forceinline__ int arow(const Unit&, int) const { return 0; }
};

struct EpiInProj {
    static constexpr bool PERM = true;
    bf16* P; float* Z;
    __device__ __forceinline__ void operator()(const f32x4 (&acc)[2][2][4][2], const Unit& u, int wr, int wc, int fr, int fq) const {
        const int row0 = u.pm * BM + wr * 64 + fr;
        if (u.pn < 16) {
            const int col0 = u.pn * BM + wc * 32 + 8 * fq;
#pragma unroll
            for (int ai = 0; ai < 2; ++ai)
#pragma unroll
                for (int m = 0; m < 4; ++m) { bf16* rowp = P + (size_t)(row0 + ai * HALF + m * 16) * PW + col0;
#pragma unroll
                    for (int bj = 0; bj < 2; ++bj) { const f32x4 v0 = acc[ai][bj][m][0], v1 = acc[ai][bj][m][1];
                        u32x4 w; w.x = cvt_pk_bf16(v0[0], v0[1]); w.y = cvt_pk_bf16(v0[2], v0[3]); w.z = cvt_pk_bf16(v1[0], v1[1]); w.w = cvt_pk_bf16(v1[2], v1[3]);
                        *(u32x4*)(rowp + bj * HALF) = w; } }
        } else if (wc == 0) {
#pragma unroll
            for (int ai = 0; ai < 2; ++ai)
#pragma unroll
                for (int m = 0; m < 4; ++m) { float* rowp = Z + (size_t)(row0 + ai * HALF + m * 16) * 32 + 8 * fq;
                    *(f32x4*)(rowp) = acc[ai][0][m][0]; *(f32x4*)(rowp + 4) = acc[ai][0][m][1]; }
        }
    }
};
struct EpiOutProj {
    static constexpr bool PERM = false;
    const float* X; float* XL; const float* ada;
    __device__ __forceinline__ void operator()(const f32x4 (&acc)[2][2][4][2], const Unit& u, int wr, int wc, int fr, int fq) const {
        const int row0 = u.pm * BM + wr * 64 + fr, col0 = u.pn * BM + wc * 32 + 4 * fq;
        const int b = (u.pm * BM) / SEQ;
        const float* g1 = ada + (size_t)b * 12288 + 2 * DM;
        f32x4 gv[2][2];
#pragma unroll
        for (int bj = 0; bj < 2; ++bj)
#pragma unroll
            for (int n = 0; n < 2; ++n) gv[bj][n] = *(const f32x4*)(g1 + col0 + bj * HALF + n * 16);
#pragma unroll
        for (int ai = 0; ai < 2; ++ai)
#pragma unroll
            for (int m = 0; m < 4; ++m) { const size_t off = (size_t)(row0 + ai * HALF + m * 16) * DM + col0;
#pragma unroll
                for (int bj = 0; bj < 2; ++bj)
#pragma unroll
                    for (int n = 0; n < 2; ++n) { const f32x4 xv = *(const f32x4*)(X + off + bj * HALF + n * 16);
                        *(f32x4*)(XL + off + bj * HALF + n * 16) = xv + gv[bj][n] * acc[ai][bj][m][n]; }
                asm volatile("" ::: "memory"); }
    }
};
struct EpiSwiglu {
    static constexpr bool PERM = true;
    bf16* HID;
    __device__ __forceinline__ void operator()(const f32x4 (&acc)[2][2][4][2], const Unit& u, int wr, int wc, int fr, int fq) const {
        const int row0 = u.pm * BM + wr * 64 + fr, col0 = u.pn * 128 + wc * 32 + 8 * fq;
#pragma unroll
        for (int ai = 0; ai < 2; ++ai)
#pragma unroll
            for (int m = 0; m < 4; ++m) { bf16* rowp = HID + (size_t)(row0 + ai * HALF + m * 16) * DEXP + col0;
                f32x4 h0, h1;
#pragma unroll
                for (int j = 0; j < 4; ++j) { h0[j] = silu_f(acc[ai][0][m][0][j]) * acc[ai][1][m][0][j]; h1[j] = silu_f(acc[ai][0][m][1][j]) * acc[ai][1][m][1][j]; }
                u32x4 w; w.x = cvt_pk_bf16(h0[0], h0[1]); w.y = cvt_pk_bf16(h0[2], h0[3]); w.z = cvt_pk_bf16(h1[0], h1[1]); w.w = cvt_pk_bf16(h1[2], h1[3]);
                *(u32x4*)(rowp) = w; }
    }
};
struct EpiBf16 {
    static constexpr bool PERM = true;
    bf16* O; int ldc;
    __device__ __forceinline__ void operator()(const f32x4 (&acc)[2][2][4][2], const Unit& u, int wr, int wc, int fr, int fq) const {
        const int row0 = u.pm * BM + wr * 64 + fr, col0 = u.pn * BM + wc * 32 + 8 * fq;
#pragma unroll
        for (int ai = 0; ai < 2; ++ai)
#pragma unroll
            for (int m = 0; m < 4; ++m) { bf16* rowp = O + (size_t)(row0 + ai * HALF + m * 16) * ldc + col0;
#pragma unroll
                for (int bj = 0; bj < 2; ++bj) { const f32x4 v0 = acc[ai][bj][m][0], v1 = acc[ai][bj][m][1];
                    u32x4 w; w.x = cvt_pk_bf16(v0[0], v0[1]); w.y = cvt_pk_bf16(v0[2], v0[3]); w.z = cvt_pk_bf16(v1[0], v1[1]); w.w = cvt_pk_bf16(v1[2], v1[3]);
                    *(u32x4*)(rowp + bj * HALF) = w; } }
    }
};

__device__ __forceinline__ void transpose_item(const float* src, int ldsrc, int scol0, int k0, bf16* dst, size_t drow0, int ldd, LAS float* scr, int lane) {
#pragma unroll 8
    for (int i = 0; i < 32; ++i) { const int kk = 2 * i + (lane >> 5); scr[kk * 33 + (lane & 31)] = src[(size_t)(k0 + kk) * ldsrc + scol0 + (lane & 31)]; }
    asm volatile("s_waitcnt lgkmcnt(0)" ::: "memory");
    const int c = lane & 7;
#pragma unroll
    for (int j = 0; j < 4; ++j) { const int n = (lane >> 3) + 8 * j; const LAS float* s = scr + (8 * c) * 33 + n;
        u32x4 o; o.x = pk2(s[0 * 33], s[1 * 33]); o.y = pk2(s[2 * 33], s[3 * 33]); o.z = pk2(s[4 * 33], s[5 * 33]); o.w = pk2(s[6 * 33], s[7 * 33]);
        *(u32x4*)(dst + (drow0 + n) * (size_t)ldd + k0 + 8 * c) = o; }
    asm volatile("s_waitcnt lgkmcnt(0)" ::: "memory");
}

__device__ __forceinline__ void phase0(const Args& a, LAS unsigned char* lds) {
    const int tid = threadIdx.x, lane = tid & 63, wave = tid >> 6, G = gridDim.x, blk = blockIdx.x;
    unsigned char* ws = a.ws;
    {
        const float* c = a.in[1]; const float* cc = a.in[3]; const float* w_ada = a.in[4]; const float* b_ada = a.in[5];
        float* ada = (float*)(ws + WS_ADA);
        LAS float* red = (LAS float*)lds;
        for (int it = blk; it < 96; it += G) {
            const int col0 = it * 128 + 2 * lane;
            float a0x = 0, a0y = 0, a1x = 0, a1y = 0, a2x = 0, a2y = 0;
            const int r0 = wave * 256;
#pragma unroll 8
            for (int r = r0; r < r0 + 256; ++r) {
                const f32x2 w = *(const f32x2*)(w_ada + (size_t)r * 12288 + col0);
                const float s0 = silu_f(c[r]), s1 = silu_f(c[DM + r]), s2 = silu_f(cc[r]);
                a0x += s0 * w.x; a0y += s0 * w.y; a1x += s1 * w.x; a1y += s1 * w.y; a2x += s2 * w.x; a2y += s2 * w.y;
            }
            red[(wave * 3 + 0) * 128 + 2 * lane] = a0x; red[(wave * 3 + 0) * 128 + 2 * lane + 1] = a0y;
            red[(wave * 3 + 1) * 128 + 2 * lane] = a1x; red[(wave * 3 + 1) * 128 + 2 * lane + 1] = a1y;
            red[(wave * 3 + 2) * 128 + 2 * lane] = a2x; red[(wave * 3 + 2) * 128 + 2 * lane + 1] = a2y;
            __syncthreads();
            if (tid < 384) { const int v = tid >> 7, col = tid & 127; float s = b_ada[it * 128 + col];
                for (int w8 = 0; w8 < 8; ++w8) s += red[(w8 * 3 + v) * 128 + col];
                ada[v * 12288 + it * 128 + col] = s; }
            __syncthreads();
        }
    }
    LAS float* scr = (LAS float*)(lds + wave * 16384);
    const int gw = blk * 8 + wave, NGW = G * 8;
    constexpr int I_WIN = 32 * 129, I_ZERO = 224, I_WOUT = 32 * 64, I_WG = 16 * 32 * 32, I_WU = I_WG, I_WD = 16 * 16 * 64, I_TW = 256;
    constexpr int I_TOTAL = I_WIN + I_ZERO + I_WOUT + I_WG + I_WU + I_WD + I_TW;
    bf16* Win = (bf16*)(ws + WS_WIN); bf16* Wout = (bf16*)(ws + WS_WOUT); bf16* Wgu = (bf16*)(ws + WS_WGU); bf16* Wd = (bf16*)(ws + WS_WD);
    for (int it = gw; it < I_TOTAL; it += NGW) {
        int r = it;
        if (r < I_WIN) { const int kb = r / 129, nb = r % 129, n0 = nb * 32;
            const size_t drow = n0 < 3072 ? (size_t)n0 : (n0 < 3104 ? (size_t)(4096 + n0 - 3072) : (size_t)(3072 + n0 - 3104));
            transpose_item(a.in[7], PROJW, n0, kb * 64, Win, drow, DM, scr, lane); continue; }
        r -= I_WIN;
        if (r < I_ZERO) { u32x4 z = {0u, 0u, 0u, 0u}; u32x4* p = (u32x4*)(Win + (size_t)(4128 + r) * DM);
#pragma unroll
            for (int j = 0; j < 4; ++j) p[lane + 64 * j] = z; continue; }
        r -= I_ZERO;
        if (r < I_WOUT) { const int kb = r / 64, nb = r % 64; transpose_item(a.in[13], DM, nb * 32, kb * 64, Wout, (size_t)nb * 32, DM, scr, lane); continue; }
        r -= I_WOUT;
        if (r < I_WG + I_WU) { const int up = r >= I_WG; if (up) r -= I_WG; const int e = r / 1024, rr = r % 1024, kb = rr / 32, nb = rr % 32, n0 = nb * 32;
            const float* src = (up ? a.in[17] : a.in[16]) + (size_t)e * DM * DEXP;
            const size_t drow = (size_t)e * 2048 + (size_t)(n0 >> 7) * 256 + (n0 & 127) + (up ? 128 : 0);
            transpose_item(src, DEXP, n0, kb * 64, Wgu, drow, DM, scr, lane); continue; }
        r -= I_WG + I_WU;
        if (r < I_WD) { const int e = r / 1024, rr = r % 1024, kb = rr / 64, nb = rr % 64;
            transpose_item(a.in[18] + (size_t)e * DEXP * DM, DM, nb * 32, kb * 64, Wd, (size_t)e * 2048 + nb * 32, DEXP, scr, lane); continue; }
        r -= I_WD;
        { const int p = r * 64 + lane; float s, c; sincospif((float)p * (1.0f / 8192.0f), &s, &c); ((f32x2*)(ws + WS_TW))[p] = (f32x2){c, s}; }
    }
}

__device__ __forceinline__ void phase1(const Args& a) {
    const int tid = threadIdx.x, lane = tid & 63, wave = tid >> 6, G = gridDim.x;
    const int gw = blockIdx.x * 8 + wave, NGW = G * 8;
    const float* ada = (const float*)(a.ws + WS_ADA); const float* g1n = a.in[6];
    bf16* H = (bf16*)(a.ws + WS_H);
    for (int r = gw; r < NROWS; r += NGW) {
        const float* xr; int v;
        if (r < NLAT) { xr = a.in[0] + (size_t)r * DM; v = r / SEQ; } else { xr = a.in[2] + (size_t)(r - NLAT) * DM; v = 2; }
        const float* sh = ada + (size_t)v * 12288; const float* sc = sh + DM;
        f32x4 x[8]; float ss = 0.f;
#pragma unroll
        for (int j = 0; j < 8; ++j) { x[j] = *(const f32x4*)(xr + 256 * j + 4 * lane); ss += (x[j].x * x[j].x + x[j].y * x[j].y) + (x[j].z * x[j].z + x[j].w * x[j].w); }
        const float rstd = rsqrtf(wave_sum(ss) * (1.f / DM) + EPS);
        u32x2* o = (u32x2*)(H + (size_t)r * DM);
#pragma unroll
        for (int j = 0; j < 8; ++j) { const int d = 256 * j + 4 * lane; const f32x4 g = *(const f32x4*)(g1n + d), s1 = *(const f32x4*)(sc + d), s0 = *(const f32x4*)(sh + d);
            const f32x4 hh = (x[j] * rstd * g) * (s1 + 1.f) + s0;
            u32x2 w; w.x = pk2(hh.x, hh.y); w.y = pk2(hh.z, hh.w); o[64 * j + lane] = w; }
    }
}

__device__ __forceinline__ void gla_scan(const Args& a, LAS unsigned char* lds, int item, bool is_ctx) {
    const int tid = threadIdx.x, lane = tid & 63, wave = tid >> 6;
    const int b = item >> 3, h = (item >> 1) & 3, dir = item & 1;
    const bf16* P = (const bf16*)(a.ws + WS_P); const float* Z = (const float*)(a.ws + WS_Z);
    const float* w_a2 = dir ? a.in[10] : a.in[8]; const float* b_a2 = dir ? a.in[11] : a.in[9];
    float* st0 = (float*)(a.ws + WS_ST0) + (size_t)((b * 2 + dir) * 4 + h) * 128 * 256;
    float* O = (float*)(a.ws + (dir ? WS_OB : WS_OF));
    LAS float* sA = (LAS float*)lds;
    LAS float* sQ = sA + 32 * 128;
    LAS float* sK = sQ + 32 * 128;
    LAS float* sV = sK + 32 * 128;
    const int vcol = wave * 32 + (lane & 31), dh = lane >> 5;
    const int ntok = is_ctx ? CTXL : SEQ;
    const size_t rowbase = is_ctx ? (size_t)(NLAT + b * CTXL) : (size_t)b * SEQ;
    float S[64];
#pragma unroll
    for (int d = 0; d < 64; ++d) S[d] = is_ctx ? 0.f : st0[(size_t)(dh * 64 + d) * 256 + vcol];
    const float qscale = 0.08838834764831845f;
    for (int c0 = 0; c0 < ntok; c0 += 32) {
        for (int e = tid; e < 32 * 128; e += NTHREADS) { const int i = e >> 7, d = e & 127; const int t = dir ? (ntok - 1 - (c0 + i)) : (c0 + i); const size_t row = rowbase + t;
            const float* zr = Z + row * 32 + dir * 16; float pre = b_a2[h * 128 + d];
#pragma unroll
            for (int r = 0; r < 16; ++r) pre += zr[r] * w_a2[r * 512 + h * 128 + d];
            sA[e] = expf(logsigmoid_f(pre) * (1.f / 16.f));
            sQ[e] = bf2f(P[row * PW + h * 128 + d]) * qscale;
            sK[e] = bf2f(P[row * PW + 512 + h * 128 + d]); }
        for (int e = tid; e < 32 * 256; e += NTHREADS) { const int i = e >> 8, v = e & 255; const int t = dir ? (ntok - 1 - (c0 + i)) : (c0 + i); const size_t row = rowbase + t;
            sV[e] = bf2f(P[row * PW + 1024 + h * 256 + v]); }
        __syncthreads();
        for (int i = 0; i < 32; ++i) {
            const float vv = sV[i * 256 + vcol]; float o = 0.f;
            const LAS f32x4* pa = (const LAS f32x4*)(sA + i * 128 + dh * 64); const LAS f32x4* pq = (const LAS f32x4*)(sQ + i * 128 + dh * 64); const LAS f32x4* pk = (const LAS f32x4*)(sK + i * 128 + dh * 64);
#pragma unroll
            for (int d4 = 0; d4 < 16; ++d4) { const f32x4 av = pa[d4], qv = pq[d4], kv = pk[d4];
#pragma unroll
                for (int j = 0; j < 4; ++j) { S[d4 * 4 + j] = av[j] * S[d4 * 4 + j] + kv[j] * vv; o += qv[j] * S[d4 * 4 + j]; } }
            o += __shfl_xor(o, 32);
            if (!is_ctx && dh == 0) { const int t = dir ? (ntok - 1 - (c0 + i)) : (c0 + i); O[(rowbase + t) * 1024 + h * 256 + vcol] = o; }
        }
        __syncthreads();
    }
    if (is_ctx) {
#pragma unroll
        for (int d = 0; d < 64; ++d) st0[(size_t)(dh * 64 + d) * 256 + vcol] = S[d];
    }
}

__device__ __forceinline__ void phase_gla_merge(const Args& a) {
    const int tid = threadIdx.x, lane = tid & 63, wave = tid >> 6;
    const int gw = blockIdx.x * 8 + wave, NGW = gridDim.x * 8;
    const float* OF = (const float*)(a.ws + WS_OF); const float* OB = (const float*)(a.ws + WS_OB);
    const bf16* P = (const bf16*)(a.ws + WS_P); bf16* Y = (bf16*)(a.ws + WS_YCAT); const float* gg = a.in[12];
    for (int r = gw; r < NLAT; r += NGW) {
#pragma unroll
        for (int j = 0; j < 4; ++j) {
            const int col = 256 * j + 4 * lane;
            const f32x4 o = *(const f32x4*)(OF + (size_t)r * 1024 + col) + *(const f32x4*)(OB + (size_t)r * 1024 + col);
            const float ss = wave_sum((o.x * o.x + o.y * o.y) + (o.z * o.z + o.w * o.w));
            const float rstd = rsqrtf(ss * (1.f / 256.f) + EPS);
            const u32x2 gw2 = *(const u32x2*)(P + (size_t)r * PW + 2048 + col);
            const f32x4 gn = *(const f32x4*)(gg + col);
            const float g0 = __uint_as_float(gw2.x << 16), g1 = __uint_as_float(gw2.x & 0xffff0000u), g2 = __uint_as_float(gw2.y << 16), g3 = __uint_as_float(gw2.y & 0xffff0000u);
            u32x2 w; w.x = pk2(o.x * rstd * gn.x * silu_f(g0), o.y * rstd * gn.y * silu_f(g1)); w.y = pk2(o.z * rstd * gn.z * silu_f(g2), o.w * rstd * gn.w * silu_f(g3));
            *(u32x2*)(Y + (size_t)r * DM + col) = w;
        }
    }
}

__device__ __forceinline__ void phase_f1(const Args& a) {
    const int tid = threadIdx.x;
    const bf16* P = (const bf16*)(a.ws + WS_P); const f32x2* TW = (const f32x2*)(a.ws + WS_TW); f32x2* FA = (f32x2*)(a.ws + WS_FA);
    const int nitems = NB * 128 * 128 * 2;
    for (int it = blockIdx.x; it < nitems; it += gridDim.x) {
        const int chh = it & 1, l2 = (it >> 1) & 127, k1 = (it >> 8) & 127, b = it >> 15;
        const int ch = chh * 512 + tid;
        float ar = 0.f, ai = 0.f;
        const bf16* up = P + ((size_t)b * SEQ + l2) * PW + 3072 + ch;
#pragma unroll 8
        for (int l1 = 0; l1 < 128; ++l1) { const float x = bf2f(up[(size_t)l1 * 128 * PW]); const f32x2 w = TW[((l1 * k1) & 127) * 128]; ar += x * w.x; ai -= x * w.y; }
        const f32x2 t = TW[l2 * k1];
        FA[(((size_t)b * 128 + k1) * 128 + l2) * 1024 + ch] = (f32x2){ar * t.x + ai * t.y, ai * t.x - ar * t.y};
    }
}
__device__ __forceinline__ void phase_f3(const Args& a) {
    const int tid = threadIdx.x;
    const f32x2* TW = (const f32x2*)(a.ws + WS_TW); const f32x2* FA = (const f32x2*)(a.ws + WS_FA); f32x2* FX = (f32x2*)(a.ws + WS_FX);
    const int nitems = NB * 128 * 32 * 2;
    for (int it = blockIdx.x; it < nitems; it += gridDim.x) {
        const int chh = it & 1, kg = (it >> 1) & 31, k1 = (it >> 6) & 127, b = it >> 13;
        const int ch = chh * 512 + tid;
        float xr[4] = {0, 0, 0, 0}, xi[4] = {0, 0, 0, 0};
        const f32x2* fp = FA + (((size_t)b * 128 + k1) * 128) * 1024 + ch;
#pragma unroll 4
        for (int l2 = 0; l2 < 128; ++l2) { const f32x2 v = fp[(size_t)l2 * 1024];
#pragma unroll
            for (int q = 0; q < 4; ++q) { const int k2 = kg * 4 + q; const f32x2 w = TW[((l2 * k2) & 127) * 128]; xr[q] += v.x * w.x + v.y * w.y; xi[q] += v.y * w.x - v.x * w.y; } }
#pragma unroll
        for (int q = 0; q < 4; ++q) { const int lp = k1 + 128 * (kg * 4 + q); FX[((size_t)b * SEQ + lp) * 1024 + ch] = (f32x2){xr[q], xi[q]}; }
    }
}
__device__ __forceinline__ void phase_f4(const Args& a, LAS unsigned char* lds) {
    const int tid = threadIdx.x;
    const f32x2* TW = (const f32x2*)(a.ws + WS_TW); const f32x2* FX = (const f32x2*)(a.ws + WS_FX); bf16* Y = (bf16*)(a.ws + WS_YCAT);
    LAS f32x2* T128 = (LAS f32x2*)lds;
    LAS f32x2* xs = T128 + 128;
    if (tid < 128) T128[tid] = TW[tid * 128];
    __syncthreads();
    const float nrm = 1.0f / 1448.15468787005f;
    for (int r = blockIdx.x; r < NLAT; r += gridDim.x) {
        xs[tid] = FX[(size_t)r * 1024 + tid]; xs[tid + 512] = FX[(size_t)r * 1024 + 512 + tid];
        __syncthreads();
#pragma unroll
        for (int half = 0; half < 2; ++half) { const int col = half * 512 + tid, g = col >> 7, cp = col & 127; float y = 0.f;
#pragma unroll 8
            for (int c = 0; c < 128; ++c) { const f32x2 v = xs[g * 128 + c]; const f32x2 w = T128[(c * cp) & 127]; y += v.x * w.x + v.y * w.y; }
            Y[(size_t)r * DM + 1024 + col] = (bf16)f2bf(y * nrm); }
        __syncthreads();
    }
}

__device__ __forceinline__ void phase_norm2(const Args& a) {
    const int tid = threadIdx.x, lane = tid & 63, wave = tid >> 6;
    const int gw = blockIdx.x * 8 + wave, NGW = gridDim.x * 8;
    const float* ada = (const float*)(a.ws + WS_ADA); const float* g2n = a.in[14]; const float* wr = a.in[15];
    const float* XL = (const float*)(a.ws + WS_XL); bf16* HF = (bf16*)(a.ws + WS_HF); float* AFF = (float*)(a.ws + WS_AFF);
    for (int r = gw; r < NLAT; r += NGW) {
        const int b = r / SEQ, t = r % SEQ;
        const float* sh = ada + (size_t)b * 12288 + 3 * DM; const float* sc = sh + DM;
        const float* xr = XL + (size_t)r * DM;
        f32x4 x[8]; float ss = 0.f;
#pragma unroll
        for (int j = 0; j < 8; ++j) { x[j] = *(const f32x4*)(xr + 256 * j + 4 * lane); ss += (x[j].x * x[j].x + x[j].y * x[j].y) + (x[j].z * x[j].z + x[j].w * x[j].w); }
        const float rstd = rsqrtf(wave_sum(ss) * (1.f / DM) + EPS);
        float p[16];
#pragma unroll
        for (int e = 0; e < 16; ++e) p[e] = 0.f;
        u32x2* o = (u32x2*)(HF + (size_t)r * DM);
#pragma unroll
        for (int j = 0; j < 8; ++j) { const int d = 256 * j + 4 * lane; const f32x4 g = *(const f32x4*)(g2n + d), s1 = *(const f32x4*)(sc + d), s0 = *(const f32x4*)(sh + d);
            const f32x4 hh = (x[j] * rstd * g) * (s1 + 1.f) + s0;
            u32x2 w; w.x = pk2(hh.x, hh.y); w.y = pk2(hh.z, hh.w); o[64 * j + lane] = w;
#pragma unroll
            for (int jj = 0; jj < 4; ++jj) { const float hv = hh[jj]; const f32x4* wp = (const f32x4*)(wr + (size_t)(d + jj) * 16);
#pragma unroll
                for (int q = 0; q < 4; ++q) { const f32x4 wv = wp[q]; p[q * 4 + 0] += hv * wv.x; p[q * 4 + 1] += hv * wv.y; p[q * 4 + 2] += hv * wv.z; p[q * 4 + 3] += hv * wv.w; } } }
        float mx = -1e30f;
#pragma unroll
        for (int e = 0; e < 16; ++e) { p[e] = wave_sum(p[e]); mx = fmaxf(mx, p[e]); }
        float sum = 0.f;
#pragma unroll
        for (int e = 0; e < 16; ++e) { p[e] = expf(p[e] - mx); sum += p[e]; }
        float mine = 0.f;
#pragma unroll
        for (int e = 0; e < 16; ++e) mine = (lane == e) ? p[e] : mine;
        if (lane < 16) AFF[((size_t)b * NE + lane) * SEQ + t] = mine / sum;
    }
}

__device__ __forceinline__ void phase_topk(const Args& a, LAS unsigned char* lds) {
    const int tid = threadIdx.x;
    LAS unsigned* keys = (LAS unsigned*)lds;
    LAS unsigned* hist = (LAS unsigned*)(lds + 65536);
    LAS unsigned* misc = hist + 256;
    LAS unsigned* sg = misc + 16;
    LAS unsigned* se = sg + 512;
    const float* AFF = (const float*)(a.ws + WS_AFF); int* TOK = (int*)(a.ws + WS_TOK); float* GATE = (float*)(a.ws + WS_GATE); int* SEL = (int*)(a.ws + WS_SEL);
    for (int be = blockIdx.x; be < NB * NE; be += gridDim.x) {
        const int b = be / NE, e = be % NE;
        for (int i = tid; i < SEQ; i += NTHREADS) keys[i] = __float_as_uint(AFF[(size_t)be * SEQ + i]);
        unsigned prefix = 0u, pmask = 0u, krem = CAP;
        for (int pass = 0; pass < 4; ++pass) {
            const int shift = 24 - 8 * pass;
            if (tid < 256) hist[tid] = 0u;
            __syncthreads();
            for (int i = tid; i < SEQ; i += NTHREADS) { const unsigned k = keys[i]; if ((k & pmask) == prefix) atomicAdd((unsigned*)&hist[(k >> shift) & 255u], 1u); }
            __syncthreads();
            if (tid == 0) { unsigned cum = 0u; int bsel = 0;
                for (int bk = 255; bk >= 0; --bk) { const unsigned c = hist[bk]; if (cum + c >= krem) { bsel = bk; break; } cum += c; }
                misc[0] = prefix | ((unsigned)bsel << shift); misc[1] = krem - cum; }
            __syncthreads();
            prefix = misc[0]; krem = misc[1]; pmask |= (0xffu << shift);
            __syncthreads();
        }
        const unsigned T = prefix;
        unsigned cg_ = 0u, ce = 0u;
        for (int i = 0; i < 32; ++i) { const unsigned k = keys[tid * 32 + i]; cg_ += (k > T); ce += (k == T); }
        sg[tid] = cg_; se[tid] = ce;
        __syncthreads();
        if (tid == 0) { unsigned rg = 0u, re = 0u; for (int i = 0; i < NTHREADS; ++i) { const unsigned x = sg[i], y = se[i]; sg[i] = rg; se[i] = re; rg += x; re += y; } }
        __syncthreads();
        unsigned gt_before = sg[tid], eq_before = se[tid];
        for (int i = 0; i < 32; ++i) { const int t = tid * 32 + i; const unsigned k = keys[t];
            const bool isgt = k > T, iseq = k == T; const bool take = isgt || (iseq && eq_before < krem);
            const unsigned slot = gt_before + (eq_before < krem ? eq_before : krem);
            if (take) { TOK[(size_t)be * CAP + slot] = t; GATE[(size_t)be * CAP + slot] = __uint_as_float(k); }
            SEL[((size_t)b * SEQ + t) * NE + e] = take ? (int)slot : -1;
            gt_before += isgt; eq_before += iseq; }
        __syncthreads();
    }
}

__device__ __forceinline__ void phase_final(const Args& a) {
    const int tid = threadIdx.x, lane = tid & 63, wave = tid >> 6;
    const int gw = blockIdx.x * 8 + wave, NGW = gridDim.x * 8;
    const float* ada = (const float*)(a.ws + WS_ADA); const float* fg = a.in[19];
    const float* XL = (const float*)(a.ws + WS_XL); const bf16* YE = (const bf16*)(a.ws + WS_YE);
    const float* GATE = (const float*)(a.ws + WS_GATE); const int* SEL = (const int*)(a.ws + WS_SEL);
    for (int r = gw; r < NLAT; r += NGW) {
        const int b = r / SEQ;
        const float* g2 = ada + (size_t)b * 12288 + 5 * DM;
        f32x4 m[8];
#pragma unroll
        for (int j = 0; j < 8; ++j) m[j] = (f32x4){0.f, 0.f, 0.f, 0.f};
        for (int e = 0; e < NE; ++e) { const int s = SEL[(size_t)r * NE + e];
            if (s >= 0) { const float gt = GATE[((size_t)b * NE + e) * CAP + s]; const bf16* yr = YE + ((size_t)(e * 2 + b) * CAP + s) * DM;
#pragma unroll
                for (int j = 0; j < 8; ++j) { const u32x2 w = *(const u32x2*)(yr + 256 * j + 4 * lane);
                    m[j].x += gt * __uint_as_float(w.x << 16); m[j].y += gt * __uint_as_float(w.x & 0xffff0000u); m[j].z += gt * __uint_as_float(w.y << 16); m[j].w += gt * __uint_as_float(w.y & 0xffff0000u); } } }
        float ss = 0.f;
#pragma unroll
        for (int j = 0; j < 8; ++j) { const int d = 256 * j + 4 * lane; const f32x4 xv = *(const f32x4*)(XL + (size_t)r * DM + d), gv = *(const f32x4*)(g2 + d);
            m[j] = xv + gv * m[j]; ss += (m[j].x * m[j].x + m[j].y * m[j].y) + (m[j].z * m[j].z + m[j].w * m[j].w); }
        const float rstd = rsqrtf(wave_sum(ss) * (1.f / DM) + EPS);
#pragma unroll
        for (int j = 0; j < 8; ++j) { const int d = 256 * j + 4 * lane; const f32x4 gv = *(const f32x4*)(fg + d);
            *(f32x4*)(a.out + (size_t)r * DM + d) = m[j] * rstd * gv; }
    }
}

constexpr int NPHASES = 15;
__global__ void __launch_bounds__(NTHREADS, 2) mega(Args a) {
    extern __shared__ __attribute__((aligned(16))) unsigned char lds_raw[];
    LAS unsigned char* lds = (LAS unsigned char*)lds_raw;
    cg::grid_group grid = cg::this_grid();
    const int lo = a.ph_lo, hi = a.ph_hi;
    unsigned char* ws = a.ws;
#define IN(k) (lo <= (k) && (k) < hi)
#define SEAM(k) do { if (IN(k) && IN((k) + 1)) grid.sync(); } while (0)
    if (IN(0)) phase0(a, lds);
    SEAM(0);
    if (IN(1)) phase1(a);
    SEAM(1);
    if (IN(2)) {
        SchedPlain S; S.init(NROWS / 256, WIN_ROWS / 256, gridDim.x, blockIdx.x); S.A = (const char*)(ws + WS_H); S.B = (const char*)(ws + WS_WIN); S.tstep = (size_t)256 * DM * 2;
        EpiInProj E{(bf16*)(ws + WS_P), (float*)(ws + WS_Z)};
        pg8::gemm_phase<EpiInProj, SchedPlain, false, true, true>(lds, DM, S, E);
    }
    SEAM(2);
    if (IN(3)) { for (int it = blockIdx.x; it < 16; it += gridDim.x) gla_scan(a, lds, it, true); }
    SEAM(3);
    if (IN(4)) { for (int it = blockIdx.x; it < 16; it += gridDim.x) gla_scan(a, lds, it, false); }
    SEAM(4);
    if (IN(5)) phase_gla_merge(a);
    SEAM(5);
    if (IN(6)) phase_f1(a);
    SEAM(6);
    if (IN(7)) phase_f3(a);
    SEAM(7);
    if (IN(8)) phase_f4(a, lds);
    SEAM(8);
    if (IN(9)) {
        SchedPlain S; S.init(NLAT / 256, DM / 256, gridDim.x, blockIdx.x); S.A = (const char*)(ws + WS_YCAT); S.B = (const char*)(ws + WS_WOUT); S.tstep = (size_t)256 * DM * 2;
        EpiOutProj E{a.in[0], (float*)(ws + WS_XL), (const float*)(ws + WS_ADA)};
        pg8::gemm_phase<EpiOutProj, SchedPlain, false, true, true>(lds, DM, S, E);
    }
    SEAM(9);
    if (IN(10)) phase_norm2(a);
    SEAM(10);
    if (IN(11)) phase_topk(a, lds);
    SEAM(11);
    if (IN(12)) {
        SchedMoeUp S; S.init(256, 8, gridDim.x, blockIdx.x); S.A = (const char*)(ws + WS_HF); S.B = (const char*)(ws + WS_WGU); S.tok = (const int*)(ws + WS_TOK);
        EpiSwiglu E{(bf16*)(ws + WS_HID)};
        pg8::gemm_phase<EpiSwiglu, SchedMoeUp, true, true, true>(lds, DM, S, E);
    }
    SEAM(12);
    if (IN(13)) {
        SchedMoeDown S; S.init(256, 8, gridDim.x, blockIdx.x); S.A = (const char*)(ws + WS_HID); S.B = (const char*)(ws + WS_WD);
        EpiBf16 E{(bf16*)(ws + WS_YE), DM};
        pg8::gemm_phase<EpiBf16, SchedMoeDown, false, true, true>(lds, DEXP, S, E);
    }
    SEAM(13);
    if (IN(14)) phase_final(a);
#undef IN
#undef SEAM
}

#ifndef N_LAUNCH_MODE
#define N_LAUNCH_MODE 1
#endif
extern "C" void kernel_launch(void* const* d_in, const int* in_sizes, int n_in, void* d_out, int out_size, void* d_ws, size_t ws_size, hipStream_t stream) {
    static int grid = 0;
    if (grid == 0) {
        if (n_in != 20 || out_size != NLAT * DM || ws_size < WS_END) { fprintf(stderr, "kernel_launch: unexpected sizes n_in %d out %d ws %zu\n", n_in, out_size, ws_size); grid = -1; return; }
        int dev = 0, cus = 0, per_cu = 0;
        (void)hipGetDevice(&dev); (void)hipDeviceGetAttribute(&cus, hipDeviceAttributeMultiprocessorCount, dev);
        if (hipFuncSetAttribute((const void*)mega, hipFuncAttributeMaxDynamicSharedMemorySize, LDS_BYTES) != hipSuccess) { fprintf(stderr, "kernel_launch: hipFuncSetAttribute failed\n"); grid = -1; return; }
        (void)hipOccupancyMaxActiveBlocksPerMultiprocessor(&per_cu, (const void*)mega, NTHREADS, LDS_BYTES);
        if (per_cu < 1) { fprintf(stderr, "kernel_launch: occupancy query reports %d blocks per CU\n", per_cu); per_cu = 1; }
        (void)hipGetLastError();
        grid = cus * 1;
    }
    if (grid < 0) return;
    Args a{};
    for (int i = 0; i < 20; ++i) a.in[i] = (const float*)d_in[i];
    a.out = (float*)d_out; a.ws = (unsigned char*)d_ws;
#if N_LAUNCH_MODE == 0
    for (int p = 0; p < NPHASES; ++p) { a.ph_lo = p; a.ph_hi = p + 1; hipLaunchKernelGGL(mega, dim3(grid), dim3(NTHREADS), LDS_BYTES, stream, a); }
#else
    a.ph_lo = 0; a.ph_hi = NPHASES;
    void* args[] = {&a};
    hipError_t e = hipLaunchCooperativeKernel((void*)mega, dim3(grid), dim3(NTHREADS), args, LDS_BYTES, stream);
    if (e != hipSuccess) fprintf(stderr, "cooperative launch failed: %s (grid %d)\n", hipGetErrorString(e), grid);
#endif
}
```

```cpp
#include <hip/hip_runtime.h>
#include <hip/hip_cooperative_groups.h>
#include <cstdio>
#include <cstdint>
namespace cg = cooperative_groups;

#define LAS __attribute__((address_space(3)))
typedef unsigned short bf16;
typedef short bf16x8 __attribute__((ext_vector_type(8)));
typedef float f32x4 __attribute__((ext_vector_type(4)));
typedef float f32x2 __attribute__((ext_vector_type(2)));
typedef unsigned u32x4 __attribute__((ext_vector_type(4)));
typedef unsigned u32x2 __attribute__((ext_vector_type(2)));

constexpr int NB = 2, SEQ = 16384, DM = 2048, CTXL = 256;
constexpr int NLAT = NB * SEQ;
constexpr int NROWS = NLAT + NB * CTXL;
constexpr int PROJW = 4128;
constexpr int NE = 16, CAP = 2048, DEXP = 1024;
constexpr int PW = 4096;
constexpr int WIN_ROWS = 4352;
constexpr float EPS = 1e-6f;

constexpr size_t MiB = 1u << 20;
constexpr size_t WS_ADA = 0;
constexpr size_t WS_TW = 1 * MiB;
constexpr size_t WS_FC = 1 * MiB + 256 * 1024;
constexpr size_t WS_FS = 1 * MiB + 320 * 1024;
constexpr size_t WS_Z = 2 * MiB;
constexpr size_t WS_AFF = 8 * MiB;
constexpr size_t WS_TOK = 10 * MiB;
constexpr size_t WS_GATE = 11 * MiB;
constexpr size_t WS_SEL = 12 * MiB;
constexpr size_t WS_ST0 = 14 * MiB;
constexpr size_t WS_WIN = 32 * MiB;
constexpr size_t WS_WOUT = 50 * MiB;
constexpr size_t WS_WGU = 58 * MiB;
constexpr size_t WS_WD = 186 * MiB;
constexpr size_t WS_P = 250 * MiB;
constexpr size_t WS_HF = 250 * MiB;
constexpr size_t WS_HID = 378 * MiB;
constexpr size_t WS_FX = 250 * MiB;
constexpr size_t WS_FA = 510 * MiB;
constexpr size_t WS_FAI = 574 * MiB;
constexpr size_t WS_H = 510 * MiB;
constexpr size_t WS_OF = 510 * MiB;
constexpr size_t WS_OB = 638 * MiB;
constexpr size_t WS_XL = 510 * MiB;
constexpr size_t WS_YCAT = 766 * MiB;
constexpr size_t WS_YE = 766 * MiB;
constexpr size_t WS_END = 1022 * MiB;

constexpr int LDS_BYTES = 147456;
constexpr int NTHREADS = 512;

struct Args {
    const float* in[20];
    float* out;
    unsigned char* ws;
    int ph_lo, ph_hi;
};

__device__ __forceinline__ float bf2f(bf16 v) { return __uint_as_float(((unsigned)v) << 16); }
__device__ __forceinline__ unsigned f2bf(float f) { unsigned u = __float_as_uint(f); return (u + 0x7fffu + ((u >> 16) & 1u)) >> 16; }
__device__ __forceinline__ unsigned pk2(float lo, float hi) { return f2bf(lo) | (f2bf(hi) << 16); }
__device__ __forceinline__ float wave_sum(float v) {
#pragma unroll
    for (int o = 1; o < 64; o <<= 1) v += __shfl_xor(v, o);
    return v;
}
__device__ __forceinline__ float silu_f(float x) { return x / (1.f + __expf(-x)); }
__device__ __forceinline__ float logsigmoid_f(float x) { return fminf(x, 0.f) - log1pf(expf(-fabsf(x))); }

namespace pg8 {
constexpr int BM = 256, BK = 64, HALF = 128, HTB = HALF * BK * 2, STAGE_BYTES = 8 * HTB, NXCD = 8, WGM = 8;
__host__ __device__ __forceinline__ int lds_byte(int r, int c) { const int st = (r >> 4) * 2 + (c >> 5), rr = r & 15, cc = c & 31, ob = rr * 64 + cc * 2; return st * 1024 + (ob ^ (((ob >> 9) & 1) << 5)); }
__host__ __device__ __forceinline__ void stage_rc(int b, int& R, int& C) { const int st = b / 1024, sb = b % 1024, swz = sb ^ (((sb >> 9) & 1) << 5); R = (st >> 1) * 16 + swz / 64; C = (st & 1) * 32 + (swz % 64) / 2; }
__host__ __device__ __forceinline__ int perm32(int rho) { const int n = rho >> 4, i = rho & 15; return 8 * (i >> 2) + 4 * n + (i & 3); }
struct Unit { int pm, pn; };
__device__ __forceinline__ unsigned cvt_pk_bf16(float lo, float hi) { unsigned r; asm volatile("v_cvt_pk_bf16_f32 %0, %1, %2" : "=v"(r) : "v"(lo), "v"(hi)); return r; }

struct OrderBase {
    int nM, nN, nwg, G, c;
    __device__ void init(int nM_, int nN_, int G_, int c_) { nM = nM_; nN = nN_; nwg = nM * nN; G = G_; c = c_; }
    __device__ bool next(int i, Unit& u) const {
        const long L = (long)i * G + c; if (L >= nwg) return false;
        int wgid = (int)L; { const int q = nwg / NXCD, r = nwg % NXCD, xcd = wgid % NXCD, off = wgid / NXCD; wgid = (xcd < r ? xcd * (q + 1) : r * (q + 1) + (xcd - r) * q) + off; }
        const int nig = WGM * nN, gid = wgid / nig, fm = gid * WGM, gsz = (nM - fm) < WGM ? (nM - fm) : WGM;
        u.pm = fm + ((wgid % nig) % gsz); u.pn = (wgid % nig) / gsz; return true;
    }
};

template <class Epi, class Sched, bool GATHER, bool ALIGN_EPI, bool SP2>
__device__ __forceinline__ void gemm_phase(LAS unsigned char* lds, const int K, const Sched& S, const Epi& E) {
    const int tid = threadIdx.x, wid = __builtin_amdgcn_readfirstlane(tid >> 6), lane = tid & 63, wr = wid >> 2, wc = wid & 3, fr = lane & 15, fq = lane >> 4;
    const int nt = K / BK;
    unsigned voffA[2], voffA1[2], voffB[2];
    int RA[2], CA[2];
#pragma unroll
    for (int i = 0; i < 2; ++i) { int R, C; stage_rc(tid * 16 + i * 8192, R, C); const int Rb = Epi::PERM ? ((R & ~31) + perm32(R & 31)) : R;
        RA[i] = R; CA[i] = C;
        voffA[i] = (unsigned)(R * K + C) * 2u; voffA1[i] = voffA[i]; voffB[i] = (unsigned)(Rb * K + C) * 2u; }
    const size_t kstep = (size_t)(BK * 2);
    const size_t hstep = (size_t)HALF * K * 2;
    const size_t hstepA = GATHER ? 0 : hstep;
    const unsigned ldsw = (unsigned)wid * 1024u;
    const int aoff = lds_byte(wr * 64 + fr, fq * 8), boff = lds_byte(wc * 32 + fr, fq * 8);
#define PG8_SA(b, h) (((b) * 2 + (h)) * HTB)
#define PG8_SB(b, h) ((4 + (b) * 2 + (h)) * HTB)
#define PG8_STAGE(bufoff, gbase, voff) do { _Pragma("unroll") for (int _i = 0; _i < 2; ++_i) \
        __builtin_amdgcn_global_load_lds((const unsigned*)((const char*)(gbase) + (voff)[_i]), (LAS unsigned*)(lds + (bufoff) + ldsw + _i * 8192), 16, 0, 0); } while (0)
#define PG8_LDA(dst, b, h) do { _Pragma("unroll") for (int m = 0; m < 4; ++m) _Pragma("unroll") for (int k = 0; k < 2; ++k) dst[m][k] = *(const LAS bf16x8*)(lds + PG8_SA(b, h) + aoff + m * 2048 + k * 1024); } while (0)
#define PG8_LDB(dst, b, h) do { _Pragma("unroll") for (int n = 0; n < 2; ++n) _Pragma("unroll") for (int k = 0; k < 2; ++k) dst[n][k] = *(const LAS bf16x8*)(lds + PG8_SB(b, h) + boff + n * 2048 + k * 1024); } while (0)
#define PG8_MMA(ai, bj, At, Bt) do { __builtin_amdgcn_s_setprio(1); _Pragma("unroll") for (int m = 0; m < 4; ++m) _Pragma("unroll") for (int n = 0; n < 2; ++n) _Pragma("unroll") for (int k = 0; k < 2; ++k) \
        acc[ai][bj][m][n] = __builtin_amdgcn_mfma_f32_16x16x32_bf16(Bt[n][k], At[m][k], acc[ai][bj][m][n], 0, 0, 0); __builtin_amdgcn_s_setprio(0); } while (0)
#define PG8_WAIT_V(n) asm volatile("s_waitcnt vmcnt(" #n ")" ::: "memory")
#define PG8_WAIT_L(n) asm volatile("s_waitcnt lgkmcnt(" #n ")" ::: "memory")
#define PG8_BAR __builtin_amdgcn_s_barrier()
#define PG8_SCHED __builtin_amdgcn_sched_barrier(0)
    Unit cur, nxt; int ui = 0;
    if (!S.next(0, cur)) return;
    f32x4 acc[2][2][4][2];
#pragma unroll
    for (int a = 0; a < 2; ++a)
#pragma unroll
        for (int b = 0; b < 2; ++b)
#pragma unroll
            for (int m = 0; m < 4; ++m)
#pragma unroll
                for (int n = 0; n < 2; ++n) acc[a][b][m][n] = (f32x4){0.f, 0.f, 0.f, 0.f};
    bf16x8 At[4][2], B0[2][2], B1[2][2];
    const char* cA = S.abase(cur); const char* cB = S.bbase(cur);
    if constexpr (GATHER) {
#pragma unroll
        for (int i = 0; i < 2; ++i) { voffA[i] = ((unsigned)S.arow(cur, RA[i]) * (unsigned)K + (unsigned)CA[i]) * 2u; voffA1[i] = ((unsigned)S.arow(cur, HALF + RA[i]) * (unsigned)K + (unsigned)CA[i]) * 2u; }
    }
    static_assert(SP2, "only the SP2 loop is kept");
    PG8_STAGE(PG8_SB(0, 0), cB, voffB); PG8_STAGE(PG8_SB(0, 1), cB + hstep, voffB); PG8_STAGE(PG8_SA(0, 0), cA, voffA); PG8_STAGE(PG8_SA(0, 1), cA + hstepA, voffA1);
    if (wr == 1) PG8_BAR;
    PG8_WAIT_V(2); PG8_BAR;
    PG8_STAGE(PG8_SB(1, 0), cB + kstep, voffB); PG8_STAGE(PG8_SA(1, 0), cA + kstep, voffA); PG8_STAGE(PG8_SB(1, 1), cB + hstep + kstep, voffB);
    PG8_WAIT_V(6); PG8_BAR;
    for (;;) {
        const bool has_next = S.next(ui + 1, nxt);
        const char* nA = has_next ? S.abase(nxt) : cA; const char* nB = has_next ? S.bbase(nxt) : cB;
        for (int t = 0; t < nt; t += 2) {
            const bool last = (t == nt - 2);
            const char* a1 = cA + (size_t)(t + 1) * kstep;
            const char* a2 = last ? nA : cA + (size_t)(t + 2) * kstep; const char* b2 = last ? nB : cB + (size_t)(t + 2) * kstep;
            const char* a3 = a2 + kstep; const char* b3 = b2 + kstep;
            PG8_LDB(B0, 0, 0); PG8_LDB(B1, 0, 1); PG8_SCHED; PG8_LDA(At, 0, 0); PG8_STAGE(PG8_SA(1, 1), a1 + hstepA, voffA1);
            if constexpr (GATHER) { if (last && has_next) {
#pragma unroll
                for (int i = 0; i < 2; ++i) { voffA[i] = ((unsigned)S.arow(nxt, RA[i]) * (unsigned)K + (unsigned)CA[i]) * 2u; voffA1[i] = ((unsigned)S.arow(nxt, HALF + RA[i]) * (unsigned)K + (unsigned)CA[i]) * 2u; } } }
            PG8_WAIT_V(8); PG8_WAIT_L(0); PG8_BAR; PG8_MMA(0, 0, At, B0); PG8_MMA(0, 1, At, B1); PG8_BAR; PG8_SCHED;
            PG8_LDA(At, 0, 1); PG8_STAGE(PG8_SB(0, 0), b2, voffB); PG8_STAGE(PG8_SB(0, 1), b2 + hstep, voffB); PG8_STAGE(PG8_SA(0, 0), a2, voffA);
            PG8_WAIT_V(8); PG8_WAIT_L(0); PG8_BAR; PG8_MMA(1, 0, At, B0); PG8_MMA(1, 1, At, B1); PG8_BAR; PG8_SCHED;
            PG8_LDB(B0, 1, 0); PG8_LDB(B1, 1, 1); PG8_SCHED; PG8_LDA(At, 1, 0); PG8_STAGE(PG8_SA(0, 1), a2 + hstepA, voffA1);
            PG8_WAIT_V(8); PG8_WAIT_L(0); PG8_BAR; PG8_MMA(0, 0, At, B0); PG8_MMA(0, 1, At, B1); PG8_BAR; PG8_SCHED;
            PG8_LDA(At, 1, 1); PG8_STAGE(PG8_SB(1, 0), b3, voffB); PG8_STAGE(PG8_SB(1, 1), b3 + hstep, voffB); PG8_STAGE(PG8_SA(1, 0), a3, voffA);
            PG8_WAIT_V(8); PG8_WAIT_L(0); PG8_BAR; PG8_MMA(1, 0, At, B0); PG8_MMA(1, 1, At, B1); PG8_BAR; PG8_SCHED;
        }
        if constexpr (ALIGN_EPI) { if (wr == 0) PG8_BAR; }
        E(acc, cur, wr, wc, fr, fq);
        if (!has_next) break;
#pragma unroll
        for (int a = 0; a < 2; ++a)
#pragma unroll
            for (int b = 0; b < 2; ++b)
#pragma unroll
                for (int m = 0; m < 4; ++m)
#pragma unroll
                    for (int n = 0; n < 2; ++n) acc[a][b][m][n] = (f32x4){0.f, 0.f, 0.f, 0.f};
        cur = nxt; cA = nA; cB = nB; ++ui;
        if constexpr (ALIGN_EPI) { if (wr == 1) PG8_BAR; }
    }
    PG8_WAIT_V(0);
    if constexpr (!ALIGN_EPI) { if (wr == 0) PG8_BAR; }
    PG8_BAR;
#undef PG8_SA
#undef PG8_SB
#undef PG8_STAGE
#undef PG8_LDA
#undef PG8_LDB
#undef PG8_MMA
#undef PG8_WAIT_V
#undef PG8_WAIT_L
#undef PG8_BAR
#undef PG8_SCHED
}
}
using pg8::Unit;
using pg8::cvt_pk_bf16;
constexpr int HALF = pg8::HALF, BM = pg8::BM;

struct SchedPlain : pg8::OrderBase {
    const char* A; const char* B; size_t tstep;
    __device__ __forceinline__ const char* abase(const Unit& u) const { return A + (size_t)u.pm * tstep; }
    __device__ __forceinline__ const char* bbase(const Unit& u) const { return B + (size_t)u.pn * tstep; }
    __device__ __forceinline__ int arow(const Unit&, int) const { return 0; }
};
struct SchedMoeUp : pg8::OrderBase {
    const char* A; const char* B; const int* tok;
    __device__ __forceinline__ const char* abase(const Unit&) const { return A; }
    __device__ __forceinline__ const char* bbase(const Unit& u) const { return B + ((size_t)(u.pm >> 4) * 2048 + (size_t)u.pn * 256) * (size_t)(DM * 2); }
    __device__ __forceinline__ int arow(const Unit& u, int r) const { const int e = u.pm >> 4, b = (u.pm >> 3) & 1, mt = u.pm & 7; return b * SEQ + tok[(b * NE + e) * CAP + mt * 256 + r]; }
};
struct SchedMoeDown : pg8::OrderBase {
    const char* A; const char* B;
    __device__ __forceinline__ const char* abase(const Unit& u) const { return A + (size_t)u.pm * 256 * (size_t)(DEXP * 2); }
    __device__ __forceinline__ const char* bbase(const Unit& u) const { return B + ((size_t)(u.pm >> 4) * 2048 + (size_t)u.pn * 256) * (size_t)(DEXP * 2); }
    __device__ __forceinline__ int arow(const Unit&, int) const { return 0; }
};

struct EpiInProj {
    static constexpr bool PERM = true;
    bf16* P; float* Z;
    __device__ __forceinline__ void operator()(const f32x4 (&acc)[2][2][4][2], const Unit& u, int wr, int wc, int fr, int fq) const {
        const int row0 = u.pm * BM + wr * 64 + fr;
        if (u.pn < 16) {
            const int col0 = u.pn * BM + wc * 32 + 8 * fq;
#pragma unroll
            for (int ai = 0; ai < 2; ++ai)
#pragma unroll
                for (int m = 0; m < 4; ++m) { bf16* rowp = P + (size_t)(row0 + ai * HALF + m * 16) * PW + col0;
#pragma unroll
                    for (int bj = 0; bj < 2; ++bj) { const f32x4 v0 = acc[ai][bj][m][0], v1 = acc[ai][bj][m][1];
                        u32x4 w; w.x = cvt_pk_bf16(v0[0], v0[1]); w.y = cvt_pk_bf16(v0[2], v0[3]); w.z = cvt_pk_bf16(v1[0], v1[1]); w.w = cvt_pk_bf16(v1[2], v1[3]);
                        *(u32x4*)(rowp + bj * HALF) = w; } }
        } else if (wc == 0) {
#pragma unroll
            for (int ai = 0; ai < 2; ++ai)
#pragma unroll
                for (int m = 0; m < 4; ++m) { float* rowp = Z + (size_t)(row0 + ai * HALF + m * 16) * 32 + 8 * fq;
                    *(f32x4*)(rowp) = acc[ai][0][m][0]; *(f32x4*)(rowp + 4) = acc[ai][0][m][1]; }
        }
    }
};
struct EpiOutProj {
    static constexpr bool PERM = false;
    const float* X; float* XL; const float* ada;
    __device__ __forceinline__ void operator()(const f32x4 (&acc)[2][2][4][2], const Unit& u, int wr, int wc, int fr, int fq) const {
        const int row0 = u.pm * BM + wr * 64 + fr, col0 = u.pn * BM + wc * 32 + 4 * fq;
        const int b = (u.pm * BM) / SEQ;
        const float* g1 = ada + (size_t)b * 12288 + 2 * DM;
        f32x4 gv[2][2];
#pragma unroll
        for (int bj = 0; bj < 2; ++bj)
#pragma unroll
            for (int n = 0; n < 2; ++n) gv[bj][n] = *(const f32x4*)(g1 + col0 + bj * HALF + n * 16);
#pragma unroll
        for (int ai = 0; ai < 2; ++ai)
#pragma unroll
            for (int m = 0; m < 4; ++m) { const size_t off = (size_t)(row0 + ai * HALF + m * 16) * DM + col0;
#pragma unroll
                for (int bj = 0; bj < 2; ++bj)
#pragma unroll
                    for (int n = 0; n < 2; ++n) { const f32x4 xv = *(const f32x4*)(X + off + bj * HALF + n * 16);
                        *(f32x4*)(XL + off + bj * HALF + n * 16) = xv + gv[bj][n] * acc[ai][bj][m][n]; }
                asm volatile("" ::: "memory"); }
    }
};
struct EpiSwiglu {
    static constexpr bool PERM = true;
    bf16* HID;
    __device__ __forceinline__ void operator()(const f32x4 (&acc)[2][2][4][2], const Unit& u, int wr, int wc, int fr, int fq) const {
        const int row0 = u.pm * BM + wr * 64 + fr, col0 = u.pn * 128 + wc * 32 + 8 * fq;
#pragma unroll
        for (int ai = 0; ai < 2; ++ai)
#pragma unroll
            for (int m = 0; m < 4; ++m) { bf16* rowp = HID + (size_t)(row0 + ai * HALF + m * 16) * DEXP + col0;
                f32x4 h0, h1;
#pragma unroll
                for (int j = 0; j < 4; ++j) { h0[j] = silu_f(acc[ai][0][m][0][j]) * acc[ai][1][m][0][j]; h1[j] = silu_f(acc[ai][0][m][1][j]) * acc[ai][1][m][1][j]; }
                u32x4 w; w.x = cvt_pk_bf16(h0[0], h0[1]); w.y = cvt_pk_bf16(h0[2], h0[3]); w.z = cvt_pk_bf16(h1[0], h1[1]); w.w = cvt_pk_bf16(h1[2], h1[3]);
                *(u32x4*)(rowp) = w; }
    }
};
struct EpiBf16 {
    static constexpr bool PERM = true;
    bf16* O; int ldc;
    __device__ __forceinline__ void operator()(const f32x4 (&acc)[2][2][4][2], const Unit& u, int wr, int wc, int fr, int fq) const {
        const int row0 = u.pm * BM + wr * 64 + fr, col0 = u.pn * BM + wc * 32 + 8 * fq;
#pragma unroll
        for (int ai = 0; ai < 2; ++ai)
#pragma unroll
            for (int m = 0; m < 4; ++m) { bf16* rowp = O + (size_t)(row0 + ai * HALF + m * 16) * ldc + col0;
#pragma unroll
                for (int bj = 0; bj < 2; ++bj) { const f32x4 v0 = acc[ai][bj][m][0], v1 = acc[ai][bj][m][1];
                    u32x4 w; w.x = cvt_pk_bf16(v0[0], v0[1]); w.y = cvt_pk_bf16(v0[2], v0[3]); w.z = cvt_pk_bf16(v1[0], v1[1]); w.w = cvt_pk_bf16(v1[2], v1[3]);
                    *(u32x4*)(rowp + bj * HALF) = w; } }
    }
};

__device__ __forceinline__ void transpose_item(const float* src, int ldsrc, int scol0, int k0, bf16* dst, size_t drow0, int ldd, LAS float* scr, int lane) {
#pragma unroll 8
    for (int i = 0; i < 32; ++i) { const int kk = 2 * i + (lane >> 5); scr[kk * 33 + (lane & 31)] = src[(size_t)(k0 + kk) * ldsrc + scol0 + (lane & 31)]; }
    asm volatile("s_waitcnt lgkmcnt(0)" ::: "memory");
    const int c = lane & 7;
#pragma unroll
    for (int j = 0; j < 4; ++j) { const int n = (lane >> 3) + 8 * j; const LAS float* s = scr + (8 * c) * 33 + n;
        u32x4 o; o.x = pk2(s[0 * 33], s[1 * 33]); o.y = pk2(s[2 * 33], s[3 * 33]); o.z = pk2(s[4 * 33], s[5 * 33]); o.w = pk2(s[6 * 33], s[7 * 33]);
        *(u32x4*)(dst + (drow0 + n) * (size_t)ldd + k0 + 8 * c) = o; }
    asm volatile("s_waitcnt lgkmcnt(0)" ::: "memory");
}

__device__ __forceinline__ void phase0(const Args& a, LAS unsigned char* lds) {
    const int tid = threadIdx.x, lane = tid & 63, wave = tid >> 6, G = gridDim.x, blk = blockIdx.x;
    unsigned char* ws = a.ws;
    {
        const float* c = a.in[1]; const float* cc = a.in[3]; const float* w_ada = a.in[4]; const float* b_ada = a.in[5];
        float* ada = (float*)(ws + WS_ADA);
        LAS float* red = (LAS float*)lds;
        for (int it = blk; it < 96; it += G) {
            const int col0 = it * 128 + 2 * lane;
            float a0x = 0, a0y = 0, a1x = 0, a1y = 0, a2x = 0, a2y = 0;
            const int r0 = wave * 256;
#pragma unroll 8
            for (int r = r0; r < r0 + 256; ++r) {
                const f32x2 w = *(const f32x2*)(w_ada + (size_t)r * 12288 + col0);
                const float s0 = silu_f(c[r]), s1 = silu_f(c[DM + r]), s2 = silu_f(cc[r]);
                a0x += s0 * w.x; a0y += s0 * w.y; a1x += s1 * w.x; a1y += s1 * w.y; a2x += s2 * w.x; a2y += s2 * w.y;
            }
            red[(wave * 3 + 0) * 128 + 2 * lane] = a0x; red[(wave * 3 + 0) * 128 + 2 * lane + 1] = a0y;
            red[(wave * 3 + 1) * 128 + 2 * lane] = a1x; red[(wave * 3 + 1) * 128 + 2 * lane + 1] = a1y;
            red[(wave * 3 + 2) * 128 + 2 * lane] = a2x; red[(wave * 3 + 2) * 128 + 2 * lane + 1] = a2y;
            __syncthreads();
            if (tid < 384) { const int v = tid >> 7, col = tid & 127; float s = b_ada[it * 128 + col];
                for (int w8 = 0; w8 < 8; ++w8) s += red[(w8 * 3 + v) * 128 + col];
                ada[v * 12288 + it * 128 + col] = s; }
            __syncthreads();
        }
    }
    LAS float* scr = (LAS float*)(lds + wave * 16384);
    const int gw = blk * 8 + wave, NGW = G * 8;
    constexpr int I_WIN = 32 * 129, I_ZERO = 224, I_WOUT = 32 * 64, I_WG = 16 * 32 * 32, I_WU = I_WG, I_WD = 16 * 16 * 64, I_TW = 256, I_FT = 256;
    constexpr int I_TOTAL = I_WIN + I_ZERO + I_WOUT + I_WG + I_WU + I_WD + I_TW + I_FT;
    bf16* Win = (bf16*)(ws + WS_WIN); bf16* Wout = (bf16*)(ws + WS_WOUT); bf16* Wgu = (bf16*)(ws + WS_WGU); bf16* Wd = (bf16*)(ws + WS_WD);
    for (int it = gw; it < I_TOTAL; it += NGW) {
        int r = it;
        if (r < I_WIN) { const int kb = r / 129, nb = r % 129, n0 = nb * 32;
            const size_t drow = n0 < 3072 ? (size_t)n0 : (n0 < 3104 ? (size_t)(4096 + n0 - 3072) : (size_t)(3072 + n0 - 3104));
            transpose_item(a.in[7], PROJW, n0, kb * 64, Win, drow, DM, scr, lane); continue; }
        r -= I_WIN;
        if (r < I_ZERO) { u32x4 z = {0u, 0u, 0u, 0u}; u32x4* p = (u32x4*)(Win + (size_t)(4128 + r) * DM);
#pragma unroll
            for (int j = 0; j < 4; ++j) p[lane + 64 * j] = z; continue; }
        r -= I_ZERO;
        if (r < I_WOUT) { const int kb = r / 64, nb = r % 64; transpose_item(a.in[13], DM, nb * 32, kb * 64, Wout, (size_t)nb * 32, DM, scr, lane); continue; }
        r -= I_WOUT;
        if (r < I_WG + I_WU) { const int up = r >= I_WG; if (up) r -= I_WG; const int e = r / 1024, rr = r % 1024, kb = rr / 32, nb = rr % 32, n0 = nb * 32;
            const float* src = (up ? a.in[17] : a.in[16]) + (size_t)e * DM * DEXP;
            const size_t drow = (size_t)e * 2048 + (size_t)(n0 >> 7) * 256 + (n0 & 127) + (up ? 128 : 0);
            transpose_item(src, DEXP, n0, kb * 64, Wgu, drow, DM, scr, lane); continue; }
        r -= I_WG + I_WU;
        if (r < I_WD) { const int e = r / 1024, rr = r % 1024, kb = rr / 64, nb = rr % 64;
            transpose_item(a.in[18] + (size_t)e * DEXP * DM, DM, nb * 32, kb * 64, Wd, (size_t)e * 2048 + nb * 32, DEXP, scr, lane); continue; }
        r -= I_WD;
        if (r < I_TW) { const int p = r * 64 + lane; float s, c; sincospif((float)p * (1.0f / 8192.0f), &s, &c); ((f32x2*)(ws + WS_TW))[p] = (f32x2){c, s}; continue; }
        r -= I_TW;
        { const int p = r * 64 + lane, k = p >> 7, l = p & 127; float s, c; sincospif((float)((k * l) & 127) * (1.0f / 64.0f), &s, &c); ((bf16*)(ws + WS_FC))[p] = (bf16)f2bf(c); ((bf16*)(ws + WS_FS))[p] = (bf16)f2bf(s); }
    }
}

__device__ __forceinline__ void phase1(const Args& a) {
    const int tid = threadIdx.x, lane = tid & 63, wave = tid >> 6, G = gridDim.x;
    const int gw = blockIdx.x * 8 + wave, NGW = G * 8;
    const float* ada = (const float*)(a.ws + WS_ADA); const float* g1n = a.in[6];
    bf16* H = (bf16*)(a.ws + WS_H);
    for (int r = gw; r < NROWS; r += NGW) {
        const float* xr; int v;
        if (r < NLAT) { xr = a.in[0] + (size_t)r * DM; v = r / SEQ; } else { xr = a.in[2] + (size_t)(r - NLAT) * DM; v = 2; }
        const float* sh = ada + (size_t)v * 12288; const float* sc = sh + DM;
        f32x4 x[8]; float ss = 0.f;
#pragma unroll
        for (int j = 0; j < 8; ++j) { x[j] = *(const f32x4*)(xr + 256 * j + 4 * lane); ss += (x[j].x * x[j].x + x[j].y * x[j].y) + (x[j].z * x[j].z + x[j].w * x[j].w); }
        const float rstd = rsqrtf(wave_sum(ss) * (1.f / DM) + EPS);
        u32x2* o = (u32x2*)(H + (size_t)r * DM);
#pragma unroll
        for (int j = 0; j < 8; ++j) { const int d = 256 * j + 4 * lane; const f32x4 g = *(const f32x4*)(g1n + d), s1 = *(const f32x4*)(sc + d), s0 = *(const f32x4*)(sh + d);
            const f32x4 hh = (x[j] * rstd * g) * (s1 + 1.f) + s0;
            u32x2 w; w.x = pk2(hh.x, hh.y); w.y = pk2(hh.z, hh.w); o[64 * j + lane] = w; }
    }
}

__device__ __forceinline__ void gla_scan(const Args& a, LAS unsigned char* lds, int item, bool is_ctx) {
    const int tid = threadIdx.x, lane = tid & 63, wave = tid >> 6;
    const int b = item >> 3, h = (item >> 1) & 3, dir = item & 1;
    const bf16* P = (const bf16*)(a.ws + WS_P); const float* Z = (const float*)(a.ws + WS_Z);
    const float* w_a2 = dir ? a.in[10] : a.in[8]; const float* b_a2 = dir ? a.in[11] : a.in[9];
    float* st0 = (float*)(a.ws + WS_ST0) + (size_t)((b * 2 + dir) * 4 + h) * 128 * 256;
    float* O = (float*)(a.ws + (dir ? WS_OB : WS_OF));
    LAS float* sA = (LAS float*)lds;
    LAS float* sQ = sA + 32 * 128;
    LAS float* sK = sQ + 32 * 128;
    LAS float* sV = sK + 32 * 128;
    const int vcol = wave * 32 + (lane & 31), dh = lane >> 5;
    const int ntok = is_ctx ? CTXL : SEQ;
    const size_t rowbase = is_ctx ? (size_t)(NLAT + b * CTXL) : (size_t)b * SEQ;
    float S[64];
#pragma unroll
    for (int d = 0; d < 64; ++d) S[d] = is_ctx ? 0.f : st0[(size_t)(dh * 64 + d) * 256 + vcol];
    const float qscale = 0.08838834764831845f;
    for (int c0 = 0; c0 < ntok; c0 += 32) {
        for (int e = tid; e < 32 * 128; e += NTHREADS) { const int i = e >> 7, d = e & 127; const int t = dir ? (ntok - 1 - (c0 + i)) : (c0 + i); const size_t row = rowbase + t;
            const float* zr = Z + row * 32 + dir * 16; float pre = b_a2[h * 128 + d];
#pragma unroll
            for (int r = 0; r < 16; ++r) pre += zr[r] * w_a2[r * 512 + h * 128 + d];
            sA[e] = expf(logsigmoid_f(pre) * (1.f / 16.f));
            sQ[e] = bf2f(P[row * PW + h * 128 + d]) * qscale;
            sK[e] = bf2f(P[row * PW + 512 + h * 128 + d]); }
        for (int e = tid; e < 32 * 256; e += NTHREADS) { const int i = e >> 8, v = e & 255; const int t = dir ? (ntok - 1 - (c0 + i)) : (c0 + i); const size_t row = rowbase + t;
            sV[e] = bf2f(P[row * PW + 1024 + h * 256 + v]); }
        __syncthreads();
        for (int i = 0; i < 32; ++i) {
            const float vv = sV[i * 256 + vcol]; float o = 0.f;
            const LAS f32x4* pa = (const LAS f32x4*)(sA + i * 128 + dh * 64); const LAS f32x4* pq = (const LAS f32x4*)(sQ + i * 128 + dh * 64); const LAS f32x4* pk = (const LAS f32x4*)(sK + i * 128 + dh * 64);
#pragma unroll
            for (int d4 = 0; d4 < 16; ++d4) { const f32x4 av = pa[d4], qv = pq[d4], kv = pk[d4];
#pragma unroll
                for (int j = 0; j < 4; ++j) { S[d4 * 4 + j] = av[j] * S[d4 * 4 + j] + kv[j] * vv; o += qv[j] * S[d4 * 4 + j]; } }
            o += __shfl_xor(o, 32);
            if (!is_ctx && dh == 0) { const int t = dir ? (ntok - 1 - (c0 + i)) : (c0 + i); O[(rowbase + t) * 1024 + h * 256 + vcol] = o; }
        }
        __syncthreads();
    }
    if (is_ctx) {
#pragma unroll
        for (int d = 0; d < 64; ++d) st0[(size_t)(dh * 64 + d) * 256 + vcol] = S[d];
    }
}

__device__ __forceinline__ void phase_gla_merge(const Args& a) {
    const int tid = threadIdx.x, lane = tid & 63, wave = tid >> 6;
    const int gw = blockIdx.x * 8 + wave, NGW = gridDim.x * 8;
    const float* OF = (const float*)(a.ws + WS_OF); const float* OB = (const float*)(a.ws + WS_OB);
    const bf16* P = (const bf16*)(a.ws + WS_P); bf16* Y = (bf16*)(a.ws + WS_YCAT); const float* gg = a.in[12];
    for (int r = gw; r < NLAT; r += NGW) {
#pragma unroll
        for (int j = 0; j < 4; ++j) {
            const int col = 256 * j + 4 * lane;
            const f32x4 o = *(const f32x4*)(OF + (size_t)r * 1024 + col) + *(const f32x4*)(OB + (size_t)r * 1024 + col);
            const float ss = wave_sum((o.x * o.x + o.y * o.y) + (o.z * o.z + o.w * o.w));
            const float rstd = rsqrtf(ss * (1.f / 256.f) + EPS);
            const u32x2 gw2 = *(const u32x2*)(P + (size_t)r * PW + 2048 + col);
            const f32x4 gn = *(const f32x4*)(gg + col);
            const float g0 = __uint_as_float(gw2.x << 16), g1 = __uint_as_float(gw2.x & 0xffff0000u), g2 = __uint_as_float(gw2.y << 16), g3 = __uint_as_float(gw2.y & 0xffff0000u);
            u32x2 w; w.x = pk2(o.x * rstd * gn.x * silu_f(g0), o.y * rstd * gn.y * silu_f(g1)); w.y = pk2(o.z * rstd * gn.z * silu_f(g2), o.w * rstd * gn.w * silu_f(g3));
            *(u32x2*)(Y + (size_t)r * DM + col) = w;
        }
    }
}

constexpr int FLD = 136;
#define MFMA16(a, b, c) __builtin_amdgcn_mfma_f32_16x16x32_bf16((a), (b), (c), 0, 0, 0)
__device__ __forceinline__ void load_dft_frags(const unsigned char* ws, int wave, int lane, bf16x8 (&fc)[4], bf16x8 (&fs)[4]) {
    const bf16* FC = (const bf16*)(ws + WS_FC); const bf16* FS = (const bf16*)(ws + WS_FS);
    const int k = 16 * wave + (lane & 15);
#pragma unroll
    for (int ks = 0; ks < 4; ++ks) { fc[ks] = *(const bf16x8*)(FC + k * 128 + ks * 32 + 8 * (lane >> 4)); fs[ks] = *(const bf16x8*)(FS + k * 128 + ks * 32 + 8 * (lane >> 4)); }
}
__device__ __forceinline__ void store_t4x8(LAS bf16* XT, int c0, int l0, const u32x4 (&x)[4]) {
#pragma unroll
    for (int i2 = 0; i2 < 4; ++i2) {
        const unsigned a0 = x[0][i2], a1 = x[1][i2], a2 = x[2][i2], a3 = x[3][i2];
        u32x2 lo, hi; lo.x = (a0 & 0xffffu) | (a1 << 16); lo.y = (a2 & 0xffffu) | (a3 << 16); hi.x = (a0 >> 16) | (a1 & 0xffff0000u); hi.y = (a2 >> 16) | (a3 & 0xffff0000u);
        *(LAS u32x2*)(XT + (c0 + 2 * i2) * FLD + l0) = lo; *(LAS u32x2*)(XT + (c0 + 2 * i2 + 1) * FLD + l0) = hi; }
}
__device__ __forceinline__ void phase_f1(const Args& a, LAS unsigned char* lds) {
    const int tid = threadIdx.x, lane = tid & 63, wave = __builtin_amdgcn_readfirstlane(tid >> 6), q = lane >> 4, cidx = lane & 15;
    const bf16* P = (const bf16*)(a.ws + WS_P); const f32x2* TW = (const f32x2*)(a.ws + WS_TW);
    bf16* A1r = (bf16*)(a.ws + WS_FA); bf16* A1i = (bf16*)(a.ws + WS_FAI);
    LAS bf16* XT = (LAS bf16*)lds;
    bf16x8 fc[4], fs[4]; load_dft_frags(a.ws, wave, lane, fc, fs);
    const int k1 = 16 * wave + cidx;
    for (int item = blockIdx.x; item < 1024; item += gridDim.x) {
        const int cb = item & 3, l2 = (item >> 2) & 127, b = item >> 9, ch0 = cb * 256;
#pragma unroll
        for (int j = 0; j < 2; ++j) { const int task = tid + 512 * j, cblk = task & 31, lb = task >> 5; u32x4 x[4];
#pragma unroll
            for (int r = 0; r < 4; ++r) x[r] = *(const u32x4*)(P + ((size_t)b * SEQ + 128 * (4 * lb + r) + l2) * PW + 3072 + ch0 + 8 * cblk);
            store_t4x8(XT, 8 * cblk, 4 * lb, x); }
        __syncthreads();
        const f32x2 tw = TW[l2 * k1];
        bf16* or_ = A1r + (((size_t)b * 128 + k1) * 128 + l2) * 1024 + ch0 + 4 * q; bf16* oi_ = A1i + (((size_t)b * 128 + k1) * 128 + l2) * 1024 + ch0 + 4 * q;
#pragma unroll 2
        for (int mt = 0; mt < 16; ++mt) {
            f32x4 cr = {0.f, 0.f, 0.f, 0.f}, cs = {0.f, 0.f, 0.f, 0.f};
#pragma unroll
            for (int ks = 0; ks < 4; ++ks) { const bf16x8 xa = *(const LAS bf16x8*)(XT + (16 * mt + cidx) * FLD + ks * 32 + 8 * q); cr = MFMA16(xa, fc[ks], cr); cs = MFMA16(xa, fs[ks], cs); }
            const f32x4 br = cr * tw.x - cs * tw.y, bi = -(cs * tw.x + cr * tw.y);
            u32x2 wr_; wr_.x = pk2(br[0], br[1]); wr_.y = pk2(br[2], br[3]); u32x2 wi_; wi_.x = pk2(bi[0], bi[1]); wi_.y = pk2(bi[2], bi[3]);
            *(u32x2*)(or_ + 16 * mt) = wr_; *(u32x2*)(oi_ + 16 * mt) = wi_;
        }
        __syncthreads();
    }
}
__device__ __forceinline__ void phase_f34(const Args& a, LAS unsigned char* lds) {
    const int tid = threadIdx.x, lane = tid & 63, wave = __builtin_amdgcn_readfirstlane(tid >> 6), q = lane >> 4, cidx = lane & 15;
    const bf16* A1r = (const bf16*)(a.ws + WS_FA); const bf16* A1i = (const bf16*)(a.ws + WS_FAI); bf16* Y = (bf16*)(a.ws + WS_YCAT);
    LAS bf16* XTr = (LAS bf16*)lds; LAS bf16* XTi = XTr + 128 * FLD; LAS bf16* XKr = XTi + 128 * FLD; LAS bf16* XKi = XKr + 128 * FLD;
    bf16x8 fc[4], fs[4]; load_dft_frags(a.ws, wave, lane, fc, fs);
    const float nrm = 1.0f / 1448.15468787005f;
    for (int item = blockIdx.x; item < 2048; item += gridDim.x) {
        const int g = item & 7, k1 = (item >> 3) & 127, b = item >> 10, ch0 = g * 128;
        { const int cblk = tid & 15, lb = tid >> 4; u32x4 xr[4], xi[4];
#pragma unroll
            for (int r = 0; r < 4; ++r) { const size_t off = (((size_t)b * 128 + k1) * 128 + 4 * lb + r) * 1024 + ch0 + 8 * cblk; xr[r] = *(const u32x4*)(A1r + off); xi[r] = *(const u32x4*)(A1i + off); }
            store_t4x8(XTr, 8 * cblk, 4 * lb, xr); store_t4x8(XTi, 8 * cblk, 4 * lb, xi); }
        __syncthreads();
        const int k2 = 16 * wave + cidx;
#pragma unroll 2
        for (int mt = 0; mt < 8; ++mt) {
            f32x4 a1 = {0.f, 0.f, 0.f, 0.f}, a2 = a1, b1 = a1, b2 = a1;
#pragma unroll
            for (int ks = 0; ks < 4; ++ks) { const bf16x8 xa = *(const LAS bf16x8*)(XTr + (16 * mt + cidx) * FLD + ks * 32 + 8 * q); const bf16x8 xb = *(const LAS bf16x8*)(XTi + (16 * mt + cidx) * FLD + ks * 32 + 8 * q);
                a1 = MFMA16(xa, fc[ks], a1); b2 = MFMA16(xa, fs[ks], b2); a2 = MFMA16(xb, fs[ks], a2); b1 = MFMA16(xb, fc[ks], b1); }
            const f32x4 xre = a1 + a2, xim = b1 - b2;
            u32x2 wr_; wr_.x = pk2(xre[0], xre[1]); wr_.y = pk2(xre[2], xre[3]); u32x2 wi_; wi_.x = pk2(xim[0], xim[1]); wi_.y = pk2(xim[2], xim[3]);
            *(LAS u32x2*)(XKr + k2 * FLD + 16 * mt + 4 * q) = wr_; *(LAS u32x2*)(XKi + k2 * FLD + 16 * mt + 4 * q) = wi_;
        }
        __syncthreads();
#pragma unroll 2
        for (int nt = 0; nt < 8; ++nt) {
            f32x4 y = {0.f, 0.f, 0.f, 0.f};
#pragma unroll
            for (int ks = 0; ks < 4; ++ks) { const bf16x8 xa = *(const LAS bf16x8*)(XKr + (16 * nt + cidx) * FLD + ks * 32 + 8 * q); const bf16x8 xb = *(const LAS bf16x8*)(XKi + (16 * nt + cidx) * FLD + ks * 32 + 8 * q);
                y = MFMA16(fc[ks], xa, y); y = MFMA16(fs[ks], xb, y); }
            const int lp = k1 + 128 * (16 * nt + cidx);
            u32x2 w; w.x = pk2(y[0] * nrm, y[1] * nrm); w.y = pk2(y[2] * nrm, y[3] * nrm);
            *(u32x2*)(Y + ((size_t)b * SEQ + lp) * DM + 1024 + ch0 + 16 * wave + 4 * q) = w;
        }
        __syncthreads();
    }
}

__device__ __forceinline__ void phase_norm2(const Args& a) {
    const int tid = threadIdx.x, lane = tid & 63, wave = tid >> 6;
    const int gw = blockIdx.x * 8 + wave, NGW = gridDim.x * 8;
    const float* ada = (const float*)(a.ws + WS_ADA); const float* g2n = a.in[14]; const float* wr = a.in[15];
    const float* XL = (const float*)(a.ws + WS_XL); bf16* HF = (bf16*)(a.ws + WS_HF); float* AFF = (float*)(a.ws + WS_AFF);
    for (int r = gw; r < NLAT; r += NGW) {
        const int b = r / SEQ, t = r % SEQ;
        const float* sh = ada + (size_t)b * 12288 + 3 * DM; const float* sc = sh + DM;
        const float* xr = XL + (size_t)r * DM;
        f32x4 x[8]; float ss = 0.f;
#pragma unroll
        for (int j = 0; j < 8; ++j) { x[j] = *(const f32x4*)(xr + 256 * j + 4 * lane); ss += (x[j].x * x[j].x + x[j].y * x[j].y) + (x[j].z * x[j].z + x[j].w * x[j].w); }
        const float rstd = rsqrtf(wave_sum(ss) * (1.f / DM) + EPS);
        float p[16];
#pragma unroll
        for (int e = 0; e < 16; ++e) p[e] = 0.f;
        u32x2* o = (u32x2*)(HF + (size_t)r * DM);
#pragma unroll
        for (int j = 0; j < 8; ++j) { const int d = 256 * j + 4 * lane; const f32x4 g = *(const f32x4*)(g2n + d), s1 = *(const f32x4*)(sc + d), s0 = *(const f32x4*)(sh + d);
            const f32x4 hh = (x[j] * rstd * g) * (s1 + 1.f) + s0;
            u32x2 w; w.x = pk2(hh.x, hh.y); w.y = pk2(hh.z, hh.w); o[64 * j + lane] = w;
#pragma unroll
            for (int jj = 0; jj < 4; ++jj) { const float hv = hh[jj]; const f32x4* wp = (const f32x4*)(wr + (size_t)(d + jj) * 16);
#pragma unroll
                for (int q = 0; q < 4; ++q) { const f32x4 wv = wp[q]; p[q * 4 + 0] += hv * wv.x; p[q * 4 + 1] += hv * wv.y; p[q * 4 + 2] += hv * wv.z; p[q * 4 + 3] += hv * wv.w; } } }
        float mx = -1e30f;
#pragma unroll
        for (int e = 0; e < 16; ++e) { p[e] = wave_sum(p[e]); mx = fmaxf(mx, p[e]); }
        float sum = 0.f;
#pragma unroll
        for (int e = 0; e < 16; ++e) { p[e] = expf(p[e] - mx); sum += p[e]; }
        float mine = 0.f;
#pragma unroll
        for (int e = 0; e < 16; ++e) mine = (lane == e) ? p[e] : mine;
        if (lane < 16) AFF[((size_t)b * NE + lane) * SEQ + t] = mine / sum;
    }
}

__device__ __forceinline__ void phase_topk(const Args& a, LAS unsigned char* lds) {
    const int tid = threadIdx.x;
    LAS unsigned* keys = (LAS unsigned*)lds;
    LAS unsigned* hist = (LAS unsigned*)(lds + 65536);
    LAS unsigned* misc = hist + 256;
    LAS unsigned* sg = misc + 16;
    LAS unsigned* se = sg + 512;
    const float* AFF = (const float*)(a.ws + WS_AFF); int* TOK = (int*)(a.ws + WS_TOK); float* GATE = (float*)(a.ws + WS_GATE); int* SEL = (int*)(a.ws + WS_SEL);
    for (int be = blockIdx.x; be < NB * NE; be += gridDim.x) {
        const int b = be / NE, e = be % NE;
        for (int i = tid; i < SEQ; i += NTHREADS) keys[i] = __float_as_uint(AFF[(size_t)be * SEQ + i]);
        unsigned prefix = 0u, pmask = 0u, krem = CAP;
        for (int pass = 0; pass < 4; ++pass) {
            const int shift = 24 - 8 * pass;
            if (tid < 256) hist[tid] = 0u;
            __syncthreads();
            for (int i = tid; i < SEQ; i += NTHREADS) { const unsigned k = keys[i]; if ((k & pmask) == prefix) atomicAdd((unsigned*)&hist[(k >> shift) & 255u], 1u); }
            __syncthreads();
            if (tid == 0) { unsigned cum = 0u; int bsel = 0;
                for (int bk = 255; bk >= 0; --bk) { const unsigned c = hist[bk]; if (cum + c >= krem) { bsel = bk; break; } cum += c; }
                misc[0] = prefix | ((unsigned)bsel << shift); misc[1] = krem - cum; }
            __syncthreads();
            prefix = misc[0]; krem = misc[1]; pmask |= (0xffu << shift);
            __syncthreads();
        }
        const unsigned T = prefix;
        unsigned cg_ = 0u, ce = 0u;
        for (int i = 0; i < 32; ++i) { const unsigned k = keys[tid * 32 + i]; cg_ += (k > T); ce += (k == T); }
        sg[tid] = cg_; se[tid] = ce;
        __syncthreads();
        if (tid == 0) { unsigned rg = 0u, re = 0u; for (int i = 0; i < NTHREADS; ++i) { const unsigned x = sg[i], y = se[i]; sg[i] = rg; se[i] = re; rg += x; re += y; } }
        __syncthreads();
        unsigned gt_before = sg[tid], eq_before = se[tid];
        for (int i = 0; i < 32; ++i) { const int t = tid * 32 + i; const unsigned k = keys[t];
            const bool isgt = k > T, iseq = k == T; const bool take = isgt || (iseq && eq_before < krem);
            const unsigned slot = gt_before + (eq_before < krem ? eq_before : krem);
            if (take) { TOK[(size_t)be * CAP + slot] = t; GATE[(size_t)be * CAP + slot] = __uint_as_float(k); }
            SEL[((size_t)b * SEQ + t) * NE + e] = take ? (int)slot : -1;
            gt_before += isgt; eq_before += iseq; }
        __syncthreads();
    }
}

__device__ __forceinline__ void phase_final(const Args& a) {
    const int tid = threadIdx.x, lane = tid & 63, wave = tid >> 6;
    const int gw = blockIdx.x * 8 + wave, NGW = gridDim.x * 8;
    const float* ada = (const float*)(a.ws + WS_ADA); const float* fg = a.in[19];
    const float* XL = (const float*)(a.ws + WS_XL); const bf16* YE = (const bf16*)(a.ws + WS_YE);
    const float* GATE = (const float*)(a.ws + WS_GATE); const int* SEL = (const int*)(a.ws + WS_SEL);
    for (int r = gw; r < NLAT; r += NGW) {
        const int b = r / SEQ;
        const float* g2 = ada + (size_t)b * 12288 + 5 * DM;
        f32x4 m[8];
#pragma unroll
        for (int j = 0; j < 8; ++j) m[j] = (f32x4){0.f, 0.f, 0.f, 0.f};
        for (int e = 0; e < NE; ++e) { const int s = SEL[(size_t)r * NE + e];
            if (s >= 0) { const float gt = GATE[((size_t)b * NE + e) * CAP + s]; const bf16* yr = YE + ((size_t)(e * 2 + b) * CAP + s) * DM;
#pragma unroll
                for (int j = 0; j < 8; ++j) { const u32x2 w = *(const u32x2*)(yr + 256 * j + 4 * lane);
                    m[j].x += gt * __uint_as_float(w.x << 16); m[j].y += gt * __uint_as_float(w.x & 0xffff0000u); m[j].z += gt * __uint_as_float(w.y << 16); m[j].w += gt * __uint_as_float(w.y & 0xffff0000u); } } }
        float ss = 0.f;
#pragma unroll
        for (int j = 0; j < 8; ++j) { const int d = 256 * j + 4 * lane; const f32x4 xv = *(const f32x4*)(XL + (size_t)r * DM + d), gv = *(const f32x4*)(g2 + d);
            m[j] = xv + gv * m[j]; ss += (m[j].x * m[j].x + m[j].y * m[j].y) + (m[j].z * m[j].z + m[j].w * m[j].w); }
        const float rstd = rsqrtf(wave_sum(ss) * (1.f / DM) + EPS);
#pragma unroll
        for (int j = 0; j < 8; ++j) { const int d = 256 * j + 4 * lane; const f32x4 gv = *(const f32x4*)(fg + d);
            *(f32x4*)(a.out + (size_t)r * DM + d) = m[j] * rstd * gv; }
    }
}

constexpr int NPHASES = 15;
__global__ void __launch_bounds__(NTHREADS, 2) mega(Args a) {
    extern __shared__ __attribute__((aligned(16))) unsigned char lds_raw[];
    LAS unsigned char* lds = (LAS unsigned char*)lds_raw;
    cg::grid_group grid = cg::this_grid();
    const int lo = a.ph_lo, hi = a.ph_hi;
    unsigned char* ws = a.ws;
#define IN(k) (lo <= (k) && (k) < hi)
#define SEAM(k) do { if (IN(k) && IN((k) + 1)) grid.sync(); } while (0)
    if (IN(0)) phase0(a, lds);
    SEAM(0);
    if (IN(1)) phase1(a);
    SEAM(1);
    if (IN(2)) {
        SchedPlain S; S.init(NROWS / 256, WIN_ROWS / 256, gridDim.x, blockIdx.x); S.A = (const char*)(ws + WS_H); S.B = (const char*)(ws + WS_WIN); S.tstep = (size_t)256 * DM * 2;
        EpiInProj E{(bf16*)(ws + WS_P), (float*)(ws + WS_Z)};
        pg8::gemm_phase<EpiInProj, SchedPlain, false, true, true>(lds, DM, S, E);
    }
    SEAM(2);
    if (IN(3)) { for (int it = blockIdx.x; it < 16; it += gridDim.x) gla_scan(a, lds, it, true); }
    SEAM(3);
    if (IN(4)) { for (int it = blockIdx.x; it < 16; it += gridDim.x) gla_scan(a, lds, it, false); }
    SEAM(4);
    if (IN(5)) phase_gla_merge(a);
    SEAM(5);
    if (IN(6)) phase_f1(a, lds);
    SEAM(6);
    if (IN(7)) phase_f34(a, lds);
    SEAM(7);
    SEAM(8);
    if (IN(9)) {
        SchedPlain S; S.init(NLAT / 256, DM / 256, gridDim.x, blockIdx.x); S.A = (const char*)(ws + WS_YCAT); S.B = (const char*)(ws + WS_WOUT); S.tstep = (size_t)256 * DM * 2;
        EpiOutProj E{a.in[0], (float*)(ws + WS_XL), (const float*)(ws + WS_ADA)};
        pg8::gemm_phase<EpiOutProj, SchedPlain, false, true, true>(lds, DM, S, E);
    }
    SEAM(9);
    if (IN(10)) phase_norm2(a);
    SEAM(10);
    if (IN(11)) phase_topk(a, lds);
    SEAM(11);
    if (IN(12)) {
        SchedMoeUp S; S.init(256, 8, gridDim.x, blockIdx.x); S.A = (const char*)(ws + WS_HF); S.B = (const char*)(ws + WS_WGU); S.tok = (const int*)(ws + WS_TOK);
        EpiSwiglu E{(bf16*)(ws + WS_HID)};
        pg8::gemm_phase<EpiSwiglu, SchedMoeUp, true, true, true>(lds, DM, S, E);
    }
    SEAM(12);
    if (IN(13)) {
        SchedMoeDown S; S.init(256, 8, gridDim.x, blockIdx.x); S.A = (const char*)(ws + WS_HID); S.B = (const char*)(ws + WS_WD);
        EpiBf16 E{(bf16*)(ws + WS_YE), DM};
        pg8::gemm_phase<EpiBf16, SchedMoeDown, false, true, true>(lds, DEXP, S, E);
    }
    SEAM(13);
    if (IN(14)) phase_final(a);
#undef IN
#undef SEAM
}

#ifndef N_LAUNCH_MODE
#define N_LAUNCH_MODE 1
#endif
extern "C" void kernel_launch(void* const* d_in, const int* in_sizes, int n_in, void* d_out, int out_size, void* d_ws, size_t ws_size, hipStream_t stream) {
    static int grid = 0;
    if (grid == 0) {
        if (n_in != 20 || out_size != NLAT * DM || ws_size < WS_END) { fprintf(stderr, "kernel_launch: unexpected sizes n_in %d out %d ws %zu\n", n_in, out_size, ws_size); grid = -1; return; }
        int dev = 0, cus = 0, per_cu = 0;
        (void)hipGetDevice(&dev); (void)hipDeviceGetAttribute(&cus, hipDeviceAttributeMultiprocessorCount, dev);
        if (hipFuncSetAttribute((const void*)mega, hipFuncAttributeMaxDynamicSharedMemorySize, LDS_BYTES) != hipSuccess) { fprintf(stderr, "kernel_launch: hipFuncSetAttribute failed\n"); grid = -1; return; }
        (void)hipOccupancyMaxActiveBlocksPerMultiprocessor(&per_cu, (const void*)mega, NTHREADS, LDS_BYTES);
        if (per_cu < 1) { fprintf(stderr, "kernel_launch: occupancy query reports %d blocks per CU\n", per_cu); per_cu = 1; }
        (void)hipGetLastError();
        grid = cus * 1;
    }
    if (grid < 0) return;
    Args a{};
    for (int i = 0; i < 20; ++i) a.in[i] = (const float*)d_in[i];
    a.out = (float*)d_out; a.ws = (unsigned char*)d_ws;
#if N_LAUNCH_MODE == 0
    for (int p = 0; p < NPHASES; ++p) { a.ph_lo = p; a.ph_hi = p + 1; hipLaunchKernelGGL(mega, dim3(grid), dim3(NTHREADS), LDS_BYTES, stream, a); }
#else
    a.ph_lo = 0; a.ph_hi = NPHASES;
    void* args[] = {&a};
    hipError_t e = hipLaunchCooperativeKernel((void*)mega, dim3(grid), dim3(NTHREADS), args, LDS_BYTES, stream);
    if (e != hipSuccess) fprintf(stderr, "cooperative launch failed: %s (grid %d)\n", hipGetErrorString(e), grid);
#endif
}
```

```cpp
#include <hip/hip_runtime.h>
#include <hip/hip_cooperative_groups.h>
#include <cstdio>
#include <cstdint>
namespace cg = cooperative_groups;

#define LAS __attribute__((address_space(3)))
typedef unsigned short bf16;
typedef short bf16x8 __attribute__((ext_vector_type(8)));
typedef float f32x4 __attribute__((ext_vector_type(4)));
typedef float f32x2 __attribute__((ext_vector_type(2)));
typedef unsigned u32x4 __attribute__((ext_vector_type(4)));
typedef unsigned u32x2 __attribute__((ext_vector_type(2)));

constexpr int NB = 2, SEQ = 16384, DM = 2048, CTXL = 256;
constexpr int NLAT = NB * SEQ;
constexpr int NROWS = NLAT + NB * CTXL;
constexpr int PROJW = 4128;
constexpr int NE = 16, CAP = 2048, DEXP = 1024;
constexpr int PW = 4096;
constexpr int WIN_ROWS = 4352;
constexpr float EPS = 1e-6f;

constexpr size_t MiB = 1u << 20;
constexpr size_t WS_ADA = 0;
constexpr size_t WS_TW = 1 * MiB;
constexpr size_t WS_FC = 1 * MiB + 256 * 1024;
constexpr size_t WS_FS = 1 * MiB + 320 * 1024;
constexpr size_t WS_Z = 2 * MiB;
constexpr size_t WS_AFF = 8 * MiB;
constexpr size_t WS_TOK = 10 * MiB;
constexpr size_t WS_GATE = 11 * MiB;
constexpr size_t WS_SEL = 12 * MiB;
constexpr size_t WS_ST0 = 14 * MiB;
constexpr size_t WS_WIN = 32 * MiB;
constexpr size_t WS_WOUT = 50 * MiB;
constexpr size_t WS_WGU = 58 * MiB;
constexpr size_t WS_WD = 186 * MiB;
constexpr size_t WS_P = 250 * MiB;
constexpr size_t WS_HF = 250 * MiB;
constexpr size_t WS_HID = 378 * MiB;
constexpr size_t WS_FX = 250 * MiB;
constexpr size_t WS_FA = 510 * MiB;
constexpr size_t WS_FAI = 574 * MiB;
constexpr size_t WS_H = 510 * MiB;
constexpr size_t WS_OF = 510 * MiB;
constexpr size_t WS_OB = 574 * MiB;
constexpr size_t WS_T = 638 * MiB;
constexpr size_t WS_SST = 670 * MiB;
constexpr size_t WS_DT = 702 * MiB;
constexpr size_t WS_XL = 510 * MiB;
constexpr size_t WS_YCAT = 766 * MiB;
constexpr size_t WS_YE = 766 * MiB;
constexpr size_t WS_END = 1022 * MiB;

constexpr int LDS_BYTES = 163840;
constexpr int NTHREADS = 512;

struct Args {
    const float* in[20];
    float* out;
    unsigned char* ws;
    int ph_lo, ph_hi;
};

__device__ __forceinline__ float bf2f(bf16 v) { return __uint_as_float(((unsigned)v) << 16); }
__device__ __forceinline__ unsigned f2bf(float f) { unsigned u = __float_as_uint(f); return (u + 0x7fffu + ((u >> 16) & 1u)) >> 16; }
__device__ __forceinline__ unsigned pk2(float lo, float hi) { return f2bf(lo) | (f2bf(hi) << 16); }
__device__ __forceinline__ float wave_sum(float v) {
#pragma unroll
    for (int o = 1; o < 64; o <<= 1) v += __shfl_xor(v, o);
    return v;
}
__device__ __forceinline__ float silu_f(float x) { return x / (1.f + __expf(-x)); }
__device__ __forceinline__ float logsigmoid_f(float x) { return fminf(x, 0.f) - log1pf(expf(-fabsf(x))); }

namespace pg8 {
constexpr int BM = 256, BK = 64, HALF = 128, HTB = HALF * BK * 2, STAGE_BYTES = 8 * HTB, NXCD = 8, WGM = 8;
__host__ __device__ __forceinline__ int lds_byte(int r, int c) { const int st = (r >> 4) * 2 + (c >> 5), rr = r & 15, cc = c & 31, ob = rr * 64 + cc * 2; return st * 1024 + (ob ^ (((ob >> 9) & 1) << 5)); }
__host__ __device__ __forceinline__ void stage_rc(int b, int& R, int& C) { const int st = b / 1024, sb = b % 1024, swz = sb ^ (((sb >> 9) & 1) << 5); R = (st >> 1) * 16 + swz / 64; C = (st & 1) * 32 + (swz % 64) / 2; }
__host__ __device__ __forceinline__ int perm32(int rho) { const int n = rho >> 4, i = rho & 15; return 8 * (i >> 2) + 4 * n + (i & 3); }
struct Unit { int pm, pn; };
__device__ __forceinline__ unsigned cvt_pk_bf16(float lo, float hi) { unsigned r; asm volatile("v_cvt_pk_bf16_f32 %0, %1, %2" : "=v"(r) : "v"(lo), "v"(hi)); return r; }

struct OrderBase {
    int nM, nN, nwg, G, c;
    __device__ void init(int nM_, int nN_, int G_, int c_) { nM = nM_; nN = nN_; nwg = nM * nN; G = G_; c = c_; }
    __device__ bool next(int i, Unit& u) const {
        const long L = (long)i * G + c; if (L >= nwg) return false;
        int wgid = (int)L; { const int q = nwg / NXCD, r = nwg % NXCD, xcd = wgid % NXCD, off = wgid / NXCD; wgid = (xcd < r ? xcd * (q + 1) : r * (q + 1) + (xcd - r) * q) + off; }
        const int nig = WGM * nN, gid = wgid / nig, fm = gid * WGM, gsz = (nM - fm) < WGM ? (nM - fm) : WGM;
        u.pm = fm + ((wgid % nig) % gsz); u.pn = (wgid % nig) / gsz; return true;
    }
};

template <class Epi, class Sched, bool GATHER, bool ALIGN_EPI, bool SP2>
__device__ __forceinline__ void gemm_phase(LAS unsigned char* lds, const int K, const Sched& S, const Epi& E) {
    const int tid = threadIdx.x, wid = __builtin_amdgcn_readfirstlane(tid >> 6), lane = tid & 63, wr = wid >> 2, wc = wid & 3, fr = lane & 15, fq = lane >> 4;
    const int nt = K / BK;
    unsigned voffA[2], voffA1[2], voffB[2];
    int RA[2], CA[2];
#pragma unroll
    for (int i = 0; i < 2; ++i) { int R, C; stage_rc(tid * 16 + i * 8192, R, C); const int Rb = Epi::PERM ? ((R & ~31) + perm32(R & 31)) : R;
        RA[i] = R; CA[i] = C;
        voffA[i] = (unsigned)(R * K + C) * 2u; voffA1[i] = voffA[i]; voffB[i] = (unsigned)(Rb * K + C) * 2u; }
    const size_t kstep = (size_t)(BK * 2);
    const size_t hstep = (size_t)HALF * K * 2;
    const size_t hstepA = GATHER ? 0 : hstep;
    const unsigned ldsw = (unsigned)wid * 1024u;
    const int aoff = lds_byte(wr * 64 + fr, fq * 8), boff = lds_byte(wc * 32 + fr, fq * 8);
#define PG8_SA(b, h) (((b) * 2 + (h)) * HTB)
#define PG8_SB(b, h) ((4 + (b) * 2 + (h)) * HTB)
#define PG8_STAGE(bufoff, gbase, voff) do { _Pragma("unroll") for (int _i = 0; _i < 2; ++_i) \
        __builtin_amdgcn_global_load_lds((const unsigned*)((const char*)(gbase) + (voff)[_i]), (LAS unsigned*)(lds + (bufoff) + ldsw + _i * 8192), 16, 0, 0); } while (0)
#define PG8_LDA(dst, b, h) do { _Pragma("unroll") for (int m = 0; m < 4; ++m) _Pragma("unroll") for (int k = 0; k < 2; ++k) dst[m][k] = *(const LAS bf16x8*)(lds + PG8_SA(b, h) + aoff + m * 2048 + k * 1024); } while (0)
#define PG8_LDB(dst, b, h) do { _Pragma("unroll") for (int n = 0; n < 2; ++n) _Pragma("unroll") for (int k = 0; k < 2; ++k) dst[n][k] = *(const LAS bf16x8*)(lds + PG8_SB(b, h) + boff + n * 2048 + k * 1024); } while (0)
#define PG8_MMA(ai, bj, At, Bt) do { __builtin_amdgcn_s_setprio(1); _Pragma("unroll") for (int m = 0; m < 4; ++m) _Pragma("unroll") for (int n = 0; n < 2; ++n) _Pragma("unroll") for (int k = 0; k < 2; ++k) \
        acc[ai][bj][m][n] = __builtin_amdgcn_mfma_f32_16x16x32_bf16(Bt[n][k], At[m][k], acc[ai][bj][m][n], 0, 0, 0); __builtin_amdgcn_s_setprio(0); } while (0)
#define PG8_WAIT_V(n) asm volatile("s_waitcnt vmcnt(" #n ")" ::: "memory")
#define PG8_WAIT_L(n) asm volatile("s_waitcnt lgkmcnt(" #n ")" ::: "memory")
#define PG8_BAR __builtin_amdgcn_s_barrier()
#define PG8_SCHED __builtin_amdgcn_sched_barrier(0)
    Unit cur, nxt; int ui = 0;
    if (!S.next(0, cur)) return;
    f32x4 acc[2][2][4][2];
#pragma unroll
    for (int a = 0; a < 2; ++a)
#pragma unroll
        for (int b = 0; b < 2; ++b)
#pragma unroll
            for (int m = 0; m < 4; ++m)
#pragma unroll
                for (int n = 0; n < 2; ++n) acc[a][b][m][n] = (f32x4){0.f, 0.f, 0.f, 0.f};
    bf16x8 At[4][2], B0[2][2], B1[2][2];
    const char* cA = S.abase(cur); const char* cB = S.bbase(cur);
    if constexpr (GATHER) {
#pragma unroll
        for (int i = 0; i < 2; ++i) { voffA[i] = ((unsigned)S.arow(cur, RA[i]) * (unsigned)K + (unsigned)CA[i]) * 2u; voffA1[i] = ((unsigned)S.arow(cur, HALF + RA[i]) * (unsigned)K + (unsigned)CA[i]) * 2u; }
    }
    static_assert(SP2, "only the SP2 loop is kept");
    PG8_STAGE(PG8_SB(0, 0), cB, voffB); PG8_STAGE(PG8_SB(0, 1), cB + hstep, voffB); PG8_STAGE(PG8_SA(0, 0), cA, voffA); PG8_STAGE(PG8_SA(0, 1), cA + hstepA, voffA1);
    if (wr == 1) PG8_BAR;
    PG8_WAIT_V(2); PG8_BAR;
    PG8_STAGE(PG8_SB(1, 0), cB + kstep, voffB); PG8_STAGE(PG8_SA(1, 0), cA + kstep, voffA); PG8_STAGE(PG8_SB(1, 1), cB + hstep + kstep, voffB);
    PG8_WAIT_V(6); PG8_BAR;
    for (;;) {
        const bool has_next = S.next(ui + 1, nxt);
        const char* nA = has_next ? S.abase(nxt) : cA; const char* nB = has_next ? S.bbase(nxt) : cB;
        for (int t = 0; t < nt; t += 2) {
            const bool last = (t == nt - 2);
            const char* a1 = cA + (size_t)(t + 1) * kstep;
            const char* a2 = last ? nA : cA + (size_t)(t + 2) * kstep; const char* b2 = last ? nB : cB + (size_t)(t + 2) * kstep;
            const char* a3 = a2 + kstep; const char* b3 = b2 + kstep;
            PG8_LDB(B0, 0, 0); PG8_LDB(B1, 0, 1); PG8_SCHED; PG8_LDA(At, 0, 0); PG8_STAGE(PG8_SA(1, 1), a1 + hstepA, voffA1);
            if constexpr (GATHER) { if (last && has_next) {
#pragma unroll
                for (int i = 0; i < 2; ++i) { voffA[i] = ((unsigned)S.arow(nxt, RA[i]) * (unsigned)K + (unsigned)CA[i]) * 2u; voffA1[i] = ((unsigned)S.arow(nxt, HALF + RA[i]) * (unsigned)K + (unsigned)CA[i]) * 2u; } } }
            PG8_WAIT_V(8); PG8_WAIT_L(0); PG8_BAR; PG8_MMA(0, 0, At, B0); PG8_MMA(0, 1, At, B1); PG8_BAR; PG8_SCHED;
            PG8_LDA(At, 0, 1); PG8_STAGE(PG8_SB(0, 0), b2, voffB); PG8_STAGE(PG8_SB(0, 1), b2 + hstep, voffB); PG8_STAGE(PG8_SA(0, 0), a2, voffA);
            PG8_WAIT_V(8); PG8_WAIT_L(0); PG8_BAR; PG8_MMA(1, 0, At, B0); PG8_MMA(1, 1, At, B1); PG8_BAR; PG8_SCHED;
            PG8_LDB(B0, 1, 0); PG8_LDB(B1, 1, 1); PG8_SCHED; PG8_LDA(At, 1, 0); PG8_STAGE(PG8_SA(0, 1), a2 + hstepA, voffA1);
            PG8_WAIT_V(8); PG8_WAIT_L(0); PG8_BAR; PG8_MMA(0, 0, At, B0); PG8_MMA(0, 1, At, B1); PG8_BAR; PG8_SCHED;
            PG8_LDA(At, 1, 1); PG8_STAGE(PG8_SB(1, 0), b3, voffB); PG8_STAGE(PG8_SB(1, 1), b3 + hstep, voffB); PG8_STAGE(PG8_SA(1, 0), a3, voffA);
            PG8_WAIT_V(8); PG8_WAIT_L(0); PG8_BAR; PG8_MMA(1, 0, At, B0); PG8_MMA(1, 1, At, B1); PG8_BAR; PG8_SCHED;
        }
        if constexpr (ALIGN_EPI) { if (wr == 0) PG8_BAR; }
        E(acc, cur, wr, wc, fr, fq);
        if (!has_next) break;
#pragma unroll
        for (int a = 0; a < 2; ++a)
#pragma unroll
            for (int b = 0; b < 2; ++b)
#pragma unroll
                for (int m = 0; m < 4; ++m)
#pragma unroll
                    for (int n = 0; n < 2; ++n) acc[a][b][m][n] = (f32x4){0.f, 0.f, 0.f, 0.f};
        cur = nxt; cA = nA; cB = nB; ++ui;
        if constexpr (ALIGN_EPI) { if (wr == 1) PG8_BAR; }
    }
    PG8_WAIT_V(0);
    if constexpr (!ALIGN_EPI) { if (wr == 0) PG8_BAR; }
    PG8_BAR;
#undef PG8_SA
#undef PG8_SB
#undef PG8_STAGE
#undef PG8_LDA
#undef PG8_LDB
#undef PG8_MMA
#undef PG8_WAIT_V
#undef PG8_WAIT_L
#undef PG8_BAR
#undef PG8_SCHED
}
}
using pg8::Unit;
using pg8::cvt_pk_bf16;
constexpr int HALF = pg8::HALF, BM = pg8::BM;

struct SchedPlain : pg8::OrderBase {
    const char* A; const char* B; size_t tstep;
    __device__ __forceinline__ const char* abase(const Unit& u) const { return A + (size_t)u.pm * tstep; }
    __device__ __forceinline__ const char* bbase(const Unit& u) const { return B + (size_t)u.pn * tstep; }
    __device__ __forceinline__ int arow(const Unit&, int) const { return 0; }
};
struct SchedMoeUp : pg8::OrderBase {
    const char* A; const char* B; const int* tok;
    __device__ __forceinline__ const char* abase(const Unit&) const { return A; }
    __device__ __forceinline__ const char* bbase(const Unit& u) const { return B + ((size_t)(u.pm >> 4) * 2048 + (size_t)u.pn * 256) * (size_t)(DM * 2); }
    __device__ __forceinline__ int arow(const Unit& u, int r) const { const int e = u.pm >> 4, b = (u.pm >> 3) & 1, mt = u.pm & 7; return b * SEQ + tok[(b * NE + e) * CAP + mt * 256 + r]; }
};
struct SchedMoeDown : pg8::OrderBase {
    const char* A; const char* B;
    __device__ __forceinline__ const char* abase(const Unit& u) const { return A + (size_t)u.pm * 256 * (size_t)(DEXP * 2); }
    __device__ __forceinline__ const char* bbase(const Unit& u) const { return B + ((size_t)(u.pm >> 4) * 2048 + (size_t)u.pn * 256) * (size_t)(DEXP * 2); }
    __device__ __forceinline__ int arow(const Unit&, int) const { return 0; }
};

struct EpiInProj {
    static constexpr bool PERM = true;
    bf16* P; float* Z;
    __device__ __forceinline__ void operator()(const f32x4 (&acc)[2][2][4][2], const Unit& u, int wr, int wc, int fr, int fq) const {
        const int row0 = u.pm * BM + wr * 64 + fr;
        if (u.pn < 16) {
            const int col0 = u.pn * BM + wc * 32 + 8 * fq;
#pragma unroll
            for (int ai = 0; ai < 2; ++ai)
#pragma unroll
                for (int m = 0; m < 4; ++m) { bf16* rowp = P + (size_t)(row0 + ai * HALF + m * 16) * PW + col0;
#pragma unroll
                    for (int bj = 0; bj < 2; ++bj) { const f32x4 v0 = acc[ai][bj][m][0], v1 = acc[ai][bj][m][1];
                        u32x4 w; w.x = cvt_pk_bf16(v0[0], v0[1]); w.y = cvt_pk_bf16(v0[2], v0[3]); w.z = cvt_pk_bf16(v1[0], v1[1]); w.w = cvt_pk_bf16(v1[2], v1[3]);
                        *(u32x4*)(rowp + bj * HALF) = w; } }
        } else if (wc == 0) {
#pragma unroll
            for (int ai = 0; ai < 2; ++ai)
#pragma unroll
                for (int m = 0; m < 4; ++m) { float* rowp = Z + (size_t)(row0 + ai * HALF + m * 16) * 32 + 8 * fq;
                    *(f32x4*)(rowp) = acc[ai][0][m][0]; *(f32x4*)(rowp + 4) = acc[ai][0][m][1]; }
        }
    }
};
struct EpiOutProj {
    static constexpr bool PERM = false;
    const float* X; float* XL; const float* ada;
    __device__ __forceinline__ void operator()(const f32x4 (&acc)[2][2][4][2], const Unit& u, int wr, int wc, int fr, int fq) const {
        const int row0 = u.pm * BM + wr * 64 + fr, col0 = u.pn * BM + wc * 32 + 4 * fq;
        const int b = (u.pm * BM) / SEQ;
        const float* g1 = ada + (size_t)b * 12288 + 2 * DM;
        f32x4 gv[2][2];
#pragma unroll
        for (int bj = 0; bj < 2; ++bj)
#pragma unroll
            for (int n = 0; n < 2; ++n) gv[bj][n] = *(const f32x4*)(g1 + col0 + bj * HALF + n * 16);
#pragma unroll
        for (int ai = 0; ai < 2; ++ai)
#pragma unroll
            for (int m = 0; m < 4; ++m) { const size_t off = (size_t)(row0 + ai * HALF + m * 16) * DM + col0;
#pragma unroll
                for (int bj = 0; bj < 2; ++bj)
#pragma unroll
                    for (int n = 0; n < 2; ++n) { const f32x4 xv = *(const f32x4*)(X + off + bj * HALF + n * 16);
                        *(f32x4*)(XL + off + bj * HALF + n * 16) = xv + gv[bj][n] * acc[ai][bj][m][n]; }
                asm volatile("" ::: "memory"); }
    }
};
struct EpiSwiglu {
    static constexpr bool PERM = true;
    bf16* HID;
    __device__ __forceinline__ void operator()(const f32x4 (&acc)[2][2][4][2], const Unit& u, int wr, int wc, int fr, int fq) const {
        const int row0 = u.pm * BM + wr * 64 + fr, col0 = u.pn * 128 + wc * 32 + 8 * fq;
#pragma unroll
        for (int ai = 0; ai < 2; ++ai)
#pragma unroll
            for (int m = 0; m < 4; ++m) { bf16* rowp = HID + (size_t)(row0 + ai * HALF + m * 16) * DEXP + col0;
                f32x4 h0, h1;
#pragma unroll
                for (int j = 0; j < 4; ++j) { h0[j] = silu_f(acc[ai][0][m][0][j]) * acc[ai][1][m][0][j]; h1[j] = silu_f(acc[ai][0][m][1][j]) * acc[ai][1][m][1][j]; }
                u32x4 w; w.x = cvt_pk_bf16(h0[0], h0[1]); w.y = cvt_pk_bf16(h0[2], h0[3]); w.z = cvt_pk_bf16(h1[0], h1[1]); w.w = cvt_pk_bf16(h1[2], h1[3]);
                *(u32x4*)(rowp) = w; }
    }
};
struct EpiBf16 {
    static constexpr bool PERM = true;
    bf16* O; int ldc;
    __device__ __forceinline__ void operator()(const f32x4 (&acc)[2][2][4][2], const Unit& u, int wr, int wc, int fr, int fq) const {
        const int row0 = u.pm * BM + wr * 64 + fr, col0 = u.pn * BM + wc * 32 + 8 * fq;
#pragma unroll
        for (int ai = 0; ai < 2; ++ai)
#pragma unroll
            for (int m = 0; m < 4; ++m) { bf16* rowp = O + (size_t)(row0 + ai * HALF + m * 16) * ldc + col0;
#pragma unroll
                for (int bj = 0; bj < 2; ++bj) { const f32x4 v0 = acc[ai][bj][m][0], v1 = acc[ai][bj][m][1];
                    u32x4 w; w.x = cvt_pk_bf16(v0[0], v0[1]); w.y = cvt_pk_bf16(v0[2], v0[3]); w.z = cvt_pk_bf16(v1[0], v1[1]); w.w = cvt_pk_bf16(v1[2], v1[3]);
                    *(u32x4*)(rowp + bj * HALF) = w; } }
    }
};

__device__ __forceinline__ void transpose_item(const float* src, int ldsrc, int scol0, int k0, bf16* dst, size_t drow0, int ldd, LAS float* scr, int lane) {
#pragma unroll 8
    for (int i = 0; i < 32; ++i) { const int kk = 2 * i + (lane >> 5); scr[kk * 33 + (lane & 31)] = src[(size_t)(k0 + kk) * ldsrc + scol0 + (lane & 31)]; }
    asm volatile("s_waitcnt lgkmcnt(0)" ::: "memory");
    const int c = lane & 7;
#pragma unroll
    for (int j = 0; j < 4; ++j) { const int n = (lane >> 3) + 8 * j; const LAS float* s = scr + (8 * c) * 33 + n;
        u32x4 o; o.x = pk2(s[0 * 33], s[1 * 33]); o.y = pk2(s[2 * 33], s[3 * 33]); o.z = pk2(s[4 * 33], s[5 * 33]); o.w = pk2(s[6 * 33], s[7 * 33]);
        *(u32x4*)(dst + (drow0 + n) * (size_t)ldd + k0 + 8 * c) = o; }
    asm volatile("s_waitcnt lgkmcnt(0)" ::: "memory");
}

__device__ __forceinline__ void phase0(const Args& a, LAS unsigned char* lds) {
    const int tid = threadIdx.x, lane = tid & 63, wave = tid >> 6, G = gridDim.x, blk = blockIdx.x;
    unsigned char* ws = a.ws;
    {
        const float* c = a.in[1]; const float* cc = a.in[3]; const float* w_ada = a.in[4]; const float* b_ada = a.in[5];
        float* ada = (float*)(ws + WS_ADA);
        LAS float* red = (LAS float*)lds;
        for (int it = blk; it < 96; it += G) {
            const int col0 = it * 128 + 2 * lane;
            float a0x = 0, a0y = 0, a1x = 0, a1y = 0, a2x = 0, a2y = 0;
            const int r0 = wave * 256;
#pragma unroll 8
            for (int r = r0; r < r0 + 256; ++r) {
                const f32x2 w = *(const f32x2*)(w_ada + (size_t)r * 12288 + col0);
                const float s0 = silu_f(c[r]), s1 = silu_f(c[DM + r]), s2 = silu_f(cc[r]);
                a0x += s0 * w.x; a0y += s0 * w.y; a1x += s1 * w.x; a1y += s1 * w.y; a2x += s2 * w.x; a2y += s2 * w.y;
            }
            red[(wave * 3 + 0) * 128 + 2 * lane] = a0x; red[(wave * 3 + 0) * 128 + 2 * lane + 1] = a0y;
            red[(wave * 3 + 1) * 128 + 2 * lane] = a1x; red[(wave * 3 + 1) * 128 + 2 * lane + 1] = a1y;
            red[(wave * 3 + 2) * 128 + 2 * lane] = a2x; red[(wave * 3 + 2) * 128 + 2 * lane + 1] = a2y;
            __syncthreads();
            if (tid < 384) { const int v = tid >> 7, col = tid & 127; float s = b_ada[it * 128 + col];
                for (int w8 = 0; w8 < 8; ++w8) s += red[(w8 * 3 + v) * 128 + col];
                ada[v * 12288 + it * 128 + col] = s; }
            __syncthreads();
        }
    }
    LAS float* scr = (LAS float*)(lds + wave * 16384);
    const int gw = blk * 8 + wave, NGW = G * 8;
    constexpr int I_WIN = 32 * 129, I_ZERO = 224, I_WOUT = 32 * 64, I_WG = 16 * 32 * 32, I_WU = I_WG, I_WD = 16 * 16 * 64, I_TW = 256, I_FT = 256;
    constexpr int I_TOTAL = I_WIN + I_ZERO + I_WOUT + I_WG + I_WU + I_WD + I_TW + I_FT;
    bf16* Win = (bf16*)(ws + WS_WIN); bf16* Wout = (bf16*)(ws + WS_WOUT); bf16* Wgu = (bf16*)(ws + WS_WGU); bf16* Wd = (bf16*)(ws + WS_WD);
    for (int it = gw; it < I_TOTAL; it += NGW) {
        int r = it;
        if (r < I_WIN) { const int kb = r / 129, nb = r % 129, n0 = nb * 32;
            const size_t drow = n0 < 3072 ? (size_t)n0 : (n0 < 3104 ? (size_t)(4096 + n0 - 3072) : (size_t)(3072 + n0 - 3104));
            transpose_item(a.in[7], PROJW, n0, kb * 64, Win, drow, DM, scr, lane); continue; }
        r -= I_WIN;
        if (r < I_ZERO) { u32x4 z = {0u, 0u, 0u, 0u}; u32x4* p = (u32x4*)(Win + (size_t)(4128 + r) * DM);
#pragma unroll
            for (int j = 0; j < 4; ++j) p[lane + 64 * j] = z; continue; }
        r -= I_ZERO;
        if (r < I_WOUT) { const int kb = r / 64, nb = r % 64; transpose_item(a.in[13], DM, nb * 32, kb * 64, Wout, (size_t)nb * 32, DM, scr, lane); continue; }
        r -= I_WOUT;
        if (r < I_WG + I_WU) { const int up = r >= I_WG; if (up) r -= I_WG; const int e = r / 1024, rr = r % 1024, kb = rr / 32, nb = rr % 32, n0 = nb * 32;
            const float* src = (up ? a.in[17] : a.in[16]) + (size_t)e * DM * DEXP;
            const size_t drow = (size_t)e * 2048 + (size_t)(n0 >> 7) * 256 + (n0 & 127) + (up ? 128 : 0);
            transpose_item(src, DEXP, n0, kb * 64, Wgu, drow, DM, scr, lane); continue; }
        r -= I_WG + I_WU;
        if (r < I_WD) { const int e = r / 1024, rr = r % 1024, kb = rr / 64, nb = rr % 64;
            transpose_item(a.in[18] + (size_t)e * DEXP * DM, DM, nb * 32, kb * 64, Wd, (size_t)e * 2048 + nb * 32, DEXP, scr, lane); continue; }
        r -= I_WD;
        if (r < I_TW) { const int p = r * 64 + lane; float s, c; sincospif((float)p * (1.0f / 8192.0f), &s, &c); ((f32x2*)(ws + WS_TW))[p] = (f32x2){c, s}; continue; }
        r -= I_TW;
        { const int p = r * 64 + lane, k = p >> 7, l = p & 127; float s, c; sincospif((float)((k * l) & 127) * (1.0f / 64.0f), &s, &c); ((bf16*)(ws + WS_FC))[p] = (bf16)f2bf(c); ((bf16*)(ws + WS_FS))[p] = (bf16)f2bf(s); }
    }
}

__device__ __forceinline__ void phase1(const Args& a) {
    const int tid = threadIdx.x, lane = tid & 63, wave = tid >> 6, G = gridDim.x;
    const int gw = blockIdx.x * 8 + wave, NGW = G * 8;
    const float* ada = (const float*)(a.ws + WS_ADA); const float* g1n = a.in[6];
    bf16* H = (bf16*)(a.ws + WS_H);
    for (int r = gw; r < NROWS; r += NGW) {
        const float* xr; int v;
        if (r < NLAT) { xr = a.in[0] + (size_t)r * DM; v = r / SEQ; } else { xr = a.in[2] + (size_t)(r - NLAT) * DM; v = 2; }
        const float* sh = ada + (size_t)v * 12288; const float* sc = sh + DM;
        f32x4 x[8]; float ss = 0.f;
#pragma unroll
        for (int j = 0; j < 8; ++j) { x[j] = *(const f32x4*)(xr + 256 * j + 4 * lane); ss += (x[j].x * x[j].x + x[j].y * x[j].y) + (x[j].z * x[j].z + x[j].w * x[j].w); }
        const float rstd = rsqrtf(wave_sum(ss) * (1.f / DM) + EPS);
        u32x2* o = (u32x2*)(H + (size_t)r * DM);
#pragma unroll
        for (int j = 0; j < 8; ++j) { const int d = 256 * j + 4 * lane; const f32x4 g = *(const f32x4*)(g1n + d), s1 = *(const f32x4*)(sc + d), s0 = *(const f32x4*)(sh + d);
            const f32x4 hh = (x[j] * rstd * g) * (s1 + 1.f) + s0;
            u32x2 w; w.x = pk2(hh.x, hh.y); w.y = pk2(hh.z, hh.w); o[64 * j + lane] = w; }
    }
}

#define MFMA16(a, b, c) __builtin_amdgcn_mfma_f32_16x16x32_bf16((a), (b), (c), 0, 0, 0)
constexpr int GQ_LD = 136, GK_LD = 72;
constexpr int GL_Q = 0, GL_KI = 17408, GL_KET = 34816, GL_VT = 53248, GL_ST = 90112, GL_DC = 159744, GL_SEG = 160256;
__device__ __forceinline__ bf16x8 ldfrag(const LAS bf16* base, int row0, int ld, int koff, int lane) { return *(const LAS bf16x8*)(base + (row0 + (lane & 15)) * ld + koff + 8 * (lane >> 4)); }
__device__ __forceinline__ float fast_logsigmoid(float x) { return fminf(x, 0.f) - __logf(1.f + __expf(-fabsf(x))); }

template <bool FULL>
__device__ __forceinline__ void gla_prep(const Args& a, LAS unsigned char* lds, size_t row0, int h, int dir, const float (&w)[16], float bias, float& totacc) {
    const int tid = threadIdx.x, d = tid & 127, seg = __builtin_amdgcn_readfirstlane(tid >> 7);
    const bf16* P = (const bf16*)(a.ws + WS_P); const float* Z = (const float*)(a.ws + WS_Z);
    LAS bf16* Qd = (LAS bf16*)(lds + GL_Q); LAS bf16* Ki = (LAS bf16*)(lds + GL_KI); LAS bf16* KeT = (LAS bf16*)(lds + GL_KET);
    LAS float* dcv = (LAS float*)(lds + GL_DC); LAS float* segt = (LAS float*)(lds + GL_SEG);
    const size_t r0 = row0 + 16 * seg;
    float kf[16], qf[16], c[16];
#pragma unroll
    for (int ii = 0; ii < 16; ++ii) { kf[ii] = bf2f(P[(r0 + ii) * PW + 512 + h * 128 + d]); if (FULL) qf[ii] = bf2f(P[(r0 + ii) * PW + h * 128 + d]); }
#pragma unroll
    for (int ii = 0; ii < 16; ++ii) { const float* zr = Z + (r0 + ii) * 32 + dir * 16; float pre = bias;
#pragma unroll
        for (int r = 0; r < 16; ++r) pre += zr[r] * w[r];
        c[ii] = fast_logsigmoid(pre) * (1.f / 16.f); }
    if (!dir) {
#pragma unroll
        for (int ii = 1; ii < 16; ++ii) c[ii] += c[ii - 1];
    } else {
#pragma unroll
        for (int ii = 14; ii >= 0; --ii) c[ii] += c[ii + 1];
    }
    segt[seg * 128 + d] = dir ? c[0] : c[15];
    __syncthreads();
    float total = 0.f, off = 0.f;
#pragma unroll
    for (int s2 = 0; s2 < 4; ++s2) { const float t = segt[s2 * 128 + d]; total += t; if (dir ? (s2 > seg) : (s2 < seg)) off += t; }
    unsigned kw[8];
#pragma unroll
    for (int ii = 0; ii < 16; ii += 2) {
        const float c0 = c[ii] + off, c1 = c[ii + 1] + off;
        kw[ii >> 1] = pk2(kf[ii] * __expf(total - c0), kf[ii + 1] * __expf(total - c1));
        if (FULL) { const int i0 = 16 * seg + ii;
            Qd[i0 * GQ_LD + d] = (bf16)f2bf(qf[ii] * 0.08838834764831845f * __expf(c0)); Qd[(i0 + 1) * GQ_LD + d] = (bf16)f2bf(qf[ii + 1] * 0.08838834764831845f * __expf(c1));
            Ki[i0 * GQ_LD + d] = (bf16)f2bf(kf[ii] * __expf(-c0)); Ki[(i0 + 1) * GQ_LD + d] = (bf16)f2bf(kf[ii + 1] * __expf(-c1)); }
    }
    *(LAS u32x4*)(KeT + d * GK_LD + 16 * seg) = (u32x4){kw[0], kw[1], kw[2], kw[3]};
    *(LAS u32x4*)(KeT + d * GK_LD + 16 * seg + 8) = (u32x4){kw[4], kw[5], kw[6], kw[7]};
    if (seg == 0) { dcv[d] = __expf(total); totacc += total; }
}
__device__ __forceinline__ void gla_load_v(const Args& a, size_t row0, int h, int wave, int lane, u32x4 (&vx)[4]) {
    const bf16* P = (const bf16*)(a.ws + WS_P);
#pragma unroll
    for (int r = 0; r < 4; ++r) vx[r] = *(const u32x4*)(P + (row0 + 4 * (lane >> 2) + r) * PW + 1024 + h * 256 + 32 * wave + 8 * (lane & 3));
}
__device__ __forceinline__ void gla_store_vt(LAS unsigned char* lds, int wave, int lane, const u32x4 (&x)[4]) {
    LAS bf16* VT = (LAS bf16*)(lds + GL_VT); const int c0 = 32 * wave + 8 * (lane & 3), l0 = 4 * (lane >> 2);
#pragma unroll
    for (int i2 = 0; i2 < 4; ++i2) {
        const unsigned a0 = x[0][i2], a1 = x[1][i2], a2 = x[2][i2], a3 = x[3][i2];
        u32x2 lo, hi; lo.x = (a0 & 0xffffu) | (a1 << 16); lo.y = (a2 & 0xffffu) | (a3 << 16); hi.x = (a0 >> 16) | (a1 & 0xffff0000u); hi.y = (a2 >> 16) | (a3 & 0xffff0000u);
        *(LAS u32x2*)(VT + (c0 + 2 * i2) * GK_LD + l0) = lo; *(LAS u32x2*)(VT + (c0 + 2 * i2 + 1) * GK_LD + l0) = hi; }
}
__device__ __forceinline__ void gla_state_update(LAS unsigned char* lds, int lane, const bf16x8 (&vt)[2][2], f32x4 (&acc)[8][2]) {
    const LAS bf16* KeT = (const LAS bf16*)(lds + GL_KET); const LAS float* dcv = (const LAS float*)(lds + GL_DC);
#pragma unroll
    for (int mt = 0; mt < 8; ++mt) {
        const f32x4 dc4 = *(const LAS f32x4*)(dcv + 16 * mt + 4 * (lane >> 4));
        const bf16x8 k0 = ldfrag(KeT, 16 * mt, GK_LD, 0, lane), k1 = ldfrag(KeT, 16 * mt, GK_LD, 32, lane);
#pragma unroll
        for (int n = 0; n < 2; ++n) { f32x4 t = acc[mt][n] * dc4; t = MFMA16(k0, vt[n][0], t); t = MFMA16(k1, vt[n][1], t); acc[mt][n] = t; }
    }
}
constexpr size_t GLA_SV = 128 * 256;
__device__ __forceinline__ void gla_passA(const Args& a, LAS unsigned char* lds, int item) {
    const int tid = threadIdx.x, lane = tid & 63, wave = __builtin_amdgcn_readfirstlane(tid >> 6), q = lane >> 4, cidx = lane & 15;
    const bool is_ctx = item >= 256; const int seq = is_ctx ? item - 256 : item >> 4, s = is_ctx ? 0 : item & 15;
    const int b = seq >> 3, dir = (seq >> 2) & 1, h = seq & 3, nchunk = is_ctx ? 4 : 16;
    const size_t rowbase = is_ctx ? (size_t)(NLAT + b * CTXL) : (size_t)b * SEQ + (size_t)s * 1024;
    const float* w_a2 = dir ? a.in[10] : a.in[8]; const float* b_a2 = dir ? a.in[11] : a.in[9];
    float w[16]; const int d = tid & 127;
#pragma unroll
    for (int r = 0; r < 16; ++r) w[r] = w_a2[r * 512 + h * 128 + d];
    const float bias = b_a2[h * 128 + d];
    f32x4 acc[8][2];
#pragma unroll
    for (int mt = 0; mt < 8; ++mt) { acc[mt][0] = (f32x4){0.f, 0.f, 0.f, 0.f}; acc[mt][1] = (f32x4){0.f, 0.f, 0.f, 0.f}; }
    float totacc = 0.f;
    for (int ci = 0; ci < nchunk; ++ci) {
        const int n = dir ? (nchunk - 1 - ci) : ci; const size_t row0 = rowbase + (size_t)n * 64;
        u32x4 vx[4]; gla_load_v(a, row0, h, wave, lane, vx);
        gla_prep<false>(a, lds, row0, h, dir, w, bias, totacc);
        gla_store_vt(lds, wave, lane, vx);
        __syncthreads();
        const LAS bf16* VT = (const LAS bf16*)(lds + GL_VT);
        bf16x8 vt[2][2];
#pragma unroll
        for (int n2 = 0; n2 < 2; ++n2) { vt[n2][0] = ldfrag(VT, 32 * wave + 16 * n2, GK_LD, 0, lane); vt[n2][1] = ldfrag(VT, 32 * wave + 16 * n2, GK_LD, 32, lane); }
        gla_state_update(lds, lane, vt, acc);
        __syncthreads();
    }
    float* T = is_ctx ? (float*)(a.ws + WS_ST0) + (size_t)seq * GLA_SV : (float*)(a.ws + WS_T) + (size_t)item * GLA_SV;
#pragma unroll
    for (int mt = 0; mt < 8; ++mt)
#pragma unroll
        for (int n2 = 0; n2 < 2; ++n2)
#pragma unroll
            for (int r = 0; r < 4; ++r) T[(size_t)(16 * mt + 4 * q + r) * 256 + 32 * wave + 16 * n2 + cidx] = acc[mt][n2][r];
    if (!is_ctx && tid < 128) ((float*)(a.ws + WS_DT))[item * 128 + tid] = __expf(totacc);
}
__device__ __forceinline__ void gla_passB(const Args& a) {
    const float* ST0 = (const float*)(a.ws + WS_ST0); const float* T = (const float*)(a.ws + WS_T); const float* DT = (const float*)(a.ws + WS_DT); float* SST = (float*)(a.ws + WS_SST);
    for (int e = blockIdx.x * NTHREADS + threadIdx.x; e < 16 * (int)GLA_SV; e += gridDim.x * NTHREADS) {
        const int seq = e >> 15, dv = e & 32767, d = dv >> 8, dir = (seq >> 2) & 1;
        float S = ST0[(size_t)seq * GLA_SV + dv];
        for (int si = 0; si < 16; ++si) { const int s = dir ? 15 - si : si; const size_t it = (size_t)seq * 16 + s;
            SST[it * GLA_SV + dv] = S; S = DT[it * 128 + d] * S + T[it * GLA_SV + dv]; }
    }
}
__device__ __forceinline__ void gla_passC(const Args& a, LAS unsigned char* lds, int item) {
    const int tid = threadIdx.x, lane = tid & 63, wave = __builtin_amdgcn_readfirstlane(tid >> 6), q = lane >> 4, cidx = lane & 15;
    const int seq = item >> 4, s = item & 15, b = seq >> 3, dir = (seq >> 2) & 1, h = seq & 3;
    const size_t rowbase = (size_t)b * SEQ + (size_t)s * 1024;
    const float* w_a2 = dir ? a.in[10] : a.in[8]; const float* b_a2 = dir ? a.in[11] : a.in[9];
    bf16* O = (bf16*)(a.ws + (dir ? WS_OB : WS_OF));
    float w[16]; const int d = tid & 127;
#pragma unroll
    for (int r = 0; r < 16; ++r) w[r] = w_a2[r * 512 + h * 128 + d];
    const float bias = b_a2[h * 128 + d];
    LAS bf16* Qd = (LAS bf16*)(lds + GL_Q); LAS bf16* Ki = (LAS bf16*)(lds + GL_KI); LAS bf16* Pm = Ki; LAS bf16* VT = (LAS bf16*)(lds + GL_VT); LAS bf16* ST = (LAS bf16*)(lds + GL_ST);
    f32x4 acc[8][2];
    { const float* S0 = (const float*)(a.ws + WS_SST) + (size_t)item * GLA_SV;
#pragma unroll
      for (int mt = 0; mt < 8; ++mt)
#pragma unroll
          for (int n2 = 0; n2 < 2; ++n2) {
#pragma unroll
              for (int r = 0; r < 4; ++r) acc[mt][n2][r] = S0[(size_t)(16 * mt + 4 * q + r) * 256 + 32 * wave + 16 * n2 + cidx];
              u32x2 wv; wv.x = pk2(acc[mt][n2][0], acc[mt][n2][1]); wv.y = pk2(acc[mt][n2][2], acc[mt][n2][3]);
              *(LAS u32x2*)(ST + (32 * wave + 16 * n2 + cidx) * GQ_LD + 16 * mt + 4 * q) = wv; } }
    float totacc = 0.f;
    for (int ci = 0; ci < 16; ++ci) {
        const int n = dir ? (15 - ci) : ci; const size_t row0 = rowbase + (size_t)n * 64;
        u32x4 vx[4]; gla_load_v(a, row0, h, wave, lane, vx);
        gla_prep<true>(a, lds, row0, h, dir, w, bias, totacc);
        gla_store_vt(lds, wave, lane, vx);
        __syncthreads();
        const int it = wave >> 1;
        u32x2 pw[2];
#pragma unroll
        for (int jj = 0; jj < 2; ++jj) { const int jt = 2 * (wave & 1) + jj; f32x4 sc = {0.f, 0.f, 0.f, 0.f};
#pragma unroll
            for (int ks = 0; ks < 4; ++ks) sc = MFMA16(ldfrag(Ki, 16 * jt, GQ_LD, 32 * ks, lane), ldfrag(Qd, 16 * it, GQ_LD, 32 * ks, lane), sc);
            const int i = 16 * it + cidx, j0 = 16 * jt + 4 * q;
#pragma unroll
            for (int r = 0; r < 4; ++r) { const bool keep = dir ? (j0 + r >= i) : (j0 + r <= i); sc[r] = keep ? sc[r] : 0.f; }
            pw[jj].x = pk2(sc[0], sc[1]); pw[jj].y = pk2(sc[2], sc[3]); }
        __syncthreads();
#pragma unroll
        for (int jj = 0; jj < 2; ++jj) *(LAS u32x2*)(Pm + (16 * it + cidx) * GK_LD + 16 * (2 * (wave & 1) + jj) + 4 * q) = pw[jj];
        __syncthreads();
        bf16x8 vt[2][2], st[2][4];
#pragma unroll
        for (int n2 = 0; n2 < 2; ++n2) { vt[n2][0] = ldfrag(VT, 32 * wave + 16 * n2, GK_LD, 0, lane); vt[n2][1] = ldfrag(VT, 32 * wave + 16 * n2, GK_LD, 32, lane);
#pragma unroll
            for (int ks = 0; ks < 4; ++ks) st[n2][ks] = ldfrag(ST, 32 * wave + 16 * n2, GQ_LD, 32 * ks, lane); }
#pragma unroll
        for (int i2 = 0; i2 < 4; ++i2) {
            const bf16x8 p0 = ldfrag(Pm, 16 * i2, GK_LD, 0, lane), p1 = ldfrag(Pm, 16 * i2, GK_LD, 32, lane);
            bf16x8 qf[4];
#pragma unroll
            for (int ks = 0; ks < 4; ++ks) qf[ks] = ldfrag(Qd, 16 * i2, GQ_LD, 32 * ks, lane);
#pragma unroll
            for (int n2 = 0; n2 < 2; ++n2) { f32x4 o = {0.f, 0.f, 0.f, 0.f};
                o = MFMA16(vt[n2][0], p0, o); o = MFMA16(vt[n2][1], p1, o);
#pragma unroll
                for (int ks = 0; ks < 4; ++ks) o = MFMA16(st[n2][ks], qf[ks], o);
                u32x2 wv; wv.x = pk2(o[0], o[1]); wv.y = pk2(o[2], o[3]);
                *(u32x2*)(O + (row0 + 16 * i2 + cidx) * 1024 + h * 256 + 32 * wave + 16 * n2 + 4 * q) = wv; }
        }
        gla_state_update(lds, lane, vt, acc);
#pragma unroll
        for (int mt = 0; mt < 8; ++mt)
#pragma unroll
            for (int n2 = 0; n2 < 2; ++n2) { u32x2 wv; wv.x = pk2(acc[mt][n2][0], acc[mt][n2][1]); wv.y = pk2(acc[mt][n2][2], acc[mt][n2][3]);
                *(LAS u32x2*)(ST + (32 * wave + 16 * n2 + cidx) * GQ_LD + 16 * mt + 4 * q) = wv; }
        __syncthreads();
    }
}

__device__ __forceinline__ void phase_gla_merge(const Args& a) {
    const int tid = threadIdx.x, lane = tid & 63, wave = tid >> 6;
    const int gw = blockIdx.x * 8 + wave, NGW = gridDim.x * 8;
    const bf16* OF = (const bf16*)(a.ws + WS_OF); const bf16* OB = (const bf16*)(a.ws + WS_OB);
    const bf16* P = (const bf16*)(a.ws + WS_P); bf16* Y = (bf16*)(a.ws + WS_YCAT); const float* gg = a.in[12];
    for (int r = gw; r < NLAT; r += NGW) {
#pragma unroll
        for (int j = 0; j < 4; ++j) {
            const int col = 256 * j + 4 * lane;
            const u32x2 fa = *(const u32x2*)(OF + (size_t)r * 1024 + col), fb = *(const u32x2*)(OB + (size_t)r * 1024 + col);
            f32x4 o; o.x = __uint_as_float(fa.x << 16) + __uint_as_float(fb.x << 16); o.y = __uint_as_float(fa.x & 0xffff0000u) + __uint_as_float(fb.x & 0xffff0000u);
            o.z = __uint_as_float(fa.y << 16) + __uint_as_float(fb.y << 16); o.w = __uint_as_float(fa.y & 0xffff0000u) + __uint_as_float(fb.y & 0xffff0000u);
            const float ss = wave_sum((o.x * o.x + o.y * o.y) + (o.z * o.z + o.w * o.w));
            const float rstd = rsqrtf(ss * (1.f / 256.f) + EPS);
            const u32x2 gw2 = *(const u32x2*)(P + (size_t)r * PW + 2048 + col);
            const f32x4 gn = *(const f32x4*)(gg + col);
            const float g0 = __uint_as_float(gw2.x << 16), g1 = __uint_as_float(gw2.x & 0xffff0000u), g2 = __uint_as_float(gw2.y << 16), g3 = __uint_as_float(gw2.y & 0xffff0000u);
            u32x2 w; w.x = pk2(o.x * rstd * gn.x * silu_f(g0), o.y * rstd * gn.y * silu_f(g1)); w.y = pk2(o.z * rstd * gn.z * silu_f(g2), o.w * rstd * gn.w * silu_f(g3));
            *(u32x2*)(Y + (size_t)r * DM + col) = w;
        }
    }
}

constexpr int FLD = 136;
__device__ __forceinline__ void load_dft_frags(const unsigned char* ws, int wave, int lane, bf16x8 (&fc)[4], bf16x8 (&fs)[4]) {
    const bf16* FC = (const bf16*)(ws + WS_FC); const bf16* FS = (const bf16*)(ws + WS_FS);
    const int k = 16 * wave + (lane & 15);
#pragma unroll
    for (int ks = 0; ks < 4; ++ks) { fc[ks] = *(const bf16x8*)(FC + k * 128 + ks * 32 + 8 * (lane >> 4)); fs[ks] = *(const bf16x8*)(FS + k * 128 + ks * 32 + 8 * (lane >> 4)); }
}
__device__ __forceinline__ void store_t4x8(LAS bf16* XT, int c0, int l0, const u32x4 (&x)[4]) {
#pragma unroll
    for (int i2 = 0; i2 < 4; ++i2) {
        const unsigned a0 = x[0][i2], a1 = x[1][i2], a2 = x[2][i2], a3 = x[3][i2];
        u32x2 lo, hi; lo.x = (a0 & 0xffffu) | (a1 << 16); lo.y = (a2 & 0xffffu) | (a3 << 16); hi.x = (a0 >> 16) | (a1 & 0xffff0000u); hi.y = (a2 >> 16) | (a3 & 0xffff0000u);
        *(LAS u32x2*)(XT + (c0 + 2 * i2) * FLD + l0) = lo; *(LAS u32x2*)(XT + (c0 + 2 * i2 + 1) * FLD + l0) = hi; }
}
__device__ __forceinline__ void phase_f1(const Args& a, LAS unsigned char* lds) {
    const int tid = threadIdx.x, lane = tid & 63, wave = __builtin_amdgcn_readfirstlane(tid >> 6), q = lane >> 4, cidx = lane & 15;
    const bf16* P = (const bf16*)(a.ws + WS_P); const f32x2* TW = (const f32x2*)(a.ws + WS_TW);
    bf16* A1r = (bf16*)(a.ws + WS_FA); bf16* A1i = (bf16*)(a.ws + WS_FAI);
    LAS bf16* XT = (LAS bf16*)lds;
    bf16x8 fc[4], fs[4]; load_dft_frags(a.ws, wave, lane, fc, fs);
    const int k1 = 16 * wave + cidx;
    for (int item = blockIdx.x; item < 1024; item += gridDim.x) {
        const int cb = item & 3, l2 = (item >> 2) & 127, b = item >> 9, ch0 = cb * 256;
#pragma unroll
        for (int j = 0; j < 2; ++j) { const int task = tid + 512 * j, cblk = task & 31, lb = task >> 5; u32x4 x[4];
#pragma unroll
            for (int r = 0; r < 4; ++r) x[r] = *(const u32x4*)(P + ((size_t)b * SEQ + 128 * (4 * lb + r) + l2) * PW + 3072 + ch0 + 8 * cblk);
            store_t4x8(XT, 8 * cblk, 4 * lb, x); }
        __syncthreads();
        const f32x2 tw = TW[l2 * k1];
        bf16* or_ = A1r + (((size_t)b * 128 + k1) * 128 + l2) * 1024 + ch0 + 4 * q; bf16* oi_ = A1i + (((size_t)b * 128 + k1) * 128 + l2) * 1024 + ch0 + 4 * q;
#pragma unroll 2
        for (int mt = 0; mt < 16; ++mt) {
            f32x4 cr = {0.f, 0.f, 0.f, 0.f}, cs = {0.f, 0.f, 0.f, 0.f};
#pragma unroll
            for (int ks = 0; ks < 4; ++ks) { const bf16x8 xa = *(const LAS bf16x8*)(XT + (16 * mt + cidx) * FLD + ks * 32 + 8 * q); cr = MFMA16(xa, fc[ks], cr); cs = MFMA16(xa, fs[ks], cs); }
            const f32x4 br = cr * tw.x - cs * tw.y, bi = -(cs * tw.x + cr * tw.y);
            u32x2 wr_; wr_.x = pk2(br[0], br[1]); wr_.y = pk2(br[2], br[3]); u32x2 wi_; wi_.x = pk2(bi[0], bi[1]); wi_.y = pk2(bi[2], bi[3]);
            *(u32x2*)(or_ + 16 * mt) = wr_; *(u32x2*)(oi_ + 16 * mt) = wi_;
        }
        __syncthreads();
    }
}
__device__ __forceinline__ void phase_f34(const Args& a, LAS unsigned char* lds) {
    const int tid = threadIdx.x, lane = tid & 63, wave = __builtin_amdgcn_readfirstlane(tid >> 6), q = lane >> 4, cidx = lane & 15;
    const bf16* A1r = (const bf16*)(a.ws + WS_FA); const bf16* A1i = (const bf16*)(a.ws + WS_FAI); bf16* Y = (bf16*)(a.ws + WS_YCAT);
    LAS bf16* XTr = (LAS bf16*)lds; LAS bf16* XTi = XTr + 128 * FLD; LAS bf16* XKr = XTi + 128 * FLD; LAS bf16* XKi = XKr + 128 * FLD;
    bf16x8 fc[4], fs[4]; load_dft_frags(a.ws, wave, lane, fc, fs);
    const float nrm = 1.0f / 1448.15468787005f;
    for (int item = blockIdx.x; item < 2048; item += gridDim.x) {
        const int g = item & 7, k1 = (item >> 3) & 127, b = item >> 10, ch0 = g * 128;
        { const int cblk = tid & 15, lb = tid >> 4; u32x4 xr[4], xi[4];
#pragma unroll
            for (int r = 0; r < 4; ++r) { const size_t off = (((size_t)b * 128 + k1) * 128 + 4 * lb + r) * 1024 + ch0 + 8 * cblk; xr[r] = *(const u32x4*)(A1r + off); xi[r] = *(const u32x4*)(A1i + off); }
            store_t4x8(XTr, 8 * cblk, 4 * lb, xr); store_t4x8(XTi, 8 * cblk, 4 * lb, xi); }
        __syncthreads();
        const int k2 = 16 * wave + cidx;
#pragma unroll 2
        for (int mt = 0; mt < 8; ++mt) {
            f32x4 a1 = {0.f, 0.f, 0.f, 0.f}, a2 = a1, b1 = a1, b2 = a1;
#pragma unroll
            for (int ks = 0; ks < 4; ++ks) { const bf16x8 xa = *(const LAS bf16x8*)(XTr + (16 * mt + cidx) * FLD + ks * 32 + 8 * q); const bf16x8 xb = *(const LAS bf16x8*)(XTi + (16 * mt + cidx) * FLD + ks * 32 + 8 * q);
                a1 = MFMA16(xa, fc[ks], a1); b2 = MFMA16(xa, fs[ks], b2); a2 = MFMA16(xb, fs[ks], a2); b1 = MFMA16(xb, fc[ks], b1); }
            const f32x4 xre = a1 + a2, xim = b1 - b2;
            u32x2 wr_; wr_.x = pk2(xre[0], xre[1]); wr_.y = pk2(xre[2], xre[3]); u32x2 wi_; wi_.x = pk2(xim[0], xim[1]); wi_.y = pk2(xim[2], xim[3]);
            *(LAS u32x2*)(XKr + k2 * FLD + 16 * mt + 4 * q) = wr_; *(LAS u32x2*)(XKi + k2 * FLD + 16 * mt + 4 * q) = wi_;
        }
        __syncthreads();
#pragma unroll 2
        for (int nt = 0; nt < 8; ++nt) {
            f32x4 y = {0.f, 0.f, 0.f, 0.f};
#pragma unroll
            for (int ks = 0; ks < 4; ++ks) { const bf16x8 xa = *(const LAS bf16x8*)(XKr + (16 * nt + cidx) * FLD + ks * 32 + 8 * q); const bf16x8 xb = *(const LAS bf16x8*)(XKi + (16 * nt + cidx) * FLD + ks * 32 + 8 * q);
                y = MFMA16(fc[ks], xa, y); y = MFMA16(fs[ks], xb, y); }
            const int lp = k1 + 128 * (16 * nt + cidx);
            u32x2 w; w.x = pk2(y[0] * nrm, y[1] * nrm); w.y = pk2(y[2] * nrm, y[3] * nrm);
            *(u32x2*)(Y + ((size_t)b * SEQ + lp) * DM + 1024 + ch0 + 16 * wave + 4 * q) = w;
        }
        __syncthreads();
    }
}

__device__ __forceinline__ void phase_norm2(const Args& a) {
    const int tid = threadIdx.x, lane = tid & 63, wave = tid >> 6;
    const int gw = blockIdx.x * 8 + wave, NGW = gridDim.x * 8;
    const float* ada = (const float*)(a.ws + WS_ADA); const float* g2n = a.in[14]; const float* wr = a.in[15];
    const float* XL = (const float*)(a.ws + WS_XL); bf16* HF = (bf16*)(a.ws + WS_HF); float* AFF = (float*)(a.ws + WS_AFF);
    for (int r = gw; r < NLAT; r += NGW) {
        const int b = r / SEQ, t = r % SEQ;
        const float* sh = ada + (size_t)b * 12288 + 3 * DM; const float* sc = sh + DM;
        const float* xr = XL + (size_t)r * DM;
        f32x4 x[8]; float ss = 0.f;
#pragma unroll
        for (int j = 0; j < 8; ++j) { x[j] = *(const f32x4*)(xr + 256 * j + 4 * lane); ss += (x[j].x * x[j].x + x[j].y * x[j].y) + (x[j].z * x[j].z + x[j].w * x[j].w); }
        const float rstd = rsqrtf(wave_sum(ss) * (1.f / DM) + EPS);
        float p[16];
#pragma unroll
        for (int e = 0; e < 16; ++e) p[e] = 0.f;
        u32x2* o = (u32x2*)(HF + (size_t)r * DM);
#pragma unroll
        for (int j = 0; j < 8; ++j) { const int d = 256 * j + 4 * lane; const f32x4 g = *(const f32x4*)(g2n + d), s1 = *(const f32x4*)(sc + d), s0 = *(const f32x4*)(sh + d);
            const f32x4 hh = (x[j] * rstd * g) * (s1 + 1.f) + s0;
            u32x2 w; w.x = pk2(hh.x, hh.y); w.y = pk2(hh.z, hh.w); o[64 * j + lane] = w;
#pragma unroll
            for (int jj = 0; jj < 4; ++jj) { const float hv = hh[jj]; const f32x4* wp = (const f32x4*)(wr + (size_t)(d + jj) * 16);
#pragma unroll
                for (int q = 0; q < 4; ++q) { const f32x4 wv = wp[q]; p[q * 4 + 0] += hv * wv.x; p[q * 4 + 1] += hv * wv.y; p[q * 4 + 2] += hv * wv.z; p[q * 4 + 3] += hv * wv.w; } } }
        float mx = -1e30f;
#pragma unroll
        for (int e = 0; e < 16; ++e) { p[e] = wave_sum(p[e]); mx = fmaxf(mx, p[e]); }
        float sum = 0.f;
#pragma unroll
        for (int e = 0; e < 16; ++e) { p[e] = expf(p[e] - mx); sum += p[e]; }
        float mine = 0.f;
#pragma unroll
        for (int e = 0; e < 16; ++e) mine = (lane == e) ? p[e] : mine;
        if (lane < 16) AFF[((size_t)b * NE + lane) * SEQ + t] = mine / sum;
    }
}

__device__ __forceinline__ void phase_topk(const Args& a, LAS unsigned char* lds) {
    const int tid = threadIdx.x;
    LAS unsigned* keys = (LAS unsigned*)lds;
    LAS unsigned* hist = (LAS unsigned*)(lds + 65536);
    LAS unsigned* misc = hist + 256;
    LAS unsigned* sg = misc + 16;
    LAS unsigned* se = sg + 512;
    const float* AFF = (const float*)(a.ws + WS_AFF); int* TOK = (int*)(a.ws + WS_TOK); float* GATE = (float*)(a.ws + WS_GATE); int* SEL = (int*)(a.ws + WS_SEL);
    for (int be = blockIdx.x; be < NB * NE; be += gridDim.x) {
        const int b = be / NE, e = be % NE;
        for (int i = tid; i < SEQ; i += NTHREADS) keys[i] = __float_as_uint(AFF[(size_t)be * SEQ + i]);
        unsigned prefix = 0u, pmask = 0u, krem = CAP;
        for (int pass = 0; pass < 4; ++pass) {
            const int shift = 24 - 8 * pass;
            if (tid < 256) hist[tid] = 0u;
            __syncthreads();
            for (int i = tid; i < SEQ; i += NTHREADS) { const unsigned k = keys[i]; if ((k & pmask) == prefix) atomicAdd((unsigned*)&hist[(k >> shift) & 255u], 1u); }
            __syncthreads();
            if (tid == 0) { unsigned cum = 0u; int bsel = 0;
                for (int bk = 255; bk >= 0; --bk) { const unsigned c = hist[bk]; if (cum + c >= krem) { bsel = bk; break; } cum += c; }
                misc[0] = prefix | ((unsigned)bsel << shift); misc[1] = krem - cum; }
            __syncthreads();
            prefix = misc[0]; krem = misc[1]; pmask |= (0xffu << shift);
            __syncthreads();
        }
        const unsigned T = prefix;
        unsigned cg_ = 0u, ce = 0u;
        for (int i = 0; i < 32; ++i) { const unsigned k = keys[tid * 32 + i]; cg_ += (k > T); ce += (k == T); }
        sg[tid] = cg_; se[tid] = ce;
        __syncthreads();
        if (tid == 0) { unsigned rg = 0u, re = 0u; for (int i = 0; i < NTHREADS; ++i) { const unsigned x = sg[i], y = se[i]; sg[i] = rg; se[i] = re; rg += x; re += y; } }
        __syncthreads();
        unsigned gt_before = sg[tid], eq_before = se[tid];
        for (int i = 0; i < 32; ++i) { const int t = tid * 32 + i; const unsigned k = keys[t];
            const bool isgt = k > T, iseq = k == T; const bool take = isgt || (iseq && eq_before < krem);
            const unsigned slot = gt_before + (eq_before < krem ? eq_before : krem);
            if (take) { TOK[(size_t)be * CAP + slot] = t; GATE[(size_t)be * CAP + slot] = __uint_as_float(k); }
            SEL[((size_t)b * SEQ + t) * NE + e] = take ? (int)slot : -1;
            gt_before += isgt; eq_before += iseq; }
        __syncthreads();
    }
}

__device__ __forceinline__ void phase_final(const Args& a) {
    const int tid = threadIdx.x, lane = tid & 63, wave = tid >> 6;
    const int gw = blockIdx.x * 8 + wave, NGW = gridDim.x * 8;
    const float* ada = (const float*)(a.ws + WS_ADA); const float* fg = a.in[19];
    const float* XL = (const float*)(a.ws + WS_XL); const bf16* YE = (const bf16*)(a.ws + WS_YE);
    const float* GATE = (const float*)(a.ws + WS_GATE); const int* SEL = (const int*)(a.ws + WS_SEL);
    for (int r = gw; r < NLAT; r += NGW) {
        const int b = r / SEQ;
        const float* g2 = ada + (size_t)b * 12288 + 5 * DM;
        f32x4 m[8];
#pragma unroll
        for (int j = 0; j < 8; ++j) m[j] = (f32x4){0.f, 0.f, 0.f, 0.f};
        for (int e = 0; e < NE; ++e) { const int s = SEL[(size_t)r * NE + e];
            if (s >= 0) { const float gt = GATE[((size_t)b * NE + e) * CAP + s]; const bf16* yr = YE + ((size_t)(e * 2 + b) * CAP + s) * DM;
#pragma unroll
                for (int j = 0; j < 8; ++j) { const u32x2 w = *(const u32x2*)(yr + 256 * j + 4 * lane);
                    m[j].x += gt * __uint_as_float(w.x << 16); m[j].y += gt * __uint_as_float(w.x & 0xffff0000u); m[j].z += gt * __uint_as_float(w.y << 16); m[j].w += gt * __uint_as_float(w.y & 0xffff0000u); } } }
        float ss = 0.f;
#pragma unroll
        for (int j = 0; j < 8; ++j) { const int d = 256 * j + 4 * lane; const f32x4 xv = *(const f32x4*)(XL + (size_t)r * DM + d), gv = *(const f32x4*)(g2 + d);
            m[j] = xv + gv * m[j]; ss += (m[j].x * m[j].x + m[j].y * m[j].y) + (m[j].z * m[j].z + m[j].w * m[j].w); }
        const float rstd = rsqrtf(wave_sum(ss) * (1.f / DM) + EPS);
#pragma unroll
        for (int j = 0; j < 8; ++j) { const int d = 256 * j + 4 * lane; const f32x4 gv = *(const f32x4*)(fg + d);
            *(f32x4*)(a.out + (size_t)r * DM + d) = m[j] * rstd * gv; }
    }
}

constexpr int NPHASES = 15;
__global__ void __launch_bounds__(NTHREADS, 2) mega(Args a) {
    extern __shared__ __attribute__((aligned(16))) unsigned char lds_raw[];
    LAS unsigned char* lds = (LAS unsigned char*)lds_raw;
    cg::grid_group grid = cg::this_grid();
    const int lo = a.ph_lo, hi = a.ph_hi;
    unsigned char* ws = a.ws;
#define IN(k) (lo <= (k) && (k) < hi)
#define SEAM(k) do { if (IN(k) && IN((k) + 1)) grid.sync(); } while (0)
    if (IN(0)) phase0(a, lds);
    SEAM(0);
    if (IN(1)) phase1(a);
    SEAM(1);
    if (IN(2)) {
        SchedPlain S; S.init(NROWS / 256, WIN_ROWS / 256, gridDim.x, blockIdx.x); S.A = (const char*)(ws + WS_H); S.B = (const char*)(ws + WS_WIN); S.tstep = (size_t)256 * DM * 2;
        EpiInProj E{(bf16*)(ws + WS_P), (float*)(ws + WS_Z)};
        pg8::gemm_phase<EpiInProj, SchedPlain, false, true, true>(lds, DM, S, E);
    }
    SEAM(2);
    if (IN(3)) { for (int it = blockIdx.x; it < 272; it += gridDim.x) gla_passA(a, lds, it); }
    SEAM(3);
    if (IN(4)) gla_passB(a);
    SEAM(4);
    if (IN(5)) { for (int it = blockIdx.x; it < 256; it += gridDim.x) gla_passC(a, lds, it); }
    SEAM(5);
    if (IN(6)) phase_gla_merge(a);
    SEAM(6);
    if (IN(7)) phase_f1(a, lds);
    SEAM(7);
    if (IN(8)) phase_f34(a, lds);
    SEAM(8);
    if (IN(9)) {
        SchedPlain S; S.init(NLAT / 256, DM / 256, gridDim.x, blockIdx.x); S.A = (const char*)(ws + WS_YCAT); S.B = (const char*)(ws + WS_WOUT); S.tstep = (size_t)256 * DM * 2;
        EpiOutProj E{a.in[0], (float*)(ws + WS_XL), (const float*)(ws + WS_ADA)};
        pg8::gemm_phase<EpiOutProj, SchedPlain, false, true, true>(lds, DM, S, E);
    }
    SEAM(9);
    if (IN(10)) phase_norm2(a);
    SEAM(10);
    if (IN(11)) phase_topk(a, lds);
    SEAM(11);
    if (IN(12)) {
        SchedMoeUp S; S.init(256, 8, gridDim.x, blockIdx.x); S.A = (const char*)(ws + WS_HF); S.B = (const char*)(ws + WS_WGU); S.tok = (const int*)(ws + WS_TOK);
        EpiSwiglu E{(bf16*)(ws + WS_HID)};
        pg8::gemm_phase<EpiSwiglu, SchedMoeUp, true, true, true>(lds, DM, S, E);
    }
    SEAM(12);
    if (IN(13)) {
        SchedMoeDown S; S.init(256, 8, gridDim.x, blockIdx.x); S.A = (const char*)(ws + WS_HID); S.B = (const char*)(ws + WS_WD);
        EpiBf16 E{(bf16*)(ws + WS_YE), DM};
        pg8::gemm_phase<EpiBf16, SchedMoeDown, false, true, true>(lds, DEXP, S, E);
    }
    SEAM(13);
    if (IN(14)) phase_final(a);
#undef IN
#undef SEAM
}

#ifndef N_LAUNCH_MODE
#define N_LAUNCH_MODE 1
#endif
extern "C" void kernel_launch(void* const* d_in, const int* in_sizes, int n_in, void* d_out, int out_size, void* d_ws, size_t ws_size, hipStream_t stream) {
    static int grid = 0;
    if (grid == 0) {
        if (n_in != 20 || out_size != NLAT * DM || ws_size < WS_END) { fprintf(stderr, "kernel_launch: unexpected sizes n_in %d out %d ws %zu\n", n_in, out_size, ws_size); grid = -1; return; }
        int dev = 0, cus = 0, per_cu = 0;
        (void)hipGetDevice(&dev); (void)hipDeviceGetAttribute(&cus, hipDeviceAttributeMultiprocessorCount, dev);
        if (hipFuncSetAttribute((const void*)mega, hipFuncAttributeMaxDynamicSharedMemorySize, LDS_BYTES) != hipSuccess) { fprintf(stderr, "kernel_launch: hipFuncSetAttribute failed\n"); grid = -1; return; }
        (void)hipOccupancyMaxActiveBlocksPerMultiprocessor(&per_cu, (const void*)mega, NTHREADS, LDS_BYTES);
        if (per_cu < 1) { fprintf(stderr, "kernel_launch: occupancy query reports %d blocks per CU\n", per_cu); per_cu = 1; }
        (void)hipGetLastError();
        grid = cus * 1;
    }
    if (grid < 0) return;
    Args a{};
    for (int i = 0; i < 20; ++i) a.in[i] = (const float*)d_in[i];
    a.out = (float*)d_out; a.ws = (unsigned char*)d_ws;
#if N_LAUNCH_MODE == 0
    for (int p = 0; p < NPHASES; ++p) { a.ph_lo = p; a.ph_hi = p + 1; hipLaunchKernelGGL(mega, dim3(grid), dim3(NTHREADS), LDS_BYTES, stream, a); }
#else
    a.ph_lo = 0; a.ph_hi = NPHASES;
    void* args[] = {&a};
    hipError_t e = hipLaunchCooperativeKernel((void*)mega, dim3(grid), dim3(NTHREADS), args, LDS_BYTES, stream);
    if (e != hipSuccess) fprintf(stderr, "cooperative launch failed: %s (grid %d)\n", hipGetErrorString(e), grid);
#endif
}
```

```cpp
#include <hip/hip_runtime.h>
#include <hip/hip_cooperative_groups.h>
#include <cstdio>
#include <cstdint>
namespace cg = cooperative_groups;

#define LAS __attribute__((address_space(3)))
typedef unsigned short bf16;
typedef short bf16x8 __attribute__((ext_vector_type(8)));
typedef float f32x4 __attribute__((ext_vector_type(4)));
typedef float f32x2 __attribute__((ext_vector_type(2)));
typedef unsigned u32x4 __attribute__((ext_vector_type(4)));
typedef unsigned u32x2 __attribute__((ext_vector_type(2)));

constexpr int NB = 2, SEQ = 16384, DM = 2048, CTXL = 256;
constexpr int NLAT = NB * SEQ;
constexpr int NROWS = NLAT + NB * CTXL;
constexpr int PROJW = 4128;
constexpr int NE = 16, CAP = 2048, DEXP = 1024;
constexpr int PW = 4096;
constexpr int WIN_ROWS = 4096;
constexpr float EPS = 1e-6f;

constexpr size_t MiB = 1u << 20;
constexpr size_t WS_ADA = 0;
constexpr size_t WS_TW = 1 * MiB;
constexpr size_t WS_FC = 1 * MiB + 256 * 1024;
constexpr size_t WS_FS = 1 * MiB + 320 * 1024;
constexpr size_t WS_WRH = 1 * MiB + 384 * 1024;
constexpr size_t WS_WRL = 1 * MiB + 448 * 1024;
constexpr size_t WS_Z = 2 * MiB;
constexpr size_t WS_AFF = 8 * MiB;
constexpr size_t WS_TOK = 10 * MiB;
constexpr size_t WS_GATE = 11 * MiB;
constexpr size_t WS_SEL = 12 * MiB;
constexpr size_t WS_ST0 = 14 * MiB;
constexpr size_t WS_CTL = 16 * MiB;
constexpr size_t CTL_BYTES = 65536;
constexpr size_t WS_WIN = 32 * MiB;
constexpr size_t WS_WOUT = 50 * MiB;
constexpr size_t WS_WGU = 58 * MiB;
constexpr size_t WS_WD = 186 * MiB;
constexpr size_t WS_P = 250 * MiB;
constexpr size_t WS_HF = 250 * MiB;
constexpr size_t WS_HID = 378 * MiB;
constexpr size_t WS_FX = 250 * MiB;
constexpr size_t WS_FA = 510 * MiB;
constexpr size_t WS_FAI = 574 * MiB;
constexpr size_t WS_H = 510 * MiB;
constexpr size_t WS_OF = 510 * MiB;
constexpr size_t WS_OB = 574 * MiB;
constexpr size_t WS_T = 638 * MiB;
constexpr size_t WS_SST = 670 * MiB;
constexpr size_t WS_DT = 702 * MiB;
constexpr size_t WS_XL = 510 * MiB;
constexpr size_t WS_YCAT = 766 * MiB;
constexpr size_t WS_YE = 766 * MiB;
constexpr size_t WS_END = 1022 * MiB;

#ifndef USE_CG_SYNC
#define USE_CG_SYNC 0
#endif
#ifndef PROBE_MASK
#define PROBE_MASK 0u
#endif
constexpr int LDS_BYTES = 163840;
constexpr int NTHREADS = 512;

struct Args {
    const float* in[20];
    float* out;
    unsigned char* ws;
    int ph_lo, ph_hi;
};

__device__ __forceinline__ float bf2f(bf16 v) { return __uint_as_float(((unsigned)v) << 16); }
typedef __bf16 bf16x2_t __attribute__((ext_vector_type(2)));
__device__ __forceinline__ unsigned pk2(float lo, float hi) { const f32x2 v = {lo, hi}; return __builtin_bit_cast(unsigned, __builtin_convertvector(v, bf16x2_t)); }
__device__ __forceinline__ unsigned f2bf(float f) { return pk2(f, 0.f) & 0xffffu; }
__device__ __forceinline__ float wave_sum(float v) {
#pragma unroll
    for (int o = 1; o < 64; o <<= 1) v += __shfl_xor(v, o);
    return v;
}
__device__ __forceinline__ float silu_f(float x) { return x / (1.f + __expf(-x)); }
__device__ __forceinline__ float logsigmoid_f(float x) { return fminf(x, 0.f) - log1pf(expf(-fabsf(x))); }

namespace pg8 {
constexpr int BM = 256, BK = 64, HALF = 128, HTB = HALF * BK * 2, STAGE_BYTES = 8 * HTB, NXCD = 8, WGM = 8;
__host__ __device__ __forceinline__ int lds_byte(int r, int c) { const int st = (r >> 4) * 2 + (c >> 5), rr = r & 15, cc = c & 31, ob = rr * 64 + cc * 2; return st * 1024 + (ob ^ (((ob >> 9) & 1) << 5)); }
__host__ __device__ __forceinline__ void stage_rc(int b, int& R, int& C) { const int st = b / 1024, sb = b % 1024, swz = sb ^ (((sb >> 9) & 1) << 5); R = (st >> 1) * 16 + swz / 64; C = (st & 1) * 32 + (swz % 64) / 2; }
__host__ __device__ __forceinline__ int perm32(int rho) { const int n = rho >> 4, i = rho & 15; return 8 * (i >> 2) + 4 * n + (i & 3); }
struct Unit { int pm, pn; };
__device__ __forceinline__ unsigned cvt_pk_bf16(float lo, float hi) { return pk2(lo, hi); }

struct OrderBase {
    int nM, nN, nwg, G, c;
    __device__ void init(int nM_, int nN_, int G_, int c_) { nM = nM_; nN = nN_; nwg = nM * nN; G = G_; c = c_; }
    __device__ bool next(int i, Unit& u) const {
        const long L = (long)i * G + c; if (L >= nwg) return false;
        int wgid = (int)L; { const int q = nwg / NXCD, r = nwg % NXCD, xcd = wgid % NXCD, off = wgid / NXCD; wgid = (xcd < r ? xcd * (q + 1) : r * (q + 1) + (xcd - r) * q) + off; }
        const int nig = WGM * nN, gid = wgid / nig, fm = gid * WGM, gsz = (nM - fm) < WGM ? (nM - fm) : WGM;
        u.pm = fm + ((wgid % nig) % gsz); u.pn = (wgid % nig) / gsz; return true;
    }
};

template <class Epi, class Sched, bool GATHER, bool ALIGN_EPI, bool SP2>
__device__ __forceinline__ void gemm_phase(LAS unsigned char* lds, const int K, const Sched& S, const Epi& E) {
    const int tid = threadIdx.x, wid = __builtin_amdgcn_readfirstlane(tid >> 6), lane = tid & 63, wr = wid >> 2, wc = wid & 3, fr = lane & 15, fq = lane >> 4;
    const int nt = K / BK;
    unsigned voffA[2], voffA1[2], voffB[2];
    int RA[2], CA[2];
#pragma unroll
    for (int i = 0; i < 2; ++i) { int R, C; stage_rc(tid * 16 + i * 8192, R, C); const int Rb = Epi::PERM ? ((R & ~31) + perm32(R & 31)) : R;
        RA[i] = R; CA[i] = C;
        voffA[i] = (unsigned)(R * K + C) * 2u; voffA1[i] = voffA[i]; voffB[i] = (unsigned)(Rb * K + C) * 2u; }
    const size_t kstep = (size_t)(BK * 2);
    const size_t hstep = (size_t)HALF * K * 2;
    const size_t hstepA = GATHER ? 0 : hstep;
    const unsigned ldsw = (unsigned)wid * 1024u;
    const int aoff = lds_byte(wr * 64 + fr, fq * 8), boff = lds_byte(wc * 32 + fr, fq * 8);
#define PG8_SA(b, h) (((b) * 2 + (h)) * HTB)
#define PG8_SB(b, h) ((4 + (b) * 2 + (h)) * HTB)
#define PG8_STAGE(bufoff, gbase, voff) do { _Pragma("unroll") for (int _i = 0; _i < 2; ++_i) \
        __builtin_amdgcn_global_load_lds((const unsigned*)((const char*)(gbase) + (voff)[_i]), (LAS unsigned*)(lds + (bufoff) + ldsw + _i * 8192), 16, 0, 0); } while (0)
#define PG8_LDA(dst, b, h) do { _Pragma("unroll") for (int m = 0; m < 4; ++m) _Pragma("unroll") for (int k = 0; k < 2; ++k) dst[m][k] = *(const LAS bf16x8*)(lds + PG8_SA(b, h) + aoff + m * 2048 + k * 1024); } while (0)
#define PG8_LDB(dst, b, h) do { _Pragma("unroll") for (int n = 0; n < 2; ++n) _Pragma("unroll") for (int k = 0; k < 2; ++k) dst[n][k] = *(const LAS bf16x8*)(lds + PG8_SB(b, h) + boff + n * 2048 + k * 1024); } while (0)
#define PG8_MMA(ai, bj, At, Bt) do { __builtin_amdgcn_s_setprio(1); _Pragma("unroll") for (int m = 0; m < 4; ++m) _Pragma("unroll") for (int n = 0; n < 2; ++n) _Pragma("unroll") for (int k = 0; k < 2; ++k) \
        acc[ai][bj][m][n] = __builtin_amdgcn_mfma_f32_16x16x32_bf16(Bt[n][k], At[m][k], acc[ai][bj][m][n], 0, 0, 0); __builtin_amdgcn_s_setprio(0); } while (0)
#define PG8_WAIT_V(n) asm volatile("s_waitcnt vmcnt(" #n ")" ::: "memory")
#define PG8_WAIT_L(n) asm volatile("s_waitcnt lgkmcnt(" #n ")" ::: "memory")
#define PG8_BAR __builtin_amdgcn_s_barrier()
#define PG8_SCHED __builtin_amdgcn_sched_barrier(0)
    Unit cur, nxt; int ui = 0;
    if (!S.next(0, cur)) return;
    f32x4 acc[2][2][4][2];
#pragma unroll
    for (int a = 0; a < 2; ++a)
#pragma unroll
        for (int b = 0; b < 2; ++b)
#pragma unroll
            for (int m = 0; m < 4; ++m)
#pragma unroll
                for (int n = 0; n < 2; ++n) acc[a][b][m][n] = (f32x4){0.f, 0.f, 0.f, 0.f};
    bf16x8 At[4][2], B0[2][2], B1[2][2];
    const char* cA = S.abase(cur); const char* cB = S.bbase(cur);
    if constexpr (GATHER) {
#pragma unroll
        for (int i = 0; i < 2; ++i) { voffA[i] = ((unsigned)S.arow(cur, RA[i]) * (unsigned)K + (unsigned)CA[i]) * 2u; voffA1[i] = ((unsigned)S.arow(cur, HALF + RA[i]) * (unsigned)K + (unsigned)CA[i]) * 2u; }
    }
    static_assert(SP2, "only the SP2 loop is kept");
    PG8_STAGE(PG8_SB(0, 0), cB, voffB); PG8_STAGE(PG8_SB(0, 1), cB + hstep, voffB); PG8_STAGE(PG8_SA(0, 0), cA, voffA); PG8_STAGE(PG8_SA(0, 1), cA + hstepA, voffA1);
    if (wr == 1) PG8_BAR;
    PG8_WAIT_V(2); PG8_BAR;
    PG8_STAGE(PG8_SB(1, 0), cB + kstep, voffB); PG8_STAGE(PG8_SA(1, 0), cA + kstep, voffA); PG8_STAGE(PG8_SB(1, 1), cB + hstep + kstep, voffB);
    PG8_WAIT_V(6); PG8_BAR;
    for (;;) {
        const bool has_next = S.next(ui + 1, nxt);
        const char* nA = has_next ? S.abase(nxt) : cA; const char* nB = has_next ? S.bbase(nxt) : cB;
        for (int t = 0; t < nt; t += 2) {
            const bool last = (t == nt - 2);
            const char* a1 = cA + (size_t)(t + 1) * kstep;
            const char* a2 = last ? nA : cA + (size_t)(t + 2) * kstep; const char* b2 = last ? nB : cB + (size_t)(t + 2) * kstep;
            const char* a3 = a2 + kstep; const char* b3 = b2 + kstep;
            PG8_LDB(B0, 0, 0); PG8_LDB(B1, 0, 1); PG8_SCHED; PG8_LDA(At, 0, 0); PG8_STAGE(PG8_SA(1, 1), a1 + hstepA, voffA1);
            if constexpr (GATHER) { if (last && has_next) {
#pragma unroll
                for (int i = 0; i < 2; ++i) { voffA[i] = ((unsigned)S.arow(nxt, RA[i]) * (unsigned)K + (unsigned)CA[i]) * 2u; voffA1[i] = ((unsigned)S.arow(nxt, HALF + RA[i]) * (unsigned)K + (unsigned)CA[i]) * 2u; } } }
            PG8_WAIT_V(8); PG8_WAIT_L(0); PG8_BAR; PG8_MMA(0, 0, At, B0); PG8_MMA(0, 1, At, B1); PG8_BAR; PG8_SCHED;
            PG8_LDA(At, 0, 1); PG8_STAGE(PG8_SB(0, 0), b2, voffB); PG8_STAGE(PG8_SB(0, 1), b2 + hstep, voffB); PG8_STAGE(PG8_SA(0, 0), a2, voffA);
            PG8_WAIT_V(8); PG8_WAIT_L(0); PG8_BAR; PG8_MMA(1, 0, At, B0); PG8_MMA(1, 1, At, B1); PG8_BAR; PG8_SCHED;
            PG8_LDB(B0, 1, 0); PG8_LDB(B1, 1, 1); PG8_SCHED; PG8_LDA(At, 1, 0); PG8_STAGE(PG8_SA(0, 1), a2 + hstepA, voffA1);
            PG8_WAIT_V(8); PG8_WAIT_L(0); PG8_BAR; PG8_MMA(0, 0, At, B0); PG8_MMA(0, 1, At, B1); PG8_BAR; PG8_SCHED;
            PG8_LDA(At, 1, 1); PG8_STAGE(PG8_SB(1, 0), b3, voffB); PG8_STAGE(PG8_SB(1, 1), b3 + hstep, voffB); PG8_STAGE(PG8_SA(1, 0), a3, voffA);
            PG8_WAIT_V(8); PG8_WAIT_L(0); PG8_BAR; PG8_MMA(1, 0, At, B0); PG8_MMA(1, 1, At, B1); PG8_BAR; PG8_SCHED;
        }
        if constexpr (ALIGN_EPI) { if (wr == 0) PG8_BAR; }
        E(acc, cur, wr, wc, fr, fq);
        if (!has_next) break;
#pragma unroll
        for (int a = 0; a < 2; ++a)
#pragma unroll
            for (int b = 0; b < 2; ++b)
#pragma unroll
                for (int m = 0; m < 4; ++m)
#pragma unroll
                    for (int n = 0; n < 2; ++n) acc[a][b][m][n] = (f32x4){0.f, 0.f, 0.f, 0.f};
        cur = nxt; cA = nA; cB = nB; ++ui;
        if constexpr (ALIGN_EPI) { if (wr == 1) PG8_BAR; }
    }
    PG8_WAIT_V(0);
    if constexpr (!ALIGN_EPI) { if (wr == 0) PG8_BAR; }
    PG8_BAR;
#undef PG8_SA
#undef PG8_SB
#undef PG8_STAGE
#undef PG8_LDA
#undef PG8_LDB
#undef PG8_MMA
#undef PG8_WAIT_V
#undef PG8_WAIT_L
#undef PG8_BAR
#undef PG8_SCHED
}
}
using pg8::Unit;
using pg8::cvt_pk_bf16;
constexpr int HALF = pg8::HALF, BM = pg8::BM;

struct SchedPlain : pg8::OrderBase {
    const char* A; const char* B; size_t tstep;
    __device__ __forceinline__ const char* abase(const Unit& u) const { return A + (size_t)u.pm * tstep; }
    __device__ __forceinline__ const char* bbase(const Unit& u) const { return B + (size_t)u.pn * tstep; }
    __device__ __forceinline__ int arow(const Unit&, int) const { return 0; }
};
struct SchedMoeUp : pg8::OrderBase {
    const char* A; const char* B; const int* tok;
    __device__ __forceinline__ const char* abase(const Unit&) const { return A; }
    __device__ __forceinline__ const char* bbase(const Unit& u) const { return B + ((size_t)(u.pm >> 4) * 2048 + (size_t)u.pn * 256) * (size_t)(DM * 2); }
    __device__ __forceinline__ int arow(const Unit& u, int r) const { const int e = u.pm >> 4, b = (u.pm >> 3) & 1, mt = u.pm & 7; return b * SEQ + tok[(b * NE + e) * CAP + mt * 256 + r]; }
};
struct SchedMoeDown : pg8::OrderBase {
    const char* A; const char* B;
    __device__ __forceinline__ const char* abase(const Unit& u) const { return A + (size_t)u.pm * 256 * (size_t)(DEXP * 2); }
    __device__ __forceinline__ const char* bbase(const Unit& u) const { return B + ((size_t)(u.pm >> 4) * 2048 + (size_t)u.pn * 256) * (size_t)(DEXP * 2); }
    __device__ __forceinline__ int arow(const Unit&, int) const { return 0; }
};

struct EpiInProj {
    static constexpr bool PERM = true;
    bf16* P;
    __device__ __forceinline__ void operator()(const f32x4 (&acc)[2][2][4][2], const Unit& u, int wr, int wc, int fr, int fq) const {
        const int row0 = u.pm * BM + wr * 64 + fr, col0 = u.pn * BM + wc * 32 + 8 * fq;
#pragma unroll
        for (int ai = 0; ai < 2; ++ai)
#pragma unroll
            for (int m = 0; m < 4; ++m) { bf16* rowp = P + (size_t)(row0 + ai * HALF + m * 16) * PW + col0;
#pragma unroll
                for (int bj = 0; bj < 2; ++bj) { const f32x4 v0 = acc[ai][bj][m][0], v1 = acc[ai][bj][m][1];
                    u32x4 w; w.x = cvt_pk_bf16(v0[0], v0[1]); w.y = cvt_pk_bf16(v0[2], v0[3]); w.z = cvt_pk_bf16(v1[0], v1[1]); w.w = cvt_pk_bf16(v1[2], v1[3]);
                    *(u32x4*)(rowp + bj * HALF) = w; } }
    }
};
struct EpiOutProj {
    static constexpr bool PERM = false;
    const float* X; float* XL; const float* ada;
    __device__ __forceinline__ void operator()(const f32x4 (&acc)[2][2][4][2], const Unit& u, int wr, int wc, int fr, int fq) const {
        const int row0 = u.pm * BM + wr * 64 + fr, col0 = u.pn * BM + wc * 32 + 4 * fq;
        const int b = (u.pm * BM) / SEQ;
        const float* g1 = ada + (size_t)b * 12288 + 2 * DM;
        f32x4 gv[2][2];
#pragma unroll
        for (int bj = 0; bj < 2; ++bj)
#pragma unroll
            for (int n = 0; n < 2; ++n) gv[bj][n] = *(const f32x4*)(g1 + col0 + bj * HALF + n * 16);
#pragma unroll
        for (int ai = 0; ai < 2; ++ai)
#pragma unroll
            for (int m = 0; m < 4; ++m) { const size_t off = (size_t)(row0 + ai * HALF + m * 16) * DM + col0;
#pragma unroll
                for (int bj = 0; bj < 2; ++bj)
#pragma unroll
                    for (int n = 0; n < 2; ++n) { const f32x4 xv = *(const f32x4*)(X + off + bj * HALF + n * 16);
                        *(f32x4*)(XL + off + bj * HALF + n * 16) = xv + gv[bj][n] * acc[ai][bj][m][n]; }
                asm volatile("" ::: "memory"); }
    }
};
struct EpiSwiglu {
    static constexpr bool PERM = true;
    bf16* HID;
    __device__ __forceinline__ void operator()(const f32x4 (&acc)[2][2][4][2], const Unit& u, int wr, int wc, int fr, int fq) const {
        const int row0 = u.pm * BM + wr * 64 + fr, col0 = u.pn * 128 + wc * 32 + 8 * fq;
#pragma unroll
        for (int ai = 0; ai < 2; ++ai)
#pragma unroll
            for (int m = 0; m < 4; ++m) { bf16* rowp = HID + (size_t)(row0 + ai * HALF + m * 16) * DEXP + col0;
                f32x4 h0, h1;
#pragma unroll
                for (int j = 0; j < 4; ++j) { h0[j] = silu_f(acc[ai][0][m][0][j]) * acc[ai][1][m][0][j]; h1[j] = silu_f(acc[ai][0][m][1][j]) * acc[ai][1][m][1][j]; }
                u32x4 w; w.x = cvt_pk_bf16(h0[0], h0[1]); w.y = cvt_pk_bf16(h0[2], h0[3]); w.z = cvt_pk_bf16(h1[0], h1[1]); w.w = cvt_pk_bf16(h1[2], h1[3]);
                *(u32x4*)(rowp) = w; }
    }
};
struct EpiBf16 {
    static constexpr bool PERM = true;
    bf16* O; int ldc;
    __device__ __forceinline__ void operator()(const f32x4 (&acc)[2][2][4][2], const Unit& u, int wr, int wc, int fr, int fq) const {
        const int row0 = u.pm * BM + wr * 64 + fr, col0 = u.pn * BM + wc * 32 + 8 * fq;
#pragma unroll
        for (int ai = 0; ai < 2; ++ai)
#pragma unroll
            for (int m = 0; m < 4; ++m) { bf16* rowp = O + (size_t)(row0 + ai * HALF + m * 16) * ldc + col0;
#pragma unroll
                for (int bj = 0; bj < 2; ++bj) { const f32x4 v0 = acc[ai][bj][m][0], v1 = acc[ai][bj][m][1];
                    u32x4 w; w.x = cvt_pk_bf16(v0[0], v0[1]); w.y = cvt_pk_bf16(v0[2], v0[3]); w.z = cvt_pk_bf16(v1[0], v1[1]); w.w = cvt_pk_bf16(v1[2], v1[3]);
                    *(u32x4*)(rowp + bj * HALF) = w; } }
    }
};

__device__ __forceinline__ void transpose_item(const float* src, int ldsrc, int scol0, int k0, bf16* dst, size_t drow0, int ldd, LAS float* scr, int lane) {
#pragma unroll 8
    for (int i = 0; i < 32; ++i) { const int kk = 2 * i + (lane >> 5); scr[kk * 33 + (lane & 31)] = src[(size_t)(k0 + kk) * ldsrc + scol0 + (lane & 31)]; }
    asm volatile("s_waitcnt lgkmcnt(0)" ::: "memory");
    const int c = lane & 7;
#pragma unroll
    for (int j = 0; j < 4; ++j) { const int n = (lane >> 3) + 8 * j; const LAS float* s = scr + (8 * c) * 33 + n;
        u32x4 o; o.x = pk2(s[0 * 33], s[1 * 33]); o.y = pk2(s[2 * 33], s[3 * 33]); o.z = pk2(s[4 * 33], s[5 * 33]); o.w = pk2(s[6 * 33], s[7 * 33]);
        *(u32x4*)(dst + (drow0 + n) * (size_t)ldd + k0 + 8 * c) = o; }
    asm volatile("s_waitcnt lgkmcnt(0)" ::: "memory");
}

__device__ __forceinline__ void phase0(const Args& a, LAS unsigned char* lds) {
    const int tid = threadIdx.x, lane = tid & 63, wave = tid >> 6, G = gridDim.x, blk = blockIdx.x;
    unsigned char* ws = a.ws;
    {
        const float* c = a.in[1]; const float* cc = a.in[3]; const float* w_ada = a.in[4]; const float* b_ada = a.in[5];
        float* ada = (float*)(ws + WS_ADA);
        LAS float* red = (LAS float*)lds;
        for (int it = blk; it < 96; it += G) {
            const int col0 = it * 128 + 2 * lane;
            float a0x = 0, a0y = 0, a1x = 0, a1y = 0, a2x = 0, a2y = 0;
            const int r0 = wave * 256;
#pragma unroll 8
            for (int r = r0; r < r0 + 256; ++r) {
                const f32x2 w = *(const f32x2*)(w_ada + (size_t)r * 12288 + col0);
                const float s0 = silu_f(c[r]), s1 = silu_f(c[DM + r]), s2 = silu_f(cc[r]);
                a0x += s0 * w.x; a0y += s0 * w.y; a1x += s1 * w.x; a1y += s1 * w.y; a2x += s2 * w.x; a2y += s2 * w.y;
            }
            red[(wave * 3 + 0) * 128 + 2 * lane] = a0x; red[(wave * 3 + 0) * 128 + 2 * lane + 1] = a0y;
            red[(wave * 3 + 1) * 128 + 2 * lane] = a1x; red[(wave * 3 + 1) * 128 + 2 * lane + 1] = a1y;
            red[(wave * 3 + 2) * 128 + 2 * lane] = a2x; red[(wave * 3 + 2) * 128 + 2 * lane + 1] = a2y;
            __syncthreads();
            if (tid < 384) { const int v = tid >> 7, col = tid & 127; float s = b_ada[it * 128 + col];
                for (int w8 = 0; w8 < 8; ++w8) s += red[(w8 * 3 + v) * 128 + col];
                ada[v * 12288 + it * 128 + col] = s; }
            __syncthreads();
        }
    }
    LAS float* scr = (LAS float*)(lds + wave * 16384);
    const int gw = blk * 8 + wave, NGW = G * 8;
    constexpr int I_WIN = 32 * 129, I_ZERO = 512, I_WOUT = 32 * 64, I_WG = 16 * 32 * 32, I_WU = I_WG, I_WD = 16 * 16 * 64, I_TW = 256, I_FT = 256;
    constexpr int I_TOTAL = I_WIN + I_ZERO + I_WOUT + I_WG + I_WU + I_WD + I_TW + I_FT;
    bf16* Win = (bf16*)(ws + WS_WIN); bf16* Wout = (bf16*)(ws + WS_WOUT); bf16* Wgu = (bf16*)(ws + WS_WGU); bf16* Wd = (bf16*)(ws + WS_WD);
    for (int it = gw; it < I_TOTAL; it += NGW) {
        int r = it;
        if (r < I_WIN) { const int kb = r / 129, nb = r % 129, n0 = nb * 32;
            const size_t drow = n0 < 3072 ? (size_t)n0 : (n0 < 3104 ? (size_t)(4096 + n0 - 3072) : (size_t)(3072 + n0 - 3104));
            transpose_item(a.in[7], PROJW, n0, kb * 64, Win, drow, DM, scr, lane); continue; }
        r -= I_WIN;
        if (r < I_ZERO) { const int p = r * 64 + lane, e = p >> 11, d = p & 2047; const float wv = a.in[15][d * 16 + e]; const unsigned hi = f2bf(wv); ((bf16*)(ws + WS_WRH))[p] = (bf16)hi; ((bf16*)(ws + WS_WRL))[p] = (bf16)f2bf(wv - bf2f((bf16)hi)); continue; }
        r -= I_ZERO;
        if (r < I_WOUT) { const int kb = r / 64, nb = r % 64; transpose_item(a.in[13], DM, nb * 32, kb * 64, Wout, (size_t)nb * 32, DM, scr, lane); continue; }
        r -= I_WOUT;
        if (r < I_WG + I_WU) { const int up = r >= I_WG; if (up) r -= I_WG; const int e = r / 1024, rr = r % 1024, kb = rr / 32, nb = rr % 32, n0 = nb * 32;
            const float* src = (up ? a.in[17] : a.in[16]) + (size_t)e * DM * DEXP;
            const size_t drow = (size_t)e * 2048 + (size_t)(n0 >> 7) * 256 + (n0 & 127) + (up ? 128 : 0);
            transpose_item(src, DEXP, n0, kb * 64, Wgu, drow, DM, scr, lane); continue; }
        r -= I_WG + I_WU;
        if (r < I_WD) { const int e = r / 1024, rr = r % 1024, kb = rr / 64, nb = rr % 64;
            transpose_item(a.in[18] + (size_t)e * DEXP * DM, DM, nb * 32, kb * 64, Wd, (size_t)e * 2048 + nb * 32, DEXP, scr, lane); continue; }
        r -= I_WD;
        if (r < I_TW) { const int p = r * 64 + lane; float s, c; sincospif((float)p * (1.0f / 8192.0f), &s, &c); ((f32x2*)(ws + WS_TW))[p] = (f32x2){c, s}; continue; }
        r -= I_TW;
        { const int p = r * 64 + lane, k = p >> 7, l = p & 127; float s, c; sincospif((float)((k * l) & 127) * (1.0f / 64.0f), &s, &c); ((bf16*)(ws + WS_FC))[p] = (bf16)f2bf(c); ((bf16*)(ws + WS_FS))[p] = (bf16)f2bf(s); }
    }
}

#define MFMA16(a, b, c) __builtin_amdgcn_mfma_f32_16x16x32_bf16((a), (b), (c), 0, 0, 0)
template <int MODE>
__device__ __forceinline__ void phase_norm_tile(const Args& a, LAS unsigned char* lds) {
    const int tid = threadIdx.x, lane = tid & 63, wave = __builtin_amdgcn_readfirstlane(tid >> 6), rl = lane & 15, q = lane >> 4;
    const float* ada = (const float*)(a.ws + WS_ADA);
    LAS float* gs = (LAS float*)lds;
    LAS float* shv = gs + 3 * DM;
    LAS float* ssred = shv + 3 * DM;
    LAS float* red = ssred + 128;
    { const float* gn = MODE == 0 ? a.in[6] : a.in[14];
      for (int i = tid; i < 3 * DM; i += NTHREADS) { const int v = i / DM, d = i % DM; const float* base = ada + (size_t)v * 12288 + (MODE == 0 ? 0 : 3 * DM);
          gs[i] = gn[d] * (1.f + base[DM + d]); shv[i] = base[d]; } }
    bf16x8 wb[2][8];
    if (MODE == 0) { const bf16* Wz = (const bf16*)(a.ws + WS_WIN) + (size_t)4096 * DM;
#pragma unroll
        for (int nt = 0; nt < 2; ++nt)
#pragma unroll
            for (int ks = 0; ks < 8; ++ks) wb[nt][ks] = *(const bf16x8*)(Wz + (size_t)(16 * nt + rl) * DM + 256 * wave + 32 * ks + 8 * q);
    } else { const bf16* WH = (const bf16*)(a.ws + WS_WRH); const bf16* WL = (const bf16*)(a.ws + WS_WRL);
#pragma unroll
        for (int ks = 0; ks < 8; ++ks) { wb[0][ks] = *(const bf16x8*)(WH + (size_t)rl * DM + 256 * wave + 32 * ks + 8 * q); wb[1][ks] = *(const bf16x8*)(WL + (size_t)rl * DM + 256 * wave + 32 * ks + 8 * q); } }
    __syncthreads();
    const int ntiles = MODE == 0 ? NROWS / 16 : NLAT / 16;
    bf16* Hout = (bf16*)(a.ws + (MODE == 0 ? WS_H : WS_HF));
    auto srcrow = [&](int r) -> const float* { if (MODE == 0) return r < NLAT ? a.in[0] + (size_t)r * DM : a.in[2] + (size_t)(r - NLAT) * DM; return (const float*)(a.ws + WS_XL) + (size_t)r * DM; };
    f32x4 xv[8][2];
    int tile = blockIdx.x;
    if (tile < ntiles) { const float* s = srcrow(tile * 16 + rl) + 256 * wave + 8 * q;
#pragma unroll
        for (int ks = 0; ks < 8; ++ks) { xv[ks][0] = *(const f32x4*)(s + 32 * ks); xv[ks][1] = *(const f32x4*)(s + 32 * ks + 4); } }
    for (; tile < ntiles; tile += gridDim.x) {
        const int r = tile * 16 + rl;
        const int v = MODE == 0 ? (tile * 16 < NLAT ? (tile * 16) / SEQ : 2) : (tile * 16) / SEQ;
        float ss = 0.f;
#pragma unroll
        for (int ks = 0; ks < 8; ++ks) { const f32x4 a0 = xv[ks][0], a1 = xv[ks][1]; ss += (a0.x * a0.x + a0.y * a0.y) + (a0.z * a0.z + a0.w * a0.w) + (a1.x * a1.x + a1.y * a1.y) + (a1.z * a1.z + a1.w * a1.w); }
        ss += __shfl_xor(ss, 16); ss += __shfl_xor(ss, 32);
        if (q == 0) ssred[wave * 16 + rl] = ss;
        __syncthreads();
        float tot = 0.f;
#pragma unroll
        for (int w8 = 0; w8 < 8; ++w8) tot += ssred[w8 * 16 + rl];
        const float rstd = rsqrtf(tot * (1.f / DM) + EPS);
        f32x4 acc0 = {0.f, 0.f, 0.f, 0.f}, acc1 = {0.f, 0.f, 0.f, 0.f};
        bf16* orow = Hout + (size_t)r * DM + 256 * wave + 8 * q;
        const LAS float* gsp = gs + v * DM + 256 * wave + 8 * q; const LAS float* shp = shv + v * DM + 256 * wave + 8 * q;
#pragma unroll
        for (int ks = 0; ks < 8; ++ks) {
            const f32x4 g0 = *(const LAS f32x4*)(gsp + 32 * ks), g1 = *(const LAS f32x4*)(gsp + 32 * ks + 4), s0 = *(const LAS f32x4*)(shp + 32 * ks), s1 = *(const LAS f32x4*)(shp + 32 * ks + 4);
            const f32x4 h0 = xv[ks][0] * rstd * g0 + s0, h1 = xv[ks][1] * rstd * g1 + s1;
            u32x4 hw; hw.x = pk2(h0.x, h0.y); hw.y = pk2(h0.z, h0.w); hw.z = pk2(h1.x, h1.y); hw.w = pk2(h1.z, h1.w);
            *(u32x4*)(orow + 32 * ks) = hw;
            const bf16x8 hf = __builtin_bit_cast(bf16x8, hw);
            if (MODE == 0) { acc0 = MFMA16(hf, wb[0][ks], acc0); acc1 = MFMA16(hf, wb[1][ks], acc1); }
            else { u32x4 lw;
                lw.x = pk2(h0.x - __uint_as_float(hw.x << 16), h0.y - __uint_as_float(hw.x & 0xffff0000u)); lw.y = pk2(h0.z - __uint_as_float(hw.y << 16), h0.w - __uint_as_float(hw.y & 0xffff0000u));
                lw.z = pk2(h1.x - __uint_as_float(hw.z << 16), h1.y - __uint_as_float(hw.z & 0xffff0000u)); lw.w = pk2(h1.z - __uint_as_float(hw.w << 16), h1.w - __uint_as_float(hw.w & 0xffff0000u));
                const bf16x8 lf = __builtin_bit_cast(bf16x8, lw);
                acc0 = MFMA16(hf, wb[0][ks], acc0); acc0 = MFMA16(lf, wb[0][ks], acc0); acc0 = MFMA16(hf, wb[1][ks], acc0); }
        }
        { const int nt2 = tile + gridDim.x; if (nt2 < ntiles) { const float* s = srcrow(nt2 * 16 + rl) + 256 * wave + 8 * q;
#pragma unroll
            for (int ks = 0; ks < 8; ++ks) { xv[ks][0] = *(const f32x4*)(s + 32 * ks); xv[ks][1] = *(const f32x4*)(s + 32 * ks + 4); } } }
#pragma unroll
        for (int rr = 0; rr < 4; ++rr) { red[(wave * 16 + 4 * q + rr) * 32 + rl] = acc0[rr]; if (MODE == 0) red[(wave * 16 + 4 * q + rr) * 32 + 16 + rl] = acc1[rr]; }
        __syncthreads();
        if (MODE == 0) { const int row = tid >> 5, col = tid & 31; float s = 0.f;
#pragma unroll
            for (int w8 = 0; w8 < 8; ++w8) s += red[(w8 * 16 + row) * 32 + col];
            ((float*)(a.ws + WS_Z))[(size_t)(tile * 16 + row) * 32 + col] = s;
        } else if (tid < 256) { const int row = tid >> 4, e = tid & 15; float s = 0.f;
#pragma unroll
            for (int w8 = 0; w8 < 8; ++w8) s += red[(w8 * 16 + row) * 32 + e];
            float m = s; m = fmaxf(m, __shfl_xor(m, 1)); m = fmaxf(m, __shfl_xor(m, 2)); m = fmaxf(m, __shfl_xor(m, 4)); m = fmaxf(m, __shfl_xor(m, 8));
            const float ex = expf(s - m); float sm = ex; sm += __shfl_xor(sm, 1); sm += __shfl_xor(sm, 2); sm += __shfl_xor(sm, 4); sm += __shfl_xor(sm, 8);
            const int rg = tile * 16 + row, b = rg / SEQ, t = rg % SEQ;
            ((float*)(a.ws + WS_AFF))[((size_t)b * NE + e) * SEQ + t] = ex / sm; }
        __syncthreads();
    }
}

constexpr int GQ_LD = 136, GK_LD = 72;
constexpr int GL_Q = 0, GL_KI = 17408, GL_KET = 34816, GL_VT = 53248, GL_ST = 90112, GL_DC = 159744, GL_SEG = 160256;
__device__ __forceinline__ bf16x8 ldfrag(const LAS bf16* base, int row0, int ld, int koff, int lane) { return *(const LAS bf16x8*)(base + (row0 + (lane & 15)) * ld + koff + 8 * (lane >> 4)); }
__device__ __forceinline__ float fast_logsigmoid(float x) { return fminf(x, 0.f) - __logf(1.f + __expf(-fabsf(x))); }

struct GlaRaw { u32x4 q[2], k[2], v[4]; f32x2 z; };
template <bool FULL>
__device__ __forceinline__ void gla_issue_loads(const Args& a, size_t row0, int h, int dir, int wave, int lane, int tid, GlaRaw& r) {
    const bf16* P = (const bf16*)(a.ws + WS_P); const float* Z = (const float*)(a.ws + WS_Z);
#pragma unroll
    for (int j = 0; j < 2; ++j) { const int e = tid + 512 * j, row = e >> 4, c8 = e & 15;
        r.k[j] = *(const u32x4*)(P + (row0 + row) * PW + 512 + h * 128 + 8 * c8);
        if (FULL) r.q[j] = *(const u32x4*)(P + (row0 + row) * PW + h * 128 + 8 * c8); }
    { const int e = tid * 2; r.z = *(const f32x2*)(Z + (row0 + (e >> 4)) * 32 + dir * 16 + (e & 15)); }
#pragma unroll
    for (int rr = 0; rr < 4; ++rr) r.v[rr] = *(const u32x4*)(P + (row0 + 4 * (lane >> 2) + rr) * PW + 1024 + h * 256 + 32 * wave + 8 * (lane & 3));
}
__device__ __forceinline__ void gla_store_vt(LAS unsigned char* lds, int wave, int lane, const u32x4 (&x)[4]) {
    LAS bf16* VT = (LAS bf16*)(lds + GL_VT); const int c0 = 32 * wave + 8 * (lane & 3), l0 = 4 * (lane >> 2);
#pragma unroll
    for (int i2 = 0; i2 < 4; ++i2) {
        const unsigned a0 = x[0][i2], a1 = x[1][i2], a2 = x[2][i2], a3 = x[3][i2];
        u32x2 lo, hi; lo.x = (a0 & 0xffffu) | (a1 << 16); lo.y = (a2 & 0xffffu) | (a3 << 16); hi.x = (a0 >> 16) | (a1 & 0xffff0000u); hi.y = (a2 >> 16) | (a3 & 0xffff0000u);
        *(LAS u32x2*)(VT + (c0 + 2 * i2) * GK_LD + l0) = lo; *(LAS u32x2*)(VT + (c0 + 2 * i2 + 1) * GK_LD + l0) = hi; }
}
template <bool FULL>
__device__ __forceinline__ void gla_stage(LAS unsigned char* lds, int wave, int lane, int tid, const GlaRaw& r) {
    LAS bf16* Qd = (LAS bf16*)(lds + GL_Q); LAS bf16* Ki = (LAS bf16*)(lds + GL_KI); LAS float* zs = (LAS float*)(lds + GL_KET);
#pragma unroll
    for (int j = 0; j < 2; ++j) { const int e = tid + 512 * j, row = e >> 4, c8 = e & 15;
        *(LAS u32x4*)(Ki + row * GQ_LD + 8 * c8) = r.k[j]; if (FULL) *(LAS u32x4*)(Qd + row * GQ_LD + 8 * c8) = r.q[j]; }
    *(LAS f32x2*)(zs + tid * 2) = r.z;
    gla_store_vt(lds, wave, lane, r.v);
}
template <bool FULL>
__device__ __forceinline__ void gla_prep(LAS unsigned char* lds, int dir, const float (&w)[16], float bias, float& totacc) {
    const int tid = threadIdx.x, d = tid & 127, seg = __builtin_amdgcn_readfirstlane(tid >> 7);
    LAS bf16* Qd = (LAS bf16*)(lds + GL_Q); LAS bf16* Ki = (LAS bf16*)(lds + GL_KI); LAS bf16* KeT = (LAS bf16*)(lds + GL_KET);
    LAS float* dcv = (LAS float*)(lds + GL_DC); LAS float* segt = (LAS float*)(lds + GL_SEG); const LAS float* zs = (const LAS float*)(lds + GL_KET);
    float kf[16], qf[16], c[16];
#pragma unroll
    for (int ii = 0; ii < 16; ++ii) { kf[ii] = bf2f(Ki[(16 * seg + ii) * GQ_LD + d]); if (FULL) qf[ii] = bf2f(Qd[(16 * seg + ii) * GQ_LD + d]); }
#pragma unroll
    for (int ii = 0; ii < 16; ++ii) { const LAS f32x4* zr = (const LAS f32x4*)(zs + (16 * seg + ii) * 16); float pre = bias;
#pragma unroll
        for (int r4 = 0; r4 < 4; ++r4) { const f32x4 zv = zr[r4]; pre += zv.x * w[4 * r4] + zv.y * w[4 * r4 + 1] + zv.z * w[4 * r4 + 2] + zv.w * w[4 * r4 + 3]; }
        c[ii] = fast_logsigmoid(pre) * (1.f / 16.f); }
    if (!dir) {
#pragma unroll
        for (int ii = 1; ii < 16; ++ii) c[ii] += c[ii - 1];
    } else {
#pragma unroll
        for (int ii = 14; ii >= 0; --ii) c[ii] += c[ii + 1];
    }
    segt[seg * 128 + d] = dir ? c[0] : c[15];
    __syncthreads();
    float total = 0.f, off = 0.f;
#pragma unroll
    for (int s2 = 0; s2 < 4; ++s2) { const float t = segt[s2 * 128 + d]; total += t; if (dir ? (s2 > seg) : (s2 < seg)) off += t; }
    unsigned kw[8];
#pragma unroll
    for (int ii = 0; ii < 16; ii += 2) {
        const float c0 = c[ii] + off, c1 = c[ii + 1] + off;
        kw[ii >> 1] = pk2(kf[ii] * __expf(total - c0), kf[ii + 1] * __expf(total - c1));
        if (FULL) { const int i0 = 16 * seg + ii;
            Qd[i0 * GQ_LD + d] = (bf16)f2bf(qf[ii] * 0.08838834764831845f * __expf(c0)); Qd[(i0 + 1) * GQ_LD + d] = (bf16)f2bf(qf[ii + 1] * 0.08838834764831845f * __expf(c1));
            Ki[i0 * GQ_LD + d] = (bf16)f2bf(kf[ii] * __expf(-c0)); Ki[(i0 + 1) * GQ_LD + d] = (bf16)f2bf(kf[ii + 1] * __expf(-c1)); }
    }
    *(LAS u32x4*)(KeT + d * GK_LD + 16 * seg) = (u32x4){kw[0], kw[1], kw[2], kw[3]};
    *(LAS u32x4*)(KeT + d * GK_LD + 16 * seg + 8) = (u32x4){kw[4], kw[5], kw[6], kw[7]};
    if (seg == 0) { dcv[d] = __expf(total); totacc += total; }
}
__device__ __forceinline__ void gla_state_update(LAS unsigned char* lds, int lane, const bf16x8 (&vt)[2][2], f32x4 (&acc)[8][2]) {
    const LAS bf16* KeT = (const LAS bf16*)(lds + GL_KET); const LAS float* dcv = (const LAS float*)(lds + GL_DC);
#pragma unroll
    for (int mt = 0; mt < 8; ++mt) {
        const f32x4 dc4 = *(const LAS f32x4*)(dcv + 16 * mt + 4 * (lane >> 4));
        const bf16x8 k0 = ldfrag(KeT, 16 * mt, GK_LD, 0, lane), k1 = ldfrag(KeT, 16 * mt, GK_LD, 32, lane);
#pragma unroll
        for (int n = 0; n < 2; ++n) { f32x4 t = acc[mt][n] * dc4; t = MFMA16(k0, vt[n][0], t); t = MFMA16(k1, vt[n][1], t); acc[mt][n] = t; }
    }
}
constexpr size_t GLA_SV = 128 * 256;
__device__ __forceinline__ void gla_passA(const Args& a, LAS unsigned char* lds, int item) {
    const int tid = threadIdx.x, lane = tid & 63, wave = __builtin_amdgcn_readfirstlane(tid >> 6), q = lane >> 4, cidx = lane & 15;
    const bool is_ctx = item >= 256; const int seq = is_ctx ? item - 256 : item >> 4, s = is_ctx ? 0 : item & 15;
    const int b = seq >> 3, dir = (seq >> 2) & 1, h = seq & 3, nchunk = is_ctx ? 4 : 16;
    const size_t rowbase = is_ctx ? (size_t)(NLAT + b * CTXL) : (size_t)b * SEQ + (size_t)s * 1024;
    const float* w_a2 = dir ? a.in[10] : a.in[8]; const float* b_a2 = dir ? a.in[11] : a.in[9];
    float w[16]; const int d = tid & 127;
#pragma unroll
    for (int r = 0; r < 16; ++r) w[r] = w_a2[r * 512 + h * 128 + d];
    const float bias = b_a2[h * 128 + d];
    f32x4 acc[8][2];
#pragma unroll
    for (int mt = 0; mt < 8; ++mt) { acc[mt][0] = (f32x4){0.f, 0.f, 0.f, 0.f}; acc[mt][1] = (f32x4){0.f, 0.f, 0.f, 0.f}; }
    float totacc = 0.f;
    GlaRaw raw; gla_issue_loads<false>(a, rowbase + (size_t)(dir ? (nchunk - 1) : 0) * 64, h, dir, wave, lane, tid, raw);
    for (int ci = 0; ci < nchunk; ++ci) {
        gla_stage<false>(lds, wave, lane, tid, raw);
        if (ci + 1 < nchunk) gla_issue_loads<false>(a, rowbase + (size_t)(dir ? (nchunk - 2 - ci) : ci + 1) * 64, h, dir, wave, lane, tid, raw);
        __syncthreads();
        gla_prep<false>(lds, dir, w, bias, totacc);
        __syncthreads();
        const LAS bf16* VT = (const LAS bf16*)(lds + GL_VT);
        bf16x8 vt[2][2];
#pragma unroll
        for (int n2 = 0; n2 < 2; ++n2) { vt[n2][0] = ldfrag(VT, 32 * wave + 16 * n2, GK_LD, 0, lane); vt[n2][1] = ldfrag(VT, 32 * wave + 16 * n2, GK_LD, 32, lane); }
        gla_state_update(lds, lane, vt, acc);
        __syncthreads();
    }
    float* T = is_ctx ? (float*)(a.ws + WS_ST0) + (size_t)seq * GLA_SV : (float*)(a.ws + WS_T) + (size_t)item * GLA_SV;
#pragma unroll
    for (int mt = 0; mt < 8; ++mt)
#pragma unroll
        for (int n2 = 0; n2 < 2; ++n2)
#pragma unroll
            for (int r = 0; r < 4; ++r) T[(size_t)(16 * mt + 4 * q + r) * 256 + 32 * wave + 16 * n2 + cidx] = acc[mt][n2][r];
    if (!is_ctx && tid < 128) ((float*)(a.ws + WS_DT))[item * 128 + tid] = __expf(totacc);
}
__device__ __forceinline__ void gla_passB(const Args& a) {
    const float* ST0 = (const float*)(a.ws + WS_ST0); const float* T = (const float*)(a.ws + WS_T); const float* DT = (const float*)(a.ws + WS_DT); float* SST = (float*)(a.ws + WS_SST);
    for (int e = blockIdx.x * NTHREADS + threadIdx.x; e < 16 * (int)GLA_SV; e += gridDim.x * NTHREADS) {
        const int seq = e >> 15, dv = e & 32767, d = dv >> 8, dir = (seq >> 2) & 1;
        float S = ST0[(size_t)seq * GLA_SV + dv];
        for (int si = 0; si < 16; ++si) { const int s = dir ? 15 - si : si; const size_t it = (size_t)seq * 16 + s;
            SST[it * GLA_SV + dv] = S; S = DT[it * 128 + d] * S + T[it * GLA_SV + dv]; }
    }
}
__device__ __forceinline__ void gla_passC(const Args& a, LAS unsigned char* lds, int item) {
    const int tid = threadIdx.x, lane = tid & 63, wave = __builtin_amdgcn_readfirstlane(tid >> 6), q = lane >> 4, cidx = lane & 15;
    const int seq = item >> 4, s = item & 15, b = seq >> 3, dir = (seq >> 2) & 1, h = seq & 3;
    const size_t rowbase = (size_t)b * SEQ + (size_t)s * 1024;
    const float* w_a2 = dir ? a.in[10] : a.in[8]; const float* b_a2 = dir ? a.in[11] : a.in[9];
    bf16* O = (bf16*)(a.ws + (dir ? WS_OB : WS_OF));
    float w[16]; const int d = tid & 127;
#pragma unroll
    for (int r = 0; r < 16; ++r) w[r] = w_a2[r * 512 + h * 128 + d];
    const float bias = b_a2[h * 128 + d];
    LAS bf16* Qd = (LAS bf16*)(lds + GL_Q); LAS bf16* Ki = (LAS bf16*)(lds + GL_KI); LAS bf16* Pm = Ki; LAS bf16* VT = (LAS bf16*)(lds + GL_VT); LAS bf16* ST = (LAS bf16*)(lds + GL_ST);
    f32x4 acc[8][2];
    { const float* S0 = (const float*)(a.ws + WS_SST) + (size_t)item * GLA_SV;
#pragma unroll
      for (int mt = 0; mt < 8; ++mt)
#pragma unroll
          for (int n2 = 0; n2 < 2; ++n2) {
#pragma unroll
              for (int r = 0; r < 4; ++r) acc[mt][n2][r] = S0[(size_t)(16 * mt + 4 * q + r) * 256 + 32 * wave + 16 * n2 + cidx];
              u32x2 wv; wv.x = pk2(acc[mt][n2][0], acc[mt][n2][1]); wv.y = pk2(acc[mt][n2][2], acc[mt][n2][3]);
              *(LAS u32x2*)(ST + (32 * wave + 16 * n2 + cidx) * GQ_LD + 16 * mt + 4 * q) = wv; } }
    float totacc = 0.f;
    GlaRaw raw; gla_issue_loads<true>(a, rowbase + (size_t)(dir ? 15 : 0) * 64, h, dir, wave, lane, tid, raw);
    for (int ci = 0; ci < 16; ++ci) {
        const int n = dir ? (15 - ci) : ci; const size_t row0 = rowbase + (size_t)n * 64;
        gla_stage<true>(lds, wave, lane, tid, raw);
        if (ci + 1 < 16) gla_issue_loads<true>(a, rowbase + (size_t)(dir ? (14 - ci) : ci + 1) * 64, h, dir, wave, lane, tid, raw);
        __syncthreads();
        gla_prep<true>(lds, dir, w, bias, totacc);
        __syncthreads();
        const int it = wave >> 1;
        u32x2 pw[2];
#pragma unroll
        for (int jj = 0; jj < 2; ++jj) { const int jt = 2 * (wave & 1) + jj; f32x4 sc = {0.f, 0.f, 0.f, 0.f};
#pragma unroll
            for (int ks = 0; ks < 4; ++ks) sc = MFMA16(ldfrag(Ki, 16 * jt, GQ_LD, 32 * ks, lane), ldfrag(Qd, 16 * it, GQ_LD, 32 * ks, lane), sc);
            const int i = 16 * it + cidx, j0 = 16 * jt + 4 * q;
#pragma unroll
            for (int r = 0; r < 4; ++r) { const bool keep = dir ? (j0 + r >= i) : (j0 + r <= i); sc[r] = keep ? sc[r] : 0.f; }
            pw[jj].x = pk2(sc[0], sc[1]); pw[jj].y = pk2(sc[2], sc[3]); }
        __syncthreads();
#pragma unroll
        for (int jj = 0; jj < 2; ++jj) *(LAS u32x2*)(Pm + (16 * it + cidx) * GK_LD + 16 * (2 * (wave & 1) + jj) + 4 * q) = pw[jj];
        __syncthreads();
        bf16x8 vt[2][2], st[2][4];
#pragma unroll
        for (int n2 = 0; n2 < 2; ++n2) { vt[n2][0] = ldfrag(VT, 32 * wave + 16 * n2, GK_LD, 0, lane); vt[n2][1] = ldfrag(VT, 32 * wave + 16 * n2, GK_LD, 32, lane);
#pragma unroll
            for (int ks = 0; ks < 4; ++ks) st[n2][ks] = ldfrag(ST, 32 * wave + 16 * n2, GQ_LD, 32 * ks, lane); }
#pragma unroll
        for (int i2 = 0; i2 < 4; ++i2) {
            const bf16x8 p0 = ldfrag(Pm, 16 * i2, GK_LD, 0, lane), p1 = ldfrag(Pm, 16 * i2, GK_LD, 32, lane);
            bf16x8 qf[4];
#pragma unroll
            for (int ks = 0; ks < 4; ++ks) qf[ks] = ldfrag(Qd, 16 * i2, GQ_LD, 32 * ks, lane);
#pragma unroll
            for (int n2 = 0; n2 < 2; ++n2) { f32x4 o = {0.f, 0.f, 0.f, 0.f};
                o = MFMA16(vt[n2][0], p0, o); o = MFMA16(vt[n2][1], p1, o);
#pragma unroll
                for (int ks = 0; ks < 4; ++ks) o = MFMA16(st[n2][ks], qf[ks], o);
                u32x2 wv; wv.x = pk2(o[0], o[1]); wv.y = pk2(o[2], o[3]);
                *(u32x2*)(O + (row0 + 16 * i2 + cidx) * 1024 + h * 256 + 32 * wave + 16 * n2 + 4 * q) = wv; }
        }
        gla_state_update(lds, lane, vt, acc);
#pragma unroll
        for (int mt = 0; mt < 8; ++mt)
#pragma unroll
            for (int n2 = 0; n2 < 2; ++n2) { u32x2 wv; wv.x = pk2(acc[mt][n2][0], acc[mt][n2][1]); wv.y = pk2(acc[mt][n2][2], acc[mt][n2][3]);
                *(LAS u32x2*)(ST + (32 * wave + 16 * n2 + cidx) * GQ_LD + 16 * mt + 4 * q) = wv; }
        __syncthreads();
    }
}

__device__ __forceinline__ void phase_gla_merge(const Args& a) {
    const int tid = threadIdx.x, lane = tid & 63, wave = tid >> 6;
    const int gw = blockIdx.x * 8 + wave, NGW = gridDim.x * 8;
    const bf16* OF = (const bf16*)(a.ws + WS_OF); const bf16* OB = (const bf16*)(a.ws + WS_OB);
    const bf16* P = (const bf16*)(a.ws + WS_P); bf16* Y = (bf16*)(a.ws + WS_YCAT); const float* gg = a.in[12];
    for (int r = gw; r < NLAT; r += NGW) {
#pragma unroll
        for (int j = 0; j < 4; ++j) {
            const int col = 256 * j + 4 * lane;
            const u32x2 fa = *(const u32x2*)(OF + (size_t)r * 1024 + col), fb = *(const u32x2*)(OB + (size_t)r * 1024 + col);
            f32x4 o; o.x = __uint_as_float(fa.x << 16) + __uint_as_float(fb.x << 16); o.y = __uint_as_float(fa.x & 0xffff0000u) + __uint_as_float(fb.x & 0xffff0000u);
            o.z = __uint_as_float(fa.y << 16) + __uint_as_float(fb.y << 16); o.w = __uint_as_float(fa.y & 0xffff0000u) + __uint_as_float(fb.y & 0xffff0000u);
            const float ss = wave_sum((o.x * o.x + o.y * o.y) + (o.z * o.z + o.w * o.w));
            const float rstd = rsqrtf(ss * (1.f / 256.f) + EPS);
            const u32x2 gw2 = *(const u32x2*)(P + (size_t)r * PW + 2048 + col);
            const f32x4 gn = *(const f32x4*)(gg + col);
            const float g0 = __uint_as_float(gw2.x << 16), g1 = __uint_as_float(gw2.x & 0xffff0000u), g2 = __uint_as_float(gw2.y << 16), g3 = __uint_as_float(gw2.y & 0xffff0000u);
            u32x2 w; w.x = pk2(o.x * rstd * gn.x * silu_f(g0), o.y * rstd * gn.y * silu_f(g1)); w.y = pk2(o.z * rstd * gn.z * silu_f(g2), o.w * rstd * gn.w * silu_f(g3));
            *(u32x2*)(Y + (size_t)r * DM + col) = w;
        }
    }
}

constexpr int FLD = 136;
__device__ __forceinline__ void load_dft_frags(const unsigned char* ws, int wave, int lane, bf16x8 (&fc)[4], bf16x8 (&fs)[4]) {
    const bf16* FC = (const bf16*)(ws + WS_FC); const bf16* FS = (const bf16*)(ws + WS_FS);
    const int k = 16 * wave + (lane & 15);
#pragma unroll
    for (int ks = 0; ks < 4; ++ks) { fc[ks] = *(const bf16x8*)(FC + k * 128 + ks * 32 + 8 * (lane >> 4)); fs[ks] = *(const bf16x8*)(FS + k * 128 + ks * 32 + 8 * (lane >> 4)); }
}
__device__ __forceinline__ void store_t4x8(LAS bf16* XT, int c0, int l0, const u32x4 (&x)[4]) {
#pragma unroll
    for (int i2 = 0; i2 < 4; ++i2) {
        const unsigned a0 = x[0][i2], a1 = x[1][i2], a2 = x[2][i2], a3 = x[3][i2];
        u32x2 lo, hi; lo.x = (a0 & 0xffffu) | (a1 << 16); lo.y = (a2 & 0xffffu) | (a3 << 16); hi.x = (a0 >> 16) | (a1 & 0xffff0000u); hi.y = (a2 >> 16) | (a3 & 0xffff0000u);
        *(LAS u32x2*)(XT + (c0 + 2 * i2) * FLD + l0) = lo; *(LAS u32x2*)(XT + (c0 + 2 * i2 + 1) * FLD + l0) = hi; }
}
__device__ __forceinline__ void phase_f1(const Args& a, LAS unsigned char* lds) {
    const int tid = threadIdx.x, lane = tid & 63, wave = __builtin_amdgcn_readfirstlane(tid >> 6), q = lane >> 4, cidx = lane & 15;
    const bf16* P = (const bf16*)(a.ws + WS_P); const f32x2* TW = (const f32x2*)(a.ws + WS_TW);
    bf16* A1r = (bf16*)(a.ws + WS_FA); bf16* A1i = (bf16*)(a.ws + WS_FAI);
    LAS bf16* XT = (LAS bf16*)lds;
    bf16x8 fc[4], fs[4]; load_dft_frags(a.ws, wave, lane, fc, fs);
    const int k1 = 16 * wave + cidx;
    for (int item = blockIdx.x; item < 1024; item += gridDim.x) {
        const int cb = item & 3, l2 = (item >> 2) & 127, b = item >> 9, ch0 = cb * 256;
#pragma unroll
        for (int j = 0; j < 2; ++j) { const int task = tid + 512 * j, cblk = task & 31, lb = task >> 5; u32x4 x[4];
#pragma unroll
            for (int r = 0; r < 4; ++r) x[r] = *(const u32x4*)(P + ((size_t)b * SEQ + 128 * (4 * lb + r) + l2) * PW + 3072 + ch0 + 8 * cblk);
            store_t4x8(XT, 8 * cblk, 4 * lb, x); }
        __syncthreads();
        const f32x2 tw = TW[l2 * k1];
        bf16* or_ = A1r + (((size_t)b * 128 + k1) * 128 + l2) * 1024 + ch0 + 4 * q; bf16* oi_ = A1i + (((size_t)b * 128 + k1) * 128 + l2) * 1024 + ch0 + 4 * q;
#pragma unroll 2
        for (int mt = 0; mt < 16; ++mt) {
            f32x4 cr = {0.f, 0.f, 0.f, 0.f}, cs = {0.f, 0.f, 0.f, 0.f};
#pragma unroll
            for (int ks = 0; ks < 4; ++ks) { const bf16x8 xa = *(const LAS bf16x8*)(XT + (16 * mt + cidx) * FLD + ks * 32 + 8 * q); cr = MFMA16(xa, fc[ks], cr); cs = MFMA16(xa, fs[ks], cs); }
            const f32x4 br = cr * tw.x - cs * tw.y, bi = -(cs * tw.x + cr * tw.y);
            u32x2 wr_; wr_.x = pk2(br[0], br[1]); wr_.y = pk2(br[2], br[3]); u32x2 wi_; wi_.x = pk2(bi[0], bi[1]); wi_.y = pk2(bi[2], bi[3]);
            *(u32x2*)(or_ + 16 * mt) = wr_; *(u32x2*)(oi_ + 16 * mt) = wi_;
        }
        __syncthreads();
    }
}
__device__ __forceinline__ void phase_f34(const Args& a, LAS unsigned char* lds) {
    const int tid = threadIdx.x, lane = tid & 63, wave = __builtin_amdgcn_readfirstlane(tid >> 6), q = lane >> 4, cidx = lane & 15;
    const bf16* A1r = (const bf16*)(a.ws + WS_FA); const bf16* A1i = (const bf16*)(a.ws + WS_FAI); bf16* Y = (bf16*)(a.ws + WS_YCAT);
    LAS bf16* XTr = (LAS bf16*)lds; LAS bf16* XTi = XTr + 128 * FLD; LAS bf16* XKr = XTi + 128 * FLD; LAS bf16* XKi = XKr + 128 * FLD;
    bf16x8 fc[4], fs[4]; load_dft_frags(a.ws, wave, lane, fc, fs);
    const float nrm = 1.0f / 1448.15468787005f;
    for (int item = blockIdx.x; item < 2048; item += gridDim.x) {
        const int g = item & 7, k1 = (item >> 3) & 127, b = item >> 10, ch0 = g * 128;
        { const int cblk = tid & 15, lb = tid >> 4; u32x4 xr[4], xi[4];
#pragma unroll
            for (int r = 0; r < 4; ++r) { const size_t off = (((size_t)b * 128 + k1) * 128 + 4 * lb + r) * 1024 + ch0 + 8 * cblk; xr[r] = *(const u32x4*)(A1r + off); xi[r] = *(const u32x4*)(A1i + off); }
            store_t4x8(XTr, 8 * cblk, 4 * lb, xr); store_t4x8(XTi, 8 * cblk, 4 * lb, xi); }
        __syncthreads();
        const int k2 = 16 * wave + cidx;
#pragma unroll 2
        for (int mt = 0; mt < 8; ++mt) {
            f32x4 a1 = {0.f, 0.f, 0.f, 0.f}, a2 = a1, b1 = a1, b2 = a1;
#pragma unroll
            for (int ks = 0; ks < 4; ++ks) { const bf16x8 xa = *(const LAS bf16x8*)(XTr + (16 * mt + cidx) * FLD + ks * 32 + 8 * q); const bf16x8 xb = *(const LAS bf16x8*)(XTi + (16 * mt + cidx) * FLD + ks * 32 + 8 * q);
                a1 = MFMA16(xa, fc[ks], a1); b2 = MFMA16(xa, fs[ks], b2); a2 = MFMA16(xb, fs[ks], a2); b1 = MFMA16(xb, fc[ks], b1); }
            const f32x4 xre = a1 + a2, xim = b1 - b2;
            u32x2 wr_; wr_.x = pk2(xre[0], xre[1]); wr_.y = pk2(xre[2], xre[3]); u32x2 wi_; wi_.x = pk2(xim[0], xim[1]); wi_.y = pk2(xim[2], xim[3]);
            *(LAS u32x2*)(XKr + k2 * FLD + 16 * mt + 4 * q) = wr_; *(LAS u32x2*)(XKi + k2 * FLD + 16 * mt + 4 * q) = wi_;
        }
        __syncthreads();
#pragma unroll 2
        for (int nt = 0; nt < 8; ++nt) {
            f32x4 y = {0.f, 0.f, 0.f, 0.f};
#pragma unroll
            for (int ks = 0; ks < 4; ++ks) { const bf16x8 xa = *(const LAS bf16x8*)(XKr + (16 * nt + cidx) * FLD + ks * 32 + 8 * q); const bf16x8 xb = *(const LAS bf16x8*)(XKi + (16 * nt + cidx) * FLD + ks * 32 + 8 * q);
                y = MFMA16(fc[ks], xa, y); y = MFMA16(fs[ks], xb, y); }
            const int lp = k1 + 128 * (16 * nt + cidx);
            u32x2 w; w.x = pk2(y[0] * nrm, y[1] * nrm); w.y = pk2(y[2] * nrm, y[3] * nrm);
            *(u32x2*)(Y + ((size_t)b * SEQ + lp) * DM + 1024 + ch0 + 16 * wave + 4 * q) = w;
        }
        __syncthreads();
    }
}

__device__ __forceinline__ void phase_topk(const Args& a, LAS unsigned char* lds) {
    const int tid = threadIdx.x;
    LAS unsigned* keys = (LAS unsigned*)lds;
    LAS unsigned* hist = (LAS unsigned*)(lds + 65536);
    LAS unsigned* misc = hist + 256;
    LAS unsigned* sg = misc + 16;
    LAS unsigned* se = sg + 512;
    const float* AFF = (const float*)(a.ws + WS_AFF); int* TOK = (int*)(a.ws + WS_TOK); float* GATE = (float*)(a.ws + WS_GATE); int* SEL = (int*)(a.ws + WS_SEL);
    for (int be = blockIdx.x; be < NB * NE; be += gridDim.x) {
        const int b = be / NE, e = be % NE;
        for (int i = tid; i < SEQ; i += NTHREADS) keys[i] = __float_as_uint(AFF[(size_t)be * SEQ + i]);
        unsigned prefix = 0u, pmask = 0u, krem = CAP;
        for (int pass = 0; pass < 4; ++pass) {
            const int shift = 24 - 8 * pass;
            if (tid < 256) hist[tid] = 0u;
            __syncthreads();
            for (int i = tid; i < SEQ; i += NTHREADS) { const unsigned k = keys[i]; if ((k & pmask) == prefix) atomicAdd((unsigned*)&hist[(k >> shift) & 255u], 1u); }
            __syncthreads();
            if (tid == 0) { unsigned cum = 0u; int bsel = 0;
                for (int bk = 255; bk >= 0; --bk) { const unsigned c = hist[bk]; if (cum + c >= krem) { bsel = bk; break; } cum += c; }
                misc[0] = prefix | ((unsigned)bsel << shift); misc[1] = krem - cum; }
            __syncthreads();
            prefix = misc[0]; krem = misc[1]; pmask |= (0xffu << shift);
            __syncthreads();
        }
        const unsigned T = prefix;
        unsigned cg_ = 0u, ce = 0u;
        for (int i = 0; i < 32; ++i) { const unsigned k = keys[tid * 32 + i]; cg_ += (k > T); ce += (k == T); }
        sg[tid] = cg_; se[tid] = ce;
        __syncthreads();
        if (tid == 0) { unsigned rg = 0u, re = 0u; for (int i = 0; i < NTHREADS; ++i) { const unsigned x = sg[i], y = se[i]; sg[i] = rg; se[i] = re; rg += x; re += y; } }
        __syncthreads();
        unsigned gt_before = sg[tid], eq_before = se[tid];
        for (int i = 0; i < 32; ++i) { const int t = tid * 32 + i; const unsigned k = keys[t];
            const bool isgt = k > T, iseq = k == T; const bool take = isgt || (iseq && eq_before < krem);
            const unsigned slot = gt_before + (eq_before < krem ? eq_before : krem);
            if (take) { TOK[(size_t)be * CAP + slot] = t; GATE[(size_t)be * CAP + slot] = __uint_as_float(k); }
            SEL[((size_t)b * SEQ + t) * NE + e] = take ? (int)slot : -1;
            gt_before += isgt; eq_before += iseq; }
        __syncthreads();
    }
}

__device__ __forceinline__ void phase_final(const Args& a) {
    const int tid = threadIdx.x, lane = tid & 63, wave = tid >> 6;
    const int gw = blockIdx.x * 8 + wave, NGW = gridDim.x * 8;
    const float* ada = (const float*)(a.ws + WS_ADA); const float* fg = a.in[19];
    const float* XL = (const float*)(a.ws + WS_XL); const bf16* YE = (const bf16*)(a.ws + WS_YE);
    const float* GATE = (const float*)(a.ws + WS_GATE); const int* SEL = (const int*)(a.ws + WS_SEL);
    for (int r = gw; r < NLAT; r += NGW) {
        const int b = r / SEQ;
        const float* g2 = ada + (size_t)b * 12288 + 5 * DM;
        f32x4 m[8];
#pragma unroll
        for (int j = 0; j < 8; ++j) m[j] = (f32x4){0.f, 0.f, 0.f, 0.f};
        for (int e = 0; e < NE; ++e) { const int s = SEL[(size_t)r * NE + e];
            if (s >= 0) { const float gt = GATE[((size_t)b * NE + e) * CAP + s]; const bf16* yr = YE + ((size_t)(e * 2 + b) * CAP + s) * DM;
#pragma unroll
                for (int j = 0; j < 8; ++j) { const u32x2 w = *(const u32x2*)(yr + 256 * j + 4 * lane);
                    m[j].x += gt * __uint_as_float(w.x << 16); m[j].y += gt * __uint_as_float(w.x & 0xffff0000u); m[j].z += gt * __uint_as_float(w.y << 16); m[j].w += gt * __uint_as_float(w.y & 0xffff0000u); } } }
        float ss = 0.f;
#pragma unroll
        for (int j = 0; j < 8; ++j) { const int d = 256 * j + 4 * lane; const f32x4 xv = *(const f32x4*)(XL + (size_t)r * DM + d), gv = *(const f32x4*)(g2 + d);
            m[j] = xv + gv * m[j]; ss += (m[j].x * m[j].x + m[j].y * m[j].y) + (m[j].z * m[j].z + m[j].w * m[j].w); }
        const float rstd = rsqrtf(wave_sum(ss) * (1.f / DM) + EPS);
#pragma unroll
        for (int j = 0; j < 8; ++j) { const int d = 256 * j + 4 * lane; const f32x4 gv = *(const f32x4*)(fg + d);
            *(f32x4*)(a.out + (size_t)r * DM + d) = m[j] * rstd * gv; }
    }
}

#define XB_TMO      128
#define XB_XCNT(j)  (256  + 64 * (j))
#define XB_XSUB(j)  (1280 + 64 * (j))
#define XB_XGEN(j)  (2304 + 64 * (j))
#define XB_TOP      3328
#define XB_TOPGEN   3392
#define XCD_BAR_WORDS 3456
#define XB_SPIN_CAP (1u << 18)
__device__ __forceinline__ unsigned xb_ld(unsigned* p)              { return __hip_atomic_load(p, __ATOMIC_RELAXED, __HIP_MEMORY_SCOPE_AGENT); }
__device__ __forceinline__ unsigned xb_add(unsigned* p, unsigned v) { return __hip_atomic_fetch_add(p, v, __ATOMIC_RELAXED, __HIP_MEMORY_SCOPE_AGENT); }
__device__ __forceinline__ unsigned xb_xcc_id() { return (unsigned)__builtin_amdgcn_s_getreg((3 << 11) | 20) & 0xFu; }
#define XB_SPIN(cond, bar) do { unsigned _sp = 0; while (cond) { __builtin_amdgcn_s_sleep(1); \
    if ((++_sp & 255u) == 0u) { if (xb_ld(&(bar)[XB_TMO])) break; if (_sp > XB_SPIN_CAP) { atomicAdd(&(bar)[XB_TMO], 1u); break; } } } } while (0)
struct XcdBarrier { unsigned* bar; unsigned x; volatile LAS unsigned* st; };
__device__ __forceinline__ XcdBarrier xcd_barrier_post(unsigned* bar, volatile LAS unsigned* st) {
    XcdBarrier b; b.bar = bar; b.x = xb_xcc_id(); b.st = st;
    if (threadIdx.x == 0) (void)xb_add(&bar[XB_XCNT(b.x)], 1u);
    return b;
}
__device__ __forceinline__ void xcd_barrier_complete(unsigned* bar, unsigned x, unsigned& nloc, unsigned& nx) {
    const unsigned G = gridDim.x * gridDim.y * gridDim.z;
    unsigned sum, cnt, mine, sp = 0u;
    for (;;) {
        sum = 0u; cnt = 0u; mine = 0u;
#pragma unroll
        for (unsigned j = 0; j < 16; ++j) { const unsigned c = xb_ld(&bar[XB_XCNT(j)]); sum += c; cnt += (c > 0u) ? 1u : 0u; mine = (j == x) ? c : mine; }
        if (sum == G) break;
        __builtin_amdgcn_s_sleep(1);
        if ((++sp & 255u) == 0u) { if (xb_ld(&bar[XB_TMO])) break; if (sp > XB_SPIN_CAP) { atomicAdd(&bar[XB_TMO], 1u); break; } }
    }
    nloc = mine > 0u ? mine : 1u; nx = cnt > 0u ? cnt : 1u;
}
__device__ __forceinline__ void xcd_barrier(const XcdBarrier& b) {
    asm volatile("s_waitcnt vmcnt(0)" ::: "memory");
    __syncthreads();
    if (threadIdx.x == 0) {
        unsigned* bar = b.bar;
        __builtin_amdgcn_s_waitcnt(0);
        unsigned nloc = b.st[0], nx = b.st[1];
        if (nloc == 0u) { xcd_barrier_complete(bar, b.x, nloc, nx); b.st[0] = nloc; b.st[1] = nx; }
        const unsigned old = xb_add(&bar[XB_XSUB(b.x)], 1u);
        const unsigned gen = old / nloc;
        if (old + 1u == (gen + 1u) * nloc) {
            __builtin_amdgcn_fence(__ATOMIC_RELEASE, "agent");
            asm volatile("s_waitcnt vmcnt(0)" ::: "memory");
            const unsigned og = xb_add(&bar[XB_TOP], 1u);
            const unsigned tg = og / nx;
            if (og + 1u == (tg + 1u) * nx) xb_add(&bar[XB_TOPGEN], 1u);
            else XB_SPIN(xb_ld(&bar[XB_TOPGEN]) == tg, bar);
            __builtin_amdgcn_fence(__ATOMIC_ACQUIRE, "agent");
            xb_add(&bar[XB_XGEN(b.x)], 1u);
            asm volatile("s_waitcnt vmcnt(0)" ::: "memory");
        } else {
            XB_SPIN(xb_ld(&bar[XB_XGEN(b.x)]) == gen, bar);
            __builtin_amdgcn_fence(__ATOMIC_ACQUIRE, "agent");
            asm volatile("s_waitcnt vmcnt(0)" ::: "memory");
        }
    }
    __syncthreads();
}

constexpr int NPHASES = 15;
__global__ void __launch_bounds__(NTHREADS, 2) mega(Args a) {
    extern __shared__ __attribute__((aligned(16))) unsigned char lds_raw[];
    LAS unsigned char* lds = (LAS unsigned char*)lds_raw;
    const int lo = a.ph_lo, hi = a.ph_hi;
    unsigned char* ws = a.ws;
#if USE_CG_SYNC
    cg::grid_group grid = cg::this_grid();
#define GRID_SYNC() grid.sync()
#else
    volatile LAS unsigned* bst = (volatile LAS unsigned*)(lds + LDS_BYTES - 16);
    if (threadIdx.x < 2) bst[threadIdx.x] = 0u;
    __syncthreads();
    XcdBarrier xbar = xcd_barrier_post((unsigned*)(ws + WS_CTL), bst);
#define GRID_SYNC() xcd_barrier(xbar)
#endif
#define IN(k) (lo <= (k) && (k) < hi)
#define SEAM(k) do { if (IN(k) && IN((k) + 1)) GRID_SYNC(); } while (0)
#define PH(k, ...) do { if (IN(k)) { __VA_ARGS__; if ((PROBE_MASK >> (k)) & 1u) { GRID_SYNC(); __VA_ARGS__; } } SEAM(k); } while (0)
    PH(0, phase0(a, lds));
    PH(1, phase_norm_tile<0>(a, lds));
    PH(2, {
        SchedPlain S; S.init(NROWS / 256, WIN_ROWS / 256, gridDim.x, blockIdx.x); S.A = (const char*)(ws + WS_H); S.B = (const char*)(ws + WS_WIN); S.tstep = (size_t)256 * DM * 2;
        EpiInProj E{(bf16*)(ws + WS_P)};
        pg8::gemm_phase<EpiInProj, SchedPlain, false, true, true>(lds, DM, S, E); });
    PH(3, { for (int it = blockIdx.x; it < 272; it += gridDim.x) gla_passA(a, lds, it); });
    PH(4, gla_passB(a));
    PH(5, { for (int it = blockIdx.x; it < 256; it += gridDim.x) gla_passC(a, lds, it); });
    PH(6, phase_gla_merge(a));
    PH(7, phase_f1(a, lds));
    PH(8, phase_f34(a, lds));
    PH(9, {
        SchedPlain S; S.init(NLAT / 256, DM / 256, gridDim.x, blockIdx.x); S.A = (const char*)(ws + WS_YCAT); S.B = (const char*)(ws + WS_WOUT); S.tstep = (size_t)256 * DM * 2;
        EpiOutProj E{a.in[0], (float*)(ws + WS_XL), (const float*)(ws + WS_ADA)};
        pg8::gemm_phase<EpiOutProj, SchedPlain, false, true, true>(lds, DM, S, E); });
    PH(10, phase_norm_tile<1>(a, lds));
    PH(11, phase_topk(a, lds));
    PH(12, {
        SchedMoeUp S; S.init(256, 8, gridDim.x, blockIdx.x); S.A = (const char*)(ws + WS_HF); S.B = (const char*)(ws + WS_WGU); S.tok = (const int*)(ws + WS_TOK);
        EpiSwiglu E{(bf16*)(ws + WS_HID)};
        pg8::gemm_phase<EpiSwiglu, SchedMoeUp, true, true, true>(lds, DM, S, E); });
    PH(13, {
        SchedMoeDown S; S.init(256, 8, gridDim.x, blockIdx.x); S.A = (const char*)(ws + WS_HID); S.B = (const char*)(ws + WS_WD);
        EpiBf16 E{(bf16*)(ws + WS_YE), DM};
        pg8::gemm_phase<EpiBf16, SchedMoeDown, false, true, true>(lds, DEXP, S, E); });
    PH(14, phase_final(a));
#undef PH
#undef IN
#undef SEAM
}

#ifndef N_LAUNCH_MODE
#define N_LAUNCH_MODE 1
#endif
extern "C" void kernel_launch(void* const* d_in, const int* in_sizes, int n_in, void* d_out, int out_size, void* d_ws, size_t ws_size, hipStream_t stream) {
    static int grid = 0;
    if (grid == 0) {
        if (n_in != 20 || out_size != NLAT * DM || ws_size < WS_END) { fprintf(stderr, "kernel_launch: unexpected sizes n_in %d out %d ws %zu\n", n_in, out_size, ws_size); grid = -1; return; }
        int dev = 0, cus = 0, per_cu = 0;
        (void)hipGetDevice(&dev); (void)hipDeviceGetAttribute(&cus, hipDeviceAttributeMultiprocessorCount, dev);
        if (hipFuncSetAttribute((const void*)mega, hipFuncAttributeMaxDynamicSharedMemorySize, LDS_BYTES) != hipSuccess) { fprintf(stderr, "kernel_launch: hipFuncSetAttribute failed\n"); grid = -1; return; }
        (void)hipOccupancyMaxActiveBlocksPerMultiprocessor(&per_cu, (const void*)mega, NTHREADS, LDS_BYTES);
        if (per_cu < 1) { fprintf(stderr, "kernel_launch: occupancy query reports %d blocks per CU\n", per_cu); per_cu = 1; }
        (void)hipGetLastError();
        grid = cus * 1;
    }
    if (grid < 0) return;
    Args a{};
    for (int i = 0; i < 20; ++i) a.in[i] = (const float*)d_in[i];
    a.out = (float*)d_out; a.ws = (unsigned char*)d_ws;
#if N_LAUNCH_MODE == 0
    for (int p = 0; p < NPHASES; ++p) { a.ph_lo = p; a.ph_hi = p + 1; hipLaunchKernelGGL(mega, dim3(grid), dim3(NTHREADS), LDS_BYTES, stream, a); }
#else
    a.ph_lo = 0; a.ph_hi = NPHASES;
#if USE_CG_SYNC
    void* args[] = {&a};
    hipError_t e = hipLaunchCooperativeKernel((void*)mega, dim3(grid), dim3(NTHREADS), args, LDS_BYTES, stream);
    if (e != hipSuccess) fprintf(stderr, "cooperative launch failed: %s (grid %d)\n", hipGetErrorString(e), grid);
#else
    if (hipMemsetAsync((char*)d_ws + WS_CTL, 0, CTL_BYTES, stream) != hipSuccess) { fprintf(stderr, "kernel_launch: memset of control words failed\n"); return; }
    hipLaunchKernelGGL(mega, dim3(grid), dim3(NTHREADS), LDS_BYTES, stream, a);
#endif
#endif
}
```

```cpp
#include <hip/hip_runtime.h>
#include <hip/hip_cooperative_groups.h>
#include <cstdio>
#include <cstdint>
namespace cg = cooperative_groups;

#define LAS __attribute__((address_space(3)))
typedef unsigned short bf16;
typedef short bf16x8 __attribute__((ext_vector_type(8)));
typedef float f32x4 __attribute__((ext_vector_type(4)));
typedef float f32x2 __attribute__((ext_vector_type(2)));
typedef unsigned u32x4 __attribute__((ext_vector_type(4)));
typedef unsigned u32x2 __attribute__((ext_vector_type(2)));

constexpr int NB = 2, SEQ = 16384, DM = 2048, CTXL = 256;
constexpr int NLAT = NB * SEQ;
constexpr int NROWS = NLAT + NB * CTXL;
constexpr int PROJW = 4128;
constexpr int NE = 16, CAP = 2048, DEXP = 1024;
constexpr int PW = 4096;
constexpr int WIN_ROWS = 4096;
constexpr float EPS = 1e-6f;

constexpr size_t MiB = 1u << 20;
constexpr size_t WS_ADA = 0;
constexpr size_t WS_TW = 1 * MiB;
constexpr size_t WS_FC = 1 * MiB + 256 * 1024;
constexpr size_t WS_FS = 1 * MiB + 320 * 1024;
constexpr size_t WS_WRH = 1 * MiB + 384 * 1024;
constexpr size_t WS_WRL = 1 * MiB + 448 * 1024;
constexpr size_t WS_Z = 2 * MiB;
constexpr size_t WS_AFF = 8 * MiB;
constexpr size_t WS_TOK = 10 * MiB;
constexpr size_t WS_GATE = 11 * MiB;
constexpr size_t WS_SEL = 12 * MiB;
constexpr size_t WS_ST0 = 14 * MiB;
constexpr size_t WS_CTL = 16 * MiB;
constexpr size_t CTL_BYTES = 65536;
constexpr size_t WS_ADAP = 20 * MiB;
constexpr size_t WS_WIN = 32 * MiB;
constexpr size_t WS_WOUT = 50 * MiB;
constexpr size_t WS_WGU = 58 * MiB;
constexpr size_t WS_WD = 186 * MiB;
constexpr size_t WS_P = 250 * MiB;
constexpr size_t WS_HF = 250 * MiB;
constexpr size_t WS_HID = 378 * MiB;
constexpr size_t WS_FX = 250 * MiB;
constexpr size_t WS_FA = 510 * MiB;
constexpr size_t WS_FAI = 574 * MiB;
constexpr size_t WS_H = 510 * MiB;
constexpr size_t WS_OF = 510 * MiB;
constexpr size_t WS_OB = 574 * MiB;
constexpr size_t WS_T = 638 * MiB;
constexpr size_t WS_SST = 670 * MiB;
constexpr size_t WS_DT = 702 * MiB;
constexpr size_t WS_DLT = 510 * MiB;
constexpr size_t WS_YCAT = 766 * MiB;
constexpr size_t WS_YE = 766 * MiB;
constexpr size_t WS_END = 1022 * MiB;

#ifndef USE_CG_SYNC
#define USE_CG_SYNC 0
#endif
#ifndef PROBE_EPI
#define PROBE_EPI 0
#endif
#ifndef PROBE_P0
#define PROBE_P0 0
#endif
#ifndef PROBE_MASK
#define PROBE_MASK 0u
#endif
constexpr int LDS_BYTES = 163840;
constexpr int NTHREADS = 512;

struct Args {
    const float* in[20];
    float* out;
    unsigned char* ws;
    int ph_lo, ph_hi;
};

__device__ __forceinline__ float bf2f(bf16 v) { return __uint_as_float(((unsigned)v) << 16); }
typedef __bf16 bf16x2_t __attribute__((ext_vector_type(2)));
__device__ __forceinline__ unsigned pk2(float lo, float hi) { const f32x2 v = {lo, hi}; return __builtin_bit_cast(unsigned, __builtin_convertvector(v, bf16x2_t)); }
__device__ __forceinline__ unsigned f2bf(float f) { return pk2(f, 0.f) & 0xffffu; }
__device__ __forceinline__ float wave_sum(float v) {
#pragma unroll
    for (int o = 1; o < 64; o <<= 1) v += __shfl_xor(v, o);
    return v;
}
__device__ __forceinline__ float silu_f(float x) { return x / (1.f + __expf(-x)); }
__device__ __forceinline__ float logsigmoid_f(float x) { return fminf(x, 0.f) - log1pf(expf(-fabsf(x))); }

namespace pg8 {
constexpr int BM = 256, BK = 64, HALF = 128, HTB = HALF * BK * 2, STAGE_BYTES = 8 * HTB, NXCD = 8, WGM = 8;
__host__ __device__ __forceinline__ int lds_byte(int r, int c) { const int st = (r >> 4) * 2 + (c >> 5), rr = r & 15, cc = c & 31, ob = rr * 64 + cc * 2; return st * 1024 + (ob ^ (((ob >> 9) & 1) << 5)); }
__host__ __device__ __forceinline__ void stage_rc(int b, int& R, int& C) { const int st = b / 1024, sb = b % 1024, swz = sb ^ (((sb >> 9) & 1) << 5); R = (st >> 1) * 16 + swz / 64; C = (st & 1) * 32 + (swz % 64) / 2; }
__host__ __device__ __forceinline__ int perm32(int rho) { const int n = rho >> 4, i = rho & 15; return 8 * (i >> 2) + 4 * n + (i & 3); }
struct Unit { int pm, pn; };
__device__ __forceinline__ unsigned cvt_pk_bf16(float lo, float hi) { return pk2(lo, hi); }

struct OrderBase {
    int nM, nN, nwg, G, c;
    __device__ void init(int nM_, int nN_, int G_, int c_) { nM = nM_; nN = nN_; nwg = nM * nN; G = G_; c = c_; }
    __device__ bool next(int i, Unit& u) const {
        const long L = (long)i * G + c; if (L >= nwg) return false;
        int wgid = (int)L; { const int q = nwg / NXCD, r = nwg % NXCD, xcd = wgid % NXCD, off = wgid / NXCD; wgid = (xcd < r ? xcd * (q + 1) : r * (q + 1) + (xcd - r) * q) + off; }
        const int nig = WGM * nN, gid = wgid / nig, fm = gid * WGM, gsz = (nM - fm) < WGM ? (nM - fm) : WGM;
        u.pm = fm + ((wgid % nig) % gsz); u.pn = (wgid % nig) / gsz; return true;
    }
};

template <class Epi, class Sched, bool GATHER, bool ALIGN_EPI, bool SP2>
__device__ __forceinline__ void gemm_phase(LAS unsigned char* lds, const int K, const Sched& S, const Epi& E) {
    const int tid = threadIdx.x, wid = __builtin_amdgcn_readfirstlane(tid >> 6), lane = tid & 63, wr = wid >> 2, wc = wid & 3, fr = lane & 15, fq = lane >> 4;
    const int nt = K / BK;
    unsigned voffA[2], voffA1[2], voffB[2];
    int RA[2], CA[2];
#pragma unroll
    for (int i = 0; i < 2; ++i) { int R, C; stage_rc(tid * 16 + i * 8192, R, C); const int Rb = Epi::PERM ? ((R & ~31) + perm32(R & 31)) : R;
        RA[i] = R; CA[i] = C;
        voffA[i] = (unsigned)(R * K + C) * 2u; voffA1[i] = voffA[i]; voffB[i] = (unsigned)(Rb * K + C) * 2u; }
    const size_t kstep = (size_t)(BK * 2);
    const size_t hstep = (size_t)HALF * K * 2;
    const size_t hstepA = GATHER ? 0 : hstep;
    const unsigned ldsw = (unsigned)wid * 1024u;
    const int aoff = lds_byte(wr * 64 + fr, fq * 8), boff = lds_byte(wc * 32 + fr, fq * 8);
#define PG8_SA(b, h) (((b) * 2 + (h)) * HTB)
#define PG8_SB(b, h) ((4 + (b) * 2 + (h)) * HTB)
#define PG8_STAGE(bufoff, gbase, voff) do { _Pragma("unroll") for (int _i = 0; _i < 2; ++_i) \
        __builtin_amdgcn_global_load_lds((const unsigned*)((const char*)(gbase) + (voff)[_i]), (LAS unsigned*)(lds + (bufoff) + ldsw + _i * 8192), 16, 0, 0); } while (0)
#define PG8_LDA(dst, b, h) do { _Pragma("unroll") for (int m = 0; m < 4; ++m) _Pragma("unroll") for (int k = 0; k < 2; ++k) dst[m][k] = *(const LAS bf16x8*)(lds + PG8_SA(b, h) + aoff + m * 2048 + k * 1024); } while (0)
#define PG8_LDB(dst, b, h) do { _Pragma("unroll") for (int n = 0; n < 2; ++n) _Pragma("unroll") for (int k = 0; k < 2; ++k) dst[n][k] = *(const LAS bf16x8*)(lds + PG8_SB(b, h) + boff + n * 2048 + k * 1024); } while (0)
#define PG8_MMA(ai, bj, At, Bt) do { __builtin_amdgcn_s_setprio(1); _Pragma("unroll") for (int m = 0; m < 4; ++m) _Pragma("unroll") for (int n = 0; n < 2; ++n) _Pragma("unroll") for (int k = 0; k < 2; ++k) \
        acc[ai][bj][m][n] = __builtin_amdgcn_mfma_f32_16x16x32_bf16(Bt[n][k], At[m][k], acc[ai][bj][m][n], 0, 0, 0); __builtin_amdgcn_s_setprio(0); } while (0)
#define PG8_WAIT_V(n) asm volatile("s_waitcnt vmcnt(" #n ")" ::: "memory")
#define PG8_WAIT_L(n) asm volatile("s_waitcnt lgkmcnt(" #n ")" ::: "memory")
#define PG8_BAR __builtin_amdgcn_s_barrier()
#define PG8_SCHED __builtin_amdgcn_sched_barrier(0)
    Unit cur, nxt; int ui = 0;
    if (!S.next(0, cur)) return;
    f32x4 acc[2][2][4][2];
#pragma unroll
    for (int a = 0; a < 2; ++a)
#pragma unroll
        for (int b = 0; b < 2; ++b)
#pragma unroll
            for (int m = 0; m < 4; ++m)
#pragma unroll
                for (int n = 0; n < 2; ++n) acc[a][b][m][n] = (f32x4){0.f, 0.f, 0.f, 0.f};
    bf16x8 At[4][2], B0[2][2], B1[2][2];
    const char* cA = S.abase(cur); const char* cB = S.bbase(cur);
    if constexpr (GATHER) {
#pragma unroll
        for (int i = 0; i < 2; ++i) { voffA[i] = ((unsigned)S.arow(cur, RA[i]) * (unsigned)K + (unsigned)CA[i]) * 2u; voffA1[i] = ((unsigned)S.arow(cur, HALF + RA[i]) * (unsigned)K + (unsigned)CA[i]) * 2u; }
    }
    static_assert(SP2, "only the SP2 loop is kept");
    PG8_STAGE(PG8_SB(0, 0), cB, voffB); PG8_STAGE(PG8_SB(0, 1), cB + hstep, voffB); PG8_STAGE(PG8_SA(0, 0), cA, voffA); PG8_STAGE(PG8_SA(0, 1), cA + hstepA, voffA1);
    if (wr == 1) PG8_BAR;
    PG8_WAIT_V(2); PG8_BAR;
    PG8_STAGE(PG8_SB(1, 0), cB + kstep, voffB); PG8_STAGE(PG8_SA(1, 0), cA + kstep, voffA); PG8_STAGE(PG8_SB(1, 1), cB + hstep + kstep, voffB);
    PG8_WAIT_V(6); PG8_BAR;
    for (;;) {
        const bool has_next = S.next(ui + 1, nxt);
        const char* nA = has_next ? S.abase(nxt) : cA; const char* nB = has_next ? S.bbase(nxt) : cB;
        for (int t = 0; t < nt; t += 2) {
            const bool last = (t == nt - 2);
            const char* a1 = cA + (size_t)(t + 1) * kstep;
            const char* a2 = last ? nA : cA + (size_t)(t + 2) * kstep; const char* b2 = last ? nB : cB + (size_t)(t + 2) * kstep;
            const char* a3 = a2 + kstep; const char* b3 = b2 + kstep;
            PG8_LDB(B0, 0, 0); PG8_LDB(B1, 0, 1); PG8_SCHED; PG8_LDA(At, 0, 0); PG8_STAGE(PG8_SA(1, 1), a1 + hstepA, voffA1);
            if constexpr (GATHER) { if (last && has_next) {
#pragma unroll
                for (int i = 0; i < 2; ++i) { voffA[i] = ((unsigned)S.arow(nxt, RA[i]) * (unsigned)K + (unsigned)CA[i]) * 2u; voffA1[i] = ((unsigned)S.arow(nxt, HALF + RA[i]) * (unsigned)K + (unsigned)CA[i]) * 2u; } } }
            PG8_WAIT_V(8); PG8_WAIT_L(0); PG8_BAR; PG8_MMA(0, 0, At, B0); PG8_MMA(0, 1, At, B1); PG8_BAR; PG8_SCHED;
            PG8_LDA(At, 0, 1); PG8_STAGE(PG8_SB(0, 0), b2, voffB); PG8_STAGE(PG8_SB(0, 1), b2 + hstep, voffB); PG8_STAGE(PG8_SA(0, 0), a2, voffA);
            PG8_WAIT_V(8); PG8_WAIT_L(0); PG8_BAR; PG8_MMA(1, 0, At, B0); PG8_MMA(1, 1, At, B1); PG8_BAR; PG8_SCHED;
            PG8_LDB(B0, 1, 0); PG8_LDB(B1, 1, 1); PG8_SCHED; PG8_LDA(At, 1, 0); PG8_STAGE(PG8_SA(0, 1), a2 + hstepA, voffA1);
            PG8_WAIT_V(8); PG8_WAIT_L(0); PG8_BAR; PG8_MMA(0, 0, At, B0); PG8_MMA(0, 1, At, B1); PG8_BAR; PG8_SCHED;
            PG8_LDA(At, 1, 1); PG8_STAGE(PG8_SB(1, 0), b3, voffB); PG8_STAGE(PG8_SB(1, 1), b3 + hstep, voffB); PG8_STAGE(PG8_SA(1, 0), a3, voffA);
            PG8_WAIT_V(8); PG8_WAIT_L(0); PG8_BAR; PG8_MMA(1, 0, At, B0); PG8_MMA(1, 1, At, B1); PG8_BAR; PG8_SCHED;
        }
        if constexpr (ALIGN_EPI) { if (wr == 0) PG8_BAR; }
        E(acc, cur, wr, wc, fr, fq);
        if (PROBE_EPI == 1) { asm volatile("" ::: "memory"); E(acc, cur, wr, wc, fr, fq); }
        if (PROBE_EPI == 2) { asm volatile("s_waitcnt vmcnt(0)" ::: "memory"); }
        if (!has_next) break;
#pragma unroll
        for (int a = 0; a < 2; ++a)
#pragma unroll
            for (int b = 0; b < 2; ++b)
#pragma unroll
                for (int m = 0; m < 4; ++m)
#pragma unroll
                    for (int n = 0; n < 2; ++n) acc[a][b][m][n] = (f32x4){0.f, 0.f, 0.f, 0.f};
        cur = nxt; cA = nA; cB = nB; ++ui;
        if constexpr (ALIGN_EPI) { if (wr == 1) PG8_BAR; }
    }
    PG8_WAIT_V(0);
    if constexpr (!ALIGN_EPI) { if (wr == 0) PG8_BAR; }
    PG8_BAR;
#undef PG8_SA
#undef PG8_SB
#undef PG8_STAGE
#undef PG8_LDA
#undef PG8_LDB
#undef PG8_MMA
#undef PG8_WAIT_V
#undef PG8_WAIT_L
#undef PG8_BAR
#undef PG8_SCHED
}
}
using pg8::Unit;
using pg8::cvt_pk_bf16;
constexpr int HALF = pg8::HALF, BM = pg8::BM;

struct SchedPlain : pg8::OrderBase {
    const char* A; const char* B; size_t tstep;
    __device__ __forceinline__ const char* abase(const Unit& u) const { return A + (size_t)u.pm * tstep; }
    __device__ __forceinline__ const char* bbase(const Unit& u) const { return B + (size_t)u.pn * tstep; }
    __device__ __forceinline__ int arow(const Unit&, int) const { return 0; }
};
struct SchedOne {
    const char* A; const char* B; size_t tstep; int pm, pn;
    __device__ __forceinline__ bool next(int i, Unit& u) const { if (i != 0) return false; u.pm = pm; u.pn = pn; return true; }
    __device__ __forceinline__ const char* abase(const Unit& u) const { return A + (size_t)u.pm * tstep; }
    __device__ __forceinline__ const char* bbase(const Unit& u) const { return B + (size_t)u.pn * tstep; }
    __device__ __forceinline__ int arow(const Unit&, int) const { return 0; }
};
struct SchedMoeUp : pg8::OrderBase {
    const char* A; const char* B; const int* tok;
    __device__ __forceinline__ const char* abase(const Unit&) const { return A; }
    __device__ __forceinline__ const char* bbase(const Unit& u) const { return B + ((size_t)(u.pm >> 4) * 2048 + (size_t)u.pn * 256) * (size_t)(DM * 2); }
    __device__ __forceinline__ int arow(const Unit& u, int r) const { const int e = u.pm >> 4, b = (u.pm >> 3) & 1, mt = u.pm & 7; return b * SEQ + tok[(b * NE + e) * CAP + mt * 256 + r]; }
};
struct SchedMoeDown : pg8::OrderBase {
    const char* A; const char* B;
    __device__ __forceinline__ const char* abase(const Unit& u) const { return A + (size_t)u.pm * 256 * (size_t)(DEXP * 2); }
    __device__ __forceinline__ const char* bbase(const Unit& u) const { return B + ((size_t)(u.pm >> 4) * 2048 + (size_t)u.pn * 256) * (size_t)(DEXP * 2); }
    __device__ __forceinline__ int arow(const Unit&, int) const { return 0; }
};

struct EpiInProj {
    static constexpr bool PERM = true;
    bf16* P;
    __device__ __forceinline__ void operator()(const f32x4 (&acc)[2][2][4][2], const Unit& u, int wr, int wc, int fr, int fq) const {
        const int row0 = u.pm * BM + wr * 64 + fr, col0 = u.pn * BM + wc * 32 + 8 * fq;
#pragma unroll
        for (int ai = 0; ai < 2; ++ai)
#pragma unroll
            for (int m = 0; m < 4; ++m) { bf16* rowp = P + (size_t)(row0 + ai * HALF + m * 16) * PW + col0;
#pragma unroll
                for (int bj = 0; bj < 2; ++bj) { const f32x4 v0 = acc[ai][bj][m][0], v1 = acc[ai][bj][m][1];
                    u32x4 w; w.x = cvt_pk_bf16(v0[0], v0[1]); w.y = cvt_pk_bf16(v0[2], v0[3]); w.z = cvt_pk_bf16(v1[0], v1[1]); w.w = cvt_pk_bf16(v1[2], v1[3]);
                    *(u32x4*)(rowp + bj * HALF) = w; } }
    }
};
struct EpiOutProj {
    static constexpr bool PERM = true;
    bf16* D; const float* ada;
    __device__ __forceinline__ void operator()(const f32x4 (&acc)[2][2][4][2], const Unit& u, int wr, int wc, int fr, int fq) const {
        const int row0 = u.pm * BM + wr * 64 + fr, col0 = u.pn * BM + wc * 32 + 8 * fq;
        const int b = (u.pm * BM) / SEQ;
        const float* g1 = ada + (size_t)b * 12288 + 2 * DM;
        f32x4 gv[2][2];
#pragma unroll
        for (int bj = 0; bj < 2; ++bj)
#pragma unroll
            for (int n = 0; n < 2; ++n) gv[bj][n] = *(const f32x4*)(g1 + col0 + bj * HALF + 4 * n);
#pragma unroll
        for (int ai = 0; ai < 2; ++ai)
#pragma unroll
            for (int m = 0; m < 4; ++m) { bf16* rowp = D + (size_t)(row0 + ai * HALF + m * 16) * DM + col0;
#pragma unroll
                for (int bj = 0; bj < 2; ++bj) { const f32x4 v0 = acc[ai][bj][m][0] * gv[bj][0], v1 = acc[ai][bj][m][1] * gv[bj][1];
                    u32x4 w; w.x = cvt_pk_bf16(v0[0], v0[1]); w.y = cvt_pk_bf16(v0[2], v0[3]); w.z = cvt_pk_bf16(v1[0], v1[1]); w.w = cvt_pk_bf16(v1[2], v1[3]);
                    *(u32x4*)(rowp + bj * HALF) = w; } }
    }
};
struct EpiSwiglu {
    static constexpr bool PERM = true;
    bf16* HID;
    __device__ __forceinline__ void operator()(const f32x4 (&acc)[2][2][4][2], const Unit& u, int wr, int wc, int fr, int fq) const {
        const int row0 = u.pm * BM + wr * 64 + fr, col0 = u.pn * 128 + wc * 32 + 8 * fq;
#pragma unroll
        for (int ai = 0; ai < 2; ++ai)
#pragma unroll
            for (int m = 0; m < 4; ++m) { bf16* rowp = HID + (size_t)(row0 + ai * HALF + m * 16) * DEXP + col0;
                f32x4 h0, h1;
#pragma unroll
                for (int j = 0; j < 4; ++j) { h0[j] = silu_f(acc[ai][0][m][0][j]) * acc[ai][1][m][0][j]; h1[j] = silu_f(acc[ai][0][m][1][j]) * acc[ai][1][m][1][j]; }
                u32x4 w; w.x = cvt_pk_bf16(h0[0], h0[1]); w.y = cvt_pk_bf16(h0[2], h0[3]); w.z = cvt_pk_bf16(h1[0], h1[1]); w.w = cvt_pk_bf16(h1[2], h1[3]);
                *(u32x4*)(rowp) = w; }
    }
};
struct EpiBf16 {
    static constexpr bool PERM = true;
    bf16* O; int ldc;
    __device__ __forceinline__ void operator()(const f32x4 (&acc)[2][2][4][2], const Unit& u, int wr, int wc, int fr, int fq) const {
        const int row0 = u.pm * BM + wr * 64 + fr, col0 = u.pn * BM + wc * 32 + 8 * fq;
#pragma unroll
        for (int ai = 0; ai < 2; ++ai)
#pragma unroll
            for (int m = 0; m < 4; ++m) { bf16* rowp = O + (size_t)(row0 + ai * HALF + m * 16) * ldc + col0;
#pragma unroll
                for (int bj = 0; bj < 2; ++bj) { const f32x4 v0 = acc[ai][bj][m][0], v1 = acc[ai][bj][m][1];
                    u32x4 w; w.x = cvt_pk_bf16(v0[0], v0[1]); w.y = cvt_pk_bf16(v0[2], v0[3]); w.z = cvt_pk_bf16(v1[0], v1[1]); w.w = cvt_pk_bf16(v1[2], v1[3]);
                    *(u32x4*)(rowp + bj * HALF) = w; } }
    }
};

__device__ __forceinline__ void transpose_item(const float* src, int ldsrc, int scol0, int k0, bf16* dst, size_t drow0, int ldd, LAS float* scr, int lane) {
#pragma unroll 8
    for (int i = 0; i < 32; ++i) { const int kk = 2 * i + (lane >> 5); scr[kk * 33 + (lane & 31)] = src[(size_t)(k0 + kk) * ldsrc + scol0 + (lane & 31)]; }
    asm volatile("s_waitcnt lgkmcnt(0)" ::: "memory");
    const int c = lane & 7;
#pragma unroll
    for (int j = 0; j < 4; ++j) { const int n = (lane >> 3) + 8 * j; const LAS float* s = scr + (8 * c) * 33 + n;
        u32x4 o; o.x = pk2(s[0 * 33], s[1 * 33]); o.y = pk2(s[2 * 33], s[3 * 33]); o.z = pk2(s[4 * 33], s[5 * 33]); o.w = pk2(s[6 * 33], s[7 * 33]);
        *(u32x4*)(dst + (drow0 + n) * (size_t)ldd + k0 + 8 * c) = o; }
    asm volatile("s_waitcnt lgkmcnt(0)" ::: "memory");
}

struct T64 { const float* src; bf16* dst; int ldsrc, ldd; };
__device__ __forceinline__ T64 decode_t64(const Args& a, int r) {
    unsigned char* ws = a.ws; T64 t;
    if (r < 2048) { const int kb = r >> 6, nb = r & 63; const int scol = nb < 48 ? nb * 64 : 3104 + (nb - 48) * 64;
        t.src = a.in[7] + (size_t)(kb * 64) * PROJW + scol; t.ldsrc = PROJW; t.dst = (bf16*)(ws + WS_WIN) + (size_t)(nb * 64) * DM + kb * 64; t.ldd = DM; return t; }
    r -= 2048;
    if (r < 1024) { const int kb = r >> 5, nb = r & 31;
        t.src = a.in[13] + (size_t)(kb * 64) * DM + nb * 64; t.ldsrc = DM; t.dst = (bf16*)(ws + WS_WOUT) + (size_t)(nb * 64) * DM + kb * 64; t.ldd = DM; return t; }
    r -= 1024;
    if (r < 16384) { const int up = r >= 8192; if (up) r -= 8192; const int e = r >> 9, rr = r & 511, kb = rr >> 4, nb = rr & 15, n0 = nb * 64;
        t.src = (up ? a.in[17] : a.in[16]) + (size_t)e * DM * DEXP + (size_t)(kb * 64) * DEXP + n0; t.ldsrc = DEXP;
        t.dst = (bf16*)(ws + WS_WGU) + ((size_t)e * 2048 + (size_t)(n0 >> 7) * 256 + (n0 & 127) + (up ? 128 : 0)) * DM + kb * 64; t.ldd = DM; return t; }
    r -= 16384;
    { const int e = r >> 9, rr = r & 511, kb = rr >> 5, nb = rr & 31;
        t.src = a.in[18] + (size_t)e * DEXP * DM + (size_t)(kb * 64) * DM + nb * 64; t.ldsrc = DM;
        t.dst = (bf16*)(ws + WS_WD) + ((size_t)e * 2048 + nb * 64) * DEXP + kb * 64; t.ldd = DEXP; return t; }
}
__device__ __forceinline__ void t64_load(const T64& t, int lane, f32x4 (&v)[16]) {
    const int krow = lane >> 4, c4 = lane & 15;
#pragma unroll
    for (int i = 0; i < 16; ++i) v[i] = *(const f32x4*)(t.src + (size_t)(4 * i + krow) * t.ldsrc + 4 * c4);
}
__device__ __forceinline__ void t64_finish(const T64& t, int lane, const f32x4 (&v)[16], LAS float* scr) {
    const int krow = lane >> 4, c4 = lane & 15;
#pragma unroll
    for (int i = 0; i < 16; ++i) { LAS float* p = scr + (4 * i + krow) * 65 + 4 * c4; p[0] = v[i].x; p[1] = v[i].y; p[2] = v[i].z; p[3] = v[i].w; }
    asm volatile("s_waitcnt lgkmcnt(0)" ::: "memory");
    const int c = lane & 7;
#pragma unroll
    for (int j = 0; j < 8; ++j) { const int n = (lane >> 3) + 8 * j; const LAS float* s = scr + (8 * c) * 65 + n;
        u32x4 o; o.x = pk2(s[0 * 65], s[1 * 65]); o.y = pk2(s[2 * 65], s[3 * 65]); o.z = pk2(s[4 * 65], s[5 * 65]); o.w = pk2(s[6 * 65], s[7 * 65]);
        *(u32x4*)(t.dst + (size_t)n * t.ldd + 8 * c) = o; }
    asm volatile("s_waitcnt lgkmcnt(0)" ::: "memory");
}
constexpr int P0_NT64 = 2048 + 1024 + 16384 + 8192;
constexpr int P0_TAIL = 1024;
constexpr int P0_NGEMV = 192;
__device__ __forceinline__ void phase0(const Args& a, LAS unsigned char* lds) {
    const int tid = threadIdx.x, lane = tid & 63, wave = tid >> 6, G = gridDim.x, blk = blockIdx.x;
    unsigned char* ws = a.ws;
    {
        const float* c = a.in[1]; const float* cc = a.in[3]; const float* w_ada = a.in[4]; const float* b_ada = a.in[5];
        float* part = (float*)(ws + WS_ADAP);
        LAS float* red = (LAS float*)lds;
        for (int rep_ = 0; rep_ < 1 + (PROBE_P0 & 1); ++rep_)
        for (int it = blk; it < P0_NGEMV; it += G) {
            const int cb = it % 48, ks = it / 48, col0 = cb * 256 + 4 * lane, r0 = ks * 512 + wave * 64;
            f32x4 a0 = {0.f, 0.f, 0.f, 0.f}, a1 = a0, a2 = a0;
#pragma unroll 16
            for (int r = r0; r < r0 + 64; ++r) {
                const f32x4 w = *(const f32x4*)(w_ada + (size_t)r * 12288 + col0);
                const float s0 = silu_f(c[r]), s1 = silu_f(c[DM + r]), s2 = silu_f(cc[r]);
                a0 += w * s0; a1 += w * s1; a2 += w * s2;
            }
            *(LAS f32x4*)(red + (wave * 3 + 0) * 256 + 4 * lane) = a0; *(LAS f32x4*)(red + (wave * 3 + 1) * 256 + 4 * lane) = a1; *(LAS f32x4*)(red + (wave * 3 + 2) * 256 + 4 * lane) = a2;
            __syncthreads();
            for (int idx = tid; idx < 768; idx += NTHREADS) { const int v = idx >> 8, col = idx & 255; float s = ks == 0 ? b_ada[cb * 256 + col] : 0.f;
#pragma unroll
                for (int w8 = 0; w8 < 8; ++w8) s += red[(w8 * 3 + v) * 256 + col];
                part[(size_t)(ks * 3 + v) * 12288 + cb * 256 + col] = s; }
            __syncthreads();
        }
    }
    LAS float* scr = (LAS float*)(lds + wave * 16640);
    const int gw = blk * 8 + wave, NGW = G * 8;
    constexpr int I_WZ = 32, I_WR = 512, I_TW = 256, I_FT = 256;
    for (int it = gw; it < I_WZ + I_WR + I_TW + I_FT; it += NGW) {
        int r = it;
        if (r < I_WZ) { transpose_item(a.in[7], PROJW, 3072, r * 64, (bf16*)(ws + WS_WIN), (size_t)4096, DM, scr, lane); continue; }
        r -= I_WZ;
        if (r < I_WR) { const int p = r * 64 + lane, e = p >> 11, d = p & 2047; const float wv = a.in[15][d * 16 + e]; const unsigned hi = f2bf(wv); ((bf16*)(ws + WS_WRH))[p] = (bf16)hi; ((bf16*)(ws + WS_WRL))[p] = (bf16)f2bf(wv - bf2f((bf16)hi)); continue; }
        r -= I_WR;
        if (r < I_TW) { const int p = r * 64 + lane; float s, c; sincospif((float)p * (1.0f / 8192.0f), &s, &c); ((f32x2*)(ws + WS_TW))[p] = (f32x2){c, s}; continue; }
        r -= I_TW;
        { const int p = r * 64 + lane, k = p >> 7, l = p & 127; float s, c; sincospif((float)((k * l) & 127) * (1.0f / 64.0f), &s, &c); ((bf16*)(ws + WS_FC))[p] = (bf16)f2bf(c); ((bf16*)(ws + WS_FS))[p] = (bf16)f2bf(s); }
    }
    const int n_gemv_wg = G > P0_NGEMV ? P0_NGEMV : 0;
    const int head_end = n_gemv_wg ? P0_NT64 - P0_TAIL : P0_NT64;
    const int n_head = gw < head_end ? (head_end - gw + NGW - 1) / NGW : 0;
    const int tgw = (blk - n_gemv_wg) * 8 + wave, tstep = (G - n_gemv_wg) * 8;
    const int n_tail = (n_gemv_wg && blk >= n_gemv_wg && tgw < P0_TAIL) ? (P0_TAIL - tgw + tstep - 1) / tstep : 0;
    const int n_items = n_head + n_tail;
    auto item_of = [&](int j) -> int { return j < n_head ? gw + j * NGW : head_end + tgw + (j - n_head) * tstep; };
    for (int rep_ = 0; rep_ < 1 + ((PROBE_P0 >> 1) & 1); ++rep_) {
    f32x4 va[16], vb[16]; T64 ta, tb;
    if (n_items > 0) { ta = decode_t64(a, item_of(0)); t64_load(ta, lane, va); }
    for (int j = 0; j < n_items; j += 2) {
        const bool h1 = j + 1 < n_items, h2 = j + 2 < n_items;
        if (h1) { tb = decode_t64(a, item_of(j + 1)); t64_load(tb, lane, vb); }
        t64_finish(ta, lane, va, scr);
        if (h2) { ta = decode_t64(a, item_of(j + 2)); t64_load(ta, lane, va); }
        if (h1) t64_finish(tb, lane, vb, scr);
    }
    }
}

#define MFMA16(a, b, c) __builtin_amdgcn_mfma_f32_16x16x32_bf16((a), (b), (c), 0, 0, 0)
__device__ __forceinline__ void finalize_ada(const Args& a) {
    const float* part = (const float*)(a.ws + WS_ADAP); float* adaw = (float*)(a.ws + WS_ADA);
    for (int i = blockIdx.x * NTHREADS + threadIdx.x; i < 3 * 12288; i += gridDim.x * NTHREADS) { float s = 0.f;
#pragma unroll
        for (int ks = 0; ks < 4; ++ks) s += part[(size_t)ks * 3 * 12288 + i];
        adaw[i] = s; }
}
constexpr int CW_CTXCNT = 4096;
template <int MODE>
__device__ __forceinline__ void norm_load_tile(const Args& a, int tile, int rl, int wave, int q, f32x4 (&xv)[8][2], u32x4 (&dv)[8]) {
    const int r = tile * 16 + rl;
    const float* s = (MODE == 0 ? (r < NLAT ? a.in[0] + (size_t)r * DM : a.in[2] + (size_t)(r - NLAT) * DM) : a.in[0] + (size_t)r * DM) + 256 * wave + 8 * q;
#pragma unroll
    for (int ks = 0; ks < 8; ++ks) { xv[ks][0] = *(const f32x4*)(s + 32 * ks); xv[ks][1] = *(const f32x4*)(s + 32 * ks + 4); }
    if (MODE == 1) { const bf16* dp = (const bf16*)(a.ws + WS_DLT) + (size_t)r * DM + 256 * wave + 8 * q;
#pragma unroll
        for (int ks = 0; ks < 8; ++ks) dv[ks] = *(const u32x4*)(dp + 32 * ks); }
}
template <int MODE>
__device__ __forceinline__ void phase_norm_tile(const Args& a, LAS unsigned char* lds, int first, int stride, int tile_end) {
    const int tid = threadIdx.x, lane = tid & 63, wave = __builtin_amdgcn_readfirstlane(tid >> 6), rl = lane & 15, q = lane >> 4;
    const float* ada = (const float*)(a.ws + WS_ADA);
    LAS float* gs = (LAS float*)lds;
    LAS float* shv = gs + 3 * DM;
    LAS float* ssred = shv + 3 * DM;
    LAS float* red = ssred + 128;
    { const float* gn = MODE == 0 ? a.in[6] : a.in[14]; const float* part = (const float*)(a.ws + WS_ADAP);
      for (int i = tid; i < 3 * DM; i += NTHREADS) { const int v = i / DM, d = i % DM;
          float sh_, sc_;
          if (MODE == 0) { const float* p0 = part + (size_t)v * 12288; sh_ = 0.f; sc_ = 0.f;
#pragma unroll
              for (int ks = 0; ks < 4; ++ks) { sh_ += p0[(size_t)ks * 3 * 12288 + d]; sc_ += p0[(size_t)ks * 3 * 12288 + DM + d]; } }
          else { const float* base = ada + (size_t)v * 12288 + 3 * DM; sh_ = base[d]; sc_ = base[DM + d]; }
          gs[i] = gn[d] * (1.f + sc_); shv[i] = sh_; }
    }
    bf16x8 wb[2][8];
    if (MODE == 0) { const bf16* Wz = (const bf16*)(a.ws + WS_WIN) + (size_t)4096 * DM;
#pragma unroll
        for (int nt = 0; nt < 2; ++nt)
#pragma unroll
            for (int ks = 0; ks < 8; ++ks) wb[nt][ks] = *(const bf16x8*)(Wz + (size_t)(16 * nt + rl) * DM + 256 * wave + 32 * ks + 8 * q);
    } else { const bf16* WH = (const bf16*)(a.ws + WS_WRH); const bf16* WL = (const bf16*)(a.ws + WS_WRL);
#pragma unroll
        for (int ks = 0; ks < 8; ++ks) { wb[0][ks] = *(const bf16x8*)(WH + (size_t)rl * DM + 256 * wave + 32 * ks + 8 * q); wb[1][ks] = *(const bf16x8*)(WL + (size_t)rl * DM + 256 * wave + 32 * ks + 8 * q); } }
    __syncthreads();
    bf16* Hout = (bf16*)(a.ws + (MODE == 0 ? WS_H : WS_HF));
    f32x4 xv[8][2]; u32x4 dv[8];
    auto tile_of = [&](int s) -> int { return MODE == 0 ? (s < 32 ? NLAT / 16 + s : s - 32) : s; };
    int sq = first;
    if (sq < tile_end) norm_load_tile<MODE>(a, tile_of(sq), rl, wave, q, xv, dv);
    for (; sq < tile_end; sq += stride) {
        const int tile = tile_of(sq);
        const int r = tile * 16 + rl;
        const int v = MODE == 0 ? (tile * 16 < NLAT ? (tile * 16) / SEQ : 2) : (tile * 16) / SEQ;
        if (MODE == 1) {
#pragma unroll
            for (int ks = 0; ks < 8; ++ks) { const u32x4 d = dv[ks];
                xv[ks][0] += (f32x4){__uint_as_float(d.x << 16), __uint_as_float(d.x & 0xffff0000u), __uint_as_float(d.y << 16), __uint_as_float(d.y & 0xffff0000u)};
                xv[ks][1] += (f32x4){__uint_as_float(d.z << 16), __uint_as_float(d.z & 0xffff0000u), __uint_as_float(d.w << 16), __uint_as_float(d.w & 0xffff0000u)}; } }
        float ss = 0.f;
#pragma unroll
        for (int ks = 0; ks < 8; ++ks) { const f32x4 a0 = xv[ks][0], a1 = xv[ks][1]; ss += (a0.x * a0.x + a0.y * a0.y) + (a0.z * a0.z + a0.w * a0.w) + (a1.x * a1.x + a1.y * a1.y) + (a1.z * a1.z + a1.w * a1.w); }
        ss += __shfl_xor(ss, 16); ss += __shfl_xor(ss, 32);
        if (q == 0) ssred[wave * 16 + rl] = ss;
        __syncthreads();
        float tot = 0.f;
#pragma unroll
        for (int w8 = 0; w8 < 8; ++w8) tot += ssred[w8 * 16 + rl];
        const float rstd = rsqrtf(tot * (1.f / DM) + EPS);
        f32x4 acc0 = {0.f, 0.f, 0.f, 0.f}, acc1 = {0.f, 0.f, 0.f, 0.f};
        bf16* orow = Hout + (size_t)r * DM + 256 * wave + 8 * q;
        const LAS float* gsp = gs + v * DM + 256 * wave + 8 * q; const LAS float* shp = shv + v * DM + 256 * wave + 8 * q;
#pragma unroll
        for (int ks = 0; ks < 8; ++ks) {
            const f32x4 g0 = *(const LAS f32x4*)(gsp + 32 * ks), g1 = *(const LAS f32x4*)(gsp + 32 * ks + 4), s0 = *(const LAS f32x4*)(shp + 32 * ks), s1 = *(const LAS f32x4*)(shp + 32 * ks + 4);
            const f32x4 h0 = xv[ks][0] * rstd * g0 + s0, h1 = xv[ks][1] * rstd * g1 + s1;
            u32x4 hw; hw.x = pk2(h0.x, h0.y); hw.y = pk2(h0.z, h0.w); hw.z = pk2(h1.x, h1.y); hw.w = pk2(h1.z, h1.w);
            *(u32x4*)(orow + 32 * ks) = hw;
            const bf16x8 hf = __builtin_bit_cast(bf16x8, hw);
            if (MODE == 0) { acc0 = MFMA16(hf, wb[0][ks], acc0); acc1 = MFMA16(hf, wb[1][ks], acc1); }
            else { u32x4 lw;
                lw.x = pk2(h0.x - __uint_as_float(hw.x << 16), h0.y - __uint_as_float(hw.x & 0xffff0000u)); lw.y = pk2(h0.z - __uint_as_float(hw.y << 16), h0.w - __uint_as_float(hw.y & 0xffff0000u));
                lw.z = pk2(h1.x - __uint_as_float(hw.z << 16), h1.y - __uint_as_float(hw.z & 0xffff0000u)); lw.w = pk2(h1.z - __uint_as_float(hw.w << 16), h1.w - __uint_as_float(hw.w & 0xffff0000u));
                const bf16x8 lf = __builtin_bit_cast(bf16x8, lw);
                acc0 = MFMA16(hf, wb[0][ks], acc0); acc0 = MFMA16(lf, wb[0][ks], acc0); acc0 = MFMA16(hf, wb[1][ks], acc0); }
        }
        if (sq + stride < tile_end) norm_load_tile<MODE>(a, tile_of(sq + stride), rl, wave, q, xv, dv);
#pragma unroll
        for (int rr = 0; rr < 4; ++rr) { red[(wave * 16 + 4 * q + rr) * 32 + rl] = acc0[rr]; if (MODE == 0) red[(wave * 16 + 4 * q + rr) * 32 + 16 + rl] = acc1[rr]; }
        __syncthreads();
        if (MODE == 0) { const int row = tid >> 5, col = tid & 31; float s = 0.f;
#pragma unroll
            for (int w8 = 0; w8 < 8; ++w8) s += red[(w8 * 16 + row) * 32 + col];
            ((float*)(a.ws + WS_Z))[(size_t)(tile * 16 + row) * 32 + col] = s;
        } else if (tid < 256) { const int row = tid >> 4, e = tid & 15; float s = 0.f;
#pragma unroll
            for (int w8 = 0; w8 < 8; ++w8) s += red[(w8 * 16 + row) * 32 + e];
            float m = s; m = fmaxf(m, __shfl_xor(m, 1)); m = fmaxf(m, __shfl_xor(m, 2)); m = fmaxf(m, __shfl_xor(m, 4)); m = fmaxf(m, __shfl_xor(m, 8));
            const float ex = expf(s - m); float sm = ex; sm += __shfl_xor(sm, 1); sm += __shfl_xor(sm, 2); sm += __shfl_xor(sm, 4); sm += __shfl_xor(sm, 8);
            const int rg = tile * 16 + row, b = rg / SEQ, t = rg % SEQ;
            ((float*)(a.ws + WS_AFF))[((size_t)b * NE + e) * SEQ + t] = ex / sm; }
        if (MODE == 0 && tile >= NLAT / 16) {
            __threadfence(); __syncthreads();
            if (tid == 0) __hip_atomic_fetch_add((unsigned*)(a.ws + WS_CTL) + CW_CTXCNT + 64 * ((tile - NLAT / 16) >> 4), 1u, __ATOMIC_RELAXED, __HIP_MEMORY_SCOPE_AGENT);
        }
        __syncthreads();
    }
}

constexpr int GQ_LD = 136, GK_LD = 72;
constexpr int GL_Q = 0, GL_KI = 17408, GL_KET = 34816, GL_VT = 53248, GL_ST = 90112, GL_DC = 159744, GL_SEG = 160256;
__device__ __forceinline__ bf16x8 ldfrag(const LAS bf16* base, int row0, int ld, int koff, int lane) { return *(const LAS bf16x8*)(base + (row0 + (lane & 15)) * ld + koff + 8 * (lane >> 4)); }
__device__ __forceinline__ float fast_logsigmoid(float x) { return fminf(x, 0.f) - __logf(1.f + __expf(-fabsf(x))); }

struct GlaRaw { u32x4 q[2], k[2], v[4]; f32x2 z; };
template <bool FULL>
__device__ __forceinline__ void gla_issue_loads(const Args& a, size_t row0, int h, int dir, int wave, int lane, int tid, GlaRaw& r) {
    const bf16* P = (const bf16*)(a.ws + WS_P); const float* Z = (const float*)(a.ws + WS_Z);
#pragma unroll
    for (int j = 0; j < 2; ++j) { const int e = tid + 512 * j, row = e >> 4, c8 = e & 15;
        r.k[j] = *(const u32x4*)(P + (row0 + row) * PW + 512 + h * 128 + 8 * c8);
        if (FULL) r.q[j] = *(const u32x4*)(P + (row0 + row) * PW + h * 128 + 8 * c8); }
    { const int e = tid * 2; r.z = *(const f32x2*)(Z + (row0 + (e >> 4)) * 32 + dir * 16 + (e & 15)); }
#pragma unroll
    for (int rr = 0; rr < 4; ++rr) r.v[rr] = *(const u32x4*)(P + (row0 + 4 * (lane >> 2) + rr) * PW + 1024 + h * 256 + 32 * wave + 8 * (lane & 3));
}
__device__ __forceinline__ void gla_store_vt(LAS unsigned char* lds, int wave, int lane, const u32x4 (&x)[4]) {
    LAS bf16* VT = (LAS bf16*)(lds + GL_VT); const int c0 = 32 * wave + 8 * (lane & 3), l0 = 4 * (lane >> 2);
#pragma unroll
    for (int i2 = 0; i2 < 4; ++i2) {
        const unsigned a0 = x[0][i2], a1 = x[1][i2], a2 = x[2][i2], a3 = x[3][i2];
        u32x2 lo, hi; lo.x = (a0 & 0xffffu) | (a1 << 16); lo.y = (a2 & 0xffffu) | (a3 << 16); hi.x = (a0 >> 16) | (a1 & 0xffff0000u); hi.y = (a2 >> 16) | (a3 & 0xffff0000u);
        *(LAS u32x2*)(VT + (c0 + 2 * i2) * GK_LD + l0) = lo; *(LAS u32x2*)(VT + (c0 + 2 * i2 + 1) * GK_LD + l0) = hi; }
}
template <bool FULL>
__device__ __forceinline__ void gla_stage(LAS unsigned char* lds, int wave, int lane, int tid, const GlaRaw& r) {
    LAS bf16* Qd = (LAS bf16*)(lds + GL_Q); LAS bf16* Ki = (LAS bf16*)(lds + GL_KI); LAS float* zs = (LAS float*)(lds + GL_KET);
#pragma unroll
    for (int j = 0; j < 2; ++j) { const int e = tid + 512 * j, row = e >> 4, c8 = e & 15;
        *(LAS u32x4*)(Ki + row * GQ_LD + 8 * c8) = r.k[j]; if (FULL) *(LAS u32x4*)(Qd + row * GQ_LD + 8 * c8) = r.q[j]; }
    *(LAS f32x2*)(zs + tid * 2) = r.z;
    gla_store_vt(lds, wave, lane, r.v);
}
template <bool FULL>
__device__ __forceinline__ void gla_prep(LAS unsigned char* lds, int dir, const float (&w)[16], float bias, float& totacc) {
    const int tid = threadIdx.x, d = tid & 127, seg = __builtin_amdgcn_readfirstlane(tid >> 7);
    LAS bf16* Qd = (LAS bf16*)(lds + GL_Q); LAS bf16* Ki = (LAS bf16*)(lds + GL_KI); LAS bf16* KeT = (LAS bf16*)(lds + GL_KET);
    LAS float* dcv = (LAS float*)(lds + GL_DC); LAS float* segt = (LAS float*)(lds + GL_SEG); const LAS float* zs = (const LAS float*)(lds + GL_KET);
    float kf[16], qf[16], c[16];
#pragma unroll
    for (int ii = 0; ii < 16; ++ii) { kf[ii] = bf2f(Ki[(16 * seg + ii) * GQ_LD + d]); if (FULL) qf[ii] = bf2f(Qd[(16 * seg + ii) * GQ_LD + d]); }
#pragma unroll
    for (int ii = 0; ii < 16; ++ii) { const LAS f32x4* zr = (const LAS f32x4*)(zs + (16 * seg + ii) * 16); float pre = bias;
#pragma unroll
        for (int r4 = 0; r4 < 4; ++r4) { const f32x4 zv = zr[r4]; pre += zv.x * w[4 * r4] + zv.y * w[4 * r4 + 1] + zv.z * w[4 * r4 + 2] + zv.w * w[4 * r4 + 3]; }
        c[ii] = fast_logsigmoid(pre) * (1.f / 16.f); }
    if (!dir) {
#pragma unroll
        for (int ii = 1; ii < 16; ++ii) c[ii] += c[ii - 1];
    } else {
#pragma unroll
        for (int ii = 14; ii >= 0; --ii) c[ii] += c[ii + 1];
    }
    segt[seg * 128 + d] = dir ? c[0] : c[15];
    __syncthreads();
    float total = 0.f, off = 0.f;
#pragma unroll
    for (int s2 = 0; s2 < 4; ++s2) { const float t = segt[s2 * 128 + d]; total += t; if (dir ? (s2 > seg) : (s2 < seg)) off += t; }
    unsigned kw[8];
#pragma unroll
    for (int ii = 0; ii < 16; ii += 2) {
        const float c0 = c[ii] + off, c1 = c[ii + 1] + off;
        kw[ii >> 1] = pk2(kf[ii] * __expf(total - c0), kf[ii + 1] * __expf(total - c1));
        if (FULL) { const int i0 = 16 * seg + ii;
            Qd[i0 * GQ_LD + d] = (bf16)f2bf(qf[ii] * 0.08838834764831845f * __expf(c0)); Qd[(i0 + 1) * GQ_LD + d] = (bf16)f2bf(qf[ii + 1] * 0.08838834764831845f * __expf(c1));
            Ki[i0 * GQ_LD + d] = (bf16)f2bf(kf[ii] * __expf(-c0)); Ki[(i0 + 1) * GQ_LD + d] = (bf16)f2bf(kf[ii + 1] * __expf(-c1)); }
    }
    *(LAS u32x4*)(KeT + d * GK_LD + 16 * seg) = (u32x4){kw[0], kw[1], kw[2], kw[3]};
    *(LAS u32x4*)(KeT + d * GK_LD + 16 * seg + 8) = (u32x4){kw[4], kw[5], kw[6], kw[7]};
    if (seg == 0) { dcv[d] = __expf(total); totacc += total; }
}
__device__ __forceinline__ void gla_state_update(LAS unsigned char* lds, int lane, const bf16x8 (&vt)[2][2], f32x4 (&acc)[8][2]) {
    const LAS bf16* KeT = (const LAS bf16*)(lds + GL_KET); const LAS float* dcv = (const LAS float*)(lds + GL_DC);
#pragma unroll
    for (int mt = 0; mt < 8; ++mt) {
        const f32x4 dc4 = *(const LAS f32x4*)(dcv + 16 * mt + 4 * (lane >> 4));
        const bf16x8 k0 = ldfrag(KeT, 16 * mt, GK_LD, 0, lane), k1 = ldfrag(KeT, 16 * mt, GK_LD, 32, lane);
#pragma unroll
        for (int n = 0; n < 2; ++n) { f32x4 t = acc[mt][n] * dc4; t = MFMA16(k0, vt[n][0], t); t = MFMA16(k1, vt[n][1], t); acc[mt][n] = t; }
    }
}
constexpr size_t GLA_SV = 128 * 256;
__device__ __forceinline__ void gla_passA(const Args& a, LAS unsigned char* lds, int item) {
    const int tid = threadIdx.x, lane = tid & 63, wave = __builtin_amdgcn_readfirstlane(tid >> 6), q = lane >> 4, cidx = lane & 15;
    const bool is_ctx = item >= 256; const int seq = is_ctx ? item - 256 : item >> 4, s = is_ctx ? 0 : item & 15;
    const int b = seq >> 3, dir = (seq >> 2) & 1, h = seq & 3, nchunk = is_ctx ? 4 : 16;
    const size_t rowbase = is_ctx ? (size_t)(NLAT + b * CTXL) : (size_t)b * SEQ + (size_t)s * 1024;
    const float* w_a2 = dir ? a.in[10] : a.in[8]; const float* b_a2 = dir ? a.in[11] : a.in[9];
    float w[16]; const int d = tid & 127;
#pragma unroll
    for (int r = 0; r < 16; ++r) w[r] = w_a2[r * 512 + h * 128 + d];
    const float bias = b_a2[h * 128 + d];
    f32x4 acc[8][2];
#pragma unroll
    for (int mt = 0; mt < 8; ++mt) { acc[mt][0] = (f32x4){0.f, 0.f, 0.f, 0.f}; acc[mt][1] = (f32x4){0.f, 0.f, 0.f, 0.f}; }
    float totacc = 0.f;
    GlaRaw raw; gla_issue_loads<false>(a, rowbase + (size_t)(dir ? (nchunk - 1) : 0) * 64, h, dir, wave, lane, tid, raw);
    for (int ci = 0; ci < nchunk; ++ci) {
        gla_stage<false>(lds, wave, lane, tid, raw);
        if (ci + 1 < nchunk) gla_issue_loads<false>(a, rowbase + (size_t)(dir ? (nchunk - 2 - ci) : ci + 1) * 64, h, dir, wave, lane, tid, raw);
        __syncthreads();
        gla_prep<false>(lds, dir, w, bias, totacc);
        __syncthreads();
        const LAS bf16* VT = (const LAS bf16*)(lds + GL_VT);
        bf16x8 vt[2][2];
#pragma unroll
        for (int n2 = 0; n2 < 2; ++n2) { vt[n2][0] = ldfrag(VT, 32 * wave + 16 * n2, GK_LD, 0, lane); vt[n2][1] = ldfrag(VT, 32 * wave + 16 * n2, GK_LD, 32, lane); }
        gla_state_update(lds, lane, vt, acc);
        __syncthreads();
    }
    float* T = is_ctx ? (float*)(a.ws + WS_ST0) + (size_t)seq * GLA_SV : (float*)(a.ws + WS_T) + (size_t)item * GLA_SV;
#pragma unroll
    for (int mt = 0; mt < 8; ++mt)
#pragma unroll
        for (int n2 = 0; n2 < 2; ++n2)
#pragma unroll
            for (int r = 0; r < 4; ++r) T[(size_t)(16 * mt + 4 * q + r) * 256 + 32 * wave + 16 * n2 + cidx] = acc[mt][n2][r];
    if (!is_ctx && tid < 128) ((float*)(a.ws + WS_DT))[item * 128 + tid] = __expf(totacc);
}
__device__ __forceinline__ void gla_passB(const Args& a) {
    const float* ST0 = (const float*)(a.ws + WS_ST0); const float* T = (const float*)(a.ws + WS_T); const float* DT = (const float*)(a.ws + WS_DT); float* SST = (float*)(a.ws + WS_SST);
    for (int e = blockIdx.x * NTHREADS + threadIdx.x; e < 16 * (int)GLA_SV; e += gridDim.x * NTHREADS) {
        const int seq = e >> 15, dv = e & 32767, d = dv >> 8, dir = (seq >> 2) & 1;
        float S = ST0[(size_t)seq * GLA_SV + dv];
        for (int si = 0; si < 16; ++si) { const int s = dir ? 15 - si : si; const size_t it = (size_t)seq * 16 + s;
            SST[it * GLA_SV + dv] = S; S = DT[it * 128 + d] * S + T[it * GLA_SV + dv]; }
    }
}
__device__ __forceinline__ void gla_passC(const Args& a, LAS unsigned char* lds, int item) {
    const int tid = threadIdx.x, lane = tid & 63, wave = __builtin_amdgcn_readfirstlane(tid >> 6), q = lane >> 4, cidx = lane & 15;
    const int seq = item >> 4, s = item & 15, b = seq >> 3, dir = (seq >> 2) & 1, h = seq & 3;
    const size_t rowbase = (size_t)b * SEQ + (size_t)s * 1024;
    const float* w_a2 = dir ? a.in[10] : a.in[8]; const float* b_a2 = dir ? a.in[11] : a.in[9];
    bf16* O = (bf16*)(a.ws + (dir ? WS_OB : WS_OF));
    float w[16]; const int d = tid & 127;
#pragma unroll
    for (int r = 0; r < 16; ++r) w[r] = w_a2[r * 512 + h * 128 + d];
    const float bias = b_a2[h * 128 + d];
    LAS bf16* Qd = (LAS bf16*)(lds + GL_Q); LAS bf16* Ki = (LAS bf16*)(lds + GL_KI); LAS bf16* Pm = Ki; LAS bf16* VT = (LAS bf16*)(lds + GL_VT); LAS bf16* ST = (LAS bf16*)(lds + GL_ST);
    f32x4 acc[8][2];
    { const float* S0 = (const float*)(a.ws + WS_SST) + (size_t)item * GLA_SV;
#pragma unroll
      for (int mt = 0; mt < 8; ++mt)
#pragma unroll
          for (int n2 = 0; n2 < 2; ++n2) {
#pragma unroll
              for (int r = 0; r < 4; ++r) acc[mt][n2][r] = S0[(size_t)(16 * mt + 4 * q + r) * 256 + 32 * wave + 16 * n2 + cidx];
              u32x2 wv; wv.x = pk2(acc[mt][n2][0], acc[mt][n2][1]); wv.y = pk2(acc[mt][n2][2], acc[mt][n2][3]);
              *(LAS u32x2*)(ST + (32 * wave + 16 * n2 + cidx) * GQ_LD + 16 * mt + 4 * q) = wv; } }
    float totacc = 0.f;
    GlaRaw raw; gla_issue_loads<true>(a, rowbase + (size_t)(dir ? 15 : 0) * 64, h, dir, wave, lane, tid, raw);
    for (int ci = 0; ci < 16; ++ci) {
        const int n = dir ? (15 - ci) : ci; const size_t row0 = rowbase + (size_t)n * 64;
        gla_stage<true>(lds, wave, lane, tid, raw);
        if (ci + 1 < 16) gla_issue_loads<true>(a, rowbase + (size_t)(dir ? (14 - ci) : ci + 1) * 64, h, dir, wave, lane, tid, raw);
        __syncthreads();
        gla_prep<true>(lds, dir, w, bias, totacc);
        __syncthreads();
        const int it = wave >> 1;
        u32x2 pw[2];
#pragma unroll
        for (int jj = 0; jj < 2; ++jj) { const int jt = 2 * (wave & 1) + jj; f32x4 sc = {0.f, 0.f, 0.f, 0.f};
#pragma unroll
            for (int ks = 0; ks < 4; ++ks) sc = MFMA16(ldfrag(Ki, 16 * jt, GQ_LD, 32 * ks, lane), ldfrag(Qd, 16 * it, GQ_LD, 32 * ks, lane), sc);
            const int i = 16 * it + cidx, j0 = 16 * jt + 4 * q;
#pragma unroll
            for (int r = 0; r < 4; ++r) { const bool keep = dir ? (j0 + r >= i) : (j0 + r <= i); sc[r] = keep ? sc[r] : 0.f; }
            pw[jj].x = pk2(sc[0], sc[1]); pw[jj].y = pk2(sc[2], sc[3]); }
        __syncthreads();
#pragma unroll
        for (int jj = 0; jj < 2; ++jj) *(LAS u32x2*)(Pm + (16 * it + cidx) * GK_LD + 16 * (2 * (wave & 1) + jj) + 4 * q) = pw[jj];
        __syncthreads();
        bf16x8 vt[2][2], st[2][4];
#pragma unroll
        for (int n2 = 0; n2 < 2; ++n2) { vt[n2][0] = ldfrag(VT, 32 * wave + 16 * n2, GK_LD, 0, lane); vt[n2][1] = ldfrag(VT, 32 * wave + 16 * n2, GK_LD, 32, lane);
#pragma unroll
            for (int ks = 0; ks < 4; ++ks) st[n2][ks] = ldfrag(ST, 32 * wave + 16 * n2, GQ_LD, 32 * ks, lane); }
#pragma unroll
        for (int i2 = 0; i2 < 4; ++i2) {
            const bf16x8 p0 = ldfrag(Pm, 16 * i2, GK_LD, 0, lane), p1 = ldfrag(Pm, 16 * i2, GK_LD, 32, lane);
            bf16x8 qf[4];
#pragma unroll
            for (int ks = 0; ks < 4; ++ks) qf[ks] = ldfrag(Qd, 16 * i2, GQ_LD, 32 * ks, lane);
#pragma unroll
            for (int n2 = 0; n2 < 2; ++n2) { f32x4 o = {0.f, 0.f, 0.f, 0.f};
                o = MFMA16(vt[n2][0], p0, o); o = MFMA16(vt[n2][1], p1, o);
#pragma unroll
                for (int ks = 0; ks < 4; ++ks) o = MFMA16(st[n2][ks], qf[ks], o);
                u32x2 wv; wv.x = pk2(o[0], o[1]); wv.y = pk2(o[2], o[3]);
                *(u32x2*)(O + (row0 + 16 * i2 + cidx) * 1024 + h * 256 + 32 * wave + 16 * n2 + 4 * q) = wv; }
        }
        gla_state_update(lds, lane, vt, acc);
#pragma unroll
        for (int mt = 0; mt < 8; ++mt)
#pragma unroll
            for (int n2 = 0; n2 < 2; ++n2) { u32x2 wv; wv.x = pk2(acc[mt][n2][0], acc[mt][n2][1]); wv.y = pk2(acc[mt][n2][2], acc[mt][n2][3]);
                *(LAS u32x2*)(ST + (32 * wave + 16 * n2 + cidx) * GQ_LD + 16 * mt + 4 * q) = wv; }
        __syncthreads();
    }
}

__device__ __forceinline__ void phase_gla_merge(const Args& a) {
    const int tid = threadIdx.x, lane = tid & 63, wave = tid >> 6;
    const int gw = blockIdx.x * 8 + wave, NGW = gridDim.x * 8;
    const bf16* OF = (const bf16*)(a.ws + WS_OF); const bf16* OB = (const bf16*)(a.ws + WS_OB);
    const bf16* P = (const bf16*)(a.ws + WS_P); bf16* Y = (bf16*)(a.ws + WS_YCAT); const float* gg = a.in[12];
    f32x4 gn[4];
#pragma unroll
    for (int j = 0; j < 4; ++j) gn[j] = *(const f32x4*)(gg + 256 * j + 4 * lane);
    for (int r0 = gw; r0 < NLAT; r0 += 2 * NGW) {
        u32x2 fa[2][4], fb[2][4], gw2[2][4];
#pragma unroll
        for (int u = 0; u < 2; ++u) { const int r = r0 + u * NGW; if (r < NLAT) {
#pragma unroll
            for (int j = 0; j < 4; ++j) { const int col = 256 * j + 4 * lane; fa[u][j] = *(const u32x2*)(OF + (size_t)r * 1024 + col); fb[u][j] = *(const u32x2*)(OB + (size_t)r * 1024 + col); gw2[u][j] = *(const u32x2*)(P + (size_t)r * PW + 2048 + col); } } }
#pragma unroll
        for (int u = 0; u < 2; ++u) { const int r = r0 + u * NGW; if (r < NLAT) {
#pragma unroll
            for (int j = 0; j < 4; ++j) {
                const int col = 256 * j + 4 * lane;
                f32x4 o; o.x = __uint_as_float(fa[u][j].x << 16) + __uint_as_float(fb[u][j].x << 16); o.y = __uint_as_float(fa[u][j].x & 0xffff0000u) + __uint_as_float(fb[u][j].x & 0xffff0000u);
                o.z = __uint_as_float(fa[u][j].y << 16) + __uint_as_float(fb[u][j].y << 16); o.w = __uint_as_float(fa[u][j].y & 0xffff0000u) + __uint_as_float(fb[u][j].y & 0xffff0000u);
                const float ss = wave_sum((o.x * o.x + o.y * o.y) + (o.z * o.z + o.w * o.w));
                const float rstd = rsqrtf(ss * (1.f / 256.f) + EPS);
                const float g0 = __uint_as_float(gw2[u][j].x << 16), g1 = __uint_as_float(gw2[u][j].x & 0xffff0000u), g2 = __uint_as_float(gw2[u][j].y << 16), g3 = __uint_as_float(gw2[u][j].y & 0xffff0000u);
                u32x2 w; w.x = pk2(o.x * rstd * gn[j].x * silu_f(g0), o.y * rstd * gn[j].y * silu_f(g1)); w.y = pk2(o.z * rstd * gn[j].z * silu_f(g2), o.w * rstd * gn[j].w * silu_f(g3));
                *(u32x2*)(Y + (size_t)r * DM + col) = w;
            } } }
    }
}

constexpr int FLD = 136;
__device__ __forceinline__ void load_dft_frags(const unsigned char* ws, int wave, int lane, bf16x8 (&fc)[4], bf16x8 (&fs)[4]) {
    const bf16* FC = (const bf16*)(ws + WS_FC); const bf16* FS = (const bf16*)(ws + WS_FS);
    const int k = 16 * wave + (lane & 15);
#pragma unroll
    for (int ks = 0; ks < 4; ++ks) { fc[ks] = *(const bf16x8*)(FC + k * 128 + ks * 32 + 8 * (lane >> 4)); fs[ks] = *(const bf16x8*)(FS + k * 128 + ks * 32 + 8 * (lane >> 4)); }
}
__device__ __forceinline__ void store_t4x8(LAS bf16* XT, int c0, int l0, const u32x4 (&x)[4]) {
#pragma unroll
    for (int i2 = 0; i2 < 4; ++i2) {
        const unsigned a0 = x[0][i2], a1 = x[1][i2], a2 = x[2][i2], a3 = x[3][i2];
        u32x2 lo, hi; lo.x = (a0 & 0xffffu) | (a1 << 16); lo.y = (a2 & 0xffffu) | (a3 << 16); hi.x = (a0 >> 16) | (a1 & 0xffff0000u); hi.y = (a2 >> 16) | (a3 & 0xffff0000u);
        *(LAS u32x2*)(XT + (c0 + 2 * i2) * FLD + l0) = lo; *(LAS u32x2*)(XT + (c0 + 2 * i2 + 1) * FLD + l0) = hi; }
}
__device__ __forceinline__ void phase_f1(const Args& a, LAS unsigned char* lds) {
    const int tid = threadIdx.x, lane = tid & 63, wave = __builtin_amdgcn_readfirstlane(tid >> 6), q = lane >> 4, cidx = lane & 15;
    const bf16* P = (const bf16*)(a.ws + WS_P); const f32x2* TW = (const f32x2*)(a.ws + WS_TW);
    bf16* A1r = (bf16*)(a.ws + WS_FA); bf16* A1i = (bf16*)(a.ws + WS_FAI);
    LAS bf16* XT = (LAS bf16*)lds;
    bf16x8 fc[4], fs[4]; load_dft_frags(a.ws, wave, lane, fc, fs);
    const int k1 = 16 * wave + cidx;
    for (int item = blockIdx.x; item < 1024; item += gridDim.x) {
        const int cb = item & 3, l2 = (item >> 2) & 127, b = item >> 9, ch0 = cb * 256;
#pragma unroll
        for (int j = 0; j < 2; ++j) { const int task = tid + 512 * j, cblk = task & 31, lb = task >> 5; u32x4 x[4];
#pragma unroll
            for (int r = 0; r < 4; ++r) x[r] = *(const u32x4*)(P + ((size_t)b * SEQ + 128 * (4 * lb + r) + l2) * PW + 3072 + ch0 + 8 * cblk);
            store_t4x8(XT, 8 * cblk, 4 * lb, x); }
        __syncthreads();
        const f32x2 tw = TW[l2 * k1];
        bf16* or_ = A1r + (((size_t)b * 128 + k1) * 128 + l2) * 1024 + ch0 + 4 * q; bf16* oi_ = A1i + (((size_t)b * 128 + k1) * 128 + l2) * 1024 + ch0 + 4 * q;
#pragma unroll 2
        for (int mt = 0; mt < 16; ++mt) {
            f32x4 cr = {0.f, 0.f, 0.f, 0.f}, cs = {0.f, 0.f, 0.f, 0.f};
#pragma unroll
            for (int ks = 0; ks < 4; ++ks) { const bf16x8 xa = *(const LAS bf16x8*)(XT + (16 * mt + cidx) * FLD + ks * 32 + 8 * q); cr = MFMA16(xa, fc[ks], cr); cs = MFMA16(xa, fs[ks], cs); }
            const f32x4 br = cr * tw.x - cs * tw.y, bi = -(cs * tw.x + cr * tw.y);
            u32x2 wr_; wr_.x = pk2(br[0], br[1]); wr_.y = pk2(br[2], br[3]); u32x2 wi_; wi_.x = pk2(bi[0], bi[1]); wi_.y = pk2(bi[2], bi[3]);
            *(u32x2*)(or_ + 16 * mt) = wr_; *(u32x2*)(oi_ + 16 * mt) = wi_;
        }
        __syncthreads();
    }
}
__device__ __forceinline__ void phase_f34(const Args& a, LAS unsigned char* lds) {
    const int tid = threadIdx.x, lane = tid & 63, wave = __builtin_amdgcn_readfirstlane(tid >> 6), q = lane >> 4, cidx = lane & 15;
    const bf16* A1r = (const bf16*)(a.ws + WS_FA); const bf16* A1i = (const bf16*)(a.ws + WS_FAI); bf16* Y = (bf16*)(a.ws + WS_YCAT);
    LAS bf16* XTr = (LAS bf16*)lds; LAS bf16* XTi = XTr + 128 * FLD; LAS bf16* XKr = XTi + 128 * FLD; LAS bf16* XKi = XKr + 128 * FLD;
    bf16x8 fc[4], fs[4]; load_dft_frags(a.ws, wave, lane, fc, fs);
    const float nrm = 1.0f / 1448.15468787005f;
    for (int item = blockIdx.x; item < 2048; item += gridDim.x) {
        const int g = item & 7, k1 = (item >> 3) & 127, b = item >> 10, ch0 = g * 128;
        { const int cblk = tid & 15, lb = tid >> 4; u32x4 xr[4], xi[4];
#pragma unroll
            for (int r = 0; r < 4; ++r) { const size_t off = (((size_t)b * 128 + k1) * 128 + 4 * lb + r) * 1024 + ch0 + 8 * cblk; xr[r] = *(const u32x4*)(A1r + off); xi[r] = *(const u32x4*)(A1i + off); }
            store_t4x8(XTr, 8 * cblk, 4 * lb, xr); store_t4x8(XTi, 8 * cblk, 4 * lb, xi); }
        __syncthreads();
        const int k2 = 16 * wave + cidx;
#pragma unroll 2
        for (int mt = 0; mt < 8; ++mt) {
            f32x4 a1 = {0.f, 0.f, 0.f, 0.f}, a2 = a1, b1 = a1, b2 = a1;
#pragma unroll
            for (int ks = 0; ks < 4; ++ks) { const bf16x8 xa = *(const LAS bf16x8*)(XTr + (16 * mt + cidx) * FLD + ks * 32 + 8 * q); const bf16x8 xb = *(const LAS bf16x8*)(XTi + (16 * mt + cidx) * FLD + ks * 32 + 8 * q);
                a1 = MFMA16(xa, fc[ks], a1); b2 = MFMA16(xa, fs[ks], b2); a2 = MFMA16(xb, fs[ks], a2); b1 = MFMA16(xb, fc[ks], b1); }
            const f32x4 xre = a1 + a2, xim = b1 - b2;
            u32x2 wr_; wr_.x = pk2(xre[0], xre[1]); wr_.y = pk2(xre[2], xre[3]); u32x2 wi_; wi_.x = pk2(xim[0], xim[1]); wi_.y = pk2(xim[2], xim[3]);
            *(LAS u32x2*)(XKr + k2 * FLD + 16 * mt + 4 * q) = wr_; *(LAS u32x2*)(XKi + k2 * FLD + 16 * mt + 4 * q) = wi_;
        }
        __syncthreads();
#pragma unroll 2
        for (int nt = 0; nt < 8; ++nt) {
            f32x4 y = {0.f, 0.f, 0.f, 0.f};
#pragma unroll
            for (int ks = 0; ks < 4; ++ks) { const bf16x8 xa = *(const LAS bf16x8*)(XKr + (16 * nt + cidx) * FLD + ks * 32 + 8 * q); const bf16x8 xb = *(const LAS bf16x8*)(XKi + (16 * nt + cidx) * FLD + ks * 32 + 8 * q);
                y = MFMA16(fc[ks], xa, y); y = MFMA16(fs[ks], xb, y); }
            const int lp = k1 + 128 * (16 * nt + cidx);
            u32x2 w; w.x = pk2(y[0] * nrm, y[1] * nrm); w.y = pk2(y[2] * nrm, y[3] * nrm);
            *(u32x2*)(Y + ((size_t)b * SEQ + lp) * DM + 1024 + ch0 + 16 * wave + 4 * q) = w;
        }
        __syncthreads();
    }
}

__device__ __forceinline__ void phase_topk(const Args& a, LAS unsigned char* lds) {
    const int tid = threadIdx.x;
    LAS unsigned* keys = (LAS unsigned*)lds;
    LAS unsigned* hist = (LAS unsigned*)(lds + 65536);
    LAS unsigned* misc = hist + 256;
    LAS unsigned* sg = misc + 16;
    LAS unsigned* se = sg + 512;
    const float* AFF = (const float*)(a.ws + WS_AFF); int* TOK = (int*)(a.ws + WS_TOK); float* GATE = (float*)(a.ws + WS_GATE); int* SEL = (int*)(a.ws + WS_SEL);
    for (int be = blockIdx.x; be < NB * NE; be += gridDim.x) {
        const int b = be / NE, e = be % NE;
        for (int i = tid; i < SEQ; i += NTHREADS) keys[i] = __float_as_uint(AFF[(size_t)be * SEQ + i]);
        unsigned prefix = 0u, pmask = 0u, krem = CAP;
        for (int pass = 0; pass < 4; ++pass) {
            const int shift = 24 - 8 * pass;
            if (tid < 256) hist[tid] = 0u;
            __syncthreads();
            for (int i = tid; i < SEQ; i += NTHREADS) { const unsigned k = keys[i]; if ((k & pmask) == prefix) atomicAdd((unsigned*)&hist[(k >> shift) & 255u], 1u); }
            __syncthreads();
            if (tid == 0) { unsigned cum = 0u; int bsel = 0;
                for (int bk = 255; bk >= 0; --bk) { const unsigned c = hist[bk]; if (cum + c >= krem) { bsel = bk; break; } cum += c; }
                misc[0] = prefix | ((unsigned)bsel << shift); misc[1] = krem - cum; }
            __syncthreads();
            prefix = misc[0]; krem = misc[1]; pmask |= (0xffu << shift);
            __syncthreads();
        }
        const unsigned T = prefix;
        unsigned cg_ = 0u, ce = 0u;
        for (int i = 0; i < 32; ++i) { const unsigned k = keys[tid * 32 + i]; cg_ += (k > T); ce += (k == T); }
        sg[tid] = cg_; se[tid] = ce;
        __syncthreads();
        if (tid == 0) { unsigned rg = 0u, re = 0u; for (int i = 0; i < NTHREADS; ++i) { const unsigned x = sg[i], y = se[i]; sg[i] = rg; se[i] = re; rg += x; re += y; } }
        __syncthreads();
        unsigned gt_before = sg[tid], eq_before = se[tid];
        for (int i = 0; i < 32; ++i) { const int t = tid * 32 + i; const unsigned k = keys[t];
            const bool isgt = k > T, iseq = k == T; const bool take = isgt || (iseq && eq_before < krem);
            const unsigned slot = gt_before + (eq_before < krem ? eq_before : krem);
            if (take) { TOK[(size_t)be * CAP + slot] = t; GATE[(size_t)be * CAP + slot] = __uint_as_float(k); }
            SEL[((size_t)b * SEQ + t) * NE + e] = take ? (int)slot : -1;
            gt_before += isgt; eq_before += iseq; }
        __syncthreads();
    }
}

__device__ __forceinline__ void acc_yrow(f32x4 (&m)[8], const u32x2 (&w)[8], float gt) {
#pragma unroll
    for (int j = 0; j < 8; ++j) { m[j].x += gt * __uint_as_float(w[j].x << 16); m[j].y += gt * __uint_as_float(w[j].x & 0xffff0000u); m[j].z += gt * __uint_as_float(w[j].y << 16); m[j].w += gt * __uint_as_float(w[j].y & 0xffff0000u); }
}
__device__ __forceinline__ void phase_final(const Args& a) {
    const int tid = threadIdx.x, lane = tid & 63, wave = tid >> 6;
    const int gw = blockIdx.x * 8 + wave, NGW = gridDim.x * 8;
    const float* ada = (const float*)(a.ws + WS_ADA); const float* fg = a.in[19];
    const float* X = a.in[0]; const bf16* DL = (const bf16*)(a.ws + WS_DLT); const bf16* YE = (const bf16*)(a.ws + WS_YE);
    const float* GATE = (const float*)(a.ws + WS_GATE); const int* SEL = (const int*)(a.ws + WS_SEL);
    int r = gw;
    int sel = -1; if (r < NLAT && lane < NE) sel = SEL[(size_t)r * NE + lane];
    for (; r < NLAT; r += NGW) {
        const int b = r / SEQ;
        const float* g2 = ada + (size_t)b * 12288 + 5 * DM;
        f32x4 xv[8];
#pragma unroll
        for (int j = 0; j < 8; ++j) xv[j] = *(const f32x4*)(X + (size_t)r * DM + 256 * j + 4 * lane);
        u32x2 dl[8];
#pragma unroll
        for (int j = 0; j < 8; ++j) dl[j] = *(const u32x2*)(DL + (size_t)r * DM + 256 * j + 4 * lane);
        const float gt = sel >= 0 ? GATE[((size_t)b * NE + lane) * CAP + sel] : 0.f;
        const int myrow = sel >= 0 ? (lane * 2 + b) * CAP + sel : 0;
        unsigned long long mask = __ballot(sel >= 0);
        { const int rn = r + NGW; sel = -1; if (rn < NLAT && lane < NE) sel = SEL[(size_t)rn * NE + lane]; }
        f32x4 m[8];
#pragma unroll
        for (int j = 0; j < 8; ++j) m[j] = (f32x4){0.f, 0.f, 0.f, 0.f};
        while (mask) {
            const int e0 = __builtin_ctzll(mask); mask &= mask - 1;
            const int has1 = mask != 0ull; const int e1 = has1 ? __builtin_ctzll(mask) : e0; if (has1) mask &= mask - 1;
            const int row0 = __builtin_amdgcn_readlane(myrow, e0), row1 = __builtin_amdgcn_readlane(myrow, e1);
            const float g0 = __builtin_bit_cast(float, __builtin_amdgcn_readlane(__builtin_bit_cast(int, gt), e0));
            const float g1 = has1 ? __builtin_bit_cast(float, __builtin_amdgcn_readlane(__builtin_bit_cast(int, gt), e1)) : 0.f;
            const bf16* y0 = YE + (size_t)row0 * DM + 4 * lane; const bf16* y1 = YE + (size_t)row1 * DM + 4 * lane;
            u32x2 w0[8], w1[8];
#pragma unroll
            for (int j = 0; j < 8; ++j) { w0[j] = *(const u32x2*)(y0 + 256 * j); w1[j] = *(const u32x2*)(y1 + 256 * j); }
            acc_yrow(m, w0, g0); acc_yrow(m, w1, g1);
        }
        float ss = 0.f;
#pragma unroll
        for (int j = 0; j < 8; ++j) { const int d = 256 * j + 4 * lane; const f32x4 gv = *(const f32x4*)(g2 + d);
            const f32x4 dv = {__uint_as_float(dl[j].x << 16), __uint_as_float(dl[j].x & 0xffff0000u), __uint_as_float(dl[j].y << 16), __uint_as_float(dl[j].y & 0xffff0000u)};
            m[j] = (xv[j] + dv) + gv * m[j]; ss += (m[j].x * m[j].x + m[j].y * m[j].y) + (m[j].z * m[j].z + m[j].w * m[j].w); }
        const float rstd = rsqrtf(wave_sum(ss) * (1.f / DM) + EPS);
#pragma unroll
        for (int j = 0; j < 8; ++j) { const int d = 256 * j + 4 * lane; const f32x4 gv = *(const f32x4*)(fg + d);
            *(f32x4*)(a.out + (size_t)r * DM + d) = m[j] * rstd * gv; }
    }
}

#define XB_TMO      128
#define XB_XCNT(j)  (256  + 64 * (j))
#define XB_XSUB(j)  (1280 + 64 * (j))
#define XB_XGEN(j)  (2304 + 64 * (j))
#define XB_TOP      3328
#define XB_TOPGEN   3392
#define XCD_BAR_WORDS 3456
#define XB_SPIN_CAP (1u << 18)
__device__ __forceinline__ unsigned xb_ld(unsigned* p)              { return __hip_atomic_load(p, __ATOMIC_RELAXED, __HIP_MEMORY_SCOPE_AGENT); }
__device__ __forceinline__ unsigned xb_add(unsigned* p, unsigned v) { return __hip_atomic_fetch_add(p, v, __ATOMIC_RELAXED, __HIP_MEMORY_SCOPE_AGENT); }
__device__ __forceinline__ unsigned xb_xcc_id() { return (unsigned)__builtin_amdgcn_s_getreg((3 << 11) | 20) & 0xFu; }
#define XB_SPIN(cond, bar) do { unsigned _sp = 0; while (cond) { __builtin_amdgcn_s_sleep(1); \
    if ((++_sp & 255u) == 0u) { if (xb_ld(&(bar)[XB_TMO])) break; if (_sp > XB_SPIN_CAP) { atomicAdd(&(bar)[XB_TMO], 1u); break; } } } } while (0)
struct XcdBarrier { unsigned* bar; unsigned x; volatile LAS unsigned* st; };
__device__ __forceinline__ XcdBarrier xcd_barrier_post(unsigned* bar, volatile LAS unsigned* st) {
    XcdBarrier b; b.bar = bar; b.x = xb_xcc_id(); b.st = st;
    if (threadIdx.x == 0) (void)xb_add(&bar[XB_XCNT(b.x)], 1u);
    return b;
}
__device__ __forceinline__ void xcd_barrier_complete(unsigned* bar, unsigned x, unsigned& nloc, unsigned& nx) {
    const unsigned G = gridDim.x * gridDim.y * gridDim.z;
    unsigned sum, cnt, mine, sp = 0u;
    for (;;) {
        sum = 0u; cnt = 0u; mine = 0u;
#pragma unroll
        for (unsigned j = 0; j < 16; ++j) { const unsigned c = xb_ld(&bar[XB_XCNT(j)]); sum += c; cnt += (c > 0u) ? 1u : 0u; mine = (j == x) ? c : mine; }
        if (sum == G) break;
        __builtin_amdgcn_s_sleep(1);
        if ((++sp & 255u) == 0u) { if (xb_ld(&bar[XB_TMO])) break; if (sp > XB_SPIN_CAP) { atomicAdd(&bar[XB_TMO], 1u); break; } }
    }
    nloc = mine > 0u ? mine : 1u; nx = cnt > 0u ? cnt : 1u;
}
__device__ __forceinline__ void xcd_barrier(const XcdBarrier& b) {
    asm volatile("s_waitcnt vmcnt(0)" ::: "memory");
    __syncthreads();
    if (threadIdx.x == 0) {
        unsigned* bar = b.bar;
        __builtin_amdgcn_s_waitcnt(0);
        unsigned nloc = b.st[0], nx = b.st[1];
        if (nloc == 0u) { xcd_barrier_complete(bar, b.x, nloc, nx); b.st[0] = nloc; b.st[1] = nx; }
        const unsigned old = xb_add(&bar[XB_XSUB(b.x)], 1u);
        const unsigned gen = old / nloc;
        if (old + 1u == (gen + 1u) * nloc) {
            __builtin_amdgcn_fence(__ATOMIC_RELEASE, "agent");
            asm volatile("s_waitcnt vmcnt(0)" ::: "memory");
            const unsigned og = xb_add(&bar[XB_TOP], 1u);
            const unsigned tg = og / nx;
            if (og + 1u == (tg + 1u) * nx) xb_add(&bar[XB_TOPGEN], 1u);
            else XB_SPIN(xb_ld(&bar[XB_TOPGEN]) == tg, bar);
            __builtin_amdgcn_fence(__ATOMIC_ACQUIRE, "agent");
            xb_add(&bar[XB_XGEN(b.x)], 1u);
            asm volatile("s_waitcnt vmcnt(0)" ::: "memory");
        } else {
            XB_SPIN(xb_ld(&bar[XB_XGEN(b.x)]) == gen, bar);
            __builtin_amdgcn_fence(__ATOMIC_ACQUIRE, "agent");
            asm volatile("s_waitcnt vmcnt(0)" ::: "memory");
        }
    }
    __syncthreads();
}

constexpr int NPHASES = 15;
__global__ void __launch_bounds__(NTHREADS, 2) mega(Args a) {
    extern __shared__ __attribute__((aligned(16))) unsigned char lds_raw[];
    LAS unsigned char* lds = (LAS unsigned char*)lds_raw;
    const int lo = a.ph_lo, hi = a.ph_hi;
    unsigned char* ws = a.ws;
#if USE_CG_SYNC
    cg::grid_group grid = cg::this_grid();
#define GRID_SYNC() grid.sync()
#else
    volatile LAS unsigned* bst = (volatile LAS unsigned*)(lds + LDS_BYTES - 16);
    if (threadIdx.x < 2) bst[threadIdx.x] = 0u;
    __syncthreads();
    XcdBarrier xbar = xcd_barrier_post((unsigned*)(ws + WS_CTL), bst);
#define GRID_SYNC() xcd_barrier(xbar)
#endif
#define IN(k) (lo <= (k) && (k) < hi)
#define SEAM(k) do { if (IN(k) && IN((k) + 1)) GRID_SYNC(); } while (0)
#define PH(k, ...) do { if (IN(k)) { __VA_ARGS__; if ((PROBE_MASK >> (k)) & 1u) { GRID_SYNC(); __VA_ARGS__; } } SEAM(k); } while (0)
    PH(0, phase0(a, lds));
    PH(1, {
        finalize_ada(a);
        const int nsp = gridDim.x >= 64 ? 12 : 0, nreg = gridDim.x - nsp;
        if ((int)blockIdx.x >= nreg) {
            const int si = blockIdx.x - nreg, b = si / 6, pn = 2 + si % 6;
            if (threadIdx.x < 64) { unsigned* cnt = (unsigned*)(ws + WS_CTL) + CW_CTXCNT + 64 * b; unsigned sp = 0;
                while ((unsigned)__builtin_amdgcn_readfirstlane(__hip_atomic_load(cnt, __ATOMIC_RELAXED, __HIP_MEMORY_SCOPE_AGENT)) < 16u) { __builtin_amdgcn_s_sleep(4); if (++sp > (1u << 22)) break; }
                __builtin_amdgcn_fence(__ATOMIC_ACQUIRE, "agent");
                asm volatile("s_waitcnt vmcnt(0)" ::: "memory"); }
            __syncthreads();
            SchedOne S; S.A = (const char*)(ws + WS_H); S.B = (const char*)(ws + WS_WIN); S.tstep = (size_t)256 * DM * 2; S.pm = NLAT / 256 + b; S.pn = pn;
            EpiInProj E{(bf16*)(ws + WS_P)};
            pg8::gemm_phase<EpiInProj, SchedOne, false, true, true>(lds, DM, S, E);
        } else phase_norm_tile<0>(a, lds, blockIdx.x, nreg, NROWS / 16); });
    PH(2, {
        SchedPlain S; S.init((gridDim.x >= 64 ? NLAT : NROWS) / 256, WIN_ROWS / 256, gridDim.x, blockIdx.x); S.A = (const char*)(ws + WS_H); S.B = (const char*)(ws + WS_WIN); S.tstep = (size_t)256 * DM * 2;
        EpiInProj E{(bf16*)(ws + WS_P)};
        pg8::gemm_phase<EpiInProj, SchedPlain, false, true, true>(lds, DM, S, E); });
    PH(3, { for (int it = blockIdx.x; it < 272; it += gridDim.x) gla_passA(a, lds, it); });
    PH(4, gla_passB(a));
    PH(5, { for (int it = blockIdx.x; it < 256; it += gridDim.x) gla_passC(a, lds, it); });
    PH(6, phase_gla_merge(a));
    PH(7, phase_f1(a, lds));
    PH(8, phase_f34(a, lds));
    PH(9, {
        SchedPlain S; S.init(NLAT / 256, DM / 256, gridDim.x, blockIdx.x); S.A = (const char*)(ws + WS_YCAT); S.B = (const char*)(ws + WS_WOUT); S.tstep = (size_t)256 * DM * 2;
        EpiOutProj E{(bf16*)(ws + WS_DLT), (const float*)(ws + WS_ADA)};
        pg8::gemm_phase<EpiOutProj, SchedPlain, false, true, true>(lds, DM, S, E); });
    PH(10, phase_norm_tile<1>(a, lds, blockIdx.x, gridDim.x, NLAT / 16));
    PH(11, phase_topk(a, lds));
    PH(12, {
        SchedMoeUp S; S.init(256, 8, gridDim.x, blockIdx.x); S.A = (const char*)(ws + WS_HF); S.B = (const char*)(ws + WS_WGU); S.tok = (const int*)(ws + WS_TOK);
        EpiSwiglu E{(bf16*)(ws + WS_HID)};
        pg8::gemm_phase<EpiSwiglu, SchedMoeUp, true, true, true>(lds, DM, S, E); });
    PH(13, {
        SchedMoeDown S; S.init(256, 8, gridDim.x, blockIdx.x); S.A = (const char*)(ws + WS_HID); S.B = (const char*)(ws + WS_WD);
        EpiBf16 E{(bf16*)(ws + WS_YE), DM};
        pg8::gemm_phase<EpiBf16, SchedMoeDown, false, true, true>(lds, DEXP, S, E); });
    PH(14, phase_final(a));
#undef PH
#undef IN
#undef SEAM
}

#ifndef N_LAUNCH_MODE
#define N_LAUNCH_MODE 1
#endif
extern "C" void kernel_launch(void* const* d_in, const int* in_sizes, int n_in, void* d_out, int out_size, void* d_ws, size_t ws_size, hipStream_t stream) {
    static int grid = 0;
    if (grid == 0) {
        if (n_in != 20 || out_size != NLAT * DM || ws_size < WS_END) { fprintf(stderr, "kernel_launch: unexpected sizes n_in %d out %d ws %zu\n", n_in, out_size, ws_size); grid = -1; return; }
        int dev = 0, cus = 0, per_cu = 0;
        (void)hipGetDevice(&dev); (void)hipDeviceGetAttribute(&cus, hipDeviceAttributeMultiprocessorCount, dev);
        if (hipFuncSetAttribute((const void*)mega, hipFuncAttributeMaxDynamicSharedMemorySize, LDS_BYTES) != hipSuccess) { fprintf(stderr, "kernel_launch: hipFuncSetAttribute failed\n"); grid = -1; return; }
        (void)hipOccupancyMaxActiveBlocksPerMultiprocessor(&per_cu, (const void*)mega, NTHREADS, LDS_BYTES);
        if (per_cu < 1) { fprintf(stderr, "kernel_launch: occupancy query reports %d blocks per CU\n", per_cu); per_cu = 1; }
        (void)hipGetLastError();
        grid = cus * 1;
    }
    if (grid < 0) return;
    Args a{};
    for (int i = 0; i < 20; ++i) a.in[i] = (const float*)d_in[i];
    a.out = (float*)d_out; a.ws = (unsigned char*)d_ws;
#if N_LAUNCH_MODE == 0
    for (int p = 0; p < NPHASES; ++p) { a.ph_lo = p; a.ph_hi = p + 1; hipLaunchKernelGGL(mega, dim3(grid), dim3(NTHREADS), LDS_BYTES, stream, a); }
#else
    a.ph_lo = 0; a.ph_hi = NPHASES;
#if USE_CG_SYNC
    void* args[] = {&a};
    hipError_t e = hipLaunchCooperativeKernel((void*)mega, dim3(grid), dim3(NTHREADS), args, LDS_BYTES, stream);
    if (e != hipSuccess) fprintf(stderr, "cooperative launch failed: %s (grid %d)\n", hipGetErrorString(e), grid);
#else
    if (hipMemsetAsync((char*)d_ws + WS_CTL, 0, CTL_BYTES, stream) != hipSuccess) { fprintf(stderr, "kernel_launch: memset of control words failed\n"); return; }
    hipLaunchKernelGGL(mega, dim3(grid), dim3(NTHREADS), LDS_BYTES, stream, a);
#endif
#endif
}
```

```cpp
#include <hip/hip_runtime.h>
#include <hip/hip_cooperative_groups.h>
#include <cstdio>
#include <cstdint>
namespace cg = cooperative_groups;

#define LAS __attribute__((address_space(3)))
typedef unsigned short bf16;
typedef short bf16x8 __attribute__((ext_vector_type(8)));
typedef float f32x4 __attribute__((ext_vector_type(4)));
typedef float f32x2 __attribute__((ext_vector_type(2)));
typedef unsigned u32x4 __attribute__((ext_vector_type(4)));
typedef unsigned u32x2 __attribute__((ext_vector_type(2)));

constexpr int NB = 2, SEQ = 16384, DM = 2048, CTXL = 256;
constexpr int NLAT = NB * SEQ;
constexpr int NROWS = NLAT + NB * CTXL;
constexpr int PROJW = 4128;
constexpr int NE = 16, CAP = 2048, DEXP = 1024;
constexpr int PW = 4096;
constexpr int WIN_ROWS = 4096;
constexpr float EPS = 1e-6f;

constexpr size_t MiB = 1u << 20;
constexpr size_t WS_ADA = 0;
constexpr size_t WS_TW = 1 * MiB;
constexpr size_t WS_FC = 1 * MiB + 256 * 1024;
constexpr size_t WS_FS = 1 * MiB + 320 * 1024;
constexpr size_t WS_WRH = 1 * MiB + 384 * 1024;
constexpr size_t WS_WRL = 1 * MiB + 448 * 1024;
constexpr size_t WS_Z = 2 * MiB;
constexpr size_t WS_AFF = 8 * MiB;
constexpr size_t WS_TOK = 10 * MiB;
constexpr size_t WS_GATE = 11 * MiB;
constexpr size_t WS_SEL = 12 * MiB;
constexpr size_t WS_ST0 = 14 * MiB;
constexpr size_t WS_CTL = 16 * MiB;
constexpr size_t CTL_BYTES = 65536;
constexpr size_t WS_ADAP = 20 * MiB;
constexpr size_t WS_WIN = 32 * MiB;
constexpr size_t WS_WOUT = 50 * MiB;
constexpr size_t WS_WGU = 58 * MiB;
constexpr size_t WS_WD = 186 * MiB;
constexpr size_t WS_P = 250 * MiB;
constexpr size_t WS_HF = 250 * MiB;
constexpr size_t WS_HID = 378 * MiB;
constexpr size_t WS_FX = 250 * MiB;
constexpr size_t WS_FA = 510 * MiB;
constexpr size_t WS_FAI = 574 * MiB;
constexpr size_t WS_H = 510 * MiB;
constexpr size_t WS_OF = 510 * MiB;
constexpr size_t WS_OB = 574 * MiB;
constexpr size_t WS_T = 638 * MiB;
constexpr size_t WS_SST = 670 * MiB;
constexpr size_t WS_DT = 702 * MiB;
constexpr size_t WS_DLT = 510 * MiB;
constexpr size_t WS_YCAT = 766 * MiB;
constexpr size_t WS_YE = 766 * MiB;
constexpr size_t WS_END = 1022 * MiB;

#ifndef USE_CG_SYNC
#define USE_CG_SYNC 0
#endif
#ifndef PROBE_EPI
#define PROBE_EPI 0
#endif
#ifndef PROBE_P0
#define PROBE_P0 0
#endif
#ifndef PROBE_MASK
#define PROBE_MASK 0u
#endif
constexpr int LDS_BYTES = 163840;
constexpr int NTHREADS = 512;

struct Args {
    const float* in[20];
    float* out;
    unsigned char* ws;
    int ph_lo, ph_hi;
};

__device__ __forceinline__ float bf2f(bf16 v) { return __uint_as_float(((unsigned)v) << 16); }
typedef __bf16 bf16x2_t __attribute__((ext_vector_type(2)));
__device__ __forceinline__ unsigned pk2(float lo, float hi) { const f32x2 v = {lo, hi}; return __builtin_bit_cast(unsigned, __builtin_convertvector(v, bf16x2_t)); }
__device__ __forceinline__ unsigned f2bf(float f) { return pk2(f, 0.f) & 0xffffu; }
__device__ __forceinline__ float wave_sum(float v) {
#pragma unroll
    for (int o = 1; o < 64; o <<= 1) v += __shfl_xor(v, o);
    return v;
}
__device__ __forceinline__ float silu_f(float x) { return x / (1.f + __expf(-x)); }
__device__ __forceinline__ float logsigmoid_f(float x) { return fminf(x, 0.f) - log1pf(expf(-fabsf(x))); }

namespace pg8 {
constexpr int BM = 256, BK = 64, HALF = 128, HTB = HALF * BK * 2, STAGE_BYTES = 8 * HTB, NXCD = 8, WGM = 8;
__host__ __device__ __forceinline__ int lds_byte(int r, int c) { const int st = (r >> 4) * 2 + (c >> 5), rr = r & 15, cc = c & 31, ob = rr * 64 + cc * 2; return st * 1024 + (ob ^ (((ob >> 9) & 1) << 5)); }
__host__ __device__ __forceinline__ void stage_rc(int b, int& R, int& C) { const int st = b / 1024, sb = b % 1024, swz = sb ^ (((sb >> 9) & 1) << 5); R = (st >> 1) * 16 + swz / 64; C = (st & 1) * 32 + (swz % 64) / 2; }
__host__ __device__ __forceinline__ int perm32(int rho) { const int n = rho >> 4, i = rho & 15; return 8 * (i >> 2) + 4 * n + (i & 3); }
struct Unit { int pm, pn; };
__device__ __forceinline__ unsigned cvt_pk_bf16(float lo, float hi) { return pk2(lo, hi); }

struct OrderBase {
    int nM, nN, nwg, G, c;
    __device__ void init(int nM_, int nN_, int G_, int c_) { nM = nM_; nN = nN_; nwg = nM * nN; G = G_; c = c_; }
    __device__ bool next(int i, Unit& u) const {
        const long L = (long)i * G + c; if (L >= nwg) return false;
        int wgid = (int)L; { const int q = nwg / NXCD, r = nwg % NXCD, xcd = wgid % NXCD, off = wgid / NXCD; wgid = (xcd < r ? xcd * (q + 1) : r * (q + 1) + (xcd - r) * q) + off; }
        const int nig = WGM * nN, gid = wgid / nig, fm = gid * WGM, gsz = (nM - fm) < WGM ? (nM - fm) : WGM;
        u.pm = fm + ((wgid % nig) % gsz); u.pn = (wgid % nig) / gsz; return true;
    }
};

template <class Epi, class Sched, bool GATHER, bool ALIGN_EPI, bool SP2>
__device__ __forceinline__ void gemm_phase(LAS unsigned char* lds, const int K, const Sched& S, const Epi& E) {
    const int tid = threadIdx.x, wid = __builtin_amdgcn_readfirstlane(tid >> 6), lane = tid & 63, wr = wid >> 2, wc = wid & 3, fr = lane & 15, fq = lane >> 4;
    const int nt = K / BK;
    unsigned voffA[2], voffA1[2], voffB[2];
    int RA[2], CA[2];
#pragma unroll
    for (int i = 0; i < 2; ++i) { int R, C; stage_rc(tid * 16 + i * 8192, R, C); const int Rb = Epi::PERM ? ((R & ~31) + perm32(R & 31)) : R;
        RA[i] = R; CA[i] = C;
        voffA[i] = (unsigned)(R * K + C) * 2u; voffA1[i] = voffA[i]; voffB[i] = (unsigned)(Rb * K + C) * 2u; }
    const size_t kstep = (size_t)(BK * 2);
    const size_t hstep = (size_t)HALF * K * 2;
    const size_t hstepA = GATHER ? 0 : hstep;
    const unsigned ldsw = (unsigned)wid * 1024u;
    const int aoff = lds_byte(wr * 64 + fr, fq * 8), boff = lds_byte(wc * 32 + fr, fq * 8);
#define PG8_SA(b, h) (((b) * 2 + (h)) * HTB)
#define PG8_SB(b, h) ((4 + (b) * 2 + (h)) * HTB)
#define PG8_STAGE(bufoff, gbase, voff) do { _Pragma("unroll") for (int _i = 0; _i < 2; ++_i) \
        __builtin_amdgcn_global_load_lds((const unsigned*)((const char*)(gbase) + (voff)[_i]), (LAS unsigned*)(lds + (bufoff) + ldsw + _i * 8192), 16, 0, 0); } while (0)
#define PG8_LDA(dst, b, h) do { _Pragma("unroll") for (int m = 0; m < 4; ++m) _Pragma("unroll") for (int k = 0; k < 2; ++k) dst[m][k] = *(const LAS bf16x8*)(lds + PG8_SA(b, h) + aoff + m * 2048 + k * 1024); } while (0)
#define PG8_LDB(dst, b, h) do { _Pragma("unroll") for (int n = 0; n < 2; ++n) _Pragma("unroll") for (int k = 0; k < 2; ++k) dst[n][k] = *(const LAS bf16x8*)(lds + PG8_SB(b, h) + boff + n * 2048 + k * 1024); } while (0)
#define PG8_MMA(ai, bj, At, Bt) do { __builtin_amdgcn_s_setprio(1); _Pragma("unroll") for (int m = 0; m < 4; ++m) _Pragma("unroll") for (int n = 0; n < 2; ++n) _Pragma("unroll") for (int k = 0; k < 2; ++k) \
        acc[ai][bj][m][n] = __builtin_amdgcn_mfma_f32_16x16x32_bf16(Bt[n][k], At[m][k], acc[ai][bj][m][n], 0, 0, 0); __builtin_amdgcn_s_setprio(0); } while (0)
#define PG8_WAIT_V(n) asm volatile("s_waitcnt vmcnt(" #n ")" ::: "memory")
#define PG8_WAIT_L(n) asm volatile("s_waitcnt lgkmcnt(" #n ")" ::: "memory")
#define PG8_BAR __builtin_amdgcn_s_barrier()
#define PG8_SCHED __builtin_amdgcn_sched_barrier(0)
    Unit cur, nxt; int ui = 0;
    if (!S.next(0, cur)) return;
    f32x4 acc[2][2][4][2];
#pragma unroll
    for (int a = 0; a < 2; ++a)
#pragma unroll
        for (int b = 0; b < 2; ++b)
#pragma unroll
            for (int m = 0; m < 4; ++m)
#pragma unroll
                for (int n = 0; n < 2; ++n) acc[a][b][m][n] = (f32x4){0.f, 0.f, 0.f, 0.f};
    bf16x8 At[4][2], B0[2][2], B1[2][2];
    const char* cA = S.abase(cur); const char* cB = S.bbase(cur);
    if constexpr (GATHER) {
#pragma unroll
        for (int i = 0; i < 2; ++i) { voffA[i] = ((unsigned)S.arow(cur, RA[i]) * (unsigned)K + (unsigned)CA[i]) * 2u; voffA1[i] = ((unsigned)S.arow(cur, HALF + RA[i]) * (unsigned)K + (unsigned)CA[i]) * 2u; }
    }
    static_assert(SP2, "only the SP2 loop is kept");
    PG8_STAGE(PG8_SB(0, 0), cB, voffB); PG8_STAGE(PG8_SB(0, 1), cB + hstep, voffB); PG8_STAGE(PG8_SA(0, 0), cA, voffA); PG8_STAGE(PG8_SA(0, 1), cA + hstepA, voffA1);
    if (wr == 1) PG8_BAR;
    PG8_WAIT_V(2); PG8_BAR;
    PG8_STAGE(PG8_SB(1, 0), cB + kstep, voffB); PG8_STAGE(PG8_SA(1, 0), cA + kstep, voffA); PG8_STAGE(PG8_SB(1, 1), cB + hstep + kstep, voffB);
    PG8_WAIT_V(6); PG8_BAR;
    for (;;) {
        const bool has_next = S.next(ui + 1, nxt);
        const char* nA = has_next ? S.abase(nxt) : cA; const char* nB = has_next ? S.bbase(nxt) : cB;
        for (int t = 0; t < nt; t += 2) {
            const bool last = (t == nt - 2);
            const char* a1 = cA + (size_t)(t + 1) * kstep;
            const char* a2 = last ? nA : cA + (size_t)(t + 2) * kstep; const char* b2 = last ? nB : cB + (size_t)(t + 2) * kstep;
            const char* a3 = a2 + kstep; const char* b3 = b2 + kstep;
            PG8_LDB(B0, 0, 0); PG8_LDB(B1, 0, 1); PG8_SCHED; PG8_LDA(At, 0, 0); PG8_STAGE(PG8_SA(1, 1), a1 + hstepA, voffA1);
            if constexpr (GATHER) { if (last && has_next) {
#pragma unroll
                for (int i = 0; i < 2; ++i) { voffA[i] = ((unsigned)S.arow(nxt, RA[i]) * (unsigned)K + (unsigned)CA[i]) * 2u; voffA1[i] = ((unsigned)S.arow(nxt, HALF + RA[i]) * (unsigned)K + (unsigned)CA[i]) * 2u; } } }
            PG8_WAIT_V(8); PG8_WAIT_L(0); PG8_BAR; PG8_MMA(0, 0, At, B0); PG8_MMA(0, 1, At, B1); PG8_BAR; PG8_SCHED;
            PG8_LDA(At, 0, 1); PG8_STAGE(PG8_SB(0, 0), b2, voffB); PG8_STAGE(PG8_SB(0, 1), b2 + hstep, voffB); PG8_STAGE(PG8_SA(0, 0), a2, voffA);
            PG8_WAIT_V(8); PG8_WAIT_L(0); PG8_BAR; PG8_MMA(1, 0, At, B0); PG8_MMA(1, 1, At, B1); PG8_BAR; PG8_SCHED;
            PG8_LDB(B0, 1, 0); PG8_LDB(B1, 1, 1); PG8_SCHED; PG8_LDA(At, 1, 0); PG8_STAGE(PG8_SA(0, 1), a2 + hstepA, voffA1);
            PG8_WAIT_V(8); PG8_WAIT_L(0); PG8_BAR; PG8_MMA(0, 0, At, B0); PG8_MMA(0, 1, At, B1); PG8_BAR; PG8_SCHED;
            PG8_LDA(At, 1, 1); PG8_STAGE(PG8_SB(1, 0), b3, voffB); PG8_STAGE(PG8_SB(1, 1), b3 + hstep, voffB); PG8_STAGE(PG8_SA(1, 0), a3, voffA);
            PG8_WAIT_V(8); PG8_WAIT_L(0); PG8_BAR; PG8_MMA(1, 0, At, B0); PG8_MMA(1, 1, At, B1); PG8_BAR; PG8_SCHED;
        }
        if constexpr (ALIGN_EPI) { if (wr == 0) PG8_BAR; }
        E(acc, cur, wr, wc, fr, fq);
        if (PROBE_EPI == 1) { asm volatile("" ::: "memory"); E(acc, cur, wr, wc, fr, fq); }
        if (PROBE_EPI == 2) { asm volatile("s_waitcnt vmcnt(0)" ::: "memory"); }
        if (!has_next) break;
#pragma unroll
        for (int a = 0; a < 2; ++a)
#pragma unroll
            for (int b = 0; b < 2; ++b)
#pragma unroll
                for (int m = 0; m < 4; ++m)
#pragma unroll
                    for (int n = 0; n < 2; ++n) acc[a][b][m][n] = (f32x4){0.f, 0.f, 0.f, 0.f};
        cur = nxt; cA = nA; cB = nB; ++ui;
        if constexpr (ALIGN_EPI) { if (wr == 1) PG8_BAR; }
    }
    PG8_WAIT_V(0);
    if constexpr (!ALIGN_EPI) { if (wr == 0) PG8_BAR; }
    PG8_BAR;
#undef PG8_SA
#undef PG8_SB
#undef PG8_STAGE
#undef PG8_LDA
#undef PG8_LDB
#undef PG8_MMA
#undef PG8_WAIT_V
#undef PG8_WAIT_L
#undef PG8_BAR
#undef PG8_SCHED
}
}
using pg8::Unit;
using pg8::cvt_pk_bf16;
constexpr int HALF = pg8::HALF, BM = pg8::BM;

struct SchedPlain : pg8::OrderBase {
    const char* A; const char* B; size_t tstep;
    __device__ __forceinline__ const char* abase(const Unit& u) const { return A + (size_t)u.pm * tstep; }
    __device__ __forceinline__ const char* bbase(const Unit& u) const { return B + (size_t)u.pn * tstep; }
    __device__ __forceinline__ int arow(const Unit&, int) const { return 0; }
};
struct SchedOne {
    const char* A; const char* B; size_t tstep; int pm, pn;
    __device__ __forceinline__ bool next(int i, Unit& u) const { if (i != 0) return false; u.pm = pm; u.pn = pn; return true; }
    __device__ __forceinline__ const char* abase(const Unit& u) const { return A + (size_t)u.pm * tstep; }
    __device__ __forceinline__ const char* bbase(const Unit& u) const { return B + (size_t)u.pn * tstep; }
    __device__ __forceinline__ int arow(const Unit&, int) const { return 0; }
};
struct SchedMoeUp : pg8::OrderBase {
    const char* A; const char* B; const int* tok;
    __device__ __forceinline__ const char* abase(const Unit&) const { return A; }
    __device__ __forceinline__ const char* bbase(const Unit& u) const { return B + ((size_t)(u.pm >> 4) * 2048 + (size_t)u.pn * 256) * (size_t)(DM * 2); }
    __device__ __forceinline__ int arow(const Unit& u, int r) const { const int e = u.pm >> 4, b = (u.pm >> 3) & 1, mt = u.pm & 7; return b * SEQ + tok[(b * NE + e) * CAP + mt * 256 + r]; }
};
struct SchedMoeDown : pg8::OrderBase {
    const char* A; const char* B;
    __device__ __forceinline__ const char* abase(const Unit& u) const { return A + (size_t)u.pm * 256 * (size_t)(DEXP * 2); }
    __device__ __forceinline__ const char* bbase(const Unit& u) const { return B + ((size_t)(u.pm >> 4) * 2048 + (size_t)u.pn * 256) * (size_t)(DEXP * 2); }
    __device__ __forceinline__ int arow(const Unit&, int) const { return 0; }
};

struct EpiInProj {
    static constexpr bool PERM = true;
    bf16* P;
    __device__ __forceinline__ void operator()(const f32x4 (&acc)[2][2][4][2], const Unit& u, int wr, int wc, int fr, int fq) const {
        const int row0 = u.pm * BM + wr * 64 + fr, col0 = u.pn * BM + wc * 32 + 8 * fq;
#pragma unroll
        for (int ai = 0; ai < 2; ++ai)
#pragma unroll
            for (int m = 0; m < 4; ++m) { bf16* rowp = P + (size_t)(row0 + ai * HALF + m * 16) * PW + col0;
#pragma unroll
                for (int bj = 0; bj < 2; ++bj) { const f32x4 v0 = acc[ai][bj][m][0], v1 = acc[ai][bj][m][1];
                    u32x4 w; w.x = cvt_pk_bf16(v0[0], v0[1]); w.y = cvt_pk_bf16(v0[2], v0[3]); w.z = cvt_pk_bf16(v1[0], v1[1]); w.w = cvt_pk_bf16(v1[2], v1[3]);
                    *(u32x4*)(rowp + bj * HALF) = w; } }
    }
};
struct EpiOutProj {
    static constexpr bool PERM = true;
    const float* X; bf16* D; const float* ada;
    __device__ __forceinline__ void operator()(const f32x4 (&acc)[2][2][4][2], const Unit& u, int wr, int wc, int fr, int fq) const {
        const int row0 = u.pm * BM + wr * 64 + fr, col0 = u.pn * BM + wc * 32 + 8 * fq;
        const int b = (u.pm * BM) / SEQ;
        const float* g1 = ada + (size_t)b * 12288 + 2 * DM;
        f32x4 gv[2][2];
#pragma unroll
        for (int bj = 0; bj < 2; ++bj)
#pragma unroll
            for (int n = 0; n < 2; ++n) gv[bj][n] = *(const f32x4*)(g1 + col0 + bj * HALF + 4 * n);
#pragma unroll
        for (int ai = 0; ai < 2; ++ai)
#pragma unroll
            for (int m = 0; m < 4; ++m) { const size_t off = (size_t)(row0 + ai * HALF + m * 16) * DM + col0;
#pragma unroll
                for (int bj = 0; bj < 2; ++bj) { const f32x4 x0 = *(const f32x4*)(X + off + bj * HALF), x1 = *(const f32x4*)(X + off + bj * HALF + 4);
                    const f32x4 v0 = x0 + acc[ai][bj][m][0] * gv[bj][0], v1 = x1 + acc[ai][bj][m][1] * gv[bj][1];
                    u32x4 w; w.x = cvt_pk_bf16(v0[0], v0[1]); w.y = cvt_pk_bf16(v0[2], v0[3]); w.z = cvt_pk_bf16(v1[0], v1[1]); w.w = cvt_pk_bf16(v1[2], v1[3]);
                    *(u32x4*)(D + off + bj * HALF) = w; }
                asm volatile("" ::: "memory"); }
    }
};
struct EpiSwiglu {
    static constexpr bool PERM = true;
    bf16* HID;
    __device__ __forceinline__ void operator()(const f32x4 (&acc)[2][2][4][2], const Unit& u, int wr, int wc, int fr, int fq) const {
        const int row0 = u.pm * BM + wr * 64 + fr, col0 = u.pn * 128 + wc * 32 + 8 * fq;
#pragma unroll
        for (int ai = 0; ai < 2; ++ai)
#pragma unroll
            for (int m = 0; m < 4; ++m) { bf16* rowp = HID + (size_t)(row0 + ai * HALF + m * 16) * DEXP + col0;
                f32x4 h0, h1;
#pragma unroll
                for (int j = 0; j < 4; ++j) { h0[j] = silu_f(acc[ai][0][m][0][j]) * acc[ai][1][m][0][j]; h1[j] = silu_f(acc[ai][0][m][1][j]) * acc[ai][1][m][1][j]; }
                u32x4 w; w.x = cvt_pk_bf16(h0[0], h0[1]); w.y = cvt_pk_bf16(h0[2], h0[3]); w.z = cvt_pk_bf16(h1[0], h1[1]); w.w = cvt_pk_bf16(h1[2], h1[3]);
                *(u32x4*)(rowp) = w; }
    }
};
struct EpiBf16 {
    static constexpr bool PERM = true;
    bf16* O; int ldc;
    __device__ __forceinline__ void operator()(const f32x4 (&acc)[2][2][4][2], const Unit& u, int wr, int wc, int fr, int fq) const {
        const int row0 = u.pm * BM + wr * 64 + fr, col0 = u.pn * BM + wc * 32 + 8 * fq;
#pragma unroll
        for (int ai = 0; ai < 2; ++ai)
#pragma unroll
            for (int m = 0; m < 4; ++m) { bf16* rowp = O + (size_t)(row0 + ai * HALF + m * 16) * ldc + col0;
#pragma unroll
                for (int bj = 0; bj < 2; ++bj) { const f32x4 v0 = acc[ai][bj][m][0], v1 = acc[ai][bj][m][1];
                    u32x4 w; w.x = cvt_pk_bf16(v0[0], v0[1]); w.y = cvt_pk_bf16(v0[2], v0[3]); w.z = cvt_pk_bf16(v1[0], v1[1]); w.w = cvt_pk_bf16(v1[2], v1[3]);
                    *(u32x4*)(rowp + bj * HALF) = w; } }
    }
};

__device__ __forceinline__ void transpose_item(const float* src, int ldsrc, int scol0, int k0, bf16* dst, size_t drow0, int ldd, LAS float* scr, int lane) {
#pragma unroll 8
    for (int i = 0; i < 32; ++i) { const int kk = 2 * i + (lane >> 5); scr[kk * 33 + (lane & 31)] = src[(size_t)(k0 + kk) * ldsrc + scol0 + (lane & 31)]; }
    asm volatile("s_waitcnt lgkmcnt(0)" ::: "memory");
    const int c = lane & 7;
#pragma unroll
    for (int j = 0; j < 4; ++j) { const int n = (lane >> 3) + 8 * j; const LAS float* s = scr + (8 * c) * 33 + n;
        u32x4 o; o.x = pk2(s[0 * 33], s[1 * 33]); o.y = pk2(s[2 * 33], s[3 * 33]); o.z = pk2(s[4 * 33], s[5 * 33]); o.w = pk2(s[6 * 33], s[7 * 33]);
        *(u32x4*)(dst + (drow0 + n) * (size_t)ldd + k0 + 8 * c) = o; }
    asm volatile("s_waitcnt lgkmcnt(0)" ::: "memory");
}

struct T64 { const float* src; bf16* dst; int ldsrc, ldd; };
__device__ __forceinline__ T64 decode_t64(const Args& a, int r) {
    unsigned char* ws = a.ws; T64 t;
    if (r < 2048) { const int kb = r >> 6, nb = r & 63; const int scol = nb < 48 ? nb * 64 : 3104 + (nb - 48) * 64;
        t.src = a.in[7] + (size_t)(kb * 64) * PROJW + scol; t.ldsrc = PROJW; t.dst = (bf16*)(ws + WS_WIN) + (size_t)(nb * 64) * DM + kb * 64; t.ldd = DM; return t; }
    r -= 2048;
    if (r < 1024) { const int kb = r >> 5, nb = r & 31;
        t.src = a.in[13] + (size_t)(kb * 64) * DM + nb * 64; t.ldsrc = DM; t.dst = (bf16*)(ws + WS_WOUT) + (size_t)(nb * 64) * DM + kb * 64; t.ldd = DM; return t; }
    r -= 1024;
    if (r < 16384) { const int up = r >= 8192; if (up) r -= 8192; const int e = r >> 9, rr = r & 511, kb = rr >> 4, nb = rr & 15, n0 = nb * 64;
        t.src = (up ? a.in[17] : a.in[16]) + (size_t)e * DM * DEXP + (size_t)(kb * 64) * DEXP + n0; t.ldsrc = DEXP;
        t.dst = (bf16*)(ws + WS_WGU) + ((size_t)e * 2048 + (size_t)(n0 >> 7) * 256 + (n0 & 127) + (up ? 128 : 0)) * DM + kb * 64; t.ldd = DM; return t; }
    r -= 16384;
    { const int e = r >> 9, rr = r & 511, kb = rr >> 5, nb = rr & 31;
        t.src = a.in[18] + (size_t)e * DEXP * DM + (size_t)(kb * 64) * DM + nb * 64; t.ldsrc = DM;
        t.dst = (bf16*)(ws + WS_WD) + ((size_t)e * 2048 + nb * 64) * DEXP + kb * 64; t.ldd = DEXP; return t; }
}
__device__ __forceinline__ void t64_load(const T64& t, int lane, f32x4 (&v)[16]) {
    const int krow = lane >> 4, c4 = lane & 15;
#pragma unroll
    for (int i = 0; i < 16; ++i) v[i] = *(const f32x4*)(t.src + (size_t)(4 * i + krow) * t.ldsrc + 4 * c4);
}
__device__ __forceinline__ void t64_finish(const T64& t, int lane, const f32x4 (&v)[16], LAS float* scr) {
    const int krow = lane >> 4, c4 = lane & 15;
#pragma unroll
    for (int i = 0; i < 16; ++i) { LAS float* p = scr + (4 * i + krow) * 65 + 4 * c4; p[0] = v[i].x; p[1] = v[i].y; p[2] = v[i].z; p[3] = v[i].w; }
    asm volatile("s_waitcnt lgkmcnt(0)" ::: "memory");
    const int c = lane & 7;
#pragma unroll
    for (int j = 0; j < 8; ++j) { const int n = (lane >> 3) + 8 * j; const LAS float* s = scr + (8 * c) * 65 + n;
        u32x4 o; o.x = pk2(s[0 * 65], s[1 * 65]); o.y = pk2(s[2 * 65], s[3 * 65]); o.z = pk2(s[4 * 65], s[5 * 65]); o.w = pk2(s[6 * 65], s[7 * 65]);
        *(u32x4*)(t.dst + (size_t)n * t.ldd + 8 * c) = o; }
    asm volatile("s_waitcnt lgkmcnt(0)" ::: "memory");
}
constexpr int P0_NT64 = 2048 + 1024 + 16384 + 8192;
constexpr int P0_TAIL = 1024;
constexpr int P0_NGEMV = 192;
__device__ __forceinline__ void phase0(const Args& a, LAS unsigned char* lds) {
    const int tid = threadIdx.x, lane = tid & 63, wave = tid >> 6, G = gridDim.x, blk = blockIdx.x;
    unsigned char* ws = a.ws;
    {
        const float* c = a.in[1]; const float* cc = a.in[3]; const float* w_ada = a.in[4]; const float* b_ada = a.in[5];
        float* part = (float*)(ws + WS_ADAP);
        LAS float* red = (LAS float*)lds;
        for (int rep_ = 0; rep_ < 1 + (PROBE_P0 & 1); ++rep_)
        for (int it = blk; it < P0_NGEMV; it += G) {
            const int cb = it % 48, ks = it / 48, col0 = cb * 256 + 4 * lane, r0 = ks * 512 + wave * 64;
            f32x4 a0 = {0.f, 0.f, 0.f, 0.f}, a1 = a0, a2 = a0;
#pragma unroll 16
            for (int r = r0; r < r0 + 64; ++r) {
                const f32x4 w = *(const f32x4*)(w_ada + (size_t)r * 12288 + col0);
                const float s0 = silu_f(c[r]), s1 = silu_f(c[DM + r]), s2 = silu_f(cc[r]);
                a0 += w * s0; a1 += w * s1; a2 += w * s2;
            }
            *(LAS f32x4*)(red + (wave * 3 + 0) * 256 + 4 * lane) = a0; *(LAS f32x4*)(red + (wave * 3 + 1) * 256 + 4 * lane) = a1; *(LAS f32x4*)(red + (wave * 3 + 2) * 256 + 4 * lane) = a2;
            __syncthreads();
            for (int idx = tid; idx < 768; idx += NTHREADS) { const int v = idx >> 8, col = idx & 255; float s = ks == 0 ? b_ada[cb * 256 + col] : 0.f;
#pragma unroll
                for (int w8 = 0; w8 < 8; ++w8) s += red[(w8 * 3 + v) * 256 + col];
                part[(size_t)(ks * 3 + v) * 12288 + cb * 256 + col] = s; }
            __syncthreads();
        }
    }
    LAS float* scr = (LAS float*)(lds + wave * 16640);
    const int gw = blk * 8 + wave, NGW = G * 8;
    constexpr int I_WZ = 32, I_WR = 512, I_TW = 256, I_FT = 256;
    for (int it = gw; it < I_WZ + I_WR + I_TW + I_FT; it += NGW) {
        int r = it;
        if (r < I_WZ) { transpose_item(a.in[7], PROJW, 3072, r * 64, (bf16*)(ws + WS_WIN), (size_t)4096, DM, scr, lane); continue; }
        r -= I_WZ;
        if (r < I_WR) { const int p = r * 64 + lane, e = p >> 11, d = p & 2047; const float wv = a.in[15][d * 16 + e]; const unsigned hi = f2bf(wv); ((bf16*)(ws + WS_WRH))[p] = (bf16)hi; ((bf16*)(ws + WS_WRL))[p] = (bf16)f2bf(wv - bf2f((bf16)hi)); continue; }
        r -= I_WR;
        if (r < I_TW) { const int p = r * 64 + lane; float s, c; sincospif((float)p * (1.0f / 8192.0f), &s, &c); ((f32x2*)(ws + WS_TW))[p] = (f32x2){c, s}; continue; }
        r -= I_TW;
        { const int p = r * 64 + lane, k = p >> 7, l = p & 127; float s, c; sincospif((float)((k * l) & 127) * (1.0f / 64.0f), &s, &c); ((bf16*)(ws + WS_FC))[p] = (bf16)f2bf(c); ((bf16*)(ws + WS_FS))[p] = (bf16)f2bf(s); }
    }
    const int n_gemv_wg = G > P0_NGEMV ? P0_NGEMV : 0;
    const int head_end = n_gemv_wg ? P0_NT64 - P0_TAIL : P0_NT64;
    const int n_head = gw < head_end ? (head_end - gw + NGW - 1) / NGW : 0;
    const int tgw = (blk - n_gemv_wg) * 8 + wave, tstep = (G - n_gemv_wg) * 8;
    const int n_tail = (n_gemv_wg && blk >= n_gemv_wg && tgw < P0_TAIL) ? (P0_TAIL - tgw + tstep - 1) / tstep : 0;
    const int n_items = n_head + n_tail;
    auto item_of = [&](int j) -> int { return j < n_head ? gw + j * NGW : head_end + tgw + (j - n_head) * tstep; };
    for (int rep_ = 0; rep_ < 1 + ((PROBE_P0 >> 1) & 1); ++rep_) {
    f32x4 va[16], vb[16]; T64 ta, tb;
    if (n_items > 0) { ta = decode_t64(a, item_of(0)); t64_load(ta, lane, va); }
    for (int j = 0; j < n_items; j += 2) {
        const bool h1 = j + 1 < n_items, h2 = j + 2 < n_items;
        if (h1) { tb = decode_t64(a, item_of(j + 1)); t64_load(tb, lane, vb); }
        t64_finish(ta, lane, va, scr);
        if (h2) { ta = decode_t64(a, item_of(j + 2)); t64_load(ta, lane, va); }
        if (h1) t64_finish(tb, lane, vb, scr);
    }
    }
}

#define MFMA16(a, b, c) __builtin_amdgcn_mfma_f32_16x16x32_bf16((a), (b), (c), 0, 0, 0)
__device__ __forceinline__ void finalize_ada(const Args& a) {
    const float* part = (const float*)(a.ws + WS_ADAP); float* adaw = (float*)(a.ws + WS_ADA);
    for (int i = blockIdx.x * NTHREADS + threadIdx.x; i < 3 * 12288; i += gridDim.x * NTHREADS) { float s = 0.f;
#pragma unroll
        for (int ks = 0; ks < 4; ++ks) s += part[(size_t)ks * 3 * 12288 + i];
        adaw[i] = s; }
}
constexpr int CW_CTXCNT = 4096;
template <int MODE>
__device__ __forceinline__ void norm_load_tile(const Args& a, int tile, int rl, int wave, int q, f32x4 (&xv)[8][2], u32x4 (&dv)[8]) {
    const int r = tile * 16 + rl;
    if (MODE == 0) { const float* s = (r < NLAT ? a.in[0] + (size_t)r * DM : a.in[2] + (size_t)(r - NLAT) * DM) + 256 * wave + 8 * q;
#pragma unroll
        for (int ks = 0; ks < 8; ++ks) { xv[ks][0] = *(const f32x4*)(s + 32 * ks); xv[ks][1] = *(const f32x4*)(s + 32 * ks + 4); } }
    if (MODE == 1) { const bf16* dp = (const bf16*)(a.ws + WS_DLT) + (size_t)r * DM + 256 * wave + 8 * q;
#pragma unroll
        for (int ks = 0; ks < 8; ++ks) dv[ks] = *(const u32x4*)(dp + 32 * ks); }
}
template <int MODE>
__device__ __forceinline__ void phase_norm_tile(const Args& a, LAS unsigned char* lds, int first, int stride, int tile_end) {
    const int tid = threadIdx.x, lane = tid & 63, wave = __builtin_amdgcn_readfirstlane(tid >> 6), rl = lane & 15, q = lane >> 4;
    const float* ada = (const float*)(a.ws + WS_ADA);
    LAS float* gs = (LAS float*)lds;
    LAS float* shv = gs + 3 * DM;
    LAS float* ssred = shv + 3 * DM;
    LAS float* red = ssred + 128;
    { const float* gn = MODE == 0 ? a.in[6] : a.in[14]; const float* part = (const float*)(a.ws + WS_ADAP);
      for (int i = tid; i < 3 * DM; i += NTHREADS) { const int v = i / DM, d = i % DM;
          float sh_, sc_;
          if (MODE == 0) { const float* p0 = part + (size_t)v * 12288; sh_ = 0.f; sc_ = 0.f;
#pragma unroll
              for (int ks = 0; ks < 4; ++ks) { sh_ += p0[(size_t)ks * 3 * 12288 + d]; sc_ += p0[(size_t)ks * 3 * 12288 + DM + d]; } }
          else { const float* base = ada + (size_t)v * 12288 + 3 * DM; sh_ = base[d]; sc_ = base[DM + d]; }
          gs[i] = gn[d] * (1.f + sc_); shv[i] = sh_; }
    }
    bf16x8 wb[2][8];
    if (MODE == 0) { const bf16* Wz = (const bf16*)(a.ws + WS_WIN) + (size_t)4096 * DM;
#pragma unroll
        for (int nt = 0; nt < 2; ++nt)
#pragma unroll
            for (int ks = 0; ks < 8; ++ks) wb[nt][ks] = *(const bf16x8*)(Wz + (size_t)(16 * nt + rl) * DM + 256 * wave + 32 * ks + 8 * q);
    } else { const bf16* WH = (const bf16*)(a.ws + WS_WRH); const bf16* WL = (const bf16*)(a.ws + WS_WRL);
#pragma unroll
        for (int ks = 0; ks < 8; ++ks) { wb[0][ks] = *(const bf16x8*)(WH + (size_t)rl * DM + 256 * wave + 32 * ks + 8 * q); wb[1][ks] = *(const bf16x8*)(WL + (size_t)rl * DM + 256 * wave + 32 * ks + 8 * q); } }
    __syncthreads();
    bf16* Hout = (bf16*)(a.ws + (MODE == 0 ? WS_H : WS_HF));
    f32x4 xv[8][2]; u32x4 dv[8];
    auto tile_of = [&](int s) -> int { return MODE == 0 ? (s < 32 ? NLAT / 16 + s : s - 32) : s; };
    int sq = first;
    if (sq < tile_end) norm_load_tile<MODE>(a, tile_of(sq), rl, wave, q, xv, dv);
    for (; sq < tile_end; sq += stride) {
        const int tile = tile_of(sq);
        const int r = tile * 16 + rl;
        const int v = MODE == 0 ? (tile * 16 < NLAT ? (tile * 16) / SEQ : 2) : (tile * 16) / SEQ;
        if (MODE == 1) {
#pragma unroll
            for (int ks = 0; ks < 8; ++ks) { const u32x4 d = dv[ks];
                xv[ks][0] = (f32x4){__uint_as_float(d.x << 16), __uint_as_float(d.x & 0xffff0000u), __uint_as_float(d.y << 16), __uint_as_float(d.y & 0xffff0000u)};
                xv[ks][1] = (f32x4){__uint_as_float(d.z << 16), __uint_as_float(d.z & 0xffff0000u), __uint_as_float(d.w << 16), __uint_as_float(d.w & 0xffff0000u)}; } }
        float ss = 0.f;
#pragma unroll
        for (int ks = 0; ks < 8; ++ks) { const f32x4 a0 = xv[ks][0], a1 = xv[ks][1]; ss += (a0.x * a0.x + a0.y * a0.y) + (a0.z * a0.z + a0.w * a0.w) + (a1.x * a1.x + a1.y * a1.y) + (a1.z * a1.z + a1.w * a1.w); }
        ss += __shfl_xor(ss, 16); ss += __shfl_xor(ss, 32);
        if (q == 0) ssred[wave * 16 + rl] = ss;
        __syncthreads();
        float tot = 0.f;
#pragma unroll
        for (int w8 = 0; w8 < 8; ++w8) tot += ssred[w8 * 16 + rl];
        const float rstd = rsqrtf(tot * (1.f / DM) + EPS);
        f32x4 acc0 = {0.f, 0.f, 0.f, 0.f}, acc1 = {0.f, 0.f, 0.f, 0.f};
        bf16* orow = Hout + (size_t)r * DM + 256 * wave + 8 * q;
        const LAS float* gsp = gs + v * DM + 256 * wave + 8 * q; const LAS float* shp = shv + v * DM + 256 * wave + 8 * q;
#pragma unroll
        for (int ks = 0; ks < 8; ++ks) {
            const f32x4 g0 = *(const LAS f32x4*)(gsp + 32 * ks), g1 = *(const LAS f32x4*)(gsp + 32 * ks + 4), s0 = *(const LAS f32x4*)(shp + 32 * ks), s1 = *(const LAS f32x4*)(shp + 32 * ks + 4);
            const f32x4 h0 = xv[ks][0] * rstd * g0 + s0, h1 = xv[ks][1] * rstd * g1 + s1;
            u32x4 hw; hw.x = pk2(h0.x, h0.y); hw.y = pk2(h0.z, h0.w); hw.z = pk2(h1.x, h1.y); hw.w = pk2(h1.z, h1.w);
            *(u32x4*)(orow + 32 * ks) = hw;
            const bf16x8 hf = __builtin_bit_cast(bf16x8, hw);
            if (MODE == 0) { acc0 = MFMA16(hf, wb[0][ks], acc0); acc1 = MFMA16(hf, wb[1][ks], acc1); }
            else { u32x4 lw;
                lw.x = pk2(h0.x - __uint_as_float(hw.x << 16), h0.y - __uint_as_float(hw.x & 0xffff0000u)); lw.y = pk2(h0.z - __uint_as_float(hw.y << 16), h0.w - __uint_as_float(hw.y & 0xffff0000u));
                lw.z = pk2(h1.x - __uint_as_float(hw.z << 16), h1.y - __uint_as_float(hw.z & 0xffff0000u)); lw.w = pk2(h1.z - __uint_as_float(hw.w << 16), h1.w - __uint_as_float(hw.w & 0xffff0000u));
                const bf16x8 lf = __builtin_bit_cast(bf16x8, lw);
                acc0 = MFMA16(hf, wb[0][ks], acc0); acc0 = MFMA16(lf, wb[0][ks], acc0); acc0 = MFMA16(hf, wb[1][ks], acc0); }
        }
        if (sq + stride < tile_end) norm_load_tile<MODE>(a, tile_of(sq + stride), rl, wave, q, xv, dv);
#pragma unroll
        for (int rr = 0; rr < 4; ++rr) { red[(wave * 16 + 4 * q + rr) * 32 + rl] = acc0[rr]; if (MODE == 0) red[(wave * 16 + 4 * q + rr) * 32 + 16 + rl] = acc1[rr]; }
        __syncthreads();
        if (MODE == 0) { const int row = tid >> 5, col = tid & 31; float s = 0.f;
#pragma unroll
            for (int w8 = 0; w8 < 8; ++w8) s += red[(w8 * 16 + row) * 32 + col];
            ((float*)(a.ws + WS_Z))[(size_t)(tile * 16 + row) * 32 + col] = s;
        } else if (tid < 256) { const int row = tid >> 4, e = tid & 15; float s = 0.f;
#pragma unroll
            for (int w8 = 0; w8 < 8; ++w8) s += red[(w8 * 16 + row) * 32 + e];
            float m = s; m = fmaxf(m, __shfl_xor(m, 1)); m = fmaxf(m, __shfl_xor(m, 2)); m = fmaxf(m, __shfl_xor(m, 4)); m = fmaxf(m, __shfl_xor(m, 8));
            const float ex = expf(s - m); float sm = ex; sm += __shfl_xor(sm, 1); sm += __shfl_xor(sm, 2); sm += __shfl_xor(sm, 4); sm += __shfl_xor(sm, 8);
            const int rg = tile * 16 + row, b = rg / SEQ, t = rg % SEQ;
            ((float*)(a.ws + WS_AFF))[((size_t)b * NE + e) * SEQ + t] = ex / sm; }
        if (MODE == 0 && tile >= NLAT / 16) {
            __threadfence(); __syncthreads();
            if (tid == 0) __hip_atomic_fetch_add((unsigned*)(a.ws + WS_CTL) + CW_CTXCNT + 64 * ((tile - NLAT / 16) >> 4), 1u, __ATOMIC_RELAXED, __HIP_MEMORY_SCOPE_AGENT);
        }
        __syncthreads();
    }
}

constexpr int GQ_LD = 136, GK_LD = 72;
constexpr int GL_Q = 0, GL_KI = 17408, GL_KET = 34816, GL_VT = 53248, GL_ST = 90112, GL_DC = 159744, GL_SEG = 160256;
__device__ __forceinline__ bf16x8 ldfrag(const LAS bf16* base, int row0, int ld, int koff, int lane) { return *(const LAS bf16x8*)(base + (row0 + (lane & 15)) * ld + koff + 8 * (lane >> 4)); }
__device__ __forceinline__ float fast_logsigmoid(float x) { return fminf(x, 0.f) - __logf(1.f + __expf(-fabsf(x))); }

struct GlaRaw { u32x4 q[2], k[2], v[4]; f32x2 z; };
template <bool FULL>
__device__ __forceinline__ void gla_issue_loads(const Args& a, size_t row0, int h, int dir, int wave, int lane, int tid, GlaRaw& r) {
    const bf16* P = (const bf16*)(a.ws + WS_P); const float* Z = (const float*)(a.ws + WS_Z);
#pragma unroll
    for (int j = 0; j < 2; ++j) { const int e = tid + 512 * j, row = e >> 4, c8 = e & 15;
        r.k[j] = *(const u32x4*)(P + (row0 + row) * PW + 512 + h * 128 + 8 * c8);
        if (FULL) r.q[j] = *(const u32x4*)(P + (row0 + row) * PW + h * 128 + 8 * c8); }
    { const int e = tid * 2; r.z = *(const f32x2*)(Z + (row0 + (e >> 4)) * 32 + dir * 16 + (e & 15)); }
#pragma unroll
    for (int rr = 0; rr < 4; ++rr) r.v[rr] = *(const u32x4*)(P + (row0 + 4 * (lane >> 2) + rr) * PW + 1024 + h * 256 + 32 * wave + 8 * (lane & 3));
}
__device__ __forceinline__ void gla_store_vt(LAS unsigned char* lds, int wave, int lane, const u32x4 (&x)[4]) {
    LAS bf16* VT = (LAS bf16*)(lds + GL_VT); const int c0 = 32 * wave + 8 * (lane & 3), l0 = 4 * (lane >> 2);
#pragma unroll
    for (int i2 = 0; i2 < 4; ++i2) {
        const unsigned a0 = x[0][i2], a1 = x[1][i2], a2 = x[2][i2], a3 = x[3][i2];
        u32x2 lo, hi; lo.x = (a0 & 0xffffu) | (a1 << 16); lo.y = (a2 & 0xffffu) | (a3 << 16); hi.x = (a0 >> 16) | (a1 & 0xffff0000u); hi.y = (a2 >> 16) | (a3 & 0xffff0000u);
        *(LAS u32x2*)(VT + (c0 + 2 * i2) * GK_LD + l0) = lo; *(LAS u32x2*)(VT + (c0 + 2 * i2 + 1) * GK_LD + l0) = hi; }
}
template <bool FULL>
__device__ __forceinline__ void gla_stage(LAS unsigned char* lds, int wave, int lane, int tid, const GlaRaw& r) {
    LAS bf16* Qd = (LAS bf16*)(lds + GL_Q); LAS bf16* Ki = (LAS bf16*)(lds + GL_KI); LAS unsigned* zs = (LAS unsigned*)(lds + GL_SEG);
#pragma unroll
    for (int j = 0; j < 2; ++j) { const int e = tid + 512 * j, row = e >> 4, c8 = e & 15;
        *(LAS u32x4*)(Ki + row * GQ_LD + 8 * c8) = r.k[j]; if (FULL) *(LAS u32x4*)(Qd + row * GQ_LD + 8 * c8) = r.q[j]; }
    zs[tid] = pk2(r.z.x, r.z.y);
    gla_store_vt(lds, wave, lane, r.v);
}
template <bool FULL>
__device__ __forceinline__ void gla_prep(LAS unsigned char* lds, int dir, const bf16x8 wfrag, float bias, float& totacc) {
    const int tid = threadIdx.x, lane = tid & 63, wave = __builtin_amdgcn_readfirstlane(tid >> 6), cidx = lane & 15, q = lane >> 4, d = 16 * wave + cidx;
    LAS bf16* Qd = (LAS bf16*)(lds + GL_Q); LAS bf16* Ki = (LAS bf16*)(lds + GL_KI); LAS bf16* KeT = (LAS bf16*)(lds + GL_KET);
    LAS float* dcv = (LAS float*)(lds + GL_DC); const LAS bf16* zs = (const LAS bf16*)(lds + GL_SEG);
    float c[4][4], t4[4], sq[4], Tt[4];
#pragma unroll
    for (int it = 0; it < 4; ++it) {
        const bf16x8 zf = *(const LAS bf16x8*)(zs + (16 * it + cidx) * 16 + 8 * (q & 1));
        f32x4 pre = {bias, bias, bias, bias};
        pre = MFMA16(zf, wfrag, pre);
#pragma unroll
        for (int r = 0; r < 4; ++r) c[it][r] = fast_logsigmoid(pre[r]) * (1.f / 16.f);
        if (!dir) { c[it][1] += c[it][0]; c[it][2] += c[it][1]; c[it][3] += c[it][2]; t4[it] = c[it][3]; }
        else { c[it][2] += c[it][3]; c[it][1] += c[it][2]; c[it][0] += c[it][1]; t4[it] = c[it][0]; }
        float s = t4[it];
        if (!dir) { const float u = __shfl_up(s, 16); if (q >= 1) s += u; const float u2 = __shfl_up(s, 32); if (q >= 2) s += u2; Tt[it] = __shfl(s, cidx + 48); }
        else { const float u = __shfl_down(s, 16); if (q <= 2) s += u; const float u2 = __shfl_down(s, 32); if (q <= 1) s += u2; Tt[it] = __shfl(s, cidx); }
        sq[it] = s - t4[it];
    }
    const float total = (Tt[0] + Tt[1]) + (Tt[2] + Tt[3]);
    float off[4];
    if (!dir) { off[0] = 0.f; off[1] = Tt[0]; off[2] = Tt[0] + Tt[1]; off[3] = Tt[0] + Tt[1] + Tt[2]; }
    else { off[3] = 0.f; off[2] = Tt[3]; off[1] = Tt[3] + Tt[2]; off[0] = Tt[3] + Tt[2] + Tt[1]; }
    const float dc = __expf(total);
#pragma unroll
    for (int it = 0; it < 4; ++it) {
        float ke[4];
#pragma unroll
        for (int r = 0; r < 4; ++r) { const int i = 16 * it + 4 * q + r; const float cum = c[it][r] + off[it] + sq[it];
            const float kf = bf2f(Ki[i * GQ_LD + d]);
            if (FULL) { const float qf = bf2f(Qd[i * GQ_LD + d]); const float kin = kf * __expf(-cum);
                Qd[i * GQ_LD + d] = (bf16)f2bf(qf * 0.08838834764831845f * __expf(cum)); Ki[i * GQ_LD + d] = (bf16)f2bf(kin); ke[r] = kin * dc; }
            else ke[r] = kf * __expf(total - cum); }
        u32x2 kw; kw.x = pk2(ke[0], ke[1]); kw.y = pk2(ke[2], ke[3]);
        *(LAS u32x2*)(KeT + d * GK_LD + 16 * it + 4 * q) = kw;
    }
    if (q == 0) { dcv[d] = dc; totacc += total; }
}
__device__ __forceinline__ bf16x8 gla_wfrag(const float* w_a2, int h, int wave, int lane) {
    const int d = 16 * wave + (lane & 15), q = lane >> 4; unsigned wv[4];
#pragma unroll
    for (int j2 = 0; j2 < 4; ++j2) { float x[2];
#pragma unroll
        for (int u = 0; u < 2; ++u) { const float wf = w_a2[(8 * (q & 1) + 2 * j2 + u) * 512 + h * 128 + d]; const float hi = bf2f((bf16)f2bf(wf)); x[u] = q < 2 ? hi : wf - hi; }
        wv[j2] = pk2(x[0], x[1]); }
    return __builtin_bit_cast(bf16x8, (u32x4){wv[0], wv[1], wv[2], wv[3]});
}
__device__ __forceinline__ void gla_state_update(LAS unsigned char* lds, int lane, const bf16x8 (&vt)[2][2], f32x4 (&acc)[8][2]) {
    const LAS bf16* KeT = (const LAS bf16*)(lds + GL_KET); const LAS float* dcv = (const LAS float*)(lds + GL_DC);
#pragma unroll
    for (int mt = 0; mt < 8; ++mt) {
        const f32x4 dc4 = *(const LAS f32x4*)(dcv + 16 * mt + 4 * (lane >> 4));
        const bf16x8 k0 = ldfrag(KeT, 16 * mt, GK_LD, 0, lane), k1 = ldfrag(KeT, 16 * mt, GK_LD, 32, lane);
#pragma unroll
        for (int n = 0; n < 2; ++n) { f32x4 t = acc[mt][n] * dc4; t = MFMA16(k0, vt[n][0], t); t = MFMA16(k1, vt[n][1], t); acc[mt][n] = t; }
    }
}
constexpr size_t GLA_SV = 128 * 256;
__device__ __forceinline__ void gla_passA(const Args& a, LAS unsigned char* lds, int item) {
    const int tid = threadIdx.x, lane = tid & 63, wave = __builtin_amdgcn_readfirstlane(tid >> 6), q = lane >> 4, cidx = lane & 15;
    const bool is_ctx = item >= 256; const int seq = is_ctx ? item - 256 : item >> 4, s = is_ctx ? 0 : item & 15;
    const int b = seq >> 3, dir = (seq >> 2) & 1, h = seq & 3, nchunk = is_ctx ? 4 : 16;
    const size_t rowbase = is_ctx ? (size_t)(NLAT + b * CTXL) : (size_t)b * SEQ + (size_t)s * 1024;
    const float* w_a2 = dir ? a.in[10] : a.in[8]; const float* b_a2 = dir ? a.in[11] : a.in[9];
    const bf16x8 wfrag = gla_wfrag(w_a2, h, wave, lane);
    const float bias = b_a2[h * 128 + 16 * wave + cidx];
    f32x4 acc[8][2];
#pragma unroll
    for (int mt = 0; mt < 8; ++mt) { acc[mt][0] = (f32x4){0.f, 0.f, 0.f, 0.f}; acc[mt][1] = (f32x4){0.f, 0.f, 0.f, 0.f}; }
    float totacc = 0.f;
    GlaRaw raw; gla_issue_loads<false>(a, rowbase + (size_t)(dir ? (nchunk - 1) : 0) * 64, h, dir, wave, lane, tid, raw);
    for (int ci = 0; ci < nchunk; ++ci) {
        gla_stage<false>(lds, wave, lane, tid, raw);
        if (ci + 1 < nchunk) gla_issue_loads<false>(a, rowbase + (size_t)(dir ? (nchunk - 2 - ci) : ci + 1) * 64, h, dir, wave, lane, tid, raw);
        __syncthreads();
        gla_prep<false>(lds, dir, wfrag, bias, totacc);
        __syncthreads();
        const LAS bf16* VT = (const LAS bf16*)(lds + GL_VT);
        bf16x8 vt[2][2];
#pragma unroll
        for (int n2 = 0; n2 < 2; ++n2) { vt[n2][0] = ldfrag(VT, 32 * wave + 16 * n2, GK_LD, 0, lane); vt[n2][1] = ldfrag(VT, 32 * wave + 16 * n2, GK_LD, 32, lane); }
        gla_state_update(lds, lane, vt, acc);
        __syncthreads();
    }
    float* T = is_ctx ? (float*)(a.ws + WS_ST0) + (size_t)seq * GLA_SV : (float*)(a.ws + WS_T) + (size_t)item * GLA_SV;
#pragma unroll
    for (int mt = 0; mt < 8; ++mt)
#pragma unroll
        for (int n2 = 0; n2 < 2; ++n2)
#pragma unroll
            for (int r = 0; r < 4; ++r) T[(size_t)(16 * mt + 4 * q + r) * 256 + 32 * wave + 16 * n2 + cidx] = acc[mt][n2][r];
    if (!is_ctx && q == 0) ((float*)(a.ws + WS_DT))[item * 128 + 16 * wave + cidx] = __expf(totacc);
}
__device__ __forceinline__ void gla_passB(const Args& a) {
    const float* ST0 = (const float*)(a.ws + WS_ST0); const float* T = (const float*)(a.ws + WS_T); const float* DT = (const float*)(a.ws + WS_DT); float* SST = (float*)(a.ws + WS_SST);
    for (int e = blockIdx.x * NTHREADS + threadIdx.x; e < 16 * (int)GLA_SV; e += gridDim.x * NTHREADS) {
        const int seq = e >> 15, dv = e & 32767, d = dv >> 8, dir = (seq >> 2) & 1;
        float S = ST0[(size_t)seq * GLA_SV + dv];
        for (int si = 0; si < 16; ++si) { const int s = dir ? 15 - si : si; const size_t it = (size_t)seq * 16 + s;
            SST[it * GLA_SV + dv] = S; S = DT[it * 128 + d] * S + T[it * GLA_SV + dv]; }
    }
}
__device__ __forceinline__ void gla_passC(const Args& a, LAS unsigned char* lds, int item) {
    const int tid = threadIdx.x, lane = tid & 63, wave = __builtin_amdgcn_readfirstlane(tid >> 6), q = lane >> 4, cidx = lane & 15;
    const int seq = item >> 4, s = item & 15, b = seq >> 3, dir = (seq >> 2) & 1, h = seq & 3;
    const size_t rowbase = (size_t)b * SEQ + (size_t)s * 1024;
    const float* w_a2 = dir ? a.in[10] : a.in[8]; const float* b_a2 = dir ? a.in[11] : a.in[9];
    bf16* O = (bf16*)(a.ws + (dir ? WS_OB : WS_OF));
    const bf16x8 wfrag = gla_wfrag(w_a2, h, wave, lane);
    const float bias = b_a2[h * 128 + 16 * wave + cidx];
    LAS bf16* Qd = (LAS bf16*)(lds + GL_Q); LAS bf16* Ki = (LAS bf16*)(lds + GL_KI); LAS bf16* Pm = Ki; LAS bf16* VT = (LAS bf16*)(lds + GL_VT); LAS bf16* ST = (LAS bf16*)(lds + GL_ST);
    f32x4 acc[8][2];
    { const float* S0 = (const float*)(a.ws + WS_SST) + (size_t)item * GLA_SV;
#pragma unroll
      for (int mt = 0; mt < 8; ++mt)
#pragma unroll
          for (int n2 = 0; n2 < 2; ++n2) {
#pragma unroll
              for (int r = 0; r < 4; ++r) acc[mt][n2][r] = S0[(size_t)(16 * mt + 4 * q + r) * 256 + 32 * wave + 16 * n2 + cidx];
              u32x2 wv; wv.x = pk2(acc[mt][n2][0], acc[mt][n2][1]); wv.y = pk2(acc[mt][n2][2], acc[mt][n2][3]);
              *(LAS u32x2*)(ST + (32 * wave + 16 * n2 + cidx) * GQ_LD + 16 * mt + 4 * q) = wv; } }
    float totacc = 0.f;
    GlaRaw raw; gla_issue_loads<true>(a, rowbase + (size_t)(dir ? 15 : 0) * 64, h, dir, wave, lane, tid, raw);
    for (int ci = 0; ci < 16; ++ci) {
        const int n = dir ? (15 - ci) : ci; const size_t row0 = rowbase + (size_t)n * 64;
        gla_stage<true>(lds, wave, lane, tid, raw);
        if (ci + 1 < 16) gla_issue_loads<true>(a, rowbase + (size_t)(dir ? (14 - ci) : ci + 1) * 64, h, dir, wave, lane, tid, raw);
        __syncthreads();
        gla_prep<true>(lds, dir, wfrag, bias, totacc);
        __syncthreads();
        const int it = wave >> 1;
        u32x2 pw[2];
#pragma unroll
        for (int jj = 0; jj < 2; ++jj) { const int jt = 2 * (wave & 1) + jj; f32x4 sc = {0.f, 0.f, 0.f, 0.f};
#pragma unroll
            for (int ks = 0; ks < 4; ++ks) sc = MFMA16(ldfrag(Ki, 16 * jt, GQ_LD, 32 * ks, lane), ldfrag(Qd, 16 * it, GQ_LD, 32 * ks, lane), sc);
            const int i = 16 * it + cidx, j0 = 16 * jt + 4 * q;
#pragma unroll
            for (int r = 0; r < 4; ++r) { const bool keep = dir ? (j0 + r >= i) : (j0 + r <= i); sc[r] = keep ? sc[r] : 0.f; }
            pw[jj].x = pk2(sc[0], sc[1]); pw[jj].y = pk2(sc[2], sc[3]); }
        __syncthreads();
#pragma unroll
        for (int jj = 0; jj < 2; ++jj) *(LAS u32x2*)(Pm + (16 * it + cidx) * GK_LD + 16 * (2 * (wave & 1) + jj) + 4 * q) = pw[jj];
        __syncthreads();
        bf16x8 vt[2][2], st[2][4];
#pragma unroll
        for (int n2 = 0; n2 < 2; ++n2) { vt[n2][0] = ldfrag(VT, 32 * wave + 16 * n2, GK_LD, 0, lane); vt[n2][1] = ldfrag(VT, 32 * wave + 16 * n2, GK_LD, 32, lane);
#pragma unroll
            for (int ks = 0; ks < 4; ++ks) st[n2][ks] = ldfrag(ST, 32 * wave + 16 * n2, GQ_LD, 32 * ks, lane); }
#pragma unroll
        for (int i2 = 0; i2 < 4; ++i2) {
            const bf16x8 p0 = ldfrag(Pm, 16 * i2, GK_LD, 0, lane), p1 = ldfrag(Pm, 16 * i2, GK_LD, 32, lane);
            bf16x8 qf[4];
#pragma unroll
            for (int ks = 0; ks < 4; ++ks) qf[ks] = ldfrag(Qd, 16 * i2, GQ_LD, 32 * ks, lane);
#pragma unroll
            for (int n2 = 0; n2 < 2; ++n2) { f32x4 o = {0.f, 0.f, 0.f, 0.f};
                o = MFMA16(vt[n2][0], p0, o); o = MFMA16(vt[n2][1], p1, o);
#pragma unroll
                for (int ks = 0; ks < 4; ++ks) o = MFMA16(st[n2][ks], qf[ks], o);
                u32x2 wv; wv.x = pk2(o[0], o[1]); wv.y = pk2(o[2], o[3]);
                *(u32x2*)(O + (row0 + 16 * i2 + cidx) * 1024 + h * 256 + 32 * wave + 16 * n2 + 4 * q) = wv; }
        }
        gla_state_update(lds, lane, vt, acc);
#pragma unroll
        for (int mt = 0; mt < 8; ++mt)
#pragma unroll
            for (int n2 = 0; n2 < 2; ++n2) { u32x2 wv; wv.x = pk2(acc[mt][n2][0], acc[mt][n2][1]); wv.y = pk2(acc[mt][n2][2], acc[mt][n2][3]);
                *(LAS u32x2*)(ST + (32 * wave + 16 * n2 + cidx) * GQ_LD + 16 * mt + 4 * q) = wv; }
        __syncthreads();
    }
}

__device__ __forceinline__ void phase_gla_merge(const Args& a) {
    const int tid = threadIdx.x, lane = tid & 63, wave = tid >> 6;
    const int gw = blockIdx.x * 8 + wave, NGW = gridDim.x * 8;
    const bf16* OF = (const bf16*)(a.ws + WS_OF); const bf16* OB = (const bf16*)(a.ws + WS_OB);
    const bf16* P = (const bf16*)(a.ws + WS_P); bf16* Y = (bf16*)(a.ws + WS_YCAT); const float* gg = a.in[12];
    f32x4 gn[4];
#pragma unroll
    for (int j = 0; j < 4; ++j) gn[j] = *(const f32x4*)(gg + 256 * j + 4 * lane);
    for (int r0 = gw; r0 < NLAT; r0 += 2 * NGW) {
        u32x2 fa[2][4], fb[2][4], gw2[2][4];
#pragma unroll
        for (int u = 0; u < 2; ++u) { const int r = r0 + u * NGW; if (r < NLAT) {
#pragma unroll
            for (int j = 0; j < 4; ++j) { const int col = 256 * j + 4 * lane; fa[u][j] = *(const u32x2*)(OF + (size_t)r * 1024 + col); fb[u][j] = *(const u32x2*)(OB + (size_t)r * 1024 + col); gw2[u][j] = *(const u32x2*)(P + (size_t)r * PW + 2048 + col); } } }
#pragma unroll
        for (int u = 0; u < 2; ++u) { const int r = r0 + u * NGW; if (r < NLAT) {
#pragma unroll
            for (int j = 0; j < 4; ++j) {
                const int col = 256 * j + 4 * lane;
                f32x4 o; o.x = __uint_as_float(fa[u][j].x << 16) + __uint_as_float(fb[u][j].x << 16); o.y = __uint_as_float(fa[u][j].x & 0xffff0000u) + __uint_as_float(fb[u][j].x & 0xffff0000u);
                o.z = __uint_as_float(fa[u][j].y << 16) + __uint_as_float(fb[u][j].y << 16); o.w = __uint_as_float(fa[u][j].y & 0xffff0000u) + __uint_as_float(fb[u][j].y & 0xffff0000u);
                const float ss = wave_sum((o.x * o.x + o.y * o.y) + (o.z * o.z + o.w * o.w));
                const float rstd = rsqrtf(ss * (1.f / 256.f) + EPS);
                const float g0 = __uint_as_float(gw2[u][j].x << 16), g1 = __uint_as_float(gw2[u][j].x & 0xffff0000u), g2 = __uint_as_float(gw2[u][j].y << 16), g3 = __uint_as_float(gw2[u][j].y & 0xffff0000u);
                u32x2 w; w.x = pk2(o.x * rstd * gn[j].x * silu_f(g0), o.y * rstd * gn[j].y * silu_f(g1)); w.y = pk2(o.z * rstd * gn[j].z * silu_f(g2), o.w * rstd * gn[j].w * silu_f(g3));
                *(u32x2*)(Y + (size_t)r * DM + col) = w;
            } } }
    }
}

constexpr int FLD = 136;
__device__ __forceinline__ void load_dft_frags(const unsigned char* ws, int wave, int lane, bf16x8 (&fc)[4], bf16x8 (&fs)[4]) {
    const bf16* FC = (const bf16*)(ws + WS_FC); const bf16* FS = (const bf16*)(ws + WS_FS);
    const int k = 16 * wave + (lane & 15);
#pragma unroll
    for (int ks = 0; ks < 4; ++ks) { fc[ks] = *(const bf16x8*)(FC + k * 128 + ks * 32 + 8 * (lane >> 4)); fs[ks] = *(const bf16x8*)(FS + k * 128 + ks * 32 + 8 * (lane >> 4)); }
}
__device__ __forceinline__ void store_t4x8(LAS bf16* XT, int c0, int l0, const u32x4 (&x)[4]) {
#pragma unroll
    for (int i2 = 0; i2 < 4; ++i2) {
        const unsigned a0 = x[0][i2], a1 = x[1][i2], a2 = x[2][i2], a3 = x[3][i2];
        u32x2 lo, hi; lo.x = (a0 & 0xffffu) | (a1 << 16); lo.y = (a2 & 0xffffu) | (a3 << 16); hi.x = (a0 >> 16) | (a1 & 0xffff0000u); hi.y = (a2 >> 16) | (a3 & 0xffff0000u);
        const int sw = (((l0 >> 3) ^ ((c0 >> 3) & 7)) << 3) + (l0 & 7);
        *(LAS u32x2*)(XT + (c0 + 2 * i2) * FLD + sw) = lo; *(LAS u32x2*)(XT + (c0 + 2 * i2 + 1) * FLD + sw) = hi; }
}
__device__ __forceinline__ bf16x8 ldfrag_sw(const LAS bf16* XT, int row0, int kc, int lane) { const int row = row0 + (lane & 15); return *(const LAS bf16x8*)(XT + row * FLD + ((kc ^ ((row >> 3) & 7)) << 3)); }
__device__ __forceinline__ void phase_f1(const Args& a, LAS unsigned char* lds) {
    const int tid = threadIdx.x, lane = tid & 63, wave = __builtin_amdgcn_readfirstlane(tid >> 6), q = lane >> 4, cidx = lane & 15;
    const bf16* P = (const bf16*)(a.ws + WS_P); const f32x2* TW = (const f32x2*)(a.ws + WS_TW);
    bf16* A1r = (bf16*)(a.ws + WS_FA); bf16* A1i = (bf16*)(a.ws + WS_FAI);
    LAS bf16* XT = (LAS bf16*)lds;
    bf16x8 fc[4], fs[4]; load_dft_frags(a.ws, wave, lane, fc, fs);
    const int k1 = 16 * wave + cidx;
    u32x4 xp[2][4];
    auto f1_load = [&](int item) { const int cb = item & 3, l2 = (item >> 2) & 127, b = item >> 9, ch0 = cb * 256;
#pragma unroll
        for (int j = 0; j < 2; ++j) { const int task = tid + 512 * j, cblk = task & 31, lb = task >> 5;
#pragma unroll
            for (int r = 0; r < 4; ++r) xp[j][r] = *(const u32x4*)(P + ((size_t)b * SEQ + 128 * (4 * lb + r) + l2) * PW + 3072 + ch0 + 8 * cblk); } };
    if ((int)blockIdx.x < 1024) f1_load(blockIdx.x);
    for (int item = blockIdx.x; item < 1024; item += gridDim.x) {
        const int cb = item & 3, l2 = (item >> 2) & 127, b = item >> 9, ch0 = cb * 256;
#pragma unroll
        for (int j = 0; j < 2; ++j) { const int task = tid + 512 * j, cblk = task & 31, lb = task >> 5; store_t4x8(XT, 8 * cblk, 4 * lb, xp[j]); }
        if (item + (int)gridDim.x < 1024) f1_load(item + gridDim.x);
        __syncthreads();
        const f32x2 tw = TW[l2 * k1];
        LAS unsigned char* ost = lds + 69632 + wave * 8448;
        u32x2 wim[16];
#pragma unroll
        for (int mt = 0; mt < 16; ++mt) {
            f32x4 cr = {0.f, 0.f, 0.f, 0.f}, cs = {0.f, 0.f, 0.f, 0.f};
#pragma unroll
            for (int ks = 0; ks < 4; ++ks) { const bf16x8 xa = ldfrag_sw(XT, 16 * mt, 4 * ks + q, lane); cr = MFMA16(xa, fc[ks], cr); cs = MFMA16(xa, fs[ks], cs); }
            const f32x4 br = cr * tw.x - cs * tw.y, bi = -(cs * tw.x + cr * tw.y);
            u32x2 wr_; wr_.x = pk2(br[0], br[1]); wr_.y = pk2(br[2], br[3]); wim[mt].x = pk2(bi[0], bi[1]); wim[mt].y = pk2(bi[2], bi[3]);
            *(LAS u32x2*)(ost + cidx * 528 + (16 * mt + 4 * q) * 2) = wr_;
        }
        const size_t obase = (((size_t)b * 128 + 16 * wave) * 128 + l2) * 1024 + ch0;
#pragma unroll
        for (int i = 0; i < 8; ++i) { const int row = 2 * i + (lane >> 5), ck = lane & 31; const u32x4 v = *(const LAS u32x4*)(ost + row * 528 + ck * 16); *(u32x4*)(A1r + obase + (size_t)row * 128 * 1024 + 8 * ck) = v; }
#pragma unroll
        for (int mt = 0; mt < 16; ++mt) *(LAS u32x2*)(ost + cidx * 528 + (16 * mt + 4 * q) * 2) = wim[mt];
#pragma unroll
        for (int i = 0; i < 8; ++i) { const int row = 2 * i + (lane >> 5), ck = lane & 31; const u32x4 v = *(const LAS u32x4*)(ost + row * 528 + ck * 16); *(u32x4*)(A1i + obase + (size_t)row * 128 * 1024 + 8 * ck) = v; }
        __syncthreads();
    }
}
__device__ __forceinline__ void phase_f34(const Args& a, LAS unsigned char* lds) {
    const int tid = threadIdx.x, lane = tid & 63, wave = __builtin_amdgcn_readfirstlane(tid >> 6), q = lane >> 4, cidx = lane & 15;
    const bf16* A1r = (const bf16*)(a.ws + WS_FA); const bf16* A1i = (const bf16*)(a.ws + WS_FAI); bf16* Y = (bf16*)(a.ws + WS_YCAT);
    LAS bf16* XTr = (LAS bf16*)lds; LAS bf16* XTi = XTr + 128 * FLD; LAS bf16* XKr = XTi + 128 * FLD; LAS bf16* XKi = XKr + 128 * FLD;
    bf16x8 fc[4], fs[4]; load_dft_frags(a.ws, wave, lane, fc, fs);
    const float nrm = 1.0f / 1448.15468787005f;
    u32x4 xr[4], xi[4];
    auto f34_load = [&](int item) { const int g = item & 7, k1 = (item >> 3) & 127, b = item >> 10, ch0 = g * 128; const int cblk = tid & 15, lb = tid >> 4;
#pragma unroll
        for (int r = 0; r < 4; ++r) { const size_t off = (((size_t)b * 128 + k1) * 128 + 4 * lb + r) * 1024 + ch0 + 8 * cblk; xr[r] = *(const u32x4*)(A1r + off); xi[r] = *(const u32x4*)(A1i + off); } };
    if ((int)blockIdx.x < 2048) f34_load(blockIdx.x);
    for (int item = blockIdx.x; item < 2048; item += gridDim.x) {
        const int g = item & 7, k1 = (item >> 3) & 127, b = item >> 10, ch0 = g * 128;
        { const int cblk = tid & 15, lb = tid >> 4; store_t4x8(XTr, 8 * cblk, 4 * lb, xr); store_t4x8(XTi, 8 * cblk, 4 * lb, xi); }
        if (item + (int)gridDim.x < 2048) f34_load(item + gridDim.x);
        __syncthreads();
        const int k2 = 16 * wave + cidx;
#pragma unroll 2
        for (int mt = 0; mt < 8; ++mt) {
            f32x4 a1 = {0.f, 0.f, 0.f, 0.f}, a2 = a1, b1 = a1, b2 = a1;
#pragma unroll
            for (int ks = 0; ks < 4; ++ks) { const bf16x8 xa = ldfrag_sw(XTr, 16 * mt, 4 * ks + q, lane); const bf16x8 xb = ldfrag_sw(XTi, 16 * mt, 4 * ks + q, lane);
                a1 = MFMA16(xa, fc[ks], a1); b2 = MFMA16(xa, fs[ks], b2); a2 = MFMA16(xb, fs[ks], a2); b1 = MFMA16(xb, fc[ks], b1); }
            const f32x4 xre = a1 + a2, xim = b1 - b2;
            u32x2 wr_; wr_.x = pk2(xre[0], xre[1]); wr_.y = pk2(xre[2], xre[3]); u32x2 wi_; wi_.x = pk2(xim[0], xim[1]); wi_.y = pk2(xim[2], xim[3]);
            *(LAS u32x2*)(XKr + k2 * FLD + 16 * mt + 4 * q) = wr_; *(LAS u32x2*)(XKi + k2 * FLD + 16 * mt + 4 * q) = wi_;
        }
        __syncthreads();
#pragma unroll 2
        for (int nt = 0; nt < 8; ++nt) {
            f32x4 y = {0.f, 0.f, 0.f, 0.f};
#pragma unroll
            for (int ks = 0; ks < 4; ++ks) { const bf16x8 xa = *(const LAS bf16x8*)(XKr + (16 * nt + cidx) * FLD + ks * 32 + 8 * q); const bf16x8 xb = *(const LAS bf16x8*)(XKi + (16 * nt + cidx) * FLD + ks * 32 + 8 * q);
                y = MFMA16(fc[ks], xa, y); y = MFMA16(fs[ks], xb, y); }
            u32x2 w; w.x = pk2(y[0] * nrm, y[1] * nrm); w.y = pk2(y[2] * nrm, y[3] * nrm);
            *(LAS u32x2*)(XTr + (16 * nt + cidx) * FLD + 16 * wave + 4 * q) = w;
        }
        __syncthreads();
#pragma unroll
        for (int i = 0; i < 4; ++i) { const int task = tid + 512 * i, row = task >> 4, ck = task & 15; const u32x4 v = *(const LAS u32x4*)(XTr + row * FLD + 8 * ck);
            *(u32x4*)(Y + ((size_t)b * SEQ + k1 + 128 * row) * DM + 1024 + ch0 + 8 * ck) = v; }
        __syncthreads();
    }
}

__device__ __forceinline__ void phase_topk(const Args& a, LAS unsigned char* lds) {
    const int tid = threadIdx.x;
    LAS unsigned* keys = (LAS unsigned*)lds;
    LAS unsigned* hist = (LAS unsigned*)(lds + 65536);
    LAS unsigned* misc = hist + 256;
    LAS unsigned* sg = misc + 16;
    LAS unsigned* se = sg + 512;
    const float* AFF = (const float*)(a.ws + WS_AFF); int* TOK = (int*)(a.ws + WS_TOK); float* GATE = (float*)(a.ws + WS_GATE); int* SEL = (int*)(a.ws + WS_SEL);
    for (int be = blockIdx.x; be < NB * NE; be += gridDim.x) {
        const int b = be / NE, e = be % NE;
        for (int i = tid; i < SEQ; i += NTHREADS) keys[i] = __float_as_uint(AFF[(size_t)be * SEQ + i]);
        unsigned prefix = 0u, pmask = 0u, krem = CAP;
        for (int pass = 0; pass < 4; ++pass) {
            const int shift = 24 - 8 * pass;
            if (tid < 256) hist[tid] = 0u;
            __syncthreads();
            for (int i = tid; i < SEQ; i += NTHREADS) { const unsigned k = keys[i]; if ((k & pmask) == prefix) atomicAdd((unsigned*)&hist[(k >> shift) & 255u], 1u); }
            __syncthreads();
            if (tid == 0) { unsigned cum = 0u; int bsel = 0;
                for (int bk = 255; bk >= 0; --bk) { const unsigned c = hist[bk]; if (cum + c >= krem) { bsel = bk; break; } cum += c; }
                misc[0] = prefix | ((unsigned)bsel << shift); misc[1] = krem - cum; }
            __syncthreads();
            prefix = misc[0]; krem = misc[1]; pmask |= (0xffu << shift);
            __syncthreads();
        }
        const unsigned T = prefix;
        unsigned cg_ = 0u, ce = 0u;
        for (int i = 0; i < 32; ++i) { const unsigned k = keys[tid * 32 + i]; cg_ += (k > T); ce += (k == T); }
        sg[tid] = cg_; se[tid] = ce;
        __syncthreads();
        if (tid == 0) { unsigned rg = 0u, re = 0u; for (int i = 0; i < NTHREADS; ++i) { const unsigned x = sg[i], y = se[i]; sg[i] = rg; se[i] = re; rg += x; re += y; } }
        __syncthreads();
        unsigned gt_before = sg[tid], eq_before = se[tid];
        for (int i = 0; i < 32; ++i) { const int t = tid * 32 + i; const unsigned k = keys[t];
            const bool isgt = k > T, iseq = k == T; const bool take = isgt || (iseq && eq_before < krem);
            const unsigned slot = gt_before + (eq_before < krem ? eq_before : krem);
            if (take) { TOK[(size_t)be * CAP + slot] = t; GATE[(size_t)be * CAP + slot] = __uint_as_float(k); }
            SEL[((size_t)b * SEQ + t) * NE + e] = take ? (int)slot : -1;
            gt_before += isgt; eq_before += iseq; }
        __syncthreads();
    }
}

__device__ __forceinline__ void acc_yrow(f32x4 (&m)[8], const u32x2 (&w)[8], float gt) {
#pragma unroll
    for (int j = 0; j < 8; ++j) { m[j].x += gt * __uint_as_float(w[j].x << 16); m[j].y += gt * __uint_as_float(w[j].x & 0xffff0000u); m[j].z += gt * __uint_as_float(w[j].y << 16); m[j].w += gt * __uint_as_float(w[j].y & 0xffff0000u); }
}
__device__ __forceinline__ void phase_final(const Args& a) {
    const int tid = threadIdx.x, lane = tid & 63, wave = tid >> 6;
    const int gw = blockIdx.x * 8 + wave, NGW = gridDim.x * 8;
    const float* ada = (const float*)(a.ws + WS_ADA); const float* fg = a.in[19];
    const float* X = a.in[0]; const bf16* DL = (const bf16*)(a.ws + WS_DLT); const bf16* YE = (const bf16*)(a.ws + WS_YE);
    const float* GATE = (const float*)(a.ws + WS_GATE); const int* SEL = (const int*)(a.ws + WS_SEL);
    int r = gw;
    int sel = -1; if (r < NLAT && lane < NE) sel = SEL[(size_t)r * NE + lane];
    for (; r < NLAT; r += NGW) {
        const int b = r / SEQ;
        const float* g2 = ada + (size_t)b * 12288 + 5 * DM;
        u32x2 dl[8];
#pragma unroll
        for (int j = 0; j < 8; ++j) dl[j] = *(const u32x2*)(DL + (size_t)r * DM + 256 * j + 4 * lane);
        const float gt = sel >= 0 ? GATE[((size_t)b * NE + lane) * CAP + sel] : 0.f;
        const int myrow = sel >= 0 ? (lane * 2 + b) * CAP + sel : 0;
        unsigned long long mask = __ballot(sel >= 0);
        { const int rn = r + NGW; sel = -1; if (rn < NLAT && lane < NE) sel = SEL[(size_t)rn * NE + lane]; }
        f32x4 m[8];
#pragma unroll
        for (int j = 0; j < 8; ++j) m[j] = (f32x4){0.f, 0.f, 0.f, 0.f};
        while (mask) {
            const int e0 = __builtin_ctzll(mask); mask &= mask - 1;
            const int has1 = mask != 0ull; const int e1 = has1 ? __builtin_ctzll(mask) : e0; if (has1) mask &= mask - 1;
            const int row0 = __builtin_amdgcn_readlane(myrow, e0), row1 = __builtin_amdgcn_readlane(myrow, e1);
            const float g0 = __builtin_bit_cast(float, __builtin_amdgcn_readlane(__builtin_bit_cast(int, gt), e0));
            const float g1 = has1 ? __builtin_bit_cast(float, __builtin_amdgcn_readlane(__builtin_bit_cast(int, gt), e1)) : 0.f;
            const bf16* y0 = YE + (size_t)row0 * DM + 4 * lane; const bf16* y1 = YE + (size_t)row1 * DM + 4 * lane;
            u32x2 w0[8], w1[8];
#pragma unroll
            for (int j = 0; j < 8; ++j) { w0[j] = *(const u32x2*)(y0 + 256 * j); w1[j] = *(const u32x2*)(y1 + 256 * j); }
            acc_yrow(m, w0, g0); acc_yrow(m, w1, g1);
        }
        float ss = 0.f;
#pragma unroll
        for (int j = 0; j < 8; ++j) { const int d = 256 * j + 4 * lane; const f32x4 gv = *(const f32x4*)(g2 + d);
            const f32x4 dv = {__uint_as_float(dl[j].x << 16), __uint_as_float(dl[j].x & 0xffff0000u), __uint_as_float(dl[j].y << 16), __uint_as_float(dl[j].y & 0xffff0000u)};
            m[j] = dv + gv * m[j]; ss += (m[j].x * m[j].x + m[j].y * m[j].y) + (m[j].z * m[j].z + m[j].w * m[j].w); }
        const float rstd = rsqrtf(wave_sum(ss) * (1.f / DM) + EPS);
#pragma unroll
        for (int j = 0; j < 8; ++j) { const int d = 256 * j + 4 * lane; const f32x4 gv = *(const f32x4*)(fg + d);
            *(f32x4*)(a.out + (size_t)r * DM + d) = m[j] * rstd * gv; }
    }
}

#define XB_TMO      128
#define XB_XCNT(j)  (256  + 64 * (j))
#define XB_XSUB(j)  (1280 + 64 * (j))
#define XB_XGEN(j)  (2304 + 64 * (j))
#define XB_TOP      3328
#define XB_TOPGEN   3392
#define XCD_BAR_WORDS 3456
#define XB_SPIN_CAP (1u << 18)
__device__ __forceinline__ unsigned xb_ld(unsigned* p)              { return __hip_atomic_load(p, __ATOMIC_RELAXED, __HIP_MEMORY_SCOPE_AGENT); }
__device__ __forceinline__ unsigned xb_add(unsigned* p, unsigned v) { return __hip_atomic_fetch_add(p, v, __ATOMIC_RELAXED, __HIP_MEMORY_SCOPE_AGENT); }
__device__ __forceinline__ unsigned xb_xcc_id() { return (unsigned)__builtin_amdgcn_s_getreg((3 << 11) | 20) & 0xFu; }
#define XB_SPIN(cond, bar) do { unsigned _sp = 0; while (cond) { __builtin_amdgcn_s_sleep(1); \
    if ((++_sp & 255u) == 0u) { if (xb_ld(&(bar)[XB_TMO])) break; if (_sp > XB_SPIN_CAP) { atomicAdd(&(bar)[XB_TMO], 1u); break; } } } } while (0)
struct XcdBarrier { unsigned* bar; unsigned x; volatile LAS unsigned* st; };
__device__ __forceinline__ XcdBarrier xcd_barrier_post(unsigned* bar, volatile LAS unsigned* st) {
    XcdBarrier b; b.bar = bar; b.x = xb_xcc_id(); b.st = st;
    if (threadIdx.x == 0) (void)xb_add(&bar[XB_XCNT(b.x)], 1u);
    return b;
}
__device__ __forceinline__ void xcd_barrier_complete(unsigned* bar, unsigned x, unsigned& nloc, unsigned& nx) {
    const unsigned G = gridDim.x * gridDim.y * gridDim.z;
    unsigned sum, cnt, mine, sp = 0u;
    for (;;) {
        sum = 0u; cnt = 0u; mine = 0u;
#pragma unroll
        for (unsigned j = 0; j < 16; ++j) { const unsigned c = xb_ld(&bar[XB_XCNT(j)]); sum += c; cnt += (c > 0u) ? 1u : 0u; mine = (j == x) ? c : mine; }
        if (sum == G) break;
        __builtin_amdgcn_s_sleep(1);
        if ((++sp & 255u) == 0u) { if (xb_ld(&bar[XB_TMO])) break; if (sp > XB_SPIN_CAP) { atomicAdd(&bar[XB_TMO], 1u); break; } }
    }
    nloc = mine > 0u ? mine : 1u; nx = cnt > 0u ? cnt : 1u;
}
__device__ __forceinline__ void xcd_barrier(const XcdBarrier& b) {
    asm volatile("s_waitcnt vmcnt(0)" ::: "memory");
    __syncthreads();
    if (threadIdx.x == 0) {
        unsigned* bar = b.bar;
        __builtin_amdgcn_s_waitcnt(0);
        unsigned nloc = b.st[0], nx = b.st[1];
        if (nloc == 0u) { xcd_barrier_complete(bar, b.x, nloc, nx); b.st[0] = nloc; b.st[1] = nx; }
        const unsigned old = xb_add(&bar[XB_XSUB(b.x)], 1u);
        const unsigned gen = old / nloc;
        if (old + 1u == (gen + 1u) * nloc) {
            __builtin_amdgcn_fence(__ATOMIC_RELEASE, "agent");
            asm volatile("s_waitcnt vmcnt(0)" ::: "memory");
            const unsigned og = xb_add(&bar[XB_TOP], 1u);
            const unsigned tg = og / nx;
            if (og + 1u == (tg + 1u) * nx) xb_add(&bar[XB_TOPGEN], 1u);
            else XB_SPIN(xb_ld(&bar[XB_TOPGEN]) == tg, bar);
            __builtin_amdgcn_fence(__ATOMIC_ACQUIRE, "agent");
            xb_add(&bar[XB_XGEN(b.x)], 1u);
            asm volatile("s_waitcnt vmcnt(0)" ::: "memory");
        } else {
            XB_SPIN(xb_ld(&bar[XB_XGEN(b.x)]) == gen, bar);
            __builtin_amdgcn_fence(__ATOMIC_ACQUIRE, "agent");
            asm volatile("s_waitcnt vmcnt(0)" ::: "memory");
        }
    }
    __syncthreads();
}

constexpr int NPHASES = 15;
__global__ void __launch_bounds__(NTHREADS, 2) mega(Args a) {
    extern __shared__ __attribute__((aligned(16))) unsigned char lds_raw[];
    LAS unsigned char* lds = (LAS unsigned char*)lds_raw;
    const int lo = a.ph_lo, hi = a.ph_hi;
    unsigned char* ws = a.ws;
#if USE_CG_SYNC
    cg::grid_group grid = cg::this_grid();
#define GRID_SYNC() grid.sync()
#else
    volatile LAS unsigned* bst = (volatile LAS unsigned*)(lds + LDS_BYTES - 16);
    if (threadIdx.x < 2) bst[threadIdx.x] = 0u;
    __syncthreads();
    XcdBarrier xbar = xcd_barrier_post((unsigned*)(ws + WS_CTL), bst);
#define GRID_SYNC() xcd_barrier(xbar)
#endif
#define IN(k) (lo <= (k) && (k) < hi)
#define SEAM(k) do { if (IN(k) && IN((k) + 1)) GRID_SYNC(); } while (0)
#define PH(k, ...) do { if (IN(k)) { __VA_ARGS__; if ((PROBE_MASK >> (k)) & 1u) { GRID_SYNC(); __VA_ARGS__; } } SEAM(k); } while (0)
    PH(0, phase0(a, lds));
    PH(1, {
        finalize_ada(a);
        const int nsp = gridDim.x >= 64 ? 12 : 0, nreg = gridDim.x - nsp;
        if ((int)blockIdx.x >= nreg) {
            const int si = blockIdx.x - nreg, b = si / 6, pn = 2 + si % 6;
            if (threadIdx.x < 64) { unsigned* cnt = (unsigned*)(ws + WS_CTL) + CW_CTXCNT + 64 * b; unsigned sp = 0;
                while ((unsigned)__builtin_amdgcn_readfirstlane(__hip_atomic_load(cnt, __ATOMIC_RELAXED, __HIP_MEMORY_SCOPE_AGENT)) < 16u) { __builtin_amdgcn_s_sleep(4); if (++sp > (1u << 22)) break; }
                __builtin_amdgcn_fence(__ATOMIC_ACQUIRE, "agent");
                asm volatile("s_waitcnt vmcnt(0)" ::: "memory"); }
            __syncthreads();
            SchedOne S; S.A = (const char*)(ws + WS_H); S.B = (const char*)(ws + WS_WIN); S.tstep = (size_t)256 * DM * 2; S.pm = NLAT / 256 + b; S.pn = pn;
            EpiInProj E{(bf16*)(ws + WS_P)};
            pg8::gemm_phase<EpiInProj, SchedOne, false, true, true>(lds, DM, S, E);
        } else phase_norm_tile<0>(a, lds, blockIdx.x, nreg, NROWS / 16); });
    PH(2, {
        SchedPlain S; S.init((gridDim.x >= 64 ? NLAT : NROWS) / 256, WIN_ROWS / 256, gridDim.x, blockIdx.x); S.A = (const char*)(ws + WS_H); S.B = (const char*)(ws + WS_WIN); S.tstep = (size_t)256 * DM * 2;
        EpiInProj E{(bf16*)(ws + WS_P)};
        pg8::gemm_phase<EpiInProj, SchedPlain, false, true, true>(lds, DM, S, E); });
    PH(3, { for (int it = blockIdx.x; it < 272; it += gridDim.x) gla_passA(a, lds, it); });
    PH(4, gla_passB(a));
    PH(5, { for (int it = blockIdx.x; it < 256; it += gridDim.x) gla_passC(a, lds, it); });
    PH(6, phase_gla_merge(a));
    PH(7, phase_f1(a, lds));
    PH(8, phase_f34(a, lds));
    PH(9, {
        SchedPlain S; S.init(NLAT / 256, DM / 256, gridDim.x, blockIdx.x); S.A = (const char*)(ws + WS_YCAT); S.B = (const char*)(ws + WS_WOUT); S.tstep = (size_t)256 * DM * 2;
        EpiOutProj E{a.in[0], (bf16*)(ws + WS_DLT), (const float*)(ws + WS_ADA)};
        pg8::gemm_phase<EpiOutProj, SchedPlain, false, true, true>(lds, DM, S, E); });
    PH(10, phase_norm_tile<1>(a, lds, blockIdx.x, gridDim.x, NLAT / 16));
    PH(11, phase_topk(a, lds));
    PH(12, {
        SchedMoeUp S; S.init(256, 8, gridDim.x, blockIdx.x); S.A = (const char*)(ws + WS_HF); S.B = (const char*)(ws + WS_WGU); S.tok = (const int*)(ws + WS_TOK);
        EpiSwiglu E{(bf16*)(ws + WS_HID)};
        pg8::gemm_phase<EpiSwiglu, SchedMoeUp, true, true, true>(lds, DM, S, E); });
    PH(13, {
        SchedMoeDown S; S.init(256, 8, gridDim.x, blockIdx.x); S.A = (const char*)(ws + WS_HID); S.B = (const char*)(ws + WS_WD);
        EpiBf16 E{(bf16*)(ws + WS_YE), DM};
        pg8::gemm_phase<EpiBf16, SchedMoeDown, false, true, true>(lds, DEXP, S, E); });
    PH(14, phase_final(a));
#undef PH
#undef IN
#undef SEAM
}

#ifndef N_LAUNCH_MODE
#define N_LAUNCH_MODE 1
#endif
extern "C" void kernel_launch(void* const* d_in, const int* in_sizes, int n_in, void* d_out, int out_size, void* d_ws, size_t ws_size, hipStream_t stream) {
    static int grid = 0;
    if (grid == 0) {
        if (n_in != 20 || out_size != NLAT * DM || ws_size < WS_END) { fprintf(stderr, "kernel_launch: unexpected sizes n_in %d out %d ws %zu\n", n_in, out_size, ws_size); grid = -1; return; }
        int dev = 0, cus = 0, per_cu = 0;
        (void)hipGetDevice(&dev); (void)hipDeviceGetAttribute(&cus, hipDeviceAttributeMultiprocessorCount, dev);
        if (hipFuncSetAttribute((const void*)mega, hipFuncAttributeMaxDynamicSharedMemorySize, LDS_BYTES) != hipSuccess) { fprintf(stderr, "kernel_launch: hipFuncSetAttribute failed\n"); grid = -1; return; }
        (void)hipOccupancyMaxActiveBlocksPerMultiprocessor(&per_cu, (const void*)mega, NTHREADS, LDS_BYTES);
        if (per_cu < 1) { fprintf(stderr, "kernel_launch: occupancy query reports %d blocks per CU\n", per_cu); per_cu = 1; }
        (void)hipGetLastError();
        grid = cus * 1;
    }
    if (grid < 0) return;
    Args a{};
    for (int i = 0; i < 20; ++i) a.in[i] = (const float*)d_in[i];
    a.out = (float*)d_out; a.ws = (unsigned char*)d_ws;
#if N_LAUNCH_MODE == 0
    for (int p = 0; p < NPHASES; ++p) { a.ph_lo = p; a.ph_hi = p + 1; hipLaunchKernelGGL(mega, dim3(grid), dim3(NTHREADS), LDS_BYTES, stream, a); }
#else
    a.ph_lo = 0; a.ph_hi = NPHASES;
#if USE_CG_SYNC
    void* args[] = {&a};
    hipError_t e = hipLaunchCooperativeKernel((void*)mega, dim3(grid), dim3(NTHREADS), args, LDS_BYTES, stream);
    if (e != hipSuccess) fprintf(stderr, "cooperative launch failed: %s (grid %d)\n", hipGetErrorString(e), grid);
#else
    if (hipMemsetAsync((char*)d_ws + WS_CTL, 0, CTL_BYTES, stream) != hipSuccess) { fprintf(stderr, "kernel_launch: memset of control words failed\n"); return; }
    hipLaunchKernelGGL(mega, dim3(grid), dim3(NTHREADS), LDS_BYTES, stream, a);
#endif
#endif
}
```

```cpp
#include <hip/hip_runtime.h>
#include <hip/hip_cooperative_groups.h>
#include <cstdio>
#include <cstdint>
namespace cg = cooperative_groups;

#define LAS __attribute__((address_space(3)))
typedef unsigned short bf16;
typedef short bf16x8 __attribute__((ext_vector_type(8)));
typedef float f32x4 __attribute__((ext_vector_type(4)));
typedef float f32x2 __attribute__((ext_vector_type(2)));
typedef unsigned u32x4 __attribute__((ext_vector_type(4)));
typedef unsigned u32x2 __attribute__((ext_vector_type(2)));

constexpr int NB = 2, SEQ = 16384, DM = 2048, CTXL = 256;
constexpr int NLAT = NB * SEQ;
constexpr int NROWS = NLAT + NB * CTXL;
constexpr int PROJW = 4128;
constexpr int NE = 16, CAP = 2048, DEXP = 1024;
constexpr int PW = 4096;
constexpr int WIN_ROWS = 4096;
constexpr float EPS = 1e-6f;

constexpr size_t MiB = 1u << 20;
constexpr size_t WS_ADA = 0;
constexpr size_t WS_TW = 1 * MiB;
constexpr size_t WS_FC = 1 * MiB + 256 * 1024;
constexpr size_t WS_FS = 1 * MiB + 320 * 1024;
constexpr size_t WS_WRH = 1 * MiB + 384 * 1024;
constexpr size_t WS_WRL = 1 * MiB + 448 * 1024;
constexpr size_t WS_Z = 2 * MiB;
constexpr size_t WS_AFF = 8 * MiB;
constexpr size_t WS_TOK = 10 * MiB;
constexpr size_t WS_GATE = 11 * MiB;
constexpr size_t WS_SEL = 12 * MiB;
constexpr size_t WS_ST0 = 14 * MiB;
constexpr size_t WS_CTL = 16 * MiB;
constexpr size_t CTL_BYTES = 65536;
constexpr size_t WS_ADAP = 20 * MiB;
constexpr size_t WS_WIN = 32 * MiB;
constexpr size_t WS_WOUT = 50 * MiB;
constexpr size_t WS_WGU = 58 * MiB;
constexpr size_t WS_WD = 186 * MiB;
constexpr size_t WS_P = 250 * MiB;
constexpr size_t WS_HF = 250 * MiB;
constexpr size_t WS_HID = 378 * MiB;
constexpr size_t WS_FX = 250 * MiB;
constexpr size_t WS_FA = 510 * MiB;
constexpr size_t WS_FAI = 574 * MiB;
constexpr size_t WS_H = 510 * MiB;
constexpr size_t WS_OF = 510 * MiB;
constexpr size_t WS_OB = 574 * MiB;
constexpr size_t WS_T = 638 * MiB;
constexpr size_t WS_SST = 670 * MiB;
constexpr size_t WS_DT = 702 * MiB;
constexpr size_t WS_DLT = 510 * MiB;
constexpr size_t WS_YCAT = 766 * MiB;
constexpr size_t WS_YE = 766 * MiB;
constexpr size_t WS_END = 1022 * MiB;

#ifndef USE_CG_SYNC
#define USE_CG_SYNC 0
#endif
#ifndef KSNAKE
#define KSNAKE 0
#endif
#ifndef PROBE_K
#define PROBE_K 0
#endif
#ifndef PROBE_EPI
#define PROBE_EPI 0
#endif
#ifndef PROBE_P0
#define PROBE_P0 0
#endif
#ifndef PROBE_MASK
#define PROBE_MASK 0u
#endif
constexpr int LDS_BYTES = 163840;
constexpr int NTHREADS = 512;

struct Args {
    const float* in[20];
    float* out;
    unsigned char* ws;
    int ph_lo, ph_hi;
};

__device__ __forceinline__ float bf2f(bf16 v) { return __uint_as_float(((unsigned)v) << 16); }
typedef __bf16 bf16x2_t __attribute__((ext_vector_type(2)));
__device__ __forceinline__ unsigned pk2(float lo, float hi) { const f32x2 v = {lo, hi}; return __builtin_bit_cast(unsigned, __builtin_convertvector(v, bf16x2_t)); }
__device__ __forceinline__ unsigned f2bf(float f) { return pk2(f, 0.f) & 0xffffu; }
__device__ __forceinline__ float wave_sum(float v) {
#pragma unroll
    for (int o = 1; o < 64; o <<= 1) v += __shfl_xor(v, o);
    return v;
}
__device__ __forceinline__ float silu_f(float x) { return x / (1.f + __expf(-x)); }
__device__ __forceinline__ float logsigmoid_f(float x) { return fminf(x, 0.f) - log1pf(expf(-fabsf(x))); }

namespace pg8 {
constexpr int BM = 256, BK = 64, HALF = 128, HTB = HALF * BK * 2, STAGE_BYTES = 8 * HTB, NXCD = 8, WGM = 8;
__host__ __device__ __forceinline__ int lds_byte(int r, int c) { const int st = (r >> 4) * 2 + (c >> 5), rr = r & 15, cc = c & 31, ob = rr * 64 + cc * 2; return st * 1024 + (ob ^ (((ob >> 9) & 1) << 5)); }
__host__ __device__ __forceinline__ void stage_rc(int b, int& R, int& C) { const int st = b / 1024, sb = b % 1024, swz = sb ^ (((sb >> 9) & 1) << 5); R = (st >> 1) * 16 + swz / 64; C = (st & 1) * 32 + (swz % 64) / 2; }
__host__ __device__ __forceinline__ int perm32(int rho) { const int n = rho >> 4, i = rho & 15; return 8 * (i >> 2) + 4 * n + (i & 3); }
struct Unit { int pm, pn; };
__device__ __forceinline__ unsigned cvt_pk_bf16(float lo, float hi) { return pk2(lo, hi); }

struct OrderBase {
    int nM, nN, nwg, G, c;
    __device__ void init(int nM_, int nN_, int G_, int c_) { nM = nM_; nN = nN_; nwg = nM * nN; G = G_; c = c_; }
    __device__ bool next(int i, Unit& u) const {
        const long L = (long)(i >> PROBE_K) * G + c; if (L >= nwg) return false;
        int wgid = (int)L; { const int q = nwg / NXCD, r = nwg % NXCD, xcd = wgid % NXCD, off = wgid / NXCD; wgid = (xcd < r ? xcd * (q + 1) : r * (q + 1) + (xcd - r) * q) + off; }
        const int nig = WGM * nN, gid = wgid / nig, fm = gid * WGM, gsz = (nM - fm) < WGM ? (nM - fm) : WGM;
        u.pm = fm + ((wgid % nig) % gsz); u.pn = (wgid % nig) / gsz; return true;
    }
};

template <class Epi, class Sched, bool GATHER, bool ALIGN_EPI, bool SP2>
__device__ __forceinline__ void gemm_phase(LAS unsigned char* lds, const int K, const Sched& S, const Epi& E) {
    const int tid = threadIdx.x, wid = __builtin_amdgcn_readfirstlane(tid >> 6), lane = tid & 63, wr = wid >> 2, wc = wid & 3, fr = lane & 15, fq = lane >> 4;
    const int nt = K / BK;
    unsigned voffA[2], voffA1[2], voffB[2];
    int RA[2], CA[2];
#pragma unroll
    for (int i = 0; i < 2; ++i) { int R, C; stage_rc(tid * 16 + i * 8192, R, C); const int Rb = Epi::PERM ? ((R & ~31) + perm32(R & 31)) : R;
        RA[i] = R; CA[i] = C;
        voffA[i] = (unsigned)(R * K + C) * 2u; voffA1[i] = voffA[i]; voffB[i] = (unsigned)(Rb * K + C) * 2u; }
    const size_t kstep = (size_t)(BK * 2);
    const size_t hstep = (size_t)HALF * K * 2;
    const size_t hstepA = GATHER ? 0 : hstep;
    const unsigned ldsw = (unsigned)wid * 1024u;
    const int aoff = lds_byte(wr * 64 + fr, fq * 8), boff = lds_byte(wc * 32 + fr, fq * 8);
#define PG8_SA(b, h) (((b) * 2 + (h)) * HTB)
#define PG8_SB(b, h) ((4 + (b) * 2 + (h)) * HTB)
#define PG8_STAGE(bufoff, gbase, voff) do { _Pragma("unroll") for (int _i = 0; _i < 2; ++_i) \
        __builtin_amdgcn_global_load_lds((const unsigned*)((const char*)(gbase) + (voff)[_i]), (LAS unsigned*)(lds + (bufoff) + ldsw + _i * 8192), 16, 0, 0); } while (0)
#define PG8_LDA(dst, b, h) do { _Pragma("unroll") for (int m = 0; m < 4; ++m) _Pragma("unroll") for (int k = 0; k < 2; ++k) dst[m][k] = *(const LAS bf16x8*)(lds + PG8_SA(b, h) + aoff + m * 2048 + k * 1024); } while (0)
#define PG8_LDB(dst, b, h) do { _Pragma("unroll") for (int n = 0; n < 2; ++n) _Pragma("unroll") for (int k = 0; k < 2; ++k) dst[n][k] = *(const LAS bf16x8*)(lds + PG8_SB(b, h) + boff + n * 2048 + k * 1024); } while (0)
#define PG8_MMA(ai, bj, At, Bt) do { __builtin_amdgcn_s_setprio(1); _Pragma("unroll") for (int m = 0; m < 4; ++m) _Pragma("unroll") for (int n = 0; n < 2; ++n) _Pragma("unroll") for (int k = 0; k < 2; ++k) \
        acc[ai][bj][m][n] = __builtin_amdgcn_mfma_f32_16x16x32_bf16(Bt[n][k], At[m][k], acc[ai][bj][m][n], 0, 0, 0); __builtin_amdgcn_s_setprio(0); } while (0)
#define PG8_WAIT_V(n) asm volatile("s_waitcnt vmcnt(" #n ")" ::: "memory")
#define PG8_WAIT_L(n) asm volatile("s_waitcnt lgkmcnt(" #n ")" ::: "memory")
#define PG8_BAR __builtin_amdgcn_s_barrier()
#define PG8_SCHED __builtin_amdgcn_sched_barrier(0)
    Unit cur, nxt; int ui = 0;
    if (!S.next(0, cur)) return;
    f32x4 acc[2][2][4][2];
#pragma unroll
    for (int a = 0; a < 2; ++a)
#pragma unroll
        for (int b = 0; b < 2; ++b)
#pragma unroll
            for (int m = 0; m < 4; ++m)
#pragma unroll
                for (int n = 0; n < 2; ++n) acc[a][b][m][n] = (f32x4){0.f, 0.f, 0.f, 0.f};
    bf16x8 At[4][2], B0[2][2], B1[2][2];
    const long kspan = (long)(nt - 1) * (long)(BK * 2);
    long ck = (long)(BK * 2);
    const char* cA = S.abase(cur); const char* cB = S.bbase(cur);
    if constexpr (GATHER) {
#pragma unroll
        for (int i = 0; i < 2; ++i) { voffA[i] = ((unsigned)S.arow(cur, RA[i]) * (unsigned)K + (unsigned)CA[i]) * 2u; voffA1[i] = ((unsigned)S.arow(cur, HALF + RA[i]) * (unsigned)K + (unsigned)CA[i]) * 2u; }
    }
    static_assert(SP2, "only the SP2 loop is kept");
    PG8_STAGE(PG8_SB(0, 0), cB, voffB); PG8_STAGE(PG8_SB(0, 1), cB + hstep, voffB); PG8_STAGE(PG8_SA(0, 0), cA, voffA); PG8_STAGE(PG8_SA(0, 1), cA + hstepA, voffA1);
    if (wr == 1) PG8_BAR;
    PG8_WAIT_V(2); PG8_BAR;
    PG8_STAGE(PG8_SB(1, 0), cB + kstep, voffB); PG8_STAGE(PG8_SA(1, 0), cA + kstep, voffA); PG8_STAGE(PG8_SB(1, 1), cB + hstep + kstep, voffB);
    PG8_WAIT_V(6); PG8_BAR;
    for (;;) {
        const bool has_next = S.next(ui + 1, nxt);
        const bool nrev = KSNAKE && has_next && (((ui + 1) >> PROBE_K) & 1);
        const long nk = has_next ? (nrev ? -(long)(BK * 2) : (long)(BK * 2)) : ck;
        const char* nA = has_next ? S.abase(nxt) + (nrev ? kspan : 0) : cA; const char* nB = has_next ? S.bbase(nxt) + (nrev ? kspan : 0) : cB;
        for (int t = 0; t < nt; t += 2) {
            const bool last = (t == nt - 2);
            const char* a1 = cA + (long)(t + 1) * ck;
            const char* a2 = last ? nA : cA + (long)(t + 2) * ck; const char* b2 = last ? nB : cB + (long)(t + 2) * ck;
            const char* a3 = a2 + (last ? nk : ck); const char* b3 = b2 + (last ? nk : ck);
            PG8_LDB(B0, 0, 0); PG8_LDB(B1, 0, 1); PG8_SCHED; PG8_LDA(At, 0, 0); PG8_STAGE(PG8_SA(1, 1), a1 + hstepA, voffA1);
            if constexpr (GATHER) { if (last && has_next) {
#pragma unroll
                for (int i = 0; i < 2; ++i) { voffA[i] = ((unsigned)S.arow(nxt, RA[i]) * (unsigned)K + (unsigned)CA[i]) * 2u; voffA1[i] = ((unsigned)S.arow(nxt, HALF + RA[i]) * (unsigned)K + (unsigned)CA[i]) * 2u; } } }
            PG8_WAIT_V(8); PG8_WAIT_L(0); PG8_BAR; PG8_MMA(0, 0, At, B0); PG8_MMA(0, 1, At, B1); PG8_BAR; PG8_SCHED;
            PG8_LDA(At, 0, 1); PG8_STAGE(PG8_SB(0, 0), b2, voffB); PG8_STAGE(PG8_SB(0, 1), b2 + hstep, voffB); PG8_STAGE(PG8_SA(0, 0), a2, voffA);
            PG8_WAIT_V(8); PG8_WAIT_L(0); PG8_BAR; PG8_MMA(1, 0, At, B0); PG8_MMA(1, 1, At, B1); PG8_BAR; PG8_SCHED;
            PG8_LDB(B0, 1, 0); PG8_LDB(B1, 1, 1); PG8_SCHED; PG8_LDA(At, 1, 0); PG8_STAGE(PG8_SA(0, 1), a2 + hstepA, voffA1);
            PG8_WAIT_V(8); PG8_WAIT_L(0); PG8_BAR; PG8_MMA(0, 0, At, B0); PG8_MMA(0, 1, At, B1); PG8_BAR; PG8_SCHED;
            PG8_LDA(At, 1, 1); PG8_STAGE(PG8_SB(1, 0), b3, voffB); PG8_STAGE(PG8_SB(1, 1), b3 + hstep, voffB); PG8_STAGE(PG8_SA(1, 0), a3, voffA);
            PG8_WAIT_V(8); PG8_WAIT_L(0); PG8_BAR; PG8_MMA(1, 0, At, B0); PG8_MMA(1, 1, At, B1); PG8_BAR; PG8_SCHED;
        }
        if constexpr (ALIGN_EPI) { if (wr == 0) PG8_BAR; }
        if (!PROBE_K || (ui & 1)) E(acc, cur, wr, wc, fr, fq);
        if (PROBE_EPI == 1) { asm volatile("" ::: "memory"); E(acc, cur, wr, wc, fr, fq); }
        if (PROBE_EPI == 2) { asm volatile("s_waitcnt vmcnt(0)" ::: "memory"); }
        if (!has_next) break;
#pragma unroll
        for (int a = 0; a < 2; ++a)
#pragma unroll
            for (int b = 0; b < 2; ++b)
#pragma unroll
                for (int m = 0; m < 4; ++m)
#pragma unroll
                    for (int n = 0; n < 2; ++n) acc[a][b][m][n] = (f32x4){0.f, 0.f, 0.f, 0.f};
        cur = nxt; cA = nA; cB = nB; ck = nk; ++ui;
        if constexpr (ALIGN_EPI) { if (wr == 1) PG8_BAR; }
    }
    PG8_WAIT_V(0);
    if constexpr (!ALIGN_EPI) { if (wr == 0) PG8_BAR; }
    PG8_BAR;
#undef PG8_SA
#undef PG8_SB
#undef PG8_STAGE
#undef PG8_LDA
#undef PG8_LDB
#undef PG8_MMA
#undef PG8_WAIT_V
#undef PG8_WAIT_L
#undef PG8_BAR
#undef PG8_SCHED
}
}
using pg8::Unit;
using pg8::cvt_pk_bf16;
constexpr int HALF = pg8::HALF, BM = pg8::BM;

struct SchedPlain : pg8::OrderBase {
    const char* A; const char* B; size_t tstep;
    __device__ __forceinline__ const char* abase(const Unit& u) const { return A + (size_t)u.pm * tstep; }
    __device__ __forceinline__ const char* bbase(const Unit& u) const { return B + (size_t)u.pn * tstep; }
    __device__ __forceinline__ int arow(const Unit&, int) const { return 0; }
};
struct SchedOne {
    const char* A; const char* B; size_t tstep; int pm, pn;
    __device__ __forceinline__ bool next(int i, Unit& u) const { if ((i >> PROBE_K) != 0) return false; u.pm = pm; u.pn = pn; return true; }
    __device__ __forceinline__ const char* abase(const Unit& u) const { return A + (size_t)u.pm * tstep; }
    __device__ __forceinline__ const char* bbase(const Unit& u) const { return B + (size_t)u.pn * tstep; }
    __device__ __forceinline__ int arow(const Unit&, int) const { return 0; }
};
struct SchedMoeUp : pg8::OrderBase {
    const char* A; const char* B; const int* tok;
    __device__ __forceinline__ const char* abase(const Unit&) const { return A; }
    __device__ __forceinline__ const char* bbase(const Unit& u) const { return B + ((size_t)(u.pm >> 4) * 2048 + (size_t)u.pn * 256) * (size_t)(DM * 2); }
    __device__ __forceinline__ int arow(const Unit& u, int r) const { const int e = u.pm >> 4, b = (u.pm >> 3) & 1, mt = u.pm & 7; return b * SEQ + tok[(b * NE + e) * CAP + mt * 256 + r]; }
};
struct SchedMoeDown : pg8::OrderBase {
    const char* A; const char* B;
    __device__ __forceinline__ const char* abase(const Unit& u) const { return A + (size_t)u.pm * 256 * (size_t)(DEXP * 2); }
    __device__ __forceinline__ const char* bbase(const Unit& u) const { return B + ((size_t)(u.pm >> 4) * 2048 + (size_t)u.pn * 256) * (size_t)(DEXP * 2); }
    __device__ __forceinline__ int arow(const Unit&, int) const { return 0; }
};

struct EpiInProj {
    static constexpr bool PERM = true;
    bf16* P;
    __device__ __forceinline__ void operator()(const f32x4 (&acc)[2][2][4][2], const Unit& u, int wr, int wc, int fr, int fq) const {
        const int row0 = u.pm * BM + wr * 64 + fr, col0 = u.pn * BM + wc * 32 + 8 * fq;
#pragma unroll
        for (int ai = 0; ai < 2; ++ai)
#pragma unroll
            for (int m = 0; m < 4; ++m) { bf16* rowp = P + (size_t)(row0 + ai * HALF + m * 16) * PW + col0;
#pragma unroll
                for (int bj = 0; bj < 2; ++bj) { const f32x4 v0 = acc[ai][bj][m][0], v1 = acc[ai][bj][m][1];
                    u32x4 w; w.x = cvt_pk_bf16(v0[0], v0[1]); w.y = cvt_pk_bf16(v0[2], v0[3]); w.z = cvt_pk_bf16(v1[0], v1[1]); w.w = cvt_pk_bf16(v1[2], v1[3]);
                    *(u32x4*)(rowp + bj * HALF) = w; } }
    }
};
struct EpiOutProj {
    static constexpr bool PERM = true;
    const float* X; bf16* D; const float* ada;
    __device__ __forceinline__ void operator()(const f32x4 (&acc)[2][2][4][2], const Unit& u, int wr, int wc, int fr, int fq) const {
        const int row0 = u.pm * BM + wr * 64 + fr, col0 = u.pn * BM + wc * 32 + 8 * fq;
        const int b = (u.pm * BM) / SEQ;
        const float* g1 = ada + (size_t)b * 12288 + 2 * DM;
        f32x4 gv[2][2];
#pragma unroll
        for (int bj = 0; bj < 2; ++bj)
#pragma unroll
            for (int n = 0; n < 2; ++n) gv[bj][n] = *(const f32x4*)(g1 + col0 + bj * HALF + 4 * n);
#pragma unroll
        for (int ai = 0; ai < 2; ++ai)
#pragma unroll
            for (int m = 0; m < 4; ++m) { const size_t off = (size_t)(row0 + ai * HALF + m * 16) * DM + col0;
#pragma unroll
                for (int bj = 0; bj < 2; ++bj) { const f32x4 x0 = *(const f32x4*)(X + off + bj * HALF), x1 = *(const f32x4*)(X + off + bj * HALF + 4);
                    const f32x4 v0 = x0 + acc[ai][bj][m][0] * gv[bj][0], v1 = x1 + acc[ai][bj][m][1] * gv[bj][1];
                    u32x4 w; w.x = cvt_pk_bf16(v0[0], v0[1]); w.y = cvt_pk_bf16(v0[2], v0[3]); w.z = cvt_pk_bf16(v1[0], v1[1]); w.w = cvt_pk_bf16(v1[2], v1[3]);
                    *(u32x4*)(D + off + bj * HALF) = w; }
                asm volatile("" ::: "memory"); }
    }
};
struct EpiSwiglu {
    static constexpr bool PERM = true;
    bf16* HID;
    __device__ __forceinline__ void operator()(const f32x4 (&acc)[2][2][4][2], const Unit& u, int wr, int wc, int fr, int fq) const {
        const int row0 = u.pm * BM + wr * 64 + fr, col0 = u.pn * 128 + wc * 32 + 8 * fq;
#pragma unroll
        for (int ai = 0; ai < 2; ++ai)
#pragma unroll
            for (int m = 0; m < 4; ++m) { bf16* rowp = HID + (size_t)(row0 + ai * HALF + m * 16) * DEXP + col0;
                f32x4 h0, h1;
#pragma unroll
                for (int j = 0; j < 4; ++j) { h0[j] = silu_f(acc[ai][0][m][0][j]) * acc[ai][1][m][0][j]; h1[j] = silu_f(acc[ai][0][m][1][j]) * acc[ai][1][m][1][j]; }
                u32x4 w; w.x = cvt_pk_bf16(h0[0], h0[1]); w.y = cvt_pk_bf16(h0[2], h0[3]); w.z = cvt_pk_bf16(h1[0], h1[1]); w.w = cvt_pk_bf16(h1[2], h1[3]);
                *(u32x4*)(rowp) = w; }
    }
};
struct EpiBf16 {
    static constexpr bool PERM = true;
    bf16* O; int ldc;
    __device__ __forceinline__ void operator()(const f32x4 (&acc)[2][2][4][2], const Unit& u, int wr, int wc, int fr, int fq) const {
        const int row0 = u.pm * BM + wr * 64 + fr, col0 = u.pn * BM + wc * 32 + 8 * fq;
#pragma unroll
        for (int ai = 0; ai < 2; ++ai)
#pragma unroll
            for (int m = 0; m < 4; ++m) { bf16* rowp = O + (size_t)(row0 + ai * HALF + m * 16) * ldc + col0;
#pragma unroll
                for (int bj = 0; bj < 2; ++bj) { const f32x4 v0 = acc[ai][bj][m][0], v1 = acc[ai][bj][m][1];
                    u32x4 w; w.x = cvt_pk_bf16(v0[0], v0[1]); w.y = cvt_pk_bf16(v0[2], v0[3]); w.z = cvt_pk_bf16(v1[0], v1[1]); w.w = cvt_pk_bf16(v1[2], v1[3]);
                    *(u32x4*)(rowp + bj * HALF) = w; } }
    }
};

__device__ __forceinline__ void transpose_item(const float* src, int ldsrc, int scol0, int k0, bf16* dst, size_t drow0, int ldd, LAS float* scr, int lane) {
#pragma unroll 8
    for (int i = 0; i < 32; ++i) { const int kk = 2 * i + (lane >> 5); scr[kk * 33 + (lane & 31)] = src[(size_t)(k0 + kk) * ldsrc + scol0 + (lane & 31)]; }
    asm volatile("s_waitcnt lgkmcnt(0)" ::: "memory");
    const int c = lane & 7;
#pragma unroll
    for (int j = 0; j < 4; ++j) { const int n = (lane >> 3) + 8 * j; const LAS float* s = scr + (8 * c) * 33 + n;
        u32x4 o; o.x = pk2(s[0 * 33], s[1 * 33]); o.y = pk2(s[2 * 33], s[3 * 33]); o.z = pk2(s[4 * 33], s[5 * 33]); o.w = pk2(s[6 * 33], s[7 * 33]);
        *(u32x4*)(dst + (drow0 + n) * (size_t)ldd + k0 + 8 * c) = o; }
    asm volatile("s_waitcnt lgkmcnt(0)" ::: "memory");
}

struct T64 { const float* src; bf16* dst; int ldsrc, ldd; };
__device__ __forceinline__ T64 decode_t64(const Args& a, int r) {
    unsigned char* ws = a.ws; T64 t;
    if (r < 2048) { const int kb = r >> 6, nb = r & 63; const int scol = nb < 48 ? nb * 64 : 3104 + (nb - 48) * 64;
        t.src = a.in[7] + (size_t)(kb * 64) * PROJW + scol; t.ldsrc = PROJW; t.dst = (bf16*)(ws + WS_WIN) + (size_t)(nb * 64) * DM + kb * 64; t.ldd = DM; return t; }
    r -= 2048;
    if (r < 1024) { const int kb = r >> 5, nb = r & 31;
        t.src = a.in[13] + (size_t)(kb * 64) * DM + nb * 64; t.ldsrc = DM; t.dst = (bf16*)(ws + WS_WOUT) + (size_t)(nb * 64) * DM + kb * 64; t.ldd = DM; return t; }
    r -= 1024;
    if (r < 16384) { const int up = r >= 8192; if (up) r -= 8192; const int e = r >> 9, rr = r & 511, kb = rr >> 4, nb = rr & 15, n0 = nb * 64;
        t.src = (up ? a.in[17] : a.in[16]) + (size_t)e * DM * DEXP + (size_t)(kb * 64) * DEXP + n0; t.ldsrc = DEXP;
        t.dst = (bf16*)(ws + WS_WGU) + ((size_t)e * 2048 + (size_t)(n0 >> 7) * 256 + (n0 & 127) + (up ? 128 : 0)) * DM + kb * 64; t.ldd = DM; return t; }
    r -= 16384;
    { const int e = r >> 9, rr = r & 511, kb = rr >> 5, nb = rr & 31;
        t.src = a.in[18] + (size_t)e * DEXP * DM + (size_t)(kb * 64) * DM + nb * 64; t.ldsrc = DM;
        t.dst = (bf16*)(ws + WS_WD) + ((size_t)e * 2048 + nb * 64) * DEXP + kb * 64; t.ldd = DEXP; return t; }
}
__device__ __forceinline__ void t64_load(const T64& t, int lane, f32x4 (&v)[16]) {
    const int krow = lane >> 4, c4 = lane & 15;
#pragma unroll
    for (int i = 0; i < 16; ++i) v[i] = *(const f32x4*)(t.src + (size_t)(4 * i + krow) * t.ldsrc + 4 * c4);
}
__device__ __forceinline__ void t64_finish(const T64& t, int lane, const f32x4 (&v)[16], LAS float* scr) {
    const int krow = lane >> 4, c4 = lane & 15;
#pragma unroll
    for (int i = 0; i < 16; ++i) { LAS float* p = scr + (4 * i + krow) * 65 + 4 * c4; p[0] = v[i].x; p[1] = v[i].y; p[2] = v[i].z; p[3] = v[i].w; }
    asm volatile("s_waitcnt lgkmcnt(0)" ::: "memory");
    const int c = lane & 7;
#pragma unroll
    for (int j = 0; j < 8; ++j) { const int n = (lane >> 3) + 8 * j; const LAS float* s = scr + (8 * c) * 65 + n;
        u32x4 o; o.x = pk2(s[0 * 65], s[1 * 65]); o.y = pk2(s[2 * 65], s[3 * 65]); o.z = pk2(s[4 * 65], s[5 * 65]); o.w = pk2(s[6 * 65], s[7 * 65]);
        *(u32x4*)(t.dst + (size_t)n * t.ldd + 8 * c) = o; }
    asm volatile("s_waitcnt lgkmcnt(0)" ::: "memory");
}
constexpr int P0_NT64 = 2048 + 1024 + 16384 + 8192;
constexpr int P0_TAIL = 1024;
constexpr int P0_NGEMV = 192;
__device__ __forceinline__ void phase0(const Args& a, LAS unsigned char* lds) {
    const int tid = threadIdx.x, lane = tid & 63, wave = tid >> 6, G = gridDim.x, blk = blockIdx.x;
    unsigned char* ws = a.ws;
    {
        const float* c = a.in[1]; const float* cc = a.in[3]; const float* w_ada = a.in[4]; const float* b_ada = a.in[5];
        float* part = (float*)(ws + WS_ADAP);
        LAS float* red = (LAS float*)lds;
        for (int rep_ = 0; rep_ < 1 + (PROBE_P0 & 1); ++rep_)
        for (int it = blk; it < P0_NGEMV; it += G) {
            const int cb = it % 48, ks = it / 48, col0 = cb * 256 + 4 * lane, r0 = ks * 512 + wave * 64;
            f32x4 a0 = {0.f, 0.f, 0.f, 0.f}, a1 = a0, a2 = a0;
#pragma unroll 16
            for (int r = r0; r < r0 + 64; ++r) {
                const f32x4 w = *(const f32x4*)(w_ada + (size_t)r * 12288 + col0);
                const float s0 = silu_f(c[r]), s1 = silu_f(c[DM + r]), s2 = silu_f(cc[r]);
                a0 += w * s0; a1 += w * s1; a2 += w * s2;
            }
            *(LAS f32x4*)(red + (wave * 3 + 0) * 256 + 4 * lane) = a0; *(LAS f32x4*)(red + (wave * 3 + 1) * 256 + 4 * lane) = a1; *(LAS f32x4*)(red + (wave * 3 + 2) * 256 + 4 * lane) = a2;
            __syncthreads();
            for (int idx = tid; idx < 768; idx += NTHREADS) { const int v = idx >> 8, col = idx & 255; float s = ks == 0 ? b_ada[cb * 256 + col] : 0.f;
#pragma unroll
                for (int w8 = 0; w8 < 8; ++w8) s += red[(w8 * 3 + v) * 256 + col];
                part[(size_t)(ks * 3 + v) * 12288 + cb * 256 + col] = s; }
            __syncthreads();
        }
    }
    LAS float* scr = (LAS float*)(lds + wave * 16640);
    const int gw = blk * 8 + wave, NGW = G * 8;
    constexpr int I_WZ = 32, I_WR = 512, I_TW = 256, I_FT = 256;
    for (int it = gw; it < I_WZ + I_WR + I_TW + I_FT; it += NGW) {
        int r = it;
        if (r < I_WZ) { transpose_item(a.in[7], PROJW, 3072, r * 64, (bf16*)(ws + WS_WIN), (size_t)4096, DM, scr, lane); continue; }
        r -= I_WZ;
        if (r < I_WR) { const int p = r * 64 + lane, e = p >> 11, d = p & 2047; const float wv = a.in[15][d * 16 + e]; const unsigned hi = f2bf(wv); ((bf16*)(ws + WS_WRH))[p] = (bf16)hi; ((bf16*)(ws + WS_WRL))[p] = (bf16)f2bf(wv - bf2f((bf16)hi)); continue; }
        r -= I_WR;
        if (r < I_TW) { const int p = r * 64 + lane; float s, c; sincospif((float)p * (1.0f / 8192.0f), &s, &c); ((f32x2*)(ws + WS_TW))[p] = (f32x2){c, s}; continue; }
        r -= I_TW;
        { const int p = r * 64 + lane, k = p >> 7, l = p & 127; float s, c; sincospif((float)((k * l) & 127) * (1.0f / 64.0f), &s, &c); ((bf16*)(ws + WS_FC))[p] = (bf16)f2bf(c); ((bf16*)(ws + WS_FS))[p] = (bf16)f2bf(s); }
    }
    const int n_gemv_wg = G > P0_NGEMV ? P0_NGEMV : 0;
    const int head_end = n_gemv_wg ? P0_NT64 - P0_TAIL : P0_NT64;
    const int n_head = gw < head_end ? (head_end - gw + NGW - 1) / NGW : 0;
    const int tgw = (blk - n_gemv_wg) * 8 + wave, tstep = (G - n_gemv_wg) * 8;
    const int n_tail = (n_gemv_wg && blk >= n_gemv_wg && tgw < P0_TAIL) ? (P0_TAIL - tgw + tstep - 1) / tstep : 0;
    const int n_items = n_head + n_tail;
    auto item_of = [&](int j) -> int { return j < n_head ? gw + j * NGW : head_end + tgw + (j - n_head) * tstep; };
    for (int rep_ = 0; rep_ < 1 + ((PROBE_P0 >> 1) & 1); ++rep_) {
    f32x4 va[16], vb[16]; T64 ta, tb;
    if (n_items > 0) { ta = decode_t64(a, item_of(0)); t64_load(ta, lane, va); }
    for (int j = 0; j < n_items; j += 2) {
        const bool h1 = j + 1 < n_items, h2 = j + 2 < n_items;
        if (h1) { tb = decode_t64(a, item_of(j + 1)); t64_load(tb, lane, vb); }
        t64_finish(ta, lane, va, scr);
        if (h2) { ta = decode_t64(a, item_of(j + 2)); t64_load(ta, lane, va); }
        if (h1) t64_finish(tb, lane, vb, scr);
    }
    }
}

#define MFMA16(a, b, c) __builtin_amdgcn_mfma_f32_16x16x32_bf16((a), (b), (c), 0, 0, 0)
__device__ __forceinline__ void finalize_ada(const Args& a) {
    const float* part = (const float*)(a.ws + WS_ADAP); float* adaw = (float*)(a.ws + WS_ADA);
    for (int i = blockIdx.x * NTHREADS + threadIdx.x; i < 3 * 12288; i += gridDim.x * NTHREADS) { float s = 0.f;
#pragma unroll
        for (int ks = 0; ks < 4; ++ks) s += part[(size_t)ks * 3 * 12288 + i];
        adaw[i] = s; }
}
constexpr int CW_CTXCNT = 4096;
template <int MODE>
__device__ __forceinline__ void norm_load_tile(const Args& a, int tile, int rl, int wave, int q, f32x4 (&xv)[8][2], u32x4 (&dv)[8]) {
    const int r = tile * 16 + rl;
    if (MODE == 0) { const float* s = (r < NLAT ? a.in[0] + (size_t)r * DM : a.in[2] + (size_t)(r - NLAT) * DM) + 256 * wave + 8 * q;
#pragma unroll
        for (int ks = 0; ks < 8; ++ks) { xv[ks][0] = *(const f32x4*)(s + 32 * ks); xv[ks][1] = *(const f32x4*)(s + 32 * ks + 4); } }
    if (MODE == 1) { const bf16* dp = (const bf16*)(a.ws + WS_DLT) + (size_t)r * DM + 256 * wave + 8 * q;
#pragma unroll
        for (int ks = 0; ks < 8; ++ks) dv[ks] = *(const u32x4*)(dp + 32 * ks); }
}
template <int MODE>
__device__ __forceinline__ void phase_norm_tile(const Args& a, LAS unsigned char* lds, int first, int stride, int tile_end) {
    const int tid = threadIdx.x, lane = tid & 63, wave = __builtin_amdgcn_readfirstlane(tid >> 6), rl = lane & 15, q = lane >> 4;
    const float* ada = (const float*)(a.ws + WS_ADA);
    LAS float* gs = (LAS float*)lds;
    LAS float* shv = gs + 3 * DM;
    LAS float* ssred = shv + 3 * DM;
    LAS float* red = ssred + 128;
    { const float* gn = MODE == 0 ? a.in[6] : a.in[14]; const float* part = (const float*)(a.ws + WS_ADAP);
      for (int i = tid; i < 3 * DM; i += NTHREADS) { const int v = i / DM, d = i % DM;
          float sh_, sc_;
          if (MODE == 0) { const float* p0 = part + (size_t)v * 12288; sh_ = 0.f; sc_ = 0.f;
#pragma unroll
              for (int ks = 0; ks < 4; ++ks) { sh_ += p0[(size_t)ks * 3 * 12288 + d]; sc_ += p0[(size_t)ks * 3 * 12288 + DM + d]; } }
          else { const float* base = ada + (size_t)v * 12288 + 3 * DM; sh_ = base[d]; sc_ = base[DM + d]; }
          gs[i] = gn[d] * (1.f + sc_); shv[i] = sh_; }
    }
    bf16x8 wb[2][8];
    if (MODE == 0) { const bf16* Wz = (const bf16*)(a.ws + WS_WIN) + (size_t)4096 * DM;
#pragma unroll
        for (int nt = 0; nt < 2; ++nt)
#pragma unroll
            for (int ks = 0; ks < 8; ++ks) wb[nt][ks] = *(const bf16x8*)(Wz + (size_t)(16 * nt + rl) * DM + 256 * wave + 32 * ks + 8 * q);
    } else { const bf16* WH = (const bf16*)(a.ws + WS_WRH); const bf16* WL = (const bf16*)(a.ws + WS_WRL);
#pragma unroll
        for (int ks = 0; ks < 8; ++ks) { wb[0][ks] = *(const bf16x8*)(WH + (size_t)rl * DM + 256 * wave + 32 * ks + 8 * q); wb[1][ks] = *(const bf16x8*)(WL + (size_t)rl * DM + 256 * wave + 32 * ks + 8 * q); } }
    __syncthreads();
    bf16* Hout = (bf16*)(a.ws + (MODE == 0 ? WS_H : WS_HF));
    f32x4 xv[8][2]; u32x4 dv[8];
    auto tile_of = [&](int s) -> int { return MODE == 0 ? (s < 32 ? NLAT / 16 + s : s - 32) : s; };
    int sq = first;
    if (sq < tile_end) norm_load_tile<MODE>(a, tile_of(sq), rl, wave, q, xv, dv);
    for (; sq < tile_end; sq += stride) {
        const int tile = tile_of(sq);
        const int r = tile * 16 + rl;
        const int v = MODE == 0 ? (tile * 16 < NLAT ? (tile * 16) / SEQ : 2) : (tile * 16) / SEQ;
        if (MODE == 1) {
#pragma unroll
            for (int ks = 0; ks < 8; ++ks) { const u32x4 d = dv[ks];
                xv[ks][0] = (f32x4){__uint_as_float(d.x << 16), __uint_as_float(d.x & 0xffff0000u), __uint_as_float(d.y << 16), __uint_as_float(d.y & 0xffff0000u)};
                xv[ks][1] = (f32x4){__uint_as_float(d.z << 16), __uint_as_float(d.z & 0xffff0000u), __uint_as_float(d.w << 16), __uint_as_float(d.w & 0xffff0000u)}; } }
        float ss = 0.f;
#pragma unroll
        for (int ks = 0; ks < 8; ++ks) { const f32x4 a0 = xv[ks][0], a1 = xv[ks][1]; ss += (a0.x * a0.x + a0.y * a0.y) + (a0.z * a0.z + a0.w * a0.w) + (a1.x * a1.x + a1.y * a1.y) + (a1.z * a1.z + a1.w * a1.w); }
        ss += __shfl_xor(ss, 16); ss += __shfl_xor(ss, 32);
        if (q == 0) ssred[wave * 16 + rl] = ss;
        __syncthreads();
        float tot = 0.f;
#pragma unroll
        for (int w8 = 0; w8 < 8; ++w8) tot += ssred[w8 * 16 + rl];
        const float rstd = rsqrtf(tot * (1.f / DM) + EPS);
        f32x4 acc0 = {0.f, 0.f, 0.f, 0.f}, acc1 = {0.f, 0.f, 0.f, 0.f};
        bf16* orow = Hout + (size_t)r * DM + 256 * wave + 8 * q;
        const LAS float* gsp = gs + v * DM + 256 * wave + 8 * q; const LAS float* shp = shv + v * DM + 256 * wave + 8 * q;
#pragma unroll
        for (int ks = 0; ks < 8; ++ks) {
            const f32x4 g0 = *(const LAS f32x4*)(gsp + 32 * ks), g1 = *(const LAS f32x4*)(gsp + 32 * ks + 4), s0 = *(const LAS f32x4*)(shp + 32 * ks), s1 = *(const LAS f32x4*)(shp + 32 * ks + 4);
            const f32x4 h0 = xv[ks][0] * rstd * g0 + s0, h1 = xv[ks][1] * rstd * g1 + s1;
            u32x4 hw; hw.x = pk2(h0.x, h0.y); hw.y = pk2(h0.z, h0.w); hw.z = pk2(h1.x, h1.y); hw.w = pk2(h1.z, h1.w);
            *(u32x4*)(orow + 32 * ks) = hw;
            const bf16x8 hf = __builtin_bit_cast(bf16x8, hw);
            if (MODE == 0) { acc0 = MFMA16(hf, wb[0][ks], acc0); acc1 = MFMA16(hf, wb[1][ks], acc1); }
            else { u32x4 lw;
                lw.x = pk2(h0.x - __uint_as_float(hw.x << 16), h0.y - __uint_as_float(hw.x & 0xffff0000u)); lw.y = pk2(h0.z - __uint_as_float(hw.y << 16), h0.w - __uint_as_float(hw.y & 0xffff0000u));
                lw.z = pk2(h1.x - __uint_as_float(hw.z << 16), h1.y - __uint_as_float(hw.z & 0xffff0000u)); lw.w = pk2(h1.z - __uint_as_float(hw.w << 16), h1.w - __uint_as_float(hw.w & 0xffff0000u));
                const bf16x8 lf = __builtin_bit_cast(bf16x8, lw);
                acc0 = MFMA16(hf, wb[0][ks], acc0); acc0 = MFMA16(lf, wb[0][ks], acc0); acc0 = MFMA16(hf, wb[1][ks], acc0); }
        }
        if (sq + stride < tile_end) norm_load_tile<MODE>(a, tile_of(sq + stride), rl, wave, q, xv, dv);
#pragma unroll
        for (int rr = 0; rr < 4; ++rr) { red[(wave * 16 + 4 * q + rr) * 32 + rl] = acc0[rr]; if (MODE == 0) red[(wave * 16 + 4 * q + rr) * 32 + 16 + rl] = acc1[rr]; }
        __syncthreads();
        if (MODE == 0) { const int row = tid >> 5, col = tid & 31; float s = 0.f;
#pragma unroll
            for (int w8 = 0; w8 < 8; ++w8) s += red[(w8 * 16 + row) * 32 + col];
            ((float*)(a.ws + WS_Z))[(size_t)(tile * 16 + row) * 32 + col] = s;
        } else if (tid < 256) { const int row = tid >> 4, e = tid & 15; float s = 0.f;
#pragma unroll
            for (int w8 = 0; w8 < 8; ++w8) s += red[(w8 * 16 + row) * 32 + e];
            float m = s; m = fmaxf(m, __shfl_xor(m, 1)); m = fmaxf(m, __shfl_xor(m, 2)); m = fmaxf(m, __shfl_xor(m, 4)); m = fmaxf(m, __shfl_xor(m, 8));
            const float ex = expf(s - m); float sm = ex; sm += __shfl_xor(sm, 1); sm += __shfl_xor(sm, 2); sm += __shfl_xor(sm, 4); sm += __shfl_xor(sm, 8);
            const int rg = tile * 16 + row, b = rg / SEQ, t = rg % SEQ;
            ((float*)(a.ws + WS_AFF))[((size_t)b * NE + e) * SEQ + t] = ex / sm; }
        if (MODE == 0 && tile >= NLAT / 16) {
            __threadfence(); __syncthreads();
            if (tid == 0) __hip_atomic_fetch_add((unsigned*)(a.ws + WS_CTL) + CW_CTXCNT + 64 * ((tile - NLAT / 16) >> 4), 1u, __ATOMIC_RELAXED, __HIP_MEMORY_SCOPE_AGENT);
        }
        __syncthreads();
    }
}

constexpr int GQ_LD = 136, GK_LD = 72;
constexpr int GL_Q = 0, GL_KI = 17408, GL_KET = 34816, GL_VT = 53248, GL_ST = 90112, GL_DC = 159744, GL_SEG = 160256;
__device__ __forceinline__ bf16x8 ldfrag(const LAS bf16* base, int row0, int ld, int koff, int lane) { return *(const LAS bf16x8*)(base + (row0 + (lane & 15)) * ld + koff + 8 * (lane >> 4)); }
__device__ __forceinline__ float fast_logsigmoid(float x) { return fminf(x, 0.f) - __logf(1.f + __expf(-fabsf(x))); }

struct GlaRaw { u32x4 q[2], k[2], v[4]; f32x2 z; };
template <bool FULL>
__device__ __forceinline__ void gla_issue_loads(const Args& a, size_t row0, int h, int dir, int wave, int lane, int tid, GlaRaw& r) {
    const bf16* P = (const bf16*)(a.ws + WS_P); const float* Z = (const float*)(a.ws + WS_Z);
#pragma unroll
    for (int j = 0; j < 2; ++j) { const int e = tid + 512 * j, row = e >> 4, c8 = e & 15;
        r.k[j] = *(const u32x4*)(P + (row0 + row) * PW + 512 + h * 128 + 8 * c8);
        if (FULL) r.q[j] = *(const u32x4*)(P + (row0 + row) * PW + h * 128 + 8 * c8); }
    { const int e = tid * 2; r.z = *(const f32x2*)(Z + (row0 + (e >> 4)) * 32 + dir * 16 + (e & 15)); }
#pragma unroll
    for (int rr = 0; rr < 4; ++rr) r.v[rr] = *(const u32x4*)(P + (row0 + 4 * (lane >> 2) + rr) * PW + 1024 + h * 256 + 32 * wave + 8 * (lane & 3));
}
__device__ __forceinline__ void gla_store_vt(LAS unsigned char* lds, int wave, int lane, const u32x4 (&x)[4]) {
    LAS bf16* VT = (LAS bf16*)(lds + GL_VT); const int c0 = 32 * wave + 8 * (lane & 3), l0 = 4 * (lane >> 2);
#pragma unroll
    for (int i2 = 0; i2 < 4; ++i2) {
        const unsigned a0 = x[0][i2], a1 = x[1][i2], a2 = x[2][i2], a3 = x[3][i2];
        u32x2 lo, hi; lo.x = (a0 & 0xffffu) | (a1 << 16); lo.y = (a2 & 0xffffu) | (a3 << 16); hi.x = (a0 >> 16) | (a1 & 0xffff0000u); hi.y = (a2 >> 16) | (a3 & 0xffff0000u);
        *(LAS u32x2*)(VT + (c0 + 2 * i2) * GK_LD + l0) = lo; *(LAS u32x2*)(VT + (c0 + 2 * i2 + 1) * GK_LD + l0) = hi; }
}
template <bool FULL>
__device__ __forceinline__ void gla_stage(LAS unsigned char* lds, int wave, int lane, int tid, const GlaRaw& r) {
    LAS bf16* Qd = (LAS bf16*)(lds + GL_Q); LAS bf16* Ki = (LAS bf16*)(lds + GL_KI); LAS unsigned* zs = (LAS unsigned*)(lds + GL_SEG);
#pragma unroll
    for (int j = 0; j < 2; ++j) { const int e = tid + 512 * j, row = e >> 4, c8 = e & 15;
        *(LAS u32x4*)(Ki + row * GQ_LD + 8 * c8) = r.k[j]; if (FULL) *(LAS u32x4*)(Qd + row * GQ_LD + 8 * c8) = r.q[j]; }
    zs[tid] = pk2(r.z.x, r.z.y);
    gla_store_vt(lds, wave, lane, r.v);
}
template <bool FULL>
__device__ __forceinline__ void gla_prep(LAS unsigned char* lds, int dir, const bf16x8 wfrag, float bias, float& totacc) {
    const int tid = threadIdx.x, lane = tid & 63, wave = __builtin_amdgcn_readfirstlane(tid >> 6), cidx = lane & 15, q = lane >> 4, d = 16 * wave + cidx;
    LAS bf16* Qd = (LAS bf16*)(lds + GL_Q); LAS bf16* Ki = (LAS bf16*)(lds + GL_KI); LAS bf16* KeT = (LAS bf16*)(lds + GL_KET);
    LAS float* dcv = (LAS float*)(lds + GL_DC); const LAS bf16* zs = (const LAS bf16*)(lds + GL_SEG);
    float c[4][4], t4[4], sq[4], Tt[4];
#pragma unroll
    for (int it = 0; it < 4; ++it) {
        const bf16x8 zf = *(const LAS bf16x8*)(zs + (16 * it + cidx) * 16 + 8 * (q & 1));
        f32x4 pre = {bias, bias, bias, bias};
        pre = MFMA16(zf, wfrag, pre);
#pragma unroll
        for (int r = 0; r < 4; ++r) c[it][r] = fast_logsigmoid(pre[r]) * (1.f / 16.f);
        if (!dir) { c[it][1] += c[it][0]; c[it][2] += c[it][1]; c[it][3] += c[it][2]; t4[it] = c[it][3]; }
        else { c[it][2] += c[it][3]; c[it][1] += c[it][2]; c[it][0] += c[it][1]; t4[it] = c[it][0]; }
        float s = t4[it];
        if (!dir) { const float u = __shfl_up(s, 16); if (q >= 1) s += u; const float u2 = __shfl_up(s, 32); if (q >= 2) s += u2; Tt[it] = __shfl(s, cidx + 48); }
        else { const float u = __shfl_down(s, 16); if (q <= 2) s += u; const float u2 = __shfl_down(s, 32); if (q <= 1) s += u2; Tt[it] = __shfl(s, cidx); }
        sq[it] = s - t4[it];
    }
    const float total = (Tt[0] + Tt[1]) + (Tt[2] + Tt[3]);
    float off[4];
    if (!dir) { off[0] = 0.f; off[1] = Tt[0]; off[2] = Tt[0] + Tt[1]; off[3] = Tt[0] + Tt[1] + Tt[2]; }
    else { off[3] = 0.f; off[2] = Tt[3]; off[1] = Tt[3] + Tt[2]; off[0] = Tt[3] + Tt[2] + Tt[1]; }
    const float dc = __expf(total);
#pragma unroll
    for (int it = 0; it < 4; ++it) {
        float ke[4];
#pragma unroll
        for (int r = 0; r < 4; ++r) { const int i = 16 * it + 4 * q + r; const float cum = c[it][r] + off[it] + sq[it];
            const float kf = bf2f(Ki[i * GQ_LD + d]);
            if (FULL) { const float qf = bf2f(Qd[i * GQ_LD + d]); const float kin = kf * __expf(-cum);
                Qd[i * GQ_LD + d] = (bf16)f2bf(qf * 0.08838834764831845f * __expf(cum)); Ki[i * GQ_LD + d] = (bf16)f2bf(kin); ke[r] = kin * dc; }
            else ke[r] = kf * __expf(total - cum); }
        u32x2 kw; kw.x = pk2(ke[0], ke[1]); kw.y = pk2(ke[2], ke[3]);
        *(LAS u32x2*)(KeT + d * GK_LD + 16 * it + 4 * q) = kw;
    }
    if (q == 0) { dcv[d] = dc; totacc += total; }
}
__device__ __forceinline__ bf16x8 gla_wfrag(const float* w_a2, int h, int wave, int lane) {
    const int d = 16 * wave + (lane & 15), q = lane >> 4; unsigned wv[4];
#pragma unroll
    for (int j2 = 0; j2 < 4; ++j2) { float x[2];
#pragma unroll
        for (int u = 0; u < 2; ++u) { const float wf = w_a2[(8 * (q & 1) + 2 * j2 + u) * 512 + h * 128 + d]; const float hi = bf2f((bf16)f2bf(wf)); x[u] = q < 2 ? hi : wf - hi; }
        wv[j2] = pk2(x[0], x[1]); }
    return __builtin_bit_cast(bf16x8, (u32x4){wv[0], wv[1], wv[2], wv[3]});
}
__device__ __forceinline__ void gla_state_update(LAS unsigned char* lds, int lane, const bf16x8 (&vt)[2][2], f32x4 (&acc)[8][2]) {
    const LAS bf16* KeT = (const LAS bf16*)(lds + GL_KET); const LAS float* dcv = (const LAS float*)(lds + GL_DC);
#pragma unroll
    for (int mt = 0; mt < 8; ++mt) {
        const f32x4 dc4 = *(const LAS f32x4*)(dcv + 16 * mt + 4 * (lane >> 4));
        const bf16x8 k0 = ldfrag(KeT, 16 * mt, GK_LD, 0, lane), k1 = ldfrag(KeT, 16 * mt, GK_LD, 32, lane);
#pragma unroll
        for (int n = 0; n < 2; ++n) { f32x4 t = acc[mt][n] * dc4; t = MFMA16(k0, vt[n][0], t); t = MFMA16(k1, vt[n][1], t); acc[mt][n] = t; }
    }
}
constexpr size_t GLA_SV = 128 * 256;
__device__ __forceinline__ void gla_passA(const Args& a, LAS unsigned char* lds, int item) {
    const int tid = threadIdx.x, lane = tid & 63, wave = __builtin_amdgcn_readfirstlane(tid >> 6), q = lane >> 4, cidx = lane & 15;
    const bool is_ctx = item >= 256; const int seq = is_ctx ? item - 256 : item >> 4, s = is_ctx ? 0 : item & 15;
    const int b = seq >> 3, dir = (seq >> 2) & 1, h = seq & 3, nchunk = is_ctx ? 4 : 16;
    const size_t rowbase = is_ctx ? (size_t)(NLAT + b * CTXL) : (size_t)b * SEQ + (size_t)s * 1024;
    const float* w_a2 = dir ? a.in[10] : a.in[8]; const float* b_a2 = dir ? a.in[11] : a.in[9];
    const bf16x8 wfrag = gla_wfrag(w_a2, h, wave, lane);
    const float bias = b_a2[h * 128 + 16 * wave + cidx];
    f32x4 acc[8][2];
#pragma unroll
    for (int mt = 0; mt < 8; ++mt) { acc[mt][0] = (f32x4){0.f, 0.f, 0.f, 0.f}; acc[mt][1] = (f32x4){0.f, 0.f, 0.f, 0.f}; }
    float totacc = 0.f;
    GlaRaw raw; gla_issue_loads<false>(a, rowbase + (size_t)(dir ? (nchunk - 1) : 0) * 64, h, dir, wave, lane, tid, raw);
    for (int ci = 0; ci < nchunk; ++ci) {
        gla_stage<false>(lds, wave, lane, tid, raw);
        if (ci + 1 < nchunk) gla_issue_loads<false>(a, rowbase + (size_t)(dir ? (nchunk - 2 - ci) : ci + 1) * 64, h, dir, wave, lane, tid, raw);
        __syncthreads();
        gla_prep<false>(lds, dir, wfrag, bias, totacc);
        __syncthreads();
        const LAS bf16* VT = (const LAS bf16*)(lds + GL_VT);
        bf16x8 vt[2][2];
#pragma unroll
        for (int n2 = 0; n2 < 2; ++n2) { vt[n2][0] = ldfrag(VT, 32 * wave + 16 * n2, GK_LD, 0, lane); vt[n2][1] = ldfrag(VT, 32 * wave + 16 * n2, GK_LD, 32, lane); }
        gla_state_update(lds, lane, vt, acc);
        __syncthreads();
    }
    float* T = is_ctx ? (float*)(a.ws + WS_ST0) + (size_t)seq * GLA_SV : (float*)(a.ws + WS_T) + (size_t)item * GLA_SV;
#pragma unroll
    for (int mt = 0; mt < 8; ++mt)
#pragma unroll
        for (int n2 = 0; n2 < 2; ++n2)
#pragma unroll
            for (int r = 0; r < 4; ++r) T[(size_t)(16 * mt + 4 * q + r) * 256 + 32 * wave + 16 * n2 + cidx] = acc[mt][n2][r];
    if (!is_ctx && q == 0) ((float*)(a.ws + WS_DT))[item * 128 + 16 * wave + cidx] = __expf(totacc);
}
__device__ __forceinline__ void gla_passB(const Args& a) {
    const float* ST0 = (const float*)(a.ws + WS_ST0); const float* T = (const float*)(a.ws + WS_T); const float* DT = (const float*)(a.ws + WS_DT); float* SST = (float*)(a.ws + WS_SST);
    for (int e = blockIdx.x * NTHREADS + threadIdx.x; e < 16 * (int)GLA_SV; e += gridDim.x * NTHREADS) {
        const int seq = e >> 15, dv = e & 32767, d = dv >> 8, dir = (seq >> 2) & 1;
        float S = ST0[(size_t)seq * GLA_SV + dv];
        float tv[16], dd[16];
#pragma unroll
        for (int si = 0; si < 16; ++si) { const int s = dir ? 15 - si : si; const size_t it = (size_t)seq * 16 + s; tv[si] = T[it * GLA_SV + dv]; dd[si] = DT[it * 128 + d]; }
#pragma unroll
        for (int si = 0; si < 16; ++si) { const int s = dir ? 15 - si : si; const size_t it = (size_t)seq * 16 + s;
            SST[it * GLA_SV + dv] = S; S = dd[si] * S + tv[si]; }
    }
}
__device__ __forceinline__ void gla_passC(const Args& a, LAS unsigned char* lds, int item) {
    const int tid = threadIdx.x, lane = tid & 63, wave = __builtin_amdgcn_readfirstlane(tid >> 6), q = lane >> 4, cidx = lane & 15;
    const int seq = item >> 4, s = item & 15, b = seq >> 3, dir = (seq >> 2) & 1, h = seq & 3;
    const size_t rowbase = (size_t)b * SEQ + (size_t)s * 1024;
    const float* w_a2 = dir ? a.in[10] : a.in[8]; const float* b_a2 = dir ? a.in[11] : a.in[9];
    bf16* O = (bf16*)(a.ws + (dir ? WS_OB : WS_OF));
    const bf16x8 wfrag = gla_wfrag(w_a2, h, wave, lane);
    const float bias = b_a2[h * 128 + 16 * wave + cidx];
    LAS bf16* Qd = (LAS bf16*)(lds + GL_Q); LAS bf16* Ki = (LAS bf16*)(lds + GL_KI); LAS bf16* Pm = Ki; LAS bf16* VT = (LAS bf16*)(lds + GL_VT); LAS bf16* ST = (LAS bf16*)(lds + GL_ST);
    f32x4 acc[8][2];
    { const float* S0 = (const float*)(a.ws + WS_SST) + (size_t)item * GLA_SV;
#pragma unroll
      for (int mt = 0; mt < 8; ++mt)
#pragma unroll
          for (int n2 = 0; n2 < 2; ++n2) {
#pragma unroll
              for (int r = 0; r < 4; ++r) acc[mt][n2][r] = S0[(size_t)(16 * mt + 4 * q + r) * 256 + 32 * wave + 16 * n2 + cidx];
              u32x2 wv; wv.x = pk2(acc[mt][n2][0], acc[mt][n2][1]); wv.y = pk2(acc[mt][n2][2], acc[mt][n2][3]);
              *(LAS u32x2*)(ST + (32 * wave + 16 * n2 + cidx) * GQ_LD + 16 * mt + 4 * q) = wv; } }
    float totacc = 0.f;
    GlaRaw raw; gla_issue_loads<true>(a, rowbase + (size_t)(dir ? 15 : 0) * 64, h, dir, wave, lane, tid, raw);
    for (int ci = 0; ci < 16; ++ci) {
        const int n = dir ? (15 - ci) : ci; const size_t row0 = rowbase + (size_t)n * 64;
        gla_stage<true>(lds, wave, lane, tid, raw);
        if (ci + 1 < 16) gla_issue_loads<true>(a, rowbase + (size_t)(dir ? (14 - ci) : ci + 1) * 64, h, dir, wave, lane, tid, raw);
        __syncthreads();
        gla_prep<true>(lds, dir, wfrag, bias, totacc);
        __syncthreads();
        const int it = wave >> 1;
        u32x2 pw[2];
#pragma unroll
        for (int jj = 0; jj < 2; ++jj) { const int jt = 2 * (wave & 1) + jj; f32x4 sc = {0.f, 0.f, 0.f, 0.f};
#pragma unroll
            for (int ks = 0; ks < 4; ++ks) sc = MFMA16(ldfrag(Ki, 16 * jt, GQ_LD, 32 * ks, lane), ldfrag(Qd, 16 * it, GQ_LD, 32 * ks, lane), sc);
            const int i = 16 * it + cidx, j0 = 16 * jt + 4 * q;
#pragma unroll
            for (int r = 0; r < 4; ++r) { const bool keep = dir ? (j0 + r >= i) : (j0 + r <= i); sc[r] = keep ? sc[r] : 0.f; }
            pw[jj].x = pk2(sc[0], sc[1]); pw[jj].y = pk2(sc[2], sc[3]); }
        __syncthreads();
#pragma unroll
        for (int jj = 0; jj < 2; ++jj) *(LAS u32x2*)(Pm + (16 * it + cidx) * GK_LD + 16 * (2 * (wave & 1) + jj) + 4 * q) = pw[jj];
        __syncthreads();
        bf16x8 vt[2][2], st[2][4];
#pragma unroll
        for (int n2 = 0; n2 < 2; ++n2) { vt[n2][0] = ldfrag(VT, 32 * wave + 16 * n2, GK_LD, 0, lane); vt[n2][1] = ldfrag(VT, 32 * wave + 16 * n2, GK_LD, 32, lane);
#pragma unroll
            for (int ks = 0; ks < 4; ++ks) st[n2][ks] = ldfrag(ST, 32 * wave + 16 * n2, GQ_LD, 32 * ks, lane); }
#pragma unroll
        for (int i2 = 0; i2 < 4; ++i2) {
            const bf16x8 p0 = ldfrag(Pm, 16 * i2, GK_LD, 0, lane), p1 = ldfrag(Pm, 16 * i2, GK_LD, 32, lane);
            bf16x8 qf[4];
#pragma unroll
            for (int ks = 0; ks < 4; ++ks) qf[ks] = ldfrag(Qd, 16 * i2, GQ_LD, 32 * ks, lane);
#pragma unroll
            for (int n2 = 0; n2 < 2; ++n2) { f32x4 o = {0.f, 0.f, 0.f, 0.f};
                o = MFMA16(vt[n2][0], p0, o); o = MFMA16(vt[n2][1], p1, o);
#pragma unroll
                for (int ks = 0; ks < 4; ++ks) o = MFMA16(st[n2][ks], qf[ks], o);
                u32x2 wv; wv.x = pk2(o[0], o[1]); wv.y = pk2(o[2], o[3]);
                *(u32x2*)(O + (row0 + 16 * i2 + cidx) * 1024 + h * 256 + 32 * wave + 16 * n2 + 4 * q) = wv; }
        }
        gla_state_update(lds, lane, vt, acc);
#pragma unroll
        for (int mt = 0; mt < 8; ++mt)
#pragma unroll
            for (int n2 = 0; n2 < 2; ++n2) { u32x2 wv; wv.x = pk2(acc[mt][n2][0], acc[mt][n2][1]); wv.y = pk2(acc[mt][n2][2], acc[mt][n2][3]);
                *(LAS u32x2*)(ST + (32 * wave + 16 * n2 + cidx) * GQ_LD + 16 * mt + 4 * q) = wv; }
        __syncthreads();
    }
}

__device__ __forceinline__ void phase_gla_merge(const Args& a) {
    const int tid = threadIdx.x, lane = tid & 63, wave = tid >> 6;
    const int gw = blockIdx.x * 8 + wave, NGW = gridDim.x * 8;
    const bf16* OF = (const bf16*)(a.ws + WS_OF); const bf16* OB = (const bf16*)(a.ws + WS_OB);
    const bf16* P = (const bf16*)(a.ws + WS_P); bf16* Y = (bf16*)(a.ws + WS_YCAT); const float* gg = a.in[12];
    f32x4 gn[4];
#pragma unroll
    for (int j = 0; j < 4; ++j) gn[j] = *(const f32x4*)(gg + 256 * j + 4 * lane);
    for (int r0 = gw; r0 < NLAT; r0 += 2 * NGW) {
        u32x2 fa[2][4], fb[2][4], gw2[2][4];
#pragma unroll
        for (int u = 0; u < 2; ++u) { const int r = r0 + u * NGW; if (r < NLAT) {
#pragma unroll
            for (int j = 0; j < 4; ++j) { const int col = 256 * j + 4 * lane; fa[u][j] = *(const u32x2*)(OF + (size_t)r * 1024 + col); fb[u][j] = *(const u32x2*)(OB + (size_t)r * 1024 + col); gw2[u][j] = *(const u32x2*)(P + (size_t)r * PW + 2048 + col); } } }
#pragma unroll
        for (int u = 0; u < 2; ++u) { const int r = r0 + u * NGW; if (r < NLAT) {
#pragma unroll
            for (int j = 0; j < 4; ++j) {
                const int col = 256 * j + 4 * lane;
                f32x4 o; o.x = __uint_as_float(fa[u][j].x << 16) + __uint_as_float(fb[u][j].x << 16); o.y = __uint_as_float(fa[u][j].x & 0xffff0000u) + __uint_as_float(fb[u][j].x & 0xffff0000u);
                o.z = __uint_as_float(fa[u][j].y << 16) + __uint_as_float(fb[u][j].y << 16); o.w = __uint_as_float(fa[u][j].y & 0xffff0000u) + __uint_as_float(fb[u][j].y & 0xffff0000u);
                const float ss = wave_sum((o.x * o.x + o.y * o.y) + (o.z * o.z + o.w * o.w));
                const float rstd = rsqrtf(ss * (1.f / 256.f) + EPS);
                const float g0 = __uint_as_float(gw2[u][j].x << 16), g1 = __uint_as_float(gw2[u][j].x & 0xffff0000u), g2 = __uint_as_float(gw2[u][j].y << 16), g3 = __uint_as_float(gw2[u][j].y & 0xffff0000u);
                u32x2 w; w.x = pk2(o.x * rstd * gn[j].x * silu_f(g0), o.y * rstd * gn[j].y * silu_f(g1)); w.y = pk2(o.z * rstd * gn[j].z * silu_f(g2), o.w * rstd * gn[j].w * silu_f(g3));
                *(u32x2*)(Y + (size_t)r * DM + col) = w;
            } } }
    }
}

constexpr int FLD = 136;
__device__ __forceinline__ void load_dft_frags(const unsigned char* ws, int wave, int lane, bf16x8 (&fc)[4], bf16x8 (&fs)[4]) {
    const bf16* FC = (const bf16*)(ws + WS_FC); const bf16* FS = (const bf16*)(ws + WS_FS);
    const int k = 16 * wave + (lane & 15);
#pragma unroll
    for (int ks = 0; ks < 4; ++ks) { fc[ks] = *(const bf16x8*)(FC + k * 128 + ks * 32 + 8 * (lane >> 4)); fs[ks] = *(const bf16x8*)(FS + k * 128 + ks * 32 + 8 * (lane >> 4)); }
}
__device__ __forceinline__ void store_t4x8(LAS bf16* XT, int c0, int l0, const u32x4 (&x)[4]) {
#pragma unroll
    for (int i2 = 0; i2 < 4; ++i2) {
        const unsigned a0 = x[0][i2], a1 = x[1][i2], a2 = x[2][i2], a3 = x[3][i2];
        u32x2 lo, hi; lo.x = (a0 & 0xffffu) | (a1 << 16); lo.y = (a2 & 0xffffu) | (a3 << 16); hi.x = (a0 >> 16) | (a1 & 0xffff0000u); hi.y = (a2 >> 16) | (a3 & 0xffff0000u);
        const int sw = (((l0 >> 3) ^ ((c0 >> 3) & 7)) << 3) + (l0 & 7);
        *(LAS u32x2*)(XT + (c0 + 2 * i2) * FLD + sw) = lo; *(LAS u32x2*)(XT + (c0 + 2 * i2 + 1) * FLD + sw) = hi; }
}
__device__ __forceinline__ bf16x8 ldfrag_sw(const LAS bf16* XT, int row0, int kc, int lane) { const int row = row0 + (lane & 15); return *(const LAS bf16x8*)(XT + row * FLD + ((kc ^ ((row >> 3) & 7)) << 3)); }
__device__ __forceinline__ void phase_f1(const Args& a, LAS unsigned char* lds) {
    const int tid = threadIdx.x, lane = tid & 63, wave = __builtin_amdgcn_readfirstlane(tid >> 6), q = lane >> 4, cidx = lane & 15;
    const bf16* P = (const bf16*)(a.ws + WS_P); const f32x2* TW = (const f32x2*)(a.ws + WS_TW);
    bf16* A1r = (bf16*)(a.ws + WS_FA); bf16* A1i = (bf16*)(a.ws + WS_FAI);
    LAS bf16* XT = (LAS bf16*)lds;
    bf16x8 fc[4], fs[4]; load_dft_frags(a.ws, wave, lane, fc, fs);
    const int k1 = 16 * wave + cidx;
    u32x4 xp[2][4];
    auto f1_load = [&](int item) { const int cb = item & 3, l2 = (item >> 2) & 127, b = item >> 9, ch0 = cb * 256;
#pragma unroll
        for (int j = 0; j < 2; ++j) { const int task = tid + 512 * j, cblk = task & 31, lb = task >> 5;
#pragma unroll
            for (int r = 0; r < 4; ++r) xp[j][r] = *(const u32x4*)(P + ((size_t)b * SEQ + 128 * (4 * lb + r) + l2) * PW + 3072 + ch0 + 8 * cblk); } };
    if ((int)blockIdx.x < 1024) f1_load(blockIdx.x);
    for (int item = blockIdx.x; item < 1024; item += gridDim.x) {
        const int cb = item & 3, l2 = (item >> 2) & 127, b = item >> 9, ch0 = cb * 256;
#pragma unroll
        for (int j = 0; j < 2; ++j) { const int task = tid + 512 * j, cblk = task & 31, lb = task >> 5; store_t4x8(XT, 8 * cblk, 4 * lb, xp[j]); }
        if (item + (int)gridDim.x < 1024) f1_load(item + gridDim.x);
        __syncthreads();
        const f32x2 tw = TW[l2 * k1];
        LAS unsigned char* ost = lds + 69632 + wave * 8448;
        u32x2 wim[16];
#pragma unroll
        for (int mt = 0; mt < 16; ++mt) {
            f32x4 cr = {0.f, 0.f, 0.f, 0.f}, cs = {0.f, 0.f, 0.f, 0.f};
#pragma unroll
            for (int ks = 0; ks < 4; ++ks) { const bf16x8 xa = ldfrag_sw(XT, 16 * mt, 4 * ks + q, lane); cr = MFMA16(xa, fc[ks], cr); cs = MFMA16(xa, fs[ks], cs); }
            const f32x4 br = cr * tw.x - cs * tw.y, bi = -(cs * tw.x + cr * tw.y);
            u32x2 wr_; wr_.x = pk2(br[0], br[1]); wr_.y = pk2(br[2], br[3]); wim[mt].x = pk2(bi[0], bi[1]); wim[mt].y = pk2(bi[2], bi[3]);
            *(LAS u32x2*)(ost + cidx * 528 + (16 * mt + 4 * q) * 2) = wr_;
        }
        const size_t obase = (((size_t)b * 128 + 16 * wave) * 128 + l2) * 1024 + ch0;
#pragma unroll
        for (int i = 0; i < 8; ++i) { const int row = 2 * i + (lane >> 5), ck = lane & 31; const u32x4 v = *(const LAS u32x4*)(ost + row * 528 + ck * 16); *(u32x4*)(A1r + obase + (size_t)row * 128 * 1024 + 8 * ck) = v; }
#pragma unroll
        for (int mt = 0; mt < 16; ++mt) *(LAS u32x2*)(ost + cidx * 528 + (16 * mt + 4 * q) * 2) = wim[mt];
#pragma unroll
        for (int i = 0; i < 8; ++i) { const int row = 2 * i + (lane >> 5), ck = lane & 31; const u32x4 v = *(const LAS u32x4*)(ost + row * 528 + ck * 16); *(u32x4*)(A1i + obase + (size_t)row * 128 * 1024 + 8 * ck) = v; }
        __syncthreads();
    }
}
__device__ __forceinline__ void phase_f34(const Args& a, LAS unsigned char* lds) {
    const int tid = threadIdx.x, lane = tid & 63, wave = __builtin_amdgcn_readfirstlane(tid >> 6), q = lane >> 4, cidx = lane & 15;
    const bf16* A1r = (const bf16*)(a.ws + WS_FA); const bf16* A1i = (const bf16*)(a.ws + WS_FAI); bf16* Y = (bf16*)(a.ws + WS_YCAT);
    LAS bf16* XTr = (LAS bf16*)lds; LAS bf16* XTi = XTr + 128 * FLD; LAS bf16* XKr = XTi + 128 * FLD; LAS bf16* XKi = XKr + 128 * FLD;
    bf16x8 fc[4], fs[4]; load_dft_frags(a.ws, wave, lane, fc, fs);
    const float nrm = 1.0f / 1448.15468787005f;
    u32x4 xr[4], xi[4];
    auto f34_load = [&](int item) { const int g = item & 7, k1 = (item >> 3) & 127, b = item >> 10, ch0 = g * 128; const int cblk = tid & 15, lb = tid >> 4;
#pragma unroll
        for (int r = 0; r < 4; ++r) { const size_t off = (((size_t)b * 128 + k1) * 128 + 4 * lb + r) * 1024 + ch0 + 8 * cblk; xr[r] = *(const u32x4*)(A1r + off); xi[r] = *(const u32x4*)(A1i + off); } };
    if ((int)blockIdx.x < 2048) f34_load(blockIdx.x);
    for (int item = blockIdx.x; item < 2048; item += gridDim.x) {
        const int g = item & 7, k1 = (item >> 3) & 127, b = item >> 10, ch0 = g * 128;
        { const int cblk = tid & 15, lb = tid >> 4; store_t4x8(XTr, 8 * cblk, 4 * lb, xr); store_t4x8(XTi, 8 * cblk, 4 * lb, xi); }
        if (item + (int)gridDim.x < 2048) f34_load(item + gridDim.x);
        __syncthreads();
        const int k2 = 16 * wave + cidx;
#pragma unroll 2
        for (int mt = 0; mt < 8; ++mt) {
            f32x4 a1 = {0.f, 0.f, 0.f, 0.f}, a2 = a1, b1 = a1, b2 = a1;
#pragma unroll
            for (int ks = 0; ks < 4; ++ks) { const bf16x8 xa = ldfrag_sw(XTr, 16 * mt, 4 * ks + q, lane); const bf16x8 xb = ldfrag_sw(XTi, 16 * mt, 4 * ks + q, lane);
                a1 = MFMA16(xa, fc[ks], a1); b2 = MFMA16(xa, fs[ks], b2); a2 = MFMA16(xb, fs[ks], a2); b1 = MFMA16(xb, fc[ks], b1); }
            const f32x4 xre = a1 + a2, xim = b1 - b2;
            u32x2 wr_; wr_.x = pk2(xre[0], xre[1]); wr_.y = pk2(xre[2], xre[3]); u32x2 wi_; wi_.x = pk2(xim[0], xim[1]); wi_.y = pk2(xim[2], xim[3]);
            *(LAS u32x2*)(XKr + k2 * FLD + 16 * mt + 4 * q) = wr_; *(LAS u32x2*)(XKi + k2 * FLD + 16 * mt + 4 * q) = wi_;
        }
        __syncthreads();
#pragma unroll 2
        for (int nt = 0; nt < 8; ++nt) {
            f32x4 y = {0.f, 0.f, 0.f, 0.f};
#pragma unroll
            for (int ks = 0; ks < 4; ++ks) { const bf16x8 xa = *(const LAS bf16x8*)(XKr + (16 * nt + cidx) * FLD + ks * 32 + 8 * q); const bf16x8 xb = *(const LAS bf16x8*)(XKi + (16 * nt + cidx) * FLD + ks * 32 + 8 * q);
                y = MFMA16(fc[ks], xa, y); y = MFMA16(fs[ks], xb, y); }
            u32x2 w; w.x = pk2(y[0] * nrm, y[1] * nrm); w.y = pk2(y[2] * nrm, y[3] * nrm);
            *(LAS u32x2*)(XTr + (16 * nt + cidx) * FLD + 16 * wave + 4 * q) = w;
        }
        __syncthreads();
#pragma unroll
        for (int i = 0; i < 4; ++i) { const int task = tid + 512 * i, row = task >> 4, ck = task & 15; const u32x4 v = *(const LAS u32x4*)(XTr + row * FLD + 8 * ck);
            *(u32x4*)(Y + ((size_t)b * SEQ + k1 + 128 * row) * DM + 1024 + ch0 + 8 * ck) = v; }
        __syncthreads();
    }
}

__device__ __forceinline__ void phase_topk(const Args& a, LAS unsigned char* lds) {
    const int tid = threadIdx.x, lane = tid & 63, wave = tid >> 6;
    LAS unsigned* keys = (LAS unsigned*)lds;
    LAS unsigned* hist = (LAS unsigned*)(lds + 65536);
    LAS unsigned* misc = hist + 256;
    LAS unsigned* wtot = misc + 16;
    const float* AFF = (const float*)(a.ws + WS_AFF); int* TOK = (int*)(a.ws + WS_TOK); float* GATE = (float*)(a.ws + WS_GATE); int* SEL = (int*)(a.ws + WS_SEL);
    for (int be = blockIdx.x; be < NB * NE; be += gridDim.x) {
        const int b = be / NE, e = be % NE;
        for (int i = tid; i < SEQ; i += NTHREADS) keys[i] = __float_as_uint(AFF[(size_t)be * SEQ + i]);
        unsigned prefix = 0u, pmask = 0u, krem = CAP;
        for (int pass = 0; pass < 4; ++pass) {
            const int shift = 24 - 8 * pass;
            if (tid < 256) hist[tid] = 0u;
            __syncthreads();
            for (int i = tid; i < SEQ; i += NTHREADS) { const unsigned k = keys[i]; if ((k & pmask) == prefix) __hip_atomic_fetch_add(&hist[(k >> shift) & 255u], 1u, __ATOMIC_RELAXED, __HIP_MEMORY_SCOPE_WORKGROUP); }
            __syncthreads();
            if (wave == 0) {
                const unsigned h0 = hist[4 * lane], h1 = hist[4 * lane + 1], h2 = hist[4 * lane + 2], h3 = hist[4 * lane + 3];
                const unsigned sl = h0 + h1 + h2 + h3; unsigned S = sl;
#pragma unroll
                for (int o = 1; o < 64; o <<= 1) { const unsigned t = __shfl_down(S, o); if (lane + o < 64) S += t; }
                const unsigned long long m = __ballot(S >= krem);
                const int ls = 63 - __builtin_clzll(m);
                if (lane == ls) { unsigned cum = S - sl; int bsel;
                    if (cum + h3 >= krem) bsel = 3; else { cum += h3; if (cum + h2 >= krem) bsel = 2; else { cum += h2; if (cum + h1 >= krem) bsel = 1; else { cum += h1; bsel = 0; } } }
                    misc[0] = prefix | ((unsigned)(4 * lane + bsel) << shift); misc[1] = krem - cum; }
            }
            __syncthreads();
            prefix = misc[0]; krem = misc[1]; pmask |= (0xffu << shift);
            __syncthreads();
        }
        const unsigned T = prefix;
        unsigned cg_ = 0u, ce = 0u;
        for (int i = 0; i < 32; ++i) { const unsigned k = keys[tid * 32 + i]; cg_ += (k > T); ce += (k == T); }
        unsigned ig = cg_, ie = ce;
#pragma unroll
        for (int o = 1; o < 64; o <<= 1) { const unsigned tg = __shfl_up(ig, o), te = __shfl_up(ie, o); if (lane >= o) { ig += tg; ie += te; } }
        if (lane == 63) { wtot[wave * 2] = ig; wtot[wave * 2 + 1] = ie; }
        __syncthreads();
        unsigned gt_before = ig - cg_, eq_before = ie - ce;
        for (int w8 = 0; w8 < wave; ++w8) { gt_before += wtot[w8 * 2]; eq_before += wtot[w8 * 2 + 1]; }
        for (int i = 0; i < 32; ++i) { const int t = tid * 32 + i; const unsigned k = keys[t];
            const bool isgt = k > T, iseq = k == T; const bool take = isgt || (iseq && eq_before < krem);
            const unsigned slot = gt_before + (eq_before < krem ? eq_before : krem);
            if (take) { TOK[(size_t)be * CAP + slot] = t; GATE[(size_t)be * CAP + slot] = __uint_as_float(k); }
            SEL[((size_t)b * SEQ + t) * NE + e] = take ? (int)slot : -1;
            gt_before += isgt; eq_before += iseq; }
        __syncthreads();
    }
}

__device__ __forceinline__ void acc_yrow(f32x4 (&m)[8], const u32x2 (&w)[8], float gt) {
#pragma unroll
    for (int j = 0; j < 8; ++j) { m[j].x += gt * __uint_as_float(w[j].x << 16); m[j].y += gt * __uint_as_float(w[j].x & 0xffff0000u); m[j].z += gt * __uint_as_float(w[j].y << 16); m[j].w += gt * __uint_as_float(w[j].y & 0xffff0000u); }
}
__device__ __forceinline__ void phase_final(const Args& a) {
    const int tid = threadIdx.x, lane = tid & 63, wave = tid >> 6;
    const int gw = blockIdx.x * 8 + wave, NGW = gridDim.x * 8;
    const float* ada = (const float*)(a.ws + WS_ADA); const float* fg = a.in[19];
    const float* X = a.in[0]; const bf16* DL = (const bf16*)(a.ws + WS_DLT); const bf16* YE = (const bf16*)(a.ws + WS_YE);
    const float* GATE = (const float*)(a.ws + WS_GATE); const int* SEL = (const int*)(a.ws + WS_SEL);
    int r = gw;
    int sel = -1; if (r < NLAT && lane < NE) sel = SEL[(size_t)r * NE + lane];
    for (; r < NLAT; r += NGW) {
        const int b = r / SEQ;
        const float* g2 = ada + (size_t)b * 12288 + 5 * DM;
        u32x2 dl[8];
#pragma unroll
        for (int j = 0; j < 8; ++j) dl[j] = *(const u32x2*)(DL + (size_t)r * DM + 256 * j + 4 * lane);
        const float gt = sel >= 0 ? GATE[((size_t)b * NE + lane) * CAP + sel] : 0.f;
        const int myrow = sel >= 0 ? (lane * 2 + b) * CAP + sel : 0;
        unsigned long long mask = __ballot(sel >= 0);
        { const int rn = r + NGW; sel = -1; if (rn < NLAT && lane < NE) sel = SEL[(size_t)rn * NE + lane]; }
        f32x4 m[8];
#pragma unroll
        for (int j = 0; j < 8; ++j) m[j] = (f32x4){0.f, 0.f, 0.f, 0.f};
        while (mask) {
            const int e0 = __builtin_ctzll(mask); mask &= mask - 1;
            const int has1 = mask != 0ull; const int e1 = has1 ? __builtin_ctzll(mask) : e0; if (has1) mask &= mask - 1;
            const int row0 = __builtin_amdgcn_readlane(myrow, e0), row1 = __builtin_amdgcn_readlane(myrow, e1);
            const float g0 = __builtin_bit_cast(float, __builtin_amdgcn_readlane(__builtin_bit_cast(int, gt), e0));
            const float g1 = has1 ? __builtin_bit_cast(float, __builtin_amdgcn_readlane(__builtin_bit_cast(int, gt), e1)) : 0.f;
            const bf16* y0 = YE + (size_t)row0 * DM + 4 * lane; const bf16* y1 = YE + (size_t)row1 * DM + 4 * lane;
            u32x2 w0[8], w1[8];
#pragma unroll
            for (int j = 0; j < 8; ++j) { w0[j] = *(const u32x2*)(y0 + 256 * j); w1[j] = *(const u32x2*)(y1 + 256 * j); }
            acc_yrow(m, w0, g0); acc_yrow(m, w1, g1);
        }
        float ss = 0.f;
#pragma unroll
        for (int j = 0; j < 8; ++j) { const int d = 256 * j + 4 * lane; const f32x4 gv = *(const f32x4*)(g2 + d);
            const f32x4 dv = {__uint_as_float(dl[j].x << 16), __uint_as_float(dl[j].x & 0xffff0000u), __uint_as_float(dl[j].y << 16), __uint_as_float(dl[j].y & 0xffff0000u)};
            m[j] = dv + gv * m[j]; ss += (m[j].x * m[j].x + m[j].y * m[j].y) + (m[j].z * m[j].z + m[j].w * m[j].w); }
        const float rstd = rsqrtf(wave_sum(ss) * (1.f / DM) + EPS);
#pragma unroll
        for (int j = 0; j < 8; ++j) { const int d = 256 * j + 4 * lane; const f32x4 gv = *(const f32x4*)(fg + d);
            *(f32x4*)(a.out + (size_t)r * DM + d) = m[j] * rstd * gv; }
    }
}

#define XB_TMO      128
#define XB_XCNT(j)  (256  + 64 * (j))
#define XB_XSUB(j)  (1280 + 64 * (j))
#define XB_XGEN(j)  (2304 + 64 * (j))
#define XB_TOP      3328
#define XB_TOPGEN   3392
#define XCD_BAR_WORDS 3456
#define XB_SPIN_CAP (1u << 18)
__device__ __forceinline__ unsigned xb_ld(unsigned* p)              { return __hip_atomic_load(p, __ATOMIC_RELAXED, __HIP_MEMORY_SCOPE_AGENT); }
__device__ __forceinline__ unsigned xb_add(unsigned* p, unsigned v) { return __hip_atomic_fetch_add(p, v, __ATOMIC_RELAXED, __HIP_MEMORY_SCOPE_AGENT); }
__device__ __forceinline__ unsigned xb_xcc_id() { return (unsigned)__builtin_amdgcn_s_getreg((3 << 11) | 20) & 0xFu; }
#define XB_SPIN(cond, bar) do { unsigned _sp = 0; while (cond) { __builtin_amdgcn_s_sleep(1); \
    if ((++_sp & 255u) == 0u) { if (xb_ld(&(bar)[XB_TMO])) break; if (_sp > XB_SPIN_CAP) { atomicAdd(&(bar)[XB_TMO], 1u); break; } } } } while (0)
struct XcdBarrier { unsigned* bar; unsigned x; volatile LAS unsigned* st; };
__device__ __forceinline__ XcdBarrier xcd_barrier_post(unsigned* bar, volatile LAS unsigned* st) {
    XcdBarrier b; b.bar = bar; b.x = xb_xcc_id(); b.st = st;
    if (threadIdx.x == 0) (void)xb_add(&bar[XB_XCNT(b.x)], 1u);
    return b;
}
__device__ __forceinline__ void xcd_barrier_complete(unsigned* bar, unsigned x, unsigned& nloc, unsigned& nx) {
    const unsigned G = gridDim.x * gridDim.y * gridDim.z;
    unsigned sum, cnt, mine, sp = 0u;
    for (;;) {
        sum = 0u; cnt = 0u; mine = 0u;
#pragma unroll
        for (unsigned j = 0; j < 16; ++j) { const unsigned c = xb_ld(&bar[XB_XCNT(j)]); sum += c; cnt += (c > 0u) ? 1u : 0u; mine = (j == x) ? c : mine; }
        if (sum == G) break;
        __builtin_amdgcn_s_sleep(1);
        if ((++sp & 255u) == 0u) { if (xb_ld(&bar[XB_TMO])) break; if (sp > XB_SPIN_CAP) { atomicAdd(&bar[XB_TMO], 1u); break; } }
    }
    nloc = mine > 0u ? mine : 1u; nx = cnt > 0u ? cnt : 1u;
}
__device__ __forceinline__ void xcd_barrier(const XcdBarrier& b) {
    asm volatile("s_waitcnt vmcnt(0)" ::: "memory");
    __syncthreads();
    if (threadIdx.x == 0) {
        unsigned* bar = b.bar;
        __builtin_amdgcn_s_waitcnt(0);
        unsigned nloc = b.st[0], nx = b.st[1];
        if (nloc == 0u) { xcd_barrier_complete(bar, b.x, nloc, nx); b.st[0] = nloc; b.st[1] = nx; }
        const unsigned old = xb_add(&bar[XB_XSUB(b.x)], 1u);
        const unsigned gen = old / nloc;
        if (old + 1u == (gen + 1u) * nloc) {
            __builtin_amdgcn_fence(__ATOMIC_RELEASE, "agent");
            asm volatile("s_waitcnt vmcnt(0)" ::: "memory");
            const unsigned og = xb_add(&bar[XB_TOP], 1u);
            const unsigned tg = og / nx;
            if (og + 1u == (tg + 1u) * nx) xb_add(&bar[XB_TOPGEN], 1u);
            else XB_SPIN(xb_ld(&bar[XB_TOPGEN]) == tg, bar);
            __builtin_amdgcn_fence(__ATOMIC_ACQUIRE, "agent");
            xb_add(&bar[XB_XGEN(b.x)], 1u);
            asm volatile("s_waitcnt vmcnt(0)" ::: "memory");
        } else {
            XB_SPIN(xb_ld(&bar[XB_XGEN(b.x)]) == gen, bar);
            __builtin_amdgcn_fence(__ATOMIC_ACQUIRE, "agent");
            asm volatile("s_waitcnt vmcnt(0)" ::: "memory");
        }
    }
    __syncthreads();
}

#ifndef STAGGER_US
#define STAGGER_US 0
#endif
__device__ __forceinline__ void gemm_stagger() {
    if (STAGGER_US > 0 && (blockIdx.x & 1)) { const unsigned long long t0 = __builtin_amdgcn_s_memrealtime();
        while (__builtin_amdgcn_s_memrealtime() - t0 < (unsigned long long)(STAGGER_US * 100)) __builtin_amdgcn_s_sleep(32); }
}
constexpr int NPHASES = 15;
__global__ void __launch_bounds__(NTHREADS, 2) mega(Args a) {
    extern __shared__ __attribute__((aligned(16))) unsigned char lds_raw[];
    LAS unsigned char* lds = (LAS unsigned char*)lds_raw;
    const int lo = a.ph_lo, hi = a.ph_hi;
    unsigned char* ws = a.ws;
#if USE_CG_SYNC
    cg::grid_group grid = cg::this_grid();
#define GRID_SYNC() grid.sync()
#else
    volatile LAS unsigned* bst = (volatile LAS unsigned*)(lds + LDS_BYTES - 16);
    if (threadIdx.x < 2) bst[threadIdx.x] = 0u;
    __syncthreads();
    XcdBarrier xbar = xcd_barrier_post((unsigned*)(ws + WS_CTL), bst);
#define GRID_SYNC() xcd_barrier(xbar)
#endif
#define IN(k) (lo <= (k) && (k) < hi)
#define SEAM(k) do { if (IN(k) && IN((k) + 1)) GRID_SYNC(); } while (0)
#define PH(k, ...) do { if (IN(k)) { __VA_ARGS__; if ((PROBE_MASK >> (k)) & 1u) { GRID_SYNC(); __VA_ARGS__; } } SEAM(k); } while (0)
    PH(0, phase0(a, lds));
    PH(1, {
        finalize_ada(a);
        const int nsp = gridDim.x >= 64 ? 12 : 0, nreg = gridDim.x - nsp;
        if ((int)blockIdx.x >= nreg) {
            const int si = blockIdx.x - nreg, b = si / 6, pn = 2 + si % 6;
            if (threadIdx.x < 64) { unsigned* cnt = (unsigned*)(ws + WS_CTL) + CW_CTXCNT + 64 * b; unsigned sp = 0;
                while ((unsigned)__builtin_amdgcn_readfirstlane(__hip_atomic_load(cnt, __ATOMIC_RELAXED, __HIP_MEMORY_SCOPE_AGENT)) < 16u) { __builtin_amdgcn_s_sleep(4); if (++sp > (1u << 22)) break; }
                __builtin_amdgcn_fence(__ATOMIC_ACQUIRE, "agent");
                asm volatile("s_waitcnt vmcnt(0)" ::: "memory"); }
            __syncthreads();
            SchedOne S; S.A = (const char*)(ws + WS_H); S.B = (const char*)(ws + WS_WIN); S.tstep = (size_t)256 * DM * 2; S.pm = NLAT / 256 + b; S.pn = pn;
            EpiInProj E{(bf16*)(ws + WS_P)};
            pg8::gemm_phase<EpiInProj, SchedOne, false, true, true>(lds, DM, S, E);
        } else phase_norm_tile<0>(a, lds, blockIdx.x, nreg, NROWS / 16); });
    PH(2, {
        gemm_stagger();
        SchedPlain S; S.init((gridDim.x >= 64 ? NLAT : NROWS) / 256, WIN_ROWS / 256, gridDim.x, blockIdx.x); S.A = (const char*)(ws + WS_H); S.B = (const char*)(ws + WS_WIN); S.tstep = (size_t)256 * DM * 2;
        EpiInProj E{(bf16*)(ws + WS_P)};
        pg8::gemm_phase<EpiInProj, SchedPlain, false, true, true>(lds, DM, S, E); });
    PH(3, { for (int it = blockIdx.x; it < 272; it += gridDim.x) gla_passA(a, lds, it); });
    PH(4, gla_passB(a));
    PH(5, { for (int it = blockIdx.x; it < 256; it += gridDim.x) gla_passC(a, lds, it); });
    PH(6, phase_gla_merge(a));
    PH(7, phase_f1(a, lds));
    PH(8, phase_f34(a, lds));
    PH(9, {
        gemm_stagger();
        SchedPlain S; S.init(NLAT / 256, DM / 256, gridDim.x, blockIdx.x); S.A = (const char*)(ws + WS_YCAT); S.B = (const char*)(ws + WS_WOUT); S.tstep = (size_t)256 * DM * 2;
        EpiOutProj E{a.in[0], (bf16*)(ws + WS_DLT), (const float*)(ws + WS_ADA)};
        pg8::gemm_phase<EpiOutProj, SchedPlain, false, true, true>(lds, DM, S, E); });
    PH(10, phase_norm_tile<1>(a, lds, blockIdx.x, gridDim.x, NLAT / 16));
    PH(11, phase_topk(a, lds));
    PH(12, {
        gemm_stagger();
        SchedMoeUp S; S.init(256, 8, gridDim.x, blockIdx.x); S.A = (const char*)(ws + WS_HF); S.B = (const char*)(ws + WS_WGU); S.tok = (const int*)(ws + WS_TOK);
        EpiSwiglu E{(bf16*)(ws + WS_HID)};
        pg8::gemm_phase<EpiSwiglu, SchedMoeUp, true, true, true>(lds, DM, S, E); });
    PH(13, {
        gemm_stagger();
        SchedMoeDown S; S.init(256, 8, gridDim.x, blockIdx.x); S.A = (const char*)(ws + WS_HID); S.B = (const char*)(ws + WS_WD);
        EpiBf16 E{(bf16*)(ws + WS_YE), DM};
        pg8::gemm_phase<EpiBf16, SchedMoeDown, false, true, true>(lds, DEXP, S, E); });
    PH(14, phase_final(a));
#undef PH
#undef IN
#undef SEAM
}

#ifndef N_LAUNCH_MODE
#define N_LAUNCH_MODE 1
#endif
extern "C" void kernel_launch(void* const* d_in, const int* in_sizes, int n_in, void* d_out, int out_size, void* d_ws, size_t ws_size, hipStream_t stream) {
    static int grid = 0;
    if (grid == 0) {
        if (n_in != 20 || out_size != NLAT * DM || ws_size < WS_END) { fprintf(stderr, "kernel_launch: unexpected sizes n_in %d out %d ws %zu\n", n_in, out_size, ws_size); grid = -1; return; }
        int dev = 0, cus = 0, per_cu = 0;
        (void)hipGetDevice(&dev); (void)hipDeviceGetAttribute(&cus, hipDeviceAttributeMultiprocessorCount, dev);
        if (hipFuncSetAttribute((const void*)mega, hipFuncAttributeMaxDynamicSharedMemorySize, LDS_BYTES) != hipSuccess) { fprintf(stderr, "kernel_launch: hipFuncSetAttribute failed\n"); grid = -1; return; }
        (void)hipOccupancyMaxActiveBlocksPerMultiprocessor(&per_cu, (const void*)mega, NTHREADS, LDS_BYTES);
        if (per_cu < 1) { fprintf(stderr, "kernel_launch: occupancy query reports %d blocks per CU\n", per_cu); per_cu = 1; }
        (void)hipGetLastError();
        grid = cus * 1;
    }
    if (grid < 0) return;
    Args a{};
    for (int i = 0; i < 20; ++i) a.in[i] = (const float*)d_in[i];
    a.out = (float*)d_out; a.ws = (unsigned char*)d_ws;
#if N_LAUNCH_MODE == 0
    for (int p = 0; p < NPHASES; ++p) { a.ph_lo = p; a.ph_hi = p + 1; hipLaunchKernelGGL(mega, dim3(grid), dim3(NTHREADS), LDS_BYTES, stream, a); }
#else
    a.ph_lo = 0; a.ph_hi = NPHASES;
#if USE_CG_SYNC
    void* args[] = {&a};
    hipError_t e = hipLaunchCooperativeKernel((void*)mega, dim3(grid), dim3(NTHREADS), args, LDS_BYTES, stream);
    if (e != hipSuccess) fprintf(stderr, "cooperative launch failed: %s (grid %d)\n", hipGetErrorString(e), grid);
#else
    if (hipMemsetAsync((char*)d_ws + WS_CTL, 0, CTL_BYTES, stream) != hipSuccess) { fprintf(stderr, "kernel_launch: memset of control words failed\n"); return; }
    hipLaunchKernelGGL(mega, dim3(grid), dim3(NTHREADS), LDS_BYTES, stream, a);
#endif
#endif
}
```

```cpp
#include <hip/hip_runtime.h>
#include <hip/hip_cooperative_groups.h>
#include <cstdio>
#include <cstdint>
namespace cg = cooperative_groups;

#define LAS __attribute__((address_space(3)))
typedef unsigned short bf16;
typedef short bf16x8 __attribute__((ext_vector_type(8)));
typedef float f32x4 __attribute__((ext_vector_type(4)));
typedef float f32x2 __attribute__((ext_vector_type(2)));
typedef unsigned u32x4 __attribute__((ext_vector_type(4)));
typedef unsigned u32x2 __attribute__((ext_vector_type(2)));

constexpr int NB = 2, SEQ = 16384, DM = 2048, CTXL = 256;
constexpr int NLAT = NB * SEQ;
constexpr int NROWS = NLAT + NB * CTXL;
constexpr int PROJW = 4128;
constexpr int NE = 16, CAP = 2048, DEXP = 1024;
constexpr int PW = 4096;
constexpr int WIN_ROWS = 4096;
constexpr float EPS = 1e-6f;

constexpr size_t MiB = 1u << 20;
constexpr size_t WS_ADA = 0;
constexpr size_t WS_TW = 1 * MiB;
constexpr size_t WS_FC = 1 * MiB + 256 * 1024;
constexpr size_t WS_FS = 1 * MiB + 320 * 1024;
constexpr size_t WS_WRH = 1 * MiB + 384 * 1024;
constexpr size_t WS_WRL = 1 * MiB + 448 * 1024;
constexpr size_t WS_Z = 2 * MiB;
constexpr size_t WS_AFF = 8 * MiB;
constexpr size_t WS_TOK = 10 * MiB;
constexpr size_t WS_GATE = 11 * MiB;
constexpr size_t WS_SEL = 12 * MiB;
constexpr size_t WS_ST0 = 14 * MiB;
constexpr size_t WS_CTL = 16 * MiB;
constexpr size_t CTL_BYTES = 65536;
constexpr size_t WS_ADAP = 20 * MiB;
constexpr size_t WS_TC = 24 * MiB;
constexpr size_t WS_DTC = 28 * MiB;
constexpr size_t WS_WIN = 32 * MiB;
constexpr size_t WS_WOUT = 50 * MiB;
constexpr size_t WS_WGU = 58 * MiB;
constexpr size_t WS_WD = 186 * MiB;
constexpr int KTOK = SEQ + CTXL;
constexpr size_t WS_QH = 250 * MiB;
constexpr size_t WS_KH = 282 * MiB;
constexpr size_t WS_VH = 316 * MiB;
constexpr size_t WS_G = 382 * MiB;
constexpr size_t WS_U = 446 * MiB;
constexpr size_t WS_HF = 250 * MiB;
constexpr size_t WS_HID = 378 * MiB;
constexpr size_t WS_FX = 250 * MiB;
constexpr size_t WS_FA = 894 * MiB;
constexpr size_t WS_FAI = 958 * MiB;
constexpr size_t WS_H = 510 * MiB;
constexpr size_t WS_OF = 510 * MiB;
constexpr size_t WS_OB = 574 * MiB;
constexpr size_t WS_T = 638 * MiB;
constexpr size_t WS_SST = 670 * MiB;
constexpr size_t WS_DT = 702 * MiB;
constexpr size_t WS_DLT = 510 * MiB;
constexpr size_t WS_YCAT = 766 * MiB;
constexpr size_t WS_YE = 766 * MiB;
constexpr size_t WS_END = 1022 * MiB;

#ifndef USE_CG_SYNC
#define USE_CG_SYNC 0
#endif
#ifndef PROBE_HALF
#define PROBE_HALF 0
#endif
#ifndef KSNAKE
#define KSNAKE 0
#endif
#ifndef PROBE_K
#define PROBE_K 0
#endif
#ifndef PROBE_EPI
#define PROBE_EPI 0
#endif
#ifndef PROBE_P0
#define PROBE_P0 0
#endif
#ifndef PROBE_MASK
#define PROBE_MASK 0u
#endif
constexpr int LDS_BYTES = 163840;
constexpr int NTHREADS = 512;

struct Args {
    const float* in[20];
    float* out;
    unsigned char* ws;
    int ph_lo, ph_hi;
};

__device__ __forceinline__ float bf2f(bf16 v) { return __uint_as_float(((unsigned)v) << 16); }
typedef __bf16 bf16x2_t __attribute__((ext_vector_type(2)));
__device__ __forceinline__ unsigned pk2(float lo, float hi) { const f32x2 v = {lo, hi}; return __builtin_bit_cast(unsigned, __builtin_convertvector(v, bf16x2_t)); }
__device__ __forceinline__ unsigned f2bf(float f) { return pk2(f, 0.f) & 0xffffu; }
__device__ __forceinline__ float wave_sum(float v) {
#pragma unroll
    for (int o = 1; o < 64; o <<= 1) v += __shfl_xor(v, o);
    return v;
}
__device__ __forceinline__ float silu_f(float x) { return x / (1.f + __expf(-x)); }
__device__ __forceinline__ float logsigmoid_f(float x) { return fminf(x, 0.f) - log1pf(expf(-fabsf(x))); }

namespace pg8 {
constexpr int BM = 256, BK = 64, HALF = 128, HTB = HALF * BK * 2, STAGE_BYTES = 8 * HTB, NXCD = 8, WGM = 8;
__host__ __device__ __forceinline__ int lds_byte(int r, int c) { const int st = (r >> 4) * 2 + (c >> 5), rr = r & 15, cc = c & 31, ob = rr * 64 + cc * 2; return st * 1024 + (ob ^ (((ob >> 9) & 1) << 5)); }
__host__ __device__ __forceinline__ void stage_rc(int b, int& R, int& C) { const int st = b / 1024, sb = b % 1024, swz = sb ^ (((sb >> 9) & 1) << 5); R = (st >> 1) * 16 + swz / 64; C = (st & 1) * 32 + (swz % 64) / 2; }
__host__ __device__ __forceinline__ int perm32(int rho) { const int n = rho >> 4, i = rho & 15; return 8 * (i >> 2) + 4 * n + (i & 3); }
struct Unit { int pm, pn; };
__device__ __forceinline__ unsigned cvt_pk_bf16(float lo, float hi) { return pk2(lo, hi); }

struct OrderBase {
    int nM, nN, nwg, G, c;
    __device__ void init(int nM_, int nN_, int G_, int c_) { nM = nM_; nN = nN_; nwg = nM * nN; G = G_; c = c_; }
    __device__ bool next(int i, Unit& u) const {
        const long L = (long)(i >> PROBE_K) * G + c; if (L >= nwg) return false;
        int wgid = (int)L; { const int q = nwg / NXCD, r = nwg % NXCD, xcd = wgid % NXCD, off = wgid / NXCD; wgid = (xcd < r ? xcd * (q + 1) : r * (q + 1) + (xcd - r) * q) + off; }
        const int nig = WGM * nN, gid = wgid / nig, fm = gid * WGM, gsz = (nM - fm) < WGM ? (nM - fm) : WGM;
        u.pm = fm + ((wgid % nig) % gsz); u.pn = (wgid % nig) / gsz; return true;
    }
};

template <class Epi, class Sched, bool GATHER, bool ALIGN_EPI, bool SP2>
__device__ __forceinline__ void gemm_phase(LAS unsigned char* lds, const int K, const Sched& S, const Epi& E) {
    const int tid = threadIdx.x, wid = __builtin_amdgcn_readfirstlane(tid >> 6), lane = tid & 63, wr = wid >> 2, wc = wid & 3, fr = lane & 15, fq = lane >> 4;
    const int nt = K / BK;
    unsigned voffA[2], voffA1[2], voffB[2];
    int RA[2], CA[2];
#pragma unroll
    for (int i = 0; i < 2; ++i) { int R, C; stage_rc(tid * 16 + i * 8192, R, C); const int Rb = Epi::PERM2 ? (64 * (R >> 5) + perm32(R & 31)) : (Epi::PERM ? ((R & ~31) + perm32(R & 31)) : R);
        RA[i] = R; CA[i] = C;
        voffA[i] = (unsigned)(R * K + C) * 2u; voffA1[i] = voffA[i]; voffB[i] = (unsigned)(Rb * K + C) * 2u; }
    const size_t kstep = (size_t)(BK * 2);
    const size_t hstepA = GATHER ? 0 : (size_t)HALF * K * 2;
    const size_t hstep = (size_t)(Epi::PERM2 ? 32 : HALF) * K * 2;
    const unsigned ldsw = (unsigned)wid * 1024u;
    const int aoff = lds_byte(wr * 64 + fr, fq * 8), boff = lds_byte(wc * 32 + fr, fq * 8);
#define PG8_SA(b, h) (((b) * 2 + (h)) * HTB)
#define PG8_SB(b, h) ((4 + (b) * 2 + (h)) * HTB)
#define PG8_STAGE(bufoff, gbase, voff) do { _Pragma("unroll") for (int _i = 0; _i < 2; ++_i) \
        __builtin_amdgcn_global_load_lds((const unsigned*)((const char*)(gbase) + (voff)[_i]), (LAS unsigned*)(lds + (bufoff) + ldsw + _i * 8192), 16, 0, 0); } while (0)
#define PG8_LDA(dst, b, h) do { _Pragma("unroll") for (int m = 0; m < 4; ++m) _Pragma("unroll") for (int k = 0; k < 2; ++k) dst[m][k] = *(const LAS bf16x8*)(lds + PG8_SA(b, h) + aoff + m * 2048 + k * 1024); } while (0)
#define PG8_LDB(dst, b, h) do { _Pragma("unroll") for (int n = 0; n < 2; ++n) _Pragma("unroll") for (int k = 0; k < 2; ++k) dst[n][k] = *(const LAS bf16x8*)(lds + PG8_SB(b, h) + boff + n * 2048 + k * 1024); } while (0)
#define PG8_MMA(ai, bj, At, Bt) do { __builtin_amdgcn_s_setprio(1); _Pragma("unroll") for (int m = 0; m < 4; ++m) _Pragma("unroll") for (int n = 0; n < 2; ++n) _Pragma("unroll") for (int k = 0; k < 2; ++k) \
        acc[ai][bj][m][n] = __builtin_amdgcn_mfma_f32_16x16x32_bf16(Bt[n][k], At[m][k], acc[ai][bj][m][n], 0, 0, 0); __builtin_amdgcn_s_setprio(0); } while (0)
#define PG8_WAIT_V(n) asm volatile("s_waitcnt vmcnt(" #n ")" ::: "memory")
#define PG8_WAIT_L(n) asm volatile("s_waitcnt lgkmcnt(" #n ")" ::: "memory")
#define PG8_BAR __builtin_amdgcn_s_barrier()
#define PG8_SCHED __builtin_amdgcn_sched_barrier(0)
    Unit cur, nxt; int ui = 0;
    if (!S.next(0, cur)) return;
    f32x4 acc[2][2][4][2];
#pragma unroll
    for (int a = 0; a < 2; ++a)
#pragma unroll
        for (int b = 0; b < 2; ++b)
#pragma unroll
            for (int m = 0; m < 4; ++m)
#pragma unroll
                for (int n = 0; n < 2; ++n) acc[a][b][m][n] = (f32x4){0.f, 0.f, 0.f, 0.f};
    bf16x8 At[4][2], B0[2][2], B1[2][2];
    const long kspan = (long)(nt - 1) * (long)(BK * 2);
    long ck = (long)(BK * 2);
    const char* cA = S.abase(cur); const char* cB = S.bbase(cur);
    if constexpr (GATHER) {
#pragma unroll
        for (int i = 0; i < 2; ++i) { voffA[i] = ((unsigned)S.arow(cur, RA[i]) * (unsigned)K + (unsigned)CA[i]) * 2u; voffA1[i] = ((unsigned)S.arow(cur, HALF + RA[i]) * (unsigned)K + (unsigned)CA[i]) * 2u; }
    }
    static_assert(SP2, "only the SP2 loop is kept");
    PG8_STAGE(PG8_SB(0, 0), cB, voffB); PG8_STAGE(PG8_SB(0, 1), cB + hstep, voffB); PG8_STAGE(PG8_SA(0, 0), cA, voffA); PG8_STAGE(PG8_SA(0, 1), cA + hstepA, voffA1);
    if (wr == 1) PG8_BAR;
    PG8_WAIT_V(2); PG8_BAR;
    PG8_STAGE(PG8_SB(1, 0), cB + kstep, voffB); PG8_STAGE(PG8_SA(1, 0), cA + kstep, voffA); PG8_STAGE(PG8_SB(1, 1), cB + hstep + kstep, voffB);
    PG8_WAIT_V(6); PG8_BAR;
    for (;;) {
        const bool has_next = S.next(ui + 1, nxt);
        const bool nrev = KSNAKE && has_next && (((ui + 1) >> PROBE_K) & 1);
        const long nk = has_next ? (nrev ? -(long)(BK * 2) : (long)(BK * 2)) : ck;
        const char* nA = has_next ? S.abase(nxt) + (nrev ? kspan : 0) : cA; const char* nB = has_next ? S.bbase(nxt) + (nrev ? kspan : 0) : cB;
        for (int t = 0; t < nt; t += 2) {
            const bool last = (t == nt - 2);
            const char* a1 = cA + (long)(t + 1) * ck;
            const char* a2 = last ? nA : cA + (long)(t + 2) * ck; const char* b2 = last ? nB : cB + (long)(t + 2) * ck;
            const char* a3 = a2 + (last ? nk : ck); const char* b3 = b2 + (last ? nk : ck);
            PG8_LDB(B0, 0, 0); PG8_LDB(B1, 0, 1); PG8_SCHED; PG8_LDA(At, 0, 0); PG8_STAGE(PG8_SA(1, 1), a1 + hstepA, voffA1);
            if constexpr (GATHER) { if (last && has_next) {
#pragma unroll
                for (int i = 0; i < 2; ++i) { voffA[i] = ((unsigned)S.arow(nxt, RA[i]) * (unsigned)K + (unsigned)CA[i]) * 2u; voffA1[i] = ((unsigned)S.arow(nxt, HALF + RA[i]) * (unsigned)K + (unsigned)CA[i]) * 2u; } } }
            PG8_WAIT_V(8); PG8_WAIT_L(0); PG8_BAR; PG8_MMA(0, 0, At, B0); PG8_MMA(0, 1, At, B1); PG8_BAR; PG8_SCHED;
            PG8_LDA(At, 0, 1); PG8_STAGE(PG8_SB(0, 0), b2, voffB); PG8_STAGE(PG8_SB(0, 1), b2 + hstep, voffB); PG8_STAGE(PG8_SA(0, 0), a2, voffA);
            PG8_WAIT_V(8); PG8_WAIT_L(0); PG8_BAR; PG8_MMA(1, 0, At, B0); PG8_MMA(1, 1, At, B1); PG8_BAR; PG8_SCHED;
            PG8_LDB(B0, 1, 0); PG8_LDB(B1, 1, 1); PG8_SCHED; PG8_LDA(At, 1, 0); PG8_STAGE(PG8_SA(0, 1), a2 + hstepA, voffA1);
            PG8_WAIT_V(8); PG8_WAIT_L(0); PG8_BAR; PG8_MMA(0, 0, At, B0); PG8_MMA(0, 1, At, B1); PG8_BAR; PG8_SCHED;
            PG8_LDA(At, 1, 1); PG8_STAGE(PG8_SB(1, 0), b3, voffB); PG8_STAGE(PG8_SB(1, 1), b3 + hstep, voffB); PG8_STAGE(PG8_SA(1, 0), a3, voffA);
            PG8_WAIT_V(8); PG8_WAIT_L(0); PG8_BAR; PG8_MMA(1, 0, At, B0); PG8_MMA(1, 1, At, B1); PG8_BAR; PG8_SCHED;
        }
        if constexpr (ALIGN_EPI) { if (wr == 0) PG8_BAR; }
        if (!PROBE_K || (ui & 1)) E(acc, cur, wr, wc, fr, fq);
        if (PROBE_EPI == 1) { asm volatile("" ::: "memory"); E(acc, cur, wr, wc, fr, fq); }
        if (PROBE_EPI == 2) { asm volatile("s_waitcnt vmcnt(0)" ::: "memory"); }
        if (!has_next) break;
#pragma unroll
        for (int a = 0; a < 2; ++a)
#pragma unroll
            for (int b = 0; b < 2; ++b)
#pragma unroll
                for (int m = 0; m < 4; ++m)
#pragma unroll
                    for (int n = 0; n < 2; ++n) acc[a][b][m][n] = (f32x4){0.f, 0.f, 0.f, 0.f};
        cur = nxt; cA = nA; cB = nB; ck = nk; ++ui;
        if constexpr (ALIGN_EPI) { if (wr == 1) PG8_BAR; }
    }
    PG8_WAIT_V(0);
    if constexpr (!ALIGN_EPI) { if (wr == 0) PG8_BAR; }
    PG8_BAR;
#undef PG8_SA
#undef PG8_SB
#undef PG8_STAGE
#undef PG8_LDA
#undef PG8_LDB
#undef PG8_MMA
#undef PG8_WAIT_V
#undef PG8_WAIT_L
#undef PG8_BAR
#undef PG8_SCHED
}
}
using pg8::Unit;
using pg8::cvt_pk_bf16;
constexpr int HALF = pg8::HALF, BM = pg8::BM;

struct SchedPlain : pg8::OrderBase {
    const char* A; const char* B; size_t tstep;
    __device__ __forceinline__ const char* abase(const Unit& u) const { return A + (size_t)u.pm * tstep; }
    __device__ __forceinline__ const char* bbase(const Unit& u) const { return B + (size_t)u.pn * tstep; }
    __device__ __forceinline__ int arow(const Unit&, int) const { return 0; }
};
struct SchedOne {
    const char* A; const char* B; size_t tstep; int pm, pn;
    __device__ __forceinline__ bool next(int i, Unit& u) const { if ((i >> PROBE_K) != 0) return false; u.pm = pm; u.pn = pn; return true; }
    __device__ __forceinline__ const char* abase(const Unit& u) const { return A + (size_t)u.pm * tstep; }
    __device__ __forceinline__ const char* bbase(const Unit& u) const { return B + (size_t)u.pn * tstep; }
    __device__ __forceinline__ int arow(const Unit&, int) const { return 0; }
};
struct SchedMoeUp : pg8::OrderBase {
    const char* A; const char* B; const int* tok;
    __device__ __forceinline__ const char* abase(const Unit&) const { return A; }
    __device__ __forceinline__ const char* bbase(const Unit& u) const { return B + ((size_t)(u.pm >> 4) * 2048 + (size_t)u.pn * 256) * (size_t)(DM * 2); }
    __device__ __forceinline__ int arow(const Unit& u, int r) const { const int e = u.pm >> 4, b = (u.pm >> 3) & 1, mt = u.pm & 7; return b * SEQ + tok[(b * NE + e) * CAP + mt * 256 + r]; }
};
struct SchedMoeDown : pg8::OrderBase {
    const char* A; const char* B;
    __device__ __forceinline__ const char* abase(const Unit& u) const { return A + (size_t)u.pm * 256 * (size_t)(DEXP * 2); }
    __device__ __forceinline__ const char* bbase(const Unit& u) const { return B + ((size_t)(u.pm >> 4) * 2048 + (size_t)u.pn * 256) * (size_t)(DEXP * 2); }
    __device__ __forceinline__ int arow(const Unit&, int) const { return 0; }
};

__device__ __forceinline__ u32x4 swz_xor8(const u32x4 v) { u32x4 r;
    r.x = (unsigned)__builtin_amdgcn_ds_swizzle((int)v.x, 0x201F); r.y = (unsigned)__builtin_amdgcn_ds_swizzle((int)v.y, 0x201F);
    r.z = (unsigned)__builtin_amdgcn_ds_swizzle((int)v.z, 0x201F); r.w = (unsigned)__builtin_amdgcn_ds_swizzle((int)v.w, 0x201F); return r; }
__device__ __forceinline__ void store_pair_rows(bf16* rowp, size_t ld, int fr, const u32x4 w0, const u32x4 w1) {
    const bool hi = (fr & 8) != 0;
    const u32x4 r = swz_xor8(hi ? w0 : w1);
    bf16* p = rowp + (hi ? 32 : 0);
    *(u32x4*)(p) = hi ? r : w0;
    *(u32x4*)(p + 8 * ld) = hi ? w1 : r;
}
struct EpiInProj {
    static constexpr bool PERM = true, PERM2 = true;
    unsigned char* ws;
    __device__ __forceinline__ void operator()(const f32x4 (&acc)[2][2][4][2], const Unit& u, int wr, int wc, int fr, int fq) const {
        const int ct = wc * 64 + 8 * fq;
        const bool lat = u.pm < NLAT / 256; const int b = lat ? u.pm / (SEQ / 256) : u.pm - NLAT / 256, t0 = lat ? (u.pm % (SEQ / 256)) * 256 : SEQ;
        bf16* base; size_t ld;
        if (u.pn < 2) { const int h = 2 * u.pn + (ct >> 7); base = (bf16*)(ws + WS_QH) + ((size_t)(b * 4 + h) * SEQ + t0) * 128 + (ct & 127); ld = 128; }
        else if (u.pn < 4) { const int h = 2 * (u.pn - 2) + (ct >> 7); base = (bf16*)(ws + WS_KH) + ((size_t)(b * 4 + h) * KTOK + t0) * 128 + (ct & 127); ld = 128; }
        else if (u.pn < 8) { const int h = u.pn - 4; base = (bf16*)(ws + WS_VH) + ((size_t)(b * 4 + h) * KTOK + t0) * 256 + ct; ld = 256; }
        else if (u.pn < 12) { base = (bf16*)(ws + WS_G) + (size_t)(u.pm * BM) * 1024 + (u.pn - 8) * 256 + ct; ld = 1024; }
        else { base = (bf16*)(ws + WS_U) + (size_t)(u.pm * BM) * 1024 + (u.pn - 12) * 256 + ct; ld = 1024; }
#pragma unroll
        for (int ai = 0; ai < 2; ++ai)
#pragma unroll
            for (int m = 0; m < 4; ++m) { bf16* rowp = base + (size_t)(wr * 64 + ai * HALF + m * 16 + (fr & 7)) * ld;
                u32x4 w[2];
#pragma unroll
                for (int bj = 0; bj < 2; ++bj) { const f32x4 v0 = acc[ai][bj][m][0], v1 = acc[ai][bj][m][1];
                    w[bj].x = cvt_pk_bf16(v0[0], v0[1]); w[bj].y = cvt_pk_bf16(v0[2], v0[3]); w[bj].z = cvt_pk_bf16(v1[0], v1[1]); w[bj].w = cvt_pk_bf16(v1[2], v1[3]); }
                store_pair_rows(rowp, ld, fr, w[0], w[1]); }
    }
};
struct EpiOutProj {
    static constexpr bool PERM = true, PERM2 = true;
    const float* X; bf16* D; const float* ada;
    __device__ __forceinline__ void operator()(const f32x4 (&acc)[2][2][4][2], const Unit& u, int wr, int wc, int fr, int fq) const {
        const int row0 = u.pm * BM + wr * 64, col0 = u.pn * BM + wc * 64 + 8 * fq;
        const int b = (u.pm * BM) / SEQ;
        const float* g1 = ada + (size_t)b * 12288 + 2 * DM;
        f32x4 gv[2][2];
#pragma unroll
        for (int bj = 0; bj < 2; ++bj)
#pragma unroll
            for (int n = 0; n < 2; ++n) gv[bj][n] = *(const f32x4*)(g1 + col0 + 32 * bj + 4 * n);
#pragma unroll
        for (int ai = 0; ai < 2; ++ai)
#pragma unroll
            for (int m = 0; m < 4; ++m) { const size_t rbase = (size_t)(row0 + ai * HALF + m * 16);
                u32x4 w[2];
#pragma unroll
                for (int bj = 0; bj < 2; ++bj) { const size_t off = (rbase + fr) * DM + col0 + 32 * bj; const f32x4 x0 = *(const f32x4*)(X + off), x1 = *(const f32x4*)(X + off + 4);
                    const f32x4 v0 = x0 + acc[ai][bj][m][0] * gv[bj][0], v1 = x1 + acc[ai][bj][m][1] * gv[bj][1];
                    w[bj].x = cvt_pk_bf16(v0[0], v0[1]); w[bj].y = cvt_pk_bf16(v0[2], v0[3]); w[bj].z = cvt_pk_bf16(v1[0], v1[1]); w[bj].w = cvt_pk_bf16(v1[2], v1[3]); }
                store_pair_rows(D + (rbase + (fr & 7)) * DM + col0, DM, fr, w[0], w[1]);
                asm volatile("" ::: "memory"); }
    }
};
struct EpiSwiglu {
    static constexpr bool PERM = true, PERM2 = false;
    bf16* HID;
    __device__ __forceinline__ void operator()(const f32x4 (&acc)[2][2][4][2], const Unit& u, int wr, int wc, int fr, int fq) const {
        const int row0 = u.pm * BM + wr * 64 + fr, col0 = u.pn * 128 + wc * 32 + 8 * fq;
#pragma unroll
        for (int ai = 0; ai < 2; ++ai)
#pragma unroll
            for (int m = 0; m < 4; ++m) { bf16* rowp = HID + (size_t)(row0 + ai * HALF + m * 16) * DEXP + col0;
                f32x4 h0, h1;
#pragma unroll
                for (int j = 0; j < 4; ++j) { h0[j] = silu_f(acc[ai][0][m][0][j]) * acc[ai][1][m][0][j]; h1[j] = silu_f(acc[ai][0][m][1][j]) * acc[ai][1][m][1][j]; }
                u32x4 w; w.x = cvt_pk_bf16(h0[0], h0[1]); w.y = cvt_pk_bf16(h0[2], h0[3]); w.z = cvt_pk_bf16(h1[0], h1[1]); w.w = cvt_pk_bf16(h1[2], h1[3]);
                *(u32x4*)(rowp) = w; }
    }
};
struct EpiBf16 {
    static constexpr bool PERM = true, PERM2 = true;
    bf16* O; int ldc;
    __device__ __forceinline__ void operator()(const f32x4 (&acc)[2][2][4][2], const Unit& u, int wr, int wc, int fr, int fq) const {
        const int row0 = u.pm * BM + wr * 64 + (fr & 7), col0 = u.pn * BM + wc * 64 + 8 * fq;
#pragma unroll
        for (int ai = 0; ai < 2; ++ai)
#pragma unroll
            for (int m = 0; m < 4; ++m) { bf16* rowp = O + (size_t)(row0 + ai * HALF + m * 16) * ldc + col0;
                u32x4 w[2];
#pragma unroll
                for (int bj = 0; bj < 2; ++bj) { const f32x4 v0 = acc[ai][bj][m][0], v1 = acc[ai][bj][m][1];
                    w[bj].x = cvt_pk_bf16(v0[0], v0[1]); w[bj].y = cvt_pk_bf16(v0[2], v0[3]); w[bj].z = cvt_pk_bf16(v1[0], v1[1]); w[bj].w = cvt_pk_bf16(v1[2], v1[3]); }
                store_pair_rows(rowp, (size_t)ldc, fr, w[0], w[1]); }
    }
};

__device__ __forceinline__ void transpose_item(const float* src, int ldsrc, int scol0, int k0, bf16* dst, size_t drow0, int ldd, LAS float* scr, int lane) {
#pragma unroll 8
    for (int i = 0; i < 32; ++i) { const int kk = 2 * i + (lane >> 5); scr[kk * 33 + (lane & 31)] = src[(size_t)(k0 + kk) * ldsrc + scol0 + (lane & 31)]; }
    asm volatile("s_waitcnt lgkmcnt(0)" ::: "memory");
    const int c = lane & 7;
#pragma unroll
    for (int j = 0; j < 4; ++j) { const int n = (lane >> 3) + 8 * j; const LAS float* s = scr + (8 * c) * 33 + n;
        u32x4 o; o.x = pk2(s[0 * 33], s[1 * 33]); o.y = pk2(s[2 * 33], s[3 * 33]); o.z = pk2(s[4 * 33], s[5 * 33]); o.w = pk2(s[6 * 33], s[7 * 33]);
        *(u32x4*)(dst + (drow0 + n) * (size_t)ldd + k0 + 8 * c) = o; }
    asm volatile("s_waitcnt lgkmcnt(0)" ::: "memory");
}

struct T64 { const float* src; bf16* dst; int ldsrc, ldd; };
__device__ __forceinline__ T64 decode_t64(const Args& a, int r) {
    unsigned char* ws = a.ws; T64 t;
    if (r < 2048) { const int kb = r >> 6, nb = r & 63; const int scol = nb < 48 ? nb * 64 : 3104 + (nb - 48) * 64;
        t.src = a.in[7] + (size_t)(kb * 64) * PROJW + scol; t.ldsrc = PROJW; t.dst = (bf16*)(ws + WS_WIN) + (size_t)(nb * 64) * DM + kb * 64; t.ldd = DM; return t; }
    r -= 2048;
    if (r < 1024) { const int kb = r >> 5, nb = r & 31;
        t.src = a.in[13] + (size_t)(kb * 64) * DM + nb * 64; t.ldsrc = DM; t.dst = (bf16*)(ws + WS_WOUT) + (size_t)(nb * 64) * DM + kb * 64; t.ldd = DM; return t; }
    r -= 1024;
    if (r < 16384) { const int up = r >= 8192; if (up) r -= 8192; const int e = r >> 9, rr = r & 511, kb = rr >> 4, nb = rr & 15, n0 = nb * 64;
        t.src = (up ? a.in[17] : a.in[16]) + (size_t)e * DM * DEXP + (size_t)(kb * 64) * DEXP + n0; t.ldsrc = DEXP;
        t.dst = (bf16*)(ws + WS_WGU) + ((size_t)e * 2048 + (size_t)(n0 >> 7) * 256 + (n0 & 127) + (up ? 128 : 0)) * DM + kb * 64; t.ldd = DM; return t; }
    r -= 16384;
    { const int e = r >> 9, rr = r & 511, kb = rr >> 5, nb = rr & 31;
        t.src = a.in[18] + (size_t)e * DEXP * DM + (size_t)(kb * 64) * DM + nb * 64; t.ldsrc = DM;
        t.dst = (bf16*)(ws + WS_WD) + ((size_t)e * 2048 + nb * 64) * DEXP + kb * 64; t.ldd = DEXP; return t; }
}
__device__ __forceinline__ void t64_load(const T64& t, int lane, f32x4 (&v)[16]) {
    const int krow = lane >> 4, c4 = lane & 15;
#pragma unroll
    for (int i = 0; i < 16; ++i) v[i] = *(const f32x4*)(t.src + (size_t)(4 * i + krow) * t.ldsrc + 4 * c4);
}
__device__ __forceinline__ void t64_finish(const T64& t, int lane, const f32x4 (&v)[16], LAS float* scr) {
    const int krow = lane >> 4, c4 = lane & 15;
#pragma unroll
    for (int i = 0; i < 16; ++i) { LAS float* p = scr + (4 * i + krow) * 65 + 4 * c4; p[0] = v[i].x; p[1] = v[i].y; p[2] = v[i].z; p[3] = v[i].w; }
    asm volatile("s_waitcnt lgkmcnt(0)" ::: "memory");
    const int c = lane & 7;
#pragma unroll
    for (int j = 0; j < 8; ++j) { const int n = (lane >> 3) + 8 * j; const LAS float* s = scr + (8 * c) * 65 + n;
        u32x4 o; o.x = pk2(s[0 * 65], s[1 * 65]); o.y = pk2(s[2 * 65], s[3 * 65]); o.z = pk2(s[4 * 65], s[5 * 65]); o.w = pk2(s[6 * 65], s[7 * 65]);
        *(u32x4*)(t.dst + (size_t)n * t.ldd + 8 * c) = o; }
    asm volatile("s_waitcnt lgkmcnt(0)" ::: "memory");
}
constexpr int P0_NT64 = 2048 + 1024 + 16384 + 8192;
constexpr int P0_TAIL = 1024;
constexpr int P0_NGEMV = 192;
__device__ __forceinline__ void phase0(const Args& a, LAS unsigned char* lds) {
    const int tid = threadIdx.x, lane = tid & 63, wave = tid >> 6, G = gridDim.x, blk = blockIdx.x;
    unsigned char* ws = a.ws;
    {
        const float* c = a.in[1]; const float* cc = a.in[3]; const float* w_ada = a.in[4]; const float* b_ada = a.in[5];
        float* part = (float*)(ws + WS_ADAP);
        LAS float* red = (LAS float*)lds;
        for (int rep_ = 0; rep_ < 1 + (PROBE_P0 & 1); ++rep_)
        for (int it = blk; it < P0_NGEMV; it += G) {
            const int cb = it % 48, ks = it / 48, col0 = cb * 256 + 4 * lane, r0 = ks * 512 + wave * 64;
            f32x4 a0 = {0.f, 0.f, 0.f, 0.f}, a1 = a0, a2 = a0;
#pragma unroll 16
            for (int r = r0; r < r0 + 64; ++r) {
                const f32x4 w = *(const f32x4*)(w_ada + (size_t)r * 12288 + col0);
                const float s0 = silu_f(c[r]), s1 = silu_f(c[DM + r]), s2 = silu_f(cc[r]);
                a0 += w * s0; a1 += w * s1; a2 += w * s2;
            }
            *(LAS f32x4*)(red + (wave * 3 + 0) * 256 + 4 * lane) = a0; *(LAS f32x4*)(red + (wave * 3 + 1) * 256 + 4 * lane) = a1; *(LAS f32x4*)(red + (wave * 3 + 2) * 256 + 4 * lane) = a2;
            __syncthreads();
            for (int idx = tid; idx < 768; idx += NTHREADS) { const int v = idx >> 8, col = idx & 255; float s = ks == 0 ? b_ada[cb * 256 + col] : 0.f;
#pragma unroll
                for (int w8 = 0; w8 < 8; ++w8) s += red[(w8 * 3 + v) * 256 + col];
                part[(size_t)(ks * 3 + v) * 12288 + cb * 256 + col] = s; }
            __syncthreads();
        }
    }
    LAS float* scr = (LAS float*)(lds + wave * 16640);
    const int gw = blk * 8 + wave, NGW = G * 8;
    constexpr int I_WZ = 32, I_WR = 512, I_TW = 256, I_FT = 256;
    for (int it = gw; it < I_WZ + I_WR + I_TW + I_FT; it += NGW) {
        int r = it;
        if (r < I_WZ) { transpose_item(a.in[7], PROJW, 3072, r * 64, (bf16*)(ws + WS_WIN), (size_t)4096, DM, scr, lane); continue; }
        r -= I_WZ;
        if (r < I_WR) { const int p = r * 64 + lane, e = p >> 11, d = p & 2047; const float wv = a.in[15][d * 16 + e]; const unsigned hi = f2bf(wv); ((bf16*)(ws + WS_WRH))[p] = (bf16)hi; ((bf16*)(ws + WS_WRL))[p] = (bf16)f2bf(wv - bf2f((bf16)hi)); continue; }
        r -= I_WR;
        if (r < I_TW) { const int p = r * 64 + lane; float s, c; sincospif((float)p * (1.0f / 8192.0f), &s, &c); ((f32x2*)(ws + WS_TW))[p] = (f32x2){c, s}; continue; }
        r -= I_TW;
        { const int p = r * 64 + lane, k = p >> 7, l = p & 127; float s, c; sincospif((float)((k * l) & 127) * (1.0f / 64.0f), &s, &c); ((bf16*)(ws + WS_FC))[p] = (bf16)f2bf(c); ((bf16*)(ws + WS_FS))[p] = (bf16)f2bf(s); }
    }
    const int n_gemv_wg = G > P0_NGEMV ? P0_NGEMV : 0;
    const int head_end = n_gemv_wg ? P0_NT64 - P0_TAIL : P0_NT64;
    const int n_head = gw < head_end ? (head_end - gw + NGW - 1) / NGW : 0;
    const int tgw = (blk - n_gemv_wg) * 8 + wave, tstep = (G - n_gemv_wg) * 8;
    const int n_tail = (n_gemv_wg && blk >= n_gemv_wg && tgw < P0_TAIL) ? (P0_TAIL - tgw + tstep - 1) / tstep : 0;
    const int n_items = n_head + n_tail;
    auto item_of = [&](int j) -> int { return j < n_head ? gw + j * NGW : head_end + tgw + (j - n_head) * tstep; };
    for (int rep_ = 0; rep_ < 1 + ((PROBE_P0 >> 1) & 1); ++rep_) {
    f32x4 va[16], vb[16]; T64 ta, tb;
    if (n_items > 0) { ta = decode_t64(a, item_of(0)); t64_load(ta, lane, va); }
    for (int j = 0; j < n_items; j += 2) {
        const bool h1 = j + 1 < n_items, h2 = j + 2 < n_items;
        if (h1) { tb = decode_t64(a, item_of(j + 1)); t64_load(tb, lane, vb); }
        t64_finish(ta, lane, va, scr);
        if (h2) { ta = decode_t64(a, item_of(j + 2)); t64_load(ta, lane, va); }
        if (h1) t64_finish(tb, lane, vb, scr);
    }
    }
}

#define MFMA16(a, b, c) __builtin_amdgcn_mfma_f32_16x16x32_bf16((a), (b), (c), 0, 0, 0)
__device__ __forceinline__ void finalize_ada(const Args& a) {
    const float* part = (const float*)(a.ws + WS_ADAP); float* adaw = (float*)(a.ws + WS_ADA);
    for (int i = blockIdx.x * NTHREADS + threadIdx.x; i < 3 * 12288; i += gridDim.x * NTHREADS) { float s = 0.f;
#pragma unroll
        for (int ks = 0; ks < 4; ++ks) s += part[(size_t)ks * 3 * 12288 + i];
        adaw[i] = s; }
}
constexpr int CW_CTXCNT = 4096;
template <int MODE>
__device__ __forceinline__ void norm_load_tile(const Args& a, int tile, int rl, int wave, int q, f32x4 (&xv)[8][2], u32x4 (&dv)[8]) {
    const int r = tile * 16 + rl;
    if (MODE == 0) { const float* s = (r < NLAT ? a.in[0] + (size_t)r * DM : a.in[2] + (size_t)(r - NLAT) * DM) + 256 * wave + 8 * q;
#pragma unroll
        for (int ks = 0; ks < 8; ++ks) { xv[ks][0] = *(const f32x4*)(s + 32 * ks); xv[ks][1] = *(const f32x4*)(s + 32 * ks + 4); } }
    if (MODE == 1) { const bf16* dp = (const bf16*)(a.ws + WS_DLT) + (size_t)r * DM + 256 * wave + 8 * q;
#pragma unroll
        for (int ks = 0; ks < 8; ++ks) dv[ks] = *(const u32x4*)(dp + 32 * ks); }
}
template <int MODE>
__device__ __forceinline__ void phase_norm_tile(const Args& a, LAS unsigned char* lds, int first, int stride, int tile_end) {
    const int tid = threadIdx.x, lane = tid & 63, wave = __builtin_amdgcn_readfirstlane(tid >> 6), rl = lane & 15, q = lane >> 4;
    const float* ada = (const float*)(a.ws + WS_ADA);
    LAS float* gs = (LAS float*)lds;
    LAS float* shv = gs + 3 * DM;
    LAS float* ssred = shv + 3 * DM;
    LAS float* red = ssred + 128;
    { const float* gn = MODE == 0 ? a.in[6] : a.in[14]; const float* part = (const float*)(a.ws + WS_ADAP);
      for (int i = tid; i < 3 * DM; i += NTHREADS) { const int v = i / DM, d = i % DM;
          float sh_, sc_;
          if (MODE == 0) { const float* p0 = part + (size_t)v * 12288; sh_ = 0.f; sc_ = 0.f;
#pragma unroll
              for (int ks = 0; ks < 4; ++ks) { sh_ += p0[(size_t)ks * 3 * 12288 + d]; sc_ += p0[(size_t)ks * 3 * 12288 + DM + d]; } }
          else { const float* base = ada + (size_t)v * 12288 + 3 * DM; sh_ = base[d]; sc_ = base[DM + d]; }
          gs[i] = gn[d] * (1.f + sc_); shv[i] = sh_; }
    }
    bf16x8 wb[2][8];
    if (MODE == 0) { const bf16* Wz = (const bf16*)(a.ws + WS_WIN) + (size_t)4096 * DM;
#pragma unroll
        for (int nt = 0; nt < 2; ++nt)
#pragma unroll
            for (int ks = 0; ks < 8; ++ks) wb[nt][ks] = *(const bf16x8*)(Wz + (size_t)(16 * nt + rl) * DM + 256 * wave + 32 * ks + 8 * q);
    } else { const bf16* WH = (const bf16*)(a.ws + WS_WRH); const bf16* WL = (const bf16*)(a.ws + WS_WRL);
#pragma unroll
        for (int ks = 0; ks < 8; ++ks) { wb[0][ks] = *(const bf16x8*)(WH + (size_t)rl * DM + 256 * wave + 32 * ks + 8 * q); wb[1][ks] = *(const bf16x8*)(WL + (size_t)rl * DM + 256 * wave + 32 * ks + 8 * q); } }
    __syncthreads();
    bf16* Hout = (bf16*)(a.ws + (MODE == 0 ? WS_H : WS_HF));
    f32x4 xv[8][2]; u32x4 dv[8];
    auto tile_of = [&](int s) -> int { return MODE == 0 ? (s < 32 ? NLAT / 16 + s : s - 32) : s; };
    int sq = first;
    if (sq < tile_end) norm_load_tile<MODE>(a, tile_of(sq), rl, wave, q, xv, dv);
    for (; sq < tile_end; sq += stride) {
        const int tile = tile_of(sq);
        const int r = tile * 16 + rl;
        const int v = MODE == 0 ? (tile * 16 < NLAT ? (tile * 16) / SEQ : 2) : (tile * 16) / SEQ;
        if (MODE == 1) {
#pragma unroll
            for (int ks = 0; ks < 8; ++ks) { const u32x4 d = dv[ks];
                xv[ks][0] = (f32x4){__uint_as_float(d.x << 16), __uint_as_float(d.x & 0xffff0000u), __uint_as_float(d.y << 16), __uint_as_float(d.y & 0xffff0000u)};
                xv[ks][1] = (f32x4){__uint_as_float(d.z << 16), __uint_as_float(d.z & 0xffff0000u), __uint_as_float(d.w << 16), __uint_as_float(d.w & 0xffff0000u)}; } }
        float ss = 0.f;
#pragma unroll
        for (int ks = 0; ks < 8; ++ks) { const f32x4 a0 = xv[ks][0], a1 = xv[ks][1]; ss += (a0.x * a0.x + a0.y * a0.y) + (a0.z * a0.z + a0.w * a0.w) + (a1.x * a1.x + a1.y * a1.y) + (a1.z * a1.z + a1.w * a1.w); }
        ss += __shfl_xor(ss, 16); ss += __shfl_xor(ss, 32);
        if (q == 0) ssred[wave * 16 + rl] = ss;
        __syncthreads();
        float tot = 0.f;
#pragma unroll
        for (int w8 = 0; w8 < 8; ++w8) tot += ssred[w8 * 16 + rl];
        const float rstd = rsqrtf(tot * (1.f / DM) + EPS);
        f32x4 acc0 = {0.f, 0.f, 0.f, 0.f}, acc1 = {0.f, 0.f, 0.f, 0.f};
        bf16* orow = Hout + (size_t)r * DM + 256 * wave + 8 * q;
        const LAS float* gsp = gs + v * DM + 256 * wave + 8 * q; const LAS float* shp = shv + v * DM + 256 * wave + 8 * q;
#pragma unroll
        for (int ks = 0; ks < 8; ++ks) {
            const f32x4 g0 = *(const LAS f32x4*)(gsp + 32 * ks), g1 = *(const LAS f32x4*)(gsp + 32 * ks + 4), s0 = *(const LAS f32x4*)(shp + 32 * ks), s1 = *(const LAS f32x4*)(shp + 32 * ks + 4);
            const f32x4 h0 = xv[ks][0] * rstd * g0 + s0, h1 = xv[ks][1] * rstd * g1 + s1;
            u32x4 hw; hw.x = pk2(h0.x, h0.y); hw.y = pk2(h0.z, h0.w); hw.z = pk2(h1.x, h1.y); hw.w = pk2(h1.z, h1.w);
            *(u32x4*)(orow + 32 * ks) = hw;
            const bf16x8 hf = __builtin_bit_cast(bf16x8, hw);
            if (MODE == 0) { acc0 = MFMA16(hf, wb[0][ks], acc0); acc1 = MFMA16(hf, wb[1][ks], acc1); }
            else { u32x4 lw;
                lw.x = pk2(h0.x - __uint_as_float(hw.x << 16), h0.y - __uint_as_float(hw.x & 0xffff0000u)); lw.y = pk2(h0.z - __uint_as_float(hw.y << 16), h0.w - __uint_as_float(hw.y & 0xffff0000u));
                lw.z = pk2(h1.x - __uint_as_float(hw.z << 16), h1.y - __uint_as_float(hw.z & 0xffff0000u)); lw.w = pk2(h1.z - __uint_as_float(hw.w << 16), h1.w - __uint_as_float(hw.w & 0xffff0000u));
                const bf16x8 lf = __builtin_bit_cast(bf16x8, lw);
                acc0 = MFMA16(hf, wb[0][ks], acc0); acc0 = MFMA16(lf, wb[0][ks], acc0); acc0 = MFMA16(hf, wb[1][ks], acc0); }
        }
        if (sq + stride < tile_end) norm_load_tile<MODE>(a, tile_of(sq + stride), rl, wave, q, xv, dv);
#pragma unroll
        for (int rr = 0; rr < 4; ++rr) { red[(wave * 16 + 4 * q + rr) * 32 + rl] = acc0[rr]; if (MODE == 0) red[(wave * 16 + 4 * q + rr) * 32 + 16 + rl] = acc1[rr]; }
        __syncthreads();
        if (MODE == 0) { const int row = tid >> 5, col = tid & 31; float s = 0.f;
#pragma unroll
            for (int w8 = 0; w8 < 8; ++w8) s += red[(w8 * 16 + row) * 32 + col];
            ((float*)(a.ws + WS_Z))[(size_t)(tile * 16 + row) * 32 + col] = s;
        } else if (tid < 256) { const int row = tid >> 4, e = tid & 15; float s = 0.f;
#pragma unroll
            for (int w8 = 0; w8 < 8; ++w8) s += red[(w8 * 16 + row) * 32 + e];
            float m = s; m = fmaxf(m, __shfl_xor(m, 1)); m = fmaxf(m, __shfl_xor(m, 2)); m = fmaxf(m, __shfl_xor(m, 4)); m = fmaxf(m, __shfl_xor(m, 8));
            const float ex = expf(s - m); float sm = ex; sm += __shfl_xor(sm, 1); sm += __shfl_xor(sm, 2); sm += __shfl_xor(sm, 4); sm += __shfl_xor(sm, 8);
            const int rg = tile * 16 + row, b = rg / SEQ, t = rg % SEQ;
            ((float*)(a.ws + WS_AFF))[((size_t)b * NE + e) * SEQ + t] = ex / sm; }
        if (MODE == 0 && tile >= NLAT / 16) {
            __threadfence(); __syncthreads();
            if (tid == 0) __hip_atomic_fetch_add((unsigned*)(a.ws + WS_CTL) + CW_CTXCNT + 64 * ((tile - NLAT / 16) >> 4), 1u, __ATOMIC_RELAXED, __HIP_MEMORY_SCOPE_AGENT);
        }
        __syncthreads();
    }
}

constexpr int GQ_LD = 136, GK_LD = 72;
constexpr int GL_Q = 0, GL_KI = 17408, GL_KET = 34816, GL_VT = 53248, GL_ST = 90112, GL_DC = 159744, GL_SEG = 160256;
__device__ __forceinline__ bf16x8 ldfrag(const LAS bf16* base, int row0, int ld, int koff, int lane) { return *(const LAS bf16x8*)(base + (row0 + (lane & 15)) * ld + koff + 8 * (lane >> 4)); }
__device__ __forceinline__ float fast_logsigmoid(float x) { return fminf(x, 0.f) - __logf(1.f + __expf(-fabsf(x))); }

struct GlaRaw { u32x4 q[2], k[2], v[4]; f32x2 z; };
template <bool FULL>
__device__ __forceinline__ void gla_issue_loads(const Args& a, int b, int h, int dir, int t0, size_t zrow0, int tid, GlaRaw& r) {
    const bf16* QH = (const bf16*)(a.ws + WS_QH) + ((size_t)(b * 4 + h) * SEQ + t0) * 128; const bf16* KH = (const bf16*)(a.ws + WS_KH) + ((size_t)(b * 4 + h) * KTOK + t0) * 128;
    const float* Z = (const float*)(a.ws + WS_Z);
#pragma unroll
    for (int j = 0; j < 2; ++j) { const int e = tid + 512 * j; r.k[j] = *(const u32x4*)(KH + (size_t)e * 8); if (FULL) r.q[j] = *(const u32x4*)(QH + (size_t)e * 8); }
    { const int e = tid * 2; r.z = *(const f32x2*)(Z + (zrow0 + (e >> 4)) * 32 + dir * 16 + (e & 15)); }
}
__device__ __forceinline__ void gla_issue_v(const Args& a, int b, int h, int t0, int tid, GlaRaw& r) {
    const bf16* VH = (const bf16*)(a.ws + WS_VH) + ((size_t)(b * 4 + h) * KTOK + t0) * 256;
#pragma unroll
    for (int rr = 0; rr < 4; ++rr) r.v[rr] = *(const u32x4*)(VH + (size_t)(4 * (tid >> 5) + rr) * 256 + 8 * (tid & 31));
}
__device__ __forceinline__ void gla_store_vt(LAS unsigned char* lds, int tid, const u32x4 (&x)[4]) {
    LAS bf16* VT = (LAS bf16*)(lds + GL_VT); const int c0 = 8 * (tid & 31), l0 = 4 * (tid >> 5);
    const int sw = (((l0 >> 3) ^ ((c0 >> 3) & 7)) << 3) + (l0 & 7);
#pragma unroll
    for (int i2 = 0; i2 < 4; ++i2) {
        const unsigned a0 = x[0][i2], a1 = x[1][i2], a2 = x[2][i2], a3 = x[3][i2];
        u32x2 lo, hi; lo.x = (a0 & 0xffffu) | (a1 << 16); lo.y = (a2 & 0xffffu) | (a3 << 16); hi.x = (a0 >> 16) | (a1 & 0xffff0000u); hi.y = (a2 >> 16) | (a3 & 0xffff0000u);
        *(LAS u32x2*)(VT + (c0 + 2 * i2) * GK_LD + sw) = lo; *(LAS u32x2*)(VT + (c0 + 2 * i2 + 1) * GK_LD + sw) = hi; }
}
__device__ __forceinline__ bf16x8 ldfrag_vt(const LAS bf16* VT, int row0, int ld, int kc, int lane) { const int row = row0 + (lane & 15); return *(const LAS bf16x8*)(VT + row * ld + ((kc ^ ((row >> 3) & 7)) << 3)); }
template <bool FULL>
__device__ __forceinline__ void gla_stage(LAS unsigned char* lds, int wave, int lane, int tid, const GlaRaw& r) {
    LAS bf16* Qd = (LAS bf16*)(lds + GL_Q); LAS bf16* Ki = (LAS bf16*)(lds + GL_KI); LAS unsigned* zs = (LAS unsigned*)(lds + GL_SEG);
#pragma unroll
    for (int j = 0; j < 2; ++j) { const int e = tid + 512 * j, row = e >> 4, c8 = e & 15;
        *(LAS u32x4*)(Ki + row * GQ_LD + 8 * c8) = r.k[j]; if (FULL) *(LAS u32x4*)(Qd + row * GQ_LD + 8 * c8) = r.q[j]; }
    zs[tid] = pk2(r.z.x, r.z.y);
    gla_store_vt(lds, tid, r.v);
}
template <bool FULL>
__device__ __forceinline__ void gla_prep(LAS unsigned char* lds, int dir, const bf16x8 wfrag, float bias, float& totacc) {
    const int tid = threadIdx.x, lane = tid & 63, wave = __builtin_amdgcn_readfirstlane(tid >> 6), cidx = lane & 15, q = lane >> 4, d = 16 * wave + cidx;
    LAS bf16* Qd = (LAS bf16*)(lds + GL_Q); LAS bf16* Ki = (LAS bf16*)(lds + GL_KI); LAS bf16* KeT = (LAS bf16*)(lds + GL_KET);
    LAS float* dcv = (LAS float*)(lds + GL_DC); const LAS bf16* zs = (const LAS bf16*)(lds + GL_SEG);
    float c[4][4], t4[4], sq[4], Tt[4];
#pragma unroll
    for (int it = 0; it < 4; ++it) {
        const bf16x8 zf = *(const LAS bf16x8*)(zs + (16 * it + cidx) * 16 + 8 * (q & 1));
        f32x4 pre = {bias, bias, bias, bias};
        pre = MFMA16(zf, wfrag, pre);
#pragma unroll
        for (int r = 0; r < 4; ++r) c[it][r] = fast_logsigmoid(pre[r]) * (1.f / 16.f);
        if (!dir) { c[it][1] += c[it][0]; c[it][2] += c[it][1]; c[it][3] += c[it][2]; t4[it] = c[it][3]; }
        else { c[it][2] += c[it][3]; c[it][1] += c[it][2]; c[it][0] += c[it][1]; t4[it] = c[it][0]; }
        float s = t4[it];
        if (!dir) { const float u = __shfl_up(s, 16); if (q >= 1) s += u; const float u2 = __shfl_up(s, 32); if (q >= 2) s += u2; Tt[it] = __shfl(s, cidx + 48); }
        else { const float u = __shfl_down(s, 16); if (q <= 2) s += u; const float u2 = __shfl_down(s, 32); if (q <= 1) s += u2; Tt[it] = __shfl(s, cidx); }
        sq[it] = s - t4[it];
    }
    const float total = (Tt[0] + Tt[1]) + (Tt[2] + Tt[3]);
    float off[4];
    if (!dir) { off[0] = 0.f; off[1] = Tt[0]; off[2] = Tt[0] + Tt[1]; off[3] = Tt[0] + Tt[1] + Tt[2]; }
    else { off[3] = 0.f; off[2] = Tt[3]; off[1] = Tt[3] + Tt[2]; off[0] = Tt[3] + Tt[2] + Tt[1]; }
    const float dc = __expf(total);
#pragma unroll
    for (int it = 0; it < 4; ++it) {
        float ke[4];
#pragma unroll
        for (int r = 0; r < 4; ++r) { const int i = 16 * it + 4 * q + r; const float cum = c[it][r] + off[it] + sq[it];
            const float kf = bf2f(Ki[i * GQ_LD + d]);
            if (FULL) { const float qf = bf2f(Qd[i * GQ_LD + d]); const float kin = kf * __expf(-cum);
                Qd[i * GQ_LD + d] = (bf16)f2bf(qf * 0.08838834764831845f * __expf(cum)); Ki[i * GQ_LD + d] = (bf16)f2bf(kin); ke[r] = kin * dc; }
            else ke[r] = kf * __expf(total - cum); }
        u32x2 kw; kw.x = pk2(ke[0], ke[1]); kw.y = pk2(ke[2], ke[3]);
        *(LAS u32x2*)(KeT + d * GK_LD + 16 * it + 4 * q) = kw;
    }
    if (q == 0) { dcv[d] = dc; totacc += total; }
}
__device__ __forceinline__ bf16x8 gla_wfrag(const float* w_a2, int h, int wave, int lane) {
    const int d = 16 * wave + (lane & 15), q = lane >> 4; unsigned wv[4];
#pragma unroll
    for (int j2 = 0; j2 < 4; ++j2) { float x[2];
#pragma unroll
        for (int u = 0; u < 2; ++u) { const float wf = w_a2[(8 * (q & 1) + 2 * j2 + u) * 512 + h * 128 + d]; const float hi = bf2f((bf16)f2bf(wf)); x[u] = q < 2 ? hi : wf - hi; }
        wv[j2] = pk2(x[0], x[1]); }
    return __builtin_bit_cast(bf16x8, (u32x4){wv[0], wv[1], wv[2], wv[3]});
}
__device__ __forceinline__ void gla_state_update(LAS unsigned char* lds, int lane, const bf16x8 (&vt)[2][2], f32x4 (&acc)[8][2]) {
    const LAS bf16* KeT = (const LAS bf16*)(lds + GL_KET); const LAS float* dcv = (const LAS float*)(lds + GL_DC);
#pragma unroll
    for (int mt = 0; mt < 8; ++mt) {
        const f32x4 dc4 = *(const LAS f32x4*)(dcv + 16 * mt + 4 * (lane >> 4));
        const bf16x8 k0 = ldfrag(KeT, 16 * mt, GK_LD, 0, lane), k1 = ldfrag(KeT, 16 * mt, GK_LD, 32, lane);
#pragma unroll
        for (int n = 0; n < 2; ++n) { f32x4 t = acc[mt][n] * dc4; t = MFMA16(k0, vt[n][0], t); t = MFMA16(k1, vt[n][1], t); acc[mt][n] = t; }
    }
}
constexpr size_t GLA_SV = 128 * 256;
constexpr int GA_LD = 136;
constexpr int GA_K = 0, GA_KET = 34816, GA_VT = 69632, GA_Z = 139264, GA_DC = 143360;
struct GlaRawA { u32x4 k[4], v[8]; f32x2 z[2]; };
__device__ __forceinline__ void glaA_issue(const Args& a, int b, int h, int dir, int t0, size_t zrow0, int tid, GlaRawA& r) {
    const bf16* KH = (const bf16*)(a.ws + WS_KH) + ((size_t)(b * 4 + h) * KTOK + t0) * 128; const float* Z = (const float*)(a.ws + WS_Z);
#pragma unroll
    for (int j = 0; j < 4; ++j) { const int e = tid + 512 * j; r.k[j] = *(const u32x4*)(KH + (size_t)e * 8); }
#pragma unroll
    for (int j = 0; j < 2; ++j) { const int e = (tid + 512 * j) * 2; r.z[j] = *(const f32x2*)(Z + (zrow0 + (e >> 4)) * 32 + dir * 16 + (e & 15)); }
}
__device__ __forceinline__ void glaA_issue_v(const Args& a, int b, int h, int t0, int tid, GlaRawA& r) {
    const bf16* VH = (const bf16*)(a.ws + WS_VH) + ((size_t)(b * 4 + h) * KTOK + t0) * 256;
#pragma unroll
    for (int j = 0; j < 2; ++j)
#pragma unroll
        for (int rr = 0; rr < 4; ++rr) r.v[4 * j + rr] = *(const u32x4*)(VH + (size_t)(4 * ((tid >> 5) + 16 * j) + rr) * 256 + 8 * (tid & 31));
}
__device__ __forceinline__ void glaA_stage(LAS unsigned char* lds, int wave, int lane, int tid, const GlaRawA& r) {
    LAS bf16* Kr = (LAS bf16*)(lds + GA_K); LAS unsigned* zs = (LAS unsigned*)(lds + GA_Z); LAS bf16* VT = (LAS bf16*)(lds + GA_VT);
#pragma unroll
    for (int j = 0; j < 4; ++j) { const int e = tid + 512 * j, row = e >> 4, c8 = e & 15; *(LAS u32x4*)(Kr + row * GA_LD + 8 * c8) = r.k[j]; }
#pragma unroll
    for (int j = 0; j < 2; ++j) zs[tid + 512 * j] = pk2(r.z[j].x, r.z[j].y);
#pragma unroll
    for (int j = 0; j < 2; ++j) { const int c0 = 8 * (tid & 31), l0 = 4 * ((tid >> 5) + 16 * j);
        const int sw = (((l0 >> 3) ^ ((c0 >> 3) & 7)) << 3) + (l0 & 7);
#pragma unroll
        for (int i2 = 0; i2 < 4; ++i2) {
            const unsigned a0 = r.v[4 * j][i2], a1 = r.v[4 * j + 1][i2], a2 = r.v[4 * j + 2][i2], a3 = r.v[4 * j + 3][i2];
            u32x2 lo, hi; lo.x = (a0 & 0xffffu) | (a1 << 16); lo.y = (a2 & 0xffffu) | (a3 << 16); hi.x = (a0 >> 16) | (a1 & 0xffff0000u); hi.y = (a2 >> 16) | (a3 & 0xffff0000u);
            *(LAS u32x2*)(VT + (c0 + 2 * i2) * GA_LD + sw) = lo; *(LAS u32x2*)(VT + (c0 + 2 * i2 + 1) * GA_LD + sw) = hi; } }
}
__device__ __forceinline__ void glaA_prep(LAS unsigned char* lds, int dir, const bf16x8 wfrag, float bias, float& totacc) {
    const int tid = threadIdx.x, lane = tid & 63, wave = __builtin_amdgcn_readfirstlane(tid >> 6), cidx = lane & 15, q = lane >> 4, d = 16 * wave + cidx;
    const LAS bf16* Kr = (const LAS bf16*)(lds + GA_K); LAS bf16* KeT = (LAS bf16*)(lds + GA_KET); LAS float* dcv = (LAS float*)(lds + GA_DC); const LAS bf16* zs = (const LAS bf16*)(lds + GA_Z);
    float carry = 0.f;
    for (int hh = 0; hh < 2; ++hh) {
        const int it0 = 4 * (dir ? hh : 1 - hh);
        float c[4][4], sq[4], Tt[4];
#pragma unroll
        for (int i = 0; i < 4; ++i) {
            const bf16x8 zf = *(const LAS bf16x8*)(zs + (16 * (it0 + i) + cidx) * 16 + 8 * (q & 1));
            f32x4 pre = {bias, bias, bias, bias};
            pre = MFMA16(zf, wfrag, pre);
#pragma unroll
            for (int r = 0; r < 4; ++r) c[i][r] = fast_logsigmoid(pre[r]) * (1.f / 16.f);
            float t4;
            if (!dir) { c[i][1] += c[i][0]; c[i][2] += c[i][1]; c[i][3] += c[i][2]; t4 = c[i][3]; }
            else { c[i][2] += c[i][3]; c[i][1] += c[i][2]; c[i][0] += c[i][1]; t4 = c[i][0]; }
            float s = t4;
            if (!dir) { const float u = __shfl_up(s, 16); if (q >= 1) s += u; const float u2 = __shfl_up(s, 32); if (q >= 2) s += u2; Tt[i] = __shfl(s, cidx + 48); }
            else { const float u = __shfl_down(s, 16); if (q <= 2) s += u; const float u2 = __shfl_down(s, 32); if (q <= 1) s += u2; Tt[i] = __shfl(s, cidx); }
            sq[i] = s - t4;
        }
        const float toth = (Tt[0] + Tt[1]) + (Tt[2] + Tt[3]);
        float off[4];
        if (!dir) { off[0] = 0.f; off[1] = Tt[0]; off[2] = Tt[0] + Tt[1]; off[3] = Tt[0] + Tt[1] + Tt[2]; }
        else { off[3] = 0.f; off[2] = Tt[3]; off[1] = Tt[3] + Tt[2]; off[0] = Tt[3] + Tt[2] + Tt[1]; }
#pragma unroll
        for (int i = 0; i < 4; ++i) {
            float ke[4];
#pragma unroll
            for (int r = 0; r < 4; ++r) { const int tk = 16 * (it0 + i) + 4 * q + r; const float cum = c[i][r] + off[i] + sq[i]; ke[r] = bf2f(Kr[tk * GA_LD + d]) * __expf(toth - cum + carry); }
            u32x2 kw; kw.x = pk2(ke[0], ke[1]); kw.y = pk2(ke[2], ke[3]);
            *(LAS u32x2*)(KeT + d * GA_LD + 16 * (it0 + i) + 4 * q) = kw;
        }
        carry += toth;
    }
    if (q == 0) { dcv[d] = __expf(carry); totacc += carry; }
}
__device__ __forceinline__ void gla_passA128(const Args& a, LAS unsigned char* lds, int item) {
    const int tid = threadIdx.x, lane = tid & 63, wave = __builtin_amdgcn_readfirstlane(tid >> 6), q = lane >> 4, cidx = lane & 15;
    const bool is_ctx = item >= 256; const int seq = is_ctx ? (item - 256) >> 1 : item >> 4, s = is_ctx ? (item - 256) & 1 : item & 15;
    const int b = seq >> 3, dir = (seq >> 2) & 1, h = seq & 3, nstep = is_ctx ? 1 : 8;
    const size_t rowbase = is_ctx ? (size_t)(NLAT + b * CTXL + s * 128) : (size_t)b * SEQ + (size_t)s * 1024;
    const float* w_a2 = dir ? a.in[10] : a.in[8]; const float* b_a2 = dir ? a.in[11] : a.in[9];
    const bf16x8 wfrag = gla_wfrag(w_a2, h, wave, lane);
    const float bias = b_a2[h * 128 + 16 * wave + cidx];
    f32x4 acc[8][2];
#pragma unroll
    for (int mt = 0; mt < 8; ++mt) { acc[mt][0] = (f32x4){0.f, 0.f, 0.f, 0.f}; acc[mt][1] = (f32x4){0.f, 0.f, 0.f, 0.f}; }
    float totacc = 0.f;
    const int tbase = is_ctx ? SEQ + s * 128 : s * 1024;
    GlaRawA raw; { const int n0 = dir ? (nstep - 1) : 0; glaA_issue(a, b, h, dir, tbase + n0 * 128, rowbase + (size_t)n0 * 128, tid, raw); glaA_issue_v(a, b, h, tbase + n0 * 128, tid, raw); }
    for (int ci = 0; ci < nstep; ++ci) {
        const int nn = dir ? (nstep - 2 - ci) : ci + 1;
        glaA_stage(lds, wave, lane, tid, raw);
        if (ci + 1 < nstep) glaA_issue(a, b, h, dir, tbase + nn * 128, rowbase + (size_t)nn * 128, tid, raw);
        __syncthreads();
        glaA_prep(lds, dir, wfrag, bias, totacc);
        __syncthreads();
        const LAS bf16* VT = (const LAS bf16*)(lds + GA_VT); const LAS bf16* KeT = (const LAS bf16*)(lds + GA_KET); const LAS float* dcv = (const LAS float*)(lds + GA_DC);
        bf16x8 vt[2][4];
#pragma unroll
        for (int n2 = 0; n2 < 2; ++n2)
#pragma unroll
            for (int ks = 0; ks < 4; ++ks) vt[n2][ks] = ldfrag_vt(VT, 32 * wave + 16 * n2, GA_LD, 4 * ks + (lane >> 4), lane);
#pragma unroll
        for (int mt = 0; mt < 8; ++mt) {
            const f32x4 dc4 = *(const LAS f32x4*)(dcv + 16 * mt + 4 * q);
            bf16x8 kf[4];
#pragma unroll
            for (int ks = 0; ks < 4; ++ks) kf[ks] = ldfrag(KeT, 16 * mt, GA_LD, 32 * ks, lane);
#pragma unroll
            for (int n2 = 0; n2 < 2; ++n2) { f32x4 t = acc[mt][n2] * dc4;
#pragma unroll
                for (int ks = 0; ks < 4; ++ks) t = MFMA16(kf[ks], vt[n2][ks], t);
                acc[mt][n2] = t; }
        }
        if (ci + 1 < nstep) glaA_issue_v(a, b, h, tbase + nn * 128, tid, raw);
        __syncthreads();
    }
    float* T = is_ctx ? (float*)(a.ws + WS_TC) + (size_t)(item - 256) * GLA_SV : (float*)(a.ws + WS_T) + (size_t)item * GLA_SV;
#pragma unroll
    for (int mt = 0; mt < 8; ++mt)
#pragma unroll
        for (int n2 = 0; n2 < 2; ++n2)
#pragma unroll
            for (int r = 0; r < 4; ++r) T[(size_t)(16 * mt + 4 * q + r) * 256 + 32 * wave + 16 * n2 + cidx] = acc[mt][n2][r];
    if (q == 0) { float* D = is_ctx ? (float*)(a.ws + WS_DTC) + (size_t)(item - 256) * 128 : (float*)(a.ws + WS_DT) + (size_t)item * 128; D[16 * wave + cidx] = __expf(totacc); }
}

__device__ __forceinline__ void gla_passB(const Args& a) {
    const float* T = (const float*)(a.ws + WS_T); const float* DT = (const float*)(a.ws + WS_DT); float* SST = (float*)(a.ws + WS_SST);
    for (int e = blockIdx.x * NTHREADS + threadIdx.x; e < 16 * (int)GLA_SV; e += gridDim.x * NTHREADS) {
        const int seq = e >> 15, dv = e & 32767, d = dv >> 8, dir = (seq >> 2) & 1;
        float S = 0.f;
        { const float* TC = (const float*)(a.ws + WS_TC); const float* DTC = (const float*)(a.ws + WS_DTC);
#pragma unroll
          for (int j = 0; j < 2; ++j) { const int cc = dir ? 1 - j : j; S = DTC[(size_t)(seq * 2 + cc) * 128 + d] * S + TC[(size_t)(seq * 2 + cc) * GLA_SV + dv]; } }
        float tv[16], dd[16];
#pragma unroll
        for (int si = 0; si < 16; ++si) { const int s = dir ? 15 - si : si; const size_t it = (size_t)seq * 16 + s; tv[si] = T[it * GLA_SV + dv]; dd[si] = DT[it * 128 + d]; }
#pragma unroll
        for (int si = 0; si < 16; ++si) { const int s = dir ? 15 - si : si; const size_t it = (size_t)seq * 16 + s;
            SST[it * GLA_SV + dv] = S; S = dd[si] * S + tv[si]; }
    }
}
__device__ __forceinline__ void gla_passC(const Args& a, LAS unsigned char* lds, int item) {
    const int tid = threadIdx.x, lane = tid & 63, wave = __builtin_amdgcn_readfirstlane(tid >> 6), q = lane >> 4, cidx = lane & 15;
    const int seq = item >> 4, s = item & 15, b = seq >> 3, dir = (seq >> 2) & 1, h = seq & 3;
    const size_t rowbase = (size_t)b * SEQ + (size_t)s * 1024;
    const float* w_a2 = dir ? a.in[10] : a.in[8]; const float* b_a2 = dir ? a.in[11] : a.in[9];
    bf16* O = (bf16*)(a.ws + (dir ? WS_OB : WS_OF));
    const bf16x8 wfrag = gla_wfrag(w_a2, h, wave, lane);
    const float bias = b_a2[h * 128 + 16 * wave + cidx];
    LAS bf16* Qd = (LAS bf16*)(lds + GL_Q); LAS bf16* Ki = (LAS bf16*)(lds + GL_KI); LAS bf16* Pm = Ki; LAS bf16* VT = (LAS bf16*)(lds + GL_VT); LAS bf16* ST = (LAS bf16*)(lds + GL_ST);
    f32x4 acc[8][2];
    { const float* S0 = (const float*)(a.ws + WS_SST) + (size_t)item * GLA_SV;
#pragma unroll
      for (int mt = 0; mt < 8; ++mt)
#pragma unroll
          for (int n2 = 0; n2 < 2; ++n2) {
#pragma unroll
              for (int r = 0; r < 4; ++r) acc[mt][n2][r] = S0[(size_t)(16 * mt + 4 * q + r) * 256 + 32 * wave + 16 * n2 + cidx];
              u32x2 wv; wv.x = pk2(acc[mt][n2][0], acc[mt][n2][1]); wv.y = pk2(acc[mt][n2][2], acc[mt][n2][3]);
              *(LAS u32x2*)(ST + (32 * wave + 16 * n2 + cidx) * GQ_LD + 16 * mt + 4 * q) = wv; } }
    float totacc = 0.f;
    const int tbase = s * 1024;
    GlaRaw raw; gla_issue_loads<true>(a, b, h, dir, tbase + (dir ? 15 : 0) * 64, rowbase + (size_t)(dir ? 15 : 0) * 64, tid, raw); gla_issue_v(a, b, h, tbase + (dir ? 15 : 0) * 64, tid, raw);
    for (int ci = 0; ci < 16; ++ci) {
        const int n = dir ? (15 - ci) : ci; const size_t row0 = rowbase + (size_t)n * 64; const int nn = dir ? (14 - ci) : ci + 1;
        gla_stage<true>(lds, wave, lane, tid, raw);
        if (ci + 1 < 16) gla_issue_loads<true>(a, b, h, dir, tbase + nn * 64, rowbase + (size_t)nn * 64, tid, raw);
        __syncthreads();
        gla_prep<true>(lds, dir, wfrag, bias, totacc);
        __syncthreads();
        const int it = wave >> 1;
        u32x2 pw[2];
#pragma unroll
        for (int jj = 0; jj < 2; ++jj) { const int jt = 2 * (wave & 1) + jj; f32x4 sc = {0.f, 0.f, 0.f, 0.f};
#pragma unroll
            for (int ks = 0; ks < 4; ++ks) sc = MFMA16(ldfrag(Ki, 16 * jt, GQ_LD, 32 * ks, lane), ldfrag(Qd, 16 * it, GQ_LD, 32 * ks, lane), sc);
            const int i = 16 * it + cidx, j0 = 16 * jt + 4 * q;
#pragma unroll
            for (int r = 0; r < 4; ++r) { const bool keep = dir ? (j0 + r >= i) : (j0 + r <= i); sc[r] = keep ? sc[r] : 0.f; }
            pw[jj].x = pk2(sc[0], sc[1]); pw[jj].y = pk2(sc[2], sc[3]); }
        __syncthreads();
#pragma unroll
        for (int jj = 0; jj < 2; ++jj) *(LAS u32x2*)(Pm + (16 * it + cidx) * GK_LD + 16 * (2 * (wave & 1) + jj) + 4 * q) = pw[jj];
        __syncthreads();
        bf16x8 vt[2][2], st[2][4];
#pragma unroll
        for (int n2 = 0; n2 < 2; ++n2) { vt[n2][0] = ldfrag_vt(VT, 32 * wave + 16 * n2, GK_LD, (lane >> 4), lane); vt[n2][1] = ldfrag_vt(VT, 32 * wave + 16 * n2, GK_LD, 4 + (lane >> 4), lane);
#pragma unroll
            for (int ks = 0; ks < 4; ++ks) st[n2][ks] = ldfrag(ST, 32 * wave + 16 * n2, GQ_LD, 32 * ks, lane); }
#pragma unroll
        for (int i2 = 0; i2 < 4; ++i2) {
            const bf16x8 p0 = ldfrag(Pm, 16 * i2, GK_LD, 0, lane), p1 = ldfrag(Pm, 16 * i2, GK_LD, 32, lane);
            bf16x8 qf[4];
#pragma unroll
            for (int ks = 0; ks < 4; ++ks) qf[ks] = ldfrag(Qd, 16 * i2, GQ_LD, 32 * ks, lane);
#pragma unroll
            for (int n2 = 0; n2 < 2; ++n2) { f32x4 o = {0.f, 0.f, 0.f, 0.f};
                o = MFMA16(vt[n2][0], p0, o); o = MFMA16(vt[n2][1], p1, o);
#pragma unroll
                for (int ks = 0; ks < 4; ++ks) o = MFMA16(st[n2][ks], qf[ks], o);
                u32x2 wv; wv.x = pk2(o[0], o[1]); wv.y = pk2(o[2], o[3]);
                *(u32x2*)(O + (row0 + 16 * i2 + cidx) * 1024 + h * 256 + 32 * wave + 16 * n2 + 4 * q) = wv; }
            if (i2 & 1) asm volatile("" ::: "memory");
        }
        if (ci + 1 < 16) gla_issue_v(a, b, h, tbase + nn * 64, tid, raw);
        gla_state_update(lds, lane, vt, acc);
#pragma unroll
        for (int mt = 0; mt < 8; ++mt)
#pragma unroll
            for (int n2 = 0; n2 < 2; ++n2) { u32x2 wv; wv.x = pk2(acc[mt][n2][0], acc[mt][n2][1]); wv.y = pk2(acc[mt][n2][2], acc[mt][n2][3]);
                *(LAS u32x2*)(ST + (32 * wave + 16 * n2 + cidx) * GQ_LD + 16 * mt + 4 * q) = wv; }
        __syncthreads();
    }
}

__device__ __forceinline__ void phase_gla_merge(const Args& a) {
    const int tid = threadIdx.x, lane = tid & 63, wave = tid >> 6;
    if (PROBE_HALF && blockIdx.x >= gridDim.x / 2) return;
    const int gw = blockIdx.x * 8 + wave, NGW = (PROBE_HALF ? gridDim.x / 2 : gridDim.x) * 8;
    const bf16* OF = (const bf16*)(a.ws + WS_OF); const bf16* OB = (const bf16*)(a.ws + WS_OB);
    const bf16* P = (const bf16*)(a.ws + WS_G); bf16* Y = (bf16*)(a.ws + WS_YCAT); const float* gg = a.in[12];
    f32x4 gn[4];
#pragma unroll
    for (int j = 0; j < 4; ++j) gn[j] = *(const f32x4*)(gg + 256 * j + 4 * lane);
    for (int r0 = gw; r0 < NLAT; r0 += 2 * NGW) {
        u32x2 fa[2][4], fb[2][4], gw2[2][4];
#pragma unroll
        for (int u = 0; u < 2; ++u) { const int r = r0 + u * NGW; if (r < NLAT) {
#pragma unroll
            for (int j = 0; j < 4; ++j) { const int col = 256 * j + 4 * lane; fa[u][j] = *(const u32x2*)(OF + (size_t)r * 1024 + col); fb[u][j] = *(const u32x2*)(OB + (size_t)r * 1024 + col); gw2[u][j] = *(const u32x2*)(P + (size_t)r * 1024 + col); } } }
#pragma unroll
        for (int u = 0; u < 2; ++u) { const int r = r0 + u * NGW; if (r < NLAT) {
#pragma unroll
            for (int j = 0; j < 4; ++j) {
                const int col = 256 * j + 4 * lane;
                f32x4 o; o.x = __uint_as_float(fa[u][j].x << 16) + __uint_as_float(fb[u][j].x << 16); o.y = __uint_as_float(fa[u][j].x & 0xffff0000u) + __uint_as_float(fb[u][j].x & 0xffff0000u);
                o.z = __uint_as_float(fa[u][j].y << 16) + __uint_as_float(fb[u][j].y << 16); o.w = __uint_as_float(fa[u][j].y & 0xffff0000u) + __uint_as_float(fb[u][j].y & 0xffff0000u);
                const float ss = wave_sum((o.x * o.x + o.y * o.y) + (o.z * o.z + o.w * o.w));
                const float rstd = rsqrtf(ss * (1.f / 256.f) + EPS);
                const float g0 = __uint_as_float(gw2[u][j].x << 16), g1 = __uint_as_float(gw2[u][j].x & 0xffff0000u), g2 = __uint_as_float(gw2[u][j].y << 16), g3 = __uint_as_float(gw2[u][j].y & 0xffff0000u);
                u32x2 w; w.x = pk2(o.x * rstd * gn[j].x * silu_f(g0), o.y * rstd * gn[j].y * silu_f(g1)); w.y = pk2(o.z * rstd * gn[j].z * silu_f(g2), o.w * rstd * gn[j].w * silu_f(g3));
                *(u32x2*)(Y + (size_t)r * DM + col) = w;
            } } }
    }
}

constexpr int FLD = 136;
__device__ __forceinline__ void load_dft_frags(const unsigned char* ws, int wave, int lane, bf16x8 (&fc)[4], bf16x8 (&fs)[4]) {
    const bf16* FC = (const bf16*)(ws + WS_FC); const bf16* FS = (const bf16*)(ws + WS_FS);
    const int k = 16 * wave + (lane & 15);
#pragma unroll
    for (int ks = 0; ks < 4; ++ks) { fc[ks] = *(const bf16x8*)(FC + k * 128 + ks * 32 + 8 * (lane >> 4)); fs[ks] = *(const bf16x8*)(FS + k * 128 + ks * 32 + 8 * (lane >> 4)); }
}
__device__ __forceinline__ void store_t4x8(LAS bf16* XT, int c0, int l0, const u32x4 (&x)[4]) {
#pragma unroll
    for (int i2 = 0; i2 < 4; ++i2) {
        const unsigned a0 = x[0][i2], a1 = x[1][i2], a2 = x[2][i2], a3 = x[3][i2];
        u32x2 lo, hi; lo.x = (a0 & 0xffffu) | (a1 << 16); lo.y = (a2 & 0xffffu) | (a3 << 16); hi.x = (a0 >> 16) | (a1 & 0xffff0000u); hi.y = (a2 >> 16) | (a3 & 0xffff0000u);
        const int sw = (((l0 >> 3) ^ ((c0 >> 3) & 7)) << 3) + (l0 & 7);
        *(LAS u32x2*)(XT + (c0 + 2 * i2) * FLD + sw) = lo; *(LAS u32x2*)(XT + (c0 + 2 * i2 + 1) * FLD + sw) = hi; }
}
__device__ __forceinline__ bf16x8 ldfrag_sw(const LAS bf16* XT, int row0, int kc, int lane) { const int row = row0 + (lane & 15); return *(const LAS bf16x8*)(XT + row * FLD + ((kc ^ ((row >> 3) & 7)) << 3)); }
__device__ __forceinline__ void phase_f1(const Args& a, LAS unsigned char* lds) {
    const int tid = threadIdx.x, lane = tid & 63, wave = __builtin_amdgcn_readfirstlane(tid >> 6), q = lane >> 4, cidx = lane & 15;
    const bf16* P = (const bf16*)(a.ws + WS_U); const f32x2* TW = (const f32x2*)(a.ws + WS_TW);
    bf16* A1r = (bf16*)(a.ws + WS_FA); bf16* A1i = (bf16*)(a.ws + WS_FAI);
    LAS bf16* XT = (LAS bf16*)lds;
    bf16x8 fc[4], fs[4]; load_dft_frags(a.ws, wave, lane, fc, fs);
    const int k1 = 16 * wave + cidx;
    u32x4 xp[2][4];
    auto f1_load = [&](int item) { const int cb = item & 3, l2 = (item >> 2) & 127, b = item >> 9, ch0 = cb * 256;
#pragma unroll
        for (int j = 0; j < 2; ++j) { const int task = tid + 512 * j, cblk = task & 31, lb = task >> 5;
#pragma unroll
            for (int r = 0; r < 4; ++r) xp[j][r] = *(const u32x4*)(P + ((size_t)b * SEQ + 128 * (4 * lb + r) + l2) * 1024 + ch0 + 8 * cblk); } };
    if ((int)blockIdx.x < 1024) f1_load(blockIdx.x);
    for (int item = blockIdx.x; item < 1024; item += gridDim.x) {
        const int cb = item & 3, l2 = (item >> 2) & 127, b = item >> 9, ch0 = cb * 256;
#pragma unroll
        for (int j = 0; j < 2; ++j) { const int task = tid + 512 * j, cblk = task & 31, lb = task >> 5; store_t4x8(XT, 8 * cblk, 4 * lb, xp[j]); }
        if (item + (int)gridDim.x < 1024) f1_load(item + gridDim.x);
        __syncthreads();
        const f32x2 tw = TW[l2 * k1];
        LAS unsigned char* ost = lds + 69632 + wave * 8448;
        u32x2 wim[16];
#pragma unroll
        for (int mt = 0; mt < 16; ++mt) {
            f32x4 cr = {0.f, 0.f, 0.f, 0.f}, cs = {0.f, 0.f, 0.f, 0.f};
#pragma unroll
            for (int ks = 0; ks < 4; ++ks) { const bf16x8 xa = ldfrag_sw(XT, 16 * mt, 4 * ks + q, lane); cr = MFMA16(xa, fc[ks], cr); cs = MFMA16(xa, fs[ks], cs); }
            const f32x4 br = cr * tw.x - cs * tw.y, bi = -(cs * tw.x + cr * tw.y);
            u32x2 wr_; wr_.x = pk2(br[0], br[1]); wr_.y = pk2(br[2], br[3]); wim[mt].x = pk2(bi[0], bi[1]); wim[mt].y = pk2(bi[2], bi[3]);
            *(LAS u32x2*)(ost + cidx * 528 + (16 * mt + 4 * q) * 2) = wr_;
        }
        const size_t obase = (((size_t)b * 128 + 16 * wave) * 128 + l2) * 1024 + ch0;
#pragma unroll
        for (int i = 0; i < 8; ++i) { const int row = 2 * i + (lane >> 5), ck = lane & 31; const u32x4 v = *(const LAS u32x4*)(ost + row * 528 + ck * 16); *(u32x4*)(A1r + obase + (size_t)row * 128 * 1024 + 8 * ck) = v; }
#pragma unroll
        for (int mt = 0; mt < 16; ++mt) *(LAS u32x2*)(ost + cidx * 528 + (16 * mt + 4 * q) * 2) = wim[mt];
#pragma unroll
        for (int i = 0; i < 8; ++i) { const int row = 2 * i + (lane >> 5), ck = lane & 31; const u32x4 v = *(const LAS u32x4*)(ost + row * 528 + ck * 16); *(u32x4*)(A1i + obase + (size_t)row * 128 * 1024 + 8 * ck) = v; }
        __syncthreads();
    }
}
__device__ __forceinline__ void phase_f34(const Args& a, LAS unsigned char* lds) {
    const int tid = threadIdx.x, lane = tid & 63, wave = __builtin_amdgcn_readfirstlane(tid >> 6), q = lane >> 4, cidx = lane & 15;
    const bf16* A1r = (const bf16*)(a.ws + WS_FA); const bf16* A1i = (const bf16*)(a.ws + WS_FAI); bf16* Y = (bf16*)(a.ws + WS_YCAT);
    LAS bf16* XTr = (LAS bf16*)lds; LAS bf16* XTi = XTr + 128 * FLD; LAS bf16* XKr = XTi + 128 * FLD; LAS bf16* XKi = XKr + 128 * FLD;
    bf16x8 fc[4], fs[4]; load_dft_frags(a.ws, wave, lane, fc, fs);
    const float nrm = 1.0f / 1448.15468787005f;
    u32x4 xr[4], xi[4];
    auto f34_load = [&](int item) { const int g = item & 7, k1 = (item >> 3) & 127, b = item >> 10, ch0 = g * 128; const int cblk = tid & 15, lb = tid >> 4;
#pragma unroll
        for (int r = 0; r < 4; ++r) { const size_t off = (((size_t)b * 128 + k1) * 128 + 4 * lb + r) * 1024 + ch0 + 8 * cblk; xr[r] = *(const u32x4*)(A1r + off); xi[r] = *(const u32x4*)(A1i + off); } };
    if ((int)blockIdx.x < 2048) f34_load(blockIdx.x);
    for (int item = blockIdx.x; item < 2048; item += gridDim.x) {
        const int g = item & 7, k1 = (item >> 3) & 127, b = item >> 10, ch0 = g * 128;
        { const int cblk = tid & 15, lb = tid >> 4; store_t4x8(XTr, 8 * cblk, 4 * lb, xr); store_t4x8(XTi, 8 * cblk, 4 * lb, xi); }
        if (item + (int)gridDim.x < 2048) f34_load(item + gridDim.x);
        __syncthreads();
        const int k2 = 16 * wave + cidx;
#pragma unroll 2
        for (int mt = 0; mt < 8; ++mt) {
            f32x4 a1 = {0.f, 0.f, 0.f, 0.f}, a2 = a1, b1 = a1, b2 = a1;
#pragma unroll
            for (int ks = 0; ks < 4; ++ks) { const bf16x8 xa = ldfrag_sw(XTr, 16 * mt, 4 * ks + q, lane); const bf16x8 xb = ldfrag_sw(XTi, 16 * mt, 4 * ks + q, lane);
                a1 = MFMA16(xa, fc[ks], a1); b2 = MFMA16(xa, fs[ks], b2); a2 = MFMA16(xb, fs[ks], a2); b1 = MFMA16(xb, fc[ks], b1); }
            const f32x4 xre = a1 + a2, xim = b1 - b2;
            u32x2 wr_; wr_.x = pk2(xre[0], xre[1]); wr_.y = pk2(xre[2], xre[3]); u32x2 wi_; wi_.x = pk2(xim[0], xim[1]); wi_.y = pk2(xim[2], xim[3]);
            *(LAS u32x2*)(XKr + k2 * FLD + 16 * mt + 4 * q) = wr_; *(LAS u32x2*)(XKi + k2 * FLD + 16 * mt + 4 * q) = wi_;
        }
        __syncthreads();
#pragma unroll 2
        for (int nt = 0; nt < 8; ++nt) {
            f32x4 y = {0.f, 0.f, 0.f, 0.f};
#pragma unroll
            for (int ks = 0; ks < 4; ++ks) { const bf16x8 xa = *(const LAS bf16x8*)(XKr + (16 * nt + cidx) * FLD + ks * 32 + 8 * q); const bf16x8 xb = *(const LAS bf16x8*)(XKi + (16 * nt + cidx) * FLD + ks * 32 + 8 * q);
                y = MFMA16(fc[ks], xa, y); y = MFMA16(fs[ks], xb, y); }
            u32x2 w; w.x = pk2(y[0] * nrm, y[1] * nrm); w.y = pk2(y[2] * nrm, y[3] * nrm);
            *(LAS u32x2*)(XTr + (16 * nt + cidx) * FLD + 16 * wave + 4 * q) = w;
        }
        __syncthreads();
#pragma unroll
        for (int i = 0; i < 4; ++i) { const int task = tid + 512 * i, row = task >> 4, ck = task & 15; const u32x4 v = *(const LAS u32x4*)(XTr + row * FLD + 8 * ck);
            *(u32x4*)(Y + ((size_t)b * SEQ + k1 + 128 * row) * DM + 1024 + ch0 + 8 * ck) = v; }
        __syncthreads();
    }
}

__device__ __forceinline__ void phase_topk(const Args& a, LAS unsigned char* lds) {
    const int tid = threadIdx.x, lane = tid & 63, wave = tid >> 6;
    LAS unsigned* keys = (LAS unsigned*)lds;
    LAS unsigned* hist = (LAS unsigned*)(lds + 65536);
    LAS unsigned* misc = hist + 256;
    LAS unsigned* wtot = misc + 16;
    const float* AFF = (const float*)(a.ws + WS_AFF); int* TOK = (int*)(a.ws + WS_TOK); float* GATE = (float*)(a.ws + WS_GATE); int* SEL = (int*)(a.ws + WS_SEL);
    for (int be = blockIdx.x; be < NB * NE; be += gridDim.x) {
        const int b = be / NE, e = be % NE;
        for (int i = tid; i < SEQ; i += NTHREADS) keys[i] = __float_as_uint(AFF[(size_t)be * SEQ + i]);
        unsigned prefix = 0u, pmask = 0u, krem = CAP;
        for (int pass = 0; pass < 4; ++pass) {
            const int shift = 24 - 8 * pass;
            if (tid < 256) hist[tid] = 0u;
            __syncthreads();
            for (int i = tid; i < SEQ; i += NTHREADS) { const unsigned k = keys[i]; if ((k & pmask) == prefix) __hip_atomic_fetch_add(&hist[(k >> shift) & 255u], 1u, __ATOMIC_RELAXED, __HIP_MEMORY_SCOPE_WORKGROUP); }
            __syncthreads();
            if (wave == 0) {
                const unsigned h0 = hist[4 * lane], h1 = hist[4 * lane + 1], h2 = hist[4 * lane + 2], h3 = hist[4 * lane + 3];
                const unsigned sl = h0 + h1 + h2 + h3; unsigned S = sl;
#pragma unroll
                for (int o = 1; o < 64; o <<= 1) { const unsigned t = __shfl_down(S, o); if (lane + o < 64) S += t; }
                const unsigned long long m = __ballot(S >= krem);
                const int ls = 63 - __builtin_clzll(m);
                if (lane == ls) { unsigned cum = S - sl; int bsel;
                    if (cum + h3 >= krem) bsel = 3; else { cum += h3; if (cum + h2 >= krem) bsel = 2; else { cum += h2; if (cum + h1 >= krem) bsel = 1; else { cum += h1; bsel = 0; } } }
                    misc[0] = prefix | ((unsigned)(4 * lane + bsel) << shift); misc[1] = krem - cum; }
            }
            __syncthreads();
            prefix = misc[0]; krem = misc[1]; pmask |= (0xffu << shift);
            __syncthreads();
        }
        const unsigned T = prefix;
        unsigned cg_ = 0u, ce = 0u;
        for (int i = 0; i < 32; ++i) { const unsigned k = keys[tid * 32 + i]; cg_ += (k > T); ce += (k == T); }
        unsigned ig = cg_, ie = ce;
#pragma unroll
        for (int o = 1; o < 64; o <<= 1) { const unsigned tg = __shfl_up(ig, o), te = __shfl_up(ie, o); if (lane >= o) { ig += tg; ie += te; } }
        if (lane == 63) { wtot[wave * 2] = ig; wtot[wave * 2 + 1] = ie; }
        __syncthreads();
        unsigned gt_before = ig - cg_, eq_before = ie - ce;
        for (int w8 = 0; w8 < wave; ++w8) { gt_before += wtot[w8 * 2]; eq_before += wtot[w8 * 2 + 1]; }
        for (int i = 0; i < 32; ++i) { const int t = tid * 32 + i; const unsigned k = keys[t];
            const bool isgt = k > T, iseq = k == T; const bool take = isgt || (iseq && eq_before < krem);
            const unsigned slot = gt_before + (eq_before < krem ? eq_before : krem);
            if (take) { TOK[(size_t)be * CAP + slot] = t; GATE[(size_t)be * CAP + slot] = __uint_as_float(k); }
            SEL[((size_t)b * SEQ + t) * NE + e] = take ? (int)slot : -1;
            gt_before += isgt; eq_before += iseq; }
        __syncthreads();
    }
}

__device__ __forceinline__ void acc_yrow(f32x4 (&m)[8], const u32x2 (&w)[8], float gt) {
#pragma unroll
    for (int j = 0; j < 8; ++j) { m[j].x += gt * __uint_as_float(w[j].x << 16); m[j].y += gt * __uint_as_float(w[j].x & 0xffff0000u); m[j].z += gt * __uint_as_float(w[j].y << 16); m[j].w += gt * __uint_as_float(w[j].y & 0xffff0000u); }
}
__device__ __forceinline__ void phase_final(const Args& a) {
    const int tid = threadIdx.x, lane = tid & 63, wave = tid >> 6;
    if (PROBE_HALF && blockIdx.x >= gridDim.x / 2) return;
    const int gw = blockIdx.x * 8 + wave, NGW = (PROBE_HALF ? gridDim.x / 2 : gridDim.x) * 8;
    const float* ada = (const float*)(a.ws + WS_ADA); const float* fg = a.in[19];
    const bf16* DL = (const bf16*)(a.ws + WS_DLT); const bf16* YE = (const bf16*)(a.ws + WS_YE);
    const float* GATE = (const float*)(a.ws + WS_GATE); const int* SEL = (const int*)(a.ws + WS_SEL);
    int selA = -1, selB = -1;
    { const int r = gw; if (r < NLAT && lane < NE) selA = SEL[(size_t)r * NE + lane]; if (r + NGW < NLAT && lane < NE) selB = SEL[(size_t)(r + NGW) * NE + lane]; }
    for (int r0 = gw; r0 < NLAT; r0 += 2 * NGW) {
        const int rA = r0, rB = r0 + NGW; const bool hasB = rB < NLAT;
        const int bA = rA / SEQ, bB = hasB ? rB / SEQ : bA;
        u32x2 dlA[8], dlB[8];
#pragma unroll
        for (int j = 0; j < 8; ++j) { dlA[j] = *(const u32x2*)(DL + (size_t)rA * DM + 256 * j + 4 * lane); dlB[j] = *(const u32x2*)(DL + (size_t)(hasB ? rB : rA) * DM + 256 * j + 4 * lane); }
        const float gtA = selA >= 0 ? GATE[((size_t)bA * NE + lane) * CAP + selA] : 0.f, gtB = selB >= 0 ? GATE[((size_t)bB * NE + lane) * CAP + selB] : 0.f;
        const int rowA = selA >= 0 ? (lane * 2 + bA) * CAP + selA : 0, rowB = selB >= 0 ? (lane * 2 + bB) * CAP + selB : 0;
        unsigned long long mA = __ballot(selA >= 0), mB = __ballot(selB >= 0);
        { const int rn = r0 + 2 * NGW; selA = -1; selB = -1; if (rn < NLAT && lane < NE) selA = SEL[(size_t)rn * NE + lane]; if (rn + NGW < NLAT && lane < NE) selB = SEL[(size_t)(rn + NGW) * NE + lane]; }
        f32x4 accA[8], accB[8];
#pragma unroll
        for (int j = 0; j < 8; ++j) { accA[j] = (f32x4){0.f, 0.f, 0.f, 0.f}; accB[j] = (f32x4){0.f, 0.f, 0.f, 0.f}; }
        while (mA | mB) {
            const bool hA = mA != 0ull, hB = mB != 0ull;
            const int eA = hA ? __builtin_ctzll(mA) : 0, eB = hB ? __builtin_ctzll(mB) : 0; mA &= mA - 1; mB &= mB - 1;
            const int yrA = hA ? __builtin_amdgcn_readlane(rowA, eA) : 0, yrB = hB ? __builtin_amdgcn_readlane(rowB, eB) : 0;
            const float gA = hA ? __builtin_bit_cast(float, __builtin_amdgcn_readlane(__builtin_bit_cast(int, gtA), eA)) : 0.f;
            const float gB = hB ? __builtin_bit_cast(float, __builtin_amdgcn_readlane(__builtin_bit_cast(int, gtB), eB)) : 0.f;
            const bf16* y0 = YE + (size_t)yrA * DM + 4 * lane; const bf16* y1 = YE + (size_t)yrB * DM + 4 * lane;
            u32x2 w0[8], w1[8];
#pragma unroll
            for (int j = 0; j < 8; ++j) { w0[j] = *(const u32x2*)(y0 + 256 * j); w1[j] = *(const u32x2*)(y1 + 256 * j); }
            acc_yrow(accA, w0, gA); acc_yrow(accB, w1, gB);
        }
#pragma unroll
        for (int u = 0; u < 2; ++u) { if (u == 1 && !hasB) break;
            const int r = u ? rB : rA; const float* g2 = ada + (size_t)(u ? bB : bA) * 12288 + 5 * DM;
            float ss = 0.f; f32x4 m[8];
#pragma unroll
            for (int j = 0; j < 8; ++j) { const int d = 256 * j + 4 * lane; const f32x4 gv = *(const f32x4*)(g2 + d); const u32x2 dw = u ? dlB[j] : dlA[j];
                const f32x4 dv = {__uint_as_float(dw.x << 16), __uint_as_float(dw.x & 0xffff0000u), __uint_as_float(dw.y << 16), __uint_as_float(dw.y & 0xffff0000u)};
                m[j] = dv + gv * (u ? accB[j] : accA[j]); ss += (m[j].x * m[j].x + m[j].y * m[j].y) + (m[j].z * m[j].z + m[j].w * m[j].w); }
            const float rstd = rsqrtf(wave_sum(ss) * (1.f / DM) + EPS);
#pragma unroll
            for (int j = 0; j < 8; ++j) { const int d = 256 * j + 4 * lane; const f32x4 gv = *(const f32x4*)(fg + d);
                *(f32x4*)(a.out + (size_t)r * DM + d) = m[j] * rstd * gv; }
        }
    }
}

#define XB_TMO      128
#define XB_XCNT(j)  (256  + 64 * (j))
#define XB_XSUB(j)  (1280 + 64 * (j))
#define XB_XGEN(j)  (2304 + 64 * (j))
#define XB_TOP      3328
#define XB_TOPGEN   3392
#define XCD_BAR_WORDS 3456
#define XB_SPIN_CAP (1u << 18)
__device__ __forceinline__ unsigned xb_ld(unsigned* p)              { return __hip_atomic_load(p, __ATOMIC_RELAXED, __HIP_MEMORY_SCOPE_AGENT); }
__device__ __forceinline__ unsigned xb_add(unsigned* p, unsigned v) { return __hip_atomic_fetch_add(p, v, __ATOMIC_RELAXED, __HIP_MEMORY_SCOPE_AGENT); }
__device__ __forceinline__ unsigned xb_xcc_id() { return (unsigned)__builtin_amdgcn_s_getreg((3 << 11) | 20) & 0xFu; }
#define XB_SPIN(cond, bar) do { unsigned _sp = 0; while (cond) { __builtin_amdgcn_s_sleep(1); \
    if ((++_sp & 255u) == 0u) { if (xb_ld(&(bar)[XB_TMO])) break; if (_sp > XB_SPIN_CAP) { atomicAdd(&(bar)[XB_TMO], 1u); break; } } } } while (0)
struct XcdBarrier { unsigned* bar; unsigned x; volatile LAS unsigned* st; };
__device__ __forceinline__ XcdBarrier xcd_barrier_post(unsigned* bar, volatile LAS unsigned* st) {
    XcdBarrier b; b.bar = bar; b.x = xb_xcc_id(); b.st = st;
    if (threadIdx.x == 0) (void)xb_add(&bar[XB_XCNT(b.x)], 1u);
    return b;
}
__device__ __forceinline__ void xcd_barrier_complete(unsigned* bar, unsigned x, unsigned& nloc, unsigned& nx) {
    const unsigned G = gridDim.x * gridDim.y * gridDim.z;
    unsigned sum, cnt, mine, sp = 0u;
    for (;;) {
        sum = 0u; cnt = 0u; mine = 0u;
#pragma unroll
        for (unsigned j = 0; j < 16; ++j) { const unsigned c = xb_ld(&bar[XB_XCNT(j)]); sum += c; cnt += (c > 0u) ? 1u : 0u; mine = (j == x) ? c : mine; }
        if (sum == G) break;
        __builtin_amdgcn_s_sleep(1);
        if ((++sp & 255u) == 0u) { if (xb_ld(&bar[XB_TMO])) break; if (sp > XB_SPIN_CAP) { atomicAdd(&bar[XB_TMO], 1u); break; } }
    }
    nloc = mine > 0u ? mine : 1u; nx = cnt > 0u ? cnt : 1u;
}
__device__ __forceinline__ void xcd_barrier(const XcdBarrier& b) {
    asm volatile("s_waitcnt vmcnt(0)" ::: "memory");
    __syncthreads();
    if (threadIdx.x == 0) {
        unsigned* bar = b.bar;
        __builtin_amdgcn_s_waitcnt(0);
        unsigned nloc = b.st[0], nx = b.st[1];
        if (nloc == 0u) { xcd_barrier_complete(bar, b.x, nloc, nx); b.st[0] = nloc; b.st[1] = nx; }
        const unsigned old = xb_add(&bar[XB_XSUB(b.x)], 1u);
        const unsigned gen = old / nloc;
        if (old + 1u == (gen + 1u) * nloc) {
            __builtin_amdgcn_fence(__ATOMIC_RELEASE, "agent");
            asm volatile("s_waitcnt vmcnt(0)" ::: "memory");
            const unsigned og = xb_add(&bar[XB_TOP], 1u);
            const unsigned tg = og / nx;
            if (og + 1u == (tg + 1u) * nx) xb_add(&bar[XB_TOPGEN], 1u);
            else XB_SPIN(xb_ld(&bar[XB_TOPGEN]) == tg, bar);
            __builtin_amdgcn_fence(__ATOMIC_ACQUIRE, "agent");
            xb_add(&bar[XB_XGEN(b.x)], 1u);
            asm volatile("s_waitcnt vmcnt(0)" ::: "memory");
        } else {
            XB_SPIN(xb_ld(&bar[XB_XGEN(b.x)]) == gen, bar);
            __builtin_amdgcn_fence(__ATOMIC_ACQUIRE, "agent");
            asm volatile("s_waitcnt vmcnt(0)" ::: "memory");
        }
    }
    __syncthreads();
}

#ifndef STAGGER_US
#define STAGGER_US 0
#endif
__device__ __forceinline__ void gemm_stagger() {
    if (STAGGER_US > 0 && (blockIdx.x & 1)) { const unsigned long long t0 = __builtin_amdgcn_s_memrealtime();
        while (__builtin_amdgcn_s_memrealtime() - t0 < (unsigned long long)(STAGGER_US * 100)) __builtin_amdgcn_s_sleep(32); }
}
constexpr int NPHASES = 15;
__global__ void __launch_bounds__(NTHREADS, 2) mega(Args a) {
    extern __shared__ __attribute__((aligned(16))) unsigned char lds_raw[];
    LAS unsigned char* lds = (LAS unsigned char*)lds_raw;
    const int lo = a.ph_lo, hi = a.ph_hi;
    unsigned char* ws = a.ws;
#if USE_CG_SYNC
    cg::grid_group grid = cg::this_grid();
#define GRID_SYNC() grid.sync()
#else
    volatile LAS unsigned* bst = (volatile LAS unsigned*)(lds + LDS_BYTES - 16);
    if (threadIdx.x < 2) bst[threadIdx.x] = 0u;
    __syncthreads();
    XcdBarrier xbar = xcd_barrier_post((unsigned*)(ws + WS_CTL), bst);
#define GRID_SYNC() xcd_barrier(xbar)
#endif
#define IN(k) (lo <= (k) && (k) < hi)
#define SEAM(k) do { if (IN(k) && IN((k) + 1)) GRID_SYNC(); } while (0)
#define PH(k, ...) do { if (IN(k)) { __VA_ARGS__; if ((PROBE_MASK >> (k)) & 1u) { GRID_SYNC(); __VA_ARGS__; } } SEAM(k); } while (0)
    PH(0, phase0(a, lds));
    PH(1, {
        finalize_ada(a);
        const int nsp = gridDim.x >= 64 ? 12 : 0, nreg = gridDim.x - nsp;
        if ((int)blockIdx.x >= nreg) {
            const int si = blockIdx.x - nreg, b = si / 6, pn = 2 + si % 6;
            if (threadIdx.x < 64) { unsigned* cnt = (unsigned*)(ws + WS_CTL) + CW_CTXCNT + 64 * b; unsigned sp = 0;
                while ((unsigned)__builtin_amdgcn_readfirstlane(__hip_atomic_load(cnt, __ATOMIC_RELAXED, __HIP_MEMORY_SCOPE_AGENT)) < 16u) { __builtin_amdgcn_s_sleep(4); if (++sp > (1u << 22)) break; }
                __builtin_amdgcn_fence(__ATOMIC_ACQUIRE, "agent");
                asm volatile("s_waitcnt vmcnt(0)" ::: "memory"); }
            __syncthreads();
            SchedOne S; S.A = (const char*)(ws + WS_H); S.B = (const char*)(ws + WS_WIN); S.tstep = (size_t)256 * DM * 2; S.pm = NLAT / 256 + b; S.pn = pn;
            EpiInProj E{ws};
            pg8::gemm_phase<EpiInProj, SchedOne, false, true, true>(lds, DM, S, E);
        } else phase_norm_tile<0>(a, lds, blockIdx.x, nreg, NROWS / 16); });
    PH(2, {
        gemm_stagger();
        SchedPlain S; S.init((gridDim.x >= 64 ? NLAT : NROWS) / 256, WIN_ROWS / 256, gridDim.x, blockIdx.x); S.A = (const char*)(ws + WS_H); S.B = (const char*)(ws + WS_WIN); S.tstep = (size_t)256 * DM * 2;
        EpiInProj E{ws};
        pg8::gemm_phase<EpiInProj, SchedPlain, false, true, true>(lds, DM, S, E); });
    PH(3, { for (int it = blockIdx.x; it < 288; it += gridDim.x) gla_passA128(a, lds, it); });
    PH(4, gla_passB(a));
    PH(5, { for (int it = blockIdx.x; it < 256; it += gridDim.x) gla_passC(a, lds, it); });
    PH(6, { phase_f1(a, lds); phase_gla_merge(a); });
    PH(8, phase_f34(a, lds));
    PH(9, {
        gemm_stagger();
        SchedPlain S; S.init(NLAT / 256, DM / 256, gridDim.x, blockIdx.x); S.A = (const char*)(ws + WS_YCAT); S.B = (const char*)(ws + WS_WOUT); S.tstep = (size_t)256 * DM * 2;
        EpiOutProj E{a.in[0], (bf16*)(ws + WS_DLT), (const float*)(ws + WS_ADA)};
        pg8::gemm_phase<EpiOutProj, SchedPlain, false, true, true>(lds, DM, S, E); });
    PH(10, phase_norm_tile<1>(a, lds, blockIdx.x, gridDim.x, NLAT / 16));
    PH(11, phase_topk(a, lds));
    PH(12, {
        gemm_stagger();
        SchedMoeUp S; S.init(256, 8, gridDim.x, blockIdx.x); S.A = (const char*)(ws + WS_HF); S.B = (const char*)(ws + WS_WGU); S.tok = (const int*)(ws + WS_TOK);
        EpiSwiglu E{(bf16*)(ws + WS_HID)};
        pg8::gemm_phase<EpiSwiglu, SchedMoeUp, true, true, true>(lds, DM, S, E); });
    PH(13, {
        gemm_stagger();
        SchedMoeDown S; S.init(256, 8, gridDim.x, blockIdx.x); S.A = (const char*)(ws + WS_HID); S.B = (const char*)(ws + WS_WD);
        EpiBf16 E{(bf16*)(ws + WS_YE), DM};
        pg8::gemm_phase<EpiBf16, SchedMoeDown, false, true, true>(lds, DEXP, S, E); });
    PH(14, phase_final(a));
#undef PH
#undef IN
#undef SEAM
}

#ifndef N_LAUNCH_MODE
#define N_LAUNCH_MODE 1
#endif
extern "C" void kernel_launch(void* const* d_in, const int* in_sizes, int n_in, void* d_out, int out_size, void* d_ws, size_t ws_size, hipStream_t stream) {
    static int grid = 0;
    if (grid == 0) {
        if (n_in != 20 || out_size != NLAT * DM || ws_size < WS_END) { fprintf(stderr, "kernel_launch: unexpected sizes n_in %d out %d ws %zu\n", n_in, out_size, ws_size); grid = -1; return; }
        int dev = 0, cus = 0, per_cu = 0;
        (void)hipGetDevice(&dev); (void)hipDeviceGetAttribute(&cus, hipDeviceAttributeMultiprocessorCount, dev);
        if (hipFuncSetAttribute((const void*)mega, hipFuncAttributeMaxDynamicSharedMemorySize, LDS_BYTES) != hipSuccess) { fprintf(stderr, "kernel_launch: hipFuncSetAttribute failed\n"); grid = -1; return; }
        (void)hipOccupancyMaxActiveBlocksPerMultiprocessor(&per_cu, (const void*)mega, NTHREADS, LDS_BYTES);
        if (per_cu < 1) { fprintf(stderr, "kernel_launch: occupancy query reports %d blocks per CU\n", per_cu); per_cu = 1; }
        (void)hipGetLastError();
        grid = cus * 1;
    }
    if (grid < 0) return;
    Args a{};
    for (int i = 0; i < 20; ++i) a.in[i] = (const float*)d_in[i];
    a.out = (float*)d_out; a.ws = (unsigned char*)d_ws;
#if N_LAUNCH_MODE == 0
    for (int p = 0; p < NPHASES; ++p) { a.ph_lo = p; a.ph_hi = p + 1; hipLaunchKernelGGL(mega, dim3(grid), dim3(NTHREADS), LDS_BYTES, stream, a); }
#else
    a.ph_lo = 0; a.ph_hi = NPHASES;
#if USE_CG_SYNC
    void* args[] = {&a};
    hipError_t e = hipLaunchCooperativeKernel((void*)mega, dim3(grid), dim3(NTHREADS), args, LDS_BYTES, stream);
    if (e != hipSuccess) fprintf(stderr, "cooperative launch failed: %s (grid %d)\n", hipGetErrorString(e), grid);
#else
    if (hipMemsetAsync((char*)d_ws + WS_CTL, 0, CTL_BYTES, stream) != hipSuccess) { fprintf(stderr, "kernel_launch: memset of control words failed\n"); return; }
    hipLaunchKernelGGL(mega, dim3(grid), dim3(NTHREADS), LDS_BYTES, stream, a);
#endif
#endif
}
```

```cpp
#include <hip/hip_runtime.h>
#include <hip/hip_cooperative_groups.h>
#include <cstdio>
#include <cstdint>
namespace cg = cooperative_groups;

#define LAS __attribute__((address_space(3)))
typedef unsigned short bf16;
typedef short bf16x8 __attribute__((ext_vector_type(8)));
typedef float f32x4 __attribute__((ext_vector_type(4)));
typedef float f32x2 __attribute__((ext_vector_type(2)));
typedef unsigned u32x4 __attribute__((ext_vector_type(4)));
typedef unsigned u32x2 __attribute__((ext_vector_type(2)));

constexpr int NB = 2, SEQ = 16384, DM = 2048, CTXL = 256;
constexpr int NLAT = NB * SEQ;
constexpr int NROWS = NLAT + NB * CTXL;
constexpr int PROJW = 4128;
constexpr int NE = 16, CAP = 2048, DEXP = 1024;
constexpr int PW = 4096;
constexpr int WIN_ROWS = 4096;
constexpr float EPS = 1e-6f;

constexpr size_t MiB = 1u << 20;
constexpr size_t WS_ADA = 0;
constexpr size_t WS_TW = 1 * MiB;
constexpr size_t WS_FC = 1 * MiB + 256 * 1024;
constexpr size_t WS_FS = 1 * MiB + 320 * 1024;
constexpr size_t WS_WRH = 1 * MiB + 384 * 1024;
constexpr size_t WS_WRL = 1 * MiB + 448 * 1024;
constexpr size_t WS_Z = 2 * MiB;
constexpr size_t WS_AFF = 8 * MiB;
constexpr size_t WS_TOK = 10 * MiB;
constexpr size_t WS_GATE = 11 * MiB;
constexpr size_t WS_SEL = 12 * MiB;
constexpr size_t WS_ST0 = 14 * MiB;
constexpr size_t WS_CTL = 16 * MiB;
constexpr size_t CTL_BYTES = 65536;
constexpr size_t WS_ADAP = 20 * MiB;
constexpr size_t WS_TC = 24 * MiB;
constexpr size_t WS_DTC = 28 * MiB;
constexpr size_t WS_WIN = 32 * MiB;
constexpr size_t WS_WOUT = 50 * MiB;
constexpr size_t WS_WGU = 58 * MiB;
constexpr size_t WS_WD = 186 * MiB;
constexpr int KTOK = SEQ + CTXL;
constexpr size_t WS_QH = 250 * MiB;
constexpr size_t WS_KH = 282 * MiB;
constexpr size_t WS_VH = 316 * MiB;
constexpr size_t WS_G = 382 * MiB;
constexpr size_t WS_U = 446 * MiB;
constexpr size_t WS_HF = 250 * MiB;
constexpr size_t WS_HID = 378 * MiB;
constexpr size_t WS_FX = 250 * MiB;
constexpr size_t WS_FA = 894 * MiB;
constexpr size_t WS_FAI = 958 * MiB;
constexpr size_t WS_H = 510 * MiB;
constexpr size_t WS_OF = 510 * MiB;
constexpr size_t WS_OB = 574 * MiB;
constexpr size_t WS_T = 638 * MiB;
constexpr size_t WS_SST = 670 * MiB;
constexpr size_t WS_DT = 702 * MiB;
constexpr size_t WS_DLT = 510 * MiB;
constexpr size_t WS_YCAT = 766 * MiB;
constexpr size_t WS_YE = 766 * MiB;
constexpr size_t WS_END = 1022 * MiB;

#ifndef USE_CG_SYNC
#define USE_CG_SYNC 0
#endif
#ifndef PROBE_HALF
#define PROBE_HALF 0
#endif
#ifndef KSNAKE
#define KSNAKE 0
#endif
#ifndef PROBE_BAR
#define PROBE_BAR 0
#endif
#ifndef PROBE_HOT
#define PROBE_HOT 0
#endif
#ifndef PROBE_K
#define PROBE_K 0
#endif
#ifndef PROBE_EPI
#define PROBE_EPI 0
#endif
#ifndef PROBE_P0
#define PROBE_P0 0
#endif
#ifndef PROBE_MASK
#define PROBE_MASK 0u
#endif
constexpr int LDS_BYTES = 163840;
constexpr int NTHREADS = 512;

struct Args {
    const float* in[20];
    float* out;
    unsigned char* ws;
    int ph_lo, ph_hi;
};

__device__ __forceinline__ float bf2f(bf16 v) { return __uint_as_float(((unsigned)v) << 16); }
typedef __bf16 bf16x2_t __attribute__((ext_vector_type(2)));
__device__ __forceinline__ unsigned pk2(float lo, float hi) { const f32x2 v = {lo, hi}; return __builtin_bit_cast(unsigned, __builtin_convertvector(v, bf16x2_t)); }
__device__ __forceinline__ unsigned f2bf(float f) { return pk2(f, 0.f) & 0xffffu; }
__device__ __forceinline__ float wave_sum(float v) {
#pragma unroll
    for (int o = 1; o < 64; o <<= 1) v += __shfl_xor(v, o);
    return v;
}
__device__ __forceinline__ float silu_f(float x) { return x / (1.f + __expf(-x)); }
__device__ __forceinline__ float logsigmoid_f(float x) { return fminf(x, 0.f) - log1pf(expf(-fabsf(x))); }

namespace pg8 {
constexpr int BM = 256, BK = 64, HALF = 128, HTB = HALF * BK * 2, STAGE_BYTES = 8 * HTB, NXCD = 8, WGM = 8;
__host__ __device__ __forceinline__ int lds_byte(int r, int c) { const int st = (r >> 4) * 2 + (c >> 5), rr = r & 15, cc = c & 31, ob = rr * 64 + cc * 2; return st * 1024 + (ob ^ (((ob >> 9) & 1) << 5)); }
__host__ __device__ __forceinline__ void stage_rc(int b, int& R, int& C) { const int st = b / 1024, sb = b % 1024, swz = sb ^ (((sb >> 9) & 1) << 5); R = (st >> 1) * 16 + swz / 64; C = (st & 1) * 32 + (swz % 64) / 2; }
__host__ __device__ __forceinline__ int perm32(int rho) { const int n = rho >> 4, i = rho & 15; return 8 * (i >> 2) + 4 * n + (i & 3); }
struct Unit { int pm, pn; };
__device__ __forceinline__ unsigned cvt_pk_bf16(float lo, float hi) { return pk2(lo, hi); }

struct OrderBase {
    int nM, nN, nwg, G, c;
    __device__ void init(int nM_, int nN_, int G_, int c_) { nM = nM_; nN = nN_; nwg = nM * nN; G = G_; c = c_; }
    __device__ bool next(int i, Unit& u) const {
        const long L = (long)(i >> PROBE_K) * G + c; if (L >= nwg) return false;
        int wgid = (int)L; { const int q = nwg / NXCD, r = nwg % NXCD, xcd = wgid % NXCD, off = wgid / NXCD; wgid = (xcd < r ? xcd * (q + 1) : r * (q + 1) + (xcd - r) * q) + off; }
        const int nig = WGM * nN, gid = wgid / nig, fm = gid * WGM, gsz = (nM - fm) < WGM ? (nM - fm) : WGM;
        u.pm = fm + ((wgid % nig) % gsz); u.pn = (wgid % nig) / gsz; if (PROBE_K && PROBE_HOT && !(i & 1)) { u.pm = 0; u.pn = 0; } return true;
    }
};

template <class Epi, class Sched, bool GATHER, bool ALIGN_EPI, bool SP2>
__device__ __forceinline__ void gemm_phase(LAS unsigned char* lds, const int K, const Sched& S, const Epi& E) {
    const int tid = threadIdx.x, wid = __builtin_amdgcn_readfirstlane(tid >> 6), lane = tid & 63, wr = wid >> 2, wc = wid & 3, fr = lane & 15, fq = lane >> 4;
    const int nt = K / BK;
    unsigned voffA[2], voffA1[2], voffB[2];
    int RA[2], CA[2];
#pragma unroll
    for (int i = 0; i < 2; ++i) { int R, C; stage_rc(tid * 16 + i * 8192, R, C); const int Rb = Epi::PERM2 ? (64 * (R >> 5) + perm32(R & 31)) : (Epi::PERM ? ((R & ~31) + perm32(R & 31)) : R);
        RA[i] = R; CA[i] = C;
        voffA[i] = (unsigned)(R * K + C) * 2u; voffA1[i] = voffA[i]; voffB[i] = (unsigned)(Rb * K + C) * 2u; }
    const size_t kstep = (size_t)(BK * 2);
    const size_t hstepA = GATHER ? 0 : (size_t)HALF * K * 2;
    const size_t hstep = (size_t)(Epi::PERM2 ? 32 : HALF) * K * 2;
    const unsigned ldsw = (unsigned)wid * 1024u;
    const int aoff = lds_byte(wr * 64 + fr, fq * 8), boff = lds_byte(wc * 32 + fr, fq * 8);
#define PG8_SA(b, h) (((b) * 2 + (h)) * HTB)
#define PG8_SB(b, h) ((4 + (b) * 2 + (h)) * HTB)
#define PG8_STAGE(bufoff, gbase, voff) do { _Pragma("unroll") for (int _i = 0; _i < 2; ++_i) \
        __builtin_amdgcn_global_load_lds((const unsigned*)((const char*)(gbase) + (voff)[_i]), (LAS unsigned*)(lds + (bufoff) + ldsw + _i * 8192), 16, 0, 0); } while (0)
#define PG8_LDA(dst, b, h) do { _Pragma("unroll") for (int m = 0; m < 4; ++m) _Pragma("unroll") for (int k = 0; k < 2; ++k) dst[m][k] = *(const LAS bf16x8*)(lds + PG8_SA(b, h) + aoff + m * 2048 + k * 1024); } while (0)
#define PG8_LDB(dst, b, h) do { _Pragma("unroll") for (int n = 0; n < 2; ++n) _Pragma("unroll") for (int k = 0; k < 2; ++k) dst[n][k] = *(const LAS bf16x8*)(lds + PG8_SB(b, h) + boff + n * 2048 + k * 1024); } while (0)
#define PG8_MMA(ai, bj, At, Bt) do { __builtin_amdgcn_s_setprio(1); _Pragma("unroll") for (int m = 0; m < 4; ++m) _Pragma("unroll") for (int n = 0; n < 2; ++n) _Pragma("unroll") for (int k = 0; k < 2; ++k) \
        acc[ai][bj][m][n] = __builtin_amdgcn_mfma_f32_16x16x32_bf16(Bt[n][k], At[m][k], acc[ai][bj][m][n], 0, 0, 0); __builtin_amdgcn_s_setprio(0); } while (0)
#define PG8_WAIT_V(n) asm volatile("s_waitcnt vmcnt(" #n ")" ::: "memory")
#define PG8_WAIT_L(n) asm volatile("s_waitcnt lgkmcnt(" #n ")" ::: "memory")
#define PG8_BAR __builtin_amdgcn_s_barrier()
#define PG8_SCHED __builtin_amdgcn_sched_barrier(0)
    Unit cur, nxt; int ui = 0;
    if (!S.next(0, cur)) return;
    f32x4 acc[2][2][4][2];
#pragma unroll
    for (int a = 0; a < 2; ++a)
#pragma unroll
        for (int b = 0; b < 2; ++b)
#pragma unroll
            for (int m = 0; m < 4; ++m)
#pragma unroll
                for (int n = 0; n < 2; ++n) acc[a][b][m][n] = (f32x4){0.f, 0.f, 0.f, 0.f};
    bf16x8 At[4][2], B0[2][2], B1[2][2];
    const long kspan = (long)(nt - 1) * (long)(BK * 2);
    long ck = (long)(BK * 2);
    const char* cA = S.abase(cur); const char* cB = S.bbase(cur);
    if constexpr (GATHER) {
#pragma unroll
        for (int i = 0; i < 2; ++i) { voffA[i] = ((unsigned)S.arow(cur, RA[i]) * (unsigned)K + (unsigned)CA[i]) * 2u; voffA1[i] = ((unsigned)S.arow(cur, HALF + RA[i]) * (unsigned)K + (unsigned)CA[i]) * 2u; }
    }
    static_assert(SP2, "only the SP2 loop is kept");
    PG8_STAGE(PG8_SB(0, 0), cB, voffB); PG8_STAGE(PG8_SB(0, 1), cB + hstep, voffB); PG8_STAGE(PG8_SA(0, 0), cA, voffA); PG8_STAGE(PG8_SA(0, 1), cA + hstepA, voffA1);
    if (wr == 1) PG8_BAR;
    PG8_WAIT_V(2); PG8_BAR;
    PG8_STAGE(PG8_SB(1, 0), cB + kstep, voffB); PG8_STAGE(PG8_SA(1, 0), cA + kstep, voffA); PG8_STAGE(PG8_SB(1, 1), cB + hstep + kstep, voffB);
    PG8_WAIT_V(6); PG8_BAR;
    for (;;) {
        const bool has_next = S.next(ui + 1, nxt);
        const bool nrev = KSNAKE && has_next && (((ui + 1) >> PROBE_K) & 1);
        const long nk = has_next ? (nrev ? -(long)(BK * 2) : (long)(BK * 2)) : ck;
        const char* nA = has_next ? S.abase(nxt) + (nrev ? kspan : 0) : cA; const char* nB = has_next ? S.bbase(nxt) + (nrev ? kspan : 0) : cB;
        for (int t = 0; t < nt; t += 2) {
            const bool last = (t == nt - 2);
            const char* a1 = cA + (long)(t + 1) * ck;
            const char* a2 = last ? nA : cA + (long)(t + 2) * ck; const char* b2 = last ? nB : cB + (long)(t + 2) * ck;
            const char* a3 = a2 + (last ? nk : ck); const char* b3 = b2 + (last ? nk : ck);
            PG8_LDB(B0, 0, 0); PG8_LDB(B1, 0, 1); PG8_SCHED; PG8_LDA(At, 0, 0); PG8_STAGE(PG8_SA(1, 1), a1 + hstepA, voffA1);
            if constexpr (GATHER) { if (last && has_next) {
#pragma unroll
                for (int i = 0; i < 2; ++i) { voffA[i] = ((unsigned)S.arow(nxt, RA[i]) * (unsigned)K + (unsigned)CA[i]) * 2u; voffA1[i] = ((unsigned)S.arow(nxt, HALF + RA[i]) * (unsigned)K + (unsigned)CA[i]) * 2u; } } }
            PG8_WAIT_V(8); PG8_WAIT_L(0); PG8_BAR; PG8_MMA(0, 0, At, B0); PG8_MMA(0, 1, At, B1); PG8_BAR; PG8_SCHED;
            PG8_LDA(At, 0, 1); PG8_STAGE(PG8_SB(0, 0), b2, voffB); PG8_STAGE(PG8_SB(0, 1), b2 + hstep, voffB); PG8_STAGE(PG8_SA(0, 0), a2, voffA);
            PG8_WAIT_V(8); PG8_WAIT_L(0); PG8_BAR; PG8_MMA(1, 0, At, B0); PG8_MMA(1, 1, At, B1); PG8_BAR; PG8_SCHED;
            PG8_LDB(B0, 1, 0); PG8_LDB(B1, 1, 1); PG8_SCHED; PG8_LDA(At, 1, 0); PG8_STAGE(PG8_SA(0, 1), a2 + hstepA, voffA1);
            PG8_WAIT_V(8); PG8_WAIT_L(0); PG8_BAR; PG8_MMA(0, 0, At, B0); PG8_MMA(0, 1, At, B1); PG8_BAR; PG8_SCHED;
            PG8_LDA(At, 1, 1); PG8_STAGE(PG8_SB(1, 0), b3, voffB); PG8_STAGE(PG8_SB(1, 1), b3 + hstep, voffB); PG8_STAGE(PG8_SA(1, 0), a3, voffA);
            PG8_WAIT_V(8); PG8_WAIT_L(0); PG8_BAR; PG8_MMA(1, 0, At, B0); PG8_MMA(1, 1, At, B1); PG8_BAR; PG8_SCHED;
        }
        if constexpr (ALIGN_EPI) { if (wr == 0) PG8_BAR; }
        if (!PROBE_K || (ui & 1)) E(acc, cur, wr, wc, fr, fq);
        if (PROBE_EPI == 1) { asm volatile("" ::: "memory"); E(acc, cur, wr, wc, fr, fq); }
        if (PROBE_EPI == 2) { asm volatile("s_waitcnt vmcnt(0)" ::: "memory"); }
        if (!has_next) break;
#pragma unroll
        for (int a = 0; a < 2; ++a)
#pragma unroll
            for (int b = 0; b < 2; ++b)
#pragma unroll
                for (int m = 0; m < 4; ++m)
#pragma unroll
                    for (int n = 0; n < 2; ++n) acc[a][b][m][n] = (f32x4){0.f, 0.f, 0.f, 0.f};
        cur = nxt; cA = nA; cB = nB; ck = nk; ++ui;
        if constexpr (ALIGN_EPI) { if (wr == 1) PG8_BAR; }
    }
    PG8_WAIT_V(0);
    if constexpr (!ALIGN_EPI) { if (wr == 0) PG8_BAR; }
    PG8_BAR;
#undef PG8_SA
#undef PG8_SB
#undef PG8_STAGE
#undef PG8_LDA
#undef PG8_LDB
#undef PG8_MMA
#undef PG8_WAIT_V
#undef PG8_WAIT_L
#undef PG8_BAR
#undef PG8_SCHED
}
}
using pg8::Unit;
using pg8::cvt_pk_bf16;
constexpr int HALF = pg8::HALF, BM = pg8::BM;

struct SchedPlain : pg8::OrderBase {
    const char* A; const char* B; size_t tstep;
    __device__ __forceinline__ const char* abase(const Unit& u) const { return A + (size_t)u.pm * tstep; }
    __device__ __forceinline__ const char* bbase(const Unit& u) const { return B + (size_t)u.pn * tstep; }
    __device__ __forceinline__ int arow(const Unit&, int) const { return 0; }
};
struct SchedOne {
    const char* A; const char* B; size_t tstep; int pm, pn;
    __device__ __forceinline__ bool next(int i, Unit& u) const { if ((i >> PROBE_K) != 0) return false; u.pm = pm; u.pn = pn; return true; }
    __device__ __forceinline__ const char* abase(const Unit& u) const { return A + (size_t)u.pm * tstep; }
    __device__ __forceinline__ const char* bbase(const Unit& u) const { return B + (size_t)u.pn * tstep; }
    __device__ __forceinline__ int arow(const Unit&, int) const { return 0; }
};
struct SchedMoeUp : pg8::OrderBase {
    const char* A; const char* B; const int* tok;
    __device__ __forceinline__ const char* abase(const Unit&) const { return A; }
    __device__ __forceinline__ const char* bbase(const Unit& u) const { return B + ((size_t)(u.pm >> 4) * 2048 + (size_t)u.pn * 256) * (size_t)(DM * 2); }
    __device__ __forceinline__ int arow(const Unit& u, int r) const { const int e = u.pm >> 4, b = (u.pm >> 3) & 1, mt = u.pm & 7; return b * SEQ + tok[(b * NE + e) * CAP + mt * 256 + r]; }
};
struct SchedMoeDown : pg8::OrderBase {
    const char* A; const char* B;
    __device__ __forceinline__ const char* abase(const Unit& u) const { return A + (size_t)u.pm * 256 * (size_t)(DEXP * 2); }
    __device__ __forceinline__ const char* bbase(const Unit& u) const { return B + ((size_t)(u.pm >> 4) * 2048 + (size_t)u.pn * 256) * (size_t)(DEXP * 2); }
    __device__ __forceinline__ int arow(const Unit&, int) const { return 0; }
};

__device__ __forceinline__ u32x4 swz_xor8(const u32x4 v) { u32x4 r;
    r.x = (unsigned)__builtin_amdgcn_ds_swizzle((int)v.x, 0x201F); r.y = (unsigned)__builtin_amdgcn_ds_swizzle((int)v.y, 0x201F);
    r.z = (unsigned)__builtin_amdgcn_ds_swizzle((int)v.z, 0x201F); r.w = (unsigned)__builtin_amdgcn_ds_swizzle((int)v.w, 0x201F); return r; }
__device__ __forceinline__ void store_pair_rows(bf16* rowp, size_t ld, int fr, const u32x4 w0, const u32x4 w1) {
    const bool hi = (fr & 8) != 0;
    const u32x4 r = swz_xor8(hi ? w0 : w1);
    bf16* p = rowp + (hi ? 32 : 0);
    *(u32x4*)(p) = hi ? r : w0;
    *(u32x4*)(p + 8 * ld) = hi ? w1 : r;
}
struct EpiInProj {
    static constexpr bool PERM = true, PERM2 = true;
    unsigned char* ws;
    __device__ __forceinline__ void operator()(const f32x4 (&acc)[2][2][4][2], const Unit& u, int wr, int wc, int fr, int fq) const {
        const int ct = wc * 64 + 8 * fq;
        const bool lat = u.pm < NLAT / 256; const int b = lat ? u.pm / (SEQ / 256) : u.pm - NLAT / 256, t0 = lat ? (u.pm % (SEQ / 256)) * 256 : SEQ;
        bf16* base; size_t ld;
        if (u.pn < 2) { const int h = 2 * u.pn + (ct >> 7); base = (bf16*)(ws + WS_QH) + ((size_t)(b * 4 + h) * SEQ + t0) * 128 + (ct & 127); ld = 128; }
        else if (u.pn < 4) { const int h = 2 * (u.pn - 2) + (ct >> 7); base = (bf16*)(ws + WS_KH) + ((size_t)(b * 4 + h) * KTOK + t0) * 128 + (ct & 127); ld = 128; }
        else if (u.pn < 8) { const int h = u.pn - 4; base = (bf16*)(ws + WS_VH) + ((size_t)(b * 4 + h) * KTOK + t0) * 256 + ct; ld = 256; }
        else if (u.pn < 12) { base = (bf16*)(ws + WS_G) + (size_t)(u.pm * BM) * 1024 + (u.pn - 8) * 256 + ct; ld = 1024; }
        else { base = (bf16*)(ws + WS_U) + (size_t)(u.pm * BM) * 1024 + (u.pn - 12) * 256 + ct; ld = 1024; }
#pragma unroll
        for (int ai = 0; ai < 2; ++ai)
#pragma unroll
            for (int m = 0; m < 4; ++m) { bf16* rowp = base + (size_t)(wr * 64 + ai * HALF + m * 16 + (fr & 7)) * ld;
                u32x4 w[2];
#pragma unroll
                for (int bj = 0; bj < 2; ++bj) { const f32x4 v0 = acc[ai][bj][m][0], v1 = acc[ai][bj][m][1];
                    w[bj].x = cvt_pk_bf16(v0[0], v0[1]); w[bj].y = cvt_pk_bf16(v0[2], v0[3]); w[bj].z = cvt_pk_bf16(v1[0], v1[1]); w[bj].w = cvt_pk_bf16(v1[2], v1[3]); }
                store_pair_rows(rowp, ld, fr, w[0], w[1]); }
    }
};
struct EpiOutProj {
    static constexpr bool PERM = true, PERM2 = true;
    const float* X; bf16* D; const float* ada;
    __device__ __forceinline__ void operator()(const f32x4 (&acc)[2][2][4][2], const Unit& u, int wr, int wc, int fr, int fq) const {
        const int row0 = u.pm * BM + wr * 64, col0 = u.pn * BM + wc * 64 + 8 * fq;
        const int b = (u.pm * BM) / SEQ;
        const float* g1 = ada + (size_t)b * 12288 + 2 * DM;
        f32x4 gv[2][2];
#pragma unroll
        for (int bj = 0; bj < 2; ++bj)
#pragma unroll
            for (int n = 0; n < 2; ++n) gv[bj][n] = *(const f32x4*)(g1 + col0 + 32 * bj + 4 * n);
#pragma unroll
        for (int ai = 0; ai < 2; ++ai)
#pragma unroll
            for (int m = 0; m < 4; ++m) { const size_t rbase = (size_t)(row0 + ai * HALF + m * 16);
                u32x4 w[2];
#pragma unroll
                for (int bj = 0; bj < 2; ++bj) { const size_t off = (rbase + fr) * DM + col0 + 32 * bj; const f32x4 x0 = *(const f32x4*)(X + off), x1 = *(const f32x4*)(X + off + 4);
                    const f32x4 v0 = x0 + acc[ai][bj][m][0] * gv[bj][0], v1 = x1 + acc[ai][bj][m][1] * gv[bj][1];
                    w[bj].x = cvt_pk_bf16(v0[0], v0[1]); w[bj].y = cvt_pk_bf16(v0[2], v0[3]); w[bj].z = cvt_pk_bf16(v1[0], v1[1]); w[bj].w = cvt_pk_bf16(v1[2], v1[3]); }
                store_pair_rows(D + (rbase + (fr & 7)) * DM + col0, DM, fr, w[0], w[1]);
                asm volatile("" ::: "memory"); }
    }
};
struct EpiSwiglu {
    static constexpr bool PERM = true, PERM2 = false;
    bf16* HID;
    __device__ __forceinline__ void operator()(const f32x4 (&acc)[2][2][4][2], const Unit& u, int wr, int wc, int fr, int fq) const {
        const int row0 = u.pm * BM + wr * 64 + fr, col0 = u.pn * 128 + wc * 32 + 8 * fq;
#pragma unroll
        for (int ai = 0; ai < 2; ++ai)
#pragma unroll
            for (int m = 0; m < 4; ++m) { bf16* rowp = HID + (size_t)(row0 + ai * HALF + m * 16) * DEXP + col0;
                f32x4 h0, h1;
#pragma unroll
                for (int j = 0; j < 4; ++j) { h0[j] = silu_f(acc[ai][0][m][0][j]) * acc[ai][1][m][0][j]; h1[j] = silu_f(acc[ai][0][m][1][j]) * acc[ai][1][m][1][j]; }
                u32x4 w; w.x = cvt_pk_bf16(h0[0], h0[1]); w.y = cvt_pk_bf16(h0[2], h0[3]); w.z = cvt_pk_bf16(h1[0], h1[1]); w.w = cvt_pk_bf16(h1[2], h1[3]);
                *(u32x4*)(rowp) = w; }
    }
};
struct EpiBf16 {
    static constexpr bool PERM = true, PERM2 = true;
    bf16* O; int ldc;
    __device__ __forceinline__ void operator()(const f32x4 (&acc)[2][2][4][2], const Unit& u, int wr, int wc, int fr, int fq) const {
        const int row0 = u.pm * BM + wr * 64 + (fr & 7), col0 = u.pn * BM + wc * 64 + 8 * fq;
#pragma unroll
        for (int ai = 0; ai < 2; ++ai)
#pragma unroll
            for (int m = 0; m < 4; ++m) { bf16* rowp = O + (size_t)(row0 + ai * HALF + m * 16) * ldc + col0;
                u32x4 w[2];
#pragma unroll
                for (int bj = 0; bj < 2; ++bj) { const f32x4 v0 = acc[ai][bj][m][0], v1 = acc[ai][bj][m][1];
                    w[bj].x = cvt_pk_bf16(v0[0], v0[1]); w[bj].y = cvt_pk_bf16(v0[2], v0[3]); w[bj].z = cvt_pk_bf16(v1[0], v1[1]); w[bj].w = cvt_pk_bf16(v1[2], v1[3]); }
                store_pair_rows(rowp, (size_t)ldc, fr, w[0], w[1]); }
    }
};

__device__ __forceinline__ void transpose_item(const float* src, int ldsrc, int scol0, int k0, bf16* dst, size_t drow0, int ldd, LAS float* scr, int lane) {
#pragma unroll 8
    for (int i = 0; i < 32; ++i) { const int kk = 2 * i + (lane >> 5); scr[kk * 33 + (lane & 31)] = src[(size_t)(k0 + kk) * ldsrc + scol0 + (lane & 31)]; }
    asm volatile("s_waitcnt lgkmcnt(0)" ::: "memory");
    const int c = lane & 7;
#pragma unroll
    for (int j = 0; j < 4; ++j) { const int n = (lane >> 3) + 8 * j; const LAS float* s = scr + (8 * c) * 33 + n;
        u32x4 o; o.x = pk2(s[0 * 33], s[1 * 33]); o.y = pk2(s[2 * 33], s[3 * 33]); o.z = pk2(s[4 * 33], s[5 * 33]); o.w = pk2(s[6 * 33], s[7 * 33]);
        *(u32x4*)(dst + (drow0 + n) * (size_t)ldd + k0 + 8 * c) = o; }
    asm volatile("s_waitcnt lgkmcnt(0)" ::: "memory");
}

struct T64 { const float* src; bf16* dst; int ldsrc, ldd; };
__device__ __forceinline__ T64 decode_t64(const Args& a, int r) {
    unsigned char* ws = a.ws; T64 t;
    if (r < 2048) { const int kb = r >> 6, nb = r & 63; const int scol = nb < 48 ? nb * 64 : 3104 + (nb - 48) * 64;
        t.src = a.in[7] + (size_t)(kb * 64) * PROJW + scol; t.ldsrc = PROJW; t.dst = (bf16*)(ws + WS_WIN) + (size_t)(nb * 64) * DM + kb * 64; t.ldd = DM; return t; }
    r -= 2048;
    if (r < 1024) { const int kb = r >> 5, nb = r & 31;
        t.src = a.in[13] + (size_t)(kb * 64) * DM + nb * 64; t.ldsrc = DM; t.dst = (bf16*)(ws + WS_WOUT) + (size_t)(nb * 64) * DM + kb * 64; t.ldd = DM; return t; }
    r -= 1024;
    if (r < 16384) { const int up = r >= 8192; if (up) r -= 8192; const int e = r >> 9, rr = r & 511, kb = rr >> 4, nb = rr & 15, n0 = nb * 64;
        t.src = (up ? a.in[17] : a.in[16]) + (size_t)e * DM * DEXP + (size_t)(kb * 64) * DEXP + n0; t.ldsrc = DEXP;
        t.dst = (bf16*)(ws + WS_WGU) + ((size_t)e * 2048 + (size_t)(n0 >> 7) * 256 + (n0 & 127) + (up ? 128 : 0)) * DM + kb * 64; t.ldd = DM; return t; }
    r -= 16384;
    { const int e = r >> 9, rr = r & 511, kb = rr >> 5, nb = rr & 31;
        t.src = a.in[18] + (size_t)e * DEXP * DM + (size_t)(kb * 64) * DM + nb * 64; t.ldsrc = DM;
        t.dst = (bf16*)(ws + WS_WD) + ((size_t)e * 2048 + nb * 64) * DEXP + kb * 64; t.ldd = DEXP; return t; }
}
__device__ __forceinline__ void t64_load(const T64& t, int lane, f32x4 (&v)[16]) {
    const int krow = lane >> 4, c4 = lane & 15;
#pragma unroll
    for (int i = 0; i < 16; ++i) v[i] = __builtin_nontemporal_load((const f32x4*)(t.src + (size_t)(4 * i + krow) * t.ldsrc + 4 * c4));
}
__device__ __forceinline__ void t64_finish(const T64& t, int lane, const f32x4 (&v)[16], LAS float* scr) {
    const int krow = lane >> 4, c4 = lane & 15;
#pragma unroll
    for (int i = 0; i < 16; ++i) { LAS float* p = scr + (4 * i + krow) * 65 + 4 * c4; p[0] = v[i].x; p[1] = v[i].y; p[2] = v[i].z; p[3] = v[i].w; }
    asm volatile("s_waitcnt lgkmcnt(0)" ::: "memory");
    const int c = lane & 7;
#pragma unroll
    for (int j = 0; j < 8; ++j) { const int n = (lane >> 3) + 8 * j; const LAS float* s = scr + (8 * c) * 65 + n;
        u32x4 o; o.x = pk2(s[0 * 65], s[1 * 65]); o.y = pk2(s[2 * 65], s[3 * 65]); o.z = pk2(s[4 * 65], s[5 * 65]); o.w = pk2(s[6 * 65], s[7 * 65]);
        *(u32x4*)(t.dst + (size_t)n * t.ldd + 8 * c) = o; }
    asm volatile("s_waitcnt lgkmcnt(0)" ::: "memory");
}
constexpr int P0_NT64 = 2048 + 1024 + 16384 + 8192;
constexpr int P0_TAIL = 1024;
constexpr int P0_NGEMV = 192;
__device__ __forceinline__ void phase0(const Args& a, LAS unsigned char* lds) {
    const int tid = threadIdx.x, lane = tid & 63, wave = tid >> 6, G = gridDim.x, blk = blockIdx.x;
    unsigned char* ws = a.ws;
    {
        const float* c = a.in[1]; const float* cc = a.in[3]; const float* w_ada = a.in[4]; const float* b_ada = a.in[5];
        float* part = (float*)(ws + WS_ADAP);
        LAS float* red = (LAS float*)lds;
        for (int rep_ = 0; rep_ < 1 + (PROBE_P0 & 1); ++rep_)
        for (int it = blk; it < P0_NGEMV; it += G) {
            const int cb = it % 48, ks = it / 48, col0 = cb * 256 + 4 * lane, r0 = ks * 512 + wave * 64;
            f32x4 a0 = {0.f, 0.f, 0.f, 0.f}, a1 = a0, a2 = a0;
#pragma unroll 16
            for (int r = r0; r < r0 + 64; ++r) {
                const f32x4 w = *(const f32x4*)(w_ada + (size_t)r * 12288 + col0);
                const float s0 = silu_f(c[r]), s1 = silu_f(c[DM + r]), s2 = silu_f(cc[r]);
                a0 += w * s0; a1 += w * s1; a2 += w * s2;
            }
            *(LAS f32x4*)(red + (wave * 3 + 0) * 256 + 4 * lane) = a0; *(LAS f32x4*)(red + (wave * 3 + 1) * 256 + 4 * lane) = a1; *(LAS f32x4*)(red + (wave * 3 + 2) * 256 + 4 * lane) = a2;
            __syncthreads();
            for (int idx = tid; idx < 768; idx += NTHREADS) { const int v = idx >> 8, col = idx & 255; float s = ks == 0 ? b_ada[cb * 256 + col] : 0.f;
#pragma unroll
                for (int w8 = 0; w8 < 8; ++w8) s += red[(w8 * 3 + v) * 256 + col];
                part[(size_t)(ks * 3 + v) * 12288 + cb * 256 + col] = s; }
            __syncthreads();
        }
    }
    LAS float* scr = (LAS float*)(lds + wave * 16640);
    const int gw = blk * 8 + wave, NGW = G * 8;
    constexpr int I_WZ = 32, I_WR = 512, I_TW = 256, I_FT = 256;
    for (int it = gw; it < I_WZ + I_WR + I_TW + I_FT; it += NGW) {
        int r = it;
        if (r < I_WZ) { transpose_item(a.in[7], PROJW, 3072, r * 64, (bf16*)(ws + WS_WIN), (size_t)4096, DM, scr, lane); continue; }
        r -= I_WZ;
        if (r < I_WR) { const int p = r * 64 + lane, e = p >> 11, d = p & 2047; const float wv = a.in[15][d * 16 + e]; const unsigned hi = f2bf(wv); ((bf16*)(ws + WS_WRH))[p] = (bf16)hi; ((bf16*)(ws + WS_WRL))[p] = (bf16)f2bf(wv - bf2f((bf16)hi)); continue; }
        r -= I_WR;
        if (r < I_TW) { const int p = r * 64 + lane; float s, c; sincospif((float)p * (1.0f / 8192.0f), &s, &c); ((f32x2*)(ws + WS_TW))[p] = (f32x2){c, s}; continue; }
        r -= I_TW;
        { const int p = r * 64 + lane, k = p >> 7, l = p & 127; float s, c; sincospif((float)((k * l) & 127) * (1.0f / 64.0f), &s, &c); ((bf16*)(ws + WS_FC))[p] = (bf16)f2bf(c); ((bf16*)(ws + WS_FS))[p] = (bf16)f2bf(s); }
    }
    const int n_gemv_wg = G > P0_NGEMV ? P0_NGEMV : 0;
    const int head_end = n_gemv_wg ? P0_NT64 - P0_TAIL : P0_NT64;
    const int n_head = gw < head_end ? (head_end - gw + NGW - 1) / NGW : 0;
    const int tgw = (blk - n_gemv_wg) * 8 + wave, tstep = (G - n_gemv_wg) * 8;
    const int n_tail = (n_gemv_wg && blk >= n_gemv_wg && tgw < P0_TAIL) ? (P0_TAIL - tgw + tstep - 1) / tstep : 0;
    const int n_items = n_head + n_tail;
    auto item_of = [&](int j) -> int { return j < n_head ? gw + j * NGW : head_end + tgw + (j - n_head) * tstep; };
    for (int rep_ = 0; rep_ < 1 + ((PROBE_P0 >> 1) & 1); ++rep_) {
    f32x4 va[16], vb[16]; T64 ta, tb;
    if (n_items > 0) { ta = decode_t64(a, item_of(0)); t64_load(ta, lane, va); }
    for (int j = 0; j < n_items; j += 2) {
        const bool h1 = j + 1 < n_items, h2 = j + 2 < n_items;
        if (h1) { tb = decode_t64(a, item_of(j + 1)); t64_load(tb, lane, vb); }
        t64_finish(ta, lane, va, scr);
        if (h2) { ta = decode_t64(a, item_of(j + 2)); t64_load(ta, lane, va); }
        if (h1) t64_finish(tb, lane, vb, scr);
    }
    }
}

#define MFMA16(a, b, c) __builtin_amdgcn_mfma_f32_16x16x32_bf16((a), (b), (c), 0, 0, 0)
__device__ __forceinline__ void finalize_ada(const Args& a) {
    const float* part = (const float*)(a.ws + WS_ADAP); float* adaw = (float*)(a.ws + WS_ADA);
    for (int i = blockIdx.x * NTHREADS + threadIdx.x; i < 3 * 12288; i += gridDim.x * NTHREADS) { float s = 0.f;
#pragma unroll
        for (int ks = 0; ks < 4; ++ks) s += part[(size_t)ks * 3 * 12288 + i];
        adaw[i] = s; }
}
constexpr int CW_CTXCNT = 4096;
template <int MODE>
__device__ __forceinline__ void norm_load_tile(const Args& a, int tile, int rl, int wave, int q, f32x4 (&xv)[8][2], u32x4 (&dv)[8]) {
    const int r = tile * 16 + rl;
    if (MODE == 0) { const float* s = (r < NLAT ? a.in[0] + (size_t)r * DM : a.in[2] + (size_t)(r - NLAT) * DM) + 256 * wave + 8 * q;
#pragma unroll
        for (int ks = 0; ks < 8; ++ks) { xv[ks][0] = *(const f32x4*)(s + 32 * ks); xv[ks][1] = *(const f32x4*)(s + 32 * ks + 4); } }
    if (MODE == 1) { const bf16* dp = (const bf16*)(a.ws + WS_DLT) + (size_t)r * DM + 256 * wave + 8 * q;
#pragma unroll
        for (int ks = 0; ks < 8; ++ks) dv[ks] = *(const u32x4*)(dp + 32 * ks); }
}
template <int MODE>
__device__ __forceinline__ void phase_norm_tile(const Args& a, LAS unsigned char* lds, int first, int stride, int tile_end) {
    const int tid = threadIdx.x, lane = tid & 63, wave = __builtin_amdgcn_readfirstlane(tid >> 6), rl = lane & 15, q = lane >> 4;
    const float* ada = (const float*)(a.ws + WS_ADA);
    LAS float* gs = (LAS float*)lds;
    LAS float* shv = gs + 3 * DM;
    LAS float* ssred = shv + 3 * DM;
    LAS float* red = ssred + 128;
    { const float* gn = MODE == 0 ? a.in[6] : a.in[14]; const float* part = (const float*)(a.ws + WS_ADAP);
      for (int i = tid; i < 3 * DM; i += NTHREADS) { const int v = i / DM, d = i % DM;
          float sh_, sc_;
          if (MODE == 0) { const float* p0 = part + (size_t)v * 12288; sh_ = 0.f; sc_ = 0.f;
#pragma unroll
              for (int ks = 0; ks < 4; ++ks) { sh_ += p0[(size_t)ks * 3 * 12288 + d]; sc_ += p0[(size_t)ks * 3 * 12288 + DM + d]; } }
          else { const float* base = ada + (size_t)v * 12288 + 3 * DM; sh_ = base[d]; sc_ = base[DM + d]; }
          gs[i] = gn[d] * (1.f + sc_); shv[i] = sh_; }
    }
    bf16x8 wb[2][8];
    if (MODE == 0) { const bf16* Wz = (const bf16*)(a.ws + WS_WIN) + (size_t)4096 * DM;
#pragma unroll
        for (int nt = 0; nt < 2; ++nt)
#pragma unroll
            for (int ks = 0; ks < 8; ++ks) wb[nt][ks] = *(const bf16x8*)(Wz + (size_t)(16 * nt + rl) * DM + 256 * wave + 32 * ks + 8 * q);
    } else { const bf16* WH = (const bf16*)(a.ws + WS_WRH); const bf16* WL = (const bf16*)(a.ws + WS_WRL);
#pragma unroll
        for (int ks = 0; ks < 8; ++ks) { wb[0][ks] = *(const bf16x8*)(WH + (size_t)rl * DM + 256 * wave + 32 * ks + 8 * q); wb[1][ks] = *(const bf16x8*)(WL + (size_t)rl * DM + 256 * wave + 32 * ks + 8 * q); } }
    __syncthreads();
    bf16* Hout = (bf16*)(a.ws + (MODE == 0 ? WS_H : WS_HF));
    f32x4 xv[8][2]; u32x4 dv[8];
    auto tile_of = [&](int s) -> int { return MODE == 0 ? (s < 32 ? NLAT / 16 + s : s - 32) : s; };
    int sq = first;
    if (sq < tile_end) norm_load_tile<MODE>(a, tile_of(sq), rl, wave, q, xv, dv);
    for (; sq < tile_end; sq += stride) {
        const int tile = tile_of(sq);
        const int r = tile * 16 + rl;
        const int v = MODE == 0 ? (tile * 16 < NLAT ? (tile * 16) / SEQ : 2) : (tile * 16) / SEQ;
        if (MODE == 1) {
#pragma unroll
            for (int ks = 0; ks < 8; ++ks) { const u32x4 d = dv[ks];
                xv[ks][0] = (f32x4){__uint_as_float(d.x << 16), __uint_as_float(d.x & 0xffff0000u), __uint_as_float(d.y << 16), __uint_as_float(d.y & 0xffff0000u)};
                xv[ks][1] = (f32x4){__uint_as_float(d.z << 16), __uint_as_float(d.z & 0xffff0000u), __uint_as_float(d.w << 16), __uint_as_float(d.w & 0xffff0000u)}; }
            if (sq + stride < tile_end) norm_load_tile<MODE>(a, tile_of(sq + stride), rl, wave, q, xv, dv); }
        float ss = 0.f;
#pragma unroll
        for (int ks = 0; ks < 8; ++ks) { const f32x4 a0 = xv[ks][0], a1 = xv[ks][1]; ss += (a0.x * a0.x + a0.y * a0.y) + (a0.z * a0.z + a0.w * a0.w) + (a1.x * a1.x + a1.y * a1.y) + (a1.z * a1.z + a1.w * a1.w); }
        ss += __shfl_xor(ss, 16); ss += __shfl_xor(ss, 32);
        if (q == 0) ssred[wave * 16 + rl] = ss;
        __syncthreads();
        float tot = 0.f;
#pragma unroll
        for (int w8 = 0; w8 < 8; ++w8) tot += ssred[w8 * 16 + rl];
        const float rstd = rsqrtf(tot * (1.f / DM) + EPS);
        f32x4 acc0 = {0.f, 0.f, 0.f, 0.f}, acc1 = {0.f, 0.f, 0.f, 0.f};
        bf16* orow = Hout + (size_t)r * DM + 256 * wave + 8 * q;
        const LAS float* gsp = gs + v * DM + 256 * wave + 8 * q; const LAS float* shp = shv + v * DM + 256 * wave + 8 * q;
#pragma unroll
        for (int ks = 0; ks < 8; ++ks) {
            const f32x4 g0 = *(const LAS f32x4*)(gsp + 32 * ks), g1 = *(const LAS f32x4*)(gsp + 32 * ks + 4), s0 = *(const LAS f32x4*)(shp + 32 * ks), s1 = *(const LAS f32x4*)(shp + 32 * ks + 4);
            const f32x4 h0 = xv[ks][0] * rstd * g0 + s0, h1 = xv[ks][1] * rstd * g1 + s1;
            u32x4 hw; hw.x = pk2(h0.x, h0.y); hw.y = pk2(h0.z, h0.w); hw.z = pk2(h1.x, h1.y); hw.w = pk2(h1.z, h1.w);
            *(u32x4*)(orow + 32 * ks) = hw;
            const bf16x8 hf = __builtin_bit_cast(bf16x8, hw);
            if (MODE == 0) { acc0 = MFMA16(hf, wb[0][ks], acc0); acc1 = MFMA16(hf, wb[1][ks], acc1); }
            else { u32x4 lw;
                lw.x = pk2(h0.x - __uint_as_float(hw.x << 16), h0.y - __uint_as_float(hw.x & 0xffff0000u)); lw.y = pk2(h0.z - __uint_as_float(hw.y << 16), h0.w - __uint_as_float(hw.y & 0xffff0000u));
                lw.z = pk2(h1.x - __uint_as_float(hw.z << 16), h1.y - __uint_as_float(hw.z & 0xffff0000u)); lw.w = pk2(h1.z - __uint_as_float(hw.w << 16), h1.w - __uint_as_float(hw.w & 0xffff0000u));
                const bf16x8 lf = __builtin_bit_cast(bf16x8, lw);
                acc0 = MFMA16(hf, wb[0][ks], acc0); acc0 = MFMA16(lf, wb[0][ks], acc0); acc0 = MFMA16(hf, wb[1][ks], acc0); }
        }
        if (MODE == 0 && sq + stride < tile_end) norm_load_tile<MODE>(a, tile_of(sq + stride), rl, wave, q, xv, dv);
#pragma unroll
        for (int rr = 0; rr < 4; ++rr) { red[(wave * 16 + 4 * q + rr) * 32 + rl] = acc0[rr]; if (MODE == 0) red[(wave * 16 + 4 * q + rr) * 32 + 16 + rl] = acc1[rr]; }
        __syncthreads();
        if (MODE == 0) { const int row = tid >> 5, col = tid & 31; float s = 0.f;
#pragma unroll
            for (int w8 = 0; w8 < 8; ++w8) s += red[(w8 * 16 + row) * 32 + col];
            ((float*)(a.ws + WS_Z))[(size_t)(tile * 16 + row) * 32 + col] = s;
        } else if (tid < 256) { const int row = tid >> 4, e = tid & 15; float s = 0.f;
#pragma unroll
            for (int w8 = 0; w8 < 8; ++w8) s += red[(w8 * 16 + row) * 32 + e];
            float m = s; m = fmaxf(m, __shfl_xor(m, 1)); m = fmaxf(m, __shfl_xor(m, 2)); m = fmaxf(m, __shfl_xor(m, 4)); m = fmaxf(m, __shfl_xor(m, 8));
            const float ex = expf(s - m); float sm = ex; sm += __shfl_xor(sm, 1); sm += __shfl_xor(sm, 2); sm += __shfl_xor(sm, 4); sm += __shfl_xor(sm, 8);
            const int rg = tile * 16 + row, b = rg / SEQ, t = rg % SEQ;
            ((float*)(a.ws + WS_AFF))[((size_t)b * NE + e) * SEQ + t] = ex / sm; }
        if (MODE == 0 && tile >= NLAT / 16) {
            __threadfence(); __syncthreads();
            if (tid == 0) __hip_atomic_fetch_add((unsigned*)(a.ws + WS_CTL) + CW_CTXCNT + 64 * ((tile - NLAT / 16) >> 4), 1u, __ATOMIC_RELAXED, __HIP_MEMORY_SCOPE_AGENT);
        }
        __syncthreads();
    }
}

constexpr int GQ_LD = 136, GK_LD = 72;
constexpr int GL_Q = 0, GL_KI = 17408, GL_KET = 34816, GL_VT = 53248, GL_ST = 90112, GL_DC = 159744, GL_SEG = 160256;
__device__ __forceinline__ bf16x8 ldfrag(const LAS bf16* base, int row0, int ld, int koff, int lane) { return *(const LAS bf16x8*)(base + (row0 + (lane & 15)) * ld + koff + 8 * (lane >> 4)); }
__device__ __forceinline__ float fast_logsigmoid(float x) { return fminf(x, 0.f) - __logf(1.f + __expf(-fabsf(x))); }

struct GlaRaw { u32x4 q[2], k[2], v[4]; f32x2 z; };
template <bool FULL>
__device__ __forceinline__ void gla_issue_loads(const Args& a, int b, int h, int dir, int t0, size_t zrow0, int tid, GlaRaw& r) {
    const bf16* QH = (const bf16*)(a.ws + WS_QH) + ((size_t)(b * 4 + h) * SEQ + t0) * 128; const bf16* KH = (const bf16*)(a.ws + WS_KH) + ((size_t)(b * 4 + h) * KTOK + t0) * 128;
    const float* Z = (const float*)(a.ws + WS_Z);
#pragma unroll
    for (int j = 0; j < 2; ++j) { const int e = tid + 512 * j; r.k[j] = *(const u32x4*)(KH + (size_t)e * 8); if (FULL) r.q[j] = *(const u32x4*)(QH + (size_t)e * 8); }
    { const int e = tid * 2; r.z = *(const f32x2*)(Z + (zrow0 + (e >> 4)) * 32 + dir * 16 + (e & 15)); }
}
__device__ __forceinline__ void gla_issue_v(const Args& a, int b, int h, int t0, int tid, GlaRaw& r) {
    const bf16* VH = (const bf16*)(a.ws + WS_VH) + ((size_t)(b * 4 + h) * KTOK + t0) * 256;
#pragma unroll
    for (int rr = 0; rr < 4; ++rr) r.v[rr] = *(const u32x4*)(VH + (size_t)(4 * (tid >> 5) + rr) * 256 + 8 * (tid & 31));
}
__device__ __forceinline__ void gla_store_vt(LAS unsigned char* lds, int tid, const u32x4 (&x)[4]) {
    LAS bf16* VT = (LAS bf16*)(lds + GL_VT); const int c0 = 8 * (tid & 31), l0 = 4 * (tid >> 5);
    const int sw = (((l0 >> 3) ^ ((c0 >> 3) & 7)) << 3) + (l0 & 7);
#pragma unroll
    for (int i2 = 0; i2 < 4; ++i2) {
        const unsigned a0 = x[0][i2], a1 = x[1][i2], a2 = x[2][i2], a3 = x[3][i2];
        u32x2 lo, hi; lo.x = (a0 & 0xffffu) | (a1 << 16); lo.y = (a2 & 0xffffu) | (a3 << 16); hi.x = (a0 >> 16) | (a1 & 0xffff0000u); hi.y = (a2 >> 16) | (a3 & 0xffff0000u);
        *(LAS u32x2*)(VT + (c0 + 2 * i2) * GK_LD + sw) = lo; *(LAS u32x2*)(VT + (c0 + 2 * i2 + 1) * GK_LD + sw) = hi; }
}
__device__ __forceinline__ bf16x8 ldfrag_vt(const LAS bf16* VT, int row0, int ld, int kc, int lane) { const int row = row0 + (lane & 15); return *(const LAS bf16x8*)(VT + row * ld + ((kc ^ ((row >> 3) & 7)) << 3)); }
template <bool FULL>
__device__ __forceinline__ void gla_stage(LAS unsigned char* lds, int wave, int lane, int tid, const GlaRaw& r) {
    LAS bf16* Qd = (LAS bf16*)(lds + GL_Q); LAS bf16* Ki = (LAS bf16*)(lds + GL_KI); LAS unsigned* zs = (LAS unsigned*)(lds + GL_SEG);
#pragma unroll
    for (int j = 0; j < 2; ++j) { const int e = tid + 512 * j, row = e >> 4, c8 = e & 15;
        *(LAS u32x4*)(Ki + row * GQ_LD + 8 * c8) = r.k[j]; if (FULL) *(LAS u32x4*)(Qd + row * GQ_LD + 8 * c8) = r.q[j]; }
    zs[tid] = pk2(r.z.x, r.z.y);
    gla_store_vt(lds, tid, r.v);
}
template <bool FULL>
__device__ __forceinline__ void gla_prep(LAS unsigned char* lds, int dir, const bf16x8 wfrag, float bias, float& totacc) {
    const int tid = threadIdx.x, lane = tid & 63, wave = __builtin_amdgcn_readfirstlane(tid >> 6), cidx = lane & 15, q = lane >> 4, d = 16 * wave + cidx;
    LAS bf16* Qd = (LAS bf16*)(lds + GL_Q); LAS bf16* Ki = (LAS bf16*)(lds + GL_KI); LAS bf16* KeT = (LAS bf16*)(lds + GL_KET);
    LAS float* dcv = (LAS float*)(lds + GL_DC); const LAS bf16* zs = (const LAS bf16*)(lds + GL_SEG);
    float c[4][4], t4[4], sq[4], Tt[4];
#pragma unroll
    for (int it = 0; it < 4; ++it) {
        const bf16x8 zf = *(const LAS bf16x8*)(zs + (16 * it + cidx) * 16 + 8 * (q & 1));
        f32x4 pre = {bias, bias, bias, bias};
        pre = MFMA16(zf, wfrag, pre);
#pragma unroll
        for (int r = 0; r < 4; ++r) c[it][r] = fast_logsigmoid(pre[r]) * (1.f / 16.f);
        if (!dir) { c[it][1] += c[it][0]; c[it][2] += c[it][1]; c[it][3] += c[it][2]; t4[it] = c[it][3]; }
        else { c[it][2] += c[it][3]; c[it][1] += c[it][2]; c[it][0] += c[it][1]; t4[it] = c[it][0]; }
        float s = t4[it];
        if (!dir) { const float u = __shfl_up(s, 16); if (q >= 1) s += u; const float u2 = __shfl_up(s, 32); if (q >= 2) s += u2; Tt[it] = __shfl(s, cidx + 48); }
        else { const float u = __shfl_down(s, 16); if (q <= 2) s += u; const float u2 = __shfl_down(s, 32); if (q <= 1) s += u2; Tt[it] = __shfl(s, cidx); }
        sq[it] = s - t4[it];
    }
    const float total = (Tt[0] + Tt[1]) + (Tt[2] + Tt[3]);
    float off[4];
    if (!dir) { off[0] = 0.f; off[1] = Tt[0]; off[2] = Tt[0] + Tt[1]; off[3] = Tt[0] + Tt[1] + Tt[2]; }
    else { off[3] = 0.f; off[2] = Tt[3]; off[1] = Tt[3] + Tt[2]; off[0] = Tt[3] + Tt[2] + Tt[1]; }
    const float dc = __expf(total);
#pragma unroll
    for (int it = 0; it < 4; ++it) {
        float ke[4];
#pragma unroll
        for (int r = 0; r < 4; ++r) { const int i = 16 * it + 4 * q + r; const float cum = c[it][r] + off[it] + sq[it];
            const float kf = bf2f(Ki[i * GQ_LD + d]);
            if (FULL) { const float qf = bf2f(Qd[i * GQ_LD + d]); const float kin = kf * __expf(-cum);
                Qd[i * GQ_LD + d] = (bf16)f2bf(qf * 0.08838834764831845f * __expf(cum)); Ki[i * GQ_LD + d] = (bf16)f2bf(kin); ke[r] = kin * dc; }
            else ke[r] = kf * __expf(total - cum); }
        u32x2 kw; kw.x = pk2(ke[0], ke[1]); kw.y = pk2(ke[2], ke[3]);
        *(LAS u32x2*)(KeT + d * GK_LD + 16 * it + 4 * q) = kw;
    }
    if (q == 0) { dcv[d] = dc; totacc += total; }
}
__device__ __forceinline__ bf16x8 gla_wfrag(const float* w_a2, int h, int wave, int lane) {
    const int d = 16 * wave + (lane & 15), q = lane >> 4; unsigned wv[4];
#pragma unroll
    for (int j2 = 0; j2 < 4; ++j2) { float x[2];
#pragma unroll
        for (int u = 0; u < 2; ++u) { const float wf = w_a2[(8 * (q & 1) + 2 * j2 + u) * 512 + h * 128 + d]; const float hi = bf2f((bf16)f2bf(wf)); x[u] = q < 2 ? hi : wf - hi; }
        wv[j2] = pk2(x[0], x[1]); }
    return __builtin_bit_cast(bf16x8, (u32x4){wv[0], wv[1], wv[2], wv[3]});
}
__device__ __forceinline__ void gla_state_update(LAS unsigned char* lds, int lane, const bf16x8 (&vt)[2][2], f32x4 (&acc)[8][2]) {
    const LAS bf16* KeT = (const LAS bf16*)(lds + GL_KET); const LAS float* dcv = (const LAS float*)(lds + GL_DC);
#pragma unroll
    for (int mt = 0; mt < 8; ++mt) {
        const f32x4 dc4 = *(const LAS f32x4*)(dcv + 16 * mt + 4 * (lane >> 4));
        const bf16x8 k0 = ldfrag(KeT, 16 * mt, GK_LD, 0, lane), k1 = ldfrag(KeT, 16 * mt, GK_LD, 32, lane);
#pragma unroll
        for (int n = 0; n < 2; ++n) { f32x4 t = acc[mt][n] * dc4; t = MFMA16(k0, vt[n][0], t); t = MFMA16(k1, vt[n][1], t); acc[mt][n] = t; }
    }
}
constexpr size_t GLA_SV = 128 * 256;
constexpr int GA_LD = 136;
constexpr int GA_K = 0, GA_KET = 34816, GA_VT = 69632, GA_Z = 139264, GA_DC = 143360;
struct GlaRawA { u32x4 k[4], v[8]; f32x2 z[2]; };
__device__ __forceinline__ void glaA_issue(const Args& a, int b, int h, int dir, int t0, size_t zrow0, int tid, GlaRawA& r) {
    const bf16* KH = (const bf16*)(a.ws + WS_KH) + ((size_t)(b * 4 + h) * KTOK + t0) * 128; const float* Z = (const float*)(a.ws + WS_Z);
#pragma unroll
    for (int j = 0; j < 4; ++j) { const int e = tid + 512 * j; r.k[j] = *(const u32x4*)(KH + (size_t)e * 8); }
#pragma unroll
    for (int j = 0; j < 2; ++j) { const int e = (tid + 512 * j) * 2; r.z[j] = *(const f32x2*)(Z + (zrow0 + (e >> 4)) * 32 + dir * 16 + (e & 15)); }
}
__device__ __forceinline__ void glaA_issue_v(const Args& a, int b, int h, int t0, int tid, GlaRawA& r) {
    const bf16* VH = (const bf16*)(a.ws + WS_VH) + ((size_t)(b * 4 + h) * KTOK + t0) * 256;
#pragma unroll
    for (int j = 0; j < 2; ++j)
#pragma unroll
        for (int rr = 0; rr < 4; ++rr) r.v[4 * j + rr] = *(const u32x4*)(VH + (size_t)(4 * ((tid >> 5) + 16 * j) + rr) * 256 + 8 * (tid & 31));
}
__device__ __forceinline__ void glaA_stage(LAS unsigned char* lds, int wave, int lane, int tid, const GlaRawA& r) {
    LAS bf16* Kr = (LAS bf16*)(lds + GA_K); LAS unsigned* zs = (LAS unsigned*)(lds + GA_Z); LAS bf16* VT = (LAS bf16*)(lds + GA_VT);
#pragma unroll
    for (int j = 0; j < 4; ++j) { const int e = tid + 512 * j, row = e >> 4, c8 = e & 15; *(LAS u32x4*)(Kr + row * GA_LD + 8 * c8) = r.k[j]; }
#pragma unroll
    for (int j = 0; j < 2; ++j) zs[tid + 512 * j] = pk2(r.z[j].x, r.z[j].y);
#pragma unroll
    for (int j = 0; j < 2; ++j) { const int c0 = 8 * (tid & 31), l0 = 4 * ((tid >> 5) + 16 * j);
        const int sw = (((l0 >> 3) ^ ((c0 >> 3) & 7)) << 3) + (l0 & 7);
#pragma unroll
        for (int i2 = 0; i2 < 4; ++i2) {
            const unsigned a0 = r.v[4 * j][i2], a1 = r.v[4 * j + 1][i2], a2 = r.v[4 * j + 2][i2], a3 = r.v[4 * j + 3][i2];
            u32x2 lo, hi; lo.x = (a0 & 0xffffu) | (a1 << 16); lo.y = (a2 & 0xffffu) | (a3 << 16); hi.x = (a0 >> 16) | (a1 & 0xffff0000u); hi.y = (a2 >> 16) | (a3 & 0xffff0000u);
            *(LAS u32x2*)(VT + (c0 + 2 * i2) * GA_LD + sw) = lo; *(LAS u32x2*)(VT + (c0 + 2 * i2 + 1) * GA_LD + sw) = hi; } }
}
__device__ __forceinline__ void glaA_prep(LAS unsigned char* lds, int dir, const bf16x8 wfrag, float bias, float& totacc) {
    const int tid = threadIdx.x, lane = tid & 63, wave = __builtin_amdgcn_readfirstlane(tid >> 6), cidx = lane & 15, q = lane >> 4, d = 16 * wave + cidx;
    const LAS bf16* Kr = (const LAS bf16*)(lds + GA_K); LAS bf16* KeT = (LAS bf16*)(lds + GA_KET); LAS float* dcv = (LAS float*)(lds + GA_DC); const LAS bf16* zs = (const LAS bf16*)(lds + GA_Z);
    float carry = 0.f;
    for (int hh = 0; hh < 2; ++hh) {
        const int it0 = 4 * (dir ? hh : 1 - hh);
        float c[4][4], sq[4], Tt[4];
#pragma unroll
        for (int i = 0; i < 4; ++i) {
            const bf16x8 zf = *(const LAS bf16x8*)(zs + (16 * (it0 + i) + cidx) * 16 + 8 * (q & 1));
            f32x4 pre = {bias, bias, bias, bias};
            pre = MFMA16(zf, wfrag, pre);
#pragma unroll
            for (int r = 0; r < 4; ++r) c[i][r] = fast_logsigmoid(pre[r]) * (1.f / 16.f);
            float t4;
            if (!dir) { c[i][1] += c[i][0]; c[i][2] += c[i][1]; c[i][3] += c[i][2]; t4 = c[i][3]; }
            else { c[i][2] += c[i][3]; c[i][1] += c[i][2]; c[i][0] += c[i][1]; t4 = c[i][0]; }
            float s = t4;
            if (!dir) { const float u = __shfl_up(s, 16); if (q >= 1) s += u; const float u2 = __shfl_up(s, 32); if (q >= 2) s += u2; Tt[i] = __shfl(s, cidx + 48); }
            else { const float u = __shfl_down(s, 16); if (q <= 2) s += u; const float u2 = __shfl_down(s, 32); if (q <= 1) s += u2; Tt[i] = __shfl(s, cidx); }
            sq[i] = s - t4;
        }
        const float toth = (Tt[0] + Tt[1]) + (Tt[2] + Tt[3]);
        float off[4];
        if (!dir) { off[0] = 0.f; off[1] = Tt[0]; off[2] = Tt[0] + Tt[1]; off[3] = Tt[0] + Tt[1] + Tt[2]; }
        else { off[3] = 0.f; off[2] = Tt[3]; off[1] = Tt[3] + Tt[2]; off[0] = Tt[3] + Tt[2] + Tt[1]; }
#pragma unroll
        for (int i = 0; i < 4; ++i) {
            float ke[4];
#pragma unroll
            for (int r = 0; r < 4; ++r) { const int tk = 16 * (it0 + i) + 4 * q + r; const float cum = c[i][r] + off[i] + sq[i]; ke[r] = bf2f(Kr[tk * GA_LD + d]) * __expf(toth - cum + carry); }
            u32x2 kw; kw.x = pk2(ke[0], ke[1]); kw.y = pk2(ke[2], ke[3]);
            *(LAS u32x2*)(KeT + d * GA_LD + 16 * (it0 + i) + 4 * q) = kw;
        }
        carry += toth;
    }
    if (q == 0) { dcv[d] = __expf(carry); totacc += carry; }
}
__device__ __forceinline__ void gla_passA128(const Args& a, LAS unsigned char* lds, int item) {
    const int tid = threadIdx.x, lane = tid & 63, wave = __builtin_amdgcn_readfirstlane(tid >> 6), q = lane >> 4, cidx = lane & 15;
    const bool is_ctx = item >= 256; const int seq = is_ctx ? (item - 256) >> 1 : item >> 4, s = is_ctx ? (item - 256) & 1 : item & 15;
    const int b = seq >> 3, dir = (seq >> 2) & 1, h = seq & 3, nstep = is_ctx ? 1 : 8;
    const size_t rowbase = is_ctx ? (size_t)(NLAT + b * CTXL + s * 128) : (size_t)b * SEQ + (size_t)s * 1024;
    const float* w_a2 = dir ? a.in[10] : a.in[8]; const float* b_a2 = dir ? a.in[11] : a.in[9];
    const bf16x8 wfrag = gla_wfrag(w_a2, h, wave, lane);
    const float bias = b_a2[h * 128 + 16 * wave + cidx];
    f32x4 acc[8][2];
#pragma unroll
    for (int mt = 0; mt < 8; ++mt) { acc[mt][0] = (f32x4){0.f, 0.f, 0.f, 0.f}; acc[mt][1] = (f32x4){0.f, 0.f, 0.f, 0.f}; }
    float totacc = 0.f;
    const int tbase = is_ctx ? SEQ + s * 128 : s * 1024;
    GlaRawA raw; { const int n0 = dir ? (nstep - 1) : 0; glaA_issue(a, b, h, dir, tbase + n0 * 128, rowbase + (size_t)n0 * 128, tid, raw); glaA_issue_v(a, b, h, tbase + n0 * 128, tid, raw); }
    for (int ci = 0; ci < nstep; ++ci) {
        const int nn = dir ? (nstep - 2 - ci) : ci + 1;
        glaA_stage(lds, wave, lane, tid, raw);
        if (ci + 1 < nstep) glaA_issue(a, b, h, dir, tbase + nn * 128, rowbase + (size_t)nn * 128, tid, raw);
        __syncthreads();
        glaA_prep(lds, dir, wfrag, bias, totacc);
        __syncthreads();
        const LAS bf16* VT = (const LAS bf16*)(lds + GA_VT); const LAS bf16* KeT = (const LAS bf16*)(lds + GA_KET); const LAS float* dcv = (const LAS float*)(lds + GA_DC);
        bf16x8 vt[2][4];
#pragma unroll
        for (int n2 = 0; n2 < 2; ++n2)
#pragma unroll
            for (int ks = 0; ks < 4; ++ks) vt[n2][ks] = ldfrag_vt(VT, 32 * wave + 16 * n2, GA_LD, 4 * ks + (lane >> 4), lane);
#pragma unroll
        for (int mt = 0; mt < 8; ++mt) {
            const f32x4 dc4 = *(const LAS f32x4*)(dcv + 16 * mt + 4 * q);
            bf16x8 kf[4];
#pragma unroll
            for (int ks = 0; ks < 4; ++ks) kf[ks] = ldfrag(KeT, 16 * mt, GA_LD, 32 * ks, lane);
#pragma unroll
            for (int n2 = 0; n2 < 2; ++n2) { f32x4 t = acc[mt][n2] * dc4;
#pragma unroll
                for (int ks = 0; ks < 4; ++ks) t = MFMA16(kf[ks], vt[n2][ks], t);
                acc[mt][n2] = t; }
        }
        if (ci + 1 < nstep) glaA_issue_v(a, b, h, tbase + nn * 128, tid, raw);
        __syncthreads();
    }
    float* T = is_ctx ? (float*)(a.ws + WS_TC) + (size_t)(item - 256) * GLA_SV : (float*)(a.ws + WS_T) + (size_t)item * GLA_SV;
#pragma unroll
    for (int mt = 0; mt < 8; ++mt)
#pragma unroll
        for (int n2 = 0; n2 < 2; ++n2)
#pragma unroll
            for (int r = 0; r < 4; ++r) T[(size_t)(16 * mt + 4 * q + r) * 256 + 32 * wave + 16 * n2 + cidx] = acc[mt][n2][r];
    if (q == 0) { float* D = is_ctx ? (float*)(a.ws + WS_DTC) + (size_t)(item - 256) * 128 : (float*)(a.ws + WS_DT) + (size_t)item * 128; D[16 * wave + cidx] = __expf(totacc); }
}

__device__ __forceinline__ void gla_passB(const Args& a) {
    const float* T = (const float*)(a.ws + WS_T); const float* DT = (const float*)(a.ws + WS_DT); float* SST = (float*)(a.ws + WS_SST);
    for (int e = blockIdx.x * NTHREADS + threadIdx.x; e < 16 * (int)GLA_SV; e += gridDim.x * NTHREADS) {
        const int seq = e >> 15, dv = e & 32767, d = dv >> 8, dir = (seq >> 2) & 1;
        float S = 0.f;
        { const float* TC = (const float*)(a.ws + WS_TC); const float* DTC = (const float*)(a.ws + WS_DTC);
#pragma unroll
          for (int j = 0; j < 2; ++j) { const int cc = dir ? 1 - j : j; S = DTC[(size_t)(seq * 2 + cc) * 128 + d] * S + TC[(size_t)(seq * 2 + cc) * GLA_SV + dv]; } }
        float tv[16], dd[16];
#pragma unroll
        for (int si = 0; si < 16; ++si) { const int s = dir ? 15 - si : si; const size_t it = (size_t)seq * 16 + s; tv[si] = T[it * GLA_SV + dv]; dd[si] = DT[it * 128 + d]; }
#pragma unroll
        for (int si = 0; si < 16; ++si) { const int s = dir ? 15 - si : si; const size_t it = (size_t)seq * 16 + s;
            SST[it * GLA_SV + dv] = S; S = dd[si] * S + tv[si]; }
    }
}
__device__ __forceinline__ void gla_passC(const Args& a, LAS unsigned char* lds, int item) {
    const int tid = threadIdx.x, lane = tid & 63, wave = __builtin_amdgcn_readfirstlane(tid >> 6), q = lane >> 4, cidx = lane & 15;
    const int seq = item >> 4, s = item & 15, b = seq >> 3, dir = (seq >> 2) & 1, h = seq & 3;
    const size_t rowbase = (size_t)b * SEQ + (size_t)s * 1024;
    const float* w_a2 = dir ? a.in[10] : a.in[8]; const float* b_a2 = dir ? a.in[11] : a.in[9];
    bf16* O = (bf16*)(a.ws + (dir ? WS_OB : WS_OF));
    const bf16x8 wfrag = gla_wfrag(w_a2, h, wave, lane);
    const float bias = b_a2[h * 128 + 16 * wave + cidx];
    LAS bf16* Qd = (LAS bf16*)(lds + GL_Q); LAS bf16* Ki = (LAS bf16*)(lds + GL_KI); LAS bf16* Pm = Ki; LAS bf16* VT = (LAS bf16*)(lds + GL_VT); LAS bf16* ST = (LAS bf16*)(lds + GL_ST);
    f32x4 acc[8][2];
    { const float* S0 = (const float*)(a.ws + WS_SST) + (size_t)item * GLA_SV;
#pragma unroll
      for (int mt = 0; mt < 8; ++mt)
#pragma unroll
          for (int n2 = 0; n2 < 2; ++n2) {
#pragma unroll
              for (int r = 0; r < 4; ++r) acc[mt][n2][r] = S0[(size_t)(16 * mt + 4 * q + r) * 256 + 32 * wave + 16 * n2 + cidx];
              u32x2 wv; wv.x = pk2(acc[mt][n2][0], acc[mt][n2][1]); wv.y = pk2(acc[mt][n2][2], acc[mt][n2][3]);
              *(LAS u32x2*)(ST + (32 * wave + 16 * n2 + cidx) * GQ_LD + 16 * mt + 4 * q) = wv; } }
    float totacc = 0.f;
    const int tbase = s * 1024;
    GlaRaw raw; gla_issue_loads<true>(a, b, h, dir, tbase + (dir ? 15 : 0) * 64, rowbase + (size_t)(dir ? 15 : 0) * 64, tid, raw); gla_issue_v(a, b, h, tbase + (dir ? 15 : 0) * 64, tid, raw);
    for (int ci = 0; ci < 16; ++ci) {
        const int n = dir ? (15 - ci) : ci; const size_t row0 = rowbase + (size_t)n * 64; const int nn = dir ? (14 - ci) : ci + 1;
        gla_stage<true>(lds, wave, lane, tid, raw);
        if (ci + 1 < 16) gla_issue_loads<true>(a, b, h, dir, tbase + nn * 64, rowbase + (size_t)nn * 64, tid, raw);
        __syncthreads();
        gla_prep<true>(lds, dir, wfrag, bias, totacc);
        __syncthreads();
        const int it = wave >> 1;
        u32x2 pw[2];
#pragma unroll
        for (int jj = 0; jj < 2; ++jj) { const int jt = 2 * (wave & 1) + jj; f32x4 sc = {0.f, 0.f, 0.f, 0.f};
#pragma unroll
            for (int ks = 0; ks < 4; ++ks) sc = MFMA16(ldfrag(Ki, 16 * jt, GQ_LD, 32 * ks, lane), ldfrag(Qd, 16 * it, GQ_LD, 32 * ks, lane), sc);
            const int i = 16 * it + cidx, j0 = 16 * jt + 4 * q;
#pragma unroll
            for (int r = 0; r < 4; ++r) { const bool keep = dir ? (j0 + r >= i) : (j0 + r <= i); sc[r] = keep ? sc[r] : 0.f; }
            pw[jj].x = pk2(sc[0], sc[1]); pw[jj].y = pk2(sc[2], sc[3]); }
        __syncthreads();
#pragma unroll
        for (int jj = 0; jj < 2; ++jj) *(LAS u32x2*)(Pm + (16 * it + cidx) * GK_LD + 16 * (2 * (wave & 1) + jj) + 4 * q) = pw[jj];
        __syncthreads();
        bf16x8 vt[2][2], st[2][4];
#pragma unroll
        for (int n2 = 0; n2 < 2; ++n2) { vt[n2][0] = ldfrag_vt(VT, 32 * wave + 16 * n2, GK_LD, (lane >> 4), lane); vt[n2][1] = ldfrag_vt(VT, 32 * wave + 16 * n2, GK_LD, 4 + (lane >> 4), lane);
#pragma unroll
            for (int ks = 0; ks < 4; ++ks) st[n2][ks] = ldfrag(ST, 32 * wave + 16 * n2, GQ_LD, 32 * ks, lane); }
#pragma unroll
        for (int i2 = 0; i2 < 4; ++i2) {
            const bf16x8 p0 = ldfrag(Pm, 16 * i2, GK_LD, 0, lane), p1 = ldfrag(Pm, 16 * i2, GK_LD, 32, lane);
            bf16x8 qf[4];
#pragma unroll
            for (int ks = 0; ks < 4; ++ks) qf[ks] = ldfrag(Qd, 16 * i2, GQ_LD, 32 * ks, lane);
#pragma unroll
            for (int n2 = 0; n2 < 2; ++n2) { f32x4 o = {0.f, 0.f, 0.f, 0.f};
                o = MFMA16(vt[n2][0], p0, o); o = MFMA16(vt[n2][1], p1, o);
#pragma unroll
                for (int ks = 0; ks < 4; ++ks) o = MFMA16(st[n2][ks], qf[ks], o);
                u32x2 wv; wv.x = pk2(o[0], o[1]); wv.y = pk2(o[2], o[3]);
                *(u32x2*)(O + (row0 + 16 * i2 + cidx) * 1024 + h * 256 + 32 * wave + 16 * n2 + 4 * q) = wv; }
            if (i2 & 1) asm volatile("" ::: "memory");
        }
        if (ci + 1 < 16) gla_issue_v(a, b, h, tbase + nn * 64, tid, raw);
        gla_state_update(lds, lane, vt, acc);
#pragma unroll
        for (int mt = 0; mt < 8; ++mt)
#pragma unroll
            for (int n2 = 0; n2 < 2; ++n2) { u32x2 wv; wv.x = pk2(acc[mt][n2][0], acc[mt][n2][1]); wv.y = pk2(acc[mt][n2][2], acc[mt][n2][3]);
                *(LAS u32x2*)(ST + (32 * wave + 16 * n2 + cidx) * GQ_LD + 16 * mt + 4 * q) = wv; }
        __syncthreads();
    }
}

__device__ __forceinline__ void merge_load(const bf16* OF, const bf16* OB, const bf16* G, int r0, int NGW, int lane, u32x2 (&fa)[2][4], u32x2 (&fb)[2][4], u32x2 (&gw2)[2][4]) {
#pragma unroll
    for (int u = 0; u < 2; ++u) { const int r = r0 + u * NGW; if (r < NLAT) {
#pragma unroll
        for (int j = 0; j < 4; ++j) { const int col = 256 * j + 4 * lane; fa[u][j] = *(const u32x2*)(OF + (size_t)r * 1024 + col); fb[u][j] = *(const u32x2*)(OB + (size_t)r * 1024 + col); gw2[u][j] = *(const u32x2*)(G + (size_t)r * 1024 + col); } } }
}
__device__ __forceinline__ void phase_gla_merge(const Args& a) {
    const int tid = threadIdx.x, lane = tid & 63, wave = tid >> 6;
    if (PROBE_HALF && blockIdx.x >= gridDim.x / 2) return;
    const int gw = blockIdx.x * 8 + wave, NGW = (PROBE_HALF ? gridDim.x / 2 : gridDim.x) * 8;
    const bf16* OF = (const bf16*)(a.ws + WS_OF); const bf16* OB = (const bf16*)(a.ws + WS_OB);
    const bf16* G = (const bf16*)(a.ws + WS_G); bf16* Y = (bf16*)(a.ws + WS_YCAT); const float* gg = a.in[12];
    f32x4 gn[4];
#pragma unroll
    for (int j = 0; j < 4; ++j) gn[j] = *(const f32x4*)(gg + 256 * j + 4 * lane);
    u32x2 fa[2][4], fb[2][4], gw2[2][4], na[2][4], nb[2][4], ng[2][4];
    if (gw < NLAT) merge_load(OF, OB, G, gw, NGW, lane, fa, fb, gw2);
    for (int r0 = gw; r0 < NLAT; r0 += 2 * NGW) {
        if (r0 + 2 * NGW < NLAT) merge_load(OF, OB, G, r0 + 2 * NGW, NGW, lane, na, nb, ng);
#pragma unroll
        for (int u = 0; u < 2; ++u) { const int r = r0 + u * NGW; if (r < NLAT) {
#pragma unroll
            for (int j = 0; j < 4; ++j) {
                const int col = 256 * j + 4 * lane;
                f32x4 o; o.x = __uint_as_float(fa[u][j].x << 16) + __uint_as_float(fb[u][j].x << 16); o.y = __uint_as_float(fa[u][j].x & 0xffff0000u) + __uint_as_float(fb[u][j].x & 0xffff0000u);
                o.z = __uint_as_float(fa[u][j].y << 16) + __uint_as_float(fb[u][j].y << 16); o.w = __uint_as_float(fa[u][j].y & 0xffff0000u) + __uint_as_float(fb[u][j].y & 0xffff0000u);
                const float ss = wave_sum((o.x * o.x + o.y * o.y) + (o.z * o.z + o.w * o.w));
                const float rstd = rsqrtf(ss * (1.f / 256.f) + EPS);
                const float g0 = __uint_as_float(gw2[u][j].x << 16), g1 = __uint_as_float(gw2[u][j].x & 0xffff0000u), g2 = __uint_as_float(gw2[u][j].y << 16), g3 = __uint_as_float(gw2[u][j].y & 0xffff0000u);
                u32x2 w; w.x = pk2(o.x * rstd * gn[j].x * silu_f(g0), o.y * rstd * gn[j].y * silu_f(g1)); w.y = pk2(o.z * rstd * gn[j].z * silu_f(g2), o.w * rstd * gn[j].w * silu_f(g3));
                *(u32x2*)(Y + (size_t)r * DM + col) = w;
            } } }
#pragma unroll
        for (int u = 0; u < 2; ++u)
#pragma unroll
            for (int j = 0; j < 4; ++j) { fa[u][j] = na[u][j]; fb[u][j] = nb[u][j]; gw2[u][j] = ng[u][j]; }
    }
}

constexpr int FLD = 136;
__device__ __forceinline__ void load_dft_frags(const unsigned char* ws, int wave, int lane, bf16x8 (&fc)[4], bf16x8 (&fs)[4]) {
    const bf16* FC = (const bf16*)(ws + WS_FC); const bf16* FS = (const bf16*)(ws + WS_FS);
    const int k = 16 * wave + (lane & 15);
#pragma unroll
    for (int ks = 0; ks < 4; ++ks) { fc[ks] = *(const bf16x8*)(FC + k * 128 + ks * 32 + 8 * (lane >> 4)); fs[ks] = *(const bf16x8*)(FS + k * 128 + ks * 32 + 8 * (lane >> 4)); }
}
__device__ __forceinline__ void store_t4x8(LAS bf16* XT, int c0, int l0, const u32x4 (&x)[4]) {
#pragma unroll
    for (int i2 = 0; i2 < 4; ++i2) {
        const unsigned a0 = x[0][i2], a1 = x[1][i2], a2 = x[2][i2], a3 = x[3][i2];
        u32x2 lo, hi; lo.x = (a0 & 0xffffu) | (a1 << 16); lo.y = (a2 & 0xffffu) | (a3 << 16); hi.x = (a0 >> 16) | (a1 & 0xffff0000u); hi.y = (a2 >> 16) | (a3 & 0xffff0000u);
        const int sw = (((l0 >> 3) ^ ((c0 >> 3) & 7)) << 3) + (l0 & 7);
        *(LAS u32x2*)(XT + (c0 + 2 * i2) * FLD + sw) = lo; *(LAS u32x2*)(XT + (c0 + 2 * i2 + 1) * FLD + sw) = hi; }
}
__device__ __forceinline__ bf16x8 ldfrag_sw(const LAS bf16* XT, int row0, int kc, int lane) { const int row = row0 + (lane & 15); return *(const LAS bf16x8*)(XT + row * FLD + ((kc ^ ((row >> 3) & 7)) << 3)); }
__device__ __forceinline__ void phase_f1(const Args& a, LAS unsigned char* lds) {
    const int tid = threadIdx.x, lane = tid & 63, wave = __builtin_amdgcn_readfirstlane(tid >> 6), q = lane >> 4, cidx = lane & 15;
    const bf16* P = (const bf16*)(a.ws + WS_U); const f32x2* TW = (const f32x2*)(a.ws + WS_TW);
    bf16* A1r = (bf16*)(a.ws + WS_FA); bf16* A1i = (bf16*)(a.ws + WS_FAI);
    LAS bf16* XT = (LAS bf16*)lds;
    bf16x8 fc[4], fs[4]; load_dft_frags(a.ws, wave, lane, fc, fs);
    const int k1 = 16 * wave + cidx;
    u32x4 xp[2][4];
    auto f1_load = [&](int item) { const int cb = item & 3, l2 = (item >> 2) & 127, b = item >> 9, ch0 = cb * 256;
#pragma unroll
        for (int j = 0; j < 2; ++j) { const int task = tid + 512 * j, cblk = task & 31, lb = task >> 5;
#pragma unroll
            for (int r = 0; r < 4; ++r) xp[j][r] = *(const u32x4*)(P + ((size_t)b * SEQ + 128 * (4 * lb + r) + l2) * 1024 + ch0 + 8 * cblk); } };
    if ((int)blockIdx.x < 1024) f1_load(blockIdx.x);
    for (int item = blockIdx.x; item < 1024; item += gridDim.x) {
        const int cb = item & 3, l2 = (item >> 2) & 127, b = item >> 9, ch0 = cb * 256;
#pragma unroll
        for (int j = 0; j < 2; ++j) { const int task = tid + 512 * j, cblk = task & 31, lb = task >> 5; store_t4x8(XT, 8 * cblk, 4 * lb, xp[j]); }
        if (item + (int)gridDim.x < 1024) f1_load(item + gridDim.x);
        __syncthreads();
        const f32x2 tw = TW[l2 * k1];
        LAS unsigned char* ost = lds + 69632 + wave * 8448;
        u32x2 wim[16];
#pragma unroll
        for (int mt = 0; mt < 16; ++mt) {
            f32x4 cr = {0.f, 0.f, 0.f, 0.f}, cs = {0.f, 0.f, 0.f, 0.f};
#pragma unroll
            for (int ks = 0; ks < 4; ++ks) { const bf16x8 xa = ldfrag_sw(XT, 16 * mt, 4 * ks + q, lane); cr = MFMA16(xa, fc[ks], cr); cs = MFMA16(xa, fs[ks], cs); }
            const f32x4 br = cr * tw.x - cs * tw.y, bi = -(cs * tw.x + cr * tw.y);
            u32x2 wr_; wr_.x = pk2(br[0], br[1]); wr_.y = pk2(br[2], br[3]); wim[mt].x = pk2(bi[0], bi[1]); wim[mt].y = pk2(bi[2], bi[3]);
            *(LAS u32x2*)(ost + cidx * 528 + (16 * mt + 4 * q) * 2) = wr_;
        }
        const size_t obase = (((size_t)b * 128 + 16 * wave) * 128 + l2) * 1024 + ch0;
#pragma unroll
        for (int i = 0; i < 8; ++i) { const int row = 2 * i + (lane >> 5), ck = lane & 31; const u32x4 v = *(const LAS u32x4*)(ost + row * 528 + ck * 16); *(u32x4*)(A1r + obase + (size_t)row * 128 * 1024 + 8 * ck) = v; }
#pragma unroll
        for (int mt = 0; mt < 16; ++mt) *(LAS u32x2*)(ost + cidx * 528 + (16 * mt + 4 * q) * 2) = wim[mt];
#pragma unroll
        for (int i = 0; i < 8; ++i) { const int row = 2 * i + (lane >> 5), ck = lane & 31; const u32x4 v = *(const LAS u32x4*)(ost + row * 528 + ck * 16); *(u32x4*)(A1i + obase + (size_t)row * 128 * 1024 + 8 * ck) = v; }
        __syncthreads();
    }
}
__device__ __forceinline__ void phase_f34(const Args& a, LAS unsigned char* lds) {
    const int tid = threadIdx.x, lane = tid & 63, wave = __builtin_amdgcn_readfirstlane(tid >> 6), q = lane >> 4, cidx = lane & 15;
    const bf16* A1r = (const bf16*)(a.ws + WS_FA); const bf16* A1i = (const bf16*)(a.ws + WS_FAI); bf16* Y = (bf16*)(a.ws + WS_YCAT);
    LAS bf16* XTr = (LAS bf16*)lds; LAS bf16* XTi = XTr + 128 * FLD; LAS bf16* XKr = XTi + 128 * FLD; LAS bf16* XKi = XKr + 128 * FLD;
    bf16x8 fc[4], fs[4]; load_dft_frags(a.ws, wave, lane, fc, fs);
    const float nrm = 1.0f / 1448.15468787005f;
    u32x4 xr[4], xi[4];
    auto f34_load = [&](int item) { const int g = item & 7, k1 = (item >> 3) & 127, b = item >> 10, ch0 = g * 128; const int cblk = tid & 15, lb = tid >> 4;
#pragma unroll
        for (int r = 0; r < 4; ++r) { const size_t off = (((size_t)b * 128 + k1) * 128 + 4 * lb + r) * 1024 + ch0 + 8 * cblk; xr[r] = *(const u32x4*)(A1r + off); xi[r] = *(const u32x4*)(A1i + off); } };
    if ((int)blockIdx.x < 2048) f34_load(blockIdx.x);
    for (int item = blockIdx.x; item < 2048; item += gridDim.x) {
        const int g = item & 7, k1 = (item >> 3) & 127, b = item >> 10, ch0 = g * 128;
        { const int cblk = tid & 15, lb = tid >> 4; store_t4x8(XTr, 8 * cblk, 4 * lb, xr); store_t4x8(XTi, 8 * cblk, 4 * lb, xi); }
        if (item + (int)gridDim.x < 2048) f34_load(item + gridDim.x);
        __syncthreads();
        const int k2 = 16 * wave + cidx;
#pragma unroll 2
        for (int mt = 0; mt < 8; ++mt) {
            f32x4 a1 = {0.f, 0.f, 0.f, 0.f}, a2 = a1, b1 = a1, b2 = a1;
#pragma unroll
            for (int ks = 0; ks < 4; ++ks) { const bf16x8 xa = ldfrag_sw(XTr, 16 * mt, 4 * ks + q, lane); const bf16x8 xb = ldfrag_sw(XTi, 16 * mt, 4 * ks + q, lane);
                a1 = MFMA16(xa, fc[ks], a1); b2 = MFMA16(xa, fs[ks], b2); a2 = MFMA16(xb, fs[ks], a2); b1 = MFMA16(xb, fc[ks], b1); }
            const f32x4 xre = a1 + a2, xim = b1 - b2;
            u32x2 wr_; wr_.x = pk2(xre[0], xre[1]); wr_.y = pk2(xre[2], xre[3]); u32x2 wi_; wi_.x = pk2(xim[0], xim[1]); wi_.y = pk2(xim[2], xim[3]);
            *(LAS u32x2*)(XKr + k2 * FLD + 16 * mt + 4 * q) = wr_; *(LAS u32x2*)(XKi + k2 * FLD + 16 * mt + 4 * q) = wi_;
        }
        __syncthreads();
#pragma unroll 2
        for (int nt = 0; nt < 8; ++nt) {
            f32x4 y = {0.f, 0.f, 0.f, 0.f};
#pragma unroll
            for (int ks = 0; ks < 4; ++ks) { const bf16x8 xa = *(const LAS bf16x8*)(XKr + (16 * nt + cidx) * FLD + ks * 32 + 8 * q); const bf16x8 xb = *(const LAS bf16x8*)(XKi + (16 * nt + cidx) * FLD + ks * 32 + 8 * q);
                y = MFMA16(fc[ks], xa, y); y = MFMA16(fs[ks], xb, y); }
            u32x2 w; w.x = pk2(y[0] * nrm, y[1] * nrm); w.y = pk2(y[2] * nrm, y[3] * nrm);
            *(LAS u32x2*)(XTr + (16 * nt + cidx) * FLD + 16 * wave + 4 * q) = w;
        }
        __syncthreads();
#pragma unroll
        for (int i = 0; i < 4; ++i) { const int task = tid + 512 * i, row = task >> 4, ck = task & 15; const u32x4 v = *(const LAS u32x4*)(XTr + row * FLD + 8 * ck);
            *(u32x4*)(Y + ((size_t)b * SEQ + k1 + 128 * row) * DM + 1024 + ch0 + 8 * ck) = v; }
        __syncthreads();
    }
}

__device__ __forceinline__ void phase_topk(const Args& a, LAS unsigned char* lds) {
    const int tid = threadIdx.x, lane = tid & 63, wave = tid >> 6;
    LAS unsigned* keys = (LAS unsigned*)lds;
    LAS unsigned* hist = (LAS unsigned*)(lds + 65536);
    LAS unsigned* misc = hist + 256;
    LAS unsigned* wtot = misc + 16;
    const float* AFF = (const float*)(a.ws + WS_AFF); int* TOK = (int*)(a.ws + WS_TOK); float* GATE = (float*)(a.ws + WS_GATE); int* SEL = (int*)(a.ws + WS_SEL);
    for (int be = blockIdx.x; be < NB * NE; be += gridDim.x) {
        const int b = be / NE, e = be % NE;
        for (int i = tid; i < SEQ; i += NTHREADS) keys[i] = __float_as_uint(AFF[(size_t)be * SEQ + i]);
        unsigned prefix = 0u, pmask = 0u, krem = CAP;
        for (int pass = 0; pass < 4; ++pass) {
            const int shift = 24 - 8 * pass;
            if (tid < 256) hist[tid] = 0u;
            __syncthreads();
            for (int i = tid; i < SEQ; i += NTHREADS) { const unsigned k = keys[i]; if ((k & pmask) == prefix) __hip_atomic_fetch_add(&hist[(k >> shift) & 255u], 1u, __ATOMIC_RELAXED, __HIP_MEMORY_SCOPE_WORKGROUP); }
            __syncthreads();
            if (wave == 0) {
                const unsigned h0 = hist[4 * lane], h1 = hist[4 * lane + 1], h2 = hist[4 * lane + 2], h3 = hist[4 * lane + 3];
                const unsigned sl = h0 + h1 + h2 + h3; unsigned S = sl;
#pragma unroll
                for (int o = 1; o < 64; o <<= 1) { const unsigned t = __shfl_down(S, o); if (lane + o < 64) S += t; }
                const unsigned long long m = __ballot(S >= krem);
                const int ls = 63 - __builtin_clzll(m);
                if (lane == ls) { unsigned cum = S - sl; int bsel;
                    if (cum + h3 >= krem) bsel = 3; else { cum += h3; if (cum + h2 >= krem) bsel = 2; else { cum += h2; if (cum + h1 >= krem) bsel = 1; else { cum += h1; bsel = 0; } } }
                    misc[0] = prefix | ((unsigned)(4 * lane + bsel) << shift); misc[1] = krem - cum; }
            }
            __syncthreads();
            prefix = misc[0]; krem = misc[1]; pmask |= (0xffu << shift);
            __syncthreads();
        }
        const unsigned T = prefix;
        unsigned cg_ = 0u, ce = 0u;
        for (int i = 0; i < 32; ++i) { const unsigned k = keys[tid * 32 + i]; cg_ += (k > T); ce += (k == T); }
        unsigned ig = cg_, ie = ce;
#pragma unroll
        for (int o = 1; o < 64; o <<= 1) { const unsigned tg = __shfl_up(ig, o), te = __shfl_up(ie, o); if (lane >= o) { ig += tg; ie += te; } }
        if (lane == 63) { wtot[wave * 2] = ig; wtot[wave * 2 + 1] = ie; }
        __syncthreads();
        unsigned gt_before = ig - cg_, eq_before = ie - ce;
        for (int w8 = 0; w8 < wave; ++w8) { gt_before += wtot[w8 * 2]; eq_before += wtot[w8 * 2 + 1]; }
        for (int i = 0; i < 32; ++i) { const int t = tid * 32 + i; const unsigned k = keys[t];
            const bool isgt = k > T, iseq = k == T; const bool take = isgt || (iseq && eq_before < krem);
            const unsigned slot = gt_before + (eq_before < krem ? eq_before : krem);
            if (take) { TOK[(size_t)be * CAP + slot] = t; GATE[(size_t)be * CAP + slot] = __uint_as_float(k); }
            SEL[((size_t)b * SEQ + t) * NE + e] = take ? (int)slot : -1;
            gt_before += isgt; eq_before += iseq; }
        __syncthreads();
    }
}

__device__ __forceinline__ void acc_yrow(f32x4 (&m)[8], const u32x2 (&w)[8], float gt) {
#pragma unroll
    for (int j = 0; j < 8; ++j) { m[j].x += gt * __uint_as_float(w[j].x << 16); m[j].y += gt * __uint_as_float(w[j].x & 0xffff0000u); m[j].z += gt * __uint_as_float(w[j].y << 16); m[j].w += gt * __uint_as_float(w[j].y & 0xffff0000u); }
}
__device__ __forceinline__ void phase_final(const Args& a) {
    const int tid = threadIdx.x, lane = tid & 63, wave = tid >> 6;
    if (PROBE_HALF && blockIdx.x >= gridDim.x / 2) return;
    const int gw = blockIdx.x * 8 + wave, NGW = (PROBE_HALF ? gridDim.x / 2 : gridDim.x) * 8;
    const float* ada = (const float*)(a.ws + WS_ADA); const float* fg = a.in[19];
    const bf16* DL = (const bf16*)(a.ws + WS_DLT); const bf16* YE = (const bf16*)(a.ws + WS_YE);
    const float* GATE = (const float*)(a.ws + WS_GATE); const int* SEL = (const int*)(a.ws + WS_SEL);
    int selA = -1, selB = -1;
    { const int r = gw; if (r < NLAT && lane < NE) selA = SEL[(size_t)r * NE + lane]; if (r + NGW < NLAT && lane < NE) selB = SEL[(size_t)(r + NGW) * NE + lane]; }
    for (int r0 = gw; r0 < NLAT; r0 += 2 * NGW) {
        const int rA = r0, rB = r0 + NGW; const bool hasB = rB < NLAT;
        const int bA = rA / SEQ, bB = hasB ? rB / SEQ : bA;
        u32x2 dlA[8], dlB[8];
#pragma unroll
        for (int j = 0; j < 8; ++j) { dlA[j] = *(const u32x2*)(DL + (size_t)rA * DM + 256 * j + 4 * lane); dlB[j] = *(const u32x2*)(DL + (size_t)(hasB ? rB : rA) * DM + 256 * j + 4 * lane); }
        const float gtA = selA >= 0 ? GATE[((size_t)bA * NE + lane) * CAP + selA] : 0.f, gtB = selB >= 0 ? GATE[((size_t)bB * NE + lane) * CAP + selB] : 0.f;
        const int rowA = selA >= 0 ? (lane * 2 + bA) * CAP + selA : 0, rowB = selB >= 0 ? (lane * 2 + bB) * CAP + selB : 0;
        unsigned long long mA = __ballot(selA >= 0), mB = __ballot(selB >= 0);
        { const int rn = r0 + 2 * NGW; selA = -1; selB = -1; if (rn < NLAT && lane < NE) selA = SEL[(size_t)rn * NE + lane]; if (rn + NGW < NLAT && lane < NE) selB = SEL[(size_t)(rn + NGW) * NE + lane]; }
        f32x4 accA[8], accB[8];
#pragma unroll
        for (int j = 0; j < 8; ++j) { accA[j] = (f32x4){0.f, 0.f, 0.f, 0.f}; accB[j] = (f32x4){0.f, 0.f, 0.f, 0.f}; }
        while (mA | mB) {
            const bool hA = mA != 0ull, hB = mB != 0ull;
            const int eA = hA ? __builtin_ctzll(mA) : 0, eB = hB ? __builtin_ctzll(mB) : 0; mA &= mA - 1; mB &= mB - 1;
            const int yrA = hA ? __builtin_amdgcn_readlane(rowA, eA) : 0, yrB = hB ? __builtin_amdgcn_readlane(rowB, eB) : 0;
            const float gA = hA ? __builtin_bit_cast(float, __builtin_amdgcn_readlane(__builtin_bit_cast(int, gtA), eA)) : 0.f;
            const float gB = hB ? __builtin_bit_cast(float, __builtin_amdgcn_readlane(__builtin_bit_cast(int, gtB), eB)) : 0.f;
            const bf16* y0 = YE + (size_t)yrA * DM + 4 * lane; const bf16* y1 = YE + (size_t)yrB * DM + 4 * lane;
            u32x2 w0[8], w1[8];
#pragma unroll
            for (int j = 0; j < 8; ++j) { w0[j] = *(const u32x2*)(y0 + 256 * j); w1[j] = *(const u32x2*)(y1 + 256 * j); }
            acc_yrow(accA, w0, gA); acc_yrow(accB, w1, gB);
        }
#pragma unroll
        for (int u = 0; u < 2; ++u) { if (u == 1 && !hasB) break;
            const int r = u ? rB : rA; const float* g2 = ada + (size_t)(u ? bB : bA) * 12288 + 5 * DM;
            float ss = 0.f; f32x4 m[8];
#pragma unroll
            for (int j = 0; j < 8; ++j) { const int d = 256 * j + 4 * lane; const f32x4 gv = *(const f32x4*)(g2 + d); const u32x2 dw = u ? dlB[j] : dlA[j];
                const f32x4 dv = {__uint_as_float(dw.x << 16), __uint_as_float(dw.x & 0xffff0000u), __uint_as_float(dw.y << 16), __uint_as_float(dw.y & 0xffff0000u)};
                m[j] = dv + gv * (u ? accB[j] : accA[j]); ss += (m[j].x * m[j].x + m[j].y * m[j].y) + (m[j].z * m[j].z + m[j].w * m[j].w); }
            const float rstd = rsqrtf(wave_sum(ss) * (1.f / DM) + EPS);
#pragma unroll
            for (int j = 0; j < 8; ++j) { const int d = 256 * j + 4 * lane; const f32x4 gv = *(const f32x4*)(fg + d);
                *(f32x4*)(a.out + (size_t)r * DM + d) = m[j] * rstd * gv; }
        }
    }
}

#define XB_TMO      128
#define XB_XCNT(j)  (256  + 64 * (j))
#define XB_XSUB(j)  (1280 + 64 * (j))
#define XB_XGEN(j)  (2304 + 64 * (j))
#define XB_TOP      3328
#define XB_TOPGEN   3392
#define XCD_BAR_WORDS 3456
#define XB_SPIN_CAP (1u << 18)
__device__ __forceinline__ unsigned xb_ld(unsigned* p)              { return __hip_atomic_load(p, __ATOMIC_RELAXED, __HIP_MEMORY_SCOPE_AGENT); }
__device__ __forceinline__ unsigned xb_add(unsigned* p, unsigned v) { return __hip_atomic_fetch_add(p, v, __ATOMIC_RELAXED, __HIP_MEMORY_SCOPE_AGENT); }
__device__ __forceinline__ unsigned xb_xcc_id() { return (unsigned)__builtin_amdgcn_s_getreg((3 << 11) | 20) & 0xFu; }
#define XB_SPIN(cond, bar) do { unsigned _sp = 0; while (cond) { __builtin_amdgcn_s_sleep(1); \
    if ((++_sp & 255u) == 0u) { if (xb_ld(&(bar)[XB_TMO])) break; if (_sp > XB_SPIN_CAP) { atomicAdd(&(bar)[XB_TMO], 1u); break; } } } } while (0)
struct XcdBarrier { unsigned* bar; unsigned x; volatile LAS unsigned* st; };
__device__ __forceinline__ XcdBarrier xcd_barrier_post(unsigned* bar, volatile LAS unsigned* st) {
    XcdBarrier b; b.bar = bar; b.x = xb_xcc_id(); b.st = st;
    if (threadIdx.x == 0) (void)xb_add(&bar[XB_XCNT(b.x)], 1u);
    return b;
}
__device__ __forceinline__ void xcd_barrier_complete(unsigned* bar, unsigned x, unsigned& nloc, unsigned& nx) {
    const unsigned G = gridDim.x * gridDim.y * gridDim.z;
    unsigned sum, cnt, mine, sp = 0u;
    for (;;) {
        sum = 0u; cnt = 0u; mine = 0u;
#pragma unroll
        for (unsigned j = 0; j < 16; ++j) { const unsigned c = xb_ld(&bar[XB_XCNT(j)]); sum += c; cnt += (c > 0u) ? 1u : 0u; mine = (j == x) ? c : mine; }
        if (sum == G) break;
        __builtin_amdgcn_s_sleep(1);
        if ((++sp & 255u) == 0u) { if (xb_ld(&bar[XB_TMO])) break; if (sp > XB_SPIN_CAP) { atomicAdd(&bar[XB_TMO], 1u); break; } }
    }
    nloc = mine > 0u ? mine : 1u; nx = cnt > 0u ? cnt : 1u;
}
__device__ __forceinline__ void xcd_barrier(const XcdBarrier& b) {
    asm volatile("s_waitcnt vmcnt(0)" ::: "memory");
    __syncthreads();
    if (threadIdx.x == 0) {
        unsigned* bar = b.bar;
        __builtin_amdgcn_s_waitcnt(0);
        unsigned nloc = b.st[0], nx = b.st[1];
        if (nloc == 0u) { xcd_barrier_complete(bar, b.x, nloc, nx); b.st[0] = nloc; b.st[1] = nx; }
        const unsigned old = xb_add(&bar[XB_XSUB(b.x)], 1u);
        const unsigned gen = old / nloc;
        if (old + 1u == (gen + 1u) * nloc) {
            __builtin_amdgcn_fence(__ATOMIC_RELEASE, "agent");
            asm volatile("s_waitcnt vmcnt(0)" ::: "memory");
            const unsigned og = xb_add(&bar[XB_TOP], 1u);
            const unsigned tg = og / nx;
            if (og + 1u == (tg + 1u) * nx) xb_add(&bar[XB_TOPGEN], 1u);
            else XB_SPIN(xb_ld(&bar[XB_TOPGEN]) == tg, bar);
            __builtin_amdgcn_fence(__ATOMIC_ACQUIRE, "agent");
            xb_add(&bar[XB_XGEN(b.x)], 1u);
            asm volatile("s_waitcnt vmcnt(0)" ::: "memory");
        } else {
            XB_SPIN(xb_ld(&bar[XB_XGEN(b.x)]) == gen, bar);
            __builtin_amdgcn_fence(__ATOMIC_ACQUIRE, "agent");
            asm volatile("s_waitcnt vmcnt(0)" ::: "memory");
        }
    }
    __syncthreads();
}

#ifndef STAGGER_US
#define STAGGER_US 0
#endif
__device__ __forceinline__ void gemm_stagger() {
    if (STAGGER_US > 0 && (blockIdx.x & 1)) { const unsigned long long t0 = __builtin_amdgcn_s_memrealtime();
        while (__builtin_amdgcn_s_memrealtime() - t0 < (unsigned long long)(STAGGER_US * 100)) __builtin_amdgcn_s_sleep(32); }
}
constexpr int NPHASES = 15;
__global__ void __launch_bounds__(NTHREADS, 2) mega(Args a) {
    extern __shared__ __attribute__((aligned(16))) unsigned char lds_raw[];
    LAS unsigned char* lds = (LAS unsigned char*)lds_raw;
    const int lo = a.ph_lo, hi = a.ph_hi;
    unsigned char* ws = a.ws;
#if USE_CG_SYNC
    cg::grid_group grid = cg::this_grid();
#define GRID_SYNC() grid.sync()
#else
    volatile LAS unsigned* bst = (volatile LAS unsigned*)(lds + LDS_BYTES - 16);
    if (threadIdx.x < 2) bst[threadIdx.x] = 0u;
    __syncthreads();
    XcdBarrier xbar = xcd_barrier_post((unsigned*)(ws + WS_CTL), bst);
#define GRID_SYNC() xcd_barrier(xbar)
#endif
#define IN(k) (lo <= (k) && (k) < hi)
#define SEAM(k) do { if (IN(k) && IN((k) + 1)) { GRID_SYNC(); if (PROBE_BAR) GRID_SYNC(); } } while (0)
#define PH(k, ...) do { if (IN(k)) { __VA_ARGS__; if ((PROBE_MASK >> (k)) & 1u) { GRID_SYNC(); __VA_ARGS__; } } SEAM(k); } while (0)
    PH(0, phase0(a, lds));
    PH(1, {
        finalize_ada(a);
        const int nsp = gridDim.x >= 64 ? 12 : 0, nreg = gridDim.x - nsp;
        if ((int)blockIdx.x >= nreg) {
            const int si = blockIdx.x - nreg, b = si / 6, pn = 2 + si % 6;
            if (threadIdx.x < 64) { unsigned* cnt = (unsigned*)(ws + WS_CTL) + CW_CTXCNT + 64 * b; unsigned sp = 0;
                while ((unsigned)__builtin_amdgcn_readfirstlane(__hip_atomic_load(cnt, __ATOMIC_RELAXED, __HIP_MEMORY_SCOPE_AGENT)) < 16u) { __builtin_amdgcn_s_sleep(4); if (++sp > (1u << 22)) break; }
                __builtin_amdgcn_fence(__ATOMIC_ACQUIRE, "agent");
                asm volatile("s_waitcnt vmcnt(0)" ::: "memory"); }
            __syncthreads();
            SchedOne S; S.A = (const char*)(ws + WS_H); S.B = (const char*)(ws + WS_WIN); S.tstep = (size_t)256 * DM * 2; S.pm = NLAT / 256 + b; S.pn = pn;
            EpiInProj E{ws};
            pg8::gemm_phase<EpiInProj, SchedOne, false, true, true>(lds, DM, S, E);
        } else phase_norm_tile<0>(a, lds, blockIdx.x, nreg, NROWS / 16); });
    PH(2, {
        gemm_stagger();
        SchedPlain S; S.init((gridDim.x >= 64 ? NLAT : NROWS) / 256, WIN_ROWS / 256, gridDim.x, blockIdx.x); S.A = (const char*)(ws + WS_H); S.B = (const char*)(ws + WS_WIN); S.tstep = (size_t)256 * DM * 2;
        EpiInProj E{ws};
        pg8::gemm_phase<EpiInProj, SchedPlain, false, true, true>(lds, DM, S, E); });
    PH(3, { for (int it = blockIdx.x; it < 288; it += gridDim.x) gla_passA128(a, lds, it); });
    PH(4, gla_passB(a));
    PH(5, { for (int it = blockIdx.x; it < 256; it += gridDim.x) gla_passC(a, lds, it); });
    PH(6, { phase_f1(a, lds); phase_gla_merge(a); });
    PH(8, phase_f34(a, lds));
    PH(9, {
        gemm_stagger();
        SchedPlain S; S.init(NLAT / 256, DM / 256, gridDim.x, blockIdx.x); S.A = (const char*)(ws + WS_YCAT); S.B = (const char*)(ws + WS_WOUT); S.tstep = (size_t)256 * DM * 2;
        EpiOutProj E{a.in[0], (bf16*)(ws + WS_DLT), (const float*)(ws + WS_ADA)};
        pg8::gemm_phase<EpiOutProj, SchedPlain, false, true, true>(lds, DM, S, E); });
    PH(10, phase_norm_tile<1>(a, lds, blockIdx.x, gridDim.x, NLAT / 16));
    PH(11, phase_topk(a, lds));
    PH(12, {
        gemm_stagger();
        SchedMoeUp S; S.init(256, 8, gridDim.x, blockIdx.x); S.A = (const char*)(ws + WS_HF); S.B = (const char*)(ws + WS_WGU); S.tok = (const int*)(ws + WS_TOK);
        EpiSwiglu E{(bf16*)(ws + WS_HID)};
        pg8::gemm_phase<EpiSwiglu, SchedMoeUp, true, true, true>(lds, DM, S, E); });
    PH(13, {
        gemm_stagger();
        SchedMoeDown S; S.init(256, 8, gridDim.x, blockIdx.x); S.A = (const char*)(ws + WS_HID); S.B = (const char*)(ws + WS_WD);
        EpiBf16 E{(bf16*)(ws + WS_YE), DM};
        pg8::gemm_phase<EpiBf16, SchedMoeDown, false, true, true>(lds, DEXP, S, E); });
    PH(14, phase_final(a));
#undef PH
#undef IN
#undef SEAM
}

#ifndef N_LAUNCH_MODE
#define N_LAUNCH_MODE 1
#endif
extern "C" void kernel_launch(void* const* d_in, const int* in_sizes, int n_in, void* d_out, int out_size, void* d_ws, size_t ws_size, hipStream_t stream) {
    static int grid = 0;
    if (grid == 0) {
        if (n_in != 20 || out_size != NLAT * DM || ws_size < WS_END) { fprintf(stderr, "kernel_launch: unexpected sizes n_in %d out %d ws %zu\n", n_in, out_size, ws_size); grid = -1; return; }
        int dev = 0, cus = 0, per_cu = 0;
        (void)hipGetDevice(&dev); (void)hipDeviceGetAttribute(&cus, hipDeviceAttributeMultiprocessorCount, dev);
        if (hipFuncSetAttribute((const void*)mega, hipFuncAttributeMaxDynamicSharedMemorySize, LDS_BYTES) != hipSuccess) { fprintf(stderr, "kernel_launch: hipFuncSetAttribute failed\n"); grid = -1; return; }
        (void)hipOccupancyMaxActiveBlocksPerMultiprocessor(&per_cu, (const void*)mega, NTHREADS, LDS_BYTES);
        if (per_cu < 1) { fprintf(stderr, "kernel_launch: occupancy query reports %d blocks per CU\n", per_cu); per_cu = 1; }
        (void)hipGetLastError();
        grid = cus * 1;
    }
    if (grid < 0) return;
    Args a{};
    for (int i = 0; i < 20; ++i) a.in[i] = (const float*)d_in[i];
    a.out = (float*)d_out; a.ws = (unsigned char*)d_ws;
#if N_LAUNCH_MODE == 0
    for (int p = 0; p < NPHASES; ++p) { a.ph_lo = p; a.ph_hi = p + 1; hipLaunchKernelGGL(mega, dim3(grid), dim3(NTHREADS), LDS_BYTES, stream, a); }
#else
    a.ph_lo = 0; a.ph_hi = NPHASES;
#if USE_CG_SYNC
    void* args[] = {&a};
    hipError_t e = hipLaunchCooperativeKernel((void*)mega, dim3(grid), dim3(NTHREADS), args, LDS_BYTES, stream);
    if (e != hipSuccess) fprintf(stderr, "cooperative launch failed: %s (grid %d)\n", hipGetErrorString(e), grid);
#else
    if (hipMemsetAsync((char*)d_ws + WS_CTL, 0, CTL_BYTES, stream) != hipSuccess) { fprintf(stderr, "kernel_launch: memset of control words failed\n"); return; }
    hipLaunchKernelGGL(mega, dim3(grid), dim3(NTHREADS), LDS_BYTES, stream, a);
#endif
#endif
}
```

```cpp
#include <hip/hip_runtime.h>
#include <hip/hip_cooperative_groups.h>
#include <cstdio>
#include <cstdint>
namespace cg = cooperative_groups;

#define LAS __attribute__((address_space(3)))
typedef unsigned short bf16;
typedef short bf16x8 __attribute__((ext_vector_type(8)));
typedef float f32x4 __attribute__((ext_vector_type(4)));
typedef float f32x2 __attribute__((ext_vector_type(2)));
typedef unsigned u32x4 __attribute__((ext_vector_type(4)));
typedef unsigned u32x2 __attribute__((ext_vector_type(2)));

constexpr int NB = 2, SEQ = 16384, DM = 2048, CTXL = 256;
constexpr int NLAT = NB * SEQ;
constexpr int NROWS = NLAT + NB * CTXL;
constexpr int PROJW = 4128;
constexpr int NE = 16, CAP = 2048, DEXP = 1024;
constexpr int PW = 4096;
constexpr int WIN_ROWS = 4096;
constexpr float EPS = 1e-6f;

constexpr size_t MiB = 1u << 20;
constexpr size_t WS_ADA = 0;
constexpr size_t WS_TW = 1 * MiB;
constexpr size_t WS_FC = 1 * MiB + 256 * 1024;
constexpr size_t WS_FS = 1 * MiB + 320 * 1024;
constexpr size_t WS_WRH = 1 * MiB + 384 * 1024;
constexpr size_t WS_WRL = 1 * MiB + 448 * 1024;
constexpr size_t WS_Z = 2 * MiB;
constexpr size_t WS_AFF = 8 * MiB;
constexpr size_t WS_TOK = 10 * MiB;
constexpr size_t WS_GATE = 11 * MiB;
constexpr size_t WS_SEL = 12 * MiB;
constexpr size_t WS_ST0 = 14 * MiB;
constexpr size_t WS_CTL = 16 * MiB;
constexpr size_t CTL_BYTES = 65536;
constexpr size_t WS_ADAP = 20 * MiB;
constexpr size_t WS_TC = 24 * MiB;
constexpr size_t WS_DTC = 28 * MiB;
constexpr size_t WS_WIN = 32 * MiB;
constexpr size_t WS_WOUT = 50 * MiB;
constexpr size_t WS_WGU = 58 * MiB;
constexpr size_t WS_WD = 186 * MiB;
constexpr int KTOK = SEQ + CTXL;
constexpr size_t WS_QH = 250 * MiB;
constexpr size_t WS_KH = 282 * MiB;
constexpr size_t WS_VH = 316 * MiB;
constexpr size_t WS_G = 382 * MiB;
constexpr size_t WS_U = 446 * MiB;
constexpr size_t WS_HF = 250 * MiB;
constexpr size_t WS_HID = 378 * MiB;
constexpr size_t WS_FX = 250 * MiB;
constexpr size_t WS_FA = 894 * MiB;
constexpr size_t WS_FAI = 958 * MiB;
constexpr size_t WS_H = 510 * MiB;
constexpr size_t WS_OF = 510 * MiB;
constexpr size_t WS_OB = 574 * MiB;
constexpr size_t WS_T = 638 * MiB;
constexpr size_t WS_SST = 670 * MiB;
constexpr size_t WS_DT = 702 * MiB;
constexpr size_t WS_DLT = 510 * MiB;
constexpr size_t WS_YCAT = 766 * MiB;
constexpr size_t WS_YE = 766 * MiB;
constexpr size_t WS_END = 1022 * MiB;

#ifndef USE_CG_SYNC
#define USE_CG_SYNC 0
#endif
#ifndef PROBE_HALF
#define PROBE_HALF 0
#endif
#ifndef KSNAKE
#define KSNAKE 0
#endif
#ifndef PROBE_BAR
#define PROBE_BAR 0
#endif
#ifndef PROBE_HOT
#define PROBE_HOT 0
#endif
#ifndef PROBE_K
#define PROBE_K 0
#endif
#ifndef PROBE_EPI
#define PROBE_EPI 0
#endif
#ifndef PROBE_P0
#define PROBE_P0 0
#endif
#ifndef PROBE_MASK
#define PROBE_MASK 0u
#endif
constexpr int LDS_BYTES = 163840;
constexpr int NTHREADS = 512;

struct Args {
    const float* in[20];
    float* out;
    unsigned char* ws;
    int ph_lo, ph_hi;
};

__device__ __forceinline__ float bf2f(bf16 v) { return __uint_as_float(((unsigned)v) << 16); }
typedef __bf16 bf16x2_t __attribute__((ext_vector_type(2)));
__device__ __forceinline__ unsigned pk2(float lo, float hi) { const f32x2 v = {lo, hi}; return __builtin_bit_cast(unsigned, __builtin_convertvector(v, bf16x2_t)); }
__device__ __forceinline__ unsigned f2bf(float f) { return pk2(f, 0.f) & 0xffffu; }
__device__ __forceinline__ float wave_sum(float v) {
#pragma unroll
    for (int o = 1; o < 64; o <<= 1) v += __shfl_xor(v, o);
    return v;
}
__device__ __forceinline__ float silu_f(float x) { return x / (1.f + __expf(-x)); }
__device__ __forceinline__ float logsigmoid_f(float x) { return fminf(x, 0.f) - log1pf(expf(-fabsf(x))); }

namespace pg8 {
constexpr int BM = 256, BK = 64, HALF = 128, HTB = HALF * BK * 2, STAGE_BYTES = 8 * HTB, NXCD = 8, WGM = 8;
__host__ __device__ __forceinline__ int lds_byte(int r, int c) { const int st = (r >> 4) * 2 + (c >> 5), rr = r & 15, cc = c & 31, ob = rr * 64 + cc * 2; return st * 1024 + (ob ^ (((ob >> 9) & 1) << 5)); }
__host__ __device__ __forceinline__ void stage_rc(int b, int& R, int& C) { const int st = b / 1024, sb = b % 1024, swz = sb ^ (((sb >> 9) & 1) << 5); R = (st >> 1) * 16 + swz / 64; C = (st & 1) * 32 + (swz % 64) / 2; }
__host__ __device__ __forceinline__ int perm32(int rho) { const int n = rho >> 4, i = rho & 15; return 8 * (i >> 2) + 4 * n + (i & 3); }
struct Unit { int pm, pn; };
__device__ __forceinline__ unsigned cvt_pk_bf16(float lo, float hi) { return pk2(lo, hi); }

struct OrderBase {
    int nM, nN, nwg, G, c;
    __device__ void init(int nM_, int nN_, int G_, int c_) { nM = nM_; nN = nN_; nwg = nM * nN; G = G_; c = c_; }
    __device__ bool next(int i, Unit& u) const {
        const long L = (long)(i >> PROBE_K) * G + c; if (L >= nwg) return false;
        int wgid = (int)L; { const int q = nwg / NXCD, r = nwg % NXCD, xcd = wgid % NXCD, off = wgid / NXCD; wgid = (xcd < r ? xcd * (q + 1) : r * (q + 1) + (xcd - r) * q) + off; }
        const int nig = WGM * nN, gid = wgid / nig, fm = gid * WGM, gsz = (nM - fm) < WGM ? (nM - fm) : WGM;
        u.pm = fm + ((wgid % nig) % gsz); u.pn = (wgid % nig) / gsz; if (PROBE_K && PROBE_HOT && !(i & 1)) { u.pm = 0; u.pn = 0; } return true;
    }
};

template <class Epi, class Sched, bool GATHER, bool ALIGN_EPI, bool SP2>
__device__ __forceinline__ void gemm_phase(LAS unsigned char* lds, const int K, const Sched& S, const Epi& E) {
    const int tid = threadIdx.x, wid = __builtin_amdgcn_readfirstlane(tid >> 6), lane = tid & 63, wr = wid >> 2, wc = wid & 3, fr = lane & 15, fq = lane >> 4;
    const int nt = K / BK;
    unsigned voffA[2], voffA1[2], voffB[2];
    int RA[2], CA[2];
#pragma unroll
    for (int i = 0; i < 2; ++i) { int R, C; stage_rc(tid * 16 + i * 8192, R, C); const int Rb = Epi::PERM2 ? (64 * (R >> 5) + perm32(R & 31)) : (Epi::PERM ? ((R & ~31) + perm32(R & 31)) : R);
        RA[i] = R; CA[i] = C;
        voffA[i] = (unsigned)(R * K + C) * 2u; voffA1[i] = voffA[i]; voffB[i] = (unsigned)(Rb * K + C) * 2u; }
    const size_t kstep = (size_t)(BK * 2);
    const size_t hstepA = GATHER ? 0 : (size_t)HALF * K * 2;
    const size_t hstep = (size_t)(Epi::PERM2 ? 32 : HALF) * K * 2;
    const unsigned ldsw = (unsigned)wid * 1024u;
    const int aoff = lds_byte(wr * 64 + fr, fq * 8), boff = lds_byte(wc * 32 + fr, fq * 8);
#define PG8_SA(b, h) (((b) * 2 + (h)) * HTB)
#define PG8_SB(b, h) ((4 + (b) * 2 + (h)) * HTB)
#define PG8_STAGE(bufoff, gbase, voff) do { _Pragma("unroll") for (int _i = 0; _i < 2; ++_i) \
        __builtin_amdgcn_global_load_lds((const unsigned*)((const char*)(gbase) + (voff)[_i]), (LAS unsigned*)(lds + (bufoff) + ldsw + _i * 8192), 16, 0, 0); } while (0)
#define PG8_LDA(dst, b, h) do { _Pragma("unroll") for (int m = 0; m < 4; ++m) _Pragma("unroll") for (int k = 0; k < 2; ++k) dst[m][k] = *(const LAS bf16x8*)(lds + PG8_SA(b, h) + aoff + m * 2048 + k * 1024); } while (0)
#define PG8_LDB(dst, b, h) do { _Pragma("unroll") for (int n = 0; n < 2; ++n) _Pragma("unroll") for (int k = 0; k < 2; ++k) dst[n][k] = *(const LAS bf16x8*)(lds + PG8_SB(b, h) + boff + n * 2048 + k * 1024); } while (0)
#define PG8_MMA(ai, bj, At, Bt) do { __builtin_amdgcn_s_setprio(1); _Pragma("unroll") for (int m = 0; m < 4; ++m) _Pragma("unroll") for (int n = 0; n < 2; ++n) _Pragma("unroll") for (int k = 0; k < 2; ++k) \
        acc[ai][bj][m][n] = __builtin_amdgcn_mfma_f32_16x16x32_bf16(Bt[n][k], At[m][k], acc[ai][bj][m][n], 0, 0, 0); __builtin_amdgcn_s_setprio(0); } while (0)
#define PG8_WAIT_V(n) asm volatile("s_waitcnt vmcnt(" #n ")" ::: "memory")
#define PG8_WAIT_L(n) asm volatile("s_waitcnt lgkmcnt(" #n ")" ::: "memory")
#define PG8_BAR __builtin_amdgcn_s_barrier()
#define PG8_SCHED __builtin_amdgcn_sched_barrier(0)
    Unit cur, nxt; int ui = 0;
    if (!S.next(0, cur)) return;
    f32x4 acc[2][2][4][2];
#pragma unroll
    for (int a = 0; a < 2; ++a)
#pragma unroll
        for (int b = 0; b < 2; ++b)
#pragma unroll
            for (int m = 0; m < 4; ++m)
#pragma unroll
                for (int n = 0; n < 2; ++n) acc[a][b][m][n] = (f32x4){0.f, 0.f, 0.f, 0.f};
    bf16x8 At[4][2], B0[2][2], B1[2][2];
    const long kspan = (long)(nt - 1) * (long)(BK * 2);
    long ck = (long)(BK * 2);
    const char* cA = S.abase(cur); const char* cB = S.bbase(cur);
    if constexpr (GATHER) {
#pragma unroll
        for (int i = 0; i < 2; ++i) { voffA[i] = ((unsigned)S.arow(cur, RA[i]) * (unsigned)K + (unsigned)CA[i]) * 2u; voffA1[i] = ((unsigned)S.arow(cur, HALF + RA[i]) * (unsigned)K + (unsigned)CA[i]) * 2u; }
    }
    static_assert(SP2, "only the SP2 loop is kept");
    PG8_STAGE(PG8_SB(0, 0), cB, voffB); PG8_STAGE(PG8_SB(0, 1), cB + hstep, voffB); PG8_STAGE(PG8_SA(0, 0), cA, voffA); PG8_STAGE(PG8_SA(0, 1), cA + hstepA, voffA1);
    if (wr == 1) PG8_BAR;
    PG8_WAIT_V(2); PG8_BAR;
    PG8_STAGE(PG8_SB(1, 0), cB + kstep, voffB); PG8_STAGE(PG8_SA(1, 0), cA + kstep, voffA); PG8_STAGE(PG8_SB(1, 1), cB + hstep + kstep, voffB);
    PG8_WAIT_V(6); PG8_BAR;
    for (;;) {
        const bool has_next = S.next(ui + 1, nxt);
        const bool nrev = KSNAKE && has_next && (((ui + 1) >> PROBE_K) & 1);
        const long nk = has_next ? (nrev ? -(long)(BK * 2) : (long)(BK * 2)) : ck;
        const char* nA = has_next ? S.abase(nxt) + (nrev ? kspan : 0) : cA; const char* nB = has_next ? S.bbase(nxt) + (nrev ? kspan : 0) : cB;
        for (int t = 0; t < nt; t += 2) {
            const bool last = (t == nt - 2);
            const char* a1 = cA + (long)(t + 1) * ck;
            const char* a2 = last ? nA : cA + (long)(t + 2) * ck; const char* b2 = last ? nB : cB + (long)(t + 2) * ck;
            const char* a3 = a2 + (last ? nk : ck); const char* b3 = b2 + (last ? nk : ck);
            PG8_LDB(B0, 0, 0); PG8_LDB(B1, 0, 1); PG8_SCHED; PG8_LDA(At, 0, 0); PG8_STAGE(PG8_SA(1, 1), a1 + hstepA, voffA1);
            if constexpr (GATHER) { if (last && has_next) {
#pragma unroll
                for (int i = 0; i < 2; ++i) { voffA[i] = ((unsigned)S.arow(nxt, RA[i]) * (unsigned)K + (unsigned)CA[i]) * 2u; voffA1[i] = ((unsigned)S.arow(nxt, HALF + RA[i]) * (unsigned)K + (unsigned)CA[i]) * 2u; } } }
            PG8_WAIT_V(8); PG8_WAIT_L(0); PG8_BAR; PG8_MMA(0, 0, At, B0); PG8_MMA(0, 1, At, B1); PG8_BAR; PG8_SCHED;
            PG8_LDA(At, 0, 1); PG8_STAGE(PG8_SB(0, 0), b2, voffB); PG8_STAGE(PG8_SB(0, 1), b2 + hstep, voffB); PG8_STAGE(PG8_SA(0, 0), a2, voffA);
            PG8_WAIT_V(8); PG8_WAIT_L(0); PG8_BAR; PG8_MMA(1, 0, At, B0); PG8_MMA(1, 1, At, B1); PG8_BAR; PG8_SCHED;
            PG8_LDB(B0, 1, 0); PG8_LDB(B1, 1, 1); PG8_SCHED; PG8_LDA(At, 1, 0); PG8_STAGE(PG8_SA(0, 1), a2 + hstepA, voffA1);
            PG8_WAIT_V(8); PG8_WAIT_L(0); PG8_BAR; PG8_MMA(0, 0, At, B0); PG8_MMA(0, 1, At, B1); PG8_BAR; PG8_SCHED;
            PG8_LDA(At, 1, 1); PG8_STAGE(PG8_SB(1, 0), b3, voffB); PG8_STAGE(PG8_SB(1, 1), b3 + hstep, voffB); PG8_STAGE(PG8_SA(1, 0), a3, voffA);
            PG8_WAIT_V(8); PG8_WAIT_L(0); PG8_BAR; PG8_MMA(1, 0, At, B0); PG8_MMA(1, 1, At, B1); PG8_BAR; PG8_SCHED;
        }
        if constexpr (ALIGN_EPI) { if (wr == 0) PG8_BAR; }
        if (!PROBE_K || (ui & 1)) E(acc, cur, wr, wc, fr, fq);
        if (PROBE_EPI == 1) { asm volatile("" ::: "memory"); E(acc, cur, wr, wc, fr, fq); }
        if (PROBE_EPI == 2) { asm volatile("s_waitcnt vmcnt(0)" ::: "memory"); }
        if (!has_next) break;
#pragma unroll
        for (int a = 0; a < 2; ++a)
#pragma unroll
            for (int b = 0; b < 2; ++b)
#pragma unroll
                for (int m = 0; m < 4; ++m)
#pragma unroll
                    for (int n = 0; n < 2; ++n) acc[a][b][m][n] = (f32x4){0.f, 0.f, 0.f, 0.f};
        cur = nxt; cA = nA; cB = nB; ck = nk; ++ui;
        if constexpr (ALIGN_EPI) { if (wr == 1) PG8_BAR; }
    }
    PG8_WAIT_V(0);
    if constexpr (!ALIGN_EPI) { if (wr == 0) PG8_BAR; }
    PG8_BAR;
#undef PG8_SA
#undef PG8_SB
#undef PG8_STAGE
#undef PG8_LDA
#undef PG8_LDB
#undef PG8_MMA
#undef PG8_WAIT_V
#undef PG8_WAIT_L
#undef PG8_BAR
#undef PG8_SCHED
}
}
using pg8::Unit;
using pg8::cvt_pk_bf16;
constexpr int HALF = pg8::HALF, BM = pg8::BM;

struct SchedPlain : pg8::OrderBase {
    const char* A; const char* B; size_t tstep;
    __device__ __forceinline__ const char* abase(const Unit& u) const { return A + (size_t)u.pm * tstep; }
    __device__ __forceinline__ const char* bbase(const Unit& u) const { return B + (size_t)u.pn * tstep; }
    __device__ __forceinline__ int arow(const Unit&, int) const { return 0; }
};
struct SchedOne {
    const char* A; const char* B; size_t tstep; int pm, pn;
    __device__ __forceinline__ bool next(int i, Unit& u) const { if ((i >> PROBE_K) != 0) return false; u.pm = pm; u.pn = pn; return true; }
    __device__ __forceinline__ const char* abase(const Unit& u) const { return A + (size_t)u.pm * tstep; }
    __device__ __forceinline__ const char* bbase(const Unit& u) const { return B + (size_t)u.pn * tstep; }
    __device__ __forceinline__ int arow(const Unit&, int) const { return 0; }
};
struct SchedMoeUp : pg8::OrderBase {
    const char* A; const char* B; const int* tok;
    __device__ __forceinline__ const char* abase(const Unit&) const { return A; }
    __device__ __forceinline__ const char* bbase(const Unit& u) const { return B + ((size_t)(u.pm >> 4) * 2048 + (size_t)u.pn * 256) * (size_t)(DM * 2); }
    __device__ __forceinline__ int arow(const Unit& u, int r) const { const int e = u.pm >> 4, b = (u.pm >> 3) & 1, mt = u.pm & 7; return b * SEQ + tok[(b * NE + e) * CAP + mt * 256 + r]; }
};
struct SchedMoeDown : pg8::OrderBase {
    const char* A; const char* B;
    __device__ __forceinline__ const char* abase(const Unit& u) const { return A + (size_t)u.pm * 256 * (size_t)(DEXP * 2); }
    __device__ __forceinline__ const char* bbase(const Unit& u) const { return B + ((size_t)(u.pm >> 4) * 2048 + (size_t)u.pn * 256) * (size_t)(DEXP * 2); }
    __device__ __forceinline__ int arow(const Unit&, int) const { return 0; }
};

__device__ __forceinline__ u32x4 swz_xor8(const u32x4 v) { u32x4 r;
    r.x = (unsigned)__builtin_amdgcn_ds_swizzle((int)v.x, 0x201F); r.y = (unsigned)__builtin_amdgcn_ds_swizzle((int)v.y, 0x201F);
    r.z = (unsigned)__builtin_amdgcn_ds_swizzle((int)v.z, 0x201F); r.w = (unsigned)__builtin_amdgcn_ds_swizzle((int)v.w, 0x201F); return r; }
__device__ __forceinline__ void store_pair_rows(bf16* rowp, size_t ld, int fr, const u32x4 w0, const u32x4 w1) {
    const bool hi = (fr & 8) != 0;
    const u32x4 r = swz_xor8(hi ? w0 : w1);
    bf16* p = rowp + (hi ? 32 : 0);
    *(u32x4*)(p) = hi ? r : w0;
    *(u32x4*)(p + 8 * ld) = hi ? w1 : r;
}
struct EpiInProj {
    static constexpr bool PERM = true, PERM2 = true;
    unsigned char* ws;
    __device__ __forceinline__ void operator()(const f32x4 (&acc)[2][2][4][2], const Unit& u, int wr, int wc, int fr, int fq) const {
        const int ct = wc * 64 + 8 * fq;
        const bool lat = u.pm < NLAT / 256; const int b = lat ? u.pm / (SEQ / 256) : u.pm - NLAT / 256, t0 = lat ? (u.pm % (SEQ / 256)) * 256 : SEQ;
        if (!lat && (u.pn < 2 || u.pn >= 8)) return;
        bf16* base; size_t ld;
        if (u.pn < 2) { const int h = 2 * u.pn + (ct >> 7); base = (bf16*)(ws + WS_QH) + ((size_t)(b * 4 + h) * SEQ + t0) * 128 + (ct & 127); ld = 128; }
        else if (u.pn < 4) { const int h = 2 * (u.pn - 2) + (ct >> 7); base = (bf16*)(ws + WS_KH) + ((size_t)(b * 4 + h) * KTOK + t0) * 128 + (ct & 127); ld = 128; }
        else if (u.pn < 8) { const int h = u.pn - 4; base = (bf16*)(ws + WS_VH) + ((size_t)(b * 4 + h) * KTOK + t0) * 256 + ct; ld = 256; }
        else if (u.pn < 12) { base = (bf16*)(ws + WS_G) + (size_t)(u.pm * BM) * 1024 + (u.pn - 8) * 256 + ct; ld = 1024; }
        else { base = (bf16*)(ws + WS_U) + (size_t)(u.pm * BM) * 1024 + (u.pn - 12) * 256 + ct; ld = 1024; }
#pragma unroll
        for (int ai = 0; ai < 2; ++ai)
#pragma unroll
            for (int m = 0; m < 4; ++m) { bf16* rowp = base + (size_t)(wr * 64 + ai * HALF + m * 16 + (fr & 7)) * ld;
                u32x4 w[2];
#pragma unroll
                for (int bj = 0; bj < 2; ++bj) { const f32x4 v0 = acc[ai][bj][m][0], v1 = acc[ai][bj][m][1];
                    w[bj].x = cvt_pk_bf16(v0[0], v0[1]); w[bj].y = cvt_pk_bf16(v0[2], v0[3]); w[bj].z = cvt_pk_bf16(v1[0], v1[1]); w[bj].w = cvt_pk_bf16(v1[2], v1[3]); }
                store_pair_rows(rowp, ld, fr, w[0], w[1]); }
    }
};
struct EpiOutProj {
    static constexpr bool PERM = true, PERM2 = true;
    const float* X; bf16* D; const float* ada;
    __device__ __forceinline__ void operator()(const f32x4 (&acc)[2][2][4][2], const Unit& u, int wr, int wc, int fr, int fq) const {
        const int row0 = u.pm * BM + wr * 64, col0 = u.pn * BM + wc * 64 + 8 * fq;
        const int b = (u.pm * BM) / SEQ;
        const float* g1 = ada + (size_t)b * 12288 + 2 * DM;
        f32x4 gv[2][2];
#pragma unroll
        for (int bj = 0; bj < 2; ++bj)
#pragma unroll
            for (int n = 0; n < 2; ++n) gv[bj][n] = *(const f32x4*)(g1 + col0 + 32 * bj + 4 * n);
#pragma unroll
        for (int ai = 0; ai < 2; ++ai)
#pragma unroll
            for (int m = 0; m < 4; ++m) { const size_t rbase = (size_t)(row0 + ai * HALF + m * 16);
                u32x4 w[2];
#pragma unroll
                for (int bj = 0; bj < 2; ++bj) { const size_t off = (rbase + fr) * DM + col0 + 32 * bj; const f32x4 x0 = *(const f32x4*)(X + off), x1 = *(const f32x4*)(X + off + 4);
                    const f32x4 v0 = x0 + acc[ai][bj][m][0] * gv[bj][0], v1 = x1 + acc[ai][bj][m][1] * gv[bj][1];
                    w[bj].x = cvt_pk_bf16(v0[0], v0[1]); w[bj].y = cvt_pk_bf16(v0[2], v0[3]); w[bj].z = cvt_pk_bf16(v1[0], v1[1]); w[bj].w = cvt_pk_bf16(v1[2], v1[3]); }
                store_pair_rows(D + (rbase + (fr & 7)) * DM + col0, DM, fr, w[0], w[1]);
                asm volatile("" ::: "memory"); }
    }
};
struct EpiSwiglu {
    static constexpr bool PERM = true, PERM2 = false;
    bf16* HID;
    __device__ __forceinline__ void operator()(const f32x4 (&acc)[2][2][4][2], const Unit& u, int wr, int wc, int fr, int fq) const {
        const int row0 = u.pm * BM + wr * 64 + fr, col0 = u.pn * 128 + wc * 32 + 8 * fq;
#pragma unroll
        for (int ai = 0; ai < 2; ++ai)
#pragma unroll
            for (int m = 0; m < 4; ++m) { bf16* rowp = HID + (size_t)(row0 + ai * HALF + m * 16) * DEXP + col0;
                f32x4 h0, h1;
#pragma unroll
                for (int j = 0; j < 4; ++j) { h0[j] = silu_f(acc[ai][0][m][0][j]) * acc[ai][1][m][0][j]; h1[j] = silu_f(acc[ai][0][m][1][j]) * acc[ai][1][m][1][j]; }
                u32x4 w; w.x = cvt_pk_bf16(h0[0], h0[1]); w.y = cvt_pk_bf16(h0[2], h0[3]); w.z = cvt_pk_bf16(h1[0], h1[1]); w.w = cvt_pk_bf16(h1[2], h1[3]);
                *(u32x4*)(rowp) = w; }
    }
};
struct EpiBf16 {
    static constexpr bool PERM = true, PERM2 = true;
    bf16* O; int ldc;
    __device__ __forceinline__ void operator()(const f32x4 (&acc)[2][2][4][2], const Unit& u, int wr, int wc, int fr, int fq) const {
        const int row0 = u.pm * BM + wr * 64 + (fr & 7), col0 = u.pn * BM + wc * 64 + 8 * fq;
#pragma unroll
        for (int ai = 0; ai < 2; ++ai)
#pragma unroll
            for (int m = 0; m < 4; ++m) { bf16* rowp = O + (size_t)(row0 + ai * HALF + m * 16) * ldc + col0;
                u32x4 w[2];
#pragma unroll
                for (int bj = 0; bj < 2; ++bj) { const f32x4 v0 = acc[ai][bj][m][0], v1 = acc[ai][bj][m][1];
                    w[bj].x = cvt_pk_bf16(v0[0], v0[1]); w[bj].y = cvt_pk_bf16(v0[2], v0[3]); w[bj].z = cvt_pk_bf16(v1[0], v1[1]); w[bj].w = cvt_pk_bf16(v1[2], v1[3]); }
                store_pair_rows(rowp, (size_t)ldc, fr, w[0], w[1]); }
    }
};

__device__ __forceinline__ void transpose_item(const float* src, int ldsrc, int scol0, int k0, bf16* dst, size_t drow0, int ldd, LAS float* scr, int lane) {
#pragma unroll 8
    for (int i = 0; i < 32; ++i) { const int kk = 2 * i + (lane >> 5); scr[kk * 33 + (lane & 31)] = src[(size_t)(k0 + kk) * ldsrc + scol0 + (lane & 31)]; }
    asm volatile("s_waitcnt lgkmcnt(0)" ::: "memory");
    const int c = lane & 7;
#pragma unroll
    for (int j = 0; j < 4; ++j) { const int n = (lane >> 3) + 8 * j; const LAS float* s = scr + (8 * c) * 33 + n;
        u32x4 o; o.x = pk2(s[0 * 33], s[1 * 33]); o.y = pk2(s[2 * 33], s[3 * 33]); o.z = pk2(s[4 * 33], s[5 * 33]); o.w = pk2(s[6 * 33], s[7 * 33]);
        *(u32x4*)(dst + (drow0 + n) * (size_t)ldd + k0 + 8 * c) = o; }
    asm volatile("s_waitcnt lgkmcnt(0)" ::: "memory");
}

struct T64 { const float* src; bf16* dst; int ldsrc, ldd; };
__device__ __forceinline__ T64 decode_t64(const Args& a, int r) {
    unsigned char* ws = a.ws; T64 t;
    if (r < 2048) { const int kb = r >> 6, nb = r & 63; const int scol = nb < 48 ? nb * 64 : 3104 + (nb - 48) * 64;
        t.src = a.in[7] + (size_t)(kb * 64) * PROJW + scol; t.ldsrc = PROJW; t.dst = (bf16*)(ws + WS_WIN) + (size_t)(nb * 64) * DM + kb * 64; t.ldd = DM; return t; }
    r -= 2048;
    if (r < 1024) { const int kb = r >> 5, nb = r & 31;
        t.src = a.in[13] + (size_t)(kb * 64) * DM + nb * 64; t.ldsrc = DM; t.dst = (bf16*)(ws + WS_WOUT) + (size_t)(nb * 64) * DM + kb * 64; t.ldd = DM; return t; }
    r -= 1024;
    if (r < 16384) { const int up = r >= 8192; if (up) r -= 8192; const int e = r >> 9, rr = r & 511, kb = rr >> 4, nb = rr & 15, n0 = nb * 64;
        t.src = (up ? a.in[17] : a.in[16]) + (size_t)e * DM * DEXP + (size_t)(kb * 64) * DEXP + n0; t.ldsrc = DEXP;
        t.dst = (bf16*)(ws + WS_WGU) + ((size_t)e * 2048 + (size_t)(n0 >> 7) * 256 + (n0 & 127) + (up ? 128 : 0)) * DM + kb * 64; t.ldd = DM; return t; }
    r -= 16384;
    { const int e = r >> 9, rr = r & 511, kb = rr >> 5, nb = rr & 31;
        t.src = a.in[18] + (size_t)e * DEXP * DM + (size_t)(kb * 64) * DM + nb * 64; t.ldsrc = DM;
        t.dst = (bf16*)(ws + WS_WD) + ((size_t)e * 2048 + nb * 64) * DEXP + kb * 64; t.ldd = DEXP; return t; }
}
__device__ __forceinline__ void t64_load(const T64& t, int lane, f32x4 (&v)[16]) {
    const int krow = lane >> 4, c4 = lane & 15;
#pragma unroll
    for (int i = 0; i < 16; ++i) v[i] = __builtin_nontemporal_load((const f32x4*)(t.src + (size_t)(4 * i + krow) * t.ldsrc + 4 * c4));
}
__device__ __forceinline__ void t64_finish(const T64& t, int lane, const f32x4 (&v)[16], LAS float* scr) {
    const int krow = lane >> 4, c4 = lane & 15;
#pragma unroll
    for (int i = 0; i < 16; ++i) { LAS float* p = scr + (4 * i + krow) * 65 + 4 * c4; p[0] = v[i].x; p[1] = v[i].y; p[2] = v[i].z; p[3] = v[i].w; }
    asm volatile("s_waitcnt lgkmcnt(0)" ::: "memory");
    const int c = lane & 7;
#pragma unroll
    for (int j = 0; j < 8; ++j) { const int n = (lane >> 3) + 8 * j; const LAS float* s = scr + (8 * c) * 65 + n;
        u32x4 o; o.x = pk2(s[0 * 65], s[1 * 65]); o.y = pk2(s[2 * 65], s[3 * 65]); o.z = pk2(s[4 * 65], s[5 * 65]); o.w = pk2(s[6 * 65], s[7 * 65]);
        *(u32x4*)(t.dst + (size_t)n * t.ldd + 8 * c) = o; }
    asm volatile("s_waitcnt lgkmcnt(0)" ::: "memory");
}
constexpr int P0_NT64 = 2048 + 1024 + 16384 + 8192;
constexpr int P0_TAIL = 1024;
constexpr int P0_NGEMV = 192;
__device__ __forceinline__ void phase0(const Args& a, LAS unsigned char* lds) {
    const int tid = threadIdx.x, lane = tid & 63, wave = tid >> 6, G = gridDim.x, blk = blockIdx.x;
    unsigned char* ws = a.ws;
    {
        const float* c = a.in[1]; const float* cc = a.in[3]; const float* w_ada = a.in[4]; const float* b_ada = a.in[5];
        float* part = (float*)(ws + WS_ADAP);
        LAS float* red = (LAS float*)lds;
        for (int rep_ = 0; rep_ < 1 + (PROBE_P0 & 1); ++rep_)
        for (int it = blk; it < P0_NGEMV; it += G) {
            const int cb = it % 48, ks = it / 48, col0 = cb * 256 + 4 * lane, r0 = ks * 512 + wave * 64;
            f32x4 a0 = {0.f, 0.f, 0.f, 0.f}, a1 = a0, a2 = a0;
#pragma unroll 16
            for (int r = r0; r < r0 + 64; ++r) {
                const f32x4 w = *(const f32x4*)(w_ada + (size_t)r * 12288 + col0);
                const float s0 = silu_f(c[r]), s1 = silu_f(c[DM + r]), s2 = silu_f(cc[r]);
                a0 += w * s0; a1 += w * s1; a2 += w * s2;
            }
            *(LAS f32x4*)(red + (wave * 3 + 0) * 256 + 4 * lane) = a0; *(LAS f32x4*)(red + (wave * 3 + 1) * 256 + 4 * lane) = a1; *(LAS f32x4*)(red + (wave * 3 + 2) * 256 + 4 * lane) = a2;
            __syncthreads();
            for (int idx = tid; idx < 768; idx += NTHREADS) { const int v = idx >> 8, col = idx & 255; float s = ks == 0 ? b_ada[cb * 256 + col] : 0.f;
#pragma unroll
                for (int w8 = 0; w8 < 8; ++w8) s += red[(w8 * 3 + v) * 256 + col];
                part[(size_t)(ks * 3 + v) * 12288 + cb * 256 + col] = s; }
            __syncthreads();
        }
    }
    LAS float* scr = (LAS float*)(lds + wave * 16640);
    const int gw = blk * 8 + wave, NGW = G * 8;
    constexpr int I_WZ = 32, I_WR = 512, I_TW = 256, I_FT = 256;
    for (int it = gw; it < I_WZ + I_WR + I_TW + I_FT; it += NGW) {
        int r = it;
        if (r < I_WZ) { transpose_item(a.in[7], PROJW, 3072, r * 64, (bf16*)(ws + WS_WIN), (size_t)4096, DM, scr, lane); continue; }
        r -= I_WZ;
        if (r < I_WR) { const int p = r * 64 + lane, e = p >> 11, d = p & 2047; const float wv = a.in[15][d * 16 + e]; const unsigned hi = f2bf(wv); ((bf16*)(ws + WS_WRH))[p] = (bf16)hi; ((bf16*)(ws + WS_WRL))[p] = (bf16)f2bf(wv - bf2f((bf16)hi)); continue; }
        r -= I_WR;
        if (r < I_TW) { const int p = r * 64 + lane; float s, c; sincospif((float)p * (1.0f / 8192.0f), &s, &c); ((f32x2*)(ws + WS_TW))[p] = (f32x2){c, s}; continue; }
        r -= I_TW;
        { const int p = r * 64 + lane, k = p >> 7, l = p & 127; float s, c; sincospif((float)((k * l) & 127) * (1.0f / 64.0f), &s, &c); ((bf16*)(ws + WS_FC))[p] = (bf16)f2bf(c); ((bf16*)(ws + WS_FS))[p] = (bf16)f2bf(s); }
    }
    const int n_gemv_wg = G > P0_NGEMV ? P0_NGEMV : 0;
    const int head_end = n_gemv_wg ? P0_NT64 - P0_TAIL : P0_NT64;
    const int n_head = gw < head_end ? (head_end - gw + NGW - 1) / NGW : 0;
    const int tgw = (blk - n_gemv_wg) * 8 + wave, tstep = (G - n_gemv_wg) * 8;
    const int n_tail = (n_gemv_wg && blk >= n_gemv_wg && tgw < P0_TAIL) ? (P0_TAIL - tgw + tstep - 1) / tstep : 0;
    const int n_items = n_head + n_tail;
    auto item_of = [&](int j) -> int { return j < n_head ? gw + j * NGW : head_end + tgw + (j - n_head) * tstep; };
    for (int rep_ = 0; rep_ < 1 + ((PROBE_P0 >> 1) & 1); ++rep_) {
    f32x4 va[16], vb[16]; T64 ta, tb;
    if (n_items > 0) { ta = decode_t64(a, item_of(0)); t64_load(ta, lane, va); }
    for (int j = 0; j < n_items; j += 2) {
        const bool h1 = j + 1 < n_items, h2 = j + 2 < n_items;
        if (h1) { tb = decode_t64(a, item_of(j + 1)); t64_load(tb, lane, vb); }
        t64_finish(ta, lane, va, scr);
        if (h2) { ta = decode_t64(a, item_of(j + 2)); t64_load(ta, lane, va); }
        if (h1) t64_finish(tb, lane, vb, scr);
    }
    }
}

#define MFMA16(a, b, c) __builtin_amdgcn_mfma_f32_16x16x32_bf16((a), (b), (c), 0, 0, 0)
__device__ __forceinline__ void finalize_ada(const Args& a) {
    const float* part = (const float*)(a.ws + WS_ADAP); float* adaw = (float*)(a.ws + WS_ADA);
    for (int i = blockIdx.x * NTHREADS + threadIdx.x; i < 3 * 12288; i += gridDim.x * NTHREADS) { float s = 0.f;
#pragma unroll
        for (int ks = 0; ks < 4; ++ks) s += part[(size_t)ks * 3 * 12288 + i];
        adaw[i] = s; }
}
constexpr int CW_CTXCNT = 4096;
template <int MODE>
__device__ __forceinline__ void norm_load_tile(const Args& a, int tile, int rl, int wave, int q, f32x4 (&xv)[8][2], u32x4 (&dv)[8]) {
    const int r = tile * 16 + rl;
    if (MODE == 0) { const float* s = (r < NLAT ? a.in[0] + (size_t)r * DM : a.in[2] + (size_t)(r - NLAT) * DM) + 256 * wave + 8 * q;
#pragma unroll
        for (int ks = 0; ks < 8; ++ks) { xv[ks][0] = *(const f32x4*)(s + 32 * ks); xv[ks][1] = *(const f32x4*)(s + 32 * ks + 4); } }
    if (MODE == 1) { const bf16* dp = (const bf16*)(a.ws + WS_DLT) + (size_t)r * DM + 256 * wave + 8 * q;
#pragma unroll
        for (int ks = 0; ks < 8; ++ks) dv[ks] = *(const u32x4*)(dp + 32 * ks); }
}
template <int MODE>
__device__ __forceinline__ void phase_norm_tile(const Args& a, LAS unsigned char* lds, int first, int stride, int tile_end) {
    const int tid = threadIdx.x, lane = tid & 63, wave = __builtin_amdgcn_readfirstlane(tid >> 6), rl = lane & 15, q = lane >> 4;
    const float* ada = (const float*)(a.ws + WS_ADA);
    LAS float* gs = (LAS float*)lds;
    LAS float* shv = gs + 3 * DM;
    LAS float* ssred = shv + 3 * DM;
    LAS float* red = ssred + 128;
    { const float* gn = MODE == 0 ? a.in[6] : a.in[14]; const float* part = (const float*)(a.ws + WS_ADAP);
      for (int i = tid; i < 3 * DM; i += NTHREADS) { const int v = i / DM, d = i % DM;
          float sh_, sc_;
          if (MODE == 0) { const float* p0 = part + (size_t)v * 12288; sh_ = 0.f; sc_ = 0.f;
#pragma unroll
              for (int ks = 0; ks < 4; ++ks) { sh_ += p0[(size_t)ks * 3 * 12288 + d]; sc_ += p0[(size_t)ks * 3 * 12288 + DM + d]; } }
          else { const float* base = ada + (size_t)v * 12288 + 3 * DM; sh_ = base[d]; sc_ = base[DM + d]; }
          gs[i] = gn[d] * (1.f + sc_); shv[i] = sh_; }
    }
    bf16x8 wb[2][8];
    if (MODE == 0) { const bf16* Wz = (const bf16*)(a.ws + WS_WIN) + (size_t)4096 * DM;
#pragma unroll
        for (int nt = 0; nt < 2; ++nt)
#pragma unroll
            for (int ks = 0; ks < 8; ++ks) wb[nt][ks] = *(const bf16x8*)(Wz + (size_t)(16 * nt + rl) * DM + 256 * wave + 32 * ks + 8 * q);
    } else { const bf16* WH = (const bf16*)(a.ws + WS_WRH); const bf16* WL = (const bf16*)(a.ws + WS_WRL);
#pragma unroll
        for (int ks = 0; ks < 8; ++ks) { wb[0][ks] = *(const bf16x8*)(WH + (size_t)rl * DM + 256 * wave + 32 * ks + 8 * q); wb[1][ks] = *(const bf16x8*)(WL + (size_t)rl * DM + 256 * wave + 32 * ks + 8 * q); } }
    __syncthreads();
    bf16* Hout = (bf16*)(a.ws + (MODE == 0 ? WS_H : WS_HF));
    f32x4 xv[8][2]; u32x4 dv[8];
    auto tile_of = [&](int s) -> int { return MODE == 0 ? (s < 32 ? NLAT / 16 + s : s - 32) : s; };
    int sq = first;
    if (sq < tile_end) norm_load_tile<MODE>(a, tile_of(sq), rl, wave, q, xv, dv);
    for (; sq < tile_end; sq += stride) {
        const int tile = tile_of(sq);
        const int r = tile * 16 + rl;
        const int v = MODE == 0 ? (tile * 16 < NLAT ? (tile * 16) / SEQ : 2) : (tile * 16) / SEQ;
        if (MODE == 1) {
#pragma unroll
            for (int ks = 0; ks < 8; ++ks) { const u32x4 d = dv[ks];
                xv[ks][0] = (f32x4){__uint_as_float(d.x << 16), __uint_as_float(d.x & 0xffff0000u), __uint_as_float(d.y << 16), __uint_as_float(d.y & 0xffff0000u)};
                xv[ks][1] = (f32x4){__uint_as_float(d.z << 16), __uint_as_float(d.z & 0xffff0000u), __uint_as_float(d.w << 16), __uint_as_float(d.w & 0xffff0000u)}; }
            if (sq + stride < tile_end) norm_load_tile<MODE>(a, tile_of(sq + stride), rl, wave, q, xv, dv); }
        float ss = 0.f;
#pragma unroll
        for (int ks = 0; ks < 8; ++ks) { const f32x4 a0 = xv[ks][0], a1 = xv[ks][1]; ss += (a0.x * a0.x + a0.y * a0.y) + (a0.z * a0.z + a0.w * a0.w) + (a1.x * a1.x + a1.y * a1.y) + (a1.z * a1.z + a1.w * a1.w); }
        ss += __shfl_xor(ss, 16); ss += __shfl_xor(ss, 32);
        if (q == 0) ssred[wave * 16 + rl] = ss;
        __syncthreads();
        float tot = 0.f;
#pragma unroll
        for (int w8 = 0; w8 < 8; ++w8) tot += ssred[w8 * 16 + rl];
        const float rstd = rsqrtf(tot * (1.f / DM) + EPS);
        f32x4 acc0 = {0.f, 0.f, 0.f, 0.f}, acc1 = {0.f, 0.f, 0.f, 0.f};
        bf16* orow = Hout + (size_t)r * DM + 256 * wave + 8 * q;
        const LAS float* gsp = gs + v * DM + 256 * wave + 8 * q; const LAS float* shp = shv + v * DM + 256 * wave + 8 * q;
#pragma unroll
        for (int ks = 0; ks < 8; ++ks) {
            const f32x4 g0 = *(const LAS f32x4*)(gsp + 32 * ks), g1 = *(const LAS f32x4*)(gsp + 32 * ks + 4), s0 = *(const LAS f32x4*)(shp + 32 * ks), s1 = *(const LAS f32x4*)(shp + 32 * ks + 4);
            const f32x4 h0 = xv[ks][0] * rstd * g0 + s0, h1 = xv[ks][1] * rstd * g1 + s1;
            u32x4 hw; hw.x = pk2(h0.x, h0.y); hw.y = pk2(h0.z, h0.w); hw.z = pk2(h1.x, h1.y); hw.w = pk2(h1.z, h1.w);
            *(u32x4*)(orow + 32 * ks) = hw;
            const bf16x8 hf = __builtin_bit_cast(bf16x8, hw);
            if (MODE == 0) { acc0 = MFMA16(hf, wb[0][ks], acc0); acc1 = MFMA16(hf, wb[1][ks], acc1); }
            else { u32x4 lw;
                lw.x = pk2(h0.x - __uint_as_float(hw.x << 16), h0.y - __uint_as_float(hw.x & 0xffff0000u)); lw.y = pk2(h0.z - __uint_as_float(hw.y << 16), h0.w - __uint_as_float(hw.y & 0xffff0000u));
                lw.z = pk2(h1.x - __uint_as_float(hw.z << 16), h1.y - __uint_as_float(hw.z & 0xffff0000u)); lw.w = pk2(h1.z - __uint_as_float(hw.w << 16), h1.w - __uint_as_float(hw.w & 0xffff0000u));
                const bf16x8 lf = __builtin_bit_cast(bf16x8, lw);
                acc0 = MFMA16(hf, wb[0][ks], acc0); acc0 = MFMA16(lf, wb[0][ks], acc0); acc0 = MFMA16(hf, wb[1][ks], acc0); }
        }
        if (MODE == 0 && sq + stride < tile_end) norm_load_tile<MODE>(a, tile_of(sq + stride), rl, wave, q, xv, dv);
#pragma unroll
        for (int rr = 0; rr < 4; ++rr) { red[(wave * 16 + 4 * q + rr) * 32 + rl] = acc0[rr]; if (MODE == 0) red[(wave * 16 + 4 * q + rr) * 32 + 16 + rl] = acc1[rr]; }
        __syncthreads();
        if (MODE == 0) { const int row = tid >> 5, col = tid & 31; float s = 0.f;
#pragma unroll
            for (int w8 = 0; w8 < 8; ++w8) s += red[(w8 * 16 + row) * 32 + col];
            ((float*)(a.ws + WS_Z))[(size_t)(tile * 16 + row) * 32 + col] = s;
        } else if (tid < 256) { const int row = tid >> 4, e = tid & 15; float s = 0.f;
#pragma unroll
            for (int w8 = 0; w8 < 8; ++w8) s += red[(w8 * 16 + row) * 32 + e];
            float m = s; m = fmaxf(m, __shfl_xor(m, 1)); m = fmaxf(m, __shfl_xor(m, 2)); m = fmaxf(m, __shfl_xor(m, 4)); m = fmaxf(m, __shfl_xor(m, 8));
            const float ex = expf(s - m); float sm = ex; sm += __shfl_xor(sm, 1); sm += __shfl_xor(sm, 2); sm += __shfl_xor(sm, 4); sm += __shfl_xor(sm, 8);
            const int rg = tile * 16 + row, b = rg / SEQ, t = rg % SEQ;
            ((float*)(a.ws + WS_AFF))[((size_t)b * NE + e) * SEQ + t] = ex / sm; }
        if (MODE == 0 && tile >= NLAT / 16) {
            __threadfence(); __syncthreads();
            if (tid == 0) __hip_atomic_fetch_add((unsigned*)(a.ws + WS_CTL) + CW_CTXCNT + 64 * ((tile - NLAT / 16) >> 4), 1u, __ATOMIC_RELAXED, __HIP_MEMORY_SCOPE_AGENT);
        }
        __syncthreads();
    }
}

constexpr int GQ_LD = 136, GK_LD = 72;
constexpr int GL_Q = 0, GL_KI = 17408, GL_KET = 34816, GL_VT = 53248, GL_ST = 90112, GL_DC = 159744, GL_SEG = 160256;
__device__ __forceinline__ bf16x8 ldfrag(const LAS bf16* base, int row0, int ld, int koff, int lane) { return *(const LAS bf16x8*)(base + (row0 + (lane & 15)) * ld + koff + 8 * (lane >> 4)); }
__device__ __forceinline__ float fast_logsigmoid(float x) { return fminf(x, 0.f) - __logf(1.f + __expf(-fabsf(x))); }

struct GlaRaw { u32x4 q[2], k[2], v[4]; f32x2 z; };
template <bool FULL>
__device__ __forceinline__ void gla_issue_loads(const Args& a, int b, int h, int dir, int t0, size_t zrow0, int tid, GlaRaw& r) {
    const bf16* QH = (const bf16*)(a.ws + WS_QH) + ((size_t)(b * 4 + h) * SEQ + t0) * 128; const bf16* KH = (const bf16*)(a.ws + WS_KH) + ((size_t)(b * 4 + h) * KTOK + t0) * 128;
    const float* Z = (const float*)(a.ws + WS_Z);
#pragma unroll
    for (int j = 0; j < 2; ++j) { const int e = tid + 512 * j; r.k[j] = *(const u32x4*)(KH + (size_t)e * 8); if (FULL) r.q[j] = *(const u32x4*)(QH + (size_t)e * 8); }
    { const int e = tid * 2; r.z = *(const f32x2*)(Z + (zrow0 + (e >> 4)) * 32 + dir * 16 + (e & 15)); }
}
__device__ __forceinline__ void gla_issue_v(const Args& a, int b, int h, int t0, int tid, GlaRaw& r) {
    const bf16* VH = (const bf16*)(a.ws + WS_VH) + ((size_t)(b * 4 + h) * KTOK + t0) * 256;
#pragma unroll
    for (int rr = 0; rr < 4; ++rr) r.v[rr] = *(const u32x4*)(VH + (size_t)(4 * (tid >> 5) + rr) * 256 + 8 * (tid & 31));
}
__device__ __forceinline__ void gla_store_vt(LAS unsigned char* lds, int tid, const u32x4 (&x)[4]) {
    LAS bf16* VT = (LAS bf16*)(lds + GL_VT); const int c0 = 8 * (tid & 31), l0 = 4 * (tid >> 5);
    const int sw = (((l0 >> 3) ^ ((c0 >> 3) & 7)) << 3) + (l0 & 7);
#pragma unroll
    for (int i2 = 0; i2 < 4; ++i2) {
        const unsigned a0 = x[0][i2], a1 = x[1][i2], a2 = x[2][i2], a3 = x[3][i2];
        u32x2 lo, hi; lo.x = (a0 & 0xffffu) | (a1 << 16); lo.y = (a2 & 0xffffu) | (a3 << 16); hi.x = (a0 >> 16) | (a1 & 0xffff0000u); hi.y = (a2 >> 16) | (a3 & 0xffff0000u);
        *(LAS u32x2*)(VT + (c0 + 2 * i2) * GK_LD + sw) = lo; *(LAS u32x2*)(VT + (c0 + 2 * i2 + 1) * GK_LD + sw) = hi; }
}
__device__ __forceinline__ bf16x8 ldfrag_vt(const LAS bf16* VT, int row0, int ld, int kc, int lane) { const int row = row0 + (lane & 15); return *(const LAS bf16x8*)(VT + row * ld + ((kc ^ ((row >> 3) & 7)) << 3)); }
template <bool FULL>
__device__ __forceinline__ void gla_stage(LAS unsigned char* lds, int wave, int lane, int tid, const GlaRaw& r) {
    LAS bf16* Qd = (LAS bf16*)(lds + GL_Q); LAS bf16* Ki = (LAS bf16*)(lds + GL_KI); LAS unsigned* zs = (LAS unsigned*)(lds + GL_SEG);
#pragma unroll
    for (int j = 0; j < 2; ++j) { const int e = tid + 512 * j, row = e >> 4, c8 = e & 15;
        *(LAS u32x4*)(Ki + row * GQ_LD + 8 * c8) = r.k[j]; if (FULL) *(LAS u32x4*)(Qd + row * GQ_LD + 8 * c8) = r.q[j]; }
    zs[tid] = pk2(r.z.x, r.z.y);
    gla_store_vt(lds, tid, r.v);
}
template <bool FULL>
__device__ __forceinline__ void gla_prep(LAS unsigned char* lds, int dir, const bf16x8 wfrag, float bias, float& totacc) {
    const int tid = threadIdx.x, lane = tid & 63, wave = __builtin_amdgcn_readfirstlane(tid >> 6), cidx = lane & 15, q = lane >> 4, d = 16 * wave + cidx;
    LAS bf16* Qd = (LAS bf16*)(lds + GL_Q); LAS bf16* Ki = (LAS bf16*)(lds + GL_KI); LAS bf16* KeT = (LAS bf16*)(lds + GL_KET);
    LAS float* dcv = (LAS float*)(lds + GL_DC); const LAS bf16* zs = (const LAS bf16*)(lds + GL_SEG);
    float c[4][4], t4[4], sq[4], Tt[4];
#pragma unroll
    for (int it = 0; it < 4; ++it) {
        const bf16x8 zf = *(const LAS bf16x8*)(zs + (16 * it + cidx) * 16 + 8 * (q & 1));
        f32x4 pre = {bias, bias, bias, bias};
        pre = MFMA16(zf, wfrag, pre);
#pragma unroll
        for (int r = 0; r < 4; ++r) c[it][r] = fast_logsigmoid(pre[r]) * (1.f / 16.f);
        if (!dir) { c[it][1] += c[it][0]; c[it][2] += c[it][1]; c[it][3] += c[it][2]; t4[it] = c[it][3]; }
        else { c[it][2] += c[it][3]; c[it][1] += c[it][2]; c[it][0] += c[it][1]; t4[it] = c[it][0]; }
        float s = t4[it];
        if (!dir) { const float u = __shfl_up(s, 16); if (q >= 1) s += u; const float u2 = __shfl_up(s, 32); if (q >= 2) s += u2; Tt[it] = __shfl(s, cidx + 48); }
        else { const float u = __shfl_down(s, 16); if (q <= 2) s += u; const float u2 = __shfl_down(s, 32); if (q <= 1) s += u2; Tt[it] = __shfl(s, cidx); }
        sq[it] = s - t4[it];
    }
    const float total = (Tt[0] + Tt[1]) + (Tt[2] + Tt[3]);
    float off[4];
    if (!dir) { off[0] = 0.f; off[1] = Tt[0]; off[2] = Tt[0] + Tt[1]; off[3] = Tt[0] + Tt[1] + Tt[2]; }
    else { off[3] = 0.f; off[2] = Tt[3]; off[1] = Tt[3] + Tt[2]; off[0] = Tt[3] + Tt[2] + Tt[1]; }
    const float dc = __expf(total);
#pragma unroll
    for (int it = 0; it < 4; ++it) {
        float ke[4];
#pragma unroll
        for (int r = 0; r < 4; ++r) { const int i = 16 * it + 4 * q + r; const float cum = c[it][r] + off[it] + sq[it];
            const float kf = bf2f(Ki[i * GQ_LD + d]);
            if (FULL) { const float qf = bf2f(Qd[i * GQ_LD + d]); const float kin = kf * __expf(-cum);
                Qd[i * GQ_LD + d] = (bf16)f2bf(qf * 0.08838834764831845f * __expf(cum)); Ki[i * GQ_LD + d] = (bf16)f2bf(kin); ke[r] = kin * dc; }
            else ke[r] = kf * __expf(total - cum); }
        u32x2 kw; kw.x = pk2(ke[0], ke[1]); kw.y = pk2(ke[2], ke[3]);
        *(LAS u32x2*)(KeT + d * GK_LD + 16 * it + 4 * q) = kw;
    }
    if (q == 0) { dcv[d] = dc; totacc += total; }
}
__device__ __forceinline__ bf16x8 gla_wfrag(const float* w_a2, int h, int wave, int lane) {
    const int d = 16 * wave + (lane & 15), q = lane >> 4; unsigned wv[4];
#pragma unroll
    for (int j2 = 0; j2 < 4; ++j2) { float x[2];
#pragma unroll
        for (int u = 0; u < 2; ++u) { const float wf = w_a2[(8 * (q & 1) + 2 * j2 + u) * 512 + h * 128 + d]; const float hi = bf2f((bf16)f2bf(wf)); x[u] = q < 2 ? hi : wf - hi; }
        wv[j2] = pk2(x[0], x[1]); }
    return __builtin_bit_cast(bf16x8, (u32x4){wv[0], wv[1], wv[2], wv[3]});
}
__device__ __forceinline__ void gla_state_update(LAS unsigned char* lds, int lane, const bf16x8 (&vt)[2][2], f32x4 (&acc)[8][2]) {
    const LAS bf16* KeT = (const LAS bf16*)(lds + GL_KET); const LAS float* dcv = (const LAS float*)(lds + GL_DC);
#pragma unroll
    for (int mt = 0; mt < 8; ++mt) {
        const f32x4 dc4 = *(const LAS f32x4*)(dcv + 16 * mt + 4 * (lane >> 4));
        const bf16x8 k0 = ldfrag(KeT, 16 * mt, GK_LD, 0, lane), k1 = ldfrag(KeT, 16 * mt, GK_LD, 32, lane);
#pragma unroll
        for (int n = 0; n < 2; ++n) { f32x4 t = acc[mt][n] * dc4; t = MFMA16(k0, vt[n][0], t); t = MFMA16(k1, vt[n][1], t); acc[mt][n] = t; }
    }
}
constexpr size_t GLA_SV = 128 * 256;
constexpr int GA_LD = 136;
constexpr int GA_K = 0, GA_KET = 34816, GA_VT = 69632, GA_Z = 139264, GA_DC = 143360;
struct GlaRawA { u32x4 k[4], v[8]; f32x2 z[2]; };
__device__ __forceinline__ void glaA_issue(const Args& a, int b, int h, int dir, int t0, size_t zrow0, int tid, GlaRawA& r) {
    const bf16* KH = (const bf16*)(a.ws + WS_KH) + ((size_t)(b * 4 + h) * KTOK + t0) * 128; const float* Z = (const float*)(a.ws + WS_Z);
#pragma unroll
    for (int j = 0; j < 4; ++j) { const int e = tid + 512 * j; r.k[j] = *(const u32x4*)(KH + (size_t)e * 8); }
#pragma unroll
    for (int j = 0; j < 2; ++j) { const int e = (tid + 512 * j) * 2; r.z[j] = *(const f32x2*)(Z + (zrow0 + (e >> 4)) * 32 + dir * 16 + (e & 15)); }
}
__device__ __forceinline__ void glaA_issue_v(const Args& a, int b, int h, int t0, int tid, GlaRawA& r) {
    const bf16* VH = (const bf16*)(a.ws + WS_VH) + ((size_t)(b * 4 + h) * KTOK + t0) * 256;
#pragma unroll
    for (int j = 0; j < 2; ++j)
#pragma unroll
        for (int rr = 0; rr < 4; ++rr) r.v[4 * j + rr] = *(const u32x4*)(VH + (size_t)(4 * ((tid >> 5) + 16 * j) + rr) * 256 + 8 * (tid & 31));
}
__device__ __forceinline__ void glaA_stage(LAS unsigned char* lds, int wave, int lane, int tid, const GlaRawA& r) {
    LAS bf16* Kr = (LAS bf16*)(lds + GA_K); LAS unsigned* zs = (LAS unsigned*)(lds + GA_Z); LAS bf16* VT = (LAS bf16*)(lds + GA_VT);
#pragma unroll
    for (int j = 0; j < 4; ++j) { const int e = tid + 512 * j, row = e >> 4, c8 = e & 15; *(LAS u32x4*)(Kr + row * GA_LD + 8 * c8) = r.k[j]; }
#pragma unroll
    for (int j = 0; j < 2; ++j) zs[tid + 512 * j] = pk2(r.z[j].x, r.z[j].y);
#pragma unroll
    for (int j = 0; j < 2; ++j) { const int c0 = 8 * (tid & 31), l0 = 4 * ((tid >> 5) + 16 * j);
        const int sw = (((l0 >> 3) ^ ((c0 >> 3) & 7)) << 3) + (l0 & 7);
#pragma unroll
        for (int i2 = 0; i2 < 4; ++i2) {
            const unsigned a0 = r.v[4 * j][i2], a1 = r.v[4 * j + 1][i2], a2 = r.v[4 * j + 2][i2], a3 = r.v[4 * j + 3][i2];
            u32x2 lo, hi; lo.x = (a0 & 0xffffu) | (a1 << 16); lo.y = (a2 & 0xffffu) | (a3 << 16); hi.x = (a0 >> 16) | (a1 & 0xffff0000u); hi.y = (a2 >> 16) | (a3 & 0xffff0000u);
            *(LAS u32x2*)(VT + (c0 + 2 * i2) * GA_LD + sw) = lo; *(LAS u32x2*)(VT + (c0 + 2 * i2 + 1) * GA_LD + sw) = hi; } }
}
__device__ __forceinline__ void glaA_prep(LAS unsigned char* lds, int dir, const bf16x8 wfrag, float bias, float& totacc) {
    const int tid = threadIdx.x, lane = tid & 63, wave = __builtin_amdgcn_readfirstlane(tid >> 6), cidx = lane & 15, q = lane >> 4, d = 16 * wave + cidx;
    const LAS bf16* Kr = (const LAS bf16*)(lds + GA_K); LAS bf16* KeT = (LAS bf16*)(lds + GA_KET); LAS float* dcv = (LAS float*)(lds + GA_DC); const LAS bf16* zs = (const LAS bf16*)(lds + GA_Z);
    float carry = 0.f;
    for (int hh = 0; hh < 2; ++hh) {
        const int it0 = 4 * (dir ? hh : 1 - hh);
        float c[4][4], sq[4], Tt[4];
#pragma unroll
        for (int i = 0; i < 4; ++i) {
            const bf16x8 zf = *(const LAS bf16x8*)(zs + (16 * (it0 + i) + cidx) * 16 + 8 * (q & 1));
            f32x4 pre = {bias, bias, bias, bias};
            pre = MFMA16(zf, wfrag, pre);
#pragma unroll
            for (int r = 0; r < 4; ++r) c[i][r] = fast_logsigmoid(pre[r]) * (1.f / 16.f);
            float t4;
            if (!dir) { c[i][1] += c[i][0]; c[i][2] += c[i][1]; c[i][3] += c[i][2]; t4 = c[i][3]; }
            else { c[i][2] += c[i][3]; c[i][1] += c[i][2]; c[i][0] += c[i][1]; t4 = c[i][0]; }
            float s = t4;
            if (!dir) { const float u = __shfl_up(s, 16); if (q >= 1) s += u; const float u2 = __shfl_up(s, 32); if (q >= 2) s += u2; Tt[i] = __shfl(s, cidx + 48); }
            else { const float u = __shfl_down(s, 16); if (q <= 2) s += u; const float u2 = __shfl_down(s, 32); if (q <= 1) s += u2; Tt[i] = __shfl(s, cidx); }
            sq[i] = s - t4;
        }
        const float toth = (Tt[0] + Tt[1]) + (Tt[2] + Tt[3]);
        float off[4];
        if (!dir) { off[0] = 0.f; off[1] = Tt[0]; off[2] = Tt[0] + Tt[1]; off[3] = Tt[0] + Tt[1] + Tt[2]; }
        else { off[3] = 0.f; off[2] = Tt[3]; off[1] = Tt[3] + Tt[2]; off[0] = Tt[3] + Tt[2] + Tt[1]; }
#pragma unroll
        for (int i = 0; i < 4; ++i) {
            float ke[4];
#pragma unroll
            for (int r = 0; r < 4; ++r) { const int tk = 16 * (it0 + i) + 4 * q + r; const float cum = c[i][r] + off[i] + sq[i]; ke[r] = bf2f(Kr[tk * GA_LD + d]) * __expf(toth - cum + carry); }
            u32x2 kw; kw.x = pk2(ke[0], ke[1]); kw.y = pk2(ke[2], ke[3]);
            *(LAS u32x2*)(KeT + d * GA_LD + 16 * (it0 + i) + 4 * q) = kw;
        }
        carry += toth;
    }
    if (q == 0) { dcv[d] = __expf(carry); totacc += carry; }
}
__device__ __forceinline__ void gla_passA128(const Args& a, LAS unsigned char* lds, int item) {
    const int tid = threadIdx.x, lane = tid & 63, wave = __builtin_amdgcn_readfirstlane(tid >> 6), q = lane >> 4, cidx = lane & 15;
    const bool is_ctx = item >= 256; const int seq = is_ctx ? (item - 256) >> 1 : item >> 4, s = is_ctx ? (item - 256) & 1 : item & 15;
    const int b = seq >> 3, dir = (seq >> 2) & 1, h = seq & 3, nstep = is_ctx ? 1 : 8;
    const size_t rowbase = is_ctx ? (size_t)(NLAT + b * CTXL + s * 128) : (size_t)b * SEQ + (size_t)s * 1024;
    const float* w_a2 = dir ? a.in[10] : a.in[8]; const float* b_a2 = dir ? a.in[11] : a.in[9];
    const bf16x8 wfrag = gla_wfrag(w_a2, h, wave, lane);
    const float bias = b_a2[h * 128 + 16 * wave + cidx];
    f32x4 acc[8][2];
#pragma unroll
    for (int mt = 0; mt < 8; ++mt) { acc[mt][0] = (f32x4){0.f, 0.f, 0.f, 0.f}; acc[mt][1] = (f32x4){0.f, 0.f, 0.f, 0.f}; }
    float totacc = 0.f;
    const int tbase = is_ctx ? SEQ + s * 128 : s * 1024;
    GlaRawA raw; { const int n0 = dir ? (nstep - 1) : 0; glaA_issue(a, b, h, dir, tbase + n0 * 128, rowbase + (size_t)n0 * 128, tid, raw); glaA_issue_v(a, b, h, tbase + n0 * 128, tid, raw); }
    for (int ci = 0; ci < nstep; ++ci) {
        const int nn = dir ? (nstep - 2 - ci) : ci + 1;
        glaA_stage(lds, wave, lane, tid, raw);
        if (ci + 1 < nstep) glaA_issue(a, b, h, dir, tbase + nn * 128, rowbase + (size_t)nn * 128, tid, raw);
        __syncthreads();
        glaA_prep(lds, dir, wfrag, bias, totacc);
        __syncthreads();
        const LAS bf16* VT = (const LAS bf16*)(lds + GA_VT); const LAS bf16* KeT = (const LAS bf16*)(lds + GA_KET); const LAS float* dcv = (const LAS float*)(lds + GA_DC);
        bf16x8 vt[2][4];
#pragma unroll
        for (int n2 = 0; n2 < 2; ++n2)
#pragma unroll
            for (int ks = 0; ks < 4; ++ks) vt[n2][ks] = ldfrag_vt(VT, 32 * wave + 16 * n2, GA_LD, 4 * ks + (lane >> 4), lane);
#pragma unroll
        for (int mt = 0; mt < 8; ++mt) {
            const f32x4 dc4 = *(const LAS f32x4*)(dcv + 16 * mt + 4 * q);
            bf16x8 kf[4];
#pragma unroll
            for (int ks = 0; ks < 4; ++ks) kf[ks] = ldfrag(KeT, 16 * mt, GA_LD, 32 * ks, lane);
#pragma unroll
            for (int n2 = 0; n2 < 2; ++n2) { f32x4 t = acc[mt][n2] * dc4;
#pragma unroll
                for (int ks = 0; ks < 4; ++ks) t = MFMA16(kf[ks], vt[n2][ks], t);
                acc[mt][n2] = t; }
        }
        if (ci + 1 < nstep) glaA_issue_v(a, b, h, tbase + nn * 128, tid, raw);
        __syncthreads();
    }
    float* T = is_ctx ? (float*)(a.ws + WS_TC) + (size_t)(item - 256) * GLA_SV : (float*)(a.ws + WS_T) + (size_t)item * GLA_SV;
#pragma unroll
    for (int mt = 0; mt < 8; ++mt)
#pragma unroll
        for (int n2 = 0; n2 < 2; ++n2)
#pragma unroll
            for (int r = 0; r < 4; ++r) T[(size_t)(16 * mt + 4 * q + r) * 256 + 32 * wave + 16 * n2 + cidx] = acc[mt][n2][r];
    if (q == 0) { float* D = is_ctx ? (float*)(a.ws + WS_DTC) + (size_t)(item - 256) * 128 : (float*)(a.ws + WS_DT) + (size_t)item * 128; D[16 * wave + cidx] = __expf(totacc); }
}

__device__ __forceinline__ void gla_passB(const Args& a) {
    const float* T = (const float*)(a.ws + WS_T); const float* DT = (const float*)(a.ws + WS_DT); float* SST = (float*)(a.ws + WS_SST);
    for (int e = blockIdx.x * NTHREADS + threadIdx.x; e < 16 * (int)GLA_SV; e += gridDim.x * NTHREADS) {
        const int seq = e >> 15, dv = e & 32767, d = dv >> 8, dir = (seq >> 2) & 1;
        float S = 0.f;
        { const float* TC = (const float*)(a.ws + WS_TC); const float* DTC = (const float*)(a.ws + WS_DTC);
#pragma unroll
          for (int j = 0; j < 2; ++j) { const int cc = dir ? 1 - j : j; S = DTC[(size_t)(seq * 2 + cc) * 128 + d] * S + TC[(size_t)(seq * 2 + cc) * GLA_SV + dv]; } }
        float tv[16], dd[16];
#pragma unroll
        for (int si = 0; si < 16; ++si) { const int s = dir ? 15 - si : si; const size_t it = (size_t)seq * 16 + s; tv[si] = T[it * GLA_SV + dv]; dd[si] = DT[it * 128 + d]; }
#pragma unroll
        for (int si = 0; si < 16; ++si) { const int s = dir ? 15 - si : si; const size_t it = (size_t)seq * 16 + s;
            SST[it * GLA_SV + dv] = S; S = dd[si] * S + tv[si]; }
    }
}
__device__ __forceinline__ void gla_passC(const Args& a, LAS unsigned char* lds, int item) {
    const int tid = threadIdx.x, lane = tid & 63, wave = __builtin_amdgcn_readfirstlane(tid >> 6), q = lane >> 4, cidx = lane & 15;
    const int seq = item >> 4, s = item & 15, b = seq >> 3, dir = (seq >> 2) & 1, h = seq & 3;
    const size_t rowbase = (size_t)b * SEQ + (size_t)s * 1024;
    const float* w_a2 = dir ? a.in[10] : a.in[8]; const float* b_a2 = dir ? a.in[11] : a.in[9];
    bf16* O = (bf16*)(a.ws + (dir ? WS_OB : WS_OF));
    const bf16x8 wfrag = gla_wfrag(w_a2, h, wave, lane);
    const float bias = b_a2[h * 128 + 16 * wave + cidx];
    LAS bf16* Qd = (LAS bf16*)(lds + GL_Q); LAS bf16* Ki = (LAS bf16*)(lds + GL_KI); LAS bf16* Pm = Ki; LAS bf16* VT = (LAS bf16*)(lds + GL_VT); LAS bf16* ST = (LAS bf16*)(lds + GL_ST);
    f32x4 acc[8][2];
    { const float* S0 = (const float*)(a.ws + WS_SST) + (size_t)item * GLA_SV;
#pragma unroll
      for (int mt = 0; mt < 8; ++mt)
#pragma unroll
          for (int n2 = 0; n2 < 2; ++n2) {
#pragma unroll
              for (int r = 0; r < 4; ++r) acc[mt][n2][r] = S0[(size_t)(16 * mt + 4 * q + r) * 256 + 32 * wave + 16 * n2 + cidx];
              u32x2 wv; wv.x = pk2(acc[mt][n2][0], acc[mt][n2][1]); wv.y = pk2(acc[mt][n2][2], acc[mt][n2][3]);
              *(LAS u32x2*)(ST + (32 * wave + 16 * n2 + cidx) * GQ_LD + 16 * mt + 4 * q) = wv; } }
    float totacc = 0.f;
    const int tbase = s * 1024;
    GlaRaw raw; gla_issue_loads<true>(a, b, h, dir, tbase + (dir ? 15 : 0) * 64, rowbase + (size_t)(dir ? 15 : 0) * 64, tid, raw); gla_issue_v(a, b, h, tbase + (dir ? 15 : 0) * 64, tid, raw);
    for (int ci = 0; ci < 16; ++ci) {
        const int n = dir ? (15 - ci) : ci; const size_t row0 = rowbase + (size_t)n * 64; const int nn = dir ? (14 - ci) : ci + 1;
        gla_stage<true>(lds, wave, lane, tid, raw);
        if (ci + 1 < 16) gla_issue_loads<true>(a, b, h, dir, tbase + nn * 64, rowbase + (size_t)nn * 64, tid, raw);
        __syncthreads();
        gla_prep<true>(lds, dir, wfrag, bias, totacc);
        __syncthreads();
        const int it = wave >> 1;
        u32x2 pw[2];
#pragma unroll
        for (int jj = 0; jj < 2; ++jj) { const int jt = 2 * (wave & 1) + jj; f32x4 sc = {0.f, 0.f, 0.f, 0.f};
#pragma unroll
            for (int ks = 0; ks < 4; ++ks) sc = MFMA16(ldfrag(Ki, 16 * jt, GQ_LD, 32 * ks, lane), ldfrag(Qd, 16 * it, GQ_LD, 32 * ks, lane), sc);
            const int i = 16 * it + cidx, j0 = 16 * jt + 4 * q;
#pragma unroll
            for (int r = 0; r < 4; ++r) { const bool keep = dir ? (j0 + r >= i) : (j0 + r <= i); sc[r] = keep ? sc[r] : 0.f; }
            pw[jj].x = pk2(sc[0], sc[1]); pw[jj].y = pk2(sc[2], sc[3]); }
        __syncthreads();
#pragma unroll
        for (int jj = 0; jj < 2; ++jj) *(LAS u32x2*)(Pm + (16 * it + cidx) * GK_LD + 16 * (2 * (wave & 1) + jj) + 4 * q) = pw[jj];
        __syncthreads();
        bf16x8 vt[2][2], st[2][4];
#pragma unroll
        for (int n2 = 0; n2 < 2; ++n2) { vt[n2][0] = ldfrag_vt(VT, 32 * wave + 16 * n2, GK_LD, (lane >> 4), lane); vt[n2][1] = ldfrag_vt(VT, 32 * wave + 16 * n2, GK_LD, 4 + (lane >> 4), lane);
#pragma unroll
            for (int ks = 0; ks < 4; ++ks) st[n2][ks] = ldfrag(ST, 32 * wave + 16 * n2, GQ_LD, 32 * ks, lane); }
#pragma unroll
        for (int i2 = 0; i2 < 4; ++i2) {
            const bf16x8 p0 = ldfrag(Pm, 16 * i2, GK_LD, 0, lane), p1 = ldfrag(Pm, 16 * i2, GK_LD, 32, lane);
            bf16x8 qf[4];
#pragma unroll
            for (int ks = 0; ks < 4; ++ks) qf[ks] = ldfrag(Qd, 16 * i2, GQ_LD, 32 * ks, lane);
#pragma unroll
            for (int n2 = 0; n2 < 2; ++n2) { f32x4 o = {0.f, 0.f, 0.f, 0.f};
                o = MFMA16(vt[n2][0], p0, o); o = MFMA16(vt[n2][1], p1, o);
#pragma unroll
                for (int ks = 0; ks < 4; ++ks) o = MFMA16(st[n2][ks], qf[ks], o);
                u32x2 wv; wv.x = pk2(o[0], o[1]); wv.y = pk2(o[2], o[3]);
                *(u32x2*)(O + (row0 + 16 * i2 + cidx) * 1024 + h * 256 + 32 * wave + 16 * n2 + 4 * q) = wv; }
            if (i2 & 1) asm volatile("" ::: "memory");
        }
        if (ci + 1 < 16) gla_issue_v(a, b, h, tbase + nn * 64, tid, raw);
        gla_state_update(lds, lane, vt, acc);
#pragma unroll
        for (int mt = 0; mt < 8; ++mt)
#pragma unroll
            for (int n2 = 0; n2 < 2; ++n2) { u32x2 wv; wv.x = pk2(acc[mt][n2][0], acc[mt][n2][1]); wv.y = pk2(acc[mt][n2][2], acc[mt][n2][3]);
                *(LAS u32x2*)(ST + (32 * wave + 16 * n2 + cidx) * GQ_LD + 16 * mt + 4 * q) = wv; }
        __syncthreads();
    }
}

__device__ __forceinline__ void merge_load(const bf16* OF, const bf16* OB, const bf16* G, int r0, int NGW, int lane, u32x2 (&fa)[2][4], u32x2 (&fb)[2][4], u32x2 (&gw2)[2][4]) {
#pragma unroll
    for (int u = 0; u < 2; ++u) { const int r = r0 + u * NGW; if (r < NLAT) {
#pragma unroll
        for (int j = 0; j < 4; ++j) { const int col = 256 * j + 4 * lane; fa[u][j] = *(const u32x2*)(OF + (size_t)r * 1024 + col); fb[u][j] = *(const u32x2*)(OB + (size_t)r * 1024 + col); gw2[u][j] = *(const u32x2*)(G + (size_t)r * 1024 + col); } } }
}
__device__ __forceinline__ void phase_gla_merge(const Args& a) {
    const int tid = threadIdx.x, lane = tid & 63, wave = tid >> 6;
    if (PROBE_HALF && blockIdx.x >= gridDim.x / 2) return;
    const int gw = blockIdx.x * 8 + wave, NGW = (PROBE_HALF ? gridDim.x / 2 : gridDim.x) * 8;
    const bf16* OF = (const bf16*)(a.ws + WS_OF); const bf16* OB = (const bf16*)(a.ws + WS_OB);
    const bf16* G = (const bf16*)(a.ws + WS_G); bf16* Y = (bf16*)(a.ws + WS_YCAT); const float* gg = a.in[12];
    f32x4 gn[4];
#pragma unroll
    for (int j = 0; j < 4; ++j) gn[j] = *(const f32x4*)(gg + 256 * j + 4 * lane);
    u32x2 fa[2][4], fb[2][4], gw2[2][4], na[2][4], nb[2][4], ng[2][4];
    if (gw < NLAT) merge_load(OF, OB, G, gw, NGW, lane, fa, fb, gw2);
    for (int r0 = gw; r0 < NLAT; r0 += 2 * NGW) {
        if (r0 + 2 * NGW < NLAT) merge_load(OF, OB, G, r0 + 2 * NGW, NGW, lane, na, nb, ng);
#pragma unroll
        for (int u = 0; u < 2; ++u) { const int r = r0 + u * NGW; if (r < NLAT) {
#pragma unroll
            for (int j = 0; j < 4; ++j) {
                const int col = 256 * j + 4 * lane;
                f32x4 o; o.x = __uint_as_float(fa[u][j].x << 16) + __uint_as_float(fb[u][j].x << 16); o.y = __uint_as_float(fa[u][j].x & 0xffff0000u) + __uint_as_float(fb[u][j].x & 0xffff0000u);
                o.z = __uint_as_float(fa[u][j].y << 16) + __uint_as_float(fb[u][j].y << 16); o.w = __uint_as_float(fa[u][j].y & 0xffff0000u) + __uint_as_float(fb[u][j].y & 0xffff0000u);
                const float ss = wave_sum((o.x * o.x + o.y * o.y) + (o.z * o.z + o.w * o.w));
                const float rstd = rsqrtf(ss * (1.f / 256.f) + EPS);
                const float g0 = __uint_as_float(gw2[u][j].x << 16), g1 = __uint_as_float(gw2[u][j].x & 0xffff0000u), g2 = __uint_as_float(gw2[u][j].y << 16), g3 = __uint_as_float(gw2[u][j].y & 0xffff0000u);
                u32x2 w; w.x = pk2(o.x * rstd * gn[j].x * silu_f(g0), o.y * rstd * gn[j].y * silu_f(g1)); w.y = pk2(o.z * rstd * gn[j].z * silu_f(g2), o.w * rstd * gn[j].w * silu_f(g3));
                *(u32x2*)(Y + (size_t)r * DM + col) = w;
            } } }
#pragma unroll
        for (int u = 0; u < 2; ++u)
#pragma unroll
            for (int j = 0; j < 4; ++j) { fa[u][j] = na[u][j]; fb[u][j] = nb[u][j]; gw2[u][j] = ng[u][j]; }
    }
}

constexpr int FLD = 136;
__device__ __forceinline__ void load_dft_frags(const unsigned char* ws, int wave, int lane, bf16x8 (&fc)[4], bf16x8 (&fs)[4]) {
    const bf16* FC = (const bf16*)(ws + WS_FC); const bf16* FS = (const bf16*)(ws + WS_FS);
    const int k = 16 * wave + (lane & 15);
#pragma unroll
    for (int ks = 0; ks < 4; ++ks) { fc[ks] = *(const bf16x8*)(FC + k * 128 + ks * 32 + 8 * (lane >> 4)); fs[ks] = *(const bf16x8*)(FS + k * 128 + ks * 32 + 8 * (lane >> 4)); }
}
__device__ __forceinline__ void store_t4x8(LAS bf16* XT, int c0, int l0, const u32x4 (&x)[4]) {
#pragma unroll
    for (int i2 = 0; i2 < 4; ++i2) {
        const unsigned a0 = x[0][i2], a1 = x[1][i2], a2 = x[2][i2], a3 = x[3][i2];
        u32x2 lo, hi; lo.x = (a0 & 0xffffu) | (a1 << 16); lo.y = (a2 & 0xffffu) | (a3 << 16); hi.x = (a0 >> 16) | (a1 & 0xffff0000u); hi.y = (a2 >> 16) | (a3 & 0xffff0000u);
        const int sw = (((l0 >> 3) ^ ((c0 >> 3) & 7)) << 3) + (l0 & 7);
        *(LAS u32x2*)(XT + (c0 + 2 * i2) * FLD + sw) = lo; *(LAS u32x2*)(XT + (c0 + 2 * i2 + 1) * FLD + sw) = hi; }
}
__device__ __forceinline__ bf16x8 ldfrag_sw(const LAS bf16* XT, int row0, int kc, int lane) { const int row = row0 + (lane & 15); return *(const LAS bf16x8*)(XT + row * FLD + ((kc ^ ((row >> 3) & 7)) << 3)); }
__device__ __forceinline__ void phase_f1(const Args& a, LAS unsigned char* lds) {
    const int tid = threadIdx.x, lane = tid & 63, wave = __builtin_amdgcn_readfirstlane(tid >> 6), q = lane >> 4, cidx = lane & 15;
    const bf16* P = (const bf16*)(a.ws + WS_U); const f32x2* TW = (const f32x2*)(a.ws + WS_TW);
    bf16* A1r = (bf16*)(a.ws + WS_FA); bf16* A1i = (bf16*)(a.ws + WS_FAI);
    LAS bf16* XT = (LAS bf16*)lds;
    bf16x8 fc[4], fs[4]; load_dft_frags(a.ws, wave, lane, fc, fs);
    const int k1 = 16 * wave + cidx;
    u32x4 xp[2][4];
    auto f1_load = [&](int item) { const int cb = item & 3, l2 = (item >> 2) & 127, b = item >> 9, ch0 = cb * 256;
#pragma unroll
        for (int j = 0; j < 2; ++j) { const int task = tid + 512 * j, cblk = task & 31, lb = task >> 5;
#pragma unroll
            for (int r = 0; r < 4; ++r) xp[j][r] = *(const u32x4*)(P + ((size_t)b * SEQ + 128 * (4 * lb + r) + l2) * 1024 + ch0 + 8 * cblk); } };
    if ((int)blockIdx.x < 1024) f1_load(blockIdx.x);
    for (int item = blockIdx.x; item < 1024; item += gridDim.x) {
        const int cb = item & 3, l2 = (item >> 2) & 127, b = item >> 9, ch0 = cb * 256;
#pragma unroll
        for (int j = 0; j < 2; ++j) { const int task = tid + 512 * j, cblk = task & 31, lb = task >> 5; store_t4x8(XT, 8 * cblk, 4 * lb, xp[j]); }
        if (item + (int)gridDim.x < 1024) f1_load(item + gridDim.x);
        __syncthreads();
        const f32x2 tw = TW[l2 * k1];
        LAS unsigned char* ost = lds + 69632 + wave * 8448;
        u32x2 wim[16];
#pragma unroll
        for (int mt = 0; mt < 16; ++mt) {
            f32x4 cr = {0.f, 0.f, 0.f, 0.f}, cs = {0.f, 0.f, 0.f, 0.f};
#pragma unroll
            for (int ks = 0; ks < 4; ++ks) { const bf16x8 xa = ldfrag_sw(XT, 16 * mt, 4 * ks + q, lane); cr = MFMA16(xa, fc[ks], cr); cs = MFMA16(xa, fs[ks], cs); }
            const f32x4 br = cr * tw.x - cs * tw.y, bi = -(cs * tw.x + cr * tw.y);
            u32x2 wr_; wr_.x = pk2(br[0], br[1]); wr_.y = pk2(br[2], br[3]); wim[mt].x = pk2(bi[0], bi[1]); wim[mt].y = pk2(bi[2], bi[3]);
            *(LAS u32x2*)(ost + cidx * 528 + (16 * mt + 4 * q) * 2) = wr_;
        }
        const size_t obase = (((size_t)b * 128 + 16 * wave) * 128 + l2) * 1024 + ch0;
#pragma unroll
        for (int i = 0; i < 8; ++i) { const int row = 2 * i + (lane >> 5), ck = lane & 31; const u32x4 v = *(const LAS u32x4*)(ost + row * 528 + ck * 16); *(u32x4*)(A1r + obase + (size_t)row * 128 * 1024 + 8 * ck) = v; }
#pragma unroll
        for (int mt = 0; mt < 16; ++mt) *(LAS u32x2*)(ost + cidx * 528 + (16 * mt + 4 * q) * 2) = wim[mt];
#pragma unroll
        for (int i = 0; i < 8; ++i) { const int row = 2 * i + (lane >> 5), ck = lane & 31; const u32x4 v = *(const LAS u32x4*)(ost + row * 528 + ck * 16); *(u32x4*)(A1i + obase + (size_t)row * 128 * 1024 + 8 * ck) = v; }
        __syncthreads();
    }
}
__device__ __forceinline__ void phase_f34(const Args& a, LAS unsigned char* lds) {
    const int tid = threadIdx.x, lane = tid & 63, wave = __builtin_amdgcn_readfirstlane(tid >> 6), q = lane >> 4, cidx = lane & 15;
    const bf16* A1r = (const bf16*)(a.ws + WS_FA); const bf16* A1i = (const bf16*)(a.ws + WS_FAI); bf16* Y = (bf16*)(a.ws + WS_YCAT);
    LAS bf16* XTr = (LAS bf16*)lds; LAS bf16* XTi = XTr + 128 * FLD; LAS bf16* XKr = XTi + 128 * FLD; LAS bf16* XKi = XKr + 128 * FLD;
    bf16x8 fc[4], fs[4]; load_dft_frags(a.ws, wave, lane, fc, fs);
    const float nrm = 1.0f / 1448.15468787005f;
    u32x4 xr[4], xi[4];
    auto f34_load = [&](int item) { const int g = item & 7, k1 = (item >> 3) & 127, b = item >> 10, ch0 = g * 128; const int cblk = tid & 15, lb = tid >> 4;
#pragma unroll
        for (int r = 0; r < 4; ++r) { const size_t off = (((size_t)b * 128 + k1) * 128 + 4 * lb + r) * 1024 + ch0 + 8 * cblk; xr[r] = *(const u32x4*)(A1r + off); xi[r] = *(const u32x4*)(A1i + off); } };
    if ((int)blockIdx.x < 2048) f34_load(blockIdx.x);
    for (int item = blockIdx.x; item < 2048; item += gridDim.x) {
        const int g = item & 7, k1 = (item >> 3) & 127, b = item >> 10, ch0 = g * 128;
        { const int cblk = tid & 15, lb = tid >> 4; store_t4x8(XTr, 8 * cblk, 4 * lb, xr); store_t4x8(XTi, 8 * cblk, 4 * lb, xi); }
        if (item + (int)gridDim.x < 2048) f34_load(item + gridDim.x);
        __syncthreads();
        const int k2 = 16 * wave + cidx;
#pragma unroll 2
        for (int mt = 0; mt < 8; ++mt) {
            f32x4 a1 = {0.f, 0.f, 0.f, 0.f}, a2 = a1, b1 = a1, b2 = a1;
#pragma unroll
            for (int ks = 0; ks < 4; ++ks) { const bf16x8 xa = ldfrag_sw(XTr, 16 * mt, 4 * ks + q, lane); const bf16x8 xb = ldfrag_sw(XTi, 16 * mt, 4 * ks + q, lane);
                a1 = MFMA16(xa, fc[ks], a1); b2 = MFMA16(xa, fs[ks], b2); a2 = MFMA16(xb, fs[ks], a2); b1 = MFMA16(xb, fc[ks], b1); }
            const f32x4 xre = a1 + a2, xim = b1 - b2;
            u32x2 wr_; wr_.x = pk2(xre[0], xre[1]); wr_.y = pk2(xre[2], xre[3]); u32x2 wi_; wi_.x = pk2(xim[0], xim[1]); wi_.y = pk2(xim[2], xim[3]);
            *(LAS u32x2*)(XKr + k2 * FLD + 16 * mt + 4 * q) = wr_; *(LAS u32x2*)(XKi + k2 * FLD + 16 * mt + 4 * q) = wi_;
        }
        __syncthreads();
#pragma unroll 2
        for (int nt = 0; nt < 8; ++nt) {
            f32x4 y = {0.f, 0.f, 0.f, 0.f};
#pragma unroll
            for (int ks = 0; ks < 4; ++ks) { const bf16x8 xa = *(const LAS bf16x8*)(XKr + (16 * nt + cidx) * FLD + ks * 32 + 8 * q); const bf16x8 xb = *(const LAS bf16x8*)(XKi + (16 * nt + cidx) * FLD + ks * 32 + 8 * q);
                y = MFMA16(fc[ks], xa, y); y = MFMA16(fs[ks], xb, y); }
            u32x2 w; w.x = pk2(y[0] * nrm, y[1] * nrm); w.y = pk2(y[2] * nrm, y[3] * nrm);
            *(LAS u32x2*)(XTr + (16 * nt + cidx) * FLD + 16 * wave + 4 * q) = w;
        }
        __syncthreads();
#pragma unroll
        for (int i = 0; i < 4; ++i) { const int task = tid + 512 * i, row = task >> 4, ck = task & 15; const u32x4 v = *(const LAS u32x4*)(XTr + row * FLD + 8 * ck);
            *(u32x4*)(Y + ((size_t)b * SEQ + k1 + 128 * row) * DM + 1024 + ch0 + 8 * ck) = v; }
        __syncthreads();
    }
}

__device__ __forceinline__ void phase_topk(const Args& a, LAS unsigned char* lds) {
    const int tid = threadIdx.x, lane = tid & 63, wave = tid >> 6;
    LAS unsigned* keys = (LAS unsigned*)lds;
    LAS unsigned* hist = (LAS unsigned*)(lds + 65536);
    LAS unsigned* misc = hist + 256;
    LAS unsigned* wtot = misc + 16;
    const float* AFF = (const float*)(a.ws + WS_AFF); int* TOK = (int*)(a.ws + WS_TOK); float* GATE = (float*)(a.ws + WS_GATE); int* SEL = (int*)(a.ws + WS_SEL);
    for (int be = blockIdx.x; be < NB * NE; be += gridDim.x) {
        const int b = be / NE, e = be % NE;
        for (int i = tid; i < SEQ; i += NTHREADS) keys[i] = __float_as_uint(AFF[(size_t)be * SEQ + i]);
        unsigned prefix = 0u, pmask = 0u, krem = CAP;
        for (int pass = 0; pass < 4; ++pass) {
            const int shift = 24 - 8 * pass;
            if (tid < 256) hist[tid] = 0u;
            __syncthreads();
            for (int i = tid; i < SEQ; i += NTHREADS) { const unsigned k = keys[i]; if ((k & pmask) == prefix) __hip_atomic_fetch_add(&hist[(k >> shift) & 255u], 1u, __ATOMIC_RELAXED, __HIP_MEMORY_SCOPE_WORKGROUP); }
            __syncthreads();
            if (wave == 0) {
                const unsigned h0 = hist[4 * lane], h1 = hist[4 * lane + 1], h2 = hist[4 * lane + 2], h3 = hist[4 * lane + 3];
                const unsigned sl = h0 + h1 + h2 + h3; unsigned S = sl;
#pragma unroll
                for (int o = 1; o < 64; o <<= 1) { const unsigned t = __shfl_down(S, o); if (lane + o < 64) S += t; }
                const unsigned long long m = __ballot(S >= krem);
                const int ls = 63 - __builtin_clzll(m);
                if (lane == ls) { unsigned cum = S - sl; int bsel;
                    if (cum + h3 >= krem) bsel = 3; else { cum += h3; if (cum + h2 >= krem) bsel = 2; else { cum += h2; if (cum + h1 >= krem) bsel = 1; else { cum += h1; bsel = 0; } } }
                    misc[0] = prefix | ((unsigned)(4 * lane + bsel) << shift); misc[1] = krem - cum; }
            }
            __syncthreads();
            prefix = misc[0]; krem = misc[1]; pmask |= (0xffu << shift);
            __syncthreads();
        }
        const unsigned T = prefix;
        unsigned cg_ = 0u, ce = 0u;
        for (int i = 0; i < 32; ++i) { const unsigned k = keys[tid * 32 + i]; cg_ += (k > T); ce += (k == T); }
        unsigned ig = cg_, ie = ce;
#pragma unroll
        for (int o = 1; o < 64; o <<= 1) { const unsigned tg = __shfl_up(ig, o), te = __shfl_up(ie, o); if (lane >= o) { ig += tg; ie += te; } }
        if (lane == 63) { wtot[wave * 2] = ig; wtot[wave * 2 + 1] = ie; }
        __syncthreads();
        unsigned gt_before = ig - cg_, eq_before = ie - ce;
        for (int w8 = 0; w8 < wave; ++w8) { gt_before += wtot[w8 * 2]; eq_before += wtot[w8 * 2 + 1]; }
        for (int i = 0; i < 32; ++i) { const int t = tid * 32 + i; const unsigned k = keys[t];
            const bool isgt = k > T, iseq = k == T; const bool take = isgt || (iseq && eq_before < krem);
            const unsigned slot = gt_before + (eq_before < krem ? eq_before : krem);
            if (take) { TOK[(size_t)be * CAP + slot] = t; GATE[(size_t)be * CAP + slot] = __uint_as_float(k); }
            SEL[((size_t)b * SEQ + t) * NE + e] = take ? (int)slot : -1;
            gt_before += isgt; eq_before += iseq; }
        __syncthreads();
    }
}

__device__ __forceinline__ void acc_yrow(f32x4 (&m)[8], const u32x2 (&w)[8], float gt) {
#pragma unroll
    for (int j = 0; j < 8; ++j) { m[j].x += gt * __uint_as_float(w[j].x << 16); m[j].y += gt * __uint_as_float(w[j].x & 0xffff0000u); m[j].z += gt * __uint_as_float(w[j].y << 16); m[j].w += gt * __uint_as_float(w[j].y & 0xffff0000u); }
}
__device__ __forceinline__ void phase_final(const Args& a) {
    const int tid = threadIdx.x, lane = tid & 63, wave = tid >> 6;
    if (PROBE_HALF && blockIdx.x >= gridDim.x / 2) return;
    const int gw = blockIdx.x * 8 + wave, NGW = (PROBE_HALF ? gridDim.x / 2 : gridDim.x) * 8;
    const float* ada = (const float*)(a.ws + WS_ADA); const float* fg = a.in[19];
    const bf16* DL = (const bf16*)(a.ws + WS_DLT); const bf16* YE = (const bf16*)(a.ws + WS_YE);
    const float* GATE = (const float*)(a.ws + WS_GATE); const int* SEL = (const int*)(a.ws + WS_SEL);
    int selA = -1, selB = -1;
    { const int r = gw; if (r < NLAT && lane < NE) selA = SEL[(size_t)r * NE + lane]; if (r + NGW < NLAT && lane < NE) selB = SEL[(size_t)(r + NGW) * NE + lane]; }
    for (int r0 = gw; r0 < NLAT; r0 += 2 * NGW) {
        const int rA = r0, rB = r0 + NGW; const bool hasB = rB < NLAT;
        const int bA = rA / SEQ, bB = hasB ? rB / SEQ : bA;
        u32x2 dlA[8], dlB[8];
#pragma unroll
        for (int j = 0; j < 8; ++j) { dlA[j] = *(const u32x2*)(DL + (size_t)rA * DM + 256 * j + 4 * lane); dlB[j] = *(const u32x2*)(DL + (size_t)(hasB ? rB : rA) * DM + 256 * j + 4 * lane); }
        const float gtA = selA >= 0 ? GATE[((size_t)bA * NE + lane) * CAP + selA] : 0.f, gtB = selB >= 0 ? GATE[((size_t)bB * NE + lane) * CAP + selB] : 0.f;
        const int rowA = selA >= 0 ? (lane * 2 + bA) * CAP + selA : 0, rowB = selB >= 0 ? (lane * 2 + bB) * CAP + selB : 0;
        unsigned long long mA = __ballot(selA >= 0), mB = __ballot(selB >= 0);
        { const int rn = r0 + 2 * NGW; selA = -1; selB = -1; if (rn < NLAT && lane < NE) selA = SEL[(size_t)rn * NE + lane]; if (rn + NGW < NLAT && lane < NE) selB = SEL[(size_t)(rn + NGW) * NE + lane]; }
        f32x4 accA[8], accB[8];
#pragma unroll
        for (int j = 0; j < 8; ++j) { accA[j] = (f32x4){0.f, 0.f, 0.f, 0.f}; accB[j] = (f32x4){0.f, 0.f, 0.f, 0.f}; }
        while (mA | mB) {
            const bool hA = mA != 0ull, hB = mB != 0ull;
            const int eA = hA ? __builtin_ctzll(mA) : 0, eB = hB ? __builtin_ctzll(mB) : 0; mA &= mA - 1; mB &= mB - 1;
            const int yrA = hA ? __builtin_amdgcn_readlane(rowA, eA) : 0, yrB = hB ? __builtin_amdgcn_readlane(rowB, eB) : 0;
            const float gA = hA ? __builtin_bit_cast(float, __builtin_amdgcn_readlane(__builtin_bit_cast(int, gtA), eA)) : 0.f;
            const float gB = hB ? __builtin_bit_cast(float, __builtin_amdgcn_readlane(__builtin_bit_cast(int, gtB), eB)) : 0.f;
            const bf16* y0 = YE + (size_t)yrA * DM + 4 * lane; const bf16* y1 = YE + (size_t)yrB * DM + 4 * lane;
            u32x2 w0[8], w1[8];
#pragma unroll
            for (int j = 0; j < 8; ++j) { w0[j] = *(const u32x2*)(y0 + 256 * j); w1[j] = *(const u32x2*)(y1 + 256 * j); }
            acc_yrow(accA, w0, gA); acc_yrow(accB, w1, gB);
        }
#pragma unroll
        for (int u = 0; u < 2; ++u) { if (u == 1 && !hasB) break;
            const int r = u ? rB : rA; const float* g2 = ada + (size_t)(u ? bB : bA) * 12288 + 5 * DM;
            float ss = 0.f; f32x4 m[8];
#pragma unroll
            for (int j = 0; j < 8; ++j) { const int d = 256 * j + 4 * lane; const f32x4 gv = *(const f32x4*)(g2 + d); const u32x2 dw = u ? dlB[j] : dlA[j];
                const f32x4 dv = {__uint_as_float(dw.x << 16), __uint_as_float(dw.x & 0xffff0000u), __uint_as_float(dw.y << 16), __uint_as_float(dw.y & 0xffff0000u)};
                m[j] = dv + gv * (u ? accB[j] : accA[j]); ss += (m[j].x * m[j].x + m[j].y * m[j].y) + (m[j].z * m[j].z + m[j].w * m[j].w); }
            const float rstd = rsqrtf(wave_sum(ss) * (1.f / DM) + EPS);
#pragma unroll
            for (int j = 0; j < 8; ++j) { const int d = 256 * j + 4 * lane; const f32x4 gv = *(const f32x4*)(fg + d);
                *(f32x4*)(a.out + (size_t)r * DM + d) = m[j] * rstd * gv; }
        }
    }
}

#define XB_TMO      128
#define XB_XCNT(j)  (256  + 64 * (j))
#define XB_XSUB(j)  (1280 + 64 * (j))
#define XB_XGEN(j)  (2304 + 64 * (j))
#define XB_TOP      3328
#define XB_TOPGEN   3392
#define XCD_BAR_WORDS 3456
#define XB_SPIN_CAP (1u << 18)
__device__ __forceinline__ unsigned xb_ld(unsigned* p)              { return __hip_atomic_load(p, __ATOMIC_RELAXED, __HIP_MEMORY_SCOPE_AGENT); }
__device__ __forceinline__ unsigned xb_add(unsigned* p, unsigned v) { return __hip_atomic_fetch_add(p, v, __ATOMIC_RELAXED, __HIP_MEMORY_SCOPE_AGENT); }
__device__ __forceinline__ unsigned xb_xcc_id() { return (unsigned)__builtin_amdgcn_s_getreg((3 << 11) | 20) & 0xFu; }
#define XB_SPIN(cond, bar) do { unsigned _sp = 0; while (cond) { __builtin_amdgcn_s_sleep(1); \
    if ((++_sp & 255u) == 0u) { if (xb_ld(&(bar)[XB_TMO])) break; if (_sp > XB_SPIN_CAP) { atomicAdd(&(bar)[XB_TMO], 1u); break; } } } } while (0)
struct XcdBarrier { unsigned* bar; unsigned x; volatile LAS unsigned* st; };
__device__ __forceinline__ XcdBarrier xcd_barrier_post(unsigned* bar, volatile LAS unsigned* st) {
    XcdBarrier b; b.bar = bar; b.x = xb_xcc_id(); b.st = st;
    if (threadIdx.x == 0) (void)xb_add(&bar[XB_XCNT(b.x)], 1u);
    return b;
}
__device__ __forceinline__ void xcd_barrier_complete(unsigned* bar, unsigned x, unsigned& nloc, unsigned& nx) {
    const unsigned G = gridDim.x * gridDim.y * gridDim.z;
    unsigned sum, cnt, mine, sp = 0u;
    for (;;) {
        sum = 0u; cnt = 0u; mine = 0u;
#pragma unroll
        for (unsigned j = 0; j < 16; ++j) { const unsigned c = xb_ld(&bar[XB_XCNT(j)]); sum += c; cnt += (c > 0u) ? 1u : 0u; mine = (j == x) ? c : mine; }
        if (sum == G) break;
        __builtin_amdgcn_s_sleep(1);
        if ((++sp & 255u) == 0u) { if (xb_ld(&bar[XB_TMO])) break; if (sp > XB_SPIN_CAP) { atomicAdd(&bar[XB_TMO], 1u); break; } }
    }
    nloc = mine > 0u ? mine : 1u; nx = cnt > 0u ? cnt : 1u;
}
__device__ __forceinline__ void xcd_barrier(const XcdBarrier& b) {
    asm volatile("s_waitcnt vmcnt(0)" ::: "memory");
    __syncthreads();
    if (threadIdx.x == 0) {
        unsigned* bar = b.bar;
        __builtin_amdgcn_s_waitcnt(0);
        unsigned nloc = b.st[0], nx = b.st[1];
        if (nloc == 0u) { xcd_barrier_complete(bar, b.x, nloc, nx); b.st[0] = nloc; b.st[1] = nx; }
        const unsigned old = xb_add(&bar[XB_XSUB(b.x)], 1u);
        const unsigned gen = old / nloc;
        if (old + 1u == (gen + 1u) * nloc) {
            __builtin_amdgcn_fence(__ATOMIC_RELEASE, "agent");
            asm volatile("s_waitcnt vmcnt(0)" ::: "memory");
            const unsigned og = xb_add(&bar[XB_TOP], 1u);
            const unsigned tg = og / nx;
            if (og + 1u == (tg + 1u) * nx) xb_add(&bar[XB_TOPGEN], 1u);
            else XB_SPIN(xb_ld(&bar[XB_TOPGEN]) == tg, bar);
            __builtin_amdgcn_fence(__ATOMIC_ACQUIRE, "agent");
            xb_add(&bar[XB_XGEN(b.x)], 1u);
            asm volatile("s_waitcnt vmcnt(0)" ::: "memory");
        } else {
            XB_SPIN(xb_ld(&bar[XB_XGEN(b.x)]) == gen, bar);
            __builtin_amdgcn_fence(__ATOMIC_ACQUIRE, "agent");
            asm volatile("s_waitcnt vmcnt(0)" ::: "memory");
        }
    }
    __syncthreads();
}

#ifndef STAGGER_US
#define STAGGER_US 0
#endif
__device__ __forceinline__ void gemm_stagger() {
    if (STAGGER_US > 0 && (blockIdx.x & 1)) { const unsigned long long t0 = __builtin_amdgcn_s_memrealtime();
        while (__builtin_amdgcn_s_memrealtime() - t0 < (unsigned long long)(STAGGER_US * 100)) __builtin_amdgcn_s_sleep(32); }
}
constexpr int NPHASES = 15;
__global__ void __launch_bounds__(NTHREADS, 2) mega(Args a) {
    extern __shared__ __attribute__((aligned(16))) unsigned char lds_raw[];
    LAS unsigned char* lds = (LAS unsigned char*)lds_raw;
    const int lo = a.ph_lo, hi = a.ph_hi;
    unsigned char* ws = a.ws;
#if USE_CG_SYNC
    cg::grid_group grid = cg::this_grid();
#define GRID_SYNC() grid.sync()
#else
    volatile LAS unsigned* bst = (volatile LAS unsigned*)(lds + LDS_BYTES - 16);
    if (threadIdx.x < 2) bst[threadIdx.x] = 0u;
    __syncthreads();
    XcdBarrier xbar = xcd_barrier_post((unsigned*)(ws + WS_CTL), bst);
#define GRID_SYNC() xcd_barrier(xbar)
#endif
#define IN(k) (lo <= (k) && (k) < hi)
#define SEAM(k) do { if (IN(k) && IN((k) + 1)) { GRID_SYNC(); if (PROBE_BAR) GRID_SYNC(); } } while (0)
#define PH(k, ...) do { if (IN(k)) { __VA_ARGS__; if ((PROBE_MASK >> (k)) & 1u) { GRID_SYNC(); __VA_ARGS__; } } SEAM(k); } while (0)
    PH(0, phase0(a, lds));
    PH(1, {
        finalize_ada(a);
        const int nsp = gridDim.x >= 64 ? 12 : 0, nreg = gridDim.x - nsp;
        if ((int)blockIdx.x >= nreg) {
            const int si = blockIdx.x - nreg, b = si / 6, pn = 2 + si % 6;
            if (threadIdx.x < 64) { unsigned* cnt = (unsigned*)(ws + WS_CTL) + CW_CTXCNT + 64 * b; unsigned sp = 0;
                while ((unsigned)__builtin_amdgcn_readfirstlane(__hip_atomic_load(cnt, __ATOMIC_RELAXED, __HIP_MEMORY_SCOPE_AGENT)) < 16u) { __builtin_amdgcn_s_sleep(4); if (++sp > (1u << 22)) break; }
                __builtin_amdgcn_fence(__ATOMIC_ACQUIRE, "agent");
                asm volatile("s_waitcnt vmcnt(0)" ::: "memory"); }
            __syncthreads();
            SchedOne S; S.A = (const char*)(ws + WS_H); S.B = (const char*)(ws + WS_WIN); S.tstep = (size_t)256 * DM * 2; S.pm = NLAT / 256 + b; S.pn = pn;
            EpiInProj E{ws};
            pg8::gemm_phase<EpiInProj, SchedOne, false, true, true>(lds, DM, S, E);
        } else phase_norm_tile<0>(a, lds, blockIdx.x, nreg, NROWS / 16); });
    PH(2, {
        gemm_stagger();
        SchedPlain S; S.init((gridDim.x >= 64 ? NLAT : NROWS) / 256, WIN_ROWS / 256, gridDim.x, blockIdx.x); S.A = (const char*)(ws + WS_H); S.B = (const char*)(ws + WS_WIN); S.tstep = (size_t)256 * DM * 2;
        EpiInProj E{ws};
        pg8::gemm_phase<EpiInProj, SchedPlain, false, true, true>(lds, DM, S, E); });
    PH(3, { for (int it = blockIdx.x; it < 288; it += gridDim.x) gla_passA128(a, lds, it); });
    PH(4, gla_passB(a));
    PH(5, { for (int it = blockIdx.x; it < 256; it += gridDim.x) gla_passC(a, lds, it); });
    PH(6, { phase_f1(a, lds); phase_gla_merge(a); });
    PH(8, phase_f34(a, lds));
    PH(9, {
        gemm_stagger();
        SchedPlain S; S.init(NLAT / 256, DM / 256, gridDim.x, blockIdx.x); S.A = (const char*)(ws + WS_YCAT); S.B = (const char*)(ws + WS_WOUT); S.tstep = (size_t)256 * DM * 2;
        EpiOutProj E{a.in[0], (bf16*)(ws + WS_DLT), (const float*)(ws + WS_ADA)};
        pg8::gemm_phase<EpiOutProj, SchedPlain, false, true, true>(lds, DM, S, E); });
    PH(10, phase_norm_tile<1>(a, lds, blockIdx.x, gridDim.x, NLAT / 16));
    PH(11, phase_topk(a, lds));
    PH(12, {
        gemm_stagger();
        SchedMoeUp S; S.init(256, 8, gridDim.x, blockIdx.x); S.A = (const char*)(ws + WS_HF); S.B = (const char*)(ws + WS_WGU); S.tok = (const int*)(ws + WS_TOK);
        EpiSwiglu E{(bf16*)(ws + WS_HID)};
        pg8::gemm_phase<EpiSwiglu, SchedMoeUp, true, true, true>(lds, DM, S, E); });
    PH(13, {
        gemm_stagger();
        SchedMoeDown S; S.init(256, 8, gridDim.x, blockIdx.x); S.A = (const char*)(ws + WS_HID); S.B = (const char*)(ws + WS_WD);
        EpiBf16 E{(bf16*)(ws + WS_YE), DM};
        pg8::gemm_phase<EpiBf16, SchedMoeDown, false, true, true>(lds, DEXP, S, E); });
    PH(14, phase_final(a));
#undef PH
#undef IN
#undef SEAM
}

#ifndef N_LAUNCH_MODE
#define N_LAUNCH_MODE 1
#endif
extern "C" void kernel_launch(void* const* d_in, const int* in_sizes, int n_in, void* d_out, int out_size, void* d_ws, size_t ws_size, hipStream_t stream) {
    static int grid = 0;
    if (grid == 0) {
        if (n_in != 20 || out_size != NLAT * DM || ws_size < WS_END) { fprintf(stderr, "kernel_launch: unexpected sizes n_in %d out %d ws %zu\n", n_in, out_size, ws_size); grid = -1; return; }
        int dev = 0, cus = 0, per_cu = 0;
        (void)hipGetDevice(&dev); (void)hipDeviceGetAttribute(&cus, hipDeviceAttributeMultiprocessorCount, dev);
        if (hipFuncSetAttribute((const void*)mega, hipFuncAttributeMaxDynamicSharedMemorySize, LDS_BYTES) != hipSuccess) { fprintf(stderr, "kernel_launch: hipFuncSetAttribute failed\n"); grid = -1; return; }
        (void)hipOccupancyMaxActiveBlocksPerMultiprocessor(&per_cu, (const void*)mega, NTHREADS, LDS_BYTES);
        if (per_cu < 1) { fprintf(stderr, "kernel_launch: occupancy query reports %d blocks per CU\n", per_cu); per_cu = 1; }
        (void)hipGetLastError();
        grid = cus * 1;
    }
    if (grid < 0) return;
    Args a{};
    for (int i = 0; i < 20; ++i) a.in[i] = (const float*)d_in[i];
    a.out = (float*)d_out; a.ws = (unsigned char*)d_ws;
#if N_LAUNCH_MODE == 0
    for (int p = 0; p < NPHASES; ++p) { a.ph_lo = p; a.ph_hi = p + 1; hipLaunchKernelGGL(mega, dim3(grid), dim3(NTHREADS), LDS_BYTES, stream, a); }
#else
    a.ph_lo = 0; a.ph_hi = NPHASES;
#if USE_CG_SYNC
    void* args[] = {&a};
    hipError_t e = hipLaunchCooperativeKernel((void*)mega, dim3(grid), dim3(NTHREADS), args, LDS_BYTES, stream);
    if (e != hipSuccess) fprintf(stderr, "cooperative launch failed: %s (grid %d)\n", hipGetErrorString(e), grid);
#else
    if (hipMemsetAsync((char*)d_ws + WS_CTL, 0, CTL_BYTES, stream) != hipSuccess) { fprintf(stderr, "kernel_launch: memset of control words failed\n"); return; }
    hipLaunchKernelGGL(mega, dim3(grid), dim3(NTHREADS), LDS_BYTES, stream, a);
#endif
#endif
}
```

```cpp
#include <hip/hip_runtime.h>
#include <hip/hip_cooperative_groups.h>
#include <cstdio>
#include <cstdint>
namespace cg = cooperative_groups;

#define LAS __attribute__((address_space(3)))
typedef unsigned short bf16;
typedef short bf16x8 __attribute__((ext_vector_type(8)));
typedef float f32x4 __attribute__((ext_vector_type(4)));
typedef float f32x2 __attribute__((ext_vector_type(2)));
typedef unsigned u32x4 __attribute__((ext_vector_type(4)));
typedef unsigned u32x2 __attribute__((ext_vector_type(2)));
typedef int i32x4 __attribute__((ext_vector_type(4)));
typedef int i32x8 __attribute__((ext_vector_type(8)));

constexpr int NB = 2, SEQ = 16384, DM = 2048, CTXL = 256;
constexpr int NLAT = NB * SEQ;
constexpr int NROWS = NLAT + NB * CTXL;
constexpr int PROJW = 4128;
constexpr int NE = 16, CAP = 2048, DEXP = 1024;
constexpr int PW = 4096;
constexpr int WIN_ROWS = 4096;
constexpr float EPS = 1e-6f;

constexpr size_t MiB = 1u << 20;
constexpr size_t WS_ADA = 0;
constexpr size_t WS_TW = 1 * MiB;
constexpr size_t WS_FC = 1 * MiB + 256 * 1024;
constexpr size_t WS_FS = 1 * MiB + 320 * 1024;
constexpr size_t WS_WRH = 1 * MiB + 384 * 1024;
constexpr size_t WS_WRL = 1 * MiB + 448 * 1024;
constexpr size_t WS_Z = 2 * MiB;
constexpr size_t WS_AFF = 8 * MiB;
constexpr size_t WS_TOK = 10 * MiB;
constexpr size_t WS_GATE = 11 * MiB;
constexpr size_t WS_SEL = 12 * MiB;
constexpr size_t WS_ST0 = 14 * MiB;
constexpr size_t WS_CTL = 16 * MiB;
constexpr size_t CTL_BYTES = 65536;
constexpr size_t WS_ADAP = 20 * MiB;
constexpr size_t WS_TC = 24 * MiB;
constexpr size_t WS_DTC = 28 * MiB;
constexpr size_t WS_WIN = 32 * MiB;
constexpr size_t WS_WOUT = 50 * MiB;
constexpr size_t WS_WGU = 58 * MiB;
constexpr size_t WS_WD = 186 * MiB;
constexpr int KTOK = SEQ + CTXL;
constexpr size_t WS_QH = 250 * MiB;
constexpr size_t WS_KH = 282 * MiB;
constexpr size_t WS_VH = 316 * MiB;
constexpr size_t WS_G = 382 * MiB;
constexpr size_t WS_U = 446 * MiB;
constexpr size_t WS_HF = 250 * MiB;
constexpr size_t WS_HID = 378 * MiB;
constexpr size_t WS_FX = 250 * MiB;
constexpr size_t WS_FA = 894 * MiB;
constexpr size_t WS_FAI = 958 * MiB;
constexpr size_t WS_H = 510 * MiB;
constexpr size_t WS_H8 = 640 * MiB;
constexpr size_t WS_WIN8 = 704 * MiB;
constexpr size_t WS_RS = 712 * MiB;
constexpr size_t WS_CS = 713 * MiB;
#ifndef INPROJ_BF16_TILES
#define INPROJ_BF16_TILES 0
#endif
constexpr size_t WS_OF = 510 * MiB;
constexpr size_t WS_OB = 574 * MiB;
constexpr size_t WS_T = 638 * MiB;
constexpr size_t WS_SST = 670 * MiB;
constexpr size_t WS_DT = 702 * MiB;
constexpr size_t WS_DLT = 510 * MiB;
constexpr size_t WS_YCAT = 766 * MiB;
constexpr size_t WS_YE = 766 * MiB;
constexpr size_t WS_END = 1022 * MiB;

#ifndef USE_CG_SYNC
#define USE_CG_SYNC 0
#endif
#ifndef PROBE_HALF
#define PROBE_HALF 0
#endif
#ifndef KSNAKE
#define KSNAKE 0
#endif
#ifndef PROBE_BAR
#define PROBE_BAR 0
#endif
#ifndef PROBE_HOT
#define PROBE_HOT 0
#endif
#ifndef PROBE_K
#define PROBE_K 0
#endif
#ifndef PROBE_EPI
#define PROBE_EPI 0
#endif
#ifndef PROBE_P0
#define PROBE_P0 0
#endif
#ifndef PROBE_MASK
#define PROBE_MASK 0u
#endif
constexpr int LDS_BYTES = 163840;
constexpr int NTHREADS = 512;

struct Args {
    const float* in[20];
    float* out;
    unsigned char* ws;
    int ph_lo, ph_hi;
};

__device__ __forceinline__ float bf2f(bf16 v) { return __uint_as_float(((unsigned)v) << 16); }
typedef __bf16 bf16x2_t __attribute__((ext_vector_type(2)));
__device__ __forceinline__ unsigned pk2(float lo, float hi) { const f32x2 v = {lo, hi}; return __builtin_bit_cast(unsigned, __builtin_convertvector(v, bf16x2_t)); }
__device__ __forceinline__ unsigned f2bf(float f) { return pk2(f, 0.f) & 0xffffu; }
__device__ __forceinline__ unsigned pk4_fp8(float a, float b, float c, float d) { unsigned r = 0u; r = (unsigned)__builtin_amdgcn_cvt_pk_fp8_f32(a, b, (int)r, false); r = (unsigned)__builtin_amdgcn_cvt_pk_fp8_f32(c, d, (int)r, true); return r; }
__device__ __forceinline__ unsigned pk4_i8(float a, float b, float c, float d) {
    const int ia = (int)rintf(a), ib = (int)rintf(b), ic = (int)rintf(c), id = (int)rintf(d);
    return ((unsigned)ia & 0xffu) | (((unsigned)ib & 0xffu) << 8) | (((unsigned)ic & 0xffu) << 16) | ((unsigned)id << 24);
}
constexpr float W8_SCALE = 64.f;
__device__ __forceinline__ int opaque_tid() { int t = threadIdx.x; asm volatile("" : "+v"(t)); return t; }
__device__ __forceinline__ float wave_sum(float v) {
#pragma unroll
    for (int o = 1; o < 64; o <<= 1) v += __shfl_xor(v, o);
    return v;
}
__device__ __forceinline__ float silu_f(float x) { return x / (1.f + __expf(-x)); }
__device__ __forceinline__ float logsigmoid_f(float x) { return fminf(x, 0.f) - log1pf(expf(-fabsf(x))); }

namespace pg8 {
constexpr int BM = 256, BK = 64, HALF = 128, HTB = HALF * BK * 2, STAGE_BYTES = 8 * HTB, NXCD = 8, WGM = 8;
__host__ __device__ __forceinline__ int lds_byte(int r, int c) { const int st = (r >> 4) * 2 + (c >> 5), rr = r & 15, cc = c & 31, ob = rr * 64 + cc * 2; return st * 1024 + (ob ^ (((ob >> 9) & 1) << 5)); }
__host__ __device__ __forceinline__ void stage_rc(int b, int& R, int& C) { const int st = b / 1024, sb = b % 1024, swz = sb ^ (((sb >> 9) & 1) << 5); R = (st >> 1) * 16 + swz / 64; C = (st & 1) * 32 + (swz % 64) / 2; }
__host__ __device__ __forceinline__ int perm32(int rho) { const int n = rho >> 4, i = rho & 15; return 8 * (i >> 2) + 4 * n + (i & 3); }
struct Unit { int pm, pn; };
__device__ __forceinline__ unsigned cvt_pk_bf16(float lo, float hi) { return pk2(lo, hi); }

struct OrderBase {
    int nM, nN, nwg, G, c, pn0;
    __device__ void init(int nM_, int nN_, int G_, int c_, int pn0_ = 0) { nM = nM_; nN = nN_; nwg = nM * nN; G = G_; c = c_; pn0 = pn0_; }
    __device__ bool next(int i, Unit& u) const {
        const long L = (long)(i >> PROBE_K) * G + c; if (L >= nwg) return false;
        int wgid = (int)L; { const int q = nwg / NXCD, r = nwg % NXCD, xcd = wgid % NXCD, off = wgid / NXCD; wgid = (xcd < r ? xcd * (q + 1) : r * (q + 1) + (xcd - r) * q) + off; }
        const int nig = WGM * nN, gid = wgid / nig, fm = gid * WGM, gsz = (nM - fm) < WGM ? (nM - fm) : WGM;
        u.pm = fm + ((wgid % nig) % gsz); u.pn = pn0 + (wgid % nig) / gsz; if (PROBE_K && PROBE_HOT && !(i & 1)) { u.pm = 0; u.pn = pn0; } return true;
    }
};

template <class Epi, class Sched, bool GATHER, bool ALIGN_EPI, bool SP2, int PREC = 0>
__device__ __forceinline__ void gemm_phase(LAS unsigned char* lds, const int K, const Sched& S, const Epi& E) {
    const int tid = opaque_tid(), wid = __builtin_amdgcn_readfirstlane(tid >> 6), lane = tid & 63, wr = wid >> 2, wc = wid & 3, fr = lane & 15, fq = lane >> 4;
    int nt = K / BK;
    constexpr bool FP8 = PREC == 1;
    if constexpr (PREC != 0) asm volatile("" : "+s"(nt));
    unsigned voffA[2], voffA1[2], voffB[2];
    int RA[2], CA[2];
#pragma unroll
    for (int i = 0; i < 2; ++i) { int R, C; stage_rc(tid * 16 + i * 8192, R, C); const int Rb = Epi::PERM2 ? (64 * (R >> 5) + perm32(R & 31)) : (Epi::PERM ? ((R & ~31) + perm32(R & 31)) : R);
        RA[i] = R; CA[i] = C;
        voffA[i] = (unsigned)(R * K + C) * 2u; voffA1[i] = voffA[i]; voffB[i] = (unsigned)(Rb * K + C) * 2u; }
    const size_t kstep = (size_t)(BK * 2);
    const size_t hstepA = GATHER ? 0 : (size_t)HALF * K * 2;
    const size_t hstep = (size_t)(Epi::PERM2 ? 32 : HALF) * K * 2;
    const unsigned ldsw = (unsigned)wid * 1024u;
    const int aoff = lds_byte(wr * 64 + fr, fq * 8), boff = lds_byte(wc * 32 + fr, fq * 8);
#define PG8_SA(b, h) (((b) * 2 + (h)) * HTB)
#define PG8_SB(b, h) ((4 + (b) * 2 + (h)) * HTB)
#define PG8_STAGE(bufoff, gbase, voff) do { _Pragma("unroll") for (int _i = 0; _i < 2; ++_i) \
        __builtin_amdgcn_global_load_lds((const unsigned*)((const char*)(gbase) + (voff)[_i]), (LAS unsigned*)(lds + (bufoff) + ldsw + _i * 8192), 16, 0, 0); } while (0)
#define PG8_LDA(dst, b, h) do { _Pragma("unroll") for (int m = 0; m < 4; ++m) _Pragma("unroll") for (int k = 0; k < 2; ++k) dst[m][k] = *(const LAS bf16x8*)(lds + PG8_SA(b, h) + aoff + m * 2048 + k * 1024); } while (0)
#define PG8_LDB(dst, b, h) do { _Pragma("unroll") for (int n = 0; n < 2; ++n) _Pragma("unroll") for (int k = 0; k < 2; ++k) dst[n][k] = *(const LAS bf16x8*)(lds + PG8_SB(b, h) + boff + n * 2048 + k * 1024); } while (0)
#define PG8_CAT8(lo, hi) __builtin_shufflevector(__builtin_bit_cast(i32x4, (lo)), __builtin_bit_cast(i32x4, (hi)), 0, 1, 2, 3, 4, 5, 6, 7)
#define PG8_MMA(ai, bj, At, Bt) do { __builtin_amdgcn_s_setprio(1); \
        if constexpr (FP8) { _Pragma("unroll") for (int m = 0; m < 4; ++m) _Pragma("unroll") for (int n = 0; n < 2; ++n) \
            acc[ai][bj][m][n] = __builtin_amdgcn_mfma_scale_f32_16x16x128_f8f6f4(PG8_CAT8(Bt[n][0], Bt[n][1]), PG8_CAT8(At[m][0], At[m][1]), acc[ai][bj][m][n], 0, 0, 0, 0x7f7f7f7f, 0, 0x7f7f7f7f); } \
        else if constexpr (PREC == 2) { _Pragma("unroll") for (int m = 0; m < 4; ++m) _Pragma("unroll") for (int n = 0; n < 2; ++n) _Pragma("unroll") for (int k = 0; k < 2; ++k) \
            acc[ai][bj][m][n] = __builtin_bit_cast(f32x4, __builtin_amdgcn_mfma_i32_16x16x64_i8(__builtin_bit_cast(i32x4, Bt[n][k]), __builtin_bit_cast(i32x4, At[m][k]), __builtin_bit_cast(i32x4, acc[ai][bj][m][n]), 0, 0, 0)); } \
        else { _Pragma("unroll") for (int m = 0; m < 4; ++m) _Pragma("unroll") for (int n = 0; n < 2; ++n) _Pragma("unroll") for (int k = 0; k < 2; ++k) \
            acc[ai][bj][m][n] = __builtin_amdgcn_mfma_f32_16x16x32_bf16(Bt[n][k], At[m][k], acc[ai][bj][m][n], 0, 0, 0); } \
        __builtin_amdgcn_s_setprio(0); } while (0)
#define PG8_WAIT_V(n) asm volatile("s_waitcnt vmcnt(" #n ")" ::: "memory")
#define PG8_WAIT_L(n) asm volatile("s_waitcnt lgkmcnt(" #n ")" ::: "memory")
#define PG8_BAR __builtin_amdgcn_s_barrier()
#define PG8_SCHED __builtin_amdgcn_sched_barrier(0)
    Unit cur, nxt; int ui = 0;
    if (!S.next(0, cur)) return;
    f32x4 acc[2][2][4][2];
#pragma unroll
    for (int a = 0; a < 2; ++a)
#pragma unroll
        for (int b = 0; b < 2; ++b)
#pragma unroll
            for (int m = 0; m < 4; ++m)
#pragma unroll
                for (int n = 0; n < 2; ++n) acc[a][b][m][n] = (f32x4){0.f, 0.f, 0.f, 0.f};
    bf16x8 At[4][2], B0[2][2], B1[2][2];
    const long kspan = (long)(nt - 1) * (long)(BK * 2);
    long ck = (long)(BK * 2);
    const char* cA = S.abase(cur); const char* cB = S.bbase(cur);
    if constexpr (GATHER) {
#pragma unroll
        for (int i = 0; i < 2; ++i) { voffA[i] = ((unsigned)S.arow(cur, RA[i]) * (unsigned)K + (unsigned)CA[i]) * 2u; voffA1[i] = ((unsigned)S.arow(cur, HALF + RA[i]) * (unsigned)K + (unsigned)CA[i]) * 2u; }
    }
    static_assert(SP2, "only the SP2 loop is kept");
    PG8_STAGE(PG8_SB(0, 0), cB, voffB); PG8_STAGE(PG8_SB(0, 1), cB + hstep, voffB); PG8_STAGE(PG8_SA(0, 0), cA, voffA); PG8_STAGE(PG8_SA(0, 1), cA + hstepA, voffA1);
    if (wr == 1) PG8_BAR;
    PG8_WAIT_V(2); PG8_BAR;
    PG8_STAGE(PG8_SB(1, 0), cB + kstep, voffB); PG8_STAGE(PG8_SA(1, 0), cA + kstep, voffA); PG8_STAGE(PG8_SB(1, 1), cB + hstep + kstep, voffB);
    PG8_WAIT_V(6); PG8_BAR;
    for (;;) {
        const bool has_next = S.next(ui + 1, nxt);
        const bool nrev = KSNAKE && has_next && (((ui + 1) >> PROBE_K) & 1);
        const long nk = has_next ? (nrev ? -(long)(BK * 2) : (long)(BK * 2)) : ck;
        const char* nA = has_next ? S.abase(nxt) + (nrev ? kspan : 0) : cA; const char* nB = has_next ? S.bbase(nxt) + (nrev ? kspan : 0) : cB;
        for (int t = 0; t < nt; t += 2) {
            const bool last = (t == nt - 2);
            const char* a1 = cA + (long)(t + 1) * ck;
            const char* a2 = last ? nA : cA + (long)(t + 2) * ck; const char* b2 = last ? nB : cB + (long)(t + 2) * ck;
            const char* a3 = a2 + (last ? nk : ck); const char* b3 = b2 + (last ? nk : ck);
            PG8_LDB(B0, 0, 0); PG8_LDB(B1, 0, 1); PG8_SCHED; PG8_LDA(At, 0, 0); PG8_STAGE(PG8_SA(1, 1), a1 + hstepA, voffA1);
            if constexpr (GATHER) { if (last && has_next) {
#pragma unroll
                for (int i = 0; i < 2; ++i) { voffA[i] = ((unsigned)S.arow(nxt, RA[i]) * (unsigned)K + (unsigned)CA[i]) * 2u; voffA1[i] = ((unsigned)S.arow(nxt, HALF + RA[i]) * (unsigned)K + (unsigned)CA[i]) * 2u; } } }
            PG8_WAIT_V(8); PG8_WAIT_L(0); PG8_BAR; PG8_MMA(0, 0, At, B0); PG8_MMA(0, 1, At, B1); PG8_BAR; PG8_SCHED;
            PG8_LDA(At, 0, 1); PG8_STAGE(PG8_SB(0, 0), b2, voffB); PG8_STAGE(PG8_SB(0, 1), b2 + hstep, voffB); PG8_STAGE(PG8_SA(0, 0), a2, voffA);
            PG8_WAIT_V(8); PG8_WAIT_L(0); PG8_BAR; PG8_MMA(1, 0, At, B0); PG8_MMA(1, 1, At, B1); PG8_BAR; PG8_SCHED;
            PG8_LDB(B0, 1, 0); PG8_LDB(B1, 1, 1); PG8_SCHED; PG8_LDA(At, 1, 0); PG8_STAGE(PG8_SA(0, 1), a2 + hstepA, voffA1);
            PG8_WAIT_V(8); PG8_WAIT_L(0); PG8_BAR; PG8_MMA(0, 0, At, B0); PG8_MMA(0, 1, At, B1); PG8_BAR; PG8_SCHED;
            PG8_LDA(At, 1, 1); PG8_STAGE(PG8_SB(1, 0), b3, voffB); PG8_STAGE(PG8_SB(1, 1), b3 + hstep, voffB); PG8_STAGE(PG8_SA(1, 0), a3, voffA);
            PG8_WAIT_V(8); PG8_WAIT_L(0); PG8_BAR; PG8_MMA(1, 0, At, B0); PG8_MMA(1, 1, At, B1); PG8_BAR; PG8_SCHED;
        }
        if constexpr (ALIGN_EPI) { if (wr == 0) PG8_BAR; }
        if (!PROBE_K || (ui & 1)) E(acc, cur, wr, wc, fr, fq);
        if (PROBE_EPI == 1) { asm volatile("" ::: "memory"); E(acc, cur, wr, wc, fr, fq); }
        if (PROBE_EPI == 2) { asm volatile("s_waitcnt vmcnt(0)" ::: "memory"); }
        if (!has_next) break;
#pragma unroll
        for (int a = 0; a < 2; ++a)
#pragma unroll
            for (int b = 0; b < 2; ++b)
#pragma unroll
                for (int m = 0; m < 4; ++m)
#pragma unroll
                    for (int n = 0; n < 2; ++n) acc[a][b][m][n] = (f32x4){0.f, 0.f, 0.f, 0.f};
        cur = nxt; cA = nA; cB = nB; ck = nk; ++ui;
        if constexpr (ALIGN_EPI) { if (wr == 1) PG8_BAR; }
    }
    PG8_WAIT_V(0);
    if constexpr (!ALIGN_EPI) { if (wr == 0) PG8_BAR; }
    PG8_BAR;
#undef PG8_SA
#undef PG8_SB
#undef PG8_STAGE
#undef PG8_LDA
#undef PG8_LDB
#undef PG8_MMA
#undef PG8_CAT8
#undef PG8_WAIT_V
#undef PG8_WAIT_L
#undef PG8_BAR
#undef PG8_SCHED
}
}
using pg8::Unit;
using pg8::cvt_pk_bf16;
constexpr int HALF = pg8::HALF, BM = pg8::BM;

struct SchedPlain : pg8::OrderBase {
    const char* A; const char* B; size_t tstep;
    __device__ __forceinline__ const char* abase(const Unit& u) const { return A + (size_t)u.pm * tstep; }
    __device__ __forceinline__ const char* bbase(const Unit& u) const { return B + (size_t)u.pn * tstep; }
    __device__ __forceinline__ int arow(const Unit&, int) const { return 0; }
};
struct SchedOne {
    const char* A; const char* B; size_t tstep; int pm, pn;
    __device__ __forceinline__ bool next(int i, Unit& u) const { if ((i >> PROBE_K) != 0) return false; u.pm = pm; u.pn = pn; return true; }
    __device__ __forceinline__ const char* abase(const Unit& u) const { return A + (size_t)u.pm * tstep; }
    __device__ __forceinline__ const char* bbase(const Unit& u) const { return B + (size_t)u.pn * tstep; }
    __device__ __forceinline__ int arow(const Unit&, int) const { return 0; }
};
struct SchedMoeUp : pg8::OrderBase {
    const char* A; const char* B; const int* tok;
    __device__ __forceinline__ const char* abase(const Unit&) const { return A; }
    __device__ __forceinline__ const char* bbase(const Unit& u) const { return B + ((size_t)(u.pm >> 4) * 2048 + (size_t)u.pn * 256) * (size_t)DM; }
    __device__ __forceinline__ int arow(const Unit& u, int r) const { const int e = u.pm >> 4, b = (u.pm >> 3) & 1, mt = u.pm & 7; return b * SEQ + tok[(b * NE + e) * CAP + mt * 256 + r]; }
};
struct SchedMoeDown : pg8::OrderBase {
    const char* A; const char* B;
    __device__ __forceinline__ const char* abase(const Unit&) const { return A; }
    __device__ __forceinline__ const char* bbase(const Unit& u) const { return B + ((size_t)(u.pm >> 4) * 2048 + (size_t)u.pn * 256) * (size_t)DEXP; }
    __device__ __forceinline__ int arow(const Unit& u, int r) const { return u.pm * 256 + r; }
};

__device__ __forceinline__ u32x4 swz_xor8(const u32x4 v) { u32x4 r;
    r.x = (unsigned)__builtin_amdgcn_ds_swizzle((int)v.x, 0x201F); r.y = (unsigned)__builtin_amdgcn_ds_swizzle((int)v.y, 0x201F);
    r.z = (unsigned)__builtin_amdgcn_ds_swizzle((int)v.z, 0x201F); r.w = (unsigned)__builtin_amdgcn_ds_swizzle((int)v.w, 0x201F); return r; }
__device__ __forceinline__ void store_pair_rows(bf16* rowp, size_t ld, int fr, const u32x4 w0, const u32x4 w1) {
    const bool hi = (fr & 8) != 0;
    const u32x4 r = swz_xor8(hi ? w0 : w1);
    bf16* p = rowp + (hi ? 32 : 0);
    *(u32x4*)(p) = hi ? r : w0;
    *(u32x4*)(p + 8 * ld) = hi ? w1 : r;
}
struct EpiInProj {
    static constexpr bool PERM = true, PERM2 = true;
    unsigned char* ws;
    __device__ __forceinline__ void operator()(const f32x4 (&acc)[2][2][4][2], const Unit& u, int wr, int wc, int fr, int fq) const {
        const int ct = wc * 64 + 8 * fq;
        const bool lat = u.pm < NLAT / 256; const int b = lat ? u.pm / (SEQ / 256) : u.pm - NLAT / 256, t0 = lat ? (u.pm % (SEQ / 256)) * 256 : SEQ;
        if (!lat && (u.pn < 2 || u.pn >= 8)) return;
        bf16* base; size_t ld;
        if (u.pn < 2) { const int h = 2 * u.pn + (ct >> 7); base = (bf16*)(ws + WS_QH) + ((size_t)(b * 4 + h) * SEQ + t0) * 128 + (ct & 127); ld = 128; }
        else if (u.pn < 4) { const int h = 2 * (u.pn - 2) + (ct >> 7); base = (bf16*)(ws + WS_KH) + ((size_t)(b * 4 + h) * KTOK + t0) * 128 + (ct & 127); ld = 128; }
        else if (u.pn < 8) { const int h = u.pn - 4; base = (bf16*)(ws + WS_VH) + ((size_t)(b * 4 + h) * KTOK + t0) * 256 + ct; ld = 256; }
        else if (u.pn < 12) { base = (bf16*)(ws + WS_G) + (size_t)(u.pm * BM) * 1024 + (u.pn - 8) * 256 + ct; ld = 1024; }
        else { base = (bf16*)(ws + WS_U) + (size_t)(u.pm * BM) * 1024 + (u.pn - 12) * 256 + ct; ld = 1024; }
#pragma unroll
        for (int ai = 0; ai < 2; ++ai)
#pragma unroll
            for (int m = 0; m < 4; ++m) { bf16* rowp = base + (size_t)(wr * 64 + ai * HALF + m * 16 + (fr & 7)) * ld;
                u32x4 w[2];
#pragma unroll
                for (int bj = 0; bj < 2; ++bj) { const f32x4 v0 = acc[ai][bj][m][0], v1 = acc[ai][bj][m][1];
                    w[bj].x = cvt_pk_bf16(v0[0], v0[1]); w[bj].y = cvt_pk_bf16(v0[2], v0[3]); w[bj].z = cvt_pk_bf16(v1[0], v1[1]); w[bj].w = cvt_pk_bf16(v1[2], v1[3]); }
                store_pair_rows(rowp, ld, fr, w[0], w[1]); }
    }
};
struct EpiInProj8 {
    static constexpr bool PERM = true, PERM2 = true;
    unsigned char* ws;
    __device__ __forceinline__ void operator()(const f32x4 (&acc)[2][2][4][2], const Unit& u, int wr, int wc, int fr, int fq) const {
        const int ct = wc * 64 + 8 * fq;
        const int b = u.pm / (SEQ / 256), t0 = (u.pm % (SEQ / 256)) * 256;
        bf16* base; size_t ld;
        if (u.pn < 2) { const int h = 2 * u.pn + (ct >> 7); base = (bf16*)(ws + WS_QH) + ((size_t)(b * 4 + h) * SEQ + t0) * 128 + (ct & 127); ld = 128; }
        else if (u.pn < 4) { const int h = 2 * (u.pn - 2) + (ct >> 7); base = (bf16*)(ws + WS_KH) + ((size_t)(b * 4 + h) * KTOK + t0) * 128 + (ct & 127); ld = 128; }
        else if (u.pn < 8) { const int h = u.pn - 4; base = (bf16*)(ws + WS_VH) + ((size_t)(b * 4 + h) * KTOK + t0) * 256 + ct; ld = 256; }
        else if (u.pn < 12) { base = (bf16*)(ws + WS_G) + (size_t)(u.pm * BM) * 1024 + (u.pn - 8) * 256 + ct; ld = 1024; }
        else { base = (bf16*)(ws + WS_U) + (size_t)(u.pm * BM) * 1024 + (u.pn - 12) * 256 + ct; ld = 1024; }
        const float* cs = (const float*)(ws + WS_CS) + u.pn * BM + ct; const float* rs = (const float*)(ws + WS_RS) + u.pm * BM + wr * 64 + fr;
        f32x4 cv[2][2];
#pragma unroll
        for (int bj = 0; bj < 2; ++bj)
#pragma unroll
            for (int n = 0; n < 2; ++n) cv[bj][n] = *(const f32x4*)(cs + 32 * bj + 4 * n);
#pragma unroll
        for (int ai = 0; ai < 2; ++ai)
#pragma unroll
            for (int m = 0; m < 4; ++m) { bf16* rowp = base + (size_t)(wr * 64 + ai * HALF + m * 16 + (fr & 7)) * ld; const float sr = rs[ai * HALF + m * 16];
                u32x4 w[2];
#pragma unroll
                for (int bj = 0; bj < 2; ++bj) { const i32x4 i0 = __builtin_bit_cast(i32x4, acc[ai][bj][m][0]), i1 = __builtin_bit_cast(i32x4, acc[ai][bj][m][1]);
                    const f32x4 v0 = __builtin_convertvector(i0, f32x4) * cv[bj][0] * sr, v1 = __builtin_convertvector(i1, f32x4) * cv[bj][1] * sr;
                    w[bj].x = cvt_pk_bf16(v0[0], v0[1]); w[bj].y = cvt_pk_bf16(v0[2], v0[3]); w[bj].z = cvt_pk_bf16(v1[0], v1[1]); w[bj].w = cvt_pk_bf16(v1[2], v1[3]); }
                store_pair_rows(rowp, ld, fr, w[0], w[1]); }
    }
};
struct EpiOutProj {
    static constexpr bool PERM = true, PERM2 = true;
    const float* X; bf16* D; const float* ada;
    __device__ __forceinline__ void operator()(const f32x4 (&acc)[2][2][4][2], const Unit& u, int wr, int wc, int fr, int fq) const {
        const int row0 = u.pm * BM + wr * 64, col0 = u.pn * BM + wc * 64 + 8 * fq;
        const int b = (u.pm * BM) / SEQ;
        const float* g1 = ada + (size_t)b * 12288 + 2 * DM;
        f32x4 gv[2][2];
#pragma unroll
        for (int bj = 0; bj < 2; ++bj)
#pragma unroll
            for (int n = 0; n < 2; ++n) gv[bj][n] = *(const f32x4*)(g1 + col0 + 32 * bj + 4 * n);
#pragma unroll
        for (int ai = 0; ai < 2; ++ai)
#pragma unroll
            for (int m = 0; m < 4; ++m) { const size_t rbase = (size_t)(row0 + ai * HALF + m * 16);
                u32x4 w[2];
#pragma unroll
                for (int bj = 0; bj < 2; ++bj) { const size_t off = (rbase + fr) * DM + col0 + 32 * bj; const f32x4 x0 = *(const f32x4*)(X + off), x1 = *(const f32x4*)(X + off + 4);
                    const f32x4 v0 = x0 + acc[ai][bj][m][0] * gv[bj][0], v1 = x1 + acc[ai][bj][m][1] * gv[bj][1];
                    w[bj].x = cvt_pk_bf16(v0[0], v0[1]); w[bj].y = cvt_pk_bf16(v0[2], v0[3]); w[bj].z = cvt_pk_bf16(v1[0], v1[1]); w[bj].w = cvt_pk_bf16(v1[2], v1[3]); }
                store_pair_rows(D + (rbase + (fr & 7)) * DM + col0, DM, fr, w[0], w[1]);
                asm volatile("" ::: "memory"); }
    }
};
struct EpiSwiglu {
    static constexpr bool PERM = true, PERM2 = false;
    unsigned char* HID;
    __device__ __forceinline__ void operator()(const f32x4 (&acc)[2][2][4][2], const Unit& u, int wr, int wc, int fr, int fq) const {
        const int row0 = u.pm * BM + wr * 64 + fr, col0 = u.pn * 128 + wc * 32 + 8 * fq; const float is = 1.f / W8_SCALE;
#pragma unroll
        for (int ai = 0; ai < 2; ++ai)
#pragma unroll
            for (int m = 0; m < 4; ++m) { unsigned char* rowp = HID + (size_t)(row0 + ai * HALF + m * 16) * DEXP + col0;
                f32x4 h0, h1;
#pragma unroll
                for (int j = 0; j < 4; ++j) { h0[j] = silu_f(acc[ai][0][m][0][j] * is) * (acc[ai][1][m][0][j] * is); h1[j] = silu_f(acc[ai][0][m][1][j] * is) * (acc[ai][1][m][1][j] * is); }
                u32x2 w; w.x = pk4_fp8(h0[0], h0[1], h0[2], h0[3]); w.y = pk4_fp8(h1[0], h1[1], h1[2], h1[3]);
                *(u32x2*)(rowp) = w; }
    }
};
struct EpiBf16 {
    static constexpr bool PERM = true, PERM2 = true;
    bf16* O; int ldc; float scale;
    __device__ __forceinline__ void operator()(const f32x4 (&acc)[2][2][4][2], const Unit& u, int wr, int wc, int fr, int fq) const {
        const int row0 = u.pm * BM + wr * 64 + (fr & 7), col0 = u.pn * BM + wc * 64 + 8 * fq;
#pragma unroll
        for (int ai = 0; ai < 2; ++ai)
#pragma unroll
            for (int m = 0; m < 4; ++m) { bf16* rowp = O + (size_t)(row0 + ai * HALF + m * 16) * ldc + col0;
                u32x4 w[2];
#pragma unroll
                for (int bj = 0; bj < 2; ++bj) { const f32x4 v0 = acc[ai][bj][m][0] * scale, v1 = acc[ai][bj][m][1] * scale;
                    w[bj].x = cvt_pk_bf16(v0[0], v0[1]); w[bj].y = cvt_pk_bf16(v0[2], v0[3]); w[bj].z = cvt_pk_bf16(v1[0], v1[1]); w[bj].w = cvt_pk_bf16(v1[2], v1[3]); }
                store_pair_rows(rowp, (size_t)ldc, fr, w[0], w[1]); }
    }
};

struct EpiF8 {
    static constexpr bool PERM = true, PERM2 = true;
    unsigned char* O; int ldc; float scale;
    __device__ __forceinline__ void operator()(const f32x4 (&acc)[2][2][4][2], const Unit& u, int wr, int wc, int fr, int fq) const {
        const int row0 = u.pm * BM + wr * 64 + (fr & 7), col0 = u.pn * BM + wc * 64 + 8 * fq; const bool hi = (fr & 8) != 0;
#pragma unroll
        for (int ai = 0; ai < 2; ++ai)
#pragma unroll
            for (int m = 0; m < 4; ++m) { unsigned char* p = O + (size_t)(row0 + ai * HALF + m * 16) * ldc + col0 + (hi ? 32 : 0);
                u32x2 w[2];
#pragma unroll
                for (int bj = 0; bj < 2; ++bj) { const f32x4 v0 = acc[ai][bj][m][0] * scale, v1 = acc[ai][bj][m][1] * scale; w[bj].x = pk4_fp8(v0[0], v0[1], v0[2], v0[3]); w[bj].y = pk4_fp8(v1[0], v1[1], v1[2], v1[3]); }
                const u32x2 s = hi ? w[0] : w[1]; u32x2 r;
                r.x = (unsigned)__builtin_amdgcn_ds_swizzle((int)s.x, 0x201F); r.y = (unsigned)__builtin_amdgcn_ds_swizzle((int)s.y, 0x201F);
                *(u32x2*)(p) = hi ? r : w[0];
                *(u32x2*)(p + 8 * (size_t)ldc) = hi ? w[1] : r; }
    }
};

__device__ __forceinline__ void transpose_item(const float* src, int ldsrc, int scol0, int k0, bf16* dst, size_t drow0, int ldd, LAS float* scr, int lane) {
#pragma unroll 8
    for (int i = 0; i < 32; ++i) { const int kk = 2 * i + (lane >> 5); scr[kk * 33 + (lane & 31)] = src[(size_t)(k0 + kk) * ldsrc + scol0 + (lane & 31)]; }
    asm volatile("s_waitcnt lgkmcnt(0)" ::: "memory");
    const int c = lane & 7;
#pragma unroll
    for (int j = 0; j < 4; ++j) { const int n = (lane >> 3) + 8 * j; const LAS float* s = scr + (8 * c) * 33 + n;
        u32x4 o; o.x = pk2(s[0 * 33], s[1 * 33]); o.y = pk2(s[2 * 33], s[3 * 33]); o.z = pk2(s[4 * 33], s[5 * 33]); o.w = pk2(s[6 * 33], s[7 * 33]);
        *(u32x4*)(dst + (drow0 + n) * (size_t)ldd + k0 + 8 * c) = o; }
    asm volatile("s_waitcnt lgkmcnt(0)" ::: "memory");
}

struct T64 { const float* src; bf16* dst; int ldsrc, ldd, f8; };
__device__ __forceinline__ T64 decode_t64(const Args& a, int r) {
    unsigned char* ws = a.ws; T64 t;
    if (r < 2048) { const int kb = r >> 6, nb = r & 63; const int scol = nb < 48 ? nb * 64 : 3104 + (nb - 48) * 64;
        t.src = a.in[7] + (size_t)(kb * 64) * PROJW + scol; t.ldsrc = PROJW; t.dst = (bf16*)(ws + WS_WIN) + (size_t)(nb * 64) * DM + kb * 64; t.ldd = DM; t.f8 = 0; return t; }
    r -= 2048;
    if (r < 1024) { const int kb = r >> 5, nb = r & 31;
        t.src = a.in[13] + (size_t)(kb * 64) * DM + nb * 64; t.ldsrc = DM; t.dst = (bf16*)(ws + WS_WOUT) + (size_t)(nb * 64) * DM + kb * 64; t.ldd = DM; t.f8 = 0; return t; }
    r -= 1024;
    if (r < 16384) { const int up = r >= 8192; if (up) r -= 8192; const int e = r >> 9, rr = r & 511, kb = rr >> 4, nb = rr & 15, n0 = nb * 64;
        t.src = (up ? a.in[17] : a.in[16]) + (size_t)e * DM * DEXP + (size_t)(kb * 64) * DEXP + n0; t.ldsrc = DEXP;
        t.dst = (bf16*)(ws + WS_WGU + ((size_t)e * 2048 + (size_t)(n0 >> 7) * 256 + (n0 & 127) + (up ? 128 : 0)) * DM + kb * 64); t.ldd = DM; t.f8 = 1; return t; }
    r -= 16384;
    { const int e = r >> 9, rr = r & 511, kb = rr >> 5, nb = rr & 31;
        t.src = a.in[18] + (size_t)e * DEXP * DM + (size_t)(kb * 64) * DM + nb * 64; t.ldsrc = DM;
        t.dst = (bf16*)(ws + WS_WD + ((size_t)e * 2048 + nb * 64) * DEXP + kb * 64); t.ldd = DEXP; t.f8 = 1; return t; }
}
__device__ __forceinline__ void t64_load(const T64& t, int lane, f32x4 (&v)[16]) {
    const int krow = lane >> 4, c4 = lane & 15;
#pragma unroll
    for (int i = 0; i < 16; ++i) v[i] = __builtin_nontemporal_load((const f32x4*)(t.src + (size_t)(4 * i + krow) * t.ldsrc + 4 * c4));
}
__device__ __forceinline__ void t64_finish(const T64& t, int lane, const f32x4 (&v)[16], LAS float* scr) {
    const int krow = lane >> 4, c4 = lane & 15;
#pragma unroll
    for (int i = 0; i < 16; ++i) { LAS float* p = scr + (4 * i + krow) * 65 + 4 * c4; p[0] = v[i].x; p[1] = v[i].y; p[2] = v[i].z; p[3] = v[i].w; }
    asm volatile("s_waitcnt lgkmcnt(0)" ::: "memory");
    const int c = lane & 7;
#pragma unroll
    for (int j = 0; j < 8; ++j) { const int n = (lane >> 3) + 8 * j; const LAS float* s = scr + (8 * c) * 65 + n;
        if (t.f8) { u32x2 o; o.x = pk4_fp8(s[0 * 65] * W8_SCALE, s[1 * 65] * W8_SCALE, s[2 * 65] * W8_SCALE, s[3 * 65] * W8_SCALE); o.y = pk4_fp8(s[4 * 65] * W8_SCALE, s[5 * 65] * W8_SCALE, s[6 * 65] * W8_SCALE, s[7 * 65] * W8_SCALE);
            *(u32x2*)((unsigned char*)t.dst + (size_t)n * t.ldd + 8 * c) = o; }
        else { u32x4 o; o.x = pk2(s[0 * 65], s[1 * 65]); o.y = pk2(s[2 * 65], s[3 * 65]); o.z = pk2(s[4 * 65], s[5 * 65]); o.w = pk2(s[6 * 65], s[7 * 65]);
            *(u32x4*)(t.dst + (size_t)n * t.ldd + 8 * c) = o; } }
    asm volatile("s_waitcnt lgkmcnt(0)" ::: "memory");
}
constexpr int P0_NT64 = 2048 + 1024 + 16384 + 8192;
constexpr int P0_TAIL = 1024;
constexpr int P0_NGEMV = 192;
__device__ __forceinline__ void phase0(const Args& a, LAS unsigned char* lds) {
    const int tid = opaque_tid(), lane = tid & 63, wave = tid >> 6, G = gridDim.x, blk = blockIdx.x;
    unsigned char* ws = a.ws;
    {
        const float* c = a.in[1]; const float* cc = a.in[3]; const float* w_ada = a.in[4]; const float* b_ada = a.in[5];
        float* part = (float*)(ws + WS_ADAP);
        LAS float* red = (LAS float*)lds;
        for (int rep_ = 0; rep_ < 1 + (PROBE_P0 & 1); ++rep_)
        for (int it = blk; it < P0_NGEMV; it += G) {
            const int cb = it % 48, ks = it / 48, col0 = cb * 256 + 4 * lane, r0 = ks * 512 + wave * 64;
            f32x4 a0 = {0.f, 0.f, 0.f, 0.f}, a1 = a0, a2 = a0;
#pragma unroll 16
            for (int r = r0; r < r0 + 64; ++r) {
                const f32x4 w = *(const f32x4*)(w_ada + (size_t)r * 12288 + col0);
                const float s0 = silu_f(c[r]), s1 = silu_f(c[DM + r]), s2 = silu_f(cc[r]);
                a0 += w * s0; a1 += w * s1; a2 += w * s2;
            }
            *(LAS f32x4*)(red + (wave * 3 + 0) * 256 + 4 * lane) = a0; *(LAS f32x4*)(red + (wave * 3 + 1) * 256 + 4 * lane) = a1; *(LAS f32x4*)(red + (wave * 3 + 2) * 256 + 4 * lane) = a2;
            __syncthreads();
            for (int idx = tid; idx < 768; idx += NTHREADS) { const int v = idx >> 8, col = idx & 255; float s = ks == 0 ? b_ada[cb * 256 + col] : 0.f;
#pragma unroll
                for (int w8 = 0; w8 < 8; ++w8) s += red[(w8 * 3 + v) * 256 + col];
                part[(size_t)(ks * 3 + v) * 12288 + cb * 256 + col] = s; }
            __syncthreads();
        }
    }
    LAS float* scr = (LAS float*)(lds + wave * 16640);
    const int gw = blk * 8 + wave, NGW = G * 8;
    constexpr int I_WZ = 32, I_WR = 512, I_TW = 256, I_FT = 256;
    for (int it = gw; it < I_WZ + I_WR + I_TW + I_FT; it += NGW) {
        int r = it;
        if (r < I_WZ) { transpose_item(a.in[7], PROJW, 3072, r * 64, (bf16*)(ws + WS_WIN), (size_t)4096, DM, scr, lane); continue; }
        r -= I_WZ;
        if (r < I_WR) { const int p = r * 64 + lane, e = p >> 11, d = p & 2047; const float wv = a.in[15][d * 16 + e]; const unsigned hi = f2bf(wv); ((bf16*)(ws + WS_WRH))[p] = (bf16)hi; ((bf16*)(ws + WS_WRL))[p] = (bf16)f2bf(wv - bf2f((bf16)hi)); continue; }
        r -= I_WR;
        if (r < I_TW) { const int p = r * 64 + lane; float s, c; sincospif((float)p * (1.0f / 8192.0f), &s, &c); ((f32x2*)(ws + WS_TW))[p] = (f32x2){c, s}; continue; }
        r -= I_TW;
        { const int p = r * 64 + lane, k = p >> 7, l = p & 127; float s, c; sincospif((float)((k * l) & 127) * (1.0f / 64.0f), &s, &c); ((bf16*)(ws + WS_FC))[p] = (bf16)f2bf(c); ((bf16*)(ws + WS_FS))[p] = (bf16)f2bf(s); }
    }
    const int n_gemv_wg = G > P0_NGEMV ? P0_NGEMV : 0;
    const int head_end = n_gemv_wg ? P0_NT64 - P0_TAIL : P0_NT64;
    const int n_head = gw < head_end ? (head_end - gw + NGW - 1) / NGW : 0;
    const int tgw = (blk - n_gemv_wg) * 8 + wave, tstep = (G - n_gemv_wg) * 8;
    const int n_tail = (n_gemv_wg && blk >= n_gemv_wg && tgw < P0_TAIL) ? (P0_TAIL - tgw + tstep - 1) / tstep : 0;
    const int n_items = n_head + n_tail;
    auto item_of = [&](int j) -> int { return j < n_head ? gw + j * NGW : head_end + tgw + (j - n_head) * tstep; };
    for (int rep_ = 0; rep_ < 1 + ((PROBE_P0 >> 1) & 1); ++rep_) {
    f32x4 va[16], vb[16]; T64 ta, tb;
    if (n_items > 0) { ta = decode_t64(a, item_of(0)); t64_load(ta, lane, va); }
    for (int j = 0; j < n_items; j += 2) {
        const bool h1 = j + 1 < n_items, h2 = j + 2 < n_items;
        if (h1) { tb = decode_t64(a, item_of(j + 1)); t64_load(tb, lane, vb); }
        t64_finish(ta, lane, va, scr);
        if (h2) { ta = decode_t64(a, item_of(j + 2)); t64_load(ta, lane, va); }
        if (h1) t64_finish(tb, lane, vb, scr);
    }
    }
}

#define MFMA16(a, b, c) __builtin_amdgcn_mfma_f32_16x16x32_bf16((a), (b), (c), 0, 0, 0)
__device__ __forceinline__ void finalize_ada(const Args& a) {
    const float* part = (const float*)(a.ws + WS_ADAP); float* adaw = (float*)(a.ws + WS_ADA);
    for (int i = blockIdx.x * NTHREADS + threadIdx.x; i < 3 * 12288; i += gridDim.x * NTHREADS) { float s = 0.f;
#pragma unroll
        for (int ks = 0; ks < 4; ++ks) s += part[(size_t)ks * 3 * 12288 + i];
        adaw[i] = s; }
}
__device__ __forceinline__ void quantize_win(const Args& a) {
    const int lane = threadIdx.x & 63, gw = blockIdx.x * 8 + (threadIdx.x >> 6), NGW = gridDim.x * 8;
    const bf16* W = (const bf16*)(a.ws + WS_WIN); unsigned char* W8 = a.ws + WS_WIN8; float* cs = (float*)(a.ws + WS_CS);
    for (int n = gw; n < 4096; n += NGW) {
        u32x4 v[4]; float f[4][8]; float amax = 0.f;
#pragma unroll
        for (int j = 0; j < 4; ++j) { v[j] = *(const u32x4*)(W + (size_t)n * DM + 512 * j + 8 * lane);
#pragma unroll
            for (int i = 0; i < 4; ++i) { f[j][2 * i] = __uint_as_float(v[j][i] << 16); f[j][2 * i + 1] = __uint_as_float(v[j][i] & 0xffff0000u); amax = fmaxf(amax, fmaxf(fabsf(f[j][2 * i]), fabsf(f[j][2 * i + 1]))); } }
#pragma unroll
        for (int o = 1; o < 64; o <<= 1) amax = fmaxf(amax, __shfl_xor(amax, o));
        const float inv = amax > 0.f ? 127.f / amax : 0.f;
#pragma unroll
        for (int j = 0; j < 4; ++j) { u32x2 w8; w8.x = pk4_i8(f[j][0] * inv, f[j][1] * inv, f[j][2] * inv, f[j][3] * inv); w8.y = pk4_i8(f[j][4] * inv, f[j][5] * inv, f[j][6] * inv, f[j][7] * inv);
            *(u32x2*)(W8 + (size_t)n * DM + 512 * j + 8 * lane) = w8; }
        if (lane == 0) cs[n] = amax * (1.f / 127.f);
    }
}
constexpr int CW_CTXCNT = 4096;
template <int MODE>
__device__ __forceinline__ void norm_load_tile(const Args& a, int tile, int rl, int wave, int q, f32x4 (&xv)[8][2], u32x4 (&dv)[8]) {
    const int r = tile * 16 + rl;
    if (MODE == 0) { const float* s = (r < NLAT ? a.in[0] + (size_t)r * DM : a.in[2] + (size_t)(r - NLAT) * DM) + 256 * wave + 8 * q;
#pragma unroll
        for (int ks = 0; ks < 8; ++ks) { xv[ks][0] = *(const f32x4*)(s + 32 * ks); xv[ks][1] = *(const f32x4*)(s + 32 * ks + 4); } }
    if (MODE == 1) { const bf16* dp = (const bf16*)(a.ws + WS_DLT) + (size_t)r * DM + 256 * wave + 8 * q;
#pragma unroll
        for (int ks = 0; ks < 8; ++ks) dv[ks] = *(const u32x4*)(dp + 32 * ks); }
}
template <int MODE>
__device__ __forceinline__ void phase_norm_tile(const Args& a, LAS unsigned char* lds, int first, int stride, int tile_end) {
    const int tid = opaque_tid(), lane = tid & 63, wave = __builtin_amdgcn_readfirstlane(tid >> 6), rl = lane & 15, q = lane >> 4;
    const float* ada = (const float*)(a.ws + WS_ADA);
    LAS float* gs = (LAS float*)lds;
    LAS float* shv = gs + 3 * DM;
    LAS float* ssred0 = shv + 3 * DM;
    LAS float* red0 = ssred0 + 256;
    LAS float* mxred0 = red0 + 8192;
    { const float* gn = MODE == 0 ? a.in[6] : a.in[14]; const float* part = (const float*)(a.ws + WS_ADAP);
      for (int i = tid; i < 3 * DM; i += NTHREADS) { const int v = i / DM, d = i % DM;
          float sh_, sc_;
          if (MODE == 0) { const float* p0 = part + (size_t)v * 12288; sh_ = 0.f; sc_ = 0.f;
#pragma unroll
              for (int ks = 0; ks < 4; ++ks) { sh_ += p0[(size_t)ks * 3 * 12288 + d]; sc_ += p0[(size_t)ks * 3 * 12288 + DM + d]; } }
          else { const float* base = ada + (size_t)v * 12288 + 3 * DM; sh_ = base[d]; sc_ = base[DM + d]; }
          gs[i] = gn[d] * (1.f + sc_); shv[i] = sh_; }
    }
    bf16x8 wb[2][8];
    if (MODE == 0) { const bf16* Wz = (const bf16*)(a.ws + WS_WIN) + (size_t)4096 * DM;
#pragma unroll
        for (int nt = 0; nt < 2; ++nt)
#pragma unroll
            for (int ks = 0; ks < 8; ++ks) wb[nt][ks] = *(const bf16x8*)(Wz + (size_t)(16 * nt + rl) * DM + 256 * wave + 32 * ks + 8 * q);
    } else { const bf16* WH = (const bf16*)(a.ws + WS_WRH); const bf16* WL = (const bf16*)(a.ws + WS_WRL);
#pragma unroll
        for (int ks = 0; ks < 8; ++ks) { wb[0][ks] = *(const bf16x8*)(WH + (size_t)rl * DM + 256 * wave + 32 * ks + 8 * q); wb[1][ks] = *(const bf16x8*)(WL + (size_t)rl * DM + 256 * wave + 32 * ks + 8 * q); } }
    __syncthreads();
    bf16* Hout = (bf16*)(a.ws + (MODE == 0 ? WS_H : WS_HF));
    f32x4 xv[8][2]; u32x4 dv[8];
    auto tile_of = [&](int s) -> int { return MODE == 0 ? (s < 32 ? NLAT / 16 + s : s - 32) : s; };
    int sq = first;
    if (sq < tile_end) norm_load_tile<MODE>(a, tile_of(sq), rl, wave, q, xv, dv);
    int par = 0;
    for (; sq < tile_end; sq += stride, par ^= 1) {
        LAS float* ssred = ssred0 + par * 128; LAS float* red = red0 + par * 4096; LAS float* mxred = mxred0 + par * 128;
        const int tile = tile_of(sq);
        const int r = tile * 16 + rl;
        const int v = MODE == 0 ? (tile * 16 < NLAT ? (tile * 16) / SEQ : 2) : (tile * 16) / SEQ;
        if (MODE == 1) {
#pragma unroll
            for (int ks = 0; ks < 8; ++ks) { const u32x4 d = dv[ks];
                xv[ks][0] = (f32x4){__uint_as_float(d.x << 16), __uint_as_float(d.x & 0xffff0000u), __uint_as_float(d.y << 16), __uint_as_float(d.y & 0xffff0000u)};
                xv[ks][1] = (f32x4){__uint_as_float(d.z << 16), __uint_as_float(d.z & 0xffff0000u), __uint_as_float(d.w << 16), __uint_as_float(d.w & 0xffff0000u)}; }
            if (sq + stride < tile_end) norm_load_tile<MODE>(a, tile_of(sq + stride), rl, wave, q, xv, dv); }
        float ss = 0.f;
#pragma unroll
        for (int ks = 0; ks < 8; ++ks) { const f32x4 a0 = xv[ks][0], a1 = xv[ks][1]; ss += (a0.x * a0.x + a0.y * a0.y) + (a0.z * a0.z + a0.w * a0.w) + (a1.x * a1.x + a1.y * a1.y) + (a1.z * a1.z + a1.w * a1.w); }
        ss += __shfl_xor(ss, 16); ss += __shfl_xor(ss, 32);
        if (q == 0) ssred[wave * 16 + rl] = ss;
        __syncthreads();
        float tot = 0.f;
#pragma unroll
        for (int w8 = 0; w8 < 8; ++w8) tot += ssred[w8 * 16 + rl];
        const float rstd = rsqrtf(tot * (1.f / DM) + EPS);
        f32x4 acc0 = {0.f, 0.f, 0.f, 0.f}, acc1 = {0.f, 0.f, 0.f, 0.f};
        const bool lat_tile = MODE == 0 && tile < NLAT / 16; float amax = 0.f;
        bf16* orow = Hout + (size_t)r * DM + 256 * wave + 8 * q;
        const LAS float* gsp = gs + v * DM + 256 * wave + 8 * q; const LAS float* shp = shv + v * DM + 256 * wave + 8 * q;
#pragma unroll
        for (int ks = 0; ks < 8; ++ks) {
            const f32x4 g0 = *(const LAS f32x4*)(gsp + 32 * ks), g1 = *(const LAS f32x4*)(gsp + 32 * ks + 4), s0 = *(const LAS f32x4*)(shp + 32 * ks), s1 = *(const LAS f32x4*)(shp + 32 * ks + 4);
            const f32x4 h0 = xv[ks][0] * rstd * g0 + s0, h1 = xv[ks][1] * rstd * g1 + s1;
            u32x4 hw; hw.x = pk2(h0.x, h0.y); hw.y = pk2(h0.z, h0.w); hw.z = pk2(h1.x, h1.y); hw.w = pk2(h1.z, h1.w);
            if (MODE == 0) { if (!lat_tile || INPROJ_BF16_TILES > 0) *(u32x4*)(orow + 32 * ks) = hw;
                if (lat_tile) { xv[ks][0] = h0; xv[ks][1] = h1;
                    amax = fmaxf(amax, fmaxf(fmaxf(fmaxf(fabsf(h0.x), fabsf(h0.y)), fmaxf(fabsf(h0.z), fabsf(h0.w))), fmaxf(fmaxf(fabsf(h1.x), fabsf(h1.y)), fmaxf(fabsf(h1.z), fabsf(h1.w))))); } }
            else { u32x2 h8; h8.x = pk4_fp8(h0.x, h0.y, h0.z, h0.w); h8.y = pk4_fp8(h1.x, h1.y, h1.z, h1.w); *(u32x2*)((unsigned char*)(a.ws + WS_HF) + (size_t)r * DM + 256 * wave + 8 * q + 32 * ks) = h8; }
            const bf16x8 hf = __builtin_bit_cast(bf16x8, hw);
            if (MODE == 0) { acc0 = MFMA16(hf, wb[0][ks], acc0); acc1 = MFMA16(hf, wb[1][ks], acc1); }
            else { u32x4 lw;
                lw.x = pk2(h0.x - __uint_as_float(hw.x << 16), h0.y - __uint_as_float(hw.x & 0xffff0000u)); lw.y = pk2(h0.z - __uint_as_float(hw.y << 16), h0.w - __uint_as_float(hw.y & 0xffff0000u));
                lw.z = pk2(h1.x - __uint_as_float(hw.z << 16), h1.y - __uint_as_float(hw.z & 0xffff0000u)); lw.w = pk2(h1.z - __uint_as_float(hw.w << 16), h1.w - __uint_as_float(hw.w & 0xffff0000u));
                const bf16x8 lf = __builtin_bit_cast(bf16x8, lw);
                acc0 = MFMA16(hf, wb[0][ks], acc0); acc0 = MFMA16(lf, wb[0][ks], acc0); acc0 = MFMA16(hf, wb[1][ks], acc0); }
        }
        if (MODE == 0 && lat_tile) {
            amax = fmaxf(amax, __shfl_xor(amax, 16)); amax = fmaxf(amax, __shfl_xor(amax, 32));
            if (q == 0) mxred[wave * 16 + rl] = amax;
            __syncthreads();
            float mx = 0.f;
#pragma unroll
            for (int w8 = 0; w8 < 8; ++w8) mx = fmaxf(mx, mxred[w8 * 16 + rl]);
            const float inv = mx > 0.f ? 127.f / mx : 0.f;
            unsigned char* o8 = a.ws + WS_H8 + (size_t)r * DM + 256 * wave + 8 * q;
#pragma unroll
            for (int ks = 0; ks < 8; ++ks) { const f32x4 h0 = xv[ks][0] * inv, h1 = xv[ks][1] * inv; u32x2 w8; w8.x = pk4_i8(h0.x, h0.y, h0.z, h0.w); w8.y = pk4_i8(h1.x, h1.y, h1.z, h1.w); *(u32x2*)(o8 + 32 * ks) = w8; }
            if (wave == 0 && q == 0) ((float*)(a.ws + WS_RS))[r] = mx * (1.f / 127.f);
        }
        if (MODE == 0 && sq + stride < tile_end) norm_load_tile<MODE>(a, tile_of(sq + stride), rl, wave, q, xv, dv);
#pragma unroll
        for (int rr = 0; rr < 4; ++rr) { red[(wave * 16 + 4 * q + rr) * 32 + rl] = acc0[rr]; if (MODE == 0) red[(wave * 16 + 4 * q + rr) * 32 + 16 + rl] = acc1[rr]; }
        __syncthreads();
        if (MODE == 0) { const int row = tid >> 5, col = tid & 31; float s = 0.f;
#pragma unroll
            for (int w8 = 0; w8 < 8; ++w8) s += red[(w8 * 16 + row) * 32 + col];
            ((float*)(a.ws + WS_Z))[(size_t)(tile * 16 + row) * 32 + col] = s;
        } else if (tid < 256) { const int row = tid >> 4, e = tid & 15; float s = 0.f;
#pragma unroll
            for (int w8 = 0; w8 < 8; ++w8) s += red[(w8 * 16 + row) * 32 + e];
            float m = s; m = fmaxf(m, __shfl_xor(m, 1)); m = fmaxf(m, __shfl_xor(m, 2)); m = fmaxf(m, __shfl_xor(m, 4)); m = fmaxf(m, __shfl_xor(m, 8));
            const float ex = expf(s - m); float sm = ex; sm += __shfl_xor(sm, 1); sm += __shfl_xor(sm, 2); sm += __shfl_xor(sm, 4); sm += __shfl_xor(sm, 8);
            const int rg = tile * 16 + row, b = rg / SEQ, t = rg % SEQ;
            ((float*)(a.ws + WS_AFF))[((size_t)b * NE + e) * SEQ + t] = ex / sm; }
        if (MODE == 0 && tile >= NLAT / 16) {
            __threadfence(); __syncthreads();
            if (tid == 0) __hip_atomic_fetch_add((unsigned*)(a.ws + WS_CTL) + CW_CTXCNT + 64 * ((tile - NLAT / 16) >> 4), 1u, __ATOMIC_RELAXED, __HIP_MEMORY_SCOPE_AGENT);
        }
    }
    __syncthreads();
}

constexpr int GQ_LD = 136, GK_LD = 72;
constexpr int GL_Q = 0, GL_KI = 17408, GL_KET = 34816, GL_VT = 53248, GL_ST = 90112, GL_DC = 159744, GL_SEG = 160256;
__device__ __forceinline__ bf16x8 ldfrag(const LAS bf16* base, int row0, int ld, int koff, int lane) { return *(const LAS bf16x8*)(base + (row0 + (lane & 15)) * ld + koff + 8 * (lane >> 4)); }
__device__ __forceinline__ float fast_logsigmoid(float x) { return fminf(x, 0.f) - __logf(1.f + __expf(-fabsf(x))); }

struct GlaRaw { u32x4 q[2], k[2], v[4]; f32x2 z; };
template <bool FULL>
__device__ __forceinline__ void gla_issue_loads(const Args& a, int b, int h, int dir, int t0, size_t zrow0, int tid, GlaRaw& r) {
    const bf16* QH = (const bf16*)(a.ws + WS_QH) + ((size_t)(b * 4 + h) * SEQ + t0) * 128; const bf16* KH = (const bf16*)(a.ws + WS_KH) + ((size_t)(b * 4 + h) * KTOK + t0) * 128;
    const float* Z = (const float*)(a.ws + WS_Z);
#pragma unroll
    for (int j = 0; j < 2; ++j) { const int e = tid + 512 * j; r.k[j] = *(const u32x4*)(KH + (size_t)e * 8); if (FULL) r.q[j] = *(const u32x4*)(QH + (size_t)e * 8); }
    { const int e = tid * 2; r.z = *(const f32x2*)(Z + (zrow0 + (e >> 4)) * 32 + dir * 16 + (e & 15)); }
}
__device__ __forceinline__ void gla_issue_v(const Args& a, int b, int h, int t0, int tid, GlaRaw& r) {
    const bf16* VH = (const bf16*)(a.ws + WS_VH) + ((size_t)(b * 4 + h) * KTOK + t0) * 256;
#pragma unroll
    for (int rr = 0; rr < 4; ++rr) r.v[rr] = *(const u32x4*)(VH + (size_t)(4 * (tid >> 5) + rr) * 256 + 8 * (tid & 31));
}
__device__ __forceinline__ void gla_store_vt(LAS unsigned char* lds, int tid, const u32x4 (&x)[4]) {
    LAS bf16* VT = (LAS bf16*)(lds + GL_VT); const int c0 = 8 * (tid & 31), l0 = 4 * (tid >> 5);
    const int sw = (((l0 >> 3) ^ ((c0 >> 3) & 7)) << 3) + (l0 & 7);
#pragma unroll
    for (int i2 = 0; i2 < 4; ++i2) {
        const unsigned a0 = x[0][i2], a1 = x[1][i2], a2 = x[2][i2], a3 = x[3][i2];
        u32x2 lo, hi; lo.x = (a0 & 0xffffu) | (a1 << 16); lo.y = (a2 & 0xffffu) | (a3 << 16); hi.x = (a0 >> 16) | (a1 & 0xffff0000u); hi.y = (a2 >> 16) | (a3 & 0xffff0000u);
        *(LAS u32x2*)(VT + (c0 + 2 * i2) * GK_LD + sw) = lo; *(LAS u32x2*)(VT + (c0 + 2 * i2 + 1) * GK_LD + sw) = hi; }
}
__device__ __forceinline__ bf16x8 ldfrag_vt(const LAS bf16* VT, int row0, int ld, int kc, int lane) { const int row = row0 + (lane & 15); return *(const LAS bf16x8*)(VT + row * ld + ((kc ^ ((row >> 3) & 7)) << 3)); }
template <bool FULL>
__device__ __forceinline__ void gla_stage(LAS unsigned char* lds, int wave, int lane, int tid, const GlaRaw& r) {
    LAS bf16* Qd = (LAS bf16*)(lds + GL_Q); LAS bf16* Ki = (LAS bf16*)(lds + GL_KI); LAS unsigned* zs = (LAS unsigned*)(lds + GL_SEG);
#pragma unroll
    for (int j = 0; j < 2; ++j) { const int e = tid + 512 * j, row = e >> 4, c8 = e & 15;
        *(LAS u32x4*)(Ki + row * GQ_LD + 8 * c8) = r.k[j]; if (FULL) *(LAS u32x4*)(Qd + row * GQ_LD + 8 * c8) = r.q[j]; }
    zs[tid] = pk2(r.z.x, r.z.y);
    gla_store_vt(lds, tid, r.v);
}
template <bool FULL>
__device__ __forceinline__ void gla_prep(LAS unsigned char* lds, int dir, const bf16x8 wfrag, float bias, float& totacc) {
    const int tid = opaque_tid(), lane = tid & 63, wave = __builtin_amdgcn_readfirstlane(tid >> 6), cidx = lane & 15, q = lane >> 4, d = 16 * wave + cidx;
    LAS bf16* Qd = (LAS bf16*)(lds + GL_Q); LAS bf16* Ki = (LAS bf16*)(lds + GL_KI); LAS bf16* KeT = (LAS bf16*)(lds + GL_KET);
    LAS float* dcv = (LAS float*)(lds + GL_DC); const LAS bf16* zs = (const LAS bf16*)(lds + GL_SEG);
    float c[4][4], t4[4], sq[4], Tt[4];
#pragma unroll
    for (int it = 0; it < 4; ++it) {
        const bf16x8 zf = *(const LAS bf16x8*)(zs + (16 * it + cidx) * 16 + 8 * (q & 1));
        f32x4 pre = {bias, bias, bias, bias};
        pre = MFMA16(zf, wfrag, pre);
#pragma unroll
        for (int r = 0; r < 4; ++r) c[it][r] = fast_logsigmoid(pre[r]) * (1.f / 16.f);
        if (!dir) { c[it][1] += c[it][0]; c[it][2] += c[it][1]; c[it][3] += c[it][2]; t4[it] = c[it][3]; }
        else { c[it][2] += c[it][3]; c[it][1] += c[it][2]; c[it][0] += c[it][1]; t4[it] = c[it][0]; }
        float s = t4[it];
        if (!dir) { const float u = __shfl_up(s, 16); if (q >= 1) s += u; const float u2 = __shfl_up(s, 32); if (q >= 2) s += u2; Tt[it] = __shfl(s, cidx + 48); }
        else { const float u = __shfl_down(s, 16); if (q <= 2) s += u; const float u2 = __shfl_down(s, 32); if (q <= 1) s += u2; Tt[it] = __shfl(s, cidx); }
        sq[it] = s - t4[it];
    }
    const float total = (Tt[0] + Tt[1]) + (Tt[2] + Tt[3]);
    float off[4];
    if (!dir) { off[0] = 0.f; off[1] = Tt[0]; off[2] = Tt[0] + Tt[1]; off[3] = Tt[0] + Tt[1] + Tt[2]; }
    else { off[3] = 0.f; off[2] = Tt[3]; off[1] = Tt[3] + Tt[2]; off[0] = Tt[3] + Tt[2] + Tt[1]; }
    const float dc = __expf(total);
#pragma unroll
    for (int it = 0; it < 4; ++it) {
        float ke[4];
#pragma unroll
        for (int r = 0; r < 4; ++r) { const int i = 16 * it + 4 * q + r; const float cum = c[it][r] + off[it] + sq[it];
            const float kf = bf2f(Ki[i * GQ_LD + d]);
            if (FULL) { const float qf = bf2f(Qd[i * GQ_LD + d]); const float kin = kf * __expf(-cum);
                Qd[i * GQ_LD + d] = (bf16)f2bf(qf * 0.08838834764831845f * __expf(cum)); Ki[i * GQ_LD + d] = (bf16)f2bf(kin); ke[r] = kin * dc; }
            else ke[r] = kf * __expf(total - cum); }
        u32x2 kw; kw.x = pk2(ke[0], ke[1]); kw.y = pk2(ke[2], ke[3]);
        *(LAS u32x2*)(KeT + d * GK_LD + 16 * it + 4 * q) = kw;
    }
    if (q == 0) { dcv[d] = dc; totacc += total; }
}
__device__ __forceinline__ bf16x8 gla_wfrag(const float* w_a2, int h, int wave, int lane) {
    const int d = 16 * wave + (lane & 15), q = lane >> 4; unsigned wv[4];
#pragma unroll
    for (int j2 = 0; j2 < 4; ++j2) { float x[2];
#pragma unroll
        for (int u = 0; u < 2; ++u) { const float wf = w_a2[(8 * (q & 1) + 2 * j2 + u) * 512 + h * 128 + d]; const float hi = bf2f((bf16)f2bf(wf)); x[u] = q < 2 ? hi : wf - hi; }
        wv[j2] = pk2(x[0], x[1]); }
    return __builtin_bit_cast(bf16x8, (u32x4){wv[0], wv[1], wv[2], wv[3]});
}
__device__ __forceinline__ void gla_state_update(LAS unsigned char* lds, int lane, const bf16x8 (&vt)[2][2], f32x4 (&acc)[8][2]) {
    const LAS bf16* KeT = (const LAS bf16*)(lds + GL_KET); const LAS float* dcv = (const LAS float*)(lds + GL_DC);
#pragma unroll
    for (int mt = 0; mt < 8; ++mt) {
        const f32x4 dc4 = *(const LAS f32x4*)(dcv + 16 * mt + 4 * (lane >> 4));
        const bf16x8 k0 = ldfrag(KeT, 16 * mt, GK_LD, 0, lane), k1 = ldfrag(KeT, 16 * mt, GK_LD, 32, lane);
#pragma unroll
        for (int n = 0; n < 2; ++n) { f32x4 t = acc[mt][n] * dc4; t = MFMA16(k0, vt[n][0], t); t = MFMA16(k1, vt[n][1], t); acc[mt][n] = t; }
    }
}
constexpr size_t GLA_SV = 128 * 256;
constexpr int GA_LD = 136;
constexpr int GA_K = 0, GA_KET = 34816, GA_VT = 69632, GA_Z = 139264, GA_DC = 143360;
struct GlaRawA { u32x4 k[4], v[8]; f32x2 z[2]; };
__device__ __forceinline__ void glaA_issue(const Args& a, int b, int h, int dir, int t0, size_t zrow0, int tid, GlaRawA& r) {
    const bf16* KH = (const bf16*)(a.ws + WS_KH) + ((size_t)(b * 4 + h) * KTOK + t0) * 128; const float* Z = (const float*)(a.ws + WS_Z);
#pragma unroll
    for (int j = 0; j < 4; ++j) { const int e = tid + 512 * j; r.k[j] = *(const u32x4*)(KH + (size_t)e * 8); }
#pragma unroll
    for (int j = 0; j < 2; ++j) { const int e = (tid + 512 * j) * 2; r.z[j] = *(const f32x2*)(Z + (zrow0 + (e >> 4)) * 32 + dir * 16 + (e & 15)); }
}
__device__ __forceinline__ void glaA_issue_v(const Args& a, int b, int h, int t0, int tid, GlaRawA& r) {
    const bf16* VH = (const bf16*)(a.ws + WS_VH) + ((size_t)(b * 4 + h) * KTOK + t0) * 256;
#pragma unroll
    for (int j = 0; j < 2; ++j)
#pragma unroll
        for (int rr = 0; rr < 4; ++rr) r.v[4 * j + rr] = *(const u32x4*)(VH + (size_t)(4 * ((tid >> 5) + 16 * j) + rr) * 256 + 8 * (tid & 31));
}
__device__ __forceinline__ void glaA_stage(LAS unsigned char* lds, int wave, int lane, int tid, const GlaRawA& r) {
    LAS bf16* Kr = (LAS bf16*)(lds + GA_K); LAS unsigned* zs = (LAS unsigned*)(lds + GA_Z); LAS bf16* VT = (LAS bf16*)(lds + GA_VT);
#pragma unroll
    for (int j = 0; j < 4; ++j) { const int e = tid + 512 * j, row = e >> 4, c8 = e & 15; *(LAS u32x4*)(Kr + row * GA_LD + 8 * c8) = r.k[j]; }
#pragma unroll
    for (int j = 0; j < 2; ++j) zs[tid + 512 * j] = pk2(r.z[j].x, r.z[j].y);
#pragma unroll
    for (int j = 0; j < 2; ++j) { const int c0 = 8 * (tid & 31), l0 = 4 * ((tid >> 5) + 16 * j);
        const int sw = (((l0 >> 3) ^ ((c0 >> 3) & 7)) << 3) + (l0 & 7);
#pragma unroll
        for (int i2 = 0; i2 < 4; ++i2) {
            const unsigned a0 = r.v[4 * j][i2], a1 = r.v[4 * j + 1][i2], a2 = r.v[4 * j + 2][i2], a3 = r.v[4 * j + 3][i2];
            u32x2 lo, hi; lo.x = (a0 & 0xffffu) | (a1 << 16); lo.y = (a2 & 0xffffu) | (a3 << 16); hi.x = (a0 >> 16) | (a1 & 0xffff0000u); hi.y = (a2 >> 16) | (a3 & 0xffff0000u);
            *(LAS u32x2*)(VT + (c0 + 2 * i2) * GA_LD + sw) = lo; *(LAS u32x2*)(VT + (c0 + 2 * i2 + 1) * GA_LD + sw) = hi; } }
}
__device__ __forceinline__ void glaA_prep(LAS unsigned char* lds, int dir, const bf16x8 wfrag, float bias, float& totacc) {
    const int tid = opaque_tid(), lane = tid & 63, wave = __builtin_amdgcn_readfirstlane(tid >> 6), cidx = lane & 15, q = lane >> 4, d = 16 * wave + cidx;
    const LAS bf16* Kr = (const LAS bf16*)(lds + GA_K); LAS bf16* KeT = (LAS bf16*)(lds + GA_KET); LAS float* dcv = (LAS float*)(lds + GA_DC); const LAS bf16* zs = (const LAS bf16*)(lds + GA_Z);
    float carry = 0.f;
    for (int hh = 0; hh < 2; ++hh) {
        const int it0 = 4 * (dir ? hh : 1 - hh);
        float c[4][4], sq[4], Tt[4];
#pragma unroll
        for (int i = 0; i < 4; ++i) {
            const bf16x8 zf = *(const LAS bf16x8*)(zs + (16 * (it0 + i) + cidx) * 16 + 8 * (q & 1));
            f32x4 pre = {bias, bias, bias, bias};
            pre = MFMA16(zf, wfrag, pre);
#pragma unroll
            for (int r = 0; r < 4; ++r) c[i][r] = fast_logsigmoid(pre[r]) * (1.f / 16.f);
            float t4;
            if (!dir) { c[i][1] += c[i][0]; c[i][2] += c[i][1]; c[i][3] += c[i][2]; t4 = c[i][3]; }
            else { c[i][2] += c[i][3]; c[i][1] += c[i][2]; c[i][0] += c[i][1]; t4 = c[i][0]; }
            float s = t4;
            if (!dir) { const float u = __shfl_up(s, 16); if (q >= 1) s += u; const float u2 = __shfl_up(s, 32); if (q >= 2) s += u2; Tt[i] = __shfl(s, cidx + 48); }
            else { const float u = __shfl_down(s, 16); if (q <= 2) s += u; const float u2 = __shfl_down(s, 32); if (q <= 1) s += u2; Tt[i] = __shfl(s, cidx); }
            sq[i] = s - t4;
        }
        const float toth = (Tt[0] + Tt[1]) + (Tt[2] + Tt[3]);
        float off[4];
        if (!dir) { off[0] = 0.f; off[1] = Tt[0]; off[2] = Tt[0] + Tt[1]; off[3] = Tt[0] + Tt[1] + Tt[2]; }
        else { off[3] = 0.f; off[2] = Tt[3]; off[1] = Tt[3] + Tt[2]; off[0] = Tt[3] + Tt[2] + Tt[1]; }
#pragma unroll
        for (int i = 0; i < 4; ++i) {
            float ke[4];
#pragma unroll
            for (int r = 0; r < 4; ++r) { const int tk = 16 * (it0 + i) + 4 * q + r; const float cum = c[i][r] + off[i] + sq[i]; ke[r] = bf2f(Kr[tk * GA_LD + d]) * __expf(toth - cum + carry); }
            u32x2 kw; kw.x = pk2(ke[0], ke[1]); kw.y = pk2(ke[2], ke[3]);
            *(LAS u32x2*)(KeT + d * GA_LD + 16 * (it0 + i) + 4 * q) = kw;
        }
        carry += toth;
    }
    if (q == 0) { dcv[d] = __expf(carry); totacc += carry; }
}
__device__ __forceinline__ void gla_passA128(const Args& a, LAS unsigned char* lds, int item) {
    const int tid = opaque_tid(), lane = tid & 63, wave = __builtin_amdgcn_readfirstlane(tid >> 6), q = lane >> 4, cidx = lane & 15;
    const bool is_ctx = item >= 256; const int seq = is_ctx ? (item - 256) >> 1 : item >> 4, s = is_ctx ? (item - 256) & 1 : item & 15;
    const int b = seq >> 3, dir = (seq >> 2) & 1, h = seq & 3, nstep = is_ctx ? 1 : 8;
    const size_t rowbase = is_ctx ? (size_t)(NLAT + b * CTXL + s * 128) : (size_t)b * SEQ + (size_t)s * 1024;
    const float* w_a2 = dir ? a.in[10] : a.in[8]; const float* b_a2 = dir ? a.in[11] : a.in[9];
    const bf16x8 wfrag = gla_wfrag(w_a2, h, wave, lane);
    const float bias = b_a2[h * 128 + 16 * wave + cidx];
    f32x4 acc[8][2];
#pragma unroll
    for (int mt = 0; mt < 8; ++mt) { acc[mt][0] = (f32x4){0.f, 0.f, 0.f, 0.f}; acc[mt][1] = (f32x4){0.f, 0.f, 0.f, 0.f}; }
    float totacc = 0.f;
    const int tbase = is_ctx ? SEQ + s * 128 : s * 1024;
    GlaRawA raw; { const int n0 = dir ? (nstep - 1) : 0; glaA_issue(a, b, h, dir, tbase + n0 * 128, rowbase + (size_t)n0 * 128, tid, raw); glaA_issue_v(a, b, h, tbase + n0 * 128, tid, raw); }
    for (int ci = 0; ci < nstep; ++ci) {
        const int nn = dir ? (nstep - 2 - ci) : ci + 1;
        glaA_stage(lds, wave, lane, tid, raw);
        if (ci + 1 < nstep) glaA_issue(a, b, h, dir, tbase + nn * 128, rowbase + (size_t)nn * 128, tid, raw);
        __syncthreads();
        glaA_prep(lds, dir, wfrag, bias, totacc);
        __syncthreads();
        const LAS bf16* VT = (const LAS bf16*)(lds + GA_VT); const LAS bf16* KeT = (const LAS bf16*)(lds + GA_KET); const LAS float* dcv = (const LAS float*)(lds + GA_DC);
        bf16x8 vt[2][4];
#pragma unroll
        for (int n2 = 0; n2 < 2; ++n2)
#pragma unroll
            for (int ks = 0; ks < 4; ++ks) vt[n2][ks] = ldfrag_vt(VT, 32 * wave + 16 * n2, GA_LD, 4 * ks + (lane >> 4), lane);
#pragma unroll
        for (int mt = 0; mt < 8; ++mt) {
            const f32x4 dc4 = *(const LAS f32x4*)(dcv + 16 * mt + 4 * q);
            bf16x8 kf[4];
#pragma unroll
            for (int ks = 0; ks < 4; ++ks) kf[ks] = ldfrag(KeT, 16 * mt, GA_LD, 32 * ks, lane);
#pragma unroll
            for (int n2 = 0; n2 < 2; ++n2) { f32x4 t = acc[mt][n2] * dc4;
#pragma unroll
                for (int ks = 0; ks < 4; ++ks) t = MFMA16(kf[ks], vt[n2][ks], t);
                acc[mt][n2] = t; }
        }
        if (ci + 1 < nstep) glaA_issue_v(a, b, h, tbase + nn * 128, tid, raw);
        __syncthreads();
    }
    float* T = is_ctx ? (float*)(a.ws + WS_TC) + (size_t)(item - 256) * GLA_SV : (float*)(a.ws + WS_T) + (size_t)item * GLA_SV;
#pragma unroll
    for (int mt = 0; mt < 8; ++mt)
#pragma unroll
        for (int n2 = 0; n2 < 2; ++n2)
#pragma unroll
            for (int r = 0; r < 4; ++r) T[(size_t)(16 * mt + 4 * q + r) * 256 + 32 * wave + 16 * n2 + cidx] = acc[mt][n2][r];
    if (q == 0) { float* D = is_ctx ? (float*)(a.ws + WS_DTC) + (size_t)(item - 256) * 128 : (float*)(a.ws + WS_DT) + (size_t)item * 128; D[16 * wave + cidx] = __expf(totacc); }
}

__device__ __forceinline__ void gla_passB(const Args& a) {
    const float* T = (const float*)(a.ws + WS_T); const float* DT = (const float*)(a.ws + WS_DT); float* SST = (float*)(a.ws + WS_SST);
    for (int e = blockIdx.x * NTHREADS + threadIdx.x; e < 16 * (int)GLA_SV; e += gridDim.x * NTHREADS) {
        const int seq = e >> 15, dv = e & 32767, d = dv >> 8, dir = (seq >> 2) & 1;
        float S = 0.f;
        { const float* TC = (const float*)(a.ws + WS_TC); const float* DTC = (const float*)(a.ws + WS_DTC);
#pragma unroll
          for (int j = 0; j < 2; ++j) { const int cc = dir ? 1 - j : j; S = DTC[(size_t)(seq * 2 + cc) * 128 + d] * S + TC[(size_t)(seq * 2 + cc) * GLA_SV + dv]; } }
        float tv[16], dd[16];
#pragma unroll
        for (int si = 0; si < 16; ++si) { const int s = dir ? 15 - si : si; const size_t it = (size_t)seq * 16 + s; tv[si] = T[it * GLA_SV + dv]; dd[si] = DT[it * 128 + d]; }
#pragma unroll
        for (int si = 0; si < 16; ++si) { const int s = dir ? 15 - si : si; const size_t it = (size_t)seq * 16 + s;
            SST[it * GLA_SV + dv] = S; S = dd[si] * S + tv[si]; }
    }
}
__device__ __forceinline__ void gla_passC(const Args& a, LAS unsigned char* lds, int item) {
    const int tid = opaque_tid(), lane = tid & 63, wave = __builtin_amdgcn_readfirstlane(tid >> 6), q = lane >> 4, cidx = lane & 15;
    const int seq = item >> 4, s = item & 15, b = seq >> 3, dir = (seq >> 2) & 1, h = seq & 3;
    const size_t rowbase = (size_t)b * SEQ + (size_t)s * 1024;
    const float* w_a2 = dir ? a.in[10] : a.in[8]; const float* b_a2 = dir ? a.in[11] : a.in[9];
    bf16* O = (bf16*)(a.ws + (dir ? WS_OB : WS_OF));
    const bf16x8 wfrag = gla_wfrag(w_a2, h, wave, lane);
    const float bias = b_a2[h * 128 + 16 * wave + cidx];
    LAS bf16* Qd = (LAS bf16*)(lds + GL_Q); LAS bf16* Ki = (LAS bf16*)(lds + GL_KI); LAS bf16* Pm = Ki; LAS bf16* VT = (LAS bf16*)(lds + GL_VT); LAS bf16* ST = (LAS bf16*)(lds + GL_ST);
    f32x4 acc[8][2];
    { const float* S0 = (const float*)(a.ws + WS_SST) + (size_t)item * GLA_SV;
#pragma unroll
      for (int mt = 0; mt < 8; ++mt)
#pragma unroll
          for (int n2 = 0; n2 < 2; ++n2) {
#pragma unroll
              for (int r = 0; r < 4; ++r) acc[mt][n2][r] = S0[(size_t)(16 * mt + 4 * q + r) * 256 + 32 * wave + 16 * n2 + cidx];
              u32x2 wv; wv.x = pk2(acc[mt][n2][0], acc[mt][n2][1]); wv.y = pk2(acc[mt][n2][2], acc[mt][n2][3]);
              *(LAS u32x2*)(ST + (32 * wave + 16 * n2 + cidx) * GQ_LD + 16 * mt + 4 * q) = wv; } }
    float totacc = 0.f;
    const int tbase = s * 1024;
    GlaRaw raw; gla_issue_loads<true>(a, b, h, dir, tbase + (dir ? 15 : 0) * 64, rowbase + (size_t)(dir ? 15 : 0) * 64, tid, raw); gla_issue_v(a, b, h, tbase + (dir ? 15 : 0) * 64, tid, raw);
    for (int ci = 0; ci < 16; ++ci) {
        const int n = dir ? (15 - ci) : ci; const size_t row0 = rowbase + (size_t)n * 64; const int nn = dir ? (14 - ci) : ci + 1;
        gla_stage<true>(lds, wave, lane, tid, raw);
        if (ci + 1 < 16) gla_issue_loads<true>(a, b, h, dir, tbase + nn * 64, rowbase + (size_t)nn * 64, tid, raw);
        __syncthreads();
        gla_prep<true>(lds, dir, wfrag, bias, totacc);
        __syncthreads();
        const int it = wave >> 1;
        u32x2 pw[2];
#pragma unroll
        for (int jj = 0; jj < 2; ++jj) { const int jt = 2 * (wave & 1) + jj; f32x4 sc = {0.f, 0.f, 0.f, 0.f};
#pragma unroll
            for (int ks = 0; ks < 4; ++ks) sc = MFMA16(ldfrag(Ki, 16 * jt, GQ_LD, 32 * ks, lane), ldfrag(Qd, 16 * it, GQ_LD, 32 * ks, lane), sc);
            const int i = 16 * it + cidx, j0 = 16 * jt + 4 * q;
#pragma unroll
            for (int r = 0; r < 4; ++r) { const bool keep = dir ? (j0 + r >= i) : (j0 + r <= i); sc[r] = keep ? sc[r] : 0.f; }
            pw[jj].x = pk2(sc[0], sc[1]); pw[jj].y = pk2(sc[2], sc[3]); }
        __syncthreads();
#pragma unroll
        for (int jj = 0; jj < 2; ++jj) *(LAS u32x2*)(Pm + (16 * it + cidx) * GK_LD + 16 * (2 * (wave & 1) + jj) + 4 * q) = pw[jj];
        __syncthreads();
        bf16x8 vt[2][2], st[2][4];
#pragma unroll
        for (int n2 = 0; n2 < 2; ++n2) { vt[n2][0] = ldfrag_vt(VT, 32 * wave + 16 * n2, GK_LD, (lane >> 4), lane); vt[n2][1] = ldfrag_vt(VT, 32 * wave + 16 * n2, GK_LD, 4 + (lane >> 4), lane);
#pragma unroll
            for (int ks = 0; ks < 4; ++ks) st[n2][ks] = ldfrag(ST, 32 * wave + 16 * n2, GQ_LD, 32 * ks, lane); }
#pragma unroll
        for (int i2 = 0; i2 < 4; ++i2) {
            const bf16x8 p0 = ldfrag(Pm, 16 * i2, GK_LD, 0, lane), p1 = ldfrag(Pm, 16 * i2, GK_LD, 32, lane);
            bf16x8 qf[4];
#pragma unroll
            for (int ks = 0; ks < 4; ++ks) qf[ks] = ldfrag(Qd, 16 * i2, GQ_LD, 32 * ks, lane);
#pragma unroll
            for (int n2 = 0; n2 < 2; ++n2) { f32x4 o = {0.f, 0.f, 0.f, 0.f};
                o = MFMA16(vt[n2][0], p0, o); o = MFMA16(vt[n2][1], p1, o);
#pragma unroll
                for (int ks = 0; ks < 4; ++ks) o = MFMA16(st[n2][ks], qf[ks], o);
                u32x2 wv; wv.x = pk2(o[0], o[1]); wv.y = pk2(o[2], o[3]);
                *(u32x2*)(O + (row0 + 16 * i2 + cidx) * 1024 + h * 256 + 32 * wave + 16 * n2 + 4 * q) = wv; }
            asm volatile("" ::: "memory");
        }
        if (ci + 1 < 16) gla_issue_v(a, b, h, tbase + nn * 64, tid, raw);
        gla_state_update(lds, lane, vt, acc);
#pragma unroll
        for (int mt = 0; mt < 8; ++mt)
#pragma unroll
            for (int n2 = 0; n2 < 2; ++n2) { u32x2 wv; wv.x = pk2(acc[mt][n2][0], acc[mt][n2][1]); wv.y = pk2(acc[mt][n2][2], acc[mt][n2][3]);
                *(LAS u32x2*)(ST + (32 * wave + 16 * n2 + cidx) * GQ_LD + 16 * mt + 4 * q) = wv; }
        __syncthreads();
    }
}

__device__ __forceinline__ void merge_load(const bf16* OF, const bf16* OB, const bf16* G, int r0, int NGW, int lane, u32x2 (&fa)[2][4], u32x2 (&fb)[2][4], u32x2 (&gw2)[2][4]) {
#pragma unroll
    for (int u = 0; u < 2; ++u) { const int r = r0 + u * NGW; if (r < NLAT) {
#pragma unroll
        for (int j = 0; j < 4; ++j) { const int col = 256 * j + 4 * lane; fa[u][j] = *(const u32x2*)(OF + (size_t)r * 1024 + col); fb[u][j] = *(const u32x2*)(OB + (size_t)r * 1024 + col); gw2[u][j] = *(const u32x2*)(G + (size_t)r * 1024 + col); } } }
}
__device__ __forceinline__ void phase_gla_merge(const Args& a) {
    const int tid = opaque_tid(), lane = tid & 63, wave = tid >> 6;
    if (PROBE_HALF && blockIdx.x >= gridDim.x / 2) return;
    const int gw = blockIdx.x * 8 + wave, NGW = (PROBE_HALF ? gridDim.x / 2 : gridDim.x) * 8;
    const bf16* OF = (const bf16*)(a.ws + WS_OF); const bf16* OB = (const bf16*)(a.ws + WS_OB);
    const bf16* G = (const bf16*)(a.ws + WS_G); bf16* Y = (bf16*)(a.ws + WS_YCAT); const float* gg = a.in[12];
    f32x4 gn[4];
#pragma unroll
    for (int j = 0; j < 4; ++j) gn[j] = *(const f32x4*)(gg + 256 * j + 4 * lane);
    u32x2 fa[2][4], fb[2][4], gw2[2][4], na[2][4], nb[2][4], ng[2][4];
    if (gw < NLAT) merge_load(OF, OB, G, gw, NGW, lane, fa, fb, gw2);
    for (int r0 = gw; r0 < NLAT; r0 += 2 * NGW) {
        if (r0 + 2 * NGW < NLAT) merge_load(OF, OB, G, r0 + 2 * NGW, NGW, lane, na, nb, ng);
#pragma unroll
        for (int u = 0; u < 2; ++u) { const int r = r0 + u * NGW; if (r < NLAT) {
#pragma unroll
            for (int j = 0; j < 4; ++j) {
                const int col = 256 * j + 4 * lane;
                f32x4 o; o.x = __uint_as_float(fa[u][j].x << 16) + __uint_as_float(fb[u][j].x << 16); o.y = __uint_as_float(fa[u][j].x & 0xffff0000u) + __uint_as_float(fb[u][j].x & 0xffff0000u);
                o.z = __uint_as_float(fa[u][j].y << 16) + __uint_as_float(fb[u][j].y << 16); o.w = __uint_as_float(fa[u][j].y & 0xffff0000u) + __uint_as_float(fb[u][j].y & 0xffff0000u);
                const float ss = wave_sum((o.x * o.x + o.y * o.y) + (o.z * o.z + o.w * o.w));
                const float rstd = rsqrtf(ss * (1.f / 256.f) + EPS);
                const float g0 = __uint_as_float(gw2[u][j].x << 16), g1 = __uint_as_float(gw2[u][j].x & 0xffff0000u), g2 = __uint_as_float(gw2[u][j].y << 16), g3 = __uint_as_float(gw2[u][j].y & 0xffff0000u);
                u32x2 w; w.x = pk2(o.x * rstd * gn[j].x * silu_f(g0), o.y * rstd * gn[j].y * silu_f(g1)); w.y = pk2(o.z * rstd * gn[j].z * silu_f(g2), o.w * rstd * gn[j].w * silu_f(g3));
                *(u32x2*)(Y + (size_t)r * DM + col) = w;
            } } }
#pragma unroll
        for (int u = 0; u < 2; ++u)
#pragma unroll
            for (int j = 0; j < 4; ++j) { fa[u][j] = na[u][j]; fb[u][j] = nb[u][j]; gw2[u][j] = ng[u][j]; }
    }
}

constexpr int FLD = 136;
__device__ __forceinline__ void load_dft_frags(const unsigned char* ws, int wave, int lane, bf16x8 (&fc)[4], bf16x8 (&fs)[4]) {
    const bf16* FC = (const bf16*)(ws + WS_FC); const bf16* FS = (const bf16*)(ws + WS_FS);
    const int k = 16 * wave + (lane & 15);
#pragma unroll
    for (int ks = 0; ks < 4; ++ks) { fc[ks] = *(const bf16x8*)(FC + k * 128 + ks * 32 + 8 * (lane >> 4)); fs[ks] = *(const bf16x8*)(FS + k * 128 + ks * 32 + 8 * (lane >> 4)); }
}
__device__ __forceinline__ void store_t4x8(LAS bf16* XT, int c0, int l0, const u32x4 (&x)[4]) {
#pragma unroll
    for (int i2 = 0; i2 < 4; ++i2) {
        const unsigned a0 = x[0][i2], a1 = x[1][i2], a2 = x[2][i2], a3 = x[3][i2];
        u32x2 lo, hi; lo.x = (a0 & 0xffffu) | (a1 << 16); lo.y = (a2 & 0xffffu) | (a3 << 16); hi.x = (a0 >> 16) | (a1 & 0xffff0000u); hi.y = (a2 >> 16) | (a3 & 0xffff0000u);
        const int sw = (((l0 >> 3) ^ ((c0 >> 3) & 7)) << 3) + (l0 & 7);
        *(LAS u32x2*)(XT + (c0 + 2 * i2) * FLD + sw) = lo; *(LAS u32x2*)(XT + (c0 + 2 * i2 + 1) * FLD + sw) = hi; }
}
__device__ __forceinline__ bf16x8 ldfrag_sw(const LAS bf16* XT, int row0, int kc, int lane) { const int row = row0 + (lane & 15); return *(const LAS bf16x8*)(XT + row * FLD + ((kc ^ ((row >> 3) & 7)) << 3)); }
__device__ __forceinline__ void phase_f1(const Args& a, LAS unsigned char* lds) {
    const int tid = opaque_tid(), lane = tid & 63, wave = __builtin_amdgcn_readfirstlane(tid >> 6), q = lane >> 4, cidx = lane & 15;
    const bf16* P = (const bf16*)(a.ws + WS_U); const f32x2* TW = (const f32x2*)(a.ws + WS_TW);
    bf16* A1r = (bf16*)(a.ws + WS_FA); bf16* A1i = (bf16*)(a.ws + WS_FAI);
    LAS bf16* XT = (LAS bf16*)lds;
    bf16x8 fc[4], fs[4]; load_dft_frags(a.ws, wave, lane, fc, fs);
    const int k1 = 16 * wave + cidx;
    u32x4 xp[2][4];
    auto f1_load = [&](int item) { const int cb = item & 3, l2 = (item >> 2) & 127, b = item >> 9, ch0 = cb * 256;
#pragma unroll
        for (int j = 0; j < 2; ++j) { const int task = tid + 512 * j, cblk = task & 31, lb = task >> 5;
#pragma unroll
            for (int r = 0; r < 4; ++r) xp[j][r] = *(const u32x4*)(P + ((size_t)b * SEQ + 128 * (4 * lb + r) + l2) * 1024 + ch0 + 8 * cblk); } };
    if ((int)blockIdx.x < 1024) f1_load(blockIdx.x);
    for (int item = blockIdx.x; item < 1024; item += gridDim.x) {
        const int cb = item & 3, l2 = (item >> 2) & 127, b = item >> 9, ch0 = cb * 256;
#pragma unroll
        for (int j = 0; j < 2; ++j) { const int task = tid + 512 * j, cblk = task & 31, lb = task >> 5; store_t4x8(XT, 8 * cblk, 4 * lb, xp[j]); }
        if (item + (int)gridDim.x < 1024) f1_load(item + gridDim.x);
        __syncthreads();
        if (wave < 5) {
        const f32x2 tw = TW[l2 * k1];
        LAS unsigned char* ost = lds + 69632 + wave * 8448;
        u32x2 wim[16];
#pragma unroll
        for (int mt = 0; mt < 16; ++mt) {
            f32x4 cr = {0.f, 0.f, 0.f, 0.f}, cs = {0.f, 0.f, 0.f, 0.f};
#pragma unroll
            for (int ks = 0; ks < 4; ++ks) { const bf16x8 xa = ldfrag_sw(XT, 16 * mt, 4 * ks + q, lane); cr = MFMA16(xa, fc[ks], cr); cs = MFMA16(xa, fs[ks], cs); }
            const f32x4 br = cr * tw.x - cs * tw.y, bi = -(cs * tw.x + cr * tw.y);
            u32x2 wr_; wr_.x = pk2(br[0], br[1]); wr_.y = pk2(br[2], br[3]); wim[mt].x = pk2(bi[0], bi[1]); wim[mt].y = pk2(bi[2], bi[3]);
            *(LAS u32x2*)(ost + cidx * 528 + (16 * mt + 4 * q) * 2) = wr_;
        }
        const size_t obase = (((size_t)b * 128 + 16 * wave) * 128 + l2) * 1024 + ch0;
#pragma unroll
        for (int i = 0; i < 8; ++i) { const int row = 2 * i + (lane >> 5), ck = lane & 31; const u32x4 v = *(const LAS u32x4*)(ost + row * 528 + ck * 16); *(u32x4*)(A1r + obase + (size_t)row * 128 * 1024 + 8 * ck) = v; }
#pragma unroll
        for (int mt = 0; mt < 16; ++mt) *(LAS u32x2*)(ost + cidx * 528 + (16 * mt + 4 * q) * 2) = wim[mt];
#pragma unroll
        for (int i = 0; i < 8; ++i) { const int row = 2 * i + (lane >> 5), ck = lane & 31; const u32x4 v = *(const LAS u32x4*)(ost + row * 528 + ck * 16); *(u32x4*)(A1i + obase + (size_t)row * 128 * 1024 + 8 * ck) = v; }
        }
        __syncthreads();
    }
}
constexpr int F34_ITEMS = NB * 65 * 8;
__device__ __forceinline__ void phase_f34(const Args& a, LAS unsigned char* lds) {
    const int tid = opaque_tid(), lane = tid & 63, wave = __builtin_amdgcn_readfirstlane(tid >> 6), q = lane >> 4, cidx = lane & 15;
    const bf16* A1r = (const bf16*)(a.ws + WS_FA); const bf16* A1i = (const bf16*)(a.ws + WS_FAI); bf16* Y = (bf16*)(a.ws + WS_YCAT);
    LAS bf16* XTr = (LAS bf16*)lds; LAS bf16* XTi = XTr + 128 * FLD; LAS bf16* XKr = XTi + 128 * FLD; LAS bf16* XKi = XKr + 128 * FLD;
    bf16x8 fc[4], fs[4]; load_dft_frags(a.ws, wave, lane, fc, fs);
    const float nrm = 1.0f / 1448.15468787005f;
    u32x4 xr[4], xi[4];
    auto f34_load = [&](int item) { const int g = item & 7, k1 = (item >> 3) % 65, b = (item >> 3) / 65, ch0 = g * 128; const int cblk = tid & 15, lb = tid >> 4;
#pragma unroll
        for (int r = 0; r < 4; ++r) { const size_t off = (((size_t)b * 128 + k1) * 128 + 4 * lb + r) * 1024 + ch0 + 8 * cblk; xr[r] = *(const u32x4*)(A1r + off); xi[r] = *(const u32x4*)(A1i + off); } };
    if ((int)blockIdx.x < F34_ITEMS) f34_load(blockIdx.x);
    for (int item = blockIdx.x; item < F34_ITEMS; item += gridDim.x) {
        const int g = item & 7, k1 = (item >> 3) % 65, b = (item >> 3) / 65, ch0 = g * 128;
        { const int cblk = tid & 15, lb = tid >> 4; store_t4x8(XTr, 8 * cblk, 4 * lb, xr); store_t4x8(XTi, 8 * cblk, 4 * lb, xi); }
        if (item + (int)gridDim.x < F34_ITEMS) f34_load(item + gridDim.x);
        __syncthreads();
        const int k2 = 16 * wave + cidx;
#pragma unroll 2
        for (int mt = 0; mt < 8; ++mt) {
            f32x4 a1 = {0.f, 0.f, 0.f, 0.f}, a2 = a1, b1 = a1, b2 = a1;
#pragma unroll
            for (int ks = 0; ks < 4; ++ks) { const bf16x8 xa = ldfrag_sw(XTr, 16 * mt, 4 * ks + q, lane); const bf16x8 xb = ldfrag_sw(XTi, 16 * mt, 4 * ks + q, lane);
                a1 = MFMA16(xa, fc[ks], a1); b2 = MFMA16(xa, fs[ks], b2); a2 = MFMA16(xb, fs[ks], a2); b1 = MFMA16(xb, fc[ks], b1); }
            const f32x4 xre = a1 + a2, xim = b1 - b2;
            u32x2 wr_; wr_.x = pk2(xre[0], xre[1]); wr_.y = pk2(xre[2], xre[3]); u32x2 wi_; wi_.x = pk2(xim[0], xim[1]); wi_.y = pk2(xim[2], xim[3]);
            *(LAS u32x2*)(XKr + k2 * FLD + 16 * mt + 4 * q) = wr_; *(LAS u32x2*)(XKi + k2 * FLD + 16 * mt + 4 * q) = wi_;
        }
        __syncthreads();
#pragma unroll 2
        for (int nt = 0; nt < 8; ++nt) {
            f32x4 y = {0.f, 0.f, 0.f, 0.f};
#pragma unroll
            for (int ks = 0; ks < 4; ++ks) { const bf16x8 xa = *(const LAS bf16x8*)(XKr + (16 * nt + cidx) * FLD + ks * 32 + 8 * q); const bf16x8 xb = *(const LAS bf16x8*)(XKi + (16 * nt + cidx) * FLD + ks * 32 + 8 * q);
                y = MFMA16(fc[ks], xa, y); y = MFMA16(fs[ks], xb, y); }
            u32x2 w; w.x = pk2(y[0] * nrm, y[1] * nrm); w.y = pk2(y[2] * nrm, y[3] * nrm);
            *(LAS u32x2*)(XTr + (16 * nt + cidx) * FLD + 16 * wave + 4 * q) = w;
        }
        __syncthreads();
#pragma unroll
        for (int i = 0; i < 4; ++i) { const int task = tid + 512 * i, row = task >> 4, ck = task & 15; const u32x4 v = *(const LAS u32x4*)(XTr + row * FLD + 8 * ck);
            *(u32x4*)(Y + ((size_t)b * SEQ + k1 + 128 * row) * DM + 1024 + ch0 + 8 * ck) = v; }
        if (k1 >= 1 && k1 <= 63) {
#pragma unroll
            for (int i = 0; i < 4; ++i) { const int task = tid + 512 * i, row = task >> 4, ck = task & 15; const LAS bf16* sr = XTr + (127 - row) * FLD; unsigned e[8];
#pragma unroll
                for (int j = 0; j < 8; ++j) e[j] = sr[(128 - (8 * ck + j)) & 127];
                const u32x4 v = {e[0] | (e[1] << 16), e[2] | (e[3] << 16), e[4] | (e[5] << 16), e[6] | (e[7] << 16)};
                *(u32x4*)(Y + ((size_t)b * SEQ + (128 - k1) + 128 * row) * DM + 1024 + ch0 + 8 * ck) = v; }
        }
        __syncthreads();
    }
}

__device__ __forceinline__ void phase_topk(const Args& a, LAS unsigned char* lds) {
    const int tid = opaque_tid(), lane = tid & 63, wave = tid >> 6;
    LAS unsigned* keys = (LAS unsigned*)lds;
    LAS unsigned* hist = (LAS unsigned*)(lds + 65536);
    LAS unsigned* misc = hist + 256;
    LAS unsigned* wtot = misc + 16;
    const float* AFF = (const float*)(a.ws + WS_AFF); int* TOK = (int*)(a.ws + WS_TOK); float* GATE = (float*)(a.ws + WS_GATE); int* SEL = (int*)(a.ws + WS_SEL);
    for (int be = blockIdx.x; be < NB * NE; be += gridDim.x) {
        const int b = be / NE, e = be % NE;
        for (int i = tid; i < SEQ; i += NTHREADS) keys[i] = __float_as_uint(AFF[(size_t)be * SEQ + i]);
        unsigned prefix = 0u, pmask = 0u, krem = CAP;
        for (int pass = 0; pass < 4; ++pass) {
            const int shift = 24 - 8 * pass;
            if (tid < 256) hist[tid] = 0u;
            __syncthreads();
            for (int i = tid; i < SEQ; i += NTHREADS) { const unsigned k = keys[i]; if ((k & pmask) == prefix) __hip_atomic_fetch_add(&hist[(k >> shift) & 255u], 1u, __ATOMIC_RELAXED, __HIP_MEMORY_SCOPE_WORKGROUP); }
            __syncthreads();
            if (wave == 0) {
                const unsigned h0 = hist[4 * lane], h1 = hist[4 * lane + 1], h2 = hist[4 * lane + 2], h3 = hist[4 * lane + 3];
                const unsigned sl = h0 + h1 + h2 + h3; unsigned S = sl;
#pragma unroll
                for (int o = 1; o < 64; o <<= 1) { const unsigned t = __shfl_down(S, o); if (lane + o < 64) S += t; }
                const unsigned long long m = __ballot(S >= krem);
                const int ls = 63 - __builtin_clzll(m);
                if (lane == ls) { unsigned cum = S - sl; int bsel;
                    if (cum + h3 >= krem) bsel = 3; else { cum += h3; if (cum + h2 >= krem) bsel = 2; else { cum += h2; if (cum + h1 >= krem) bsel = 1; else { cum += h1; bsel = 0; } } }
                    misc[0] = prefix | ((unsigned)(4 * lane + bsel) << shift); misc[1] = krem - cum; }
            }
            __syncthreads();
            prefix = misc[0]; krem = misc[1]; pmask |= (0xffu << shift);
            __syncthreads();
        }
        const unsigned T = prefix;
        unsigned cg_ = 0u, ce = 0u;
        for (int i = 0; i < 32; ++i) { const unsigned k = keys[tid * 32 + i]; cg_ += (k > T); ce += (k == T); }
        unsigned ig = cg_, ie = ce;
#pragma unroll
        for (int o = 1; o < 64; o <<= 1) { const unsigned tg = __shfl_up(ig, o), te = __shfl_up(ie, o); if (lane >= o) { ig += tg; ie += te; } }
        if (lane == 63) { wtot[wave * 2] = ig; wtot[wave * 2 + 1] = ie; }
        __syncthreads();
        unsigned gt_before = ig - cg_, eq_before = ie - ce;
        for (int w8 = 0; w8 < wave; ++w8) { gt_before += wtot[w8 * 2]; eq_before += wtot[w8 * 2 + 1]; }
        for (int i = 0; i < 32; ++i) { const int t = tid * 32 + i; const unsigned k = keys[t];
            const bool isgt = k > T, iseq = k == T; const bool take = isgt || (iseq && eq_before < krem);
            const unsigned slot = gt_before + (eq_before < krem ? eq_before : krem);
            if (take) { TOK[(size_t)be * CAP + slot] = t; GATE[(size_t)be * CAP + slot] = __uint_as_float(k); }
            SEL[((size_t)b * SEQ + t) * NE + e] = take ? (int)slot : -1;
            gt_before += isgt; eq_before += iseq; }
        __syncthreads();
    }
}

__device__ __forceinline__ void acc_yrow8(f32x4 (&m)[8], const u32x2 (&w)[4], float gt) {
#pragma unroll
    for (int j = 0; j < 4; ++j) { const f32x2 a0 = __builtin_amdgcn_cvt_pk_f32_fp8((int)w[j].x, false), a1 = __builtin_amdgcn_cvt_pk_f32_fp8((int)w[j].x, true), a2 = __builtin_amdgcn_cvt_pk_f32_fp8((int)w[j].y, false), a3 = __builtin_amdgcn_cvt_pk_f32_fp8((int)w[j].y, true);
        m[2 * j].x += gt * a0.x; m[2 * j].y += gt * a0.y; m[2 * j].z += gt * a1.x; m[2 * j].w += gt * a1.y; m[2 * j + 1].x += gt * a2.x; m[2 * j + 1].y += gt * a2.y; m[2 * j + 1].z += gt * a3.x; m[2 * j + 1].w += gt * a3.y; }
}
__device__ __forceinline__ void phase_final(const Args& a) {
    const int tid = opaque_tid(), lane = tid & 63, wave = tid >> 6;
    if (PROBE_HALF && blockIdx.x >= gridDim.x / 2) return;
    const int gw = blockIdx.x * 8 + wave, NGW = (PROBE_HALF ? gridDim.x / 2 : gridDim.x) * 8;
    const float* ada = (const float*)(a.ws + WS_ADA); const float* fg = a.in[19];
    const bf16* DL = (const bf16*)(a.ws + WS_DLT); const unsigned char* YE = a.ws + WS_YE;
    const float* GATE = (const float*)(a.ws + WS_GATE); const int* SEL = (const int*)(a.ws + WS_SEL);
    int selA = -1, selB = -1;
    { const int r = gw; if (r < NLAT && lane < NE) selA = SEL[(size_t)r * NE + lane]; if (r + NGW < NLAT && lane < NE) selB = SEL[(size_t)(r + NGW) * NE + lane]; }
    for (int r0 = gw; r0 < NLAT; r0 += 2 * NGW) {
        const int rA = r0, rB = r0 + NGW; const bool hasB = rB < NLAT;
        const int bA = rA / SEQ, bB = hasB ? rB / SEQ : bA;
        u32x4 dlA[4], dlB[4];
#pragma unroll
        for (int j = 0; j < 4; ++j) { dlA[j] = *(const u32x4*)(DL + (size_t)rA * DM + 512 * j + 8 * lane); dlB[j] = *(const u32x4*)(DL + (size_t)(hasB ? rB : rA) * DM + 512 * j + 8 * lane); }
        const float gtA = selA >= 0 ? GATE[((size_t)bA * NE + lane) * CAP + selA] : 0.f, gtB = selB >= 0 ? GATE[((size_t)bB * NE + lane) * CAP + selB] : 0.f;
        const int rowA = selA >= 0 ? (lane * 2 + bA) * CAP + selA : 0, rowB = selB >= 0 ? (lane * 2 + bB) * CAP + selB : 0;
        unsigned long long mA = __ballot(selA >= 0), mB = __ballot(selB >= 0);
        { const int rn = r0 + 2 * NGW; selA = -1; selB = -1; if (rn < NLAT && lane < NE) selA = SEL[(size_t)rn * NE + lane]; if (rn + NGW < NLAT && lane < NE) selB = SEL[(size_t)(rn + NGW) * NE + lane]; }
        f32x4 accA[8], accB[8];
#pragma unroll
        for (int j = 0; j < 8; ++j) { accA[j] = (f32x4){0.f, 0.f, 0.f, 0.f}; accB[j] = (f32x4){0.f, 0.f, 0.f, 0.f}; }
        while (mA | mB) {
            const bool hA = mA != 0ull, hB = mB != 0ull;
            const int eA = hA ? __builtin_ctzll(mA) : 0, eB = hB ? __builtin_ctzll(mB) : 0; mA &= mA - 1; mB &= mB - 1;
            const int yrA = hA ? __builtin_amdgcn_readlane(rowA, eA) : 0, yrB = hB ? __builtin_amdgcn_readlane(rowB, eB) : 0;
            const float gA = hA ? __builtin_bit_cast(float, __builtin_amdgcn_readlane(__builtin_bit_cast(int, gtA), eA)) : 0.f;
            const float gB = hB ? __builtin_bit_cast(float, __builtin_amdgcn_readlane(__builtin_bit_cast(int, gtB), eB)) : 0.f;
            const unsigned char* y0 = YE + (size_t)yrA * DM + 8 * lane; const unsigned char* y1 = YE + (size_t)yrB * DM + 8 * lane;
            u32x2 w0[4], w1[4];
#pragma unroll
            for (int j = 0; j < 4; ++j) { w0[j] = *(const u32x2*)(y0 + 512 * j); w1[j] = *(const u32x2*)(y1 + 512 * j); }
            acc_yrow8(accA, w0, gA); acc_yrow8(accB, w1, gB);
        }
#pragma unroll
        for (int u = 0; u < 2; ++u) { if (u == 1 && !hasB) break;
            const int r = u ? rB : rA; const float* g2 = ada + (size_t)(u ? bB : bA) * 12288 + 5 * DM;
            float ss = 0.f; f32x4 m[8];
#pragma unroll
            for (int j = 0; j < 4; ++j) { const int d = 512 * j + 8 * lane; const f32x4 gv0 = *(const f32x4*)(g2 + d), gv1 = *(const f32x4*)(g2 + d + 4); const u32x4 dw = u ? dlB[j] : dlA[j];
                const f32x4 d0 = {__uint_as_float(dw.x << 16), __uint_as_float(dw.x & 0xffff0000u), __uint_as_float(dw.y << 16), __uint_as_float(dw.y & 0xffff0000u)};
                const f32x4 d1 = {__uint_as_float(dw.z << 16), __uint_as_float(dw.z & 0xffff0000u), __uint_as_float(dw.w << 16), __uint_as_float(dw.w & 0xffff0000u)};
                m[2 * j] = d0 + gv0 * (u ? accB[2 * j] : accA[2 * j]); m[2 * j + 1] = d1 + gv1 * (u ? accB[2 * j + 1] : accA[2 * j + 1]);
                ss += (m[2 * j].x * m[2 * j].x + m[2 * j].y * m[2 * j].y) + (m[2 * j].z * m[2 * j].z + m[2 * j].w * m[2 * j].w) + (m[2 * j + 1].x * m[2 * j + 1].x + m[2 * j + 1].y * m[2 * j + 1].y) + (m[2 * j + 1].z * m[2 * j + 1].z + m[2 * j + 1].w * m[2 * j + 1].w); }
            const float rstd = rsqrtf(wave_sum(ss) * (1.f / DM) + EPS);
#pragma unroll
            for (int j = 0; j < 4; ++j) { const int d = 512 * j + 8 * lane; const f32x4 gv0 = *(const f32x4*)(fg + d), gv1 = *(const f32x4*)(fg + d + 4);
                *(f32x4*)(a.out + (size_t)r * DM + d) = m[2 * j] * rstd * gv0; *(f32x4*)(a.out + (size_t)r * DM + d + 4) = m[2 * j + 1] * rstd * gv1; }
        }
    }
}

#define XB_TMO      128
#define XB_XCNT(j)  (256  + 64 * (j))
#define XB_XSUB(j)  (1280 + 64 * (j))
#define XB_XGEN(j)  (2304 + 64 * (j))
#define XB_TOP      3328
#define XB_TOPGEN   3392
#define XCD_BAR_WORDS 3456
#define XB_SPIN_CAP (1u << 18)
__device__ __forceinline__ unsigned xb_ld(unsigned* p)              { return __hip_atomic_load(p, __ATOMIC_RELAXED, __HIP_MEMORY_SCOPE_AGENT); }
__device__ __forceinline__ unsigned xb_add(unsigned* p, unsigned v) { return __hip_atomic_fetch_add(p, v, __ATOMIC_RELAXED, __HIP_MEMORY_SCOPE_AGENT); }
__device__ __forceinline__ unsigned xb_xcc_id() { return (unsigned)__builtin_amdgcn_s_getreg((3 << 11) | 20) & 0xFu; }
#define XB_SPIN(cond, bar) do { unsigned _sp = 0; while (cond) { __builtin_amdgcn_s_sleep(1); \
    if ((++_sp & 255u) == 0u) { if (xb_ld(&(bar)[XB_TMO])) break; if (_sp > XB_SPIN_CAP) { atomicAdd(&(bar)[XB_TMO], 1u); break; } } } } while (0)
struct XcdBarrier { unsigned* bar; unsigned x; volatile LAS unsigned* st; };
__device__ __forceinline__ XcdBarrier xcd_barrier_post(unsigned* bar, volatile LAS unsigned* st) {
    XcdBarrier b; b.bar = bar; b.x = xb_xcc_id(); b.st = st;
    if (threadIdx.x == 0) (void)xb_add(&bar[XB_XCNT(b.x)], 1u);
    return b;
}
__device__ __forceinline__ void xcd_barrier_complete(unsigned* bar, unsigned x, unsigned& nloc, unsigned& nx) {
    const unsigned G = gridDim.x * gridDim.y * gridDim.z;
    unsigned sum, cnt, mine, sp = 0u;
    for (;;) {
        sum = 0u; cnt = 0u; mine = 0u;
#pragma unroll
        for (unsigned j = 0; j < 16; ++j) { const unsigned c = xb_ld(&bar[XB_XCNT(j)]); sum += c; cnt += (c > 0u) ? 1u : 0u; mine = (j == x) ? c : mine; }
        if (sum == G) break;
        __builtin_amdgcn_s_sleep(1);
        if ((++sp & 255u) == 0u) { if (xb_ld(&bar[XB_TMO])) break; if (sp > XB_SPIN_CAP) { atomicAdd(&bar[XB_TMO], 1u); break; } }
    }
    nloc = mine > 0u ? mine : 1u; nx = cnt > 0u ? cnt : 1u;
}
__device__ __forceinline__ void xcd_barrier(const XcdBarrier& b) {
    asm volatile("s_waitcnt vmcnt(0)" ::: "memory");
    __syncthreads();
    if (threadIdx.x == 0) {
        unsigned* bar = b.bar;
        __builtin_amdgcn_s_waitcnt(0);
        unsigned nloc = b.st[0], nx = b.st[1];
        if (nloc == 0u) { xcd_barrier_complete(bar, b.x, nloc, nx); b.st[0] = nloc; b.st[1] = nx; }
        const unsigned old = xb_add(&bar[XB_XSUB(b.x)], 1u);
        const unsigned gen = old / nloc;
        if (old + 1u == (gen + 1u) * nloc) {
            __builtin_amdgcn_fence(__ATOMIC_RELEASE, "agent");
            asm volatile("s_waitcnt vmcnt(0)" ::: "memory");
            const unsigned og = xb_add(&bar[XB_TOP], 1u);
            const unsigned tg = og / nx;
            if (og + 1u == (tg + 1u) * nx) xb_add(&bar[XB_TOPGEN], 1u);
            else XB_SPIN(xb_ld(&bar[XB_TOPGEN]) == tg, bar);
            __builtin_amdgcn_fence(__ATOMIC_ACQUIRE, "agent");
            xb_add(&bar[XB_XGEN(b.x)], 1u);
            asm volatile("s_waitcnt vmcnt(0)" ::: "memory");
        } else {
            XB_SPIN(xb_ld(&bar[XB_XGEN(b.x)]) == gen, bar);
            __builtin_amdgcn_fence(__ATOMIC_ACQUIRE, "agent");
            asm volatile("s_waitcnt vmcnt(0)" ::: "memory");
        }
    }
    __syncthreads();
}

#ifndef STAGGER_US
#define STAGGER_US 0
#endif
__device__ __forceinline__ void gemm_stagger() {
    if (STAGGER_US > 0 && (blockIdx.x & 1)) { const unsigned long long t0 = __builtin_amdgcn_s_memrealtime();
        while (__builtin_amdgcn_s_memrealtime() - t0 < (unsigned long long)(STAGGER_US * 100)) __builtin_amdgcn_s_sleep(32); }
}
constexpr int NPHASES = 15;
__global__ void __launch_bounds__(NTHREADS, 2) mega(Args a) {
    extern __shared__ __attribute__((aligned(16))) unsigned char lds_raw[];
    LAS unsigned char* lds = (LAS unsigned char*)lds_raw;
    const int lo = a.ph_lo, hi = a.ph_hi;
    unsigned char* ws = a.ws;
#if USE_CG_SYNC
    cg::grid_group grid = cg::this_grid();
#define GRID_SYNC() grid.sync()
#else
    volatile LAS unsigned* bst = (volatile LAS unsigned*)(lds + LDS_BYTES - 16);
    if (threadIdx.x < 2) bst[threadIdx.x] = 0u;
    __syncthreads();
    XcdBarrier xbar = xcd_barrier_post((unsigned*)(ws + WS_CTL), bst);
#define GRID_SYNC() xcd_barrier(xbar)
#endif
#define IN(k) (lo <= (k) && (k) < hi)
#define SEAM(k) do { if (IN(k) && IN((k) + 1)) { GRID_SYNC(); if (PROBE_BAR) GRID_SYNC(); } } while (0)
#define PH(k, ...) do { if (IN(k)) { __VA_ARGS__; if ((PROBE_MASK >> (k)) & 1u) { GRID_SYNC(); __VA_ARGS__; } } SEAM(k); } while (0)
    PH(0, phase0(a, lds));
    PH(1, {
        finalize_ada(a);
        quantize_win(a);
        const int nsp = gridDim.x >= 64 ? 12 : 0, nreg = gridDim.x - nsp;
        if ((int)blockIdx.x >= nreg) {
            const int si = blockIdx.x - nreg, b = si / 6, pn = 2 + si % 6;
            if (threadIdx.x < 64) { unsigned* cnt = (unsigned*)(ws + WS_CTL) + CW_CTXCNT + 64 * b; unsigned sp = 0;
                while ((unsigned)__builtin_amdgcn_readfirstlane(__hip_atomic_load(cnt, __ATOMIC_RELAXED, __HIP_MEMORY_SCOPE_AGENT)) < 16u) { __builtin_amdgcn_s_sleep(4); if (++sp > (1u << 22)) break; }
                __builtin_amdgcn_fence(__ATOMIC_ACQUIRE, "agent");
                asm volatile("s_waitcnt vmcnt(0)" ::: "memory"); }
            __syncthreads();
            SchedOne S; S.A = (const char*)(ws + WS_H); S.B = (const char*)(ws + WS_WIN); S.tstep = (size_t)256 * DM * 2; S.pm = NLAT / 256 + b; S.pn = pn;
            EpiInProj E{ws};
            pg8::gemm_phase<EpiInProj, SchedOne, false, true, true>(lds, DM, S, E);
        } else phase_norm_tile<0>(a, lds, blockIdx.x, nreg, NROWS / 16); });
    PH(2, {
        if (gridDim.x >= 64) {
            if (INPROJ_BF16_TILES > 0) {
                SchedPlain S; S.init(NLAT / 256, INPROJ_BF16_TILES, gridDim.x, blockIdx.x); S.A = (const char*)(ws + WS_H); S.B = (const char*)(ws + WS_WIN); S.tstep = (size_t)256 * DM * 2;
                EpiInProj E{ws};
                pg8::gemm_phase<EpiInProj, SchedPlain, false, true, true>(lds, DM, S, E);
            }
            SchedPlain S; S.init(NLAT / 256, WIN_ROWS / 256 - INPROJ_BF16_TILES, gridDim.x, blockIdx.x, INPROJ_BF16_TILES); S.A = (const char*)(ws + WS_H8); S.B = (const char*)(ws + WS_WIN8); S.tstep = (size_t)256 * DM;
            EpiInProj8 E{ws};
            pg8::gemm_phase<EpiInProj8, SchedPlain, false, true, true, 2>(lds, DM / 2, S, E);
        } });
    PH(3, { for (int it = blockIdx.x; it < 288; it += gridDim.x) gla_passA128(a, lds, it); });
    PH(4, { gla_passB(a); phase_f1(a, lds); });
    PH(5, { for (int it = blockIdx.x; it < 256; it += gridDim.x) gla_passC(a, lds, it); });
    PH(6, phase_gla_merge(a));
    PH(8, phase_f34(a, lds));
    PH(9, {
        gemm_stagger();
        SchedPlain S; S.init(NLAT / 256, DM / 256, gridDim.x, blockIdx.x); S.A = (const char*)(ws + WS_YCAT); S.B = (const char*)(ws + WS_WOUT); S.tstep = (size_t)256 * DM * 2;
        EpiOutProj E{a.in[0], (bf16*)(ws + WS_DLT), (const float*)(ws + WS_ADA)};
        pg8::gemm_phase<EpiOutProj, SchedPlain, false, true, true>(lds, DM, S, E); });
    PH(10, phase_norm_tile<1>(a, lds, blockIdx.x, gridDim.x, NLAT / 16));
    PH(11, phase_topk(a, lds));
    PH(12, {
        gemm_stagger();
        SchedMoeUp S; S.init(256, 8, gridDim.x, blockIdx.x); S.A = (const char*)(ws + WS_HF); S.B = (const char*)(ws + WS_WGU); S.tok = (const int*)(ws + WS_TOK);
        EpiSwiglu E{ws + WS_HID};
        pg8::gemm_phase<EpiSwiglu, SchedMoeUp, true, true, true, 1>(lds, DM / 2, S, E); });
    PH(13, {
        gemm_stagger();
        SchedMoeDown S; S.init(256, 8, gridDim.x, blockIdx.x); S.A = (const char*)(ws + WS_HID); S.B = (const char*)(ws + WS_WD);
        EpiF8 E{ws + WS_YE, DM, 1.f / W8_SCALE};
        pg8::gemm_phase<EpiF8, SchedMoeDown, true, true, true, 1>(lds, DEXP / 2, S, E); });
    PH(14, phase_final(a));
#undef PH
#undef IN
#undef SEAM
}

#ifndef N_LAUNCH_MODE
#define N_LAUNCH_MODE 1
#endif
extern "C" void kernel_launch(void* const* d_in, const int* in_sizes, int n_in, void* d_out, int out_size, void* d_ws, size_t ws_size, hipStream_t stream) {
    static int grid = 0;
    if (grid == 0) {
        if (n_in != 20 || out_size != NLAT * DM || ws_size < WS_END) { fprintf(stderr, "kernel_launch: unexpected sizes n_in %d out %d ws %zu\n", n_in, out_size, ws_size); grid = -1; return; }
        int dev = 0, cus = 0, per_cu = 0;
        (void)hipGetDevice(&dev); (void)hipDeviceGetAttribute(&cus, hipDeviceAttributeMultiprocessorCount, dev);
        if (hipFuncSetAttribute((const void*)mega, hipFuncAttributeMaxDynamicSharedMemorySize, LDS_BYTES) != hipSuccess) { fprintf(stderr, "kernel_launch: hipFuncSetAttribute failed\n"); grid = -1; return; }
        (void)hipOccupancyMaxActiveBlocksPerMultiprocessor(&per_cu, (const void*)mega, NTHREADS, LDS_BYTES);
        if (per_cu < 1) { fprintf(stderr, "kernel_launch: occupancy query reports %d blocks per CU\n", per_cu); per_cu = 1; }
        (void)hipGetLastError();
        grid = cus * 1;
    }
    if (grid < 0) return;
    Args a{};
    for (int i = 0; i < 20; ++i) a.in[i] = (const float*)d_in[i];
    a.out = (float*)d_out; a.ws = (unsigned char*)d_ws;
#if N_LAUNCH_MODE == 0
    for (int p = 0; p < NPHASES; ++p) { a.ph_lo = p; a.ph_hi = p + 1; hipLaunchKernelGGL(mega, dim3(grid), dim3(NTHREADS), LDS_BYTES, stream, a); }
#else
    a.ph_lo = 0; a.ph_hi = NPHASES;
#if USE_CG_SYNC
    void* args[] = {&a};
    hipError_t e = hipLaunchCooperativeKernel((void*)mega, dim3(grid), dim3(NTHREADS), args, LDS_BYTES, stream);
    if (e != hipSuccess) fprintf(stderr, "cooperative launch failed: %s (grid %d)\n", hipGetErrorString(e), grid);
#else
    if (hipMemsetAsync((char*)d_ws + WS_CTL, 0, CTL_BYTES, stream) != hipSuccess) { fprintf(stderr, "kernel_launch: memset of control words failed\n"); return; }
    hipLaunchKernelGGL(mega, dim3(grid), dim3(NTHREADS), LDS_BYTES, stream, a);
#endif
#endif
}
```

```cpp
#include <hip/hip_runtime.h>
#include <hip/hip_cooperative_groups.h>
#include <cstdio>
#include <cstdint>
namespace cg = cooperative_groups;

#define LAS __attribute__((address_space(3)))
typedef unsigned short bf16;
typedef short bf16x8 __attribute__((ext_vector_type(8)));
typedef float f32x4 __attribute__((ext_vector_type(4)));
typedef float f32x2 __attribute__((ext_vector_type(2)));
typedef unsigned u32x4 __attribute__((ext_vector_type(4)));
typedef unsigned u32x2 __attribute__((ext_vector_type(2)));
typedef int i32x4 __attribute__((ext_vector_type(4)));
typedef int i32x8 __attribute__((ext_vector_type(8)));

constexpr int NB = 2, SEQ = 16384, DM = 2048, CTXL = 256;
constexpr int NLAT = NB * SEQ;
constexpr int NROWS = NLAT + NB * CTXL;
constexpr int PROJW = 4128;
constexpr int NE = 16, CAP = 2048, DEXP = 1024;
constexpr int PW = 4096;
constexpr int WIN_ROWS = 4096;
constexpr float EPS = 1e-6f;

constexpr size_t MiB = 1u << 20;
constexpr size_t WS_ADA = 0;
constexpr size_t WS_TW = 1 * MiB;
constexpr size_t WS_FC = 1 * MiB + 256 * 1024;
constexpr size_t WS_FS = 1 * MiB + 320 * 1024;
constexpr size_t WS_WRH = 1 * MiB + 384 * 1024;
constexpr size_t WS_WRL = 1 * MiB + 448 * 1024;
constexpr size_t WS_Z = 2 * MiB;
constexpr size_t WS_AFF = 8 * MiB;
constexpr size_t WS_TOK = 10 * MiB;
constexpr size_t WS_GATE = 11 * MiB;
constexpr size_t WS_SEL = 12 * MiB;
constexpr size_t WS_ST0 = 14 * MiB;
constexpr size_t WS_CTL = 16 * MiB;
constexpr size_t CTL_BYTES = 65536;
constexpr size_t WS_ADAP = 20 * MiB;
constexpr size_t WS_TC = 24 * MiB;
constexpr size_t WS_DTC = 28 * MiB;
constexpr size_t WS_WIN = 32 * MiB;
constexpr size_t WS_WOUT = 50 * MiB;
constexpr size_t WS_WGU = 58 * MiB;
constexpr size_t WS_WD = 186 * MiB;
constexpr int KTOK = SEQ + CTXL;
constexpr size_t WS_QH = 250 * MiB;
constexpr size_t WS_KH = 282 * MiB;
constexpr size_t WS_VH = 316 * MiB;
constexpr size_t WS_G = 382 * MiB;
constexpr size_t WS_U = 446 * MiB;
constexpr size_t WS_HF = 250 * MiB;
constexpr size_t WS_HID = 378 * MiB;
constexpr size_t WS_FX = 250 * MiB;
constexpr size_t WS_FA = 894 * MiB;
constexpr size_t WS_FAI = 958 * MiB;
constexpr size_t WS_H = 510 * MiB;
constexpr size_t WS_H8 = 640 * MiB;
constexpr size_t WS_WIN8 = 704 * MiB;
constexpr size_t WS_RS = 712 * MiB;
constexpr size_t WS_CS = 713 * MiB;
#ifndef INPROJ_BF16_TILES
#define INPROJ_BF16_TILES 0
#endif
constexpr size_t WS_OF = 510 * MiB;
constexpr size_t WS_OB = 574 * MiB;
constexpr size_t WS_T = 638 * MiB;
constexpr size_t WS_SST = 670 * MiB;
constexpr size_t WS_DT = 702 * MiB;
constexpr size_t WS_DLT = 510 * MiB;
constexpr size_t WS_YCAT = 766 * MiB;
constexpr size_t WS_YE = 766 * MiB;
constexpr size_t WS_END = 1022 * MiB;

#ifndef USE_CG_SYNC
#define USE_CG_SYNC 0
#endif
#ifndef PROBE_HALF
#define PROBE_HALF 0
#endif
#ifndef KSNAKE
#define KSNAKE 0
#endif
#ifndef PROBE_BAR
#define PROBE_BAR 0
#endif
#ifndef PROBE_HOT
#define PROBE_HOT 0
#endif
#ifndef PROBE_K
#define PROBE_K 0
#endif
#ifndef PROBE_EPI
#define PROBE_EPI 0
#endif
#ifndef PROBE_P0
#define PROBE_P0 0
#endif
#ifndef PROBE_MASK
#define PROBE_MASK 0u
#endif
constexpr int LDS_BYTES = 163840;
constexpr int NTHREADS = 512;

struct Args {
    const float* in[20];
    float* out;
    unsigned char* ws;
    int ph_lo, ph_hi;
};

__device__ __forceinline__ float bf2f(bf16 v) { return __uint_as_float(((unsigned)v) << 16); }
typedef __bf16 bf16x2_t __attribute__((ext_vector_type(2)));
__device__ __forceinline__ unsigned pk2(float lo, float hi) { const f32x2 v = {lo, hi}; return __builtin_bit_cast(unsigned, __builtin_convertvector(v, bf16x2_t)); }
__device__ __forceinline__ unsigned f2bf(float f) { return pk2(f, 0.f) & 0xffffu; }
__device__ __forceinline__ unsigned pk4_fp8(float a, float b, float c, float d) { unsigned r = 0u; r = (unsigned)__builtin_amdgcn_cvt_pk_fp8_f32(a, b, (int)r, false); r = (unsigned)__builtin_amdgcn_cvt_pk_fp8_f32(c, d, (int)r, true); return r; }
__device__ __forceinline__ unsigned pk4_i8(float a, float b, float c, float d) {
    const int ia = (int)rintf(a), ib = (int)rintf(b), ic = (int)rintf(c), id = (int)rintf(d);
    return ((unsigned)ia & 0xffu) | (((unsigned)ib & 0xffu) << 8) | (((unsigned)ic & 0xffu) << 16) | ((unsigned)id << 24);
}
constexpr float W8_SCALE = 64.f;
__device__ __forceinline__ int opaque_tid() { int t = threadIdx.x; asm volatile("" : "+v"(t)); return t; }
__device__ __forceinline__ float wave_sum(float v) {
#pragma unroll
    for (int o = 1; o < 64; o <<= 1) v += __shfl_xor(v, o);
    return v;
}
__device__ __forceinline__ float silu_f(float x) { return x / (1.f + __expf(-x)); }
__device__ __forceinline__ float logsigmoid_f(float x) { return fminf(x, 0.f) - log1pf(expf(-fabsf(x))); }

namespace pg8 {
constexpr int BM = 256, BK = 64, HALF = 128, HTB = HALF * BK * 2, STAGE_BYTES = 8 * HTB, NXCD = 8, WGM = 8;
__host__ __device__ __forceinline__ int lds_byte(int r, int c) { const int st = (r >> 4) * 2 + (c >> 5), rr = r & 15, cc = c & 31, ob = rr * 64 + cc * 2; return st * 1024 + (ob ^ (((ob >> 9) & 1) << 5)); }
__host__ __device__ __forceinline__ void stage_rc(int b, int& R, int& C) { const int st = b / 1024, sb = b % 1024, swz = sb ^ (((sb >> 9) & 1) << 5); R = (st >> 1) * 16 + swz / 64; C = (st & 1) * 32 + (swz % 64) / 2; }
__host__ __device__ __forceinline__ int perm32(int rho) { const int n = rho >> 4, i = rho & 15; return 8 * (i >> 2) + 4 * n + (i & 3); }
struct Unit { int pm, pn; };
__device__ __forceinline__ unsigned cvt_pk_bf16(float lo, float hi) { return pk2(lo, hi); }

struct OrderBase {
    int nM, nN, nwg, G, c, pn0;
    __device__ void init(int nM_, int nN_, int G_, int c_, int pn0_ = 0) { nM = nM_; nN = nN_; nwg = nM * nN; G = G_; c = c_; pn0 = pn0_; }
    __device__ bool next(int i, Unit& u) const {
        const long L = (long)(i >> PROBE_K) * G + c; if (L >= nwg) return false;
        int wgid = (int)L; { const int q = nwg / NXCD, r = nwg % NXCD, xcd = wgid % NXCD, off = wgid / NXCD; wgid = (xcd < r ? xcd * (q + 1) : r * (q + 1) + (xcd - r) * q) + off; }
        const int nig = WGM * nN, gid = wgid / nig, fm = gid * WGM, gsz = (nM - fm) < WGM ? (nM - fm) : WGM;
        u.pm = fm + ((wgid % nig) % gsz); u.pn = pn0 + (wgid % nig) / gsz; if (PROBE_K && PROBE_HOT && !(i & 1)) { u.pm = 0; u.pn = pn0; } return true;
    }
};

template <class Epi, class Sched, bool GATHER, bool ALIGN_EPI, bool SP2, int PREC = 0>
__device__ __forceinline__ void gemm_phase(LAS unsigned char* lds, const int K, const Sched& S, const Epi& E) {
    const int tid = opaque_tid(), wid = __builtin_amdgcn_readfirstlane(tid >> 6), lane = tid & 63, wr = wid >> 2, wc = wid & 3, fr = lane & 15, fq = lane >> 4;
    int nt = K / BK;
    constexpr bool FP8 = PREC == 1;
    if constexpr (PREC != 0) asm volatile("" : "+s"(nt));
    unsigned voffA[2], voffA1[2], voffB[2];
    int RA[2], CA[2];
#pragma unroll
    for (int i = 0; i < 2; ++i) { int R, C; stage_rc(tid * 16 + i * 8192, R, C); const int Rb = Epi::PERM2 ? (64 * (R >> 5) + perm32(R & 31)) : (Epi::PERM ? ((R & ~31) + perm32(R & 31)) : R);
        RA[i] = R; CA[i] = C;
        voffA[i] = (unsigned)(R * K + C) * 2u; voffA1[i] = voffA[i]; voffB[i] = (unsigned)(Rb * K + C) * 2u; }
    const size_t kstep = (size_t)(BK * 2);
    const size_t hstepA = GATHER ? 0 : (size_t)HALF * K * 2;
    const size_t hstep = (size_t)(Epi::PERM2 ? 32 : HALF) * K * 2;
    const unsigned ldsw = (unsigned)wid * 1024u;
    const int aoff = lds_byte(wr * 64 + fr, fq * 8), boff = lds_byte(wc * 32 + fr, fq * 8);
#define PG8_SA(b, h) (((b) * 2 + (h)) * HTB)
#define PG8_SB(b, h) ((4 + (b) * 2 + (h)) * HTB)
#define PG8_STAGE(bufoff, gbase, voff) do { _Pragma("unroll") for (int _i = 0; _i < 2; ++_i) \
        __builtin_amdgcn_global_load_lds((const unsigned*)((const char*)(gbase) + (voff)[_i]), (LAS unsigned*)(lds + (bufoff) + ldsw + _i * 8192), 16, 0, 0); } while (0)
#define PG8_LDA(dst, b, h) do { _Pragma("unroll") for (int m = 0; m < 4; ++m) _Pragma("unroll") for (int k = 0; k < 2; ++k) dst[m][k] = *(const LAS bf16x8*)(lds + PG8_SA(b, h) + aoff + m * 2048 + k * 1024); } while (0)
#define PG8_LDB(dst, b, h) do { _Pragma("unroll") for (int n = 0; n < 2; ++n) _Pragma("unroll") for (int k = 0; k < 2; ++k) dst[n][k] = *(const LAS bf16x8*)(lds + PG8_SB(b, h) + boff + n * 2048 + k * 1024); } while (0)
#define PG8_CAT8(lo, hi) __builtin_shufflevector(__builtin_bit_cast(i32x4, (lo)), __builtin_bit_cast(i32x4, (hi)), 0, 1, 2, 3, 4, 5, 6, 7)
#define PG8_MMA(ai, bj, At, Bt) do { __builtin_amdgcn_s_setprio(1); \
        if constexpr (FP8) { _Pragma("unroll") for (int m = 0; m < 4; ++m) _Pragma("unroll") for (int n = 0; n < 2; ++n) \
            acc[ai][bj][m][n] = __builtin_amdgcn_mfma_scale_f32_16x16x128_f8f6f4(PG8_CAT8(Bt[n][0], Bt[n][1]), PG8_CAT8(At[m][0], At[m][1]), acc[ai][bj][m][n], 0, 0, 0, 0x7f7f7f7f, 0, 0x7f7f7f7f); } \
        else if constexpr (PREC == 2) { _Pragma("unroll") for (int m = 0; m < 4; ++m) _Pragma("unroll") for (int n = 0; n < 2; ++n) _Pragma("unroll") for (int k = 0; k < 2; ++k) \
            acc[ai][bj][m][n] = __builtin_bit_cast(f32x4, __builtin_amdgcn_mfma_i32_16x16x64_i8(__builtin_bit_cast(i32x4, Bt[n][k]), __builtin_bit_cast(i32x4, At[m][k]), __builtin_bit_cast(i32x4, acc[ai][bj][m][n]), 0, 0, 0)); } \
        else { _Pragma("unroll") for (int m = 0; m < 4; ++m) _Pragma("unroll") for (int n = 0; n < 2; ++n) _Pragma("unroll") for (int k = 0; k < 2; ++k) \
            acc[ai][bj][m][n] = __builtin_amdgcn_mfma_f32_16x16x32_bf16(Bt[n][k], At[m][k], acc[ai][bj][m][n], 0, 0, 0); } \
        __builtin_amdgcn_s_setprio(0); } while (0)
#define PG8_WAIT_V(n) asm volatile("s_waitcnt vmcnt(" #n ")" ::: "memory")
#define PG8_WAIT_L(n) asm volatile("s_waitcnt lgkmcnt(" #n ")" ::: "memory")
#define PG8_BAR __builtin_amdgcn_s_barrier()
#define PG8_SCHED __builtin_amdgcn_sched_barrier(0)
    Unit cur, nxt; int ui = 0;
    if (!S.next(0, cur)) return;
    f32x4 acc[2][2][4][2];
#pragma unroll
    for (int a = 0; a < 2; ++a)
#pragma unroll
        for (int b = 0; b < 2; ++b)
#pragma unroll
            for (int m = 0; m < 4; ++m)
#pragma unroll
                for (int n = 0; n < 2; ++n) acc[a][b][m][n] = (f32x4){0.f, 0.f, 0.f, 0.f};
    bf16x8 At[4][2], B0[2][2], B1[2][2];
    const long kspan = (long)(nt - 1) * (long)(BK * 2);
    long ck = (long)(BK * 2);
    const char* cA = S.abase(cur); const char* cB = S.bbase(cur);
    if constexpr (GATHER) {
#pragma unroll
        for (int i = 0; i < 2; ++i) { voffA[i] = ((unsigned)S.arow(cur, RA[i]) * (unsigned)K + (unsigned)CA[i]) * 2u; voffA1[i] = ((unsigned)S.arow(cur, HALF + RA[i]) * (unsigned)K + (unsigned)CA[i]) * 2u; }
    }
    static_assert(SP2, "only the SP2 loop is kept");
    PG8_STAGE(PG8_SB(0, 0), cB, voffB); PG8_STAGE(PG8_SB(0, 1), cB + hstep, voffB); PG8_STAGE(PG8_SA(0, 0), cA, voffA); PG8_STAGE(PG8_SA(0, 1), cA + hstepA, voffA1);
    if (wr == 1) PG8_BAR;
    PG8_WAIT_V(2); PG8_BAR;
    PG8_STAGE(PG8_SB(1, 0), cB + kstep, voffB); PG8_STAGE(PG8_SA(1, 0), cA + kstep, voffA); PG8_STAGE(PG8_SB(1, 1), cB + hstep + kstep, voffB);
    PG8_WAIT_V(6); PG8_BAR;
    for (;;) {
        const bool has_next = S.next(ui + 1, nxt);
        const bool nrev = KSNAKE && has_next && (((ui + 1) >> PROBE_K) & 1);
        const long nk = has_next ? (nrev ? -(long)(BK * 2) : (long)(BK * 2)) : ck;
        const char* nA = has_next ? S.abase(nxt) + (nrev ? kspan : 0) : cA; const char* nB = has_next ? S.bbase(nxt) + (nrev ? kspan : 0) : cB;
        for (int t = 0; t < nt; t += 2) {
            const bool last = (t == nt - 2);
            const char* a1 = cA + (long)(t + 1) * ck;
            const char* a2 = last ? nA : cA + (long)(t + 2) * ck; const char* b2 = last ? nB : cB + (long)(t + 2) * ck;
            const char* a3 = a2 + (last ? nk : ck); const char* b3 = b2 + (last ? nk : ck);
            PG8_LDB(B0, 0, 0); PG8_LDB(B1, 0, 1); PG8_SCHED; PG8_LDA(At, 0, 0); PG8_STAGE(PG8_SA(1, 1), a1 + hstepA, voffA1);
            if constexpr (GATHER) { if (last && has_next) {
#pragma unroll
                for (int i = 0; i < 2; ++i) { voffA[i] = ((unsigned)S.arow(nxt, RA[i]) * (unsigned)K + (unsigned)CA[i]) * 2u; voffA1[i] = ((unsigned)S.arow(nxt, HALF + RA[i]) * (unsigned)K + (unsigned)CA[i]) * 2u; } } }
            PG8_WAIT_V(8); PG8_WAIT_L(0); PG8_BAR; PG8_MMA(0, 0, At, B0); PG8_MMA(0, 1, At, B1); PG8_BAR; PG8_SCHED;
            PG8_LDA(At, 0, 1); PG8_STAGE(PG8_SB(0, 0), b2, voffB); PG8_STAGE(PG8_SB(0, 1), b2 + hstep, voffB); PG8_STAGE(PG8_SA(0, 0), a2, voffA);
            PG8_WAIT_V(8); PG8_WAIT_L(0); PG8_BAR; PG8_MMA(1, 0, At, B0); PG8_MMA(1, 1, At, B1); PG8_BAR; PG8_SCHED;
            PG8_LDB(B0, 1, 0); PG8_LDB(B1, 1, 1); PG8_SCHED; PG8_LDA(At, 1, 0); PG8_STAGE(PG8_SA(0, 1), a2 + hstepA, voffA1);
            PG8_WAIT_V(8); PG8_WAIT_L(0); PG8_BAR; PG8_MMA(0, 0, At, B0); PG8_MMA(0, 1, At, B1); PG8_BAR; PG8_SCHED;
            PG8_LDA(At, 1, 1); PG8_STAGE(PG8_SB(1, 0), b3, voffB); PG8_STAGE(PG8_SB(1, 1), b3 + hstep, voffB); PG8_STAGE(PG8_SA(1, 0), a3, voffA);
            PG8_WAIT_V(8); PG8_WAIT_L(0); PG8_BAR; PG8_MMA(1, 0, At, B0); PG8_MMA(1, 1, At, B1); PG8_BAR; PG8_SCHED;
        }
        if constexpr (ALIGN_EPI) { if (wr == 0) PG8_BAR; }
        if (!PROBE_K || (ui & 1)) E(acc, cur, wr, wc, fr, fq);
        if (PROBE_EPI == 1) { asm volatile("" ::: "memory"); E(acc, cur, wr, wc, fr, fq); }
        if (PROBE_EPI == 2) { asm volatile("s_waitcnt vmcnt(0)" ::: "memory"); }
        if (!has_next) break;
#pragma unroll
        for (int a = 0; a < 2; ++a)
#pragma unroll
            for (int b = 0; b < 2; ++b)
#pragma unroll
                for (int m = 0; m < 4; ++m)
#pragma unroll
                    for (int n = 0; n < 2; ++n) acc[a][b][m][n] = (f32x4){0.f, 0.f, 0.f, 0.f};
        cur = nxt; cA = nA; cB = nB; ck = nk; ++ui;
        if constexpr (ALIGN_EPI) { if (wr == 1) PG8_BAR; }
    }
    PG8_WAIT_V(0);
    if constexpr (!ALIGN_EPI) { if (wr == 0) PG8_BAR; }
    PG8_BAR;
#undef PG8_SA
#undef PG8_SB
#undef PG8_STAGE
#undef PG8_LDA
#undef PG8_LDB
#undef PG8_MMA
#undef PG8_CAT8
#undef PG8_WAIT_V
#undef PG8_WAIT_L
#undef PG8_BAR
#undef PG8_SCHED
}
}
using pg8::Unit;
using pg8::cvt_pk_bf16;
constexpr int HALF = pg8::HALF, BM = pg8::BM;

struct SchedPlain : pg8::OrderBase {
    const char* A; const char* B; size_t tstep;
    __device__ __forceinline__ const char* abase(const Unit& u) const { return A + (size_t)u.pm * tstep; }
    __device__ __forceinline__ const char* bbase(const Unit& u) const { return B + (size_t)u.pn * tstep; }
    __device__ __forceinline__ int arow(const Unit&, int) const { return 0; }
};
struct SchedOne {
    const char* A; const char* B; size_t tstep; int pm, pn;
    __device__ __forceinline__ bool next(int i, Unit& u) const { if ((i >> PROBE_K) != 0) return false; u.pm = pm; u.pn = pn; return true; }
    __device__ __forceinline__ const char* abase(const Unit& u) const { return A + (size_t)u.pm * tstep; }
    __device__ __forceinline__ const char* bbase(const Unit& u) const { return B + (size_t)u.pn * tstep; }
    __device__ __forceinline__ int arow(const Unit&, int) const { return 0; }
};
struct SchedMoeUp : pg8::OrderBase {
    const char* A; const char* B; const int* tok;
    __device__ __forceinline__ const char* abase(const Unit&) const { return A; }
    __device__ __forceinline__ const char* bbase(const Unit& u) const { return B + ((size_t)(u.pm >> 4) * 2048 + (size_t)u.pn * 256) * (size_t)DM; }
    __device__ __forceinline__ int arow(const Unit& u, int r) const { const int e = u.pm >> 4, b = (u.pm >> 3) & 1, mt = u.pm & 7; return b * SEQ + tok[(b * NE + e) * CAP + mt * 256 + r]; }
};
struct SchedMoeDown : pg8::OrderBase {
    const char* A; const char* B;
    __device__ __forceinline__ const char* abase(const Unit&) const { return A; }
    __device__ __forceinline__ const char* bbase(const Unit& u) const { return B + ((size_t)(u.pm >> 4) * 2048 + (size_t)u.pn * 256) * (size_t)DEXP; }
    __device__ __forceinline__ int arow(const Unit& u, int r) const { return u.pm * 256 + r; }
};

__device__ __forceinline__ u32x4 swz_xor8(const u32x4 v) { u32x4 r;
    r.x = (unsigned)__builtin_amdgcn_ds_swizzle((int)v.x, 0x201F); r.y = (unsigned)__builtin_amdgcn_ds_swizzle((int)v.y, 0x201F);
    r.z = (unsigned)__builtin_amdgcn_ds_swizzle((int)v.z, 0x201F); r.w = (unsigned)__builtin_amdgcn_ds_swizzle((int)v.w, 0x201F); return r; }
__device__ __forceinline__ void store_pair_rows(bf16* rowp, size_t ld, int fr, const u32x4 w0, const u32x4 w1) {
    const bool hi = (fr & 8) != 0;
    const u32x4 r = swz_xor8(hi ? w0 : w1);
    bf16* p = rowp + (hi ? 32 : 0);
    *(u32x4*)(p) = hi ? r : w0;
    *(u32x4*)(p + 8 * ld) = hi ? w1 : r;
}
struct EpiInProj {
    static constexpr bool PERM = true, PERM2 = true;
    unsigned char* ws;
    __device__ __forceinline__ void operator()(const f32x4 (&acc)[2][2][4][2], const Unit& u, int wr, int wc, int fr, int fq) const {
        const int ct = wc * 64 + 8 * fq;
        const bool lat = u.pm < NLAT / 256; const int b = lat ? u.pm / (SEQ / 256) : u.pm - NLAT / 256, t0 = lat ? (u.pm % (SEQ / 256)) * 256 : SEQ;
        if (!lat && (u.pn < 2 || u.pn >= 8)) return;
        bf16* base; size_t ld;
        if (u.pn < 2) { const int h = 2 * u.pn + (ct >> 7); base = (bf16*)(ws + WS_QH) + ((size_t)(b * 4 + h) * SEQ + t0) * 128 + (ct & 127); ld = 128; }
        else if (u.pn < 4) { const int h = 2 * (u.pn - 2) + (ct >> 7); base = (bf16*)(ws + WS_KH) + ((size_t)(b * 4 + h) * KTOK + t0) * 128 + (ct & 127); ld = 128; }
        else if (u.pn < 8) { const int h = u.pn - 4; base = (bf16*)(ws + WS_VH) + ((size_t)(b * 4 + h) * KTOK + t0) * 256 + ct; ld = 256; }
        else if (u.pn < 12) { base = (bf16*)(ws + WS_G) + (size_t)(u.pm * BM) * 1024 + (u.pn - 8) * 256 + ct; ld = 1024; }
        else { base = (bf16*)(ws + WS_U) + (size_t)(u.pm * BM) * 1024 + (u.pn - 12) * 256 + ct; ld = 1024; }
#pragma unroll
        for (int ai = 0; ai < 2; ++ai)
#pragma unroll
            for (int m = 0; m < 4; ++m) { bf16* rowp = base + (size_t)(wr * 64 + ai * HALF + m * 16 + (fr & 7)) * ld;
                u32x4 w[2];
#pragma unroll
                for (int bj = 0; bj < 2; ++bj) { const f32x4 v0 = acc[ai][bj][m][0], v1 = acc[ai][bj][m][1];
                    w[bj].x = cvt_pk_bf16(v0[0], v0[1]); w[bj].y = cvt_pk_bf16(v0[2], v0[3]); w[bj].z = cvt_pk_bf16(v1[0], v1[1]); w[bj].w = cvt_pk_bf16(v1[2], v1[3]); }
                store_pair_rows(rowp, ld, fr, w[0], w[1]); }
    }
};
struct EpiInProj8 {
    static constexpr bool PERM = true, PERM2 = true;
    unsigned char* ws;
    __device__ __forceinline__ void operator()(const f32x4 (&acc)[2][2][4][2], const Unit& u, int wr, int wc, int fr, int fq) const {
        const int ct = wc * 64 + 8 * fq;
        const int b = u.pm / (SEQ / 256), t0 = (u.pm % (SEQ / 256)) * 256;
        bf16* base; size_t ld;
        if (u.pn < 2) { const int h = 2 * u.pn + (ct >> 7); base = (bf16*)(ws + WS_QH) + ((size_t)(b * 4 + h) * SEQ + t0) * 128 + (ct & 127); ld = 128; }
        else if (u.pn < 4) { const int h = 2 * (u.pn - 2) + (ct >> 7); base = (bf16*)(ws + WS_KH) + ((size_t)(b * 4 + h) * KTOK + t0) * 128 + (ct & 127); ld = 128; }
        else if (u.pn < 8) { const int h = u.pn - 4; base = (bf16*)(ws + WS_VH) + ((size_t)(b * 4 + h) * KTOK + t0) * 256 + ct; ld = 256; }
        else if (u.pn < 12) { base = (bf16*)(ws + WS_G) + (size_t)(u.pm * BM) * 1024 + (u.pn - 8) * 256 + ct; ld = 1024; }
        else { base = (bf16*)(ws + WS_U) + (size_t)(u.pm * BM) * 1024 + (u.pn - 12) * 256 + ct; ld = 1024; }
        const float* cs = (const float*)(ws + WS_CS) + u.pn * BM + ct; const float* rs = (const float*)(ws + WS_RS) + u.pm * BM + wr * 64 + fr;
        f32x4 cv[2][2];
#pragma unroll
        for (int bj = 0; bj < 2; ++bj)
#pragma unroll
            for (int n = 0; n < 2; ++n) cv[bj][n] = *(const f32x4*)(cs + 32 * bj + 4 * n);
#pragma unroll
        for (int ai = 0; ai < 2; ++ai)
#pragma unroll
            for (int m = 0; m < 4; ++m) { bf16* rowp = base + (size_t)(wr * 64 + ai * HALF + m * 16 + (fr & 7)) * ld; const float sr = rs[ai * HALF + m * 16];
                u32x4 w[2];
#pragma unroll
                for (int bj = 0; bj < 2; ++bj) { const i32x4 i0 = __builtin_bit_cast(i32x4, acc[ai][bj][m][0]), i1 = __builtin_bit_cast(i32x4, acc[ai][bj][m][1]);
                    const f32x4 v0 = __builtin_convertvector(i0, f32x4) * cv[bj][0] * sr, v1 = __builtin_convertvector(i1, f32x4) * cv[bj][1] * sr;
                    w[bj].x = cvt_pk_bf16(v0[0], v0[1]); w[bj].y = cvt_pk_bf16(v0[2], v0[3]); w[bj].z = cvt_pk_bf16(v1[0], v1[1]); w[bj].w = cvt_pk_bf16(v1[2], v1[3]); }
                store_pair_rows(rowp, ld, fr, w[0], w[1]); }
    }
};
struct EpiOutProj {
    static constexpr bool PERM = true, PERM2 = true;
    const float* X; bf16* D; const float* ada;
    __device__ __forceinline__ void operator()(const f32x4 (&acc)[2][2][4][2], const Unit& u, int wr, int wc, int fr, int fq) const {
        const int row0 = u.pm * BM + wr * 64, col0 = u.pn * BM + wc * 64 + 8 * fq;
        const int b = (u.pm * BM) / SEQ;
        const float* g1 = ada + (size_t)b * 12288 + 2 * DM;
        f32x4 gv[2][2];
#pragma unroll
        for (int bj = 0; bj < 2; ++bj)
#pragma unroll
            for (int n = 0; n < 2; ++n) gv[bj][n] = *(const f32x4*)(g1 + col0 + 32 * bj + 4 * n);
#pragma unroll
        for (int ai = 0; ai < 2; ++ai)
#pragma unroll
            for (int m = 0; m < 4; ++m) { const size_t rbase = (size_t)(row0 + ai * HALF + m * 16);
                u32x4 w[2];
#pragma unroll
                for (int bj = 0; bj < 2; ++bj) { const size_t off = (rbase + fr) * DM + col0 + 32 * bj; const f32x4 x0 = *(const f32x4*)(X + off), x1 = *(const f32x4*)(X + off + 4);
                    const f32x4 v0 = x0 + acc[ai][bj][m][0] * gv[bj][0], v1 = x1 + acc[ai][bj][m][1] * gv[bj][1];
                    w[bj].x = cvt_pk_bf16(v0[0], v0[1]); w[bj].y = cvt_pk_bf16(v0[2], v0[3]); w[bj].z = cvt_pk_bf16(v1[0], v1[1]); w[bj].w = cvt_pk_bf16(v1[2], v1[3]); }
                store_pair_rows(D + (rbase + (fr & 7)) * DM + col0, DM, fr, w[0], w[1]);
                asm volatile("" ::: "memory"); }
    }
};
struct EpiSwiglu {
    static constexpr bool PERM = true, PERM2 = false;
    unsigned char* HID;
    __device__ __forceinline__ void operator()(const f32x4 (&acc)[2][2][4][2], const Unit& u, int wr, int wc, int fr, int fq) const {
        const int row0 = u.pm * BM + wr * 64 + fr, col0 = u.pn * 128 + wc * 32 + 8 * fq; const float is = 1.f / W8_SCALE;
#pragma unroll
        for (int ai = 0; ai < 2; ++ai)
#pragma unroll
            for (int m = 0; m < 4; ++m) { unsigned char* rowp = HID + (size_t)(row0 + ai * HALF + m * 16) * DEXP + col0;
                f32x4 h0, h1;
#pragma unroll
                for (int j = 0; j < 4; ++j) { h0[j] = silu_f(acc[ai][0][m][0][j] * is) * (acc[ai][1][m][0][j] * is); h1[j] = silu_f(acc[ai][0][m][1][j] * is) * (acc[ai][1][m][1][j] * is); }
                u32x2 w; w.x = pk4_fp8(h0[0], h0[1], h0[2], h0[3]); w.y = pk4_fp8(h1[0], h1[1], h1[2], h1[3]);
                *(u32x2*)(rowp) = w; }
    }
};
struct EpiBf16 {
    static constexpr bool PERM = true, PERM2 = true;
    bf16* O; int ldc; float scale;
    __device__ __forceinline__ void operator()(const f32x4 (&acc)[2][2][4][2], const Unit& u, int wr, int wc, int fr, int fq) const {
        const int row0 = u.pm * BM + wr * 64 + (fr & 7), col0 = u.pn * BM + wc * 64 + 8 * fq;
#pragma unroll
        for (int ai = 0; ai < 2; ++ai)
#pragma unroll
            for (int m = 0; m < 4; ++m) { bf16* rowp = O + (size_t)(row0 + ai * HALF + m * 16) * ldc + col0;
                u32x4 w[2];
#pragma unroll
                for (int bj = 0; bj < 2; ++bj) { const f32x4 v0 = acc[ai][bj][m][0] * scale, v1 = acc[ai][bj][m][1] * scale;
                    w[bj].x = cvt_pk_bf16(v0[0], v0[1]); w[bj].y = cvt_pk_bf16(v0[2], v0[3]); w[bj].z = cvt_pk_bf16(v1[0], v1[1]); w[bj].w = cvt_pk_bf16(v1[2], v1[3]); }
                store_pair_rows(rowp, (size_t)ldc, fr, w[0], w[1]); }
    }
};

struct EpiF8 {
    static constexpr bool PERM = true, PERM2 = true;
    unsigned char* O; int ldc; float scale;
    __device__ __forceinline__ void operator()(const f32x4 (&acc)[2][2][4][2], const Unit& u, int wr, int wc, int fr, int fq) const {
        const int row0 = u.pm * BM + wr * 64 + (fr & 7), col0 = u.pn * BM + wc * 64 + 8 * fq; const bool hi = (fr & 8) != 0;
#pragma unroll
        for (int ai = 0; ai < 2; ++ai)
#pragma unroll
            for (int m = 0; m < 4; ++m) { unsigned char* p = O + (size_t)(row0 + ai * HALF + m * 16) * ldc + col0 + (hi ? 32 : 0);
                u32x2 w[2];
#pragma unroll
                for (int bj = 0; bj < 2; ++bj) { const f32x4 v0 = acc[ai][bj][m][0] * scale, v1 = acc[ai][bj][m][1] * scale; w[bj].x = pk4_fp8(v0[0], v0[1], v0[2], v0[3]); w[bj].y = pk4_fp8(v1[0], v1[1], v1[2], v1[3]); }
                const u32x2 s = hi ? w[0] : w[1]; u32x2 r;
                r.x = (unsigned)__builtin_amdgcn_ds_swizzle((int)s.x, 0x201F); r.y = (unsigned)__builtin_amdgcn_ds_swizzle((int)s.y, 0x201F);
                *(u32x2*)(p) = hi ? r : w[0];
                *(u32x2*)(p + 8 * (size_t)ldc) = hi ? w[1] : r; }
    }
};

__device__ __forceinline__ void transpose_item(const float* src, int ldsrc, int scol0, int k0, bf16* dst, size_t drow0, int ldd, LAS float* scr, int lane) {
#pragma unroll 8
    for (int i = 0; i < 32; ++i) { const int kk = 2 * i + (lane >> 5); scr[kk * 33 + (lane & 31)] = src[(size_t)(k0 + kk) * ldsrc + scol0 + (lane & 31)]; }
    asm volatile("s_waitcnt lgkmcnt(0)" ::: "memory");
    const int c = lane & 7;
#pragma unroll
    for (int j = 0; j < 4; ++j) { const int n = (lane >> 3) + 8 * j; const LAS float* s = scr + (8 * c) * 33 + n;
        u32x4 o; o.x = pk2(s[0 * 33], s[1 * 33]); o.y = pk2(s[2 * 33], s[3 * 33]); o.z = pk2(s[4 * 33], s[5 * 33]); o.w = pk2(s[6 * 33], s[7 * 33]);
        *(u32x4*)(dst + (drow0 + n) * (size_t)ldd + k0 + 8 * c) = o; }
    asm volatile("s_waitcnt lgkmcnt(0)" ::: "memory");
}

struct T64 { const float* src; bf16* dst; int ldsrc, ldd, f8; };
__device__ __forceinline__ T64 decode_t64(const Args& a, int r) {
    unsigned char* ws = a.ws; T64 t;
    if (r < 2048) { const int kb = r >> 6, nb = r & 63; const int scol = nb < 48 ? nb * 64 : 3104 + (nb - 48) * 64;
        t.src = a.in[7] + (size_t)(kb * 64) * PROJW + scol; t.ldsrc = PROJW; t.dst = (bf16*)(ws + WS_WIN) + (size_t)(nb * 64) * DM + kb * 64; t.ldd = DM; t.f8 = 0; return t; }
    r -= 2048;
    if (r < 1024) { const int kb = r >> 5, nb = r & 31;
        t.src = a.in[13] + (size_t)(kb * 64) * DM + nb * 64; t.ldsrc = DM; t.dst = (bf16*)(ws + WS_WOUT) + (size_t)(nb * 64) * DM + kb * 64; t.ldd = DM; t.f8 = 0; return t; }
    r -= 1024;
    if (r < 16384) { const int up = r >= 8192; if (up) r -= 8192; const int e = r >> 9, rr = r & 511, kb = rr >> 4, nb = rr & 15, n0 = nb * 64;
        t.src = (up ? a.in[17] : a.in[16]) + (size_t)e * DM * DEXP + (size_t)(kb * 64) * DEXP + n0; t.ldsrc = DEXP;
        t.dst = (bf16*)(ws + WS_WGU + ((size_t)e * 2048 + (size_t)(n0 >> 7) * 256 + (n0 & 127) + (up ? 128 : 0)) * DM + kb * 64); t.ldd = DM; t.f8 = 1; return t; }
    r -= 16384;
    { const int e = r >> 9, rr = r & 511, kb = rr >> 5, nb = rr & 31;
        t.src = a.in[18] + (size_t)e * DEXP * DM + (size_t)(kb * 64) * DM + nb * 64; t.ldsrc = DM;
        t.dst = (bf16*)(ws + WS_WD + ((size_t)e * 2048 + nb * 64) * DEXP + kb * 64); t.ldd = DEXP; t.f8 = 1; return t; }
}
__device__ __forceinline__ void t64_load(const T64& t, int lane, f32x4 (&v)[16]) {
    const int krow = lane >> 4, c4 = lane & 15;
#pragma unroll
    for (int i = 0; i < 16; ++i) v[i] = __builtin_nontemporal_load((const f32x4*)(t.src + (size_t)(4 * i + krow) * t.ldsrc + 4 * c4));
}
__device__ __forceinline__ void t64_finish(const T64& t, int lane, const f32x4 (&v)[16], LAS float* scr) {
    const int krow = lane >> 4, c4 = lane & 15;
#pragma unroll
    for (int i = 0; i < 16; ++i) { LAS float* p = scr + (4 * i + krow) * 65 + 4 * c4; p[0] = v[i].x; p[1] = v[i].y; p[2] = v[i].z; p[3] = v[i].w; }
    asm volatile("s_waitcnt lgkmcnt(0)" ::: "memory");
    const int c = lane & 7;
#pragma unroll
    for (int j = 0; j < 8; ++j) { const int n = (lane >> 3) + 8 * j; const LAS float* s = scr + (8 * c) * 65 + n;
        if (t.f8) { u32x2 o; o.x = pk4_fp8(s[0 * 65] * W8_SCALE, s[1 * 65] * W8_SCALE, s[2 * 65] * W8_SCALE, s[3 * 65] * W8_SCALE); o.y = pk4_fp8(s[4 * 65] * W8_SCALE, s[5 * 65] * W8_SCALE, s[6 * 65] * W8_SCALE, s[7 * 65] * W8_SCALE);
            *(u32x2*)((unsigned char*)t.dst + (size_t)n * t.ldd + 8 * c) = o; }
        else { u32x4 o; o.x = pk2(s[0 * 65], s[1 * 65]); o.y = pk2(s[2 * 65], s[3 * 65]); o.z = pk2(s[4 * 65], s[5 * 65]); o.w = pk2(s[6 * 65], s[7 * 65]);
            *(u32x4*)(t.dst + (size_t)n * t.ldd + 8 * c) = o; } }
    asm volatile("s_waitcnt lgkmcnt(0)" ::: "memory");
}
constexpr int T64_ALL = 2048 + 1024 + 16384 + 8192;
constexpr int BG8_ITEMS = 1920, BG11_ITEMS = 3584;
constexpr int P0_NT64 = T64_ALL - BG8_ITEMS - BG11_ITEMS;
constexpr int P0_TAIL = 1024;
constexpr int P0_NGEMV = 192;
__device__ __forceinline__ void phase0(const Args& a, LAS unsigned char* lds) {
    const int tid = opaque_tid(), lane = tid & 63, wave = tid >> 6, G = gridDim.x, blk = blockIdx.x;
    unsigned char* ws = a.ws;
    {
        const float* c = a.in[1]; const float* cc = a.in[3]; const float* w_ada = a.in[4]; const float* b_ada = a.in[5];
        float* part = (float*)(ws + WS_ADAP);
        LAS float* red = (LAS float*)lds;
        for (int rep_ = 0; rep_ < 1 + (PROBE_P0 & 1); ++rep_)
        for (int it = blk; it < P0_NGEMV; it += G) {
            const int cb = it % 48, ks = it / 48, col0 = cb * 256 + 4 * lane, r0 = ks * 512 + wave * 64;
            f32x4 a0 = {0.f, 0.f, 0.f, 0.f}, a1 = a0, a2 = a0;
#pragma unroll 16
            for (int r = r0; r < r0 + 64; ++r) {
                const f32x4 w = *(const f32x4*)(w_ada + (size_t)r * 12288 + col0);
                const float s0 = silu_f(c[r]), s1 = silu_f(c[DM + r]), s2 = silu_f(cc[r]);
                a0 += w * s0; a1 += w * s1; a2 += w * s2;
            }
            *(LAS f32x4*)(red + (wave * 3 + 0) * 256 + 4 * lane) = a0; *(LAS f32x4*)(red + (wave * 3 + 1) * 256 + 4 * lane) = a1; *(LAS f32x4*)(red + (wave * 3 + 2) * 256 + 4 * lane) = a2;
            __syncthreads();
            for (int idx = tid; idx < 768; idx += NTHREADS) { const int v = idx >> 8, col = idx & 255; float s = ks == 0 ? b_ada[cb * 256 + col] : 0.f;
#pragma unroll
                for (int w8 = 0; w8 < 8; ++w8) s += red[(w8 * 3 + v) * 256 + col];
                part[(size_t)(ks * 3 + v) * 12288 + cb * 256 + col] = s; }
            __syncthreads();
        }
    }
    LAS float* scr = (LAS float*)(lds + wave * 16640);
    const int gw = blk * 8 + wave, NGW = G * 8;
    constexpr int I_WZ = 32, I_WR = 512, I_TW = 256, I_FT = 256;
    for (int it = gw; it < I_WZ + I_WR + I_TW + I_FT; it += NGW) {
        int r = it;
        if (r < I_WZ) { transpose_item(a.in[7], PROJW, 3072, r * 64, (bf16*)(ws + WS_WIN), (size_t)4096, DM, scr, lane); continue; }
        r -= I_WZ;
        if (r < I_WR) { const int p = r * 64 + lane, e = p >> 11, d = p & 2047; const float wv = a.in[15][d * 16 + e]; const unsigned hi = f2bf(wv); ((bf16*)(ws + WS_WRH))[p] = (bf16)hi; ((bf16*)(ws + WS_WRL))[p] = (bf16)f2bf(wv - bf2f((bf16)hi)); continue; }
        r -= I_WR;
        if (r < I_TW) { const int p = r * 64 + lane; float s, c; sincospif((float)p * (1.0f / 8192.0f), &s, &c); ((f32x2*)(ws + WS_TW))[p] = (f32x2){c, s}; continue; }
        r -= I_TW;
        { const int p = r * 64 + lane, k = p >> 7, l = p & 127; float s, c; sincospif((float)((k * l) & 127) * (1.0f / 64.0f), &s, &c); ((bf16*)(ws + WS_FC))[p] = (bf16)f2bf(c); ((bf16*)(ws + WS_FS))[p] = (bf16)f2bf(s); }
    }
    const int n_gemv_wg = G > P0_NGEMV ? P0_NGEMV : 0;
    const int head_end = n_gemv_wg ? P0_NT64 - P0_TAIL : P0_NT64;
    const int n_head = gw < head_end ? (head_end - gw + NGW - 1) / NGW : 0;
    const int tgw = (blk - n_gemv_wg) * 8 + wave, tstep = (G - n_gemv_wg) * 8;
    const int n_tail = (n_gemv_wg && blk >= n_gemv_wg && tgw < P0_TAIL) ? (P0_TAIL - tgw + tstep - 1) / tstep : 0;
    const int n_items = n_head + n_tail;
    auto item_of = [&](int j) -> int { return j < n_head ? gw + j * NGW : head_end + tgw + (j - n_head) * tstep; };
    for (int rep_ = 0; rep_ < 1 + ((PROBE_P0 >> 1) & 1); ++rep_) {
    f32x4 va[16], vb[16]; T64 ta, tb;
    if (n_items > 0) { ta = decode_t64(a, item_of(0)); t64_load(ta, lane, va); }
    for (int j = 0; j < n_items; j += 2) {
        const bool h1 = j + 1 < n_items, h2 = j + 2 < n_items;
        if (h1) { tb = decode_t64(a, item_of(j + 1)); t64_load(tb, lane, vb); }
        t64_finish(ta, lane, va, scr);
        if (h2) { ta = decode_t64(a, item_of(j + 2)); t64_load(ta, lane, va); }
        if (h1) t64_finish(tb, lane, vb, scr);
    }
    }
}

__device__ __forceinline__ void t64_range(const Args& a, LAS unsigned char* lds, int lo, int hi, int wg0) {
    if ((int)blockIdx.x < wg0 || (int)gridDim.x <= wg0) return;
    const int tid = opaque_tid(), lane = tid & 63, wave = tid >> 6;
    LAS float* scr = (LAS float*)(lds + wave * 16640);
    const int gw = ((int)blockIdx.x - wg0) * 8 + wave, NGW = ((int)gridDim.x - wg0) * 8;
    const int n_items = lo + gw < hi ? (hi - lo - gw + NGW - 1) / NGW : 0;
    f32x4 va[16], vb[16]; T64 ta, tb;
    if (n_items > 0) { ta = decode_t64(a, lo + gw); t64_load(ta, lane, va); }
    for (int j = 0; j < n_items; j += 2) {
        const bool h1 = j + 1 < n_items, h2 = j + 2 < n_items;
        if (h1) { tb = decode_t64(a, lo + gw + (j + 1) * NGW); t64_load(tb, lane, vb); }
        t64_finish(ta, lane, va, scr);
        if (h2) { ta = decode_t64(a, lo + gw + (j + 2) * NGW); t64_load(ta, lane, va); }
        if (h1) t64_finish(tb, lane, vb, scr);
    }
}
#define MFMA16(a, b, c) __builtin_amdgcn_mfma_f32_16x16x32_bf16((a), (b), (c), 0, 0, 0)
__device__ __forceinline__ void finalize_ada(const Args& a) {
    const float* part = (const float*)(a.ws + WS_ADAP); float* adaw = (float*)(a.ws + WS_ADA);
    for (int i = blockIdx.x * NTHREADS + threadIdx.x; i < 3 * 12288; i += gridDim.x * NTHREADS) { float s = 0.f;
#pragma unroll
        for (int ks = 0; ks < 4; ++ks) s += part[(size_t)ks * 3 * 12288 + i];
        adaw[i] = s; }
}
__device__ __forceinline__ void quantize_win(const Args& a) {
    const int lane = threadIdx.x & 63, gw = blockIdx.x * 8 + (threadIdx.x >> 6), NGW = gridDim.x * 8;
    const bf16* W = (const bf16*)(a.ws + WS_WIN); unsigned char* W8 = a.ws + WS_WIN8; float* cs = (float*)(a.ws + WS_CS);
    for (int n = gw; n < 4096; n += NGW) {
        u32x4 v[4]; float f[4][8]; float amax = 0.f;
#pragma unroll
        for (int j = 0; j < 4; ++j) { v[j] = *(const u32x4*)(W + (size_t)n * DM + 512 * j + 8 * lane);
#pragma unroll
            for (int i = 0; i < 4; ++i) { f[j][2 * i] = __uint_as_float(v[j][i] << 16); f[j][2 * i + 1] = __uint_as_float(v[j][i] & 0xffff0000u); amax = fmaxf(amax, fmaxf(fabsf(f[j][2 * i]), fabsf(f[j][2 * i + 1]))); } }
#pragma unroll
        for (int o = 1; o < 64; o <<= 1) amax = fmaxf(amax, __shfl_xor(amax, o));
        const float inv = amax > 0.f ? 127.f / amax : 0.f;
#pragma unroll
        for (int j = 0; j < 4; ++j) { u32x2 w8; w8.x = pk4_i8(f[j][0] * inv, f[j][1] * inv, f[j][2] * inv, f[j][3] * inv); w8.y = pk4_i8(f[j][4] * inv, f[j][5] * inv, f[j][6] * inv, f[j][7] * inv);
            *(u32x2*)(W8 + (size_t)n * DM + 512 * j + 8 * lane) = w8; }
        if (lane == 0) cs[n] = amax * (1.f / 127.f);
    }
}
constexpr int CW_CTXCNT = 4096;
template <int MODE>
__device__ __forceinline__ void norm_load_tile(const Args& a, int tile, int rl, int wave, int q, f32x4 (&xv)[8][2], u32x4 (&dv)[8]) {
    const int r = tile * 16 + rl;
    if (MODE == 0) { const float* s = (r < NLAT ? a.in[0] + (size_t)r * DM : a.in[2] + (size_t)(r - NLAT) * DM) + 256 * wave + 8 * q;
#pragma unroll
        for (int ks = 0; ks < 8; ++ks) { xv[ks][0] = *(const f32x4*)(s + 32 * ks); xv[ks][1] = *(const f32x4*)(s + 32 * ks + 4); } }
    if (MODE == 1) { const bf16* dp = (const bf16*)(a.ws + WS_DLT) + (size_t)r * DM + 256 * wave + 8 * q;
#pragma unroll
        for (int ks = 0; ks < 8; ++ks) dv[ks] = *(const u32x4*)(dp + 32 * ks); }
}
template <int MODE>
__device__ __forceinline__ void phase_norm_tile(const Args& a, LAS unsigned char* lds, int first, int stride, int tile_end) {
    const int tid = opaque_tid(), lane = tid & 63, wave = __builtin_amdgcn_readfirstlane(tid >> 6), rl = lane & 15, q = lane >> 4;
    const float* ada = (const float*)(a.ws + WS_ADA);
    LAS float* gs = (LAS float*)lds;
    LAS float* shv = gs + 3 * DM;
    LAS float* ssred0 = shv + 3 * DM;
    LAS float* red0 = ssred0 + 256;
    LAS float* mxred0 = red0 + 8192;
    { const float* gn = MODE == 0 ? a.in[6] : a.in[14]; const float* part = (const float*)(a.ws + WS_ADAP);
      for (int i = tid; i < 3 * DM; i += NTHREADS) { const int v = i / DM, d = i % DM;
          float sh_, sc_;
          if (MODE == 0) { const float* p0 = part + (size_t)v * 12288; sh_ = 0.f; sc_ = 0.f;
#pragma unroll
              for (int ks = 0; ks < 4; ++ks) { sh_ += p0[(size_t)ks * 3 * 12288 + d]; sc_ += p0[(size_t)ks * 3 * 12288 + DM + d]; } }
          else { const float* base = ada + (size_t)v * 12288 + 3 * DM; sh_ = base[d]; sc_ = base[DM + d]; }
          gs[i] = gn[d] * (1.f + sc_); shv[i] = sh_; }
    }
    bf16x8 wb[2][8];
    if (MODE == 0) { const bf16* Wz = (const bf16*)(a.ws + WS_WIN) + (size_t)4096 * DM;
#pragma unroll
        for (int nt = 0; nt < 2; ++nt)
#pragma unroll
            for (int ks = 0; ks < 8; ++ks) wb[nt][ks] = *(const bf16x8*)(Wz + (size_t)(16 * nt + rl) * DM + 256 * wave + 32 * ks + 8 * q);
    } else { const bf16* WH = (const bf16*)(a.ws + WS_WRH); const bf16* WL = (const bf16*)(a.ws + WS_WRL);
#pragma unroll
        for (int ks = 0; ks < 8; ++ks) { wb[0][ks] = *(const bf16x8*)(WH + (size_t)rl * DM + 256 * wave + 32 * ks + 8 * q); wb[1][ks] = *(const bf16x8*)(WL + (size_t)rl * DM + 256 * wave + 32 * ks + 8 * q); } }
    __syncthreads();
    bf16* Hout = (bf16*)(a.ws + (MODE == 0 ? WS_H : WS_HF));
    f32x4 xv[8][2]; u32x4 dv[8];
    auto tile_of = [&](int s) -> int { return MODE == 0 ? (s < 32 ? NLAT / 16 + s : s - 32) : s; };
    int sq = first;
    if (sq < tile_end) norm_load_tile<MODE>(a, tile_of(sq), rl, wave, q, xv, dv);
    int par = 0;
    for (; sq < tile_end; sq += stride, par ^= 1) {
        LAS float* ssred = ssred0 + par * 128; LAS float* red = red0 + par * 4096; LAS float* mxred = mxred0 + par * 128;
        const int tile = tile_of(sq);
        const int r = tile * 16 + rl;
        const int v = MODE == 0 ? (tile * 16 < NLAT ? (tile * 16) / SEQ : 2) : (tile * 16) / SEQ;
        if (MODE == 1) {
#pragma unroll
            for (int ks = 0; ks < 8; ++ks) { const u32x4 d = dv[ks];
                xv[ks][0] = (f32x4){__uint_as_float(d.x << 16), __uint_as_float(d.x & 0xffff0000u), __uint_as_float(d.y << 16), __uint_as_float(d.y & 0xffff0000u)};
                xv[ks][1] = (f32x4){__uint_as_float(d.z << 16), __uint_as_float(d.z & 0xffff0000u), __uint_as_float(d.w << 16), __uint_as_float(d.w & 0xffff0000u)}; }
            if (sq + stride < tile_end) norm_load_tile<MODE>(a, tile_of(sq + stride), rl, wave, q, xv, dv); }
        float ss = 0.f;
#pragma unroll
        for (int ks = 0; ks < 8; ++ks) { const f32x4 a0 = xv[ks][0], a1 = xv[ks][1]; ss += (a0.x * a0.x + a0.y * a0.y) + (a0.z * a0.z + a0.w * a0.w) + (a1.x * a1.x + a1.y * a1.y) + (a1.z * a1.z + a1.w * a1.w); }
        ss += __shfl_xor(ss, 16); ss += __shfl_xor(ss, 32);
        if (q == 0) ssred[wave * 16 + rl] = ss;
        __syncthreads();
        float tot = 0.f;
#pragma unroll
        for (int w8 = 0; w8 < 8; ++w8) tot += ssred[w8 * 16 + rl];
        const float rstd = rsqrtf(tot * (1.f / DM) + EPS);
        f32x4 acc0 = {0.f, 0.f, 0.f, 0.f}, acc1 = {0.f, 0.f, 0.f, 0.f};
        const bool lat_tile = MODE == 0 && tile < NLAT / 16; float amax = 0.f;
        bf16* orow = Hout + (size_t)r * DM + 256 * wave + 8 * q;
        const LAS float* gsp = gs + v * DM + 256 * wave + 8 * q; const LAS float* shp = shv + v * DM + 256 * wave + 8 * q;
#pragma unroll
        for (int ks = 0; ks < 8; ++ks) {
            const f32x4 g0 = *(const LAS f32x4*)(gsp + 32 * ks), g1 = *(const LAS f32x4*)(gsp + 32 * ks + 4), s0 = *(const LAS f32x4*)(shp + 32 * ks), s1 = *(const LAS f32x4*)(shp + 32 * ks + 4);
            const f32x4 h0 = xv[ks][0] * rstd * g0 + s0, h1 = xv[ks][1] * rstd * g1 + s1;
            u32x4 hw; hw.x = pk2(h0.x, h0.y); hw.y = pk2(h0.z, h0.w); hw.z = pk2(h1.x, h1.y); hw.w = pk2(h1.z, h1.w);
            if (MODE == 0) { if (!lat_tile || INPROJ_BF16_TILES > 0) *(u32x4*)(orow + 32 * ks) = hw;
                if (lat_tile) { xv[ks][0] = h0; xv[ks][1] = h1;
                    amax = fmaxf(amax, fmaxf(fmaxf(fmaxf(fabsf(h0.x), fabsf(h0.y)), fmaxf(fabsf(h0.z), fabsf(h0.w))), fmaxf(fmaxf(fabsf(h1.x), fabsf(h1.y)), fmaxf(fabsf(h1.z), fabsf(h1.w))))); } }
            else { u32x2 h8; h8.x = pk4_fp8(h0.x, h0.y, h0.z, h0.w); h8.y = pk4_fp8(h1.x, h1.y, h1.z, h1.w); *(u32x2*)((unsigned char*)(a.ws + WS_HF) + (size_t)r * DM + 256 * wave + 8 * q + 32 * ks) = h8; }
            const bf16x8 hf = __builtin_bit_cast(bf16x8, hw);
            if (MODE == 0) { acc0 = MFMA16(hf, wb[0][ks], acc0); acc1 = MFMA16(hf, wb[1][ks], acc1); }
            else { u32x4 lw;
                lw.x = pk2(h0.x - __uint_as_float(hw.x << 16), h0.y - __uint_as_float(hw.x & 0xffff0000u)); lw.y = pk2(h0.z - __uint_as_float(hw.y << 16), h0.w - __uint_as_float(hw.y & 0xffff0000u));
                lw.z = pk2(h1.x - __uint_as_float(hw.z << 16), h1.y - __uint_as_float(hw.z & 0xffff0000u)); lw.w = pk2(h1.z - __uint_as_float(hw.w << 16), h1.w - __uint_as_float(hw.w & 0xffff0000u));
                const bf16x8 lf = __builtin_bit_cast(bf16x8, lw);
                acc0 = MFMA16(hf, wb[0][ks], acc0); acc0 = MFMA16(lf, wb[0][ks], acc0); acc0 = MFMA16(hf, wb[1][ks], acc0); }
        }
        if (MODE == 0 && lat_tile) {
            amax = fmaxf(amax, __shfl_xor(amax, 16)); amax = fmaxf(amax, __shfl_xor(amax, 32));
            if (q == 0) mxred[wave * 16 + rl] = amax;
            __syncthreads();
            float mx = 0.f;
#pragma unroll
            for (int w8 = 0; w8 < 8; ++w8) mx = fmaxf(mx, mxred[w8 * 16 + rl]);
            const float inv = mx > 0.f ? 127.f / mx : 0.f;
            unsigned char* o8 = a.ws + WS_H8 + (size_t)r * DM + 256 * wave + 8 * q;
#pragma unroll
            for (int ks = 0; ks < 8; ++ks) { const f32x4 h0 = xv[ks][0] * inv, h1 = xv[ks][1] * inv; u32x2 w8; w8.x = pk4_i8(h0.x, h0.y, h0.z, h0.w); w8.y = pk4_i8(h1.x, h1.y, h1.z, h1.w); *(u32x2*)(o8 + 32 * ks) = w8; }
            if (wave == 0 && q == 0) ((float*)(a.ws + WS_RS))[r] = mx * (1.f / 127.f);
        }
        if (MODE == 0 && sq + stride < tile_end) norm_load_tile<MODE>(a, tile_of(sq + stride), rl, wave, q, xv, dv);
#pragma unroll
        for (int rr = 0; rr < 4; ++rr) { red[(wave * 16 + 4 * q + rr) * 32 + rl] = acc0[rr]; if (MODE == 0) red[(wave * 16 + 4 * q + rr) * 32 + 16 + rl] = acc1[rr]; }
        __syncthreads();
        if (MODE == 0) { const int row = tid >> 5, col = tid & 31; float s = 0.f;
#pragma unroll
            for (int w8 = 0; w8 < 8; ++w8) s += red[(w8 * 16 + row) * 32 + col];
            ((float*)(a.ws + WS_Z))[(size_t)(tile * 16 + row) * 32 + col] = s;
        } else if (tid < 256) { const int row = tid >> 4, e = tid & 15; float s = 0.f;
#pragma unroll
            for (int w8 = 0; w8 < 8; ++w8) s += red[(w8 * 16 + row) * 32 + e];
            float m = s; m = fmaxf(m, __shfl_xor(m, 1)); m = fmaxf(m, __shfl_xor(m, 2)); m = fmaxf(m, __shfl_xor(m, 4)); m = fmaxf(m, __shfl_xor(m, 8));
            const float ex = expf(s - m); float sm = ex; sm += __shfl_xor(sm, 1); sm += __shfl_xor(sm, 2); sm += __shfl_xor(sm, 4); sm += __shfl_xor(sm, 8);
            const int rg = tile * 16 + row, b = rg / SEQ, t = rg % SEQ;
            ((float*)(a.ws + WS_AFF))[((size_t)b * NE + e) * SEQ + t] = ex / sm; }
        if (MODE == 0 && tile >= NLAT / 16) {
            __threadfence(); __syncthreads();
            if (tid == 0) __hip_atomic_fetch_add((unsigned*)(a.ws + WS_CTL) + CW_CTXCNT + 64 * ((tile - NLAT / 16) >> 4), 1u, __ATOMIC_RELAXED, __HIP_MEMORY_SCOPE_AGENT);
        }
    }
    __syncthreads();
}

constexpr int GQ_LD = 136, GK_LD = 72;
constexpr int GL_Q = 0, GL_KI = 17408, GL_KET = 34816, GL_VT = 53248, GL_ST = 90112, GL_DC = 159744, GL_SEG = 160256;
__device__ __forceinline__ bf16x8 ldfrag(const LAS bf16* base, int row0, int ld, int koff, int lane) { return *(const LAS bf16x8*)(base + (row0 + (lane & 15)) * ld + koff + 8 * (lane >> 4)); }
__device__ __forceinline__ float fast_logsigmoid(float x) { return fminf(x, 0.f) - __logf(1.f + __expf(-fabsf(x))); }

struct GlaRaw { u32x4 q[2], k[2], v[4]; f32x2 z; };
template <bool FULL>
__device__ __forceinline__ void gla_issue_loads(const Args& a, int b, int h, int dir, int t0, size_t zrow0, int tid, GlaRaw& r) {
    const bf16* QH = (const bf16*)(a.ws + WS_QH) + ((size_t)(b * 4 + h) * SEQ + t0) * 128; const bf16* KH = (const bf16*)(a.ws + WS_KH) + ((size_t)(b * 4 + h) * KTOK + t0) * 128;
    const float* Z = (const float*)(a.ws + WS_Z);
#pragma unroll
    for (int j = 0; j < 2; ++j) { const int e = tid + 512 * j; r.k[j] = *(const u32x4*)(KH + (size_t)e * 8); if (FULL) r.q[j] = *(const u32x4*)(QH + (size_t)e * 8); }
    { const int e = tid * 2; r.z = *(const f32x2*)(Z + (zrow0 + (e >> 4)) * 32 + dir * 16 + (e & 15)); }
}
__device__ __forceinline__ void gla_issue_v(const Args& a, int b, int h, int t0, int tid, GlaRaw& r) {
    const bf16* VH = (const bf16*)(a.ws + WS_VH) + ((size_t)(b * 4 + h) * KTOK + t0) * 256;
#pragma unroll
    for (int rr = 0; rr < 4; ++rr) r.v[rr] = *(const u32x4*)(VH + (size_t)(4 * (tid >> 5) + rr) * 256 + 8 * (tid & 31));
}
__device__ __forceinline__ void gla_store_vt(LAS unsigned char* lds, int tid, const u32x4 (&x)[4]) {
    LAS bf16* VT = (LAS bf16*)(lds + GL_VT); const int c0 = 8 * (tid & 31), l0 = 4 * (tid >> 5);
    const int sw = (((l0 >> 3) ^ ((c0 >> 3) & 7)) << 3) + (l0 & 7);
#pragma unroll
    for (int i2 = 0; i2 < 4; ++i2) {
        const unsigned a0 = x[0][i2], a1 = x[1][i2], a2 = x[2][i2], a3 = x[3][i2];
        u32x2 lo, hi; lo.x = (a0 & 0xffffu) | (a1 << 16); lo.y = (a2 & 0xffffu) | (a3 << 16); hi.x = (a0 >> 16) | (a1 & 0xffff0000u); hi.y = (a2 >> 16) | (a3 & 0xffff0000u);
        *(LAS u32x2*)(VT + (c0 + 2 * i2) * GK_LD + sw) = lo; *(LAS u32x2*)(VT + (c0 + 2 * i2 + 1) * GK_LD + sw) = hi; }
}
__device__ __forceinline__ bf16x8 ldfrag_vt(const LAS bf16* VT, int row0, int ld, int kc, int lane) { const int row = row0 + (lane & 15); return *(const LAS bf16x8*)(VT + row * ld + ((kc ^ ((row >> 3) & 7)) << 3)); }
template <bool FULL>
__device__ __forceinline__ void gla_stage(LAS unsigned char* lds, int wave, int lane, int tid, const GlaRaw& r) {
    LAS bf16* Qd = (LAS bf16*)(lds + GL_Q); LAS bf16* Ki = (LAS bf16*)(lds + GL_KI); LAS unsigned* zs = (LAS unsigned*)(lds + GL_SEG);
#pragma unroll
    for (int j = 0; j < 2; ++j) { const int e = tid + 512 * j, row = e >> 4, c8 = e & 15;
        *(LAS u32x4*)(Ki + row * GQ_LD + 8 * c8) = r.k[j]; if (FULL) *(LAS u32x4*)(Qd + row * GQ_LD + 8 * c8) = r.q[j]; }
    zs[tid] = pk2(r.z.x, r.z.y);
    gla_store_vt(lds, tid, r.v);
}
template <bool FULL>
__device__ __forceinline__ void gla_prep(LAS unsigned char* lds, int dir, const bf16x8 wfrag, float bias, float& totacc) {
    const int tid = opaque_tid(), lane = tid & 63, wave = __builtin_amdgcn_readfirstlane(tid >> 6), cidx = lane & 15, q = lane >> 4, d = 16 * wave + cidx;
    LAS bf16* Qd = (LAS bf16*)(lds + GL_Q); LAS bf16* Ki = (LAS bf16*)(lds + GL_KI); LAS bf16* KeT = (LAS bf16*)(lds + GL_KET);
    LAS float* dcv = (LAS float*)(lds + GL_DC); const LAS bf16* zs = (const LAS bf16*)(lds + GL_SEG);
    float c[4][4], t4[4], sq[4], Tt[4];
#pragma unroll
    for (int it = 0; it < 4; ++it) {
        const bf16x8 zf = *(const LAS bf16x8*)(zs + (16 * it + cidx) * 16 + 8 * (q & 1));
        f32x4 pre = {bias, bias, bias, bias};
        pre = MFMA16(zf, wfrag, pre);
#pragma unroll
        for (int r = 0; r < 4; ++r) c[it][r] = fast_logsigmoid(pre[r]) * (1.f / 16.f);
        if (!dir) { c[it][1] += c[it][0]; c[it][2] += c[it][1]; c[it][3] += c[it][2]; t4[it] = c[it][3]; }
        else { c[it][2] += c[it][3]; c[it][1] += c[it][2]; c[it][0] += c[it][1]; t4[it] = c[it][0]; }
        float s = t4[it];
        if (!dir) { const float u = __shfl_up(s, 16); if (q >= 1) s += u; const float u2 = __shfl_up(s, 32); if (q >= 2) s += u2; Tt[it] = __shfl(s, cidx + 48); }
        else { const float u = __shfl_down(s, 16); if (q <= 2) s += u; const float u2 = __shfl_down(s, 32); if (q <= 1) s += u2; Tt[it] = __shfl(s, cidx); }
        sq[it] = s - t4[it];
    }
    const float total = (Tt[0] + Tt[1]) + (Tt[2] + Tt[3]);
    float off[4];
    if (!dir) { off[0] = 0.f; off[1] = Tt[0]; off[2] = Tt[0] + Tt[1]; off[3] = Tt[0] + Tt[1] + Tt[2]; }
    else { off[3] = 0.f; off[2] = Tt[3]; off[1] = Tt[3] + Tt[2]; off[0] = Tt[3] + Tt[2] + Tt[1]; }
    const float dc = __expf(total);
#pragma unroll
    for (int it = 0; it < 4; ++it) {
        float ke[4];
#pragma unroll
        for (int r = 0; r < 4; ++r) { const int i = 16 * it + 4 * q + r; const float cum = c[it][r] + off[it] + sq[it];
            const float kf = bf2f(Ki[i * GQ_LD + d]);
            if (FULL) { const float qf = bf2f(Qd[i * GQ_LD + d]); const float kin = kf * __expf(-cum);
                Qd[i * GQ_LD + d] = (bf16)f2bf(qf * 0.08838834764831845f * __expf(cum)); Ki[i * GQ_LD + d] = (bf16)f2bf(kin); ke[r] = kin * dc; }
            else ke[r] = kf * __expf(total - cum); }
        u32x2 kw; kw.x = pk2(ke[0], ke[1]); kw.y = pk2(ke[2], ke[3]);
        *(LAS u32x2*)(KeT + d * GK_LD + 16 * it + 4 * q) = kw;
    }
    if (q == 0) { dcv[d] = dc; totacc += total; }
}
__device__ __forceinline__ bf16x8 gla_wfrag(const float* w_a2, int h, int wave, int lane) {
    const int d = 16 * wave + (lane & 15), q = lane >> 4; unsigned wv[4];
#pragma unroll
    for (int j2 = 0; j2 < 4; ++j2) { float x[2];
#pragma unroll
        for (int u = 0; u < 2; ++u) { const float wf = w_a2[(8 * (q & 1) + 2 * j2 + u) * 512 + h * 128 + d]; const float hi = bf2f((bf16)f2bf(wf)); x[u] = q < 2 ? hi : wf - hi; }
        wv[j2] = pk2(x[0], x[1]); }
    return __builtin_bit_cast(bf16x8, (u32x4){wv[0], wv[1], wv[2], wv[3]});
}
__device__ __forceinline__ void gla_state_update(LAS unsigned char* lds, int lane, const bf16x8 (&vt)[2][2], f32x4 (&acc)[8][2]) {
    const LAS bf16* KeT = (const LAS bf16*)(lds + GL_KET); const LAS float* dcv = (const LAS float*)(lds + GL_DC);
#pragma unroll
    for (int mt = 0; mt < 8; ++mt) {
        const f32x4 dc4 = *(const LAS f32x4*)(dcv + 16 * mt + 4 * (lane >> 4));
        const bf16x8 k0 = ldfrag(KeT, 16 * mt, GK_LD, 0, lane), k1 = ldfrag(KeT, 16 * mt, GK_LD, 32, lane);
#pragma unroll
        for (int n = 0; n < 2; ++n) { f32x4 t = acc[mt][n] * dc4; t = MFMA16(k0, vt[n][0], t); t = MFMA16(k1, vt[n][1], t); acc[mt][n] = t; }
    }
}
constexpr size_t GLA_SV = 128 * 256;
constexpr int GA_LD = 136;
constexpr int GA_K = 0, GA_KET = 34816, GA_VT = 69632, GA_Z = 139264, GA_DC = 143360;
struct GlaRawA { u32x4 k[4], v[8]; f32x2 z[2]; };
__device__ __forceinline__ void glaA_issue(const Args& a, int b, int h, int dir, int t0, size_t zrow0, int tid, GlaRawA& r) {
    const bf16* KH = (const bf16*)(a.ws + WS_KH) + ((size_t)(b * 4 + h) * KTOK + t0) * 128; const float* Z = (const float*)(a.ws + WS_Z);
#pragma unroll
    for (int j = 0; j < 4; ++j) { const int e = tid + 512 * j; r.k[j] = *(const u32x4*)(KH + (size_t)e * 8); }
#pragma unroll
    for (int j = 0; j < 2; ++j) { const int e = (tid + 512 * j) * 2; r.z[j] = *(const f32x2*)(Z + (zrow0 + (e >> 4)) * 32 + dir * 16 + (e & 15)); }
}
__device__ __forceinline__ void glaA_issue_v(const Args& a, int b, int h, int t0, int tid, GlaRawA& r) {
    const bf16* VH = (const bf16*)(a.ws + WS_VH) + ((size_t)(b * 4 + h) * KTOK + t0) * 256;
#pragma unroll
    for (int j = 0; j < 2; ++j)
#pragma unroll
        for (int rr = 0; rr < 4; ++rr) r.v[4 * j + rr] = *(const u32x4*)(VH + (size_t)(4 * ((tid >> 5) + 16 * j) + rr) * 256 + 8 * (tid & 31));
}
__device__ __forceinline__ void glaA_stage(LAS unsigned char* lds, int wave, int lane, int tid, const GlaRawA& r) {
    LAS bf16* Kr = (LAS bf16*)(lds + GA_K); LAS unsigned* zs = (LAS unsigned*)(lds + GA_Z); LAS bf16* VT = (LAS bf16*)(lds + GA_VT);
#pragma unroll
    for (int j = 0; j < 4; ++j) { const int e = tid + 512 * j, row = e >> 4, c8 = e & 15; *(LAS u32x4*)(Kr + row * GA_LD + 8 * c8) = r.k[j]; }
#pragma unroll
    for (int j = 0; j < 2; ++j) zs[tid + 512 * j] = pk2(r.z[j].x, r.z[j].y);
#pragma unroll
    for (int j = 0; j < 2; ++j) { const int c0 = 8 * (tid & 31), l0 = 4 * ((tid >> 5) + 16 * j);
        const int sw = (((l0 >> 3) ^ ((c0 >> 3) & 7)) << 3) + (l0 & 7);
#pragma unroll
        for (int i2 = 0; i2 < 4; ++i2) {
            const unsigned a0 = r.v[4 * j][i2], a1 = r.v[4 * j + 1][i2], a2 = r.v[4 * j + 2][i2], a3 = r.v[4 * j + 3][i2];
            u32x2 lo, hi; lo.x = (a0 & 0xffffu) | (a1 << 16); lo.y = (a2 & 0xffffu) | (a3 << 16); hi.x = (a0 >> 16) | (a1 & 0xffff0000u); hi.y = (a2 >> 16) | (a3 & 0xffff0000u);
            *(LAS u32x2*)(VT + (c0 + 2 * i2) * GA_LD + sw) = lo; *(LAS u32x2*)(VT + (c0 + 2 * i2 + 1) * GA_LD + sw) = hi; } }
}
__device__ __forceinline__ void glaA_prep(LAS unsigned char* lds, int dir, const bf16x8 wfrag, float bias, float& totacc) {
    const int tid = opaque_tid(), lane = tid & 63, wave = __builtin_amdgcn_readfirstlane(tid >> 6), cidx = lane & 15, q = lane >> 4, d = 16 * wave + cidx;
    const LAS bf16* Kr = (const LAS bf16*)(lds + GA_K); LAS bf16* KeT = (LAS bf16*)(lds + GA_KET); LAS float* dcv = (LAS float*)(lds + GA_DC); const LAS bf16* zs = (const LAS bf16*)(lds + GA_Z);
    float carry = 0.f;
    for (int hh = 0; hh < 2; ++hh) {
        const int it0 = 4 * (dir ? hh : 1 - hh);
        float c[4][4], sq[4], Tt[4];
#pragma unroll
        for (int i = 0; i < 4; ++i) {
            const bf16x8 zf = *(const LAS bf16x8*)(zs + (16 * (it0 + i) + cidx) * 16 + 8 * (q & 1));
            f32x4 pre = {bias, bias, bias, bias};
            pre = MFMA16(zf, wfrag, pre);
#pragma unroll
            for (int r = 0; r < 4; ++r) c[i][r] = fast_logsigmoid(pre[r]) * (1.f / 16.f);
            float t4;
            if (!dir) { c[i][1] += c[i][0]; c[i][2] += c[i][1]; c[i][3] += c[i][2]; t4 = c[i][3]; }
            else { c[i][2] += c[i][3]; c[i][1] += c[i][2]; c[i][0] += c[i][1]; t4 = c[i][0]; }
            float s = t4;
            if (!dir) { const float u = __shfl_up(s, 16); if (q >= 1) s += u; const float u2 = __shfl_up(s, 32); if (q >= 2) s += u2; Tt[i] = __shfl(s, cidx + 48); }
            else { const float u = __shfl_down(s, 16); if (q <= 2) s += u; const float u2 = __shfl_down(s, 32); if (q <= 1) s += u2; Tt[i] = __shfl(s, cidx); }
            sq[i] = s - t4;
        }
        const float toth = (Tt[0] + Tt[1]) + (Tt[2] + Tt[3]);
        float off[4];
        if (!dir) { off[0] = 0.f; off[1] = Tt[0]; off[2] = Tt[0] + Tt[1]; off[3] = Tt[0] + Tt[1] + Tt[2]; }
        else { off[3] = 0.f; off[2] = Tt[3]; off[1] = Tt[3] + Tt[2]; off[0] = Tt[3] + Tt[2] + Tt[1]; }
#pragma unroll
        for (int i = 0; i < 4; ++i) {
            float ke[4];
#pragma unroll
            for (int r = 0; r < 4; ++r) { const int tk = 16 * (it0 + i) + 4 * q + r; const float cum = c[i][r] + off[i] + sq[i]; ke[r] = bf2f(Kr[tk * GA_LD + d]) * __expf(toth - cum + carry); }
            u32x2 kw; kw.x = pk2(ke[0], ke[1]); kw.y = pk2(ke[2], ke[3]);
            *(LAS u32x2*)(KeT + d * GA_LD + 16 * (it0 + i) + 4 * q) = kw;
        }
        carry += toth;
    }
    if (q == 0) { dcv[d] = __expf(carry); totacc += carry; }
}
__device__ __forceinline__ void gla_passA128(const Args& a, LAS unsigned char* lds, int item) {
    const int tid = opaque_tid(), lane = tid & 63, wave = __builtin_amdgcn_readfirstlane(tid >> 6), q = lane >> 4, cidx = lane & 15;
    const bool is_ctx = item >= 256; const int seq = is_ctx ? (item - 256) >> 1 : item >> 4, s = is_ctx ? (item - 256) & 1 : item & 15;
    const int b = seq >> 3, dir = (seq >> 2) & 1, h = seq & 3, nstep = is_ctx ? 1 : 8;
    const size_t rowbase = is_ctx ? (size_t)(NLAT + b * CTXL + s * 128) : (size_t)b * SEQ + (size_t)s * 1024;
    const float* w_a2 = dir ? a.in[10] : a.in[8]; const float* b_a2 = dir ? a.in[11] : a.in[9];
    const bf16x8 wfrag = gla_wfrag(w_a2, h, wave, lane);
    const float bias = b_a2[h * 128 + 16 * wave + cidx];
    f32x4 acc[8][2];
#pragma unroll
    for (int mt = 0; mt < 8; ++mt) { acc[mt][0] = (f32x4){0.f, 0.f, 0.f, 0.f}; acc[mt][1] = (f32x4){0.f, 0.f, 0.f, 0.f}; }
    float totacc = 0.f;
    const int tbase = is_ctx ? SEQ + s * 128 : s * 1024;
    GlaRawA raw; { const int n0 = dir ? (nstep - 1) : 0; glaA_issue(a, b, h, dir, tbase + n0 * 128, rowbase + (size_t)n0 * 128, tid, raw); glaA_issue_v(a, b, h, tbase + n0 * 128, tid, raw); }
    for (int ci = 0; ci < nstep; ++ci) {
        const int nn = dir ? (nstep - 2 - ci) : ci + 1;
        glaA_stage(lds, wave, lane, tid, raw);
        if (ci + 1 < nstep) glaA_issue(a, b, h, dir, tbase + nn * 128, rowbase + (size_t)nn * 128, tid, raw);
        __syncthreads();
        glaA_prep(lds, dir, wfrag, bias, totacc);
        __syncthreads();
        const LAS bf16* VT = (const LAS bf16*)(lds + GA_VT); const LAS bf16* KeT = (const LAS bf16*)(lds + GA_KET); const LAS float* dcv = (const LAS float*)(lds + GA_DC);
        bf16x8 vt[2][4];
#pragma unroll
        for (int n2 = 0; n2 < 2; ++n2)
#pragma unroll
            for (int ks = 0; ks < 4; ++ks) vt[n2][ks] = ldfrag_vt(VT, 32 * wave + 16 * n2, GA_LD, 4 * ks + (lane >> 4), lane);
#pragma unroll
        for (int mt = 0; mt < 8; ++mt) {
            const f32x4 dc4 = *(const LAS f32x4*)(dcv + 16 * mt + 4 * q);
            bf16x8 kf[4];
#pragma unroll
            for (int ks = 0; ks < 4; ++ks) kf[ks] = ldfrag(KeT, 16 * mt, GA_LD, 32 * ks, lane);
#pragma unroll
            for (int n2 = 0; n2 < 2; ++n2) { f32x4 t = acc[mt][n2] * dc4;
#pragma unroll
                for (int ks = 0; ks < 4; ++ks) t = MFMA16(kf[ks], vt[n2][ks], t);
                acc[mt][n2] = t; }
        }
        if (ci + 1 < nstep) glaA_issue_v(a, b, h, tbase + nn * 128, tid, raw);
        __syncthreads();
    }
    float* T = is_ctx ? (float*)(a.ws + WS_TC) + (size_t)(item - 256) * GLA_SV : (float*)(a.ws + WS_T) + (size_t)item * GLA_SV;
#pragma unroll
    for (int mt = 0; mt < 8; ++mt)
#pragma unroll
        for (int n2 = 0; n2 < 2; ++n2)
#pragma unroll
            for (int r = 0; r < 4; ++r) T[(size_t)(16 * mt + 4 * q + r) * 256 + 32 * wave + 16 * n2 + cidx] = acc[mt][n2][r];
    if (q == 0) { float* D = is_ctx ? (float*)(a.ws + WS_DTC) + (size_t)(item - 256) * 128 : (float*)(a.ws + WS_DT) + (size_t)item * 128; D[16 * wave + cidx] = __expf(totacc); }
}

__device__ __forceinline__ void gla_passB(const Args& a) {
    const float* T = (const float*)(a.ws + WS_T); const float* DT = (const float*)(a.ws + WS_DT); float* SST = (float*)(a.ws + WS_SST);
    for (int e = blockIdx.x * NTHREADS + threadIdx.x; e < 16 * (int)GLA_SV; e += gridDim.x * NTHREADS) {
        const int seq = e >> 15, dv = e & 32767, d = dv >> 8, dir = (seq >> 2) & 1;
        float S = 0.f;
        { const float* TC = (const float*)(a.ws + WS_TC); const float* DTC = (const float*)(a.ws + WS_DTC);
#pragma unroll
          for (int j = 0; j < 2; ++j) { const int cc = dir ? 1 - j : j; S = DTC[(size_t)(seq * 2 + cc) * 128 + d] * S + TC[(size_t)(seq * 2 + cc) * GLA_SV + dv]; } }
        float tv[16], dd[16];
#pragma unroll
        for (int si = 0; si < 16; ++si) { const int s = dir ? 15 - si : si; const size_t it = (size_t)seq * 16 + s; tv[si] = T[it * GLA_SV + dv]; dd[si] = DT[it * 128 + d]; }
#pragma unroll
        for (int si = 0; si < 16; ++si) { const int s = dir ? 15 - si : si; const size_t it = (size_t)seq * 16 + s;
            SST[it * GLA_SV + dv] = S; S = dd[si] * S + tv[si]; }
    }
}
__device__ __forceinline__ void gla_passC(const Args& a, LAS unsigned char* lds, int item) {
    const int tid = opaque_tid(), lane = tid & 63, wave = __builtin_amdgcn_readfirstlane(tid >> 6), q = lane >> 4, cidx = lane & 15;
    const int seq = item >> 4, s = item & 15, b = seq >> 3, dir = (seq >> 2) & 1, h = seq & 3;
    const size_t rowbase = (size_t)b * SEQ + (size_t)s * 1024;
    const float* w_a2 = dir ? a.in[10] : a.in[8]; const float* b_a2 = dir ? a.in[11] : a.in[9];
    bf16* O = (bf16*)(a.ws + (dir ? WS_OB : WS_OF));
    const bf16x8 wfrag = gla_wfrag(w_a2, h, wave, lane);
    const float bias = b_a2[h * 128 + 16 * wave + cidx];
    LAS bf16* Qd = (LAS bf16*)(lds + GL_Q); LAS bf16* Ki = (LAS bf16*)(lds + GL_KI); LAS bf16* Pm = Ki; LAS bf16* VT = (LAS bf16*)(lds + GL_VT); LAS bf16* ST = (LAS bf16*)(lds + GL_ST);
    f32x4 acc[8][2];
    { const float* S0 = (const float*)(a.ws + WS_SST) + (size_t)item * GLA_SV;
#pragma unroll
      for (int mt = 0; mt < 8; ++mt)
#pragma unroll
          for (int n2 = 0; n2 < 2; ++n2) {
#pragma unroll
              for (int r = 0; r < 4; ++r) acc[mt][n2][r] = S0[(size_t)(16 * mt + 4 * q + r) * 256 + 32 * wave + 16 * n2 + cidx];
              u32x2 wv; wv.x = pk2(acc[mt][n2][0], acc[mt][n2][1]); wv.y = pk2(acc[mt][n2][2], acc[mt][n2][3]);
              *(LAS u32x2*)(ST + (32 * wave + 16 * n2 + cidx) * GQ_LD + 16 * mt + 4 * q) = wv; } }
    float totacc = 0.f;
    const int tbase = s * 1024;
    GlaRaw raw; gla_issue_loads<true>(a, b, h, dir, tbase + (dir ? 15 : 0) * 64, rowbase + (size_t)(dir ? 15 : 0) * 64, tid, raw); gla_issue_v(a, b, h, tbase + (dir ? 15 : 0) * 64, tid, raw);
    for (int ci = 0; ci < 16; ++ci) {
        const int n = dir ? (15 - ci) : ci; const size_t row0 = rowbase + (size_t)n * 64; const int nn = dir ? (14 - ci) : ci + 1;
        gla_stage<true>(lds, wave, lane, tid, raw);
        if (ci + 1 < 16) gla_issue_loads<true>(a, b, h, dir, tbase + nn * 64, rowbase + (size_t)nn * 64, tid, raw);
        __syncthreads();
        gla_prep<true>(lds, dir, wfrag, bias, totacc);
        __syncthreads();
        const int it = wave >> 1;
        u32x2 pw[2];
#pragma unroll
        for (int jj = 0; jj < 2; ++jj) { const int jt = 2 * (wave & 1) + jj; f32x4 sc = {0.f, 0.f, 0.f, 0.f};
#pragma unroll
            for (int ks = 0; ks < 4; ++ks) sc = MFMA16(ldfrag(Ki, 16 * jt, GQ_LD, 32 * ks, lane), ldfrag(Qd, 16 * it, GQ_LD, 32 * ks, lane), sc);
            const int i = 16 * it + cidx, j0 = 16 * jt + 4 * q;
#pragma unroll
            for (int r = 0; r < 4; ++r) { const bool keep = dir ? (j0 + r >= i) : (j0 + r <= i); sc[r] = keep ? sc[r] : 0.f; }
            pw[jj].x = pk2(sc[0], sc[1]); pw[jj].y = pk2(sc[2], sc[3]); }
        __syncthreads();
#pragma unroll
        for (int jj = 0; jj < 2; ++jj) *(LAS u32x2*)(Pm + (16 * it + cidx) * GK_LD + 16 * (2 * (wave & 1) + jj) + 4 * q) = pw[jj];
        __syncthreads();
        bf16x8 vt[2][2], st[2][4];
#pragma unroll
        for (int n2 = 0; n2 < 2; ++n2) { vt[n2][0] = ldfrag_vt(VT, 32 * wave + 16 * n2, GK_LD, (lane >> 4), lane); vt[n2][1] = ldfrag_vt(VT, 32 * wave + 16 * n2, GK_LD, 4 + (lane >> 4), lane);
#pragma unroll
            for (int ks = 0; ks < 4; ++ks) st[n2][ks] = ldfrag(ST, 32 * wave + 16 * n2, GQ_LD, 32 * ks, lane); }
#pragma unroll
        for (int i2 = 0; i2 < 4; ++i2) {
            const bf16x8 p0 = ldfrag(Pm, 16 * i2, GK_LD, 0, lane), p1 = ldfrag(Pm, 16 * i2, GK_LD, 32, lane);
            bf16x8 qf[4];
#pragma unroll
            for (int ks = 0; ks < 4; ++ks) qf[ks] = ldfrag(Qd, 16 * i2, GQ_LD, 32 * ks, lane);
#pragma unroll
            for (int n2 = 0; n2 < 2; ++n2) { f32x4 o = {0.f, 0.f, 0.f, 0.f};
                o = MFMA16(vt[n2][0], p0, o); o = MFMA16(vt[n2][1], p1, o);
#pragma unroll
                for (int ks = 0; ks < 4; ++ks) o = MFMA16(st[n2][ks], qf[ks], o);
                u32x2 wv; wv.x = pk2(o[0], o[1]); wv.y = pk2(o[2], o[3]);
                *(u32x2*)(O + (row0 + 16 * i2 + cidx) * 1024 + h * 256 + 32 * wave + 16 * n2 + 4 * q) = wv; }
            asm volatile("" ::: "memory");
        }
        if (ci + 1 < 16) gla_issue_v(a, b, h, tbase + nn * 64, tid, raw);
        gla_state_update(lds, lane, vt, acc);
#pragma unroll
        for (int mt = 0; mt < 8; ++mt)
#pragma unroll
            for (int n2 = 0; n2 < 2; ++n2) { u32x2 wv; wv.x = pk2(acc[mt][n2][0], acc[mt][n2][1]); wv.y = pk2(acc[mt][n2][2], acc[mt][n2][3]);
                *(LAS u32x2*)(ST + (32 * wave + 16 * n2 + cidx) * GQ_LD + 16 * mt + 4 * q) = wv; }
        __syncthreads();
    }
}

__device__ __forceinline__ void merge_load(const bf16* OF, const bf16* OB, const bf16* G, int r0, int NGW, int lane, u32x2 (&fa)[2][4], u32x2 (&fb)[2][4], u32x2 (&gw2)[2][4]) {
#pragma unroll
    for (int u = 0; u < 2; ++u) { const int r = r0 + u * NGW; if (r < NLAT) {
#pragma unroll
        for (int j = 0; j < 4; ++j) { const int col = 256 * j + 4 * lane; fa[u][j] = *(const u32x2*)(OF + (size_t)r * 1024 + col); fb[u][j] = *(const u32x2*)(OB + (size_t)r * 1024 + col); gw2[u][j] = *(const u32x2*)(G + (size_t)r * 1024 + col); } } }
}
__device__ __forceinline__ void phase_gla_merge(const Args& a) {
    const int tid = opaque_tid(), lane = tid & 63, wave = tid >> 6;
    if (PROBE_HALF && blockIdx.x >= gridDim.x / 2) return;
    const int gw = blockIdx.x * 8 + wave, NGW = (PROBE_HALF ? gridDim.x / 2 : gridDim.x) * 8;
    const bf16* OF = (const bf16*)(a.ws + WS_OF); const bf16* OB = (const bf16*)(a.ws + WS_OB);
    const bf16* G = (const bf16*)(a.ws + WS_G); bf16* Y = (bf16*)(a.ws + WS_YCAT); const float* gg = a.in[12];
    f32x4 gn[4];
#pragma unroll
    for (int j = 0; j < 4; ++j) gn[j] = *(const f32x4*)(gg + 256 * j + 4 * lane);
    u32x2 fa[2][4], fb[2][4], gw2[2][4], na[2][4], nb[2][4], ng[2][4];
    if (gw < NLAT) merge_load(OF, OB, G, gw, NGW, lane, fa, fb, gw2);
    for (int r0 = gw; r0 < NLAT; r0 += 2 * NGW) {
        if (r0 + 2 * NGW < NLAT) merge_load(OF, OB, G, r0 + 2 * NGW, NGW, lane, na, nb, ng);
#pragma unroll
        for (int u = 0; u < 2; ++u) { const int r = r0 + u * NGW; if (r < NLAT) {
#pragma unroll
            for (int j = 0; j < 4; ++j) {
                const int col = 256 * j + 4 * lane;
                f32x4 o; o.x = __uint_as_float(fa[u][j].x << 16) + __uint_as_float(fb[u][j].x << 16); o.y = __uint_as_float(fa[u][j].x & 0xffff0000u) + __uint_as_float(fb[u][j].x & 0xffff0000u);
                o.z = __uint_as_float(fa[u][j].y << 16) + __uint_as_float(fb[u][j].y << 16); o.w = __uint_as_float(fa[u][j].y & 0xffff0000u) + __uint_as_float(fb[u][j].y & 0xffff0000u);
                const float ss = wave_sum((o.x * o.x + o.y * o.y) + (o.z * o.z + o.w * o.w));
                const float rstd = rsqrtf(ss * (1.f / 256.f) + EPS);
                const float g0 = __uint_as_float(gw2[u][j].x << 16), g1 = __uint_as_float(gw2[u][j].x & 0xffff0000u), g2 = __uint_as_float(gw2[u][j].y << 16), g3 = __uint_as_float(gw2[u][j].y & 0xffff0000u);
                u32x2 w; w.x = pk2(o.x * rstd * gn[j].x * silu_f(g0), o.y * rstd * gn[j].y * silu_f(g1)); w.y = pk2(o.z * rstd * gn[j].z * silu_f(g2), o.w * rstd * gn[j].w * silu_f(g3));
                *(u32x2*)(Y + (size_t)r * DM + col) = w;
            } } }
#pragma unroll
        for (int u = 0; u < 2; ++u)
#pragma unroll
            for (int j = 0; j < 4; ++j) { fa[u][j] = na[u][j]; fb[u][j] = nb[u][j]; gw2[u][j] = ng[u][j]; }
    }
}

constexpr int FLD = 136;
__device__ __forceinline__ void load_dft_frags(const unsigned char* ws, int wave, int lane, bf16x8 (&fc)[4], bf16x8 (&fs)[4]) {
    const bf16* FC = (const bf16*)(ws + WS_FC); const bf16* FS = (const bf16*)(ws + WS_FS);
    const int k = 16 * wave + (lane & 15);
#pragma unroll
    for (int ks = 0; ks < 4; ++ks) { fc[ks] = *(const bf16x8*)(FC + k * 128 + ks * 32 + 8 * (lane >> 4)); fs[ks] = *(const bf16x8*)(FS + k * 128 + ks * 32 + 8 * (lane >> 4)); }
}
__device__ __forceinline__ void store_t4x8(LAS bf16* XT, int c0, int l0, const u32x4 (&x)[4]) {
#pragma unroll
    for (int i2 = 0; i2 < 4; ++i2) {
        const unsigned a0 = x[0][i2], a1 = x[1][i2], a2 = x[2][i2], a3 = x[3][i2];
        u32x2 lo, hi; lo.x = (a0 & 0xffffu) | (a1 << 16); lo.y = (a2 & 0xffffu) | (a3 << 16); hi.x = (a0 >> 16) | (a1 & 0xffff0000u); hi.y = (a2 >> 16) | (a3 & 0xffff0000u);
        const int sw = (((l0 >> 3) ^ ((c0 >> 3) & 7)) << 3) + (l0 & 7);
        *(LAS u32x2*)(XT + (c0 + 2 * i2) * FLD + sw) = lo; *(LAS u32x2*)(XT + (c0 + 2 * i2 + 1) * FLD + sw) = hi; }
}
__device__ __forceinline__ bf16x8 ldfrag_sw(const LAS bf16* XT, int row0, int kc, int lane) { const int row = row0 + (lane & 15); return *(const LAS bf16x8*)(XT + row * FLD + ((kc ^ ((row >> 3) & 7)) << 3)); }
__device__ __forceinline__ void phase_f1(const Args& a, LAS unsigned char* lds) {
    const int tid = opaque_tid(), lane = tid & 63, wave = __builtin_amdgcn_readfirstlane(tid >> 6), q = lane >> 4, cidx = lane & 15;
    const bf16* P = (const bf16*)(a.ws + WS_U); const f32x2* TW = (const f32x2*)(a.ws + WS_TW);
    bf16* A1r = (bf16*)(a.ws + WS_FA); bf16* A1i = (bf16*)(a.ws + WS_FAI);
    LAS bf16* XT = (LAS bf16*)lds;
    bf16x8 fc[4], fs[4]; load_dft_frags(a.ws, wave, lane, fc, fs);
    const int k1 = 16 * wave + cidx;
    u32x4 xp[2][4];
    auto f1_load = [&](int item) { const int cb = item & 3, l2 = (item >> 2) & 127, b = item >> 9, ch0 = cb * 256;
#pragma unroll
        for (int j = 0; j < 2; ++j) { const int task = tid + 512 * j, cblk = task & 31, lb = task >> 5;
#pragma unroll
            for (int r = 0; r < 4; ++r) xp[j][r] = *(const u32x4*)(P + ((size_t)b * SEQ + 128 * (4 * lb + r) + l2) * 1024 + ch0 + 8 * cblk); } };
    if ((int)blockIdx.x < 1024) f1_load(blockIdx.x);
    for (int item = blockIdx.x; item < 1024; item += gridDim.x) {
        const int cb = item & 3, l2 = (item >> 2) & 127, b = item >> 9, ch0 = cb * 256;
#pragma unroll
        for (int j = 0; j < 2; ++j) { const int task = tid + 512 * j, cblk = task & 31, lb = task >> 5; store_t4x8(XT, 8 * cblk, 4 * lb, xp[j]); }
        if (item + (int)gridDim.x < 1024) f1_load(item + gridDim.x);
        __syncthreads();
        if (wave < 5) {
        const f32x2 tw = TW[l2 * k1];
        LAS unsigned char* ost = lds + 69632 + wave * 8448;
        u32x2 wim[16];
#pragma unroll
        for (int mt = 0; mt < 16; ++mt) {
            f32x4 cr = {0.f, 0.f, 0.f, 0.f}, cs = {0.f, 0.f, 0.f, 0.f};
#pragma unroll
            for (int ks = 0; ks < 4; ++ks) { const bf16x8 xa = ldfrag_sw(XT, 16 * mt, 4 * ks + q, lane); cr = MFMA16(xa, fc[ks], cr); cs = MFMA16(xa, fs[ks], cs); }
            const f32x4 br = cr * tw.x - cs * tw.y, bi = -(cs * tw.x + cr * tw.y);
            u32x2 wr_; wr_.x = pk2(br[0], br[1]); wr_.y = pk2(br[2], br[3]); wim[mt].x = pk2(bi[0], bi[1]); wim[mt].y = pk2(bi[2], bi[3]);
            *(LAS u32x2*)(ost + cidx * 528 + (16 * mt + 4 * q) * 2) = wr_;
        }
        const size_t obase = (((size_t)b * 128 + 16 * wave) * 128 + l2) * 1024 + ch0;
#pragma unroll
        for (int i = 0; i < 8; ++i) { const int row = 2 * i + (lane >> 5), ck = lane & 31; const u32x4 v = *(const LAS u32x4*)(ost + row * 528 + ck * 16); *(u32x4*)(A1r + obase + (size_t)row * 128 * 1024 + 8 * ck) = v; }
#pragma unroll
        for (int mt = 0; mt < 16; ++mt) *(LAS u32x2*)(ost + cidx * 528 + (16 * mt + 4 * q) * 2) = wim[mt];
#pragma unroll
        for (int i = 0; i < 8; ++i) { const int row = 2 * i + (lane >> 5), ck = lane & 31; const u32x4 v = *(const LAS u32x4*)(ost + row * 528 + ck * 16); *(u32x4*)(A1i + obase + (size_t)row * 128 * 1024 + 8 * ck) = v; }
        }
        __syncthreads();
    }
}
constexpr int F34_ITEMS = NB * 65 * 8;
__device__ __forceinline__ void phase_f34(const Args& a, LAS unsigned char* lds) {
    const int tid = opaque_tid(), lane = tid & 63, wave = __builtin_amdgcn_readfirstlane(tid >> 6), q = lane >> 4, cidx = lane & 15;
    const bf16* A1r = (const bf16*)(a.ws + WS_FA); const bf16* A1i = (const bf16*)(a.ws + WS_FAI); bf16* Y = (bf16*)(a.ws + WS_YCAT);
    LAS bf16* XTr = (LAS bf16*)lds; LAS bf16* XTi = XTr + 128 * FLD; LAS bf16* XKr = XTi + 128 * FLD; LAS bf16* XKi = XKr + 128 * FLD;
    bf16x8 fc[4], fs[4]; load_dft_frags(a.ws, wave, lane, fc, fs);
    const float nrm = 1.0f / 1448.15468787005f;
    u32x4 xr[4], xi[4];
    auto f34_load = [&](int item) { const int g = item & 7, k1 = (item >> 3) % 65, b = (item >> 3) / 65, ch0 = g * 128; const int cblk = tid & 15, lb = tid >> 4;
#pragma unroll
        for (int r = 0; r < 4; ++r) { const size_t off = (((size_t)b * 128 + k1) * 128 + 4 * lb + r) * 1024 + ch0 + 8 * cblk; xr[r] = *(const u32x4*)(A1r + off); xi[r] = *(const u32x4*)(A1i + off); } };
    if ((int)blockIdx.x < F34_ITEMS) f34_load(blockIdx.x);
    for (int item = blockIdx.x; item < F34_ITEMS; item += gridDim.x) {
        const int g = item & 7, k1 = (item >> 3) % 65, b = (item >> 3) / 65, ch0 = g * 128;
        { const int cblk = tid & 15, lb = tid >> 4; store_t4x8(XTr, 8 * cblk, 4 * lb, xr); store_t4x8(XTi, 8 * cblk, 4 * lb, xi); }
        if (item + (int)gridDim.x < F34_ITEMS) f34_load(item + gridDim.x);
        __syncthreads();
        const int k2 = 16 * wave + cidx;
#pragma unroll 2
        for (int mt = 0; mt < 8; ++mt) {
            f32x4 a1 = {0.f, 0.f, 0.f, 0.f}, a2 = a1, b1 = a1, b2 = a1;
#pragma unroll
            for (int ks = 0; ks < 4; ++ks) { const bf16x8 xa = ldfrag_sw(XTr, 16 * mt, 4 * ks + q, lane); const bf16x8 xb = ldfrag_sw(XTi, 16 * mt, 4 * ks + q, lane);
                a1 = MFMA16(xa, fc[ks], a1); b2 = MFMA16(xa, fs[ks], b2); a2 = MFMA16(xb, fs[ks], a2); b1 = MFMA16(xb, fc[ks], b1); }
            const f32x4 xre = a1 + a2, xim = b1 - b2;
            u32x2 wr_; wr_.x = pk2(xre[0], xre[1]); wr_.y = pk2(xre[2], xre[3]); u32x2 wi_; wi_.x = pk2(xim[0], xim[1]); wi_.y = pk2(xim[2], xim[3]);
            *(LAS u32x2*)(XKr + k2 * FLD + 16 * mt + 4 * q) = wr_; *(LAS u32x2*)(XKi + k2 * FLD + 16 * mt + 4 * q) = wi_;
        }
        __syncthreads();
#pragma unroll 2
        for (int nt = 0; nt < 8; ++nt) {
            f32x4 y = {0.f, 0.f, 0.f, 0.f};
#pragma unroll
            for (int ks = 0; ks < 4; ++ks) { const bf16x8 xa = *(const LAS bf16x8*)(XKr + (16 * nt + cidx) * FLD + ks * 32 + 8 * q); const bf16x8 xb = *(const LAS bf16x8*)(XKi + (16 * nt + cidx) * FLD + ks * 32 + 8 * q);
                y = MFMA16(fc[ks], xa, y); y = MFMA16(fs[ks], xb, y); }
            u32x2 w; w.x = pk2(y[0] * nrm, y[1] * nrm); w.y = pk2(y[2] * nrm, y[3] * nrm);
            *(LAS u32x2*)(XTr + (16 * nt + cidx) * FLD + 16 * wave + 4 * q) = w;
        }
        __syncthreads();
#pragma unroll
        for (int i = 0; i < 4; ++i) { const int task = tid + 512 * i, row = task >> 4, ck = task & 15; const u32x4 v = *(const LAS u32x4*)(XTr + row * FLD + 8 * ck);
            *(u32x4*)(Y + ((size_t)b * SEQ + k1 + 128 * row) * DM + 1024 + ch0 + 8 * ck) = v; }
        if (k1 >= 1 && k1 <= 63) {
#pragma unroll
            for (int i = 0; i < 4; ++i) { const int task = tid + 512 * i, row = task >> 4, ck = task & 15; const LAS bf16* sr = XTr + (127 - row) * FLD; unsigned e[8];
#pragma unroll
                for (int j = 0; j < 8; ++j) e[j] = sr[(128 - (8 * ck + j)) & 127];
                const u32x4 v = {e[0] | (e[1] << 16), e[2] | (e[3] << 16), e[4] | (e[5] << 16), e[6] | (e[7] << 16)};
                *(u32x4*)(Y + ((size_t)b * SEQ + (128 - k1) + 128 * row) * DM + 1024 + ch0 + 8 * ck) = v; }
        }
        __syncthreads();
    }
}

__device__ __forceinline__ void phase_topk(const Args& a, LAS unsigned char* lds) {
    const int tid = opaque_tid(), lane = tid & 63, wave = tid >> 6;
    LAS unsigned* keys = (LAS unsigned*)lds;
    LAS unsigned* hist = (LAS unsigned*)(lds + 65536);
    LAS unsigned* misc = hist + 256;
    LAS unsigned* wtot = misc + 16;
    const float* AFF = (const float*)(a.ws + WS_AFF); int* TOK = (int*)(a.ws + WS_TOK); float* GATE = (float*)(a.ws + WS_GATE); int* SEL = (int*)(a.ws + WS_SEL);
    for (int be = blockIdx.x; be < NB * NE; be += gridDim.x) {
        const int b = be / NE, e = be % NE;
        for (int i = tid; i < SEQ; i += NTHREADS) keys[i] = __float_as_uint(AFF[(size_t)be * SEQ + i]);
        unsigned prefix = 0u, pmask = 0u, krem = CAP;
        for (int pass = 0; pass < 4; ++pass) {
            const int shift = 24 - 8 * pass;
            if (tid < 256) hist[tid] = 0u;
            __syncthreads();
            for (int i = tid; i < SEQ; i += NTHREADS) { const unsigned k = keys[i]; if ((k & pmask) == prefix) __hip_atomic_fetch_add(&hist[(k >> shift) & 255u], 1u, __ATOMIC_RELAXED, __HIP_MEMORY_SCOPE_WORKGROUP); }
            __syncthreads();
            if (wave == 0) {
                const unsigned h0 = hist[4 * lane], h1 = hist[4 * lane + 1], h2 = hist[4 * lane + 2], h3 = hist[4 * lane + 3];
                const unsigned sl = h0 + h1 + h2 + h3; unsigned S = sl;
#pragma unroll
                for (int o = 1; o < 64; o <<= 1) { const unsigned t = __shfl_down(S, o); if (lane + o < 64) S += t; }
                const unsigned long long m = __ballot(S >= krem);
                const int ls = 63 - __builtin_clzll(m);
                if (lane == ls) { unsigned cum = S - sl; int bsel;
                    if (cum + h3 >= krem) bsel = 3; else { cum += h3; if (cum + h2 >= krem) bsel = 2; else { cum += h2; if (cum + h1 >= krem) bsel = 1; else { cum += h1; bsel = 0; } } }
                    misc[0] = prefix | ((unsigned)(4 * lane + bsel) << shift); misc[1] = krem - cum; }
            }
            __syncthreads();
            prefix = misc[0]; krem = misc[1]; pmask |= (0xffu << shift);
            __syncthreads();
        }
        const unsigned T = prefix;
        unsigned cg_ = 0u, ce = 0u;
        for (int i = 0; i < 32; ++i) { const unsigned k = keys[tid * 32 + i]; cg_ += (k > T); ce += (k == T); }
        unsigned ig = cg_, ie = ce;
#pragma unroll
        for (int o = 1; o < 64; o <<= 1) { const unsigned tg = __shfl_up(ig, o), te = __shfl_up(ie, o); if (lane >= o) { ig += tg; ie += te; } }
        if (lane == 63) { wtot[wave * 2] = ig; wtot[wave * 2 + 1] = ie; }
        __syncthreads();
        unsigned gt_before = ig - cg_, eq_before = ie - ce;
        for (int w8 = 0; w8 < wave; ++w8) { gt_before += wtot[w8 * 2]; eq_before += wtot[w8 * 2 + 1]; }
        for (int i = 0; i < 32; ++i) { const int t = tid * 32 + i; const unsigned k = keys[t];
            const bool isgt = k > T, iseq = k == T; const bool take = isgt || (iseq && eq_before < krem);
            const unsigned slot = gt_before + (eq_before < krem ? eq_before : krem);
            if (take) { TOK[(size_t)be * CAP + slot] = t; GATE[(size_t)be * CAP + slot] = __uint_as_float(k); }
            SEL[((size_t)b * SEQ + t) * NE + e] = take ? (int)slot : -1;
            gt_before += isgt; eq_before += iseq; }
        __syncthreads();
    }
}

__device__ __forceinline__ void acc_yrow8(f32x4 (&m)[8], const u32x2 (&w)[4], float gt) {
#pragma unroll
    for (int j = 0; j < 4; ++j) { const f32x2 a0 = __builtin_amdgcn_cvt_pk_f32_fp8((int)w[j].x, false), a1 = __builtin_amdgcn_cvt_pk_f32_fp8((int)w[j].x, true), a2 = __builtin_amdgcn_cvt_pk_f32_fp8((int)w[j].y, false), a3 = __builtin_amdgcn_cvt_pk_f32_fp8((int)w[j].y, true);
        m[2 * j].x += gt * a0.x; m[2 * j].y += gt * a0.y; m[2 * j].z += gt * a1.x; m[2 * j].w += gt * a1.y; m[2 * j + 1].x += gt * a2.x; m[2 * j + 1].y += gt * a2.y; m[2 * j + 1].z += gt * a3.x; m[2 * j + 1].w += gt * a3.y; }
}
__device__ __forceinline__ void phase_final(const Args& a) {
    const int tid = opaque_tid(), lane = tid & 63, wave = tid >> 6;
    if (PROBE_HALF && blockIdx.x >= gridDim.x / 2) return;
    const int gw = blockIdx.x * 8 + wave, NGW = (PROBE_HALF ? gridDim.x / 2 : gridDim.x) * 8;
    const float* ada = (const float*)(a.ws + WS_ADA); const float* fg = a.in[19];
    const bf16* DL = (const bf16*)(a.ws + WS_DLT); const unsigned char* YE = a.ws + WS_YE;
    const float* GATE = (const float*)(a.ws + WS_GATE); const int* SEL = (const int*)(a.ws + WS_SEL);
    int selA = -1, selB = -1;
    { const int r = gw; if (r < NLAT && lane < NE) selA = SEL[(size_t)r * NE + lane]; if (r + NGW < NLAT && lane < NE) selB = SEL[(size_t)(r + NGW) * NE + lane]; }
    for (int r0 = gw; r0 < NLAT; r0 += 2 * NGW) {
        const int rA = r0, rB = r0 + NGW; const bool hasB = rB < NLAT;
        const int bA = rA / SEQ, bB = hasB ? rB / SEQ : bA;
        u32x4 dlA[4], dlB[4];
#pragma unroll
        for (int j = 0; j < 4; ++j) { dlA[j] = *(const u32x4*)(DL + (size_t)rA * DM + 512 * j + 8 * lane); dlB[j] = *(const u32x4*)(DL + (size_t)(hasB ? rB : rA) * DM + 512 * j + 8 * lane); }
        const float gtA = selA >= 0 ? GATE[((size_t)bA * NE + lane) * CAP + selA] : 0.f, gtB = selB >= 0 ? GATE[((size_t)bB * NE + lane) * CAP + selB] : 0.f;
        const int rowA = selA >= 0 ? (lane * 2 + bA) * CAP + selA : 0, rowB = selB >= 0 ? (lane * 2 + bB) * CAP + selB : 0;
        unsigned long long mA = __ballot(selA >= 0), mB = __ballot(selB >= 0);
        { const int rn = r0 + 2 * NGW; selA = -1; selB = -1; if (rn < NLAT && lane < NE) selA = SEL[(size_t)rn * NE + lane]; if (rn + NGW < NLAT && lane < NE) selB = SEL[(size_t)(rn + NGW) * NE + lane]; }
        f32x4 accA[8], accB[8];
#pragma unroll
        for (int j = 0; j < 8; ++j) { accA[j] = (f32x4){0.f, 0.f, 0.f, 0.f}; accB[j] = (f32x4){0.f, 0.f, 0.f, 0.f}; }
        while (mA | mB) {
            const bool hA = mA != 0ull, hB = mB != 0ull;
            const int eA = hA ? __builtin_ctzll(mA) : 0, eB = hB ? __builtin_ctzll(mB) : 0; mA &= mA - 1; mB &= mB - 1;
            const int yrA = hA ? __builtin_amdgcn_readlane(rowA, eA) : 0, yrB = hB ? __builtin_amdgcn_readlane(rowB, eB) : 0;
            const float gA = hA ? __builtin_bit_cast(float, __builtin_amdgcn_readlane(__builtin_bit_cast(int, gtA), eA)) : 0.f;
            const float gB = hB ? __builtin_bit_cast(float, __builtin_amdgcn_readlane(__builtin_bit_cast(int, gtB), eB)) : 0.f;
            const unsigned char* y0 = YE + (size_t)yrA * DM + 8 * lane; const unsigned char* y1 = YE + (size_t)yrB * DM + 8 * lane;
            u32x2 w0[4], w1[4];
#pragma unroll
            for (int j = 0; j < 4; ++j) { w0[j] = *(const u32x2*)(y0 + 512 * j); w1[j] = *(const u32x2*)(y1 + 512 * j); }
            acc_yrow8(accA, w0, gA); acc_yrow8(accB, w1, gB);
        }
#pragma unroll
        for (int u = 0; u < 2; ++u) { if (u == 1 && !hasB) break;
            const int r = u ? rB : rA; const float* g2 = ada + (size_t)(u ? bB : bA) * 12288 + 5 * DM;
            float ss = 0.f; f32x4 m[8];
#pragma unroll
            for (int j = 0; j < 4; ++j) { const int d = 512 * j + 8 * lane; const f32x4 gv0 = *(const f32x4*)(g2 + d), gv1 = *(const f32x4*)(g2 + d + 4); const u32x4 dw = u ? dlB[j] : dlA[j];
                const f32x4 d0 = {__uint_as_float(dw.x << 16), __uint_as_float(dw.x & 0xffff0000u), __uint_as_float(dw.y << 16), __uint_as_float(dw.y & 0xffff0000u)};
                const f32x4 d1 = {__uint_as_float(dw.z << 16), __uint_as_float(dw.z & 0xffff0000u), __uint_as_float(dw.w << 16), __uint_as_float(dw.w & 0xffff0000u)};
                m[2 * j] = d0 + gv0 * (u ? accB[2 * j] : accA[2 * j]); m[2 * j + 1] = d1 + gv1 * (u ? accB[2 * j + 1] : accA[2 * j + 1]);
                ss += (m[2 * j].x * m[2 * j].x + m[2 * j].y * m[2 * j].y) + (m[2 * j].z * m[2 * j].z + m[2 * j].w * m[2 * j].w) + (m[2 * j + 1].x * m[2 * j + 1].x + m[2 * j + 1].y * m[2 * j + 1].y) + (m[2 * j + 1].z * m[2 * j + 1].z + m[2 * j + 1].w * m[2 * j + 1].w); }
            const float rstd = rsqrtf(wave_sum(ss) * (1.f / DM) + EPS);
#pragma unroll
            for (int j = 0; j < 4; ++j) { const int d = 512 * j + 8 * lane; const f32x4 gv0 = *(const f32x4*)(fg + d), gv1 = *(const f32x4*)(fg + d + 4);
                *(f32x4*)(a.out + (size_t)r * DM + d) = m[2 * j] * rstd * gv0; *(f32x4*)(a.out + (size_t)r * DM + d + 4) = m[2 * j + 1] * rstd * gv1; }
        }
    }
}

#define XB_TMO      128
#define XB_XCNT(j)  (256  + 64 * (j))
#define XB_XSUB(j)  (1280 + 64 * (j))
#define XB_XGEN(j)  (2304 + 64 * (j))
#define XB_TOP      3328
#define XB_TOPGEN   3392
#define XCD_BAR_WORDS 3456
#define XB_SPIN_CAP (1u << 18)
__device__ __forceinline__ unsigned xb_ld(unsigned* p)              { return __hip_atomic_load(p, __ATOMIC_RELAXED, __HIP_MEMORY_SCOPE_AGENT); }
__device__ __forceinline__ unsigned xb_add(unsigned* p, unsigned v) { return __hip_atomic_fetch_add(p, v, __ATOMIC_RELAXED, __HIP_MEMORY_SCOPE_AGENT); }
__device__ __forceinline__ unsigned xb_xcc_id() { return (unsigned)__builtin_amdgcn_s_getreg((3 << 11) | 20) & 0xFu; }
#define XB_SPIN(cond, bar) do { unsigned _sp = 0; while (cond) { __builtin_amdgcn_s_sleep(1); \
    if ((++_sp & 255u) == 0u) { if (xb_ld(&(bar)[XB_TMO])) break; if (_sp > XB_SPIN_CAP) { atomicAdd(&(bar)[XB_TMO], 1u); break; } } } } while (0)
struct XcdBarrier { unsigned* bar; unsigned x; volatile LAS unsigned* st; };
__device__ __forceinline__ XcdBarrier xcd_barrier_post(unsigned* bar, volatile LAS unsigned* st) {
    XcdBarrier b; b.bar = bar; b.x = xb_xcc_id(); b.st = st;
    if (threadIdx.x == 0) (void)xb_add(&bar[XB_XCNT(b.x)], 1u);
    return b;
}
__device__ __forceinline__ void xcd_barrier_complete(unsigned* bar, unsigned x, unsigned& nloc, unsigned& nx) {
    const unsigned G = gridDim.x * gridDim.y * gridDim.z;
    unsigned sum, cnt, mine, sp = 0u;
    for (;;) {
        sum = 0u; cnt = 0u; mine = 0u;
#pragma unroll
        for (unsigned j = 0; j < 16; ++j) { const unsigned c = xb_ld(&bar[XB_XCNT(j)]); sum += c; cnt += (c > 0u) ? 1u : 0u; mine = (j == x) ? c : mine; }
        if (sum == G) break;
        __builtin_amdgcn_s_sleep(1);
        if ((++sp & 255u) == 0u) { if (xb_ld(&bar[XB_TMO])) break; if (sp > XB_SPIN_CAP) { atomicAdd(&bar[XB_TMO], 1u); break; } }
    }
    nloc = mine > 0u ? mine : 1u; nx = cnt > 0u ? cnt : 1u;
}
__device__ __forceinline__ void xcd_barrier(const XcdBarrier& b) {
    asm volatile("s_waitcnt vmcnt(0)" ::: "memory");
    __syncthreads();
    if (threadIdx.x == 0) {
        unsigned* bar = b.bar;
        __builtin_amdgcn_s_waitcnt(0);
        unsigned nloc = b.st[0], nx = b.st[1];
        if (nloc == 0u) { xcd_barrier_complete(bar, b.x, nloc, nx); b.st[0] = nloc; b.st[1] = nx; }
        const unsigned old = xb_add(&bar[XB_XSUB(b.x)], 1u);
        const unsigned gen = old / nloc;
        if (old + 1u == (gen + 1u) * nloc) {
            __builtin_amdgcn_fence(__ATOMIC_RELEASE, "agent");
            asm volatile("s_waitcnt vmcnt(0)" ::: "memory");
            const unsigned og = xb_add(&bar[XB_TOP], 1u);
            const unsigned tg = og / nx;
            if (og + 1u == (tg + 1u) * nx) xb_add(&bar[XB_TOPGEN], 1u);
            else XB_SPIN(xb_ld(&bar[XB_TOPGEN]) == tg, bar);
            __builtin_amdgcn_fence(__ATOMIC_ACQUIRE, "agent");
            xb_add(&bar[XB_XGEN(b.x)], 1u);
            asm volatile("s_waitcnt vmcnt(0)" ::: "memory");
        } else {
            XB_SPIN(xb_ld(&bar[XB_XGEN(b.x)]) == gen, bar);
            __builtin_amdgcn_fence(__ATOMIC_ACQUIRE, "agent");
            asm volatile("s_waitcnt vmcnt(0)" ::: "memory");
        }
    }
    __syncthreads();
}

#ifndef STAGGER_US
#define STAGGER_US 0
#endif
__device__ __forceinline__ void gemm_stagger() {
    if (STAGGER_US > 0 && (blockIdx.x & 1)) { const unsigned long long t0 = __builtin_amdgcn_s_memrealtime();
        while (__builtin_amdgcn_s_memrealtime() - t0 < (unsigned long long)(STAGGER_US * 100)) __builtin_amdgcn_s_sleep(32); }
}
constexpr int NPHASES = 15;
__global__ void __launch_bounds__(NTHREADS, 2) mega(Args a) {
    extern __shared__ __attribute__((aligned(16))) unsigned char lds_raw[];
    LAS unsigned char* lds = (LAS unsigned char*)lds_raw;
    const int lo = a.ph_lo, hi = a.ph_hi;
    unsigned char* ws = a.ws;
#if USE_CG_SYNC
    cg::grid_group grid = cg::this_grid();
#define GRID_SYNC() grid.sync()
#else
    volatile LAS unsigned* bst = (volatile LAS unsigned*)(lds + LDS_BYTES - 16);
    if (threadIdx.x < 2) bst[threadIdx.x] = 0u;
    __syncthreads();
    XcdBarrier xbar = xcd_barrier_post((unsigned*)(ws + WS_CTL), bst);
#define GRID_SYNC() xcd_barrier(xbar)
#endif
#define IN(k) (lo <= (k) && (k) < hi)
#define SEAM(k) do { if (IN(k) && IN((k) + 1)) { GRID_SYNC(); if (PROBE_BAR) GRID_SYNC(); } } while (0)
#define PH(k, ...) do { if (IN(k)) { __VA_ARGS__; if ((PROBE_MASK >> (k)) & 1u) { GRID_SYNC(); __VA_ARGS__; } } SEAM(k); } while (0)
    PH(0, phase0(a, lds));
    PH(1, {
        finalize_ada(a);
        quantize_win(a);
        const int nsp = gridDim.x >= 64 ? 12 : 0, nreg = gridDim.x - nsp;
        if ((int)blockIdx.x >= nreg) {
            const int si = blockIdx.x - nreg, b = si / 6, pn = 2 + si % 6;
            if (threadIdx.x < 64) { unsigned* cnt = (unsigned*)(ws + WS_CTL) + CW_CTXCNT + 64 * b; unsigned sp = 0;
                while ((unsigned)__builtin_amdgcn_readfirstlane(__hip_atomic_load(cnt, __ATOMIC_RELAXED, __HIP_MEMORY_SCOPE_AGENT)) < 16u) { __builtin_amdgcn_s_sleep(4); if (++sp > (1u << 22)) break; }
                __builtin_amdgcn_fence(__ATOMIC_ACQUIRE, "agent");
                asm volatile("s_waitcnt vmcnt(0)" ::: "memory"); }
            __syncthreads();
            SchedOne S; S.A = (const char*)(ws + WS_H); S.B = (const char*)(ws + WS_WIN); S.tstep = (size_t)256 * DM * 2; S.pm = NLAT / 256 + b; S.pn = pn;
            EpiInProj E{ws};
            pg8::gemm_phase<EpiInProj, SchedOne, false, true, true>(lds, DM, S, E);
        } else phase_norm_tile<0>(a, lds, blockIdx.x, nreg, NROWS / 16); });
    PH(2, {
        if (gridDim.x >= 64) {
            if (INPROJ_BF16_TILES > 0) {
                SchedPlain S; S.init(NLAT / 256, INPROJ_BF16_TILES, gridDim.x, blockIdx.x); S.A = (const char*)(ws + WS_H); S.B = (const char*)(ws + WS_WIN); S.tstep = (size_t)256 * DM * 2;
                EpiInProj E{ws};
                pg8::gemm_phase<EpiInProj, SchedPlain, false, true, true>(lds, DM, S, E);
            }
            SchedPlain S; S.init(NLAT / 256, WIN_ROWS / 256 - INPROJ_BF16_TILES, gridDim.x, blockIdx.x, INPROJ_BF16_TILES); S.A = (const char*)(ws + WS_H8); S.B = (const char*)(ws + WS_WIN8); S.tstep = (size_t)256 * DM;
            EpiInProj8 E{ws};
            pg8::gemm_phase<EpiInProj8, SchedPlain, false, true, true, 2>(lds, DM / 2, S, E);
        } });
    PH(3, { for (int it = blockIdx.x; it < 288; it += gridDim.x) gla_passA128(a, lds, it); });
    PH(4, { gla_passB(a); phase_f1(a, lds); });
    PH(5, { for (int it = blockIdx.x; it < 256; it += gridDim.x) gla_passC(a, lds, it); });
    PH(6, phase_gla_merge(a));
    PH(8, { phase_f34(a, lds); __syncthreads(); t64_range(a, lds, P0_NT64, P0_NT64 + BG8_ITEMS, gridDim.x > 16 ? 16 : 0); });
    PH(9, {
        gemm_stagger();
        SchedPlain S; S.init(NLAT / 256, DM / 256, gridDim.x, blockIdx.x); S.A = (const char*)(ws + WS_YCAT); S.B = (const char*)(ws + WS_WOUT); S.tstep = (size_t)256 * DM * 2;
        EpiOutProj E{a.in[0], (bf16*)(ws + WS_DLT), (const float*)(ws + WS_ADA)};
        pg8::gemm_phase<EpiOutProj, SchedPlain, false, true, true>(lds, DM, S, E); });
    PH(10, phase_norm_tile<1>(a, lds, blockIdx.x, gridDim.x, NLAT / 16));
    PH(11, { phase_topk(a, lds); __syncthreads(); t64_range(a, lds, P0_NT64 + BG8_ITEMS, T64_ALL, gridDim.x > 32 ? 32 : 0); });
    PH(12, {
        gemm_stagger();
        SchedMoeUp S; S.init(256, 8, gridDim.x, blockIdx.x); S.A = (const char*)(ws + WS_HF); S.B = (const char*)(ws + WS_WGU); S.tok = (const int*)(ws + WS_TOK);
        EpiSwiglu E{ws + WS_HID};
        pg8::gemm_phase<EpiSwiglu, SchedMoeUp, true, true, true, 1>(lds, DM / 2, S, E); });
    PH(13, {
        gemm_stagger();
        SchedMoeDown S; S.init(256, 8, gridDim.x, blockIdx.x); S.A = (const char*)(ws + WS_HID); S.B = (const char*)(ws + WS_WD);
        EpiF8 E{ws + WS_YE, DM, 1.f / W8_SCALE};
        pg8::gemm_phase<EpiF8, SchedMoeDown, true, true, true, 1>(lds, DEXP / 2, S, E); });
    PH(14, phase_final(a));
#undef PH
#undef IN
#undef SEAM
}

#ifndef N_LAUNCH_MODE
#define N_LAUNCH_MODE 1
#endif
extern "C" void kernel_launch(void* const* d_in, const int* in_sizes, int n_in, void* d_out, int out_size, void* d_ws, size_t ws_size, hipStream_t stream) {
    static int grid = 0;
    if (grid == 0) {
        if (n_in != 20 || out_size != NLAT * DM || ws_size < WS_END) { fprintf(stderr, "kernel_launch: unexpected sizes n_in %d out %d ws %zu\n", n_in, out_size, ws_size); grid = -1; return; }
        int dev = 0, cus = 0, per_cu = 0;
        (void)hipGetDevice(&dev); (void)hipDeviceGetAttribute(&cus, hipDeviceAttributeMultiprocessorCount, dev);
        if (hipFuncSetAttribute((const void*)mega, hipFuncAttributeMaxDynamicSharedMemorySize, LDS_BYTES) != hipSuccess) { fprintf(stderr, "kernel_launch: hipFuncSetAttribute failed\n"); grid = -1; return; }
        (void)hipOccupancyMaxActiveBlocksPerMultiprocessor(&per_cu, (const void*)mega, NTHREADS, LDS_BYTES);
        if (per_cu < 1) { fprintf(stderr, "kernel_launch: occupancy query reports %d blocks per CU\n", per_cu); per_cu = 1; }
        (void)hipGetLastError();
        grid = cus * 1;
    }
    if (grid < 0) return;
    Args a{};
    for (int i = 0; i < 20; ++i) a.in[i] = (const float*)d_in[i];
    a.out = (float*)d_out; a.ws = (unsigned char*)d_ws;
#if N_LAUNCH_MODE == 0
    for (int p = 0; p < NPHASES; ++p) { a.ph_lo = p; a.ph_hi = p + 1; hipLaunchKernelGGL(mega, dim3(grid), dim3(NTHREADS), LDS_BYTES, stream, a); }
#else
    a.ph_lo = 0; a.ph_hi = NPHASES;
#if USE_CG_SYNC
    void* args[] = {&a};
    hipError_t e = hipLaunchCooperativeKernel((void*)mega, dim3(grid), dim3(NTHREADS), args, LDS_BYTES, stream);
    if (e != hipSuccess) fprintf(stderr, "cooperative launch failed: %s (grid %d)\n", hipGetErrorString(e), grid);
#else
    if (hipMemsetAsync((char*)d_ws + WS_CTL, 0, CTL_BYTES, stream) != hipSuccess) { fprintf(stderr, "kernel_launch: memset of control words failed\n"); return; }
    hipLaunchKernelGGL(mega, dim3(grid), dim3(NTHREADS), LDS_BYTES, stream, a);
#endif
#endif
}
```
